# Optimizing an MI355X kernel written in HIP

```python
import math
import jax
import jax.numpy as jnp
from jax import lax
import numpy as np

D_MODEL = 1024
BATCH = 8
SEQ = 2048
DEPTH = 2

D_MIX = 2 * D_MODEL
CONV_WIDTH = 4
EPS = 1e-6
N_ADA = 6
SSD_INNER = D_MIX // 2
SSD_HEADDIM = 64
SSD_HEADS = SSD_INNER // SSD_HEADDIM
SSD_GROUPS = 2
SSD_HPG = SSD_HEADS // SSD_GROUPS
SSD_STATE = 128
SSD_CHUNK = 128
SSD_CONV_DIM = SSD_INNER + 2 * SSD_GROUPS * SSD_STATE
HG_WIDTH = D_MIX // 4
HG_EXPAND = 128
HG_HEADS = HG_WIDTH // HG_EXPAND
HG_CHUNK = 64
LRU_WIDTH = D_MIX // 4
LRU_BLOCKS = 8
LRU_BLOCK_W = LRU_WIDTH // LRU_BLOCKS
LRU_C = 8.0
N_EXPERTS = 64
TOP_K = 8
N_EXPERT_GROUPS = 8
E_PER_GROUP = N_EXPERTS // N_EXPERT_GROUPS
TOPK_GROUPS = 4
D_EXPERT = 256
D_SHARED = 256
ROUTED_SCALE = 2.5
MASK_SCORE = -1.0e4
MOE_BLOCK = 256
IN_SIZES = (SSD_INNER, SSD_CONV_DIM, SSD_HEADS, HG_WIDTH, HG_WIDTH, HG_WIDTH, HG_WIDTH, LRU_WIDTH, LRU_WIDTH)
IN_SPLITS = tuple(int(s) for s in np.cumsum(IN_SIZES)[:-1])
D_IN = int(sum(IN_SIZES))

kernel_name = 'hybrid_ssd_hgrn2_rglru_moe_adaln'


def rms_norm(x, w):
    xf = x.astype(jnp.float32)
    y = xf * lax.rsqrt(jnp.mean(xf * xf, axis=-1, keepdims=True) + EPS)
    return (y * w.astype(jnp.float32)).astype(x.dtype)


def modulate(h, shift, scale):
    return h * (1 + scale[:, None, :]) + shift[:, None, :]


def causal_conv(x, w, b):
    y = lax.conv_general_dilated(x, w[:, None, :].astype(x.dtype), window_strides=(1,),
                                 padding=((w.shape[0] - 1, 0),),
                                 dimension_numbers=('NWC', 'WIO', 'NWC'),
                                 feature_group_count=x.shape[-1])
    return y + b.astype(x.dtype)


def segsum_exp(a):
    q = a.shape[-1]
    x = jnp.broadcast_to(a[..., None], a.shape + (q,))
    x = jnp.where(jnp.tril(jnp.ones((q, q), bool), -1), x, 0.0)
    s = jnp.cumsum(x, axis=-2)
    lower = jnp.tril(jnp.ones((q, q), bool))
    return jnp.where(lower, jnp.exp(jnp.where(lower, s, 0.0)), 0.0)


def ssd_mixer(z, xbc, dt_raw, conv_w, conv_b, dt_bias, a_log, d_skip, norm_w):
    bsz, t_len, _ = z.shape
    nc = t_len // SSD_CHUNK
    xbc = jax.nn.silu(causal_conv(xbc, conv_w, conv_b))
    xs, b_in, c_in = jnp.split(xbc, [SSD_INNER, SSD_INNER + SSD_GROUPS * SSD_STATE], axis=-1)
    dt = jax.nn.softplus(dt_raw + dt_bias.astype(jnp.float32))
    a_head = -jnp.exp(a_log.astype(jnp.float32))
    xh = xs.reshape(bsz, t_len, SSD_HEADS, SSD_HEADDIM)
    xdt = (xh * dt[..., None]).reshape(bsz, nc, SSD_CHUNK, SSD_GROUPS, SSD_HPG, SSD_HEADDIM)
    bc = b_in.reshape(bsz, nc, SSD_CHUNK, SSD_GROUPS, SSD_STATE)
    cc = c_in.reshape(bsz, nc, SSD_CHUNK, SSD_GROUPS, SSD_STATE)
    a = (dt * a_head).reshape(bsz, nc, SSD_CHUNK, SSD_GROUPS, SSD_HPG).transpose(0, 3, 4, 1, 2)
    a_cum = jnp.cumsum(a, axis=-1)
    decay_in = segsum_exp(a)
    cb = jnp.einsum('bclgn,bcsgn->bgcls', cc, bc)
    y_diag = jnp.einsum('bgrcls,bcsgrp->bclgrp', cb[:, :, None] * decay_in, xdt)
    decay_states = jnp.exp(a_cum[..., -1:] - a_cum)
    states = jnp.einsum('bclgn,bgrcl,bclgrp->bcgrpn', bc, decay_states, xdt)
    chunk_decay = jnp.pad(a_cum[..., -1], ((0, 0), (0, 0), (0, 0), (1, 0)))
    decay_chunk = segsum_exp(chunk_decay)
    states = jnp.concatenate([jnp.zeros_like(states[:, :1]), states], axis=1)
    states = jnp.einsum('bgrzc,bcgrpn->bzgrpn', decay_chunk, states)[:, :-1]
    y_off = jnp.einsum('bclgn,bcgrpn,bgrcl->bclgrp', cc, states, jnp.exp(a_cum))
    y = (y_diag + y_off).reshape(bsz, t_len, SSD_HEADS, SSD_HEADDIM) + xh * d_skip.astype(jnp.float32)[:, None]
    y = y.reshape(bsz, t_len, SSD_INNER) * jax.nn.silu(z)
    y = rms_norm(y.reshape(bsz, t_len, SSD_GROUPS, SSD_INNER // SSD_GROUPS),
                 norm_w.reshape(SSD_GROUPS, SSD_INNER // SSD_GROUPS))
    return y.reshape(bsz, t_len, SSD_INNER)


def hgrn2_mixer(q, f, v, g, lb, norm_w):
    bsz, t_len, _ = q.shape
    nc = t_len // HG_CHUNK
    q = jax.nn.silu(q)
    lb = lb.astype(jnp.float32)
    k = (1.0 - lb) * jax.nn.sigmoid(-f)
    log_f = jnp.log1p(-k)

    def to_chunks(t):
        return t.reshape(bsz, nc, HG_CHUNK, HG_HEADS, HG_EXPAND).transpose(1, 0, 3, 2, 4)

    causal = jnp.tril(jnp.ones((HG_CHUNK, HG_CHUNK), bool))[:, :, None]

    def step(state, inp):
        qc, kc, vc, lc = inp
        b = jnp.cumsum(lc, axis=2)
        o_inter = jnp.einsum('bhtk,bhkv->bhtv', qc * jnp.exp(b), state)
        diff = b[:, :, :, None, :] - b[:, :, None, :, :]
        decay = jnp.where(causal, jnp.exp(jnp.where(causal, diff, 0.0)), 0.0)
        attn = jnp.einsum('bhtsk,bhsk->bhts', decay * qc[:, :, :, None, :], kc)
        o = o_inter + jnp.einsum('bhts,bhsv->bhtv', attn, vc)
        b_last = b[:, :, -1:, :]
        state = jnp.exp(b_last[:, :, 0, :, None]) * state + jnp.einsum('bhsk,bhsv->bhkv', kc * jnp.exp(b_last - b), vc)
        return state, o

    s0 = jnp.zeros((bsz, HG_HEADS, HG_EXPAND, HG_EXPAND), jnp.float32)
    _, o = lax.scan(step, s0, (to_chunks(q), to_chunks(k), to_chunks(v), to_chunks(log_f)))
    o = o.transpose(1, 0, 3, 2, 4).reshape(bsz, t_len, HG_HEADS, HG_EXPAND)
    o = rms_norm(o, norm_w.reshape(HG_HEADS, HG_EXPAND)).reshape(bsz, t_len, HG_WIDTH)
    return o * jax.nn.silu(g)


def rglru_mixer(gate, xb, conv_w, conv_b, wa, ba, wx, bx, lam, norm_w):
    bsz, t_len, _ = xb.shape
    xb = causal_conv(xb, conv_w, conv_b)
    xblk = xb.reshape(bsz, t_len, LRU_BLOCKS, LRU_BLOCK_W)
    r = jax.nn.sigmoid(jnp.einsum('btgi,gij->btgj', xblk, wa).reshape(bsz, t_len, LRU_WIDTH) + ba)
    i = jax.nn.sigmoid(jnp.einsum('btgi,gij->btgj', xblk, wx).reshape(bsz, t_len, LRU_WIDTH) + bx)
    log_a = -LRU_C * r * jax.nn.softplus(-lam.astype(jnp.float32))
    a = jnp.exp(log_a)
    u = jnp.sqrt(-jnp.expm1(2.0 * log_a)) * (i * xb)

    def combine(lhs, rhs):
        a1, b1 = lhs
        a2, b2 = rhs
        return a1 * a2, a2 * b1 + b2

    _, h = lax.associative_scan(combine, (a, u), axis=1)
    y = h * jax.nn.gelu(gate)
    return rms_norm(y, norm_w)


def hybrid_mixer(h, w_in, ssd_conv_w, ssd_conv_b, ssd_dt_bias, ssd_a_log, ssd_d, ssd_norm_w,
                 hg_lb, hg_norm_w, lru_conv_w, lru_conv_b, lru_wa, lru_ba, lru_wx, lru_bx,
                 lru_lambda, lru_norm_w, w_out):
    u = (h @ w_in).astype(jnp.float32)
    z, xbc, dt_raw, hq, hf, hv, hg, lgate, lx = jnp.split(u, IN_SPLITS, axis=-1)
    y_ssd = ssd_mixer(z, xbc, dt_raw, ssd_conv_w, ssd_conv_b, ssd_dt_bias, ssd_a_log, ssd_d, ssd_norm_w)
    y_hg = hgrn2_mixer(hq, hf, hv, hg, hg_lb, hg_norm_w)
    y_lru = rglru_mixer(lgate, lx, lru_conv_w, lru_conv_b, lru_wa, lru_ba, lru_wx, lru_bx, lru_lambda, lru_norm_w)
    y = jnp.concatenate([y_ssd, y_hg, y_lru], axis=-1).astype(h.dtype)
    return y @ w_out


def swiglu(x, wg, wu, wd):
    return (jax.nn.silu(x @ wg) * (x @ wu)) @ wd


def moe_ffn(h, router_w, router_bias, exp_gate, exp_up, exp_down, sh_gate, sh_up, sh_down):
    bsz, t_len, d = h.shape
    tokens = h.reshape(-1, d)
    n_tok = tokens.shape[0]
    scores = jax.nn.sigmoid((tokens @ router_w).astype(jnp.float32))
    sel = scores + router_bias.astype(jnp.float32)
    grp_score = lax.top_k(sel.reshape(n_tok, N_EXPERT_GROUPS, E_PER_GROUP), 2)[0].sum(-1)
    _, top_g = lax.top_k(grp_score, TOPK_GROUPS)
    group_mask = jnp.any(top_g[:, :, None] == jnp.arange(N_EXPERT_GROUPS)[None, None, :], axis=1)
    expert_mask = jnp.repeat(group_mask, E_PER_GROUP, axis=1)
    _, idx = lax.top_k(jnp.where(expert_mask, sel, MASK_SCORE), TOP_K)
    w = jnp.take_along_axis(scores, idx, axis=1)
    w = w / jnp.sum(w, axis=-1, keepdims=True) * ROUTED_SCALE
    n_assign = n_tok * TOP_K
    flat_e = idx.reshape(-1).astype(jnp.int32)
    flat_w = w.reshape(-1)
    flat_tok = jnp.arange(n_assign, dtype=jnp.int32) // TOP_K
    order = jnp.argsort(flat_e)
    sorted_e = flat_e[order]
    counts = jnp.bincount(flat_e, length=N_EXPERTS)
    padded = (counts + MOE_BLOCK - 1) // MOE_BLOCK * MOE_BLOCK
    pad_end = jnp.cumsum(padded)
    pad_start = pad_end - padded
    start = jnp.cumsum(counts) - counts
    dest = pad_start[sorted_e] + jnp.arange(n_assign, dtype=jnp.int32) - start[sorted_e]
    n_slots = n_assign + N_EXPERTS * MOE_BLOCK
    n_blocks = n_slots // MOE_BLOCK
    slot_tok = jnp.full((n_slots,), n_tok, jnp.int32).at[dest].set(flat_tok[order])
    slot_w = jnp.zeros((n_slots,), tokens.dtype).at[dest].set(flat_w[order].astype(tokens.dtype))
    block_e = jnp.minimum(jnp.searchsorted(pad_end, jnp.arange(n_blocks) * MOE_BLOCK, side='right'),
                          N_EXPERTS - 1).astype(jnp.int32)
    tok_pad = jnp.concatenate([tokens, jnp.zeros((1, d), tokens.dtype)], axis=0)

    def run_block(args):
        t_idx, e, wt = args
        xb = tok_pad[t_idx]
        return swiglu(xb, exp_gate[e], exp_up[e], exp_down[e]) * wt[:, None]

    y_slots = lax.map(run_block, (slot_tok.reshape(n_blocks, MOE_BLOCK), block_e,
                                  slot_w.reshape(n_blocks, MOE_BLOCK)))
    routed = jax.ops.segment_sum(y_slots.reshape(n_slots, d), slot_tok, num_segments=n_tok + 1)[:n_tok]
    shared = swiglu(tokens, sh_gate, sh_up, sh_down)
    return (routed + shared).reshape(bsz, t_len, d)


def setup_inputs(seed: int = 0) -> dict:
    key = jax.random.key(seed)
    ks = iter(jax.random.split(key, 48))
    f32 = jnp.float32
    L = DEPTH

    def nrm(shape, scale):
        return jax.random.normal(next(ks), shape, f32) * scale

    def gain(shape):
        return 1.0 + nrm(shape, 0.02)

    dt = jnp.exp(jax.random.uniform(next(ks), (L, SSD_HEADS), f32, math.log(1e-3), math.log(1e-1)))
    a_c = jax.random.uniform(next(ks), (L, LRU_WIDTH), f32, 0.9, 0.999)
    sig = a_c ** (1.0 / LRU_C)
    return {
        'x': nrm((BATCH, SEQ, D_MODEL), 1.0),
        'c': nrm((BATCH, D_MODEL), 1.0),
        'ada_w': nrm((L, D_MODEL, N_ADA * D_MODEL), 0.5 * D_MODEL ** -0.5),
        'ada_b': nrm((L, N_ADA * D_MODEL), 0.02),
        'norm_mix_w': gain((L, D_MODEL)),
        'norm_ffn_w': gain((L, D_MODEL)),
        'w_in': nrm((L, D_MODEL, D_IN), D_MODEL ** -0.5),
        'ssd_conv_w': nrm((L, CONV_WIDTH, SSD_CONV_DIM), CONV_WIDTH ** -0.5),
        'ssd_conv_b': nrm((L, SSD_CONV_DIM), 0.02),
        'ssd_dt_bias': dt + jnp.log(-jnp.expm1(-dt)),
        'ssd_a_log': jnp.log(jax.random.uniform(next(ks), (L, SSD_HEADS), f32, 1.0, 16.0)),
        'ssd_d': gain((L, SSD_HEADS)),
        'ssd_norm_w': gain((L, SSD_INNER)),
        'hg_lower_bounds': nrm((L, HG_WIDTH), 0.5),
        'hg_norm_w': gain((L, HG_WIDTH)),
        'lru_conv_w': nrm((L, CONV_WIDTH, LRU_WIDTH), CONV_WIDTH ** -0.5),
        'lru_conv_b': nrm((L, LRU_WIDTH), 0.02),
        'lru_wa': nrm((L, LRU_BLOCKS, LRU_BLOCK_W, LRU_BLOCK_W), LRU_BLOCK_W ** -0.5),
        'lru_ba': nrm((L, LRU_WIDTH), 0.02),
        'lru_wx': nrm((L, LRU_BLOCKS, LRU_BLOCK_W, LRU_BLOCK_W), LRU_BLOCK_W ** -0.5),
        'lru_bx': nrm((L, LRU_WIDTH), 0.02),
        'lru_lambda': jnp.log(sig) - jnp.log1p(-sig),
        'lru_norm_w': gain((L, LRU_WIDTH)),
        'w_out': nrm((L, D_MIX, D_MODEL), D_MIX ** -0.5),
        'router_w': nrm((L, D_MODEL, N_EXPERTS), D_MODEL ** -0.5),
        'router_bias': nrm((L, N_EXPERTS), 0.01),
        'exp_gate': nrm((L, N_EXPERTS, D_MODEL, D_EXPERT), D_MODEL ** -0.5),
        'exp_up': nrm((L, N_EXPERTS, D_MODEL, D_EXPERT), D_MODEL ** -0.5),
        'exp_down': nrm((L, N_EXPERTS, D_EXPERT, D_MODEL), D_EXPERT ** -0.5),
        'sh_gate': nrm((L, D_MODEL, D_SHARED), D_MODEL ** -0.5),
        'sh_up': nrm((L, D_MODEL, D_SHARED), D_MODEL ** -0.5),
        'sh_down': nrm((L, D_SHARED, D_MODEL), D_SHARED ** -0.5),
        'final_norm_w': gain((D_MODEL,)),
    }


def reference(x, c, ada_w, ada_b, norm_mix_w, norm_ffn_w, w_in, ssd_conv_w, ssd_conv_b,
              ssd_dt_bias, ssd_a_log, ssd_d, ssd_norm_w, hg_lower_bounds, hg_norm_w,
              lru_conv_w, lru_conv_b, lru_wa, lru_ba, lru_wx, lru_bx, lru_lambda, lru_norm_w,
              w_out, router_w, router_bias, exp_gate, exp_up, exp_down, sh_gate, sh_up,
              sh_down, final_norm_w):
    lb_soft = jax.nn.softmax(hg_lower_bounds.astype(jnp.float32), axis=0)
    lower_bounds = jnp.cumsum(lb_soft, axis=0) - lb_soft[0]
    c_act = jax.nn.silu(c)
    for l in range(DEPTH):
        mod = c_act @ ada_w[l] + ada_b[l]
        sh_m, sc_m, g_m, sh_f, sc_f, g_f = jnp.split(mod, N_ADA, axis=-1)
        h = modulate(rms_norm(x, norm_mix_w[l]), sh_m, sc_m)
        mix = hybrid_mixer(h, w_in[l], ssd_conv_w[l], ssd_conv_b[l], ssd_dt_bias[l], ssd_a_log[l],
                           ssd_d[l], ssd_norm_w[l], lower_bounds[l], hg_norm_w[l], lru_conv_w[l],
                           lru_conv_b[l], lru_wa[l], lru_ba[l], lru_wx[l], lru_bx[l], lru_lambda[l],
                           lru_norm_w[l], w_out[l])
        x = x + g_m[:, None, :] * mix
        h = modulate(rms_norm(x, norm_ffn_w[l]), sh_f, sc_f)
        ffn = moe_ffn(h, router_w[l], router_bias[l], exp_gate[l], exp_up[l], exp_down[l],
                      sh_gate[l], sh_up[l], sh_down[l])
        x = x + g_f[:, None, :] * ffn
    return rms_norm(x, final_norm_w)
```

```cpp
#include <hip/hip_runtime.h>
#include <hip/hip_cooperative_groups.h>
#include <cstdio>
#include <cstdint>
namespace cg = cooperative_groups;

#ifndef MK_MEGA
#define MK_MEGA 0
#endif

#define LAS __attribute__((address_space(3)))
typedef unsigned short bf16_t;
typedef short bf16x8 __attribute__((ext_vector_type(8)));
typedef float f32x4 __attribute__((ext_vector_type(4)));
typedef float f32x2 __attribute__((ext_vector_type(2)));
typedef unsigned u32x4 __attribute__((ext_vector_type(4)));
typedef unsigned u32x2 __attribute__((ext_vector_type(2)));

constexpr int NTOK = 16384, DM = 1024, SEQ = 2048, NBATCH = 8, NLAYER = 2;
constexpr int DIN = 5648, NU = 5632;
constexpr int UZ = 0, UXS = 1024, UB = 2048, UC = 2304, UHQ = 2560, UHF = 3072, UHV = 3584, UHG = 4096, ULG = 4608, ULX = 5120;
constexpr int NMOD = 6144;
constexpr float EPS = 1e-6f;
constexpr int NEXP = 64, TOPK = 8;
constexpr int MAXSLOT = 147456;
constexpr int NTHREADS = 512, NWAVES = 8;
constexpr int LDS_BYTES = 160 * 1024;

constexpr size_t MiB = (size_t)1 << 20;
constexpr size_t WS_CTL = 0, CTL_ZERO_BYTES = 1 * MiB;
constexpr size_t WS_MOD = 1 * MiB;
constexpr size_t WS_LB = WS_MOD + 512 * 1024;
constexpr size_t WS_LRUW = WS_LB + 8192;
constexpr size_t WS_DTRAW = 2 * MiB, WS_DT = 3 * MiB, WS_ACUM = 4 * MiB;
constexpr size_t WS_HGBL = 5 * MiB;
constexpr size_t WS_SELM = 5 * MiB + 512 * 1024;
constexpr size_t WS_RW = 6 * MiB;
constexpr size_t WS_SLOTOF = 6 * MiB + 512 * 1024;
constexpr size_t WS_SLOTTOK = 7 * MiB;
constexpr size_t WS_RINFO = 7 * MiB + 768 * 1024;
constexpr size_t WS_CNT = 8 * MiB;
constexpr size_t WS_WIN = 12 * MiB;
constexpr size_t WS_WOUT = 34 * MiB;
constexpr size_t WS_GU = 42 * MiB;
constexpr size_t WS_DN = 107 * MiB;
constexpr size_t WS_H = 140 * MiB;
constexpr size_t WS_U = 172 * MiB;
constexpr size_t WS_SST = 348 * MiB;
constexpr size_t WS_HST = 380 * MiB;
constexpr size_t WS_LA = 412 * MiB, WS_LH = 428 * MiB;
constexpr size_t WS_XBC = 444 * MiB;
constexpr size_t WS_YCAT = 492 * MiB;
constexpr size_t WS_HMID = 172 * MiB;
constexpr size_t WS_Y = 252 * MiB;
constexpr size_t WS_END = 556 * MiB;

__device__ __forceinline__ float bf2f(bf16_t b) { return __uint_as_float(((unsigned)b) << 16); }
__device__ __forceinline__ unsigned f2bf(float f) { unsigned u = __float_as_uint(f); return (u + 0x7fffu + ((u >> 16) & 1u)) >> 16; }
__device__ __forceinline__ unsigned pk2(float lo, float hi) { return f2bf(lo) | (f2bf(hi) << 16); }
__device__ __forceinline__ float lo_bf(unsigned w) { return __uint_as_float(w << 16); }
__device__ __forceinline__ float hi_bf(unsigned w) { return __uint_as_float(w & 0xffff0000u); }
__device__ __forceinline__ float sigmoidf_(float x) { return 1.0f / (1.0f + __expf(-x)); }
__device__ __forceinline__ float siluf_(float x) { return x / (1.0f + __expf(-x)); }
__device__ __forceinline__ float softplusf_(float x) { return fmaxf(x, 0.f) + log1pf(__expf(-fabsf(x))); }
__device__ __forceinline__ float gelu_tanhf_(float x) { const float t = tanhf(0.7978845608028654f * (x + 0.044715f * x * x * x)); return 0.5f * x * (1.0f + t); }
__device__ __forceinline__ float wave_sum(float v) {
#pragma unroll
    for (int o = 1; o < 64; o <<= 1) v += __shfl_xor(v, o);
    return v;
}
#define LDS_WAIT() asm volatile("s_waitcnt lgkmcnt(0)" ::: "memory")
#define MFMA16(a, b, c) __builtin_amdgcn_mfma_f32_16x16x32_bf16((a), (b), (c), 0, 0, 0)

namespace pg8 {
constexpr int BM = 256, BK = 64, HALF = 128, HTB = HALF * BK * 2, STAGE_BYTES = 8 * HTB, NXCD = 8, WGM = 8;
__device__ __forceinline__ int lds_byte(int r, int c) { const int st = (r >> 4) * 2 + (c >> 5), rr = r & 15, cc = c & 31, ob = rr * 64 + cc * 2; return st * 1024 + (ob ^ (((ob >> 9) & 1) << 5)); }
__device__ __forceinline__ void stage_rc(int b, int& R, int& C) { const int st = b / 1024, sb = b % 1024, swz = sb ^ (((sb >> 9) & 1) << 5); R = (st >> 1) * 16 + swz / 64; C = (st & 1) * 32 + (swz % 64) / 2; }
__device__ __forceinline__ int perm32(int rho) { const int n = rho >> 4, i = rho & 15; return 8 * (i >> 2) + 4 * n + (i & 3); }

struct Unit { int pm, pn, e; };
struct Gemm { const bf16_t* A; const bf16_t* Bt; int K; size_t estride; };

struct DenseOrder {
    int nM, nN, nwg, G, c;
    __device__ void init(int M, int N, int G_, int c_) { nM = M / BM; nN = N / BM; nwg = nM * nN; G = G_; c = c_; }
    __device__ bool next(int i, Unit& u) const {
        const long L = (long)i * G + c; if (L >= nwg) return false;
        int wgid = (int)L; { const int q = nwg / NXCD, r = nwg % NXCD, xcd = wgid % NXCD, off = wgid / NXCD; wgid = (xcd < r ? xcd * (q + 1) : r * (q + 1) + (xcd - r) * q) + off; }
        const int nig = WGM * nN, gid = wgid / nig, fm = gid * WGM, gsz = (nM - fm) < WGM ? (nM - fm) : WGM;
        u.pm = fm + ((wgid % nig) % gsz); u.pn = (wgid % nig) / gsz; u.e = 0; return true;
    }
};
struct DenseRows { __device__ __forceinline__ int row(const Unit& u, int r) const { return u.pm * BM + r; } };

template <class Epi, class Sched, class AMap, bool ALIGN_EPI, bool SP2>
__device__ __forceinline__ void gemm_phase(LAS unsigned char* lds, const Gemm g, const Sched& S, const Epi& E, const AMap& AM) {
    const int tid = threadIdx.x, wid = __builtin_amdgcn_readfirstlane(tid >> 6), lane = tid & 63, wr = wid >> 2, wc = wid & 3, fr = lane & 15, fq = lane >> 4;
    const int K = g.K, nt = K / BK;
    int Rr[2], Cc[2]; unsigned voffB[2];
#pragma unroll
    for (int i = 0; i < 2; ++i) { int R, C; stage_rc(tid * 16 + i * 8192, R, C); Rr[i] = R; Cc[i] = C; const int Rb = Epi::PERM ? ((R & ~31) + perm32(R & 31)) : R; voffB[i] = (unsigned)(Rb * K + C) * 2u; }
    const size_t kstep = (size_t)(BK * 2);
    const size_t hstep = (size_t)HALF * K * 2;
    const size_t tstep = 2 * hstep;
    const unsigned ldsw = (unsigned)wid * 1024u;
    const int aoff = lds_byte(wr * 64 + fr, fq * 8), boff = lds_byte(wc * 32 + fr, fq * 8);
#define PG8_SA(b, h) (((b) * 2 + (h)) * HTB)
#define PG8_SB(b, h) ((4 + (b) * 2 + (h)) * HTB)
#define PG8_STAGE2(bufoff, gbase, v0, v1) do { \
        __builtin_amdgcn_global_load_lds((const unsigned*)((const char*)(gbase) + (v0)), (LAS unsigned*)(lds + (bufoff) + ldsw), 16, 0, 0); \
        __builtin_amdgcn_global_load_lds((const unsigned*)((const char*)(gbase) + (v1)), (LAS unsigned*)(lds + (bufoff) + ldsw + 8192), 16, 0, 0); } while (0)
#define PG8_STAGEB(bufoff, gbase) PG8_STAGE2(bufoff, gbase, voffB[0], voffB[1])
#define PG8_LDA(dst, b, h) do { _Pragma("unroll") for (int m = 0; m < 4; ++m) _Pragma("unroll") for (int k = 0; k < 2; ++k) dst[m][k] = *(const LAS bf16x8*)(lds + PG8_SA(b, h) + aoff + m * 2048 + k * 1024); } while (0)
#define PG8_LDB(dst, b, h) do { _Pragma("unroll") for (int n = 0; n < 2; ++n) _Pragma("unroll") for (int k = 0; k < 2; ++k) dst[n][k] = *(const LAS bf16x8*)(lds + PG8_SB(b, h) + boff + n * 2048 + k * 1024); } while (0)
#define PG8_MMA(ai, bj, At, Bt) do { __builtin_amdgcn_s_setprio(1); _Pragma("unroll") for (int m = 0; m < 4; ++m) _Pragma("unroll") for (int n = 0; n < 2; ++n) _Pragma("unroll") for (int k = 0; k < 2; ++k) \
        acc[ai][bj][m][n] = __builtin_amdgcn_mfma_f32_16x16x32_bf16(Bt[n][k], At[m][k], acc[ai][bj][m][n], 0, 0, 0); __builtin_amdgcn_s_setprio(0); } while (0)
#define PG8_WAIT_V(n) asm volatile("s_waitcnt vmcnt(" #n ")" ::: "memory")
#define PG8_WAIT_L(n) asm volatile("s_waitcnt lgkmcnt(" #n ")" ::: "memory")
#define PG8_BAR __builtin_amdgcn_s_barrier()
#define PG8_SCHED __builtin_amdgcn_sched_barrier(0)
#define PG8_AOFFS(u, v00, v01, v10, v11) do { \
        v00 = (unsigned)(AM.row(u, Rr[0]) * K + Cc[0]) * 2u; v01 = (unsigned)(AM.row(u, Rr[1]) * K + Cc[1]) * 2u; \
        v10 = (unsigned)(AM.row(u, HALF + Rr[0]) * K + Cc[0]) * 2u; v11 = (unsigned)(AM.row(u, HALF + Rr[1]) * K + Cc[1]) * 2u; } while (0)
    Unit cur, nxt; int ui = 0;
    if (!S.next(0, cur)) return;
    f32x4 acc[2][2][4][2];
#pragma unroll
    for (int a = 0; a < 2; ++a)
#pragma unroll
        for (int b = 0; b < 2; ++b)
#pragma unroll
            for (int m = 0; m < 4; ++m)
#pragma unroll
                for (int n = 0; n < 2; ++n) acc[a][b][m][n] = (f32x4){0.f, 0.f, 0.f, 0.f};
    bf16x8 At[4][2], B0[2][2], B1[2][2];
    const char* const Abase = (const char*)g.A;
    const char* cB = (const char*)g.Bt + (size_t)cur.e * g.estride + (size_t)cur.pn * tstep;
    unsigned c00, c01, c10, c11, n00, n01, n10, n11;
    PG8_AOFFS(cur, c00, c01, c10, c11);
    n00 = c00; n01 = c01; n10 = c10; n11 = c11;
    if constexpr (SP2) {
        PG8_STAGEB(PG8_SB(0, 0), cB); PG8_STAGEB(PG8_SB(0, 1), cB + hstep); PG8_STAGE2(PG8_SA(0, 0), Abase, c00, c01); PG8_STAGE2(PG8_SA(0, 1), Abase, c10, c11);
        if (wr == 1) PG8_BAR;
        PG8_WAIT_V(2); PG8_BAR;
        PG8_STAGEB(PG8_SB(1, 0), cB + kstep); PG8_STAGE2(PG8_SA(1, 0), Abase + kstep, c00, c01); PG8_STAGEB(PG8_SB(1, 1), cB + hstep + kstep);
        PG8_WAIT_V(6); PG8_BAR;
    } else {
        PG8_STAGEB(PG8_SB(0, 0), cB); PG8_STAGE2(PG8_SA(0, 0), Abase, c00, c01); PG8_STAGEB(PG8_SB(0, 1), cB + hstep); PG8_STAGE2(PG8_SA(0, 1), Abase, c10, c11);
        if (wr == 1) PG8_BAR;
        PG8_WAIT_V(4); PG8_BAR;
        PG8_STAGEB(PG8_SB(1, 0), cB + kstep); PG8_STAGE2(PG8_SA(1, 0), Abase + kstep, c00, c01); PG8_STAGEB(PG8_SB(1, 1), cB + hstep + kstep);
        PG8_WAIT_V(6); PG8_BAR;
    }
    for (;;) {
        const bool has_next = S.next(ui + 1, nxt);
        const char* nB = cB;
        if (has_next) { nB = (const char*)g.Bt + (size_t)nxt.e * g.estride + (size_t)nxt.pn * tstep; PG8_AOFFS(nxt, n00, n01, n10, n11); }
        else { n00 = c00; n01 = c01; n10 = c10; n11 = c11; }
        for (int t = 0; t < nt; t += 2) {
            const bool last = (t == nt - 2);
            const char* a1 = Abase + (size_t)(t + 1) * kstep;
            const char* a2 = last ? Abase : Abase + (size_t)(t + 2) * kstep;
            const char* b2 = last ? nB : cB + (size_t)(t + 2) * kstep;
            const char* a3 = a2 + kstep; const char* b3 = b2 + kstep;
            const unsigned x00 = last ? n00 : c00, x01 = last ? n01 : c01, x10 = last ? n10 : c10, x11 = last ? n11 : c11;
            if constexpr (SP2) {
            PG8_LDB(B0, 0, 0); PG8_LDB(B1, 0, 1); PG8_SCHED; PG8_LDA(At, 0, 0); PG8_STAGE2(PG8_SA(1, 1), a1, c10, c11);
            PG8_WAIT_V(8); PG8_WAIT_L(0); PG8_BAR; PG8_MMA(0, 0, At, B0); PG8_MMA(0, 1, At, B1); PG8_BAR; PG8_SCHED;
            PG8_LDA(At, 0, 1); PG8_STAGEB(PG8_SB(0, 0), b2); PG8_STAGEB(PG8_SB(0, 1), b2 + hstep); PG8_STAGE2(PG8_SA(0, 0), a2, x00, x01);
            PG8_WAIT_V(8); PG8_WAIT_L(0); PG8_BAR; PG8_MMA(1, 0, At, B0); PG8_MMA(1, 1, At, B1); PG8_BAR; PG8_SCHED;
            PG8_LDB(B0, 1, 0); PG8_LDB(B1, 1, 1); PG8_SCHED; PG8_LDA(At, 1, 0); PG8_STAGE2(PG8_SA(0, 1), a2, x10, x11);
            PG8_WAIT_V(8); PG8_WAIT_L(0); PG8_BAR; PG8_MMA(0, 0, At, B0); PG8_MMA(0, 1, At, B1); PG8_BAR; PG8_SCHED;
            PG8_LDA(At, 1, 1); PG8_STAGEB(PG8_SB(1, 0), b3); PG8_STAGEB(PG8_SB(1, 1), b3 + hstep); PG8_STAGE2(PG8_SA(1, 0), a3, x00, x01);
            PG8_WAIT_V(8); PG8_WAIT_L(0); PG8_BAR; PG8_MMA(1, 0, At, B0); PG8_MMA(1, 1, At, B1); PG8_BAR; PG8_SCHED;
            } else {
            PG8_LDB(B0, 0, 0); PG8_SCHED; PG8_LDA(At, 0, 0); PG8_STAGE2(PG8_SA(1, 1), a1, c10, c11);
            PG8_WAIT_L(8); PG8_BAR; PG8_WAIT_L(0); PG8_MMA(0, 0, At, B0); PG8_BAR; PG8_SCHED;
            PG8_LDB(B1, 0, 1); PG8_STAGEB(PG8_SB(0, 0), b2);
            PG8_BAR; PG8_WAIT_L(0); PG8_MMA(0, 1, At, B1); PG8_BAR;
            PG8_LDA(At, 0, 1); PG8_STAGE2(PG8_SA(0, 0), a2, x00, x01);
            PG8_BAR; PG8_WAIT_L(0); PG8_MMA(1, 0, At, B0); PG8_BAR; PG8_SCHED;
            PG8_STAGEB(PG8_SB(0, 1), b2 + hstep);
            PG8_WAIT_V(6); PG8_BAR; PG8_MMA(1, 1, At, B1); PG8_BAR;
            PG8_LDB(B0, 1, 0); PG8_SCHED; PG8_LDA(At, 1, 0); PG8_STAGE2(PG8_SA(0, 1), a2, x10, x11);
            PG8_WAIT_L(8); PG8_BAR; PG8_WAIT_L(0); PG8_MMA(0, 0, At, B0); PG8_BAR; PG8_SCHED;
            PG8_LDB(B1, 1, 1); PG8_STAGEB(PG8_SB(1, 0), b3);
            PG8_BAR; PG8_WAIT_L(0); PG8_MMA(0, 1, At, B1); PG8_BAR;
            PG8_LDA(At, 1, 1); PG8_STAGE2(PG8_SA(1, 0), a3, x00, x01);
            PG8_BAR; PG8_WAIT_L(0); PG8_MMA(1, 0, At, B0); PG8_BAR; PG8_SCHED;
            PG8_STAGEB(PG8_SB(1, 1), b3 + hstep);
            PG8_WAIT_V(6); PG8_BAR; PG8_MMA(1, 1, At, B1); PG8_BAR;
            }
        }
        if constexpr (ALIGN_EPI) { if (wr == 0) PG8_BAR; }
        E(acc, cur, wr, wc, fr, fq);
        if (!has_next) break;
#pragma unroll
        for (int a = 0; a < 2; ++a)
#pragma unroll
            for (int b = 0; b < 2; ++b)
#pragma unroll
                for (int m = 0; m < 4; ++m)
#pragma unroll
                    for (int n = 0; n < 2; ++n) acc[a][b][m][n] = (f32x4){0.f, 0.f, 0.f, 0.f};
        cur = nxt; cB = nB; c00 = n00; c01 = n01; c10 = n10; c11 = n11; ++ui;
        if constexpr (ALIGN_EPI) { if (wr == 1) PG8_BAR; }
    }
    PG8_WAIT_V(0);
    if constexpr (!ALIGN_EPI) { if (wr == 0) PG8_BAR; }
    PG8_BAR;
#undef PG8_SA
#undef PG8_SB
#undef PG8_STAGE2
#undef PG8_STAGEB
#undef PG8_LDA
#undef PG8_LDB
#undef PG8_MMA
#undef PG8_WAIT_V
#undef PG8_WAIT_L
#undef PG8_BAR
#undef PG8_SCHED
#undef PG8_AOFFS
}
}

struct Params {
    const float* in[33];
    float* out;
    unsigned char* ws;
    int layer, pad;
};
enum { I_X = 0, I_C, I_ADAW, I_ADAB, I_NMIX, I_NFFN, I_WIN, I_SCW, I_SCB, I_SDTB, I_SALOG, I_SD, I_SNW, I_HLB, I_HNW, I_LCW, I_LCB, I_LWA, I_LBA, I_LWX, I_LBX, I_LLAM, I_LNW,
       I_WOUT, I_RW, I_RB, I_EG, I_EU, I_ED, I_SG, I_SU, I_SDN, I_FNW };

using pg8::Unit;
struct EpiU {
    static constexpr bool PERM = true;
    bf16_t* O; int ldc;
    __device__ __forceinline__ void operator()(const f32x4 (&acc)[2][2][4][2], const Unit& u, int wr, int wc, int fr, int fq) const {
        const int row0 = u.pm * 256 + wr * 64 + fr, col0 = u.pn * 256 + wc * 32 + 8 * fq;
#pragma unroll
        for (int ai = 0; ai < 2; ++ai)
#pragma unroll
            for (int m = 0; m < 4; ++m) { bf16_t* rowp = O + (size_t)(row0 + ai * 128 + m * 16) * ldc + col0;
#pragma unroll
                for (int bj = 0; bj < 2; ++bj) { const f32x4 v0 = acc[ai][bj][m][0], v1 = acc[ai][bj][m][1];
                    u32x4 w; w.x = pk2(v0[0], v0[1]); w.y = pk2(v0[2], v0[3]); w.z = pk2(v1[0], v1[1]); w.w = pk2(v1[2], v1[3]);
                    *(u32x4*)(rowp + bj * 128) = w; } }
    }
};
struct EpiOut {
    static constexpr bool PERM = false;
    const float* xin; float* xout; const float* gate;
    __device__ __forceinline__ void operator()(const f32x4 (&acc)[2][2][4][2], const Unit& u, int wr, int wc, int fr, int fq) const {
        const int row0 = u.pm * 256 + wr * 64 + fr, col0 = u.pn * 256 + wc * 32 + 4 * fq, b = u.pm >> 3;
        f32x4 gv[2][2];
#pragma unroll
        for (int bj = 0; bj < 2; ++bj)
#pragma unroll
            for (int n = 0; n < 2; ++n) gv[bj][n] = *(const f32x4*)(gate + (size_t)b * NMOD + col0 + bj * 128 + n * 16);
#pragma unroll
        for (int ai = 0; ai < 2; ++ai)
#pragma unroll
            for (int m = 0; m < 4; ++m) { const size_t off = (size_t)(row0 + ai * 128 + m * 16) * DM + col0;
#pragma unroll
                for (int bj = 0; bj < 2; ++bj)
#pragma unroll
                    for (int n = 0; n < 2; ++n) { const f32x4 xi = *(const f32x4*)(xin + off + bj * 128 + n * 16);
                        *(f32x4*)(xout + off + bj * 128 + n * 16) = xi + gv[bj][n] * acc[ai][bj][m][n]; } }
    }
};
struct EpiH {
    static constexpr bool PERM = true;
    bf16_t* Hm;
    __device__ __forceinline__ void operator()(const f32x4 (&acc)[2][2][4][2], const Unit& u, int wr, int wc, int fr, int fq) const {
        const int row0 = u.pm * 256 + wr * 64 + fr, col0 = u.pn * 128 + wc * 32 + 8 * fq;
#pragma unroll
        for (int ai = 0; ai < 2; ++ai)
#pragma unroll
            for (int m = 0; m < 4; ++m) { bf16_t* rowp = Hm + (size_t)(row0 + ai * 128 + m * 16) * 256 + col0;
                f32x4 h0, h1;
#pragma unroll
                for (int j = 0; j < 4; ++j) { h0[j] = siluf_(acc[ai][0][m][0][j]) * acc[ai][1][m][0][j]; h1[j] = siluf_(acc[ai][0][m][1][j]) * acc[ai][1][m][1][j]; }
                u32x4 w; w.x = pk2(h0[0], h0[1]); w.y = pk2(h0[2], h0[3]); w.z = pk2(h1[0], h1[1]); w.w = pk2(h1[2], h1[3]);
                *(u32x4*)rowp = w; }
    }
};
struct EpiY {
    static constexpr bool PERM = true;
    bf16_t* Y; float* x; const float* gate; const int* rinfo;
    __device__ __forceinline__ void operator()(const f32x4 (&acc)[2][2][4][2], const Unit& u, int wr, int wc, int fr, int fq) const {
        const int col0 = u.pn * 256 + wc * 32 + 8 * fq;
        if (u.e < NEXP) {
            const int row0 = u.pm * 256 + wr * 64 + fr;
#pragma unroll
            for (int ai = 0; ai < 2; ++ai)
#pragma unroll
                for (int m = 0; m < 4; ++m) { bf16_t* rowp = Y + (size_t)(row0 + ai * 128 + m * 16) * DM + col0;
#pragma unroll
                    for (int bj = 0; bj < 2; ++bj) { const f32x4 v0 = acc[ai][bj][m][0], v1 = acc[ai][bj][m][1];
                        u32x4 w; w.x = pk2(v0[0], v0[1]); w.y = pk2(v0[2], v0[3]); w.z = pk2(v1[0], v1[1]); w.w = pk2(v1[2], v1[3]);
                        *(u32x4*)(rowp + bj * 128) = w; } }
        } else {
            const int nblk = rinfo[0];
            const int tok0 = (u.pm - nblk) * 256 + wr * 64 + fr, b = tok0 >> 11;
            f32x4 gv[2][2];
#pragma unroll
            for (int bj = 0; bj < 2; ++bj)
#pragma unroll
                for (int n = 0; n < 2; ++n) gv[bj][n] = *(const f32x4*)(gate + (size_t)b * NMOD + col0 + bj * 128 + n * 4);
#pragma unroll
            for (int ai = 0; ai < 2; ++ai)
#pragma unroll
                for (int m = 0; m < 4; ++m) { float* rowp = x + (size_t)(tok0 + ai * 128 + m * 16) * DM + col0;
#pragma unroll
                    for (int bj = 0; bj < 2; ++bj)
#pragma unroll
                        for (int n = 0; n < 2; ++n) { f32x4* p = (f32x4*)(rowp + bj * 128 + n * 4); *p = *p + gv[bj][n] * acc[ai][bj][m][n]; } }
        }
    }
};
struct MoeOrder {
    const int* rinfo; int NQ, G, c;
    __device__ bool next(int i, Unit& u) const {
        const int nblk = rinfo[0]; const long L = (long)i * G + c;
        if (L >= (long)(nblk + 64) * NQ) return false;
        const int rb = (int)(L / NQ); u.pm = rb; u.pn = (int)(L % NQ); u.e = (rb < nblk) ? rinfo[64 + rb] : NEXP; return true;
    }
};
struct GatherRows {
    const int* slot_tok; const int* rinfo;
    __device__ __forceinline__ int row(const Unit& u, int r) const {
        const int nblk = rinfo[0];
        if (u.pm < nblk) { const int t = slot_tok[u.pm * 256 + r]; return t < 0 ? 0 : t; }
        return (u.pm - nblk) * 256 + r;
    }
};

struct Ctx { LAS unsigned char* lds; int tid, lane, wave, G, bid; };

template <class RowMap>
__device__ __forceinline__ void transpose_item(const float* W, int N, int k0, int n0, bf16_t* WT, int ldk, const RowMap& rm, LAS float* scr, int lane) {
    const int nn = n0 + (lane & 31);
#pragma unroll 8
    for (int i = 0; i < 32; ++i) { const int kk = 2 * i + (lane >> 5); scr[kk * 33 + (lane & 31)] = (nn < N) ? W[(size_t)(k0 + kk) * N + nn] : 0.f; }
    LDS_WAIT();
    const int c = lane & 7;
#pragma unroll
    for (int j = 0; j < 4; ++j) { const int n = (lane >> 3) + 8 * j; const LAS float* s = scr + (8 * c) * 33 + n;
        u32x4 o; o.x = pk2(s[0 * 33], s[1 * 33]); o.y = pk2(s[2 * 33], s[3 * 33]); o.z = pk2(s[4 * 33], s[5 * 33]); o.w = pk2(s[6 * 33], s[7 * 33]);
        const int dr = (n0 + n < N) ? rm(n0 + n) : -1;
        if (dr >= 0) *(u32x4*)(WT + (size_t)dr * ldk + k0 + 8 * c) = o; }
    LDS_WAIT();
}
struct RmIdent { __device__ __forceinline__ int operator()(int n) const { return n; } };
struct RmWin { __device__ __forceinline__ int operator()(int n) const { return n < 2560 ? n : (n < 2576 ? -1 : n - 16); } };
struct RmGate { __device__ __forceinline__ int operator()(int n) const { return (n >> 7) * 256 + (n & 127); } };
struct RmUp { __device__ __forceinline__ int operator()(int n) const { return (n >> 7) * 256 + 128 + (n & 127); } };

__device__ __forceinline__ void phase_prep_io(const Params& p, const Ctx& c) {
    LAS float* scr = (LAS float*)(c.lds + c.wave * 16384);
    const int gw = c.bid * NWAVES + c.wave, NGW = c.G * NWAVES;
    constexpr int I_IN = 16 * 177, I_OUT = 32 * 32, PER_L = I_IN + I_OUT;
    for (int it = gw; it < NLAYER * PER_L; it += NGW) {
        const int l = it / PER_L; int r = it % PER_L;
        if (r < I_IN) { const int kb = r / 177, nb = r % 177;
            transpose_item(p.in[I_WIN] + (size_t)l * DM * DIN, DIN, kb * 64, nb * 32, (bf16_t*)(p.ws + WS_WIN) + (size_t)l * NU * DM, DM, RmWin(), scr, c.lane); }
        else { r -= I_IN; const int kb = r / 32, nb = r % 32;
            transpose_item(p.in[I_WOUT] + (size_t)l * 2048 * DM, DM, kb * 64, nb * 32, (bf16_t*)(p.ws + WS_WOUT) + (size_t)l * DM * 2048, 2048, RmIdent(), scr, c.lane); }
    }
}
__device__ __forceinline__ void phase_prep_experts(const Params& p, const Ctx& c, int l) {
    LAS float* scr = (LAS float*)(c.lds + c.wave * 16384);
    const int gw = c.bid * NWAVES + c.wave, NGW = c.G * NWAVES;
    constexpr int PER_E = 3 * 128;
    bf16_t* GU = (bf16_t*)(p.ws + WS_GU); bf16_t* DN = (bf16_t*)(p.ws + WS_DN);
    for (int it = gw; it < 65 * PER_E; it += NGW) {
        const int e = it / PER_E; int r = it % PER_E; const int which = r / 128; r %= 128;
        if (which < 2) {
            const float* src = (e < NEXP) ? p.in[which == 0 ? I_EG : I_EU] + ((size_t)l * NEXP + e) * DM * 256 : p.in[which == 0 ? I_SG : I_SU] + (size_t)l * DM * 256;
            const int kb = r / 8, nb = r % 8;
            if (which == 0) transpose_item(src, 256, kb * 64, nb * 32, GU + (size_t)e * 512 * DM, DM, RmGate(), scr, c.lane);
            else transpose_item(src, 256, kb * 64, nb * 32, GU + (size_t)e * 512 * DM, DM, RmUp(), scr, c.lane);
        } else {
            const float* src = (e < NEXP) ? p.in[I_ED] + ((size_t)l * NEXP + e) * 256 * DM : p.in[I_SDN] + (size_t)l * 256 * DM;
            const int kb = r / 32, nb = r % 32;
            transpose_item(src, DM, kb * 64, nb * 32, DN + (size_t)e * DM * 256, 256, RmIdent(), scr, c.lane);
        }
    }
}
__device__ __forceinline__ void phase_prep_small(const Params& p, const Ctx& c) {
    LAS float* sc = (LAS float*)c.lds;
    LAS float* red = (LAS float*)(c.lds + 32768);
    float* mod = (float*)(p.ws + WS_MOD);
    bool have_sc = false;
    for (int it = c.bid; it < NLAYER * 96; it += c.G) {
        if (!have_sc) { for (int i = c.tid; i < 8 * 1024; i += NTHREADS) sc[i] = siluf_(p.in[I_C][i]); have_sc = true; }
        __syncthreads();
        const int l = it / 96, j0 = (it % 96) * 64, j = c.tid & 63, kg = c.tid >> 6;
        const float* W = p.in[I_ADAW] + (size_t)l * DM * NMOD + j0 + j;
        float a[8];
#pragma unroll
        for (int b = 0; b < 8; ++b) a[b] = 0.f;
        for (int k = kg * 128; k < kg * 128 + 128; ++k) { const float w = W[(size_t)k * NMOD];
#pragma unroll
            for (int b = 0; b < 8; ++b) a[b] += sc[b * 1024 + k] * w; }
#pragma unroll
        for (int b = 0; b < 8; ++b) red[(kg * 8 + b) * 64 + j] = a[b];
        __syncthreads();
        { const int b = c.tid >> 6; float s = 0.f;
#pragma unroll
          for (int g = 0; g < 8; ++g) s += red[(g * 8 + b) * 64 + j];
          mod[((size_t)l * 8 + b) * NMOD + j0 + j] = s + p.in[I_ADAB][(size_t)l * NMOD + j0 + j]; }
        __syncthreads();
    }
    if (c.bid == c.G - 1) {
        float* lb = (float*)(p.ws + WS_LB);
        for (int i = c.tid; i < 512; i += NTHREADS) { const float v0 = p.in[I_HLB][i], v1 = p.in[I_HLB][512 + i]; const float m = fmaxf(v0, v1), e0 = expf(v0 - m), e1 = expf(v1 - m);
            lb[i] = 0.f; lb[512 + i] = e1 / (e0 + e1); }
    }
    { bf16_t* LW = (bf16_t*)(p.ws + WS_LRUW);
      for (int o = c.bid * NTHREADS + c.tid; o < NLAYER * 2 * 8 * 4096; o += c.G * NTHREADS) {
          const int i = o & 63, j = (o >> 6) & 63, g = (o >> 12) & 7, mat = (o >> 15) & 1, l = o >> 16;
          const float* src = p.in[mat == 0 ? I_LWA : I_LWX] + (((size_t)l * 8 + g) * 64 + i) * 64 + j;
          LW[o] = (bf16_t)f2bf(*src); } }
}

__device__ __forceinline__ void phase_norm_mix(const Params& p, const Ctx& c, int l, const float* xin) {
    LAS float* wdt = (LAS float*)c.lds;
    const float* Win = p.in[I_WIN] + (size_t)l * DM * DIN;
    for (int i = c.tid; i < 16 * 1024; i += NTHREADS) { const int k = i >> 4, j = i & 15; wdt[j * 1024 + k] = Win[(size_t)k * DIN + 2560 + j]; }
    __syncthreads();
    const float* mod = (const float*)(p.ws + WS_MOD) + (size_t)l * 8 * NMOD;
    const float* nw = p.in[I_NMIX] + (size_t)l * DM;
    bf16_t* H = (bf16_t*)(p.ws + WS_H); float* dtraw = (float*)(p.ws + WS_DTRAW);
    const int gw = c.bid * NWAVES + c.wave, NGW = c.G * NWAVES;
    for (int tok = gw; tok < NTOK; tok += NGW) {
        const int b = tok >> 11;
        const f32x4* xr = (const f32x4*)(xin + (size_t)tok * DM) + c.lane;
        f32x4 v[4]; float ss = 0.f;
#pragma unroll
        for (int j = 0; j < 4; ++j) { v[j] = xr[64 * j]; ss += (v[j][0] * v[j][0] + v[j][1] * v[j][1]) + (v[j][2] * v[j][2] + v[j][3] * v[j][3]); }
        const float rstd = 1.0f / sqrtf(wave_sum(ss) * (1.0f / DM) + EPS);
        f32x4 hv[4];
#pragma unroll
        for (int j = 0; j < 4; ++j) {
            const int col = 256 * j + 4 * c.lane;
            const f32x4 w4 = *(const f32x4*)(nw + col), sh = *(const f32x4*)(mod + (size_t)b * NMOD + col), sc = *(const f32x4*)(mod + (size_t)b * NMOD + 1024 + col);
            hv[j] = (v[j] * rstd * w4) * (sc + 1.0f) + sh;
            u32x2 o; o.x = pk2(hv[j][0], hv[j][1]); o.y = pk2(hv[j][2], hv[j][3]);
            *(u32x2*)(H + (size_t)tok * DM + col) = o;
        }
        float mine = 0.f;
#pragma unroll 2
        for (int q = 0; q < 16; ++q) {
            float s = 0.f;
#pragma unroll
            for (int j = 0; j < 4; ++j) { const f32x4 wq = *(const LAS f32x4*)(wdt + q * 1024 + 256 * j + 4 * c.lane); s += (hv[j][0] * wq[0] + hv[j][1] * wq[1]) + (hv[j][2] * wq[2] + hv[j][3] * wq[3]); }
            s = wave_sum(s);
            mine = (c.lane == q) ? s : mine;
        }
        if (c.lane < 16) dtraw[(size_t)tok * 16 + c.lane] = mine;
    }
}

__device__ __forceinline__ void phase_ssd_conv(const Params& p, const Ctx& c, int l) {
    const bf16_t* U = (const bf16_t*)(p.ws + WS_U); bf16_t* XA = (bf16_t*)(p.ws + WS_XBC);
    const float* cw = p.in[I_SCW] + (size_t)l * 4 * 1536; const float* cb = p.in[I_SCB] + (size_t)l * 1536;
    const float* dtraw = (const float*)(p.ws + WS_DTRAW); float* dt = (float*)(p.ws + WS_DT); float* acum = (float*)(p.ws + WS_ACUM);
    for (int it = c.bid; it < 128; it += c.G) {
        const int b = it >> 4, ch = it & 15, tok0 = b * SEQ + ch * 128;
        for (int q = c.tid; q < 768; q += NTHREADS) {
            const int c0 = 2 * q;
            const float w00 = cw[c0], w01 = cw[1536 + c0], w02 = cw[3072 + c0], w03 = cw[4608 + c0], bb0 = cb[c0];
            const float w10 = cw[c0 + 1], w11 = cw[1536 + c0 + 1], w12 = cw[3072 + c0 + 1], w13 = cw[4608 + c0 + 1], bb1 = cb[c0 + 1];
            float a0 = 0.f, a1 = 0.f, a2 = 0.f, b0 = 0.f, b1 = 0.f, b2 = 0.f;
            if (ch > 0) { const unsigned r0 = *(const unsigned*)(U + (size_t)(tok0 - 3) * NU + UXS + c0), r1 = *(const unsigned*)(U + (size_t)(tok0 - 2) * NU + UXS + c0), r2 = *(const unsigned*)(U + (size_t)(tok0 - 1) * NU + UXS + c0);
                a0 = lo_bf(r0); b0 = hi_bf(r0); a1 = lo_bf(r1); b1 = hi_bf(r1); a2 = lo_bf(r2); b2 = hi_bf(r2); }
            for (int t = 0; t < 128; ++t) {
                const unsigned r = *(const unsigned*)(U + (size_t)(tok0 + t) * NU + UXS + c0);
                const float xa = lo_bf(r), xb = hi_bf(r);
                const float ya = bb0 + w00 * a0 + w01 * a1 + w02 * a2 + w03 * xa, yb = bb1 + w10 * b0 + w11 * b1 + w12 * b2 + w13 * xb;
                *(unsigned*)(XA + (size_t)(tok0 + t) * 1536 + c0) = pk2(siluf_(ya), siluf_(yb));
                a0 = a1; a1 = a2; a2 = xa; b0 = b1; b1 = b2; b2 = xb;
            }
        }
        if (c.tid < 16) { const int h = c.tid; const float bias = p.in[I_SDTB][l * 16 + h], A = -expf(p.in[I_SALOG][l * 16 + h]); float cum = 0.f;
            for (int t = 0; t < 128; ++t) { const float d = softplusf_(dtraw[(size_t)(tok0 + t) * 16 + h] + bias); cum += d * A; dt[(size_t)(tok0 + t) * 16 + h] = d; acum[(size_t)(tok0 + t) * 16 + h] = cum; } }
    }
}

__device__ __forceinline__ void phase_ssd_state(const Params& p, const Ctx& c) {
    LAS bf16_t* XT = (LAS bf16_t*)c.lds;
    LAS bf16_t* BT = (LAS bf16_t*)(c.lds + 64 * 136 * 2);
    const bf16_t* XA = (const bf16_t*)(p.ws + WS_XBC); const float* dt = (const float*)(p.ws + WS_DT); const float* acum = (const float*)(p.ws + WS_ACUM);
    bf16_t* ST = (bf16_t*)(p.ws + WS_SST);
    const int fr = c.lane & 15, fq = c.lane >> 4;
    for (int it = c.bid; it < 2048; it += c.G) {
        const int h = it & 15, bc = it >> 4, tok0 = bc * 128, g = h >> 3;
        const float aend = acum[(size_t)(tok0 + 127) * 16 + h];
        for (int i = c.tid; i < 128 * 32; i += NTHREADS) { const int lrow = i >> 5, pp = i & 31;
            const unsigned r = *(const unsigned*)(XA + (size_t)(tok0 + lrow) * 1536 + h * 64 + 2 * pp);
            const float f = dt[(size_t)(tok0 + lrow) * 16 + h] * __expf(aend - acum[(size_t)(tok0 + lrow) * 16 + h]);
            XT[(2 * pp) * 136 + lrow] = (bf16_t)f2bf(lo_bf(r) * f); XT[(2 * pp + 1) * 136 + lrow] = (bf16_t)f2bf(hi_bf(r) * f); }
        for (int i = c.tid; i < 128 * 64; i += NTHREADS) { const int lrow = i >> 6, nn = i & 63;
            const unsigned r = *(const unsigned*)(XA + (size_t)(tok0 + lrow) * 1536 + 1024 + g * 128 + 2 * nn);
            BT[(2 * nn) * 136 + lrow] = (bf16_t)(r & 0xffffu); BT[(2 * nn + 1) * 136 + lrow] = (bf16_t)(r >> 16); }
        __syncthreads();
        f32x4 acc[4];
#pragma unroll
        for (int m = 0; m < 4; ++m) acc[m] = (f32x4){0.f, 0.f, 0.f, 0.f};
#pragma unroll
        for (int ks = 0; ks < 4; ++ks) {
            const bf16x8 bfr = *(const LAS bf16x8*)(BT + (16 * c.wave + fr) * 136 + ks * 32 + 8 * fq);
#pragma unroll
            for (int m = 0; m < 4; ++m) { const bf16x8 afr = *(const LAS bf16x8*)(XT + (16 * m + fr) * 136 + ks * 32 + 8 * fq); acc[m] = MFMA16(afr, bfr, acc[m]); }
        }
#pragma unroll
        for (int m = 0; m < 4; ++m)
#pragma unroll
            for (int r = 0; r < 4; ++r) ST[(size_t)it * 8192 + (16 * m + 4 * fq + r) * 128 + 16 * c.wave + fr] = (bf16_t)f2bf(acc[m][r]);
        __syncthreads();
    }
}
__device__ __forceinline__ void phase_ssd_scan(const Params& p, const Ctx& c) {
    unsigned* ST = (unsigned*)(p.ws + WS_SST); const float* acum = (const float*)(p.ws + WS_ACUM);
    for (int i = c.bid * NTHREADS + c.tid; i < 128 * 4096; i += c.G * NTHREADS) {
        const int e2 = i & 4095, bh = i >> 12, b = bh >> 4, h = bh & 15;
        float r0 = 0.f, r1 = 0.f;
        for (int ch = 0; ch < 16; ++ch) {
            const size_t it = (size_t)((b * 16 + ch) * 16 + h);
            const unsigned loc = ST[it * 4096 + e2];
            ST[it * 4096 + e2] = pk2(r0, r1);
            const float d = __expf(acum[(size_t)(b * SEQ + ch * 128 + 127) * 16 + h]);
            r0 = d * r0 + lo_bf(loc); r1 = d * r1 + hi_bf(loc);
        }
    }
}
__device__ __forceinline__ void phase_ssd_out(const Params& p, const Ctx& c, int l) {
    LAS bf16_t* Cs = (LAS bf16_t*)c.lds;
    LAS bf16_t* Bs = (LAS bf16_t*)(c.lds + 34816);
    LAS bf16_t* CBD = (LAS bf16_t*)(c.lds + 2 * 34816);
    LAS bf16_t* XT = (LAS bf16_t*)(c.lds + 3 * 34816);
    LAS bf16_t* STs = (LAS bf16_t*)(c.lds + 3 * 34816 + 17408);
    LAS float* acs = (LAS float*)(c.lds + 3 * 34816 + 2 * 17408);
    const bf16_t* XA = (const bf16_t*)(p.ws + WS_XBC); const float* dt = (const float*)(p.ws + WS_DT); const float* acum = (const float*)(p.ws + WS_ACUM);
    const bf16_t* ST = (const bf16_t*)(p.ws + WS_SST); bf16_t* YP = (bf16_t*)(p.ws + WS_H);
    const int fr = c.lane & 15, fq = c.lane >> 4, w = c.wave;
    for (int it = c.bid; it < 2048; it += c.G) {
        const int h = it & 15, bc = it >> 4, tok0 = bc * 128, g = h >> 3;
        const float Dh = p.in[I_SD][l * 16 + h];
        for (int i = c.tid; i < 128 * 16; i += NTHREADS) { const int row = i >> 4, ck = i & 15;
            *(LAS u32x4*)(Bs + row * 136 + ck * 8) = *(const u32x4*)(XA + (size_t)(tok0 + row) * 1536 + 1024 + g * 128 + ck * 8);
            *(LAS u32x4*)(Cs + row * 136 + ck * 8) = *(const u32x4*)(XA + (size_t)(tok0 + row) * 1536 + 1280 + g * 128 + ck * 8); }
        for (int i = c.tid; i < 64 * 16; i += NTHREADS) { const int row = i >> 4, ck = i & 15;
            *(LAS u32x4*)(STs + row * 136 + ck * 8) = *(const u32x4*)(ST + (size_t)it * 8192 + row * 128 + ck * 8); }
        for (int i = c.tid; i < 128 * 32; i += NTHREADS) { const int lrow = i >> 5, pp = i & 31;
            const unsigned r = *(const unsigned*)(XA + (size_t)(tok0 + lrow) * 1536 + h * 64 + 2 * pp);
            const float f = dt[(size_t)(tok0 + lrow) * 16 + h];
            XT[(2 * pp) * 136 + lrow] = (bf16_t)f2bf(lo_bf(r) * f); XT[(2 * pp + 1) * 136 + lrow] = (bf16_t)f2bf(hi_bf(r) * f); }
        if (c.tid < 128) acs[c.tid] = acum[(size_t)(tok0 + c.tid) * 16 + h];
        __syncthreads();
        {
            f32x4 cb[8];
#pragma unroll
            for (int n = 0; n < 8; ++n) cb[n] = (f32x4){0.f, 0.f, 0.f, 0.f};
#pragma unroll
            for (int ks = 0; ks < 4; ++ks) {
                const bf16x8 afr = *(const LAS bf16x8*)(Cs + (16 * w + fr) * 136 + ks * 32 + 8 * fq);
#pragma unroll
                for (int n = 0; n < 8; ++n) { const bf16x8 bfr = *(const LAS bf16x8*)(Bs + (16 * n + fr) * 136 + ks * 32 + 8 * fq); cb[n] = MFMA16(afr, bfr, cb[n]); }
            }
#pragma unroll
            for (int n = 0; n < 8; ++n)
#pragma unroll
                for (int r = 0; r < 4; ++r) { const int lr = 16 * w + 4 * fq + r, sc = 16 * n + fr;
                    const float v = (sc <= lr) ? cb[n][r] * __expf(acs[lr] - acs[sc]) : 0.f;
                    CBD[lr * 136 + sc] = (bf16_t)f2bf(v); }
        }
        __syncthreads();
        {
            f32x4 a1[4], a2[4];
#pragma unroll
            for (int n = 0; n < 4; ++n) { a1[n] = (f32x4){0.f, 0.f, 0.f, 0.f}; a2[n] = (f32x4){0.f, 0.f, 0.f, 0.f}; }
#pragma unroll
            for (int ks = 0; ks < 4; ++ks) {
                const bf16x8 ad = *(const LAS bf16x8*)(CBD + (16 * w + fr) * 136 + ks * 32 + 8 * fq);
                const bf16x8 ac = *(const LAS bf16x8*)(Cs + (16 * w + fr) * 136 + ks * 32 + 8 * fq);
#pragma unroll
                for (int n = 0; n < 4; ++n) {
                    const bf16x8 bx = *(const LAS bf16x8*)(XT + (16 * n + fr) * 136 + ks * 32 + 8 * fq);
                    const bf16x8 bs = *(const LAS bf16x8*)(STs + (16 * n + fr) * 136 + ks * 32 + 8 * fq);
                    a1[n] = MFMA16(ad, bx, a1[n]); a2[n] = MFMA16(ac, bs, a2[n]); }
            }
#pragma unroll
            for (int n = 0; n < 4; ++n)
#pragma unroll
                for (int r = 0; r < 4; ++r) { const int lr = 16 * w + 4 * fq + r, pc = 16 * n + fr;
                    const float xs = bf2f(XA[(size_t)(tok0 + lr) * 1536 + h * 64 + pc]);
                    const float y = a1[n][r] + __expf(acs[lr]) * a2[n][r] + Dh * xs;
                    YP[(size_t)(tok0 + lr) * DM + h * 64 + pc] = (bf16_t)f2bf(y); }
        }
        __syncthreads();
    }
}
__device__ __forceinline__ void phase_ssd_gate(const Params& p, const Ctx& c, int l) {
    const bf16_t* YP = (const bf16_t*)(p.ws + WS_H); const bf16_t* U = (const bf16_t*)(p.ws + WS_U); bf16_t* YC = (bf16_t*)(p.ws + WS_YCAT);
    const float* nw = p.in[I_SNW] + (size_t)l * 1024;
    const int gw = c.bid * NWAVES + c.wave, NGW = c.G * NWAVES;
    for (int i = gw; i < NTOK * 2; i += NGW) {
        const int tok = i >> 1, g = i & 1, col = g * 512 + 8 * c.lane;
        const u32x4 yv = *(const u32x4*)(YP + (size_t)tok * DM + col), zv = *(const u32x4*)(U + (size_t)tok * NU + UZ + col);
        float v[8]; float ss = 0.f;
#pragma unroll
        for (int j = 0; j < 4; ++j) { v[2 * j] = lo_bf(yv[j]) * siluf_(lo_bf(zv[j])); v[2 * j + 1] = hi_bf(yv[j]) * siluf_(hi_bf(zv[j])); ss += v[2 * j] * v[2 * j] + v[2 * j + 1] * v[2 * j + 1]; }
        const float rstd = 1.0f / sqrtf(wave_sum(ss) * (1.0f / 512.0f) + EPS);
        const f32x4 w0 = *(const f32x4*)(nw + col), w1 = *(const f32x4*)(nw + col + 4);
        u32x4 o; o.x = pk2(v[0] * rstd * w0[0], v[1] * rstd * w0[1]); o.y = pk2(v[2] * rstd * w0[2], v[3] * rstd * w0[3]);
        o.z = pk2(v[4] * rstd * w1[0], v[5] * rstd * w1[1]); o.w = pk2(v[6] * rstd * w1[2], v[7] * rstd * w1[3]);
        *(u32x4*)(YC + (size_t)tok * 2048 + col) = o;
    }
}

__device__ __forceinline__ void phase_hg_state(const Params& p, const Ctx& c, int l) {
    LAS float* Bf = (LAS float*)c.lds;
    LAS float* KK = (LAS float*)(c.lds + 33792);
    LAS bf16_t* KDT = (LAS bf16_t*)(c.lds + 2 * 33792);
    LAS bf16_t* VT = (LAS bf16_t*)(c.lds + 2 * 33792 + 18432);
    const bf16_t* U = (const bf16_t*)(p.ws + WS_U); const float* lb = (const float*)(p.ws + WS_LB) + l * 512;
    bf16_t* ST = (bf16_t*)(p.ws + WS_HST); float* BL = (float*)(p.ws + WS_HGBL);
    const int fr = c.lane & 15, fq = c.lane >> 4, w = c.wave;
    for (int it = c.bid; it < 1024; it += c.G) {
        const int ch = it & 31, bh = it >> 5, h = bh & 3, b = bh >> 2, tok0 = b * SEQ + ch * 64;
        for (int i = c.tid; i < 64 * 64; i += NTHREADS) { const int s = i >> 6, kp = i & 63;
            const unsigned rf = *(const unsigned*)(U + (size_t)(tok0 + s) * NU + UHF + h * 128 + 2 * kp);
            const unsigned rv = *(const unsigned*)(U + (size_t)(tok0 + s) * NU + UHV + h * 128 + 2 * kp);
            const float k0 = (1.0f - lb[h * 128 + 2 * kp]) * sigmoidf_(-lo_bf(rf)), k1 = (1.0f - lb[h * 128 + 2 * kp + 1]) * sigmoidf_(-hi_bf(rf));
            KK[s * 132 + 2 * kp] = k0; KK[s * 132 + 2 * kp + 1] = k1;
            Bf[s * 132 + 2 * kp] = log1pf(-k0); Bf[s * 132 + 2 * kp + 1] = log1pf(-k1);
            VT[(2 * kp) * 72 + s] = (bf16_t)(rv & 0xffffu); VT[(2 * kp + 1) * 72 + s] = (bf16_t)(rv >> 16); }
        __syncthreads();
        if (c.tid < 128) { float cum = 0.f; for (int s = 0; s < 64; ++s) { cum += Bf[s * 132 + c.tid]; Bf[s * 132 + c.tid] = cum; } BL[(size_t)it * 128 + c.tid] = cum; }
        __syncthreads();
        for (int i = c.tid; i < 64 * 128; i += NTHREADS) { const int s = i >> 7, k = i & 127;
            KDT[k * 72 + s] = (bf16_t)f2bf(KK[s * 132 + k] * __expf(Bf[63 * 132 + k] - Bf[s * 132 + k])); }
        __syncthreads();
        f32x4 acc[8];
#pragma unroll
        for (int n = 0; n < 8; ++n) acc[n] = (f32x4){0.f, 0.f, 0.f, 0.f};
#pragma unroll
        for (int ks = 0; ks < 2; ++ks) {
            const bf16x8 afr = *(const LAS bf16x8*)(VT + (16 * w + fr) * 72 + ks * 32 + 8 * fq);
#pragma unroll
            for (int n = 0; n < 8; ++n) { const bf16x8 bfr = *(const LAS bf16x8*)(KDT + (16 * n + fr) * 72 + ks * 32 + 8 * fq); acc[n] = MFMA16(afr, bfr, acc[n]); }
        }
#pragma unroll
        for (int n = 0; n < 8; ++n)
#pragma unroll
            for (int r = 0; r < 4; ++r) ST[(size_t)it * 16384 + (16 * w + 4 * fq + r) * 128 + 16 * n + fr] = (bf16_t)f2bf(acc[n][r]);
        __syncthreads();
    }
}
__device__ __forceinline__ void phase_hg_scan(const Params& p, const Ctx& c) {
    unsigned* ST = (unsigned*)(p.ws + WS_HST); const float* BL = (const float*)(p.ws + WS_HGBL);
    for (int i = c.bid * NTHREADS + c.tid; i < 32 * 8192; i += c.G * NTHREADS) {
        const int e2 = i & 8191, bh = i >> 13, k0 = (2 * e2) & 127;
        float r0 = 0.f, r1 = 0.f;
        for (int ch = 0; ch < 32; ++ch) {
            const size_t it = (size_t)(bh * 32 + ch);
            const unsigned loc = ST[it * 8192 + e2];
            ST[it * 8192 + e2] = pk2(r0, r1);
            const float d0 = __expf(BL[it * 128 + k0]), d1 = __expf(BL[it * 128 + k0 + 1]);
            r0 = d0 * r0 + lo_bf(loc); r1 = d1 * r1 + hi_bf(loc);
        }
    }
}
__device__ __forceinline__ void phase_hg_out(const Params& p, const Ctx& c, int l) {
    LAS bf16_t* Qs = (LAS bf16_t*)c.lds;
    LAS bf16_t* Ks = (LAS bf16_t*)(c.lds + 17408);
    LAS float* Bf = (LAS float*)(c.lds + 2 * 17408);
    LAS bf16_t* QB = (LAS bf16_t*)(c.lds + 2 * 17408 + 33792);
    LAS bf16_t* STs = (LAS bf16_t*)(c.lds + 3 * 17408 + 33792);
    LAS bf16_t* ATT = (LAS bf16_t*)(c.lds + 3 * 17408 + 33792 + 34816);
    LAS bf16_t* VT = (LAS bf16_t*)(c.lds + 3 * 17408 + 33792 + 34816 + 9216);
    const bf16_t* U = (const bf16_t*)(p.ws + WS_U); const float* lb = (const float*)(p.ws + WS_LB) + l * 512;
    const bf16_t* ST = (const bf16_t*)(p.ws + WS_HST); bf16_t* YC = (bf16_t*)(p.ws + WS_YCAT);
    const float* nw = p.in[I_HNW] + (size_t)l * 512;
    const int fr = c.lane & 15, fq = c.lane >> 4, w = c.wave;
    for (int it = c.bid; it < 1024; it += c.G) {
        const int ch = it & 31, bh = it >> 5, h = bh & 3, b = bh >> 2, tok0 = b * SEQ + ch * 64;
        for (int i = c.tid; i < 64 * 64; i += NTHREADS) { const int s = i >> 6, kp = i & 63;
            const size_t ro = (size_t)(tok0 + s) * NU + h * 128 + 2 * kp;
            const unsigned rq = *(const unsigned*)(U + ro + UHQ), rf = *(const unsigned*)(U + ro + UHF), rv = *(const unsigned*)(U + ro + UHV);
            const float k0 = (1.0f - lb[h * 128 + 2 * kp]) * sigmoidf_(-lo_bf(rf)), k1 = (1.0f - lb[h * 128 + 2 * kp + 1]) * sigmoidf_(-hi_bf(rf));
            *(LAS unsigned*)(Ks + s * 136 + 2 * kp) = pk2(k0, k1);
            *(LAS unsigned*)(Qs + s * 136 + 2 * kp) = pk2(siluf_(lo_bf(rq)), siluf_(hi_bf(rq)));
            Bf[s * 132 + 2 * kp] = log1pf(-k0); Bf[s * 132 + 2 * kp + 1] = log1pf(-k1);
            VT[(2 * kp) * 72 + s] = (bf16_t)(rv & 0xffffu); VT[(2 * kp + 1) * 72 + s] = (bf16_t)(rv >> 16); }
        for (int i = c.tid; i < 128 * 16; i += NTHREADS) { const int row = i >> 4, ck = i & 15;
            *(LAS u32x4*)(STs + row * 136 + ck * 8) = *(const u32x4*)(ST + (size_t)it * 16384 + row * 128 + ck * 8); }
        __syncthreads();
        if (c.tid < 128) { float cum = 0.f; for (int s = 0; s < 64; ++s) { cum += Bf[s * 132 + c.tid]; Bf[s * 132 + c.tid] = cum; } }
        __syncthreads();
        for (int i = c.tid; i < 64 * 64; i += NTHREADS) { const int t = i >> 6, kp = i & 63;
            const unsigned q2 = *(const LAS unsigned*)(Qs + t * 136 + 2 * kp);
            *(LAS unsigned*)(QB + t * 136 + 2 * kp) = pk2(lo_bf(q2) * __expf(Bf[t * 132 + 2 * kp]), hi_bf(q2) * __expf(Bf[t * 132 + 2 * kp + 1])); }
        for (int t = w; t < 64; t += 8) {
            const int s = c.lane; float a = 0.f;
            if (s <= t) {
                for (int k = 0; k < 128; k += 4) {
                    const f32x4 bt = *(const LAS f32x4*)(Bf + t * 132 + k), bs = *(const LAS f32x4*)(Bf + s * 132 + k);
                    const u32x2 qv = *(const LAS u32x2*)(Qs + t * 136 + k), kv = *(const LAS u32x2*)(Ks + s * 136 + k);
                    a += lo_bf(qv.x) * lo_bf(kv.x) * __expf(bt[0] - bs[0]) + hi_bf(qv.x) * hi_bf(kv.x) * __expf(bt[1] - bs[1])
                       + lo_bf(qv.y) * lo_bf(kv.y) * __expf(bt[2] - bs[2]) + hi_bf(qv.y) * hi_bf(kv.y) * __expf(bt[3] - bs[3]);
                }
            }
            ATT[t * 72 + s] = (bf16_t)f2bf(a);
        }
        __syncthreads();
        f32x4 acc[4];
#pragma unroll
        for (int m = 0; m < 4; ++m) acc[m] = (f32x4){0.f, 0.f, 0.f, 0.f};
#pragma unroll
        for (int ks = 0; ks < 4; ++ks) {
            const bf16x8 bfr = *(const LAS bf16x8*)(STs + (16 * w + fr) * 136 + ks * 32 + 8 * fq);
#pragma unroll
            for (int m = 0; m < 4; ++m) { const bf16x8 afr = *(const LAS bf16x8*)(QB + (16 * m + fr) * 136 + ks * 32 + 8 * fq); acc[m] = MFMA16(afr, bfr, acc[m]); }
        }
#pragma unroll
        for (int ks = 0; ks < 2; ++ks) {
            const bf16x8 bfr = *(const LAS bf16x8*)(VT + (16 * w + fr) * 72 + ks * 32 + 8 * fq);
#pragma unroll
            for (int m = 0; m < 4; ++m) { const bf16x8 afr = *(const LAS bf16x8*)(ATT + (16 * m + fr) * 72 + ks * 32 + 8 * fq); acc[m] = MFMA16(afr, bfr, acc[m]); }
        }
#pragma unroll
        for (int m = 0; m < 4; ++m)
#pragma unroll
            for (int r = 0; r < 4; ++r) Bf[(16 * m + 4 * fq + r) * 132 + 16 * w + fr] = acc[m][r];
        __syncthreads();
        for (int t = w * 8; t < w * 8 + 8; ++t) {
            const f32x2 o = *(const LAS f32x2*)(Bf + t * 132 + 2 * c.lane);
            const float rstd = 1.0f / sqrtf(wave_sum(o.x * o.x + o.y * o.y) * (1.0f / 128.0f) + EPS);
            const unsigned gv = *(const unsigned*)(U + (size_t)(tok0 + t) * NU + UHG + h * 128 + 2 * c.lane);
            const f32x2 wv = *(const f32x2*)(nw + h * 128 + 2 * c.lane);
            *(unsigned*)(YC + (size_t)(tok0 + t) * 2048 + 1024 + h * 128 + 2 * c.lane) = pk2(o.x * rstd * wv.x * siluf_(lo_bf(gv)), o.y * rstd * wv.y * siluf_(hi_bf(gv)));
        }
        __syncthreads();
    }
}

__device__ __forceinline__ void phase_lru1(const Params& p, const Ctx& c, int l) {
    LAS unsigned char* wl = c.lds + c.wave * 12288;
    LAS bf16_t* XB = (LAS bf16_t*)wl;
    LAS float* As = (LAS float*)(wl + 2304);
    LAS float* Us = (LAS float*)(wl + 2304 + 4096);
    const bf16_t* U = (const bf16_t*)(p.ws + WS_U); bf16_t* LA = (bf16_t*)(p.ws + WS_LA); bf16_t* LH = (bf16_t*)(p.ws + WS_LH);
    const bf16_t* LW = (const bf16_t*)(p.ws + WS_LRUW) + (size_t)l * 2 * 8 * 4096;
    const int fr = c.lane & 15, fq = c.lane >> 4, g = c.wave, chn = g * 64 + c.lane;
    const float cw0 = p.in[I_LCW][(size_t)l * 2048 + chn], cw1 = p.in[I_LCW][(size_t)l * 2048 + 512 + chn], cw2 = p.in[I_LCW][(size_t)l * 2048 + 1024 + chn], cw3 = p.in[I_LCW][(size_t)l * 2048 + 1536 + chn];
    const float cbias = p.in[I_LCB][l * 512 + chn];
    bf16x8 wfa[4][2], wfx[4][2];
#pragma unroll
    for (int n = 0; n < 4; ++n)
#pragma unroll
        for (int ks = 0; ks < 2; ++ks) { wfa[n][ks] = *(const bf16x8*)(LW + (size_t)(0 * 8 + g) * 4096 + (16 * n + fr) * 64 + ks * 32 + 8 * fq);
                                         wfx[n][ks] = *(const bf16x8*)(LW + (size_t)(1 * 8 + g) * 4096 + (16 * n + fr) * 64 + ks * 32 + 8 * fq); }
    float bav[4], bxv[4], spl[4];
#pragma unroll
    for (int n = 0; n < 4; ++n) { const int j = g * 64 + 16 * n + fr; bav[n] = p.in[I_LBA][l * 512 + j]; bxv[n] = p.in[I_LBX][l * 512 + j]; spl[n] = softplusf_(-p.in[I_LLAM][l * 512 + j]); }
    for (int it = c.bid; it < 128; it += c.G) {
        const int seg = it & 15, tok0 = (it >> 4) * SEQ + seg * 128;
        float x0 = 0.f, x1 = 0.f, x2 = 0.f;
        if (seg > 0) { x0 = bf2f(U[(size_t)(tok0 - 3) * NU + ULX + chn]); x1 = bf2f(U[(size_t)(tok0 - 2) * NU + ULX + chn]); x2 = bf2f(U[(size_t)(tok0 - 1) * NU + ULX + chn]); }
        float hrun = 0.f, arun = 1.f;
        for (int st = 0; st < 8; ++st) {
            const int t0 = tok0 + st * 16;
#pragma unroll
            for (int tt = 0; tt < 16; ++tt) { const float xr = bf2f(U[(size_t)(t0 + tt) * NU + ULX + chn]);
                const float xb = cbias + cw0 * x0 + cw1 * x1 + cw2 * x2 + cw3 * xr; x0 = x1; x1 = x2; x2 = xr;
                XB[tt * 72 + c.lane] = (bf16_t)f2bf(xb); }
            LDS_WAIT();
            f32x4 ar[4], ai[4];
#pragma unroll
            for (int n = 0; n < 4; ++n) { ar[n] = (f32x4){0.f, 0.f, 0.f, 0.f}; ai[n] = (f32x4){0.f, 0.f, 0.f, 0.f}; }
#pragma unroll
            for (int ks = 0; ks < 2; ++ks) { const bf16x8 afr = *(const LAS bf16x8*)(XB + fr * 72 + ks * 32 + 8 * fq);
#pragma unroll
                for (int n = 0; n < 4; ++n) { ar[n] = MFMA16(afr, wfa[n][ks], ar[n]); ai[n] = MFMA16(afr, wfx[n][ks], ai[n]); } }
#pragma unroll
            for (int n = 0; n < 4; ++n)
#pragma unroll
                for (int r = 0; r < 4; ++r) { const int t = 4 * fq + r, j = 16 * n + fr;
                    const float rg = sigmoidf_(ar[n][r] + bav[n]), ig = sigmoidf_(ai[n][r] + bxv[n]);
                    const float la = -8.0f * rg * spl[n], a = __expf(la), mult = sqrtf(-expm1f(2.0f * la));
                    As[t * 64 + j] = a; Us[t * 64 + j] = mult * ig * bf2f(XB[t * 72 + j]); }
            LDS_WAIT();
#pragma unroll
            for (int tt = 0; tt < 16; ++tt) { const float a = As[tt * 64 + c.lane], uu = Us[tt * 64 + c.lane];
                hrun = a * hrun + uu; arun = a * arun;
                LA[(size_t)(t0 + tt) * 512 + chn] = (bf16_t)f2bf(arun); LH[(size_t)(t0 + tt) * 512 + chn] = (bf16_t)f2bf(hrun); }
            LDS_WAIT();
        }
    }
}
__device__ __forceinline__ void phase_lru2(const Params& p, const Ctx& c, int l) {
    LAS float* PART = (LAS float*)c.lds;
    const bf16_t* U = (const bf16_t*)(p.ws + WS_U); const bf16_t* LA = (const bf16_t*)(p.ws + WS_LA); const bf16_t* LH = (const bf16_t*)(p.ws + WS_LH);
    bf16_t* YC = (bf16_t*)(p.ws + WS_YCAT);
    const int g = c.wave, chn = g * 64 + c.lane;
    const float nwv = p.in[I_LNW][l * 512 + chn];
    for (int it = c.bid; it < 128; it += c.G) {
        const int seg = it & 15, b = it >> 4, tok0 = b * SEQ + seg * 128;
        float hin = 0.f;
        for (int s2 = 0; s2 < seg; ++s2) { const size_t row = (size_t)(b * SEQ + s2 * 128 + 127); hin = bf2f(LH[row * 512 + chn]) + bf2f(LA[row * 512 + chn]) * hin; }
        for (int sb = 0; sb < 4; ++sb) {
            float y[32];
#pragma unroll
            for (int tt = 0; tt < 32; ++tt) { const size_t tok = (size_t)(tok0 + sb * 32 + tt);
                const float hh = bf2f(LH[tok * 512 + chn]) + bf2f(LA[tok * 512 + chn]) * hin;
                y[tt] = hh * gelu_tanhf_(bf2f(U[tok * NU + ULG + chn]));
                const float ss = wave_sum(y[tt] * y[tt]);
                if (c.lane == 0) PART[tt * 8 + g] = ss; }
            __syncthreads();
#pragma unroll
            for (int tt = 0; tt < 32; ++tt) { const f32x4 p0 = *(const LAS f32x4*)(PART + tt * 8), p1 = *(const LAS f32x4*)(PART + tt * 8 + 4);
                const float tot = ((p0[0] + p0[1]) + (p0[2] + p0[3])) + ((p1[0] + p1[1]) + (p1[2] + p1[3]));
                const float rstd = 1.0f / sqrtf(tot * (1.0f / 512.0f) + EPS);
                YC[(size_t)(tok0 + sb * 32 + tt) * 2048 + 1536 + chn] = (bf16_t)f2bf(y[tt] * rstd * nwv); }
            __syncthreads();
        }
    }
}

__device__ __forceinline__ void phase_norm_router(const Params& p, const Ctx& c, int l, const float* xin) {
    LAS float* HS = (LAS float*)(c.lds + c.wave * 16384);
    const float* mod = (const float*)(p.ws + WS_MOD) + (size_t)l * 8 * NMOD;
    const float* nw = p.in[I_NFFN] + (size_t)l * DM;
    const float* RWt = p.in[I_RW] + (size_t)l * DM * NEXP;
    const float rbias = p.in[I_RB][l * NEXP + c.lane];
    bf16_t* H = (bf16_t*)(p.ws + WS_H);
    unsigned long long* selm = (unsigned long long*)(p.ws + WS_SELM); float* rw = (float*)(p.ws + WS_RW);
    const int gw = c.bid * NWAVES + c.wave, NGW = c.G * NWAVES;
    for (int t4 = gw; t4 < NTOK / 4; t4 += NGW) {
        const int tokb = t4 * 4, b = tokb >> 11;
#pragma unroll
        for (int q = 0; q < 4; ++q) {
            const int tok = tokb + q;
            const f32x4* xr = (const f32x4*)(xin + (size_t)tok * DM) + c.lane;
            f32x4 v[4]; float ss = 0.f;
#pragma unroll
            for (int j = 0; j < 4; ++j) { v[j] = xr[64 * j]; ss += (v[j][0] * v[j][0] + v[j][1] * v[j][1]) + (v[j][2] * v[j][2] + v[j][3] * v[j][3]); }
            const float rstd = 1.0f / sqrtf(wave_sum(ss) * (1.0f / DM) + EPS);
#pragma unroll
            for (int j = 0; j < 4; ++j) {
                const int col = 256 * j + 4 * c.lane;
                const f32x4 w4 = *(const f32x4*)(nw + col), sh = *(const f32x4*)(mod + (size_t)b * NMOD + 3072 + col), sc = *(const f32x4*)(mod + (size_t)b * NMOD + 4096 + col);
                const f32x4 h = (v[j] * rstd * w4) * (sc + 1.0f) + sh;
                u32x2 o; o.x = pk2(h[0], h[1]); o.y = pk2(h[2], h[3]);
                *(u32x2*)(H + (size_t)tok * DM + col) = o;
                *(LAS f32x4*)(HS + q * 1024 + col) = h;
            }
        }
        LDS_WAIT();
        float lg[4] = {0.f, 0.f, 0.f, 0.f};
        for (int k = 0; k < 1024; k += 4) {
            const float w0 = RWt[(size_t)(k + 0) * NEXP + c.lane], w1 = RWt[(size_t)(k + 1) * NEXP + c.lane], w2 = RWt[(size_t)(k + 2) * NEXP + c.lane], w3 = RWt[(size_t)(k + 3) * NEXP + c.lane];
#pragma unroll
            for (int q = 0; q < 4; ++q) { const f32x4 hv = *(const LAS f32x4*)(HS + q * 1024 + k); lg[q] += (hv[0] * w0 + hv[1] * w1) + (hv[2] * w2 + hv[3] * w3); }
        }
#pragma unroll
        for (int q = 0; q < 4; ++q) {
            const int tok = tokb + q;
            const float s = sigmoidf_(lg[q]), v = s + rbias;
            float m1 = v;
            m1 = fmaxf(m1, __shfl_xor(m1, 1)); m1 = fmaxf(m1, __shfl_xor(m1, 2)); m1 = fmaxf(m1, __shfl_xor(m1, 4));
            const unsigned long long eq = __ballot(v == m1);
            const int gbase = c.lane & ~7;
            const unsigned gm = (unsigned)((eq >> gbase) & 0xffull);
            const int first = gbase + __builtin_ctz(gm);
            float m2 = (c.lane == first) ? -3.0e38f : v;
            m2 = fmaxf(m2, __shfl_xor(m2, 1)); m2 = fmaxf(m2, __shfl_xor(m2, 2)); m2 = fmaxf(m2, __shfl_xor(m2, 4));
            const float gs = m1 + m2;
            const int mygrp = c.lane >> 3; int grank = 0;
#pragma unroll
            for (int g2 = 0; g2 < 8; ++g2) { const float o = __shfl(gs, g2 * 8); grank += (o > gs || (o == gs && g2 < mygrp)) ? 1 : 0; }
            const float vm = (grank < 4) ? v : -1.0e4f;
            int erank = 0;
            for (int e2 = 0; e2 < 64; ++e2) { const float o = __shfl(vm, e2); erank += (o > vm || (o == vm && e2 < c.lane)) ? 1 : 0; }
            const bool sel = erank < TOPK;
            const unsigned long long mask = __ballot(sel);
            const float wsum = wave_sum(sel ? s : 0.f);
            if (sel) { const int kk = __builtin_popcountll(mask & ((1ull << c.lane) - 1ull)); rw[(size_t)tok * 8 + kk] = s / wsum * 2.5f; }
            if (c.lane == 0) selm[tok] = mask;
        }
        LDS_WAIT();
    }
}
__device__ __forceinline__ void phase_route_count(const Params& p, const Ctx& c) {
    const unsigned long long* selm = (const unsigned long long*)(p.ws + WS_SELM); int* cnt = (int*)(p.ws + WS_CNT);
    const int gw = c.bid * NWAVES + c.wave, NGW = c.G * NWAVES;
    for (int ch = gw; ch < 256; ch += NGW) {
        const unsigned long long mine = selm[ch * 64 + c.lane]; int n = 0;
        for (int i = 0; i < 64; ++i) { const unsigned long long m = __shfl(mine, i); n += (int)((m >> c.lane) & 1ull); }
        cnt[ch * 64 + c.lane] = n;
    }
}
__device__ __forceinline__ void phase_route_assign(const Params& p, const Ctx& c) {
    const unsigned long long* selm = (const unsigned long long*)(p.ws + WS_SELM); const int* cnt = (const int*)(p.ws + WS_CNT);
    int* slot_tok = (int*)(p.ws + WS_SLOTTOK); int* slot_of = (int*)(p.ws + WS_SLOTOF); int* rinfo = (int*)(p.ws + WS_RINFO);
    const int gw = c.bid * NWAVES + c.wave, NGW = c.G * NWAVES;
    for (int ch = gw; ch < 256; ch += NGW) {
        int total = 0, before = 0;
        for (int j = 0; j < 256; ++j) { const int v = cnt[j * 64 + c.lane]; total += v; before += (j < ch) ? v : 0; }
        const int pad = (total + 255) & ~255;
        int incl = pad;
#pragma unroll
        for (int o = 1; o < 64; o <<= 1) { const int t = __shfl_up(incl, o); if (c.lane >= o) incl += t; }
        const int pstart = incl - pad;
        int run = pstart + before;
        const unsigned long long mine = selm[ch * 64 + c.lane];
        for (int i = 0; i < 64; ++i) {
            const unsigned long long m = __shfl(mine, i); const int tok = ch * 64 + i;
            if ((m >> c.lane) & 1ull) { const int kk = __builtin_popcountll(m & ((1ull << c.lane) - 1ull)); slot_tok[run] = tok; slot_of[tok * 8 + kk] = run; ++run; }
        }
        if (ch == 0) {
            for (int s = pstart + total; s < pstart + pad; ++s) slot_tok[s] = -1;
            for (int bk = pstart >> 8; bk < (pstart + pad) >> 8; ++bk) rinfo[64 + bk] = c.lane;
            if (c.lane == 63) rinfo[0] = incl >> 8;
        }
    }
}
__device__ __forceinline__ void phase_combine(const Params& p, const Ctx& c, int l) {
    const float* gate = (const float*)(p.ws + WS_MOD) + (size_t)l * 8 * NMOD + 5120;
    const bf16_t* Y = (const bf16_t*)(p.ws + WS_Y); const int* slot_of = (const int*)(p.ws + WS_SLOTOF); const float* rw = (const float*)(p.ws + WS_RW);
    const float* fw = p.in[I_FNW];
    const int gw = c.bid * NWAVES + c.wave, NGW = c.G * NWAVES;
    for (int tok = gw; tok < NTOK; tok += NGW) {
        const int b = tok >> 11;
        f32x4 acc[4];
#pragma unroll
        for (int j = 0; j < 4; ++j) acc[j] = (f32x4){0.f, 0.f, 0.f, 0.f};
#pragma unroll
        for (int k = 0; k < 8; ++k) { const int sl = slot_of[tok * 8 + k]; const float wk = rw[tok * 8 + k];
#pragma unroll
            for (int j = 0; j < 4; ++j) { const u32x2 yv = *(const u32x2*)(Y + (size_t)sl * DM + 256 * j + 4 * c.lane);
                acc[j][0] += wk * lo_bf(yv.x); acc[j][1] += wk * hi_bf(yv.x); acc[j][2] += wk * lo_bf(yv.y); acc[j][3] += wk * hi_bf(yv.y); } }
        f32x4* xr = (f32x4*)(p.out + (size_t)tok * DM) + c.lane;
        f32x4 v[4]; float ss = 0.f;
#pragma unroll
        for (int j = 0; j < 4; ++j) { const f32x4 gv = *(const f32x4*)(gate + (size_t)b * NMOD + 256 * j + 4 * c.lane); v[j] = xr[64 * j] + gv * acc[j];
            ss += (v[j][0] * v[j][0] + v[j][1] * v[j][1]) + (v[j][2] * v[j][2] + v[j][3] * v[j][3]); }
        if (l == NLAYER - 1) {
            const float rstd = 1.0f / sqrtf(wave_sum(ss) * (1.0f / DM) + EPS);
#pragma unroll
            for (int j = 0; j < 4; ++j) { const f32x4 w4 = *(const f32x4*)(fw + 256 * j + 4 * c.lane); xr[64 * j] = v[j] * rstd * w4; }
        } else {
#pragma unroll
            for (int j = 0; j < 4; ++j) xr[64 * j] = v[j];
        }
    }
}

constexpr int NQ_PHASE = 14;
template <int Q> __device__ __forceinline__ void run_q(const Params& p, const Ctx& c, int l) {
    const float* xin = (l == 0) ? p.in[I_X] : p.out;
    if constexpr (Q == 14) { phase_prep_io(p, c); __syncthreads(); phase_prep_small(p, c); __syncthreads(); phase_prep_experts(p, c, 0); }
    if constexpr (Q == 0) { if (l > 0) { phase_prep_experts(p, c, l); __syncthreads(); } phase_norm_mix(p, c, l, xin); }
    if constexpr (Q == 1) { pg8::Gemm g{(const bf16_t*)(p.ws + WS_H), (const bf16_t*)(p.ws + WS_WIN) + (size_t)l * NU * DM, DM, 0};
              pg8::DenseOrder S; S.init(NTOK, NU, c.G, c.bid); EpiU E{(bf16_t*)(p.ws + WS_U), NU};
              pg8::gemm_phase<EpiU, pg8::DenseOrder, pg8::DenseRows, true, true>(c.lds, g, S, E, pg8::DenseRows()); }
    if constexpr (Q == 2) { phase_ssd_conv(p, c, l); __syncthreads(); phase_hg_state(p, c, l); __syncthreads(); phase_lru1(p, c, l); }
    if constexpr (Q == 3) { phase_ssd_state(p, c); __syncthreads(); phase_hg_scan(p, c); __syncthreads(); phase_lru2(p, c, l); }
    if constexpr (Q == 4) { phase_ssd_scan(p, c); __syncthreads(); phase_hg_out(p, c, l); }
    if constexpr (Q == 5) phase_ssd_out(p, c, l);
    if constexpr (Q == 6) phase_ssd_gate(p, c, l);
    if constexpr (Q == 7) { pg8::Gemm g{(const bf16_t*)(p.ws + WS_YCAT), (const bf16_t*)(p.ws + WS_WOUT) + (size_t)l * DM * 2048, 2048, 0};
              pg8::DenseOrder S; S.init(NTOK, DM, c.G, c.bid); EpiOut E{xin, p.out, (const float*)(p.ws + WS_MOD) + (size_t)l * 8 * NMOD + 2048};
              pg8::gemm_phase<EpiOut, pg8::DenseOrder, pg8::DenseRows, false, true>(c.lds, g, S, E, pg8::DenseRows()); }
    if constexpr (Q == 8) phase_norm_router(p, c, l, p.out);
    if constexpr (Q == 9) phase_route_count(p, c);
    if constexpr (Q == 10) phase_route_assign(p, c);
    if constexpr (Q == 11) { pg8::Gemm g{(const bf16_t*)(p.ws + WS_H), (const bf16_t*)(p.ws + WS_GU), DM, (size_t)512 * DM * 2};
               MoeOrder S{(const int*)(p.ws + WS_RINFO), 2, c.G, c.bid}; EpiH E{(bf16_t*)(p.ws + WS_HMID)};
               GatherRows AM{(const int*)(p.ws + WS_SLOTTOK), (const int*)(p.ws + WS_RINFO)};
               pg8::gemm_phase<EpiH, MoeOrder, GatherRows, true, true>(c.lds, g, S, E, AM); }
    if constexpr (Q == 12) { pg8::Gemm g{(const bf16_t*)(p.ws + WS_HMID), (const bf16_t*)(p.ws + WS_DN), 256, (size_t)DM * 256 * 2};
               MoeOrder S{(const int*)(p.ws + WS_RINFO), 4, c.G, c.bid};
               EpiY E{(bf16_t*)(p.ws + WS_Y), p.out, (const float*)(p.ws + WS_MOD) + (size_t)l * 8 * NMOD + 5120, (const int*)(p.ws + WS_RINFO)};
               pg8::gemm_phase<EpiY, MoeOrder, pg8::DenseRows, true, true>(c.lds, g, S, E, pg8::DenseRows()); }
    if constexpr (Q == 13) phase_combine(p, c, l);
}

template <int Q> __global__ void __launch_bounds__(NTHREADS, 2) phase_kernel(Params p) {
    extern __shared__ __attribute__((aligned(16))) unsigned char lds_raw[];
    Ctx c; c.lds = (LAS unsigned char*)lds_raw; c.tid = threadIdx.x; c.lane = c.tid & 63; c.wave = __builtin_amdgcn_readfirstlane(c.tid >> 6); c.G = gridDim.x; c.bid = blockIdx.x;
    run_q<Q>(p, c, p.layer);
}
template <int Q> static void launch_q(const Params& p, int grid, hipStream_t stream) {
    static bool attr = false;
    if (!attr) { (void)hipFuncSetAttribute((const void*)phase_kernel<Q>, hipFuncAttributeMaxDynamicSharedMemorySize, LDS_BYTES); attr = true; }
    hipLaunchKernelGGL(phase_kernel<Q>, dim3(grid), dim3(NTHREADS), LDS_BYTES, stream, p);
}

extern "C" void kernel_launch(void* const* d_in, const int* in_sizes, int n_in, void* d_out, int out_size, void* d_ws, size_t ws_size, hipStream_t stream) {
    static int grid = 0;
    if (grid == 0) {
        if (n_in != 33 || out_size != NTOK * DM || ws_size < WS_END) { fprintf(stderr, "kernel_launch: unexpected shapes (n_in %d out %d ws %zu)\n", n_in, out_size, ws_size); grid = -1; return; }
        int dev = 0, cus = 0;
        (void)hipGetDevice(&dev); (void)hipDeviceGetAttribute(&cus, hipDeviceAttributeMultiprocessorCount, dev);
        grid = cus > 0 ? cus : 256;
    }
    if (grid < 0) return;
    (void)hipMemsetAsync((char*)d_ws + WS_CTL, 0, CTL_ZERO_BYTES, stream);
    Params p{};
    for (int i = 0; i < 33; ++i) p.in[i] = (const float*)d_in[i];
    p.out = (float*)d_out; p.ws = (unsigned char*)d_ws;
    p.layer = 0; launch_q<14>(p, grid, stream);
    for (int l = 0; l < NLAYER; ++l) {
        p.layer = l;
        launch_q<0>(p, grid, stream); launch_q<1>(p, grid, stream); launch_q<2>(p, grid, stream); launch_q<3>(p, grid, stream); launch_q<4>(p, grid, stream);
        launch_q<5>(p, grid, stream); launch_q<6>(p, grid, stream); launch_q<7>(p, grid, stream); launch_q<8>(p, grid, stream); launch_q<9>(p, grid, stream);
        launch_q<10>(p, grid, stream); launch_q<11>(p, grid, stream); launch_q<12>(p, grid, stream); launch_q<13>(p, grid, stream);
    }
}
```

```cpp
#include <hip/hip_runtime.h>
#include <hip/hip_cooperative_groups.h>
#include <cstdio>
#include <cstdint>
namespace cg = cooperative_groups;

#ifndef MK_MEGA
#define MK_MEGA 1
#endif

#define LAS __attribute__((address_space(3)))
typedef unsigned short bf16_t;
typedef short bf16x8 __attribute__((ext_vector_type(8)));
typedef float f32x4 __attribute__((ext_vector_type(4)));
typedef float f32x2 __attribute__((ext_vector_type(2)));
typedef unsigned u32x4 __attribute__((ext_vector_type(4)));
typedef unsigned u32x2 __attribute__((ext_vector_type(2)));

constexpr int NTOK = 16384, DM = 1024, SEQ = 2048, NBATCH = 8, NLAYER = 2;
constexpr int DIN = 5648, NU = 5632;
constexpr int UZ = 0, UXS = 1024, UB = 2048, UC = 2304, UHQ = 2560, UHF = 3072, UHV = 3584, UHG = 4096, ULG = 4608, ULX = 5120;
constexpr int NMOD = 6144;
constexpr float EPS = 1e-6f;
constexpr int NEXP = 64, TOPK = 8;
constexpr int MAXSLOT = 147456;
constexpr int NTHREADS = 512, NWAVES = 8;
constexpr int LDS_BYTES = 160 * 1024;
constexpr int LDS_PTAB = LDS_BYTES - 512;

constexpr size_t MiB = (size_t)1 << 20;
constexpr size_t WS_CTL = 0, CTL_ZERO_BYTES = 1 * MiB;
constexpr size_t WS_MOD = 1 * MiB;
constexpr size_t WS_LB = WS_MOD + 512 * 1024;
constexpr size_t WS_LRUW = WS_LB + 8192;
constexpr size_t WS_DTRAW = 2 * MiB, WS_DT = 3 * MiB, WS_ACUM = 4 * MiB;
constexpr size_t WS_HGBL = 5 * MiB;
constexpr size_t WS_SELM = 5 * MiB + 512 * 1024;
constexpr size_t WS_RW = 6 * MiB;
constexpr size_t WS_SLOTOF = 6 * MiB + 512 * 1024;
constexpr size_t WS_SLOTTOK = 7 * MiB;
constexpr size_t WS_RINFO = 7 * MiB + 768 * 1024;
constexpr size_t WS_CNT = 8 * MiB;
constexpr size_t WS_WIN = 12 * MiB;
constexpr size_t WS_WOUT = 34 * MiB;
constexpr size_t WS_GU = 42 * MiB;
constexpr size_t WS_DN = 107 * MiB;
constexpr size_t WS_H = 140 * MiB;
constexpr size_t WS_U = 172 * MiB;
constexpr size_t WS_SST = 348 * MiB;
constexpr size_t WS_HST = 380 * MiB;
constexpr size_t WS_LA = 412 * MiB, WS_LH = 428 * MiB;
constexpr size_t WS_XBC = 444 * MiB;
constexpr size_t WS_YCAT = 492 * MiB;
constexpr size_t WS_HMID = 172 * MiB;
constexpr size_t WS_Y = 252 * MiB;
constexpr size_t WS_END = 556 * MiB;

__device__ __forceinline__ float bf2f(bf16_t b) { return __uint_as_float(((unsigned)b) << 16); }
__device__ __forceinline__ unsigned f2bf(float f) { unsigned u = __float_as_uint(f); return (u + 0x7fffu + ((u >> 16) & 1u)) >> 16; }
__device__ __forceinline__ unsigned pk2(float lo, float hi) { return f2bf(lo) | (f2bf(hi) << 16); }
__device__ __forceinline__ float lo_bf(unsigned w) { return __uint_as_float(w << 16); }
__device__ __forceinline__ float hi_bf(unsigned w) { return __uint_as_float(w & 0xffff0000u); }
__device__ __forceinline__ float sigmoidf_(float x) { return 1.0f / (1.0f + __expf(-x)); }
__device__ __forceinline__ float siluf_(float x) { return x / (1.0f + __expf(-x)); }
__device__ __forceinline__ float softplusf_(float x) { return fmaxf(x, 0.f) + log1pf(__expf(-fabsf(x))); }
__device__ __forceinline__ float gelu_tanhf_(float x) { const float t = tanhf(0.7978845608028654f * (x + 0.044715f * x * x * x)); return 0.5f * x * (1.0f + t); }
__device__ __forceinline__ float shfl_xor_l(float v, int mask, int lane) { return __builtin_bit_cast(float, __builtin_amdgcn_ds_bpermute((lane ^ mask) << 2, __builtin_bit_cast(int, v))); }
__device__ __forceinline__ int shfl_up_l(int v, int d, int lane) { return __builtin_amdgcn_ds_bpermute((lane - d) << 2, v); }
__device__ __forceinline__ float rdlane_f(float v, int src) { return __builtin_bit_cast(float, __builtin_amdgcn_readlane(__builtin_bit_cast(int, v), src)); }
__device__ __forceinline__ unsigned long long rdlane_u64(unsigned long long v, int src) {
    const unsigned lo = (unsigned)__builtin_amdgcn_readlane((int)(unsigned)v, src), hi = (unsigned)__builtin_amdgcn_readlane((int)(unsigned)(v >> 32), src); return ((unsigned long long)hi << 32) | lo; }
__device__ __forceinline__ float wave_sum(float v, int lane) {
#pragma unroll
    for (int o = 1; o < 64; o <<= 1) v += shfl_xor_l(v, o, lane);
    return v;
}
#define LDS_WAIT() asm volatile("s_waitcnt lgkmcnt(0)" ::: "memory")
__device__ __forceinline__ int fresh_lane() { unsigned ones = ~0u; asm volatile("" : "+s"(ones)); return (int)__builtin_amdgcn_mbcnt_hi(ones, __builtin_amdgcn_mbcnt_lo(ones, 0u)); }
#define MFMA16(a, b, c) __builtin_amdgcn_mfma_f32_16x16x32_bf16((a), (b), (c), 0, 0, 0)

namespace pg8 {
constexpr int BM = 256, BK = 64, HALF = 128, HTB = HALF * BK * 2, STAGE_BYTES = 8 * HTB, NXCD = 8, WGM = 8;
__device__ __forceinline__ int lds_byte(int r, int c) { const int st = (r >> 4) * 2 + (c >> 5), rr = r & 15, cc = c & 31, ob = rr * 64 + cc * 2; return st * 1024 + (ob ^ (((ob >> 9) & 1) << 5)); }
__device__ __forceinline__ void stage_rc(int b, int& R, int& C) { const int st = b / 1024, sb = b % 1024, swz = sb ^ (((sb >> 9) & 1) << 5); R = (st >> 1) * 16 + swz / 64; C = (st & 1) * 32 + (swz % 64) / 2; }
__device__ __forceinline__ int perm32(int rho) { const int n = rho >> 4, i = rho & 15; return 8 * (i >> 2) + 4 * n + (i & 3); }

struct Unit { int pm, pn, e; };
struct Gemm { const bf16_t* A; const bf16_t* Bt; int K; size_t estride; };

struct DenseOrder {
    int nM, nN, nwg, G, c;
    __device__ void init(int M, int N, int G_, int c_) { nM = M / BM; nN = N / BM; nwg = nM * nN; G = G_; c = c_; }
    __device__ bool next(int i, Unit& u) const {
        const long L = (long)i * G + c; if (L >= nwg) return false;
        int wgid = (int)L; { const int q = nwg / NXCD, r = nwg % NXCD, xcd = wgid % NXCD, off = wgid / NXCD; wgid = (xcd < r ? xcd * (q + 1) : r * (q + 1) + (xcd - r) * q) + off; }
        const int nig = WGM * nN, gid = wgid / nig, fm = gid * WGM, gsz = (nM - fm) < WGM ? (nM - fm) : WGM;
        u.pm = fm + ((wgid % nig) % gsz); u.pn = (wgid % nig) / gsz; u.e = 0; return true;
    }
};
struct DenseRows { __device__ __forceinline__ int row(const Unit& u, int r) const { return u.pm * BM + r; } };

template <class Epi, class Sched, class AMap, bool ALIGN_EPI, bool SP2>
__device__ __forceinline__ void gemm_phase(LAS unsigned char* lds, const Gemm g, const Sched& S, const Epi& E, const AMap& AM, int wave_id) {
    const int wid = wave_id, lane = fresh_lane(), tid = wid * 64 + lane, wr = wid >> 2, wc = wid & 3, fr = lane & 15, fq = lane >> 4;
    const int K = g.K, nt = K / BK;
    unsigned voffB0;
    { int R, C; stage_rc(tid * 16, R, C); const int Rb = Epi::PERM ? ((R & ~31) + perm32(R & 31)) : R; voffB0 = (unsigned)(Rb * K + C) * 2u; }
    const size_t p1step = (size_t)64 * K * 2;
    const size_t kstep = (size_t)(BK * 2);
    const size_t hstep = (size_t)HALF * K * 2;
    const size_t tstep = 2 * hstep;
    const unsigned ldsw = (unsigned)wid * 1024u;
    const int aoff = lds_byte(wr * 64 + fr, fq * 8), boff = lds_byte(wc * 32 + fr, fq * 8);
#define PG8_SA(b, h) (((b) * 2 + (h)) * HTB)
#define PG8_SB(b, h) ((4 + (b) * 2 + (h)) * HTB)
#define PG8_STAGE2(bufoff, gbase, v0, v1) do { \
        __builtin_amdgcn_global_load_lds((const unsigned*)((const char*)(gbase) + (v0)), (LAS unsigned*)(lds + (bufoff) + ldsw), 16, 0, 0); \
        __builtin_amdgcn_global_load_lds((const unsigned*)((const char*)(gbase) + (v1)), (LAS unsigned*)(lds + (bufoff) + ldsw + 8192), 16, 0, 0); } while (0)
#define PG8_STAGEB(bufoff, gbase) do { \
        __builtin_amdgcn_global_load_lds((const unsigned*)((const char*)(gbase) + voffB0), (LAS unsigned*)(lds + (bufoff) + ldsw), 16, 0, 0); \
        __builtin_amdgcn_global_load_lds((const unsigned*)((const char*)(gbase) + p1step + voffB0), (LAS unsigned*)(lds + (bufoff) + ldsw + 8192), 16, 0, 0); } while (0)
#define PG8_LDA(dst, b, h) do { _Pragma("unroll") for (int m = 0; m < 4; ++m) _Pragma("unroll") for (int k = 0; k < 2; ++k) dst[m][k] = *(const LAS bf16x8*)(lds + PG8_SA(b, h) + aoff + m * 2048 + k * 1024); } while (0)
#define PG8_LDB(dst, b, h) do { _Pragma("unroll") for (int n = 0; n < 2; ++n) _Pragma("unroll") for (int k = 0; k < 2; ++k) dst[n][k] = *(const LAS bf16x8*)(lds + PG8_SB(b, h) + boff + n * 2048 + k * 1024); } while (0)
#define PG8_MMA(ai, bj, At, Bt) do { __builtin_amdgcn_s_setprio(1); _Pragma("unroll") for (int m = 0; m < 4; ++m) _Pragma("unroll") for (int n = 0; n < 2; ++n) _Pragma("unroll") for (int k = 0; k < 2; ++k) \
        acc[ai][bj][m][n] = __builtin_amdgcn_mfma_f32_16x16x32_bf16(Bt[n][k], At[m][k], acc[ai][bj][m][n], 0, 0, 0); __builtin_amdgcn_s_setprio(0); } while (0)
#define PG8_WAIT_V(n) asm volatile("s_waitcnt vmcnt(" #n ")" ::: "memory")
#define PG8_WAIT_L(n) asm volatile("s_waitcnt lgkmcnt(" #n ")" ::: "memory")
#define PG8_BAR __builtin_amdgcn_s_barrier()
#define PG8_SCHED __builtin_amdgcn_sched_barrier(0)
#define PG8_AOFFS(u, v00, v01, v10, v11) do { int R_, C_; stage_rc(tid * 16, R_, C_); \
        v00 = (unsigned)(AM.row(u, R_) * K + C_) * 2u; v01 = (unsigned)(AM.row(u, R_ + 64) * K + C_) * 2u; \
        v10 = (unsigned)(AM.row(u, HALF + R_) * K + C_) * 2u; v11 = (unsigned)(AM.row(u, HALF + R_ + 64) * K + C_) * 2u; } while (0)
    Unit cur, nxt; int ui = 0;
    if (!S.next(0, cur)) return;
    f32x4 acc[2][2][4][2];
#pragma unroll
    for (int a = 0; a < 2; ++a)
#pragma unroll
        for (int b = 0; b < 2; ++b)
#pragma unroll
            for (int m = 0; m < 4; ++m)
#pragma unroll
                for (int n = 0; n < 2; ++n) acc[a][b][m][n] = (f32x4){0.f, 0.f, 0.f, 0.f};
    bf16x8 At[4][2], B0[2][2], B1[2][2];
    const char* const Abase = (const char*)g.A;
    const char* cB = (const char*)g.Bt + (size_t)cur.e * g.estride + (size_t)cur.pn * tstep;
    unsigned c00, c01, c10, c11, n00, n01, n10, n11;
    PG8_AOFFS(cur, c00, c01, c10, c11);
    n00 = c00; n01 = c01; n10 = c10; n11 = c11;
    if constexpr (SP2) {
        PG8_STAGEB(PG8_SB(0, 0), cB); PG8_STAGEB(PG8_SB(0, 1), cB + hstep); PG8_STAGE2(PG8_SA(0, 0), Abase, c00, c01); PG8_STAGE2(PG8_SA(0, 1), Abase, c10, c11);
        if (wr == 1) PG8_BAR;
        PG8_WAIT_V(2); PG8_BAR;
        PG8_STAGEB(PG8_SB(1, 0), cB + kstep); PG8_STAGE2(PG8_SA(1, 0), Abase + kstep, c00, c01); PG8_STAGEB(PG8_SB(1, 1), cB + hstep + kstep);
        PG8_WAIT_V(6); PG8_BAR;
    } else {
        PG8_STAGEB(PG8_SB(0, 0), cB); PG8_STAGE2(PG8_SA(0, 0), Abase, c00, c01); PG8_STAGEB(PG8_SB(0, 1), cB + hstep); PG8_STAGE2(PG8_SA(0, 1), Abase, c10, c11);
        if (wr == 1) PG8_BAR;
        PG8_WAIT_V(4); PG8_BAR;
        PG8_STAGEB(PG8_SB(1, 0), cB + kstep); PG8_STAGE2(PG8_SA(1, 0), Abase + kstep, c00, c01); PG8_STAGEB(PG8_SB(1, 1), cB + hstep + kstep);
        PG8_WAIT_V(6); PG8_BAR;
    }
    for (;;) {
        const bool has_next = S.next(ui + 1, nxt);
        const char* nB = cB;
        if (has_next) { nB = (const char*)g.Bt + (size_t)nxt.e * g.estride + (size_t)nxt.pn * tstep; PG8_AOFFS(nxt, n00, n01, n10, n11); }
        else { n00 = c00; n01 = c01; n10 = c10; n11 = c11; }
        for (int t = 0; t < nt; t += 2) {
            const bool last = (t == nt - 2);
            const char* a1 = Abase + (size_t)(t + 1) * kstep;
            const char* a2 = last ? Abase : Abase + (size_t)(t + 2) * kstep;
            const char* b2 = last ? nB : cB + (size_t)(t + 2) * kstep;
            const char* a3 = a2 + kstep; const char* b3 = b2 + kstep;
            const unsigned x00 = last ? n00 : c00, x01 = last ? n01 : c01, x10 = last ? n10 : c10, x11 = last ? n11 : c11;
            if constexpr (SP2) {
            PG8_LDB(B0, 0, 0); PG8_LDB(B1, 0, 1); PG8_SCHED; PG8_LDA(At, 0, 0); PG8_STAGE2(PG8_SA(1, 1), a1, c10, c11);
            PG8_WAIT_V(8); PG8_WAIT_L(0); PG8_BAR; PG8_MMA(0, 0, At, B0); PG8_MMA(0, 1, At, B1); PG8_BAR; PG8_SCHED;
            PG8_LDA(At, 0, 1); PG8_STAGEB(PG8_SB(0, 0), b2); PG8_STAGEB(PG8_SB(0, 1), b2 + hstep); PG8_STAGE2(PG8_SA(0, 0), a2, x00, x01);
            PG8_WAIT_V(8); PG8_WAIT_L(0); PG8_BAR; PG8_MMA(1, 0, At, B0); PG8_MMA(1, 1, At, B1); PG8_BAR; PG8_SCHED;
            PG8_LDB(B0, 1, 0); PG8_LDB(B1, 1, 1); PG8_SCHED; PG8_LDA(At, 1, 0); PG8_STAGE2(PG8_SA(0, 1), a2, x10, x11);
            PG8_WAIT_V(8); PG8_WAIT_L(0); PG8_BAR; PG8_MMA(0, 0, At, B0); PG8_MMA(0, 1, At, B1); PG8_BAR; PG8_SCHED;
            PG8_LDA(At, 1, 1); PG8_STAGEB(PG8_SB(1, 0), b3); PG8_STAGEB(PG8_SB(1, 1), b3 + hstep); PG8_STAGE2(PG8_SA(1, 0), a3, x00, x01);
            PG8_WAIT_V(8); PG8_WAIT_L(0); PG8_BAR; PG8_MMA(1, 0, At, B0); PG8_MMA(1, 1, At, B1); PG8_BAR; PG8_SCHED;
            } else {
            PG8_LDB(B0, 0, 0); PG8_SCHED; PG8_LDA(At, 0, 0); PG8_STAGE2(PG8_SA(1, 1), a1, c10, c11);
            PG8_WAIT_L(8); PG8_BAR; PG8_WAIT_L(0); PG8_MMA(0, 0, At, B0); PG8_BAR; PG8_SCHED;
            PG8_LDB(B1, 0, 1); PG8_STAGEB(PG8_SB(0, 0), b2);
            PG8_BAR; PG8_WAIT_L(0); PG8_MMA(0, 1, At, B1); PG8_BAR;
            PG8_LDA(At, 0, 1); PG8_STAGE2(PG8_SA(0, 0), a2, x00, x01);
            PG8_BAR; PG8_WAIT_L(0); PG8_MMA(1, 0, At, B0); PG8_BAR; PG8_SCHED;
            PG8_STAGEB(PG8_SB(0, 1), b2 + hstep);
            PG8_WAIT_V(6); PG8_BAR; PG8_MMA(1, 1, At, B1); PG8_BAR;
            PG8_LDB(B0, 1, 0); PG8_SCHED; PG8_LDA(At, 1, 0); PG8_STAGE2(PG8_SA(0, 1), a2, x10, x11);
            PG8_WAIT_L(8); PG8_BAR; PG8_WAIT_L(0); PG8_MMA(0, 0, At, B0); PG8_BAR; PG8_SCHED;
            PG8_LDB(B1, 1, 1); PG8_STAGEB(PG8_SB(1, 0), b3);
            PG8_BAR; PG8_WAIT_L(0); PG8_MMA(0, 1, At, B1); PG8_BAR;
            PG8_LDA(At, 1, 1); PG8_STAGE2(PG8_SA(1, 0), a3, x00, x01);
            PG8_BAR; PG8_WAIT_L(0); PG8_MMA(1, 0, At, B0); PG8_BAR; PG8_SCHED;
            PG8_STAGEB(PG8_SB(1, 1), b3 + hstep);
            PG8_WAIT_V(6); PG8_BAR; PG8_MMA(1, 1, At, B1); PG8_BAR;
            }
        }
        if constexpr (ALIGN_EPI) { if (wr == 0) PG8_BAR; }
        E(acc, cur, wr, wc);
        if (!has_next) break;
#pragma unroll
        for (int a = 0; a < 2; ++a)
#pragma unroll
            for (int b = 0; b < 2; ++b)
#pragma unroll
                for (int m = 0; m < 4; ++m)
#pragma unroll
                    for (int n = 0; n < 2; ++n) acc[a][b][m][n] = (f32x4){0.f, 0.f, 0.f, 0.f};
        cur = nxt; cB = nB; c00 = n00; c01 = n01; c10 = n10; c11 = n11; ++ui;
        if constexpr (ALIGN_EPI) { if (wr == 1) PG8_BAR; }
    }
    PG8_WAIT_V(0);
    if constexpr (!ALIGN_EPI) { if (wr == 0) PG8_BAR; }
    PG8_BAR;
#undef PG8_SA
#undef PG8_SB
#undef PG8_STAGE2
#undef PG8_STAGEB
#undef PG8_LDA
#undef PG8_LDB
#undef PG8_MMA
#undef PG8_WAIT_V
#undef PG8_WAIT_L
#undef PG8_BAR
#undef PG8_SCHED
#undef PG8_AOFFS
}
}

struct Params {
    const float* in[33];
    float* out;
    unsigned char* ws;
    int layer, pad;
};
enum { I_X = 0, I_C, I_ADAW, I_ADAB, I_NMIX, I_NFFN, I_WIN, I_SCW, I_SCB, I_SDTB, I_SALOG, I_SD, I_SNW, I_HLB, I_HNW, I_LCW, I_LCB, I_LWA, I_LBA, I_LWX, I_LBX, I_LLAM, I_LNW,
       I_WOUT, I_RW, I_RB, I_EG, I_EU, I_ED, I_SG, I_SU, I_SDN, I_FNW };

using pg8::Unit;
struct EpiU {
    static constexpr bool PERM = true;
    bf16_t* O; int ldc;
    __device__ __forceinline__ void operator()(const f32x4 (&acc)[2][2][4][2], const Unit& u, int wr, int wc) const {
        const int lane_ = fresh_lane(), fr = lane_ & 15, fq = lane_ >> 4;
        const int row0 = u.pm * 256 + wr * 64 + fr, col0 = u.pn * 256 + wc * 32 + 8 * fq;
#pragma unroll
        for (int ai = 0; ai < 2; ++ai)
#pragma unroll
            for (int m = 0; m < 4; ++m) { bf16_t* rowp = O + (size_t)(row0 + ai * 128 + m * 16) * ldc + col0;
#pragma unroll
                for (int bj = 0; bj < 2; ++bj) { const f32x4 v0 = acc[ai][bj][m][0], v1 = acc[ai][bj][m][1];
                    u32x4 w; w.x = pk2(v0[0], v0[1]); w.y = pk2(v0[2], v0[3]); w.z = pk2(v1[0], v1[1]); w.w = pk2(v1[2], v1[3]);
                    *(u32x4*)(rowp + bj * 128) = w; } }
    }
};
struct EpiOut {
    static constexpr bool PERM = false;
    const float* xin; float* xout; const float* gate;
    __device__ __forceinline__ void operator()(const f32x4 (&acc)[2][2][4][2], const Unit& u, int wr, int wc) const {
        const int lane_ = fresh_lane(), fr = lane_ & 15, fq = lane_ >> 4;
        const int row0 = u.pm * 256 + wr * 64 + fr, col0 = u.pn * 256 + wc * 32 + 4 * fq, b = u.pm >> 3;
        f32x4 gv[2][2];
#pragma unroll
        for (int bj = 0; bj < 2; ++bj)
#pragma unroll
            for (int n = 0; n < 2; ++n) gv[bj][n] = *(const f32x4*)(gate + (size_t)b * NMOD + col0 + bj * 128 + n * 16);
#pragma unroll
        for (int ai = 0; ai < 2; ++ai)
#pragma unroll
            for (int m = 0; m < 4; ++m) { const size_t off = (size_t)(row0 + ai * 128 + m * 16) * DM + col0;
#pragma unroll
                for (int bj = 0; bj < 2; ++bj)
#pragma unroll
                    for (int n = 0; n < 2; ++n) { const f32x4 xi = *(const f32x4*)(xin + off + bj * 128 + n * 16);
                        *(f32x4*)(xout + off + bj * 128 + n * 16) = xi + gv[bj][n] * acc[ai][bj][m][n]; }
                asm volatile("" ::: "memory"); }
    }
};
struct EpiH {
    static constexpr bool PERM = true;
    bf16_t* Hm;
    __device__ __forceinline__ void operator()(const f32x4 (&acc)[2][2][4][2], const Unit& u, int wr, int wc) const {
        const int lane_ = fresh_lane(), fr = lane_ & 15, fq = lane_ >> 4;
        const int row0 = u.pm * 256 + wr * 64 + fr, col0 = u.pn * 128 + wc * 32 + 8 * fq;
#pragma unroll
        for (int ai = 0; ai < 2; ++ai)
#pragma unroll
            for (int m = 0; m < 4; ++m) { bf16_t* rowp = Hm + (size_t)(row0 + ai * 128 + m * 16) * 256 + col0;
                f32x4 h0, h1;
#pragma unroll
                for (int j = 0; j < 4; ++j) { h0[j] = siluf_(acc[ai][0][m][0][j]) * acc[ai][1][m][0][j]; h1[j] = siluf_(acc[ai][0][m][1][j]) * acc[ai][1][m][1][j]; }
                u32x4 w; w.x = pk2(h0[0], h0[1]); w.y = pk2(h0[2], h0[3]); w.z = pk2(h1[0], h1[1]); w.w = pk2(h1[2], h1[3]);
                *(u32x4*)rowp = w; }
    }
};
struct EpiY {
    static constexpr bool PERM = true;
    bf16_t* Y; bf16_t* Ysh; const int* rinfo;
    __device__ __forceinline__ void operator()(const f32x4 (&acc)[2][2][4][2], const Unit& u, int wr, int wc) const {
        const int lane_ = fresh_lane(), fr = lane_ & 15, fq = lane_ >> 4;
        const int col0 = u.pn * 256 + wc * 32 + 8 * fq;
        bf16_t* base = Y + (size_t)u.pm * 256 * DM;
        if (u.e >= NEXP) base = Ysh + (size_t)(u.pm - rinfo[0]) * 256 * DM;
        base += (size_t)(wr * 64 + fr) * DM + col0;
#pragma unroll
        for (int ai = 0; ai < 2; ++ai)
#pragma unroll
            for (int m = 0; m < 4; ++m) { bf16_t* rowp = base + (size_t)(ai * 128 + m * 16) * DM;
#pragma unroll
                for (int bj = 0; bj < 2; ++bj) { const f32x4 v0 = acc[ai][bj][m][0], v1 = acc[ai][bj][m][1];
                    u32x4 w; w.x = pk2(v0[0], v0[1]); w.y = pk2(v0[2], v0[3]); w.z = pk2(v1[0], v1[1]); w.w = pk2(v1[2], v1[3]);
                    *(u32x4*)(rowp + bj * 128) = w; } }
    }
};
struct MoeOrder {
    const int* rinfo; int NQ, G, c;
    __device__ bool next(int i, Unit& u) const {
        const int nblk = rinfo[0]; const long L = (long)i * G + c;
        if (L >= (long)(nblk + 64) * NQ) return false;
        const int rb = (int)(L / NQ); u.pm = rb; u.pn = (int)(L % NQ); u.e = (rb < nblk) ? rinfo[64 + rb] : NEXP; return true;
    }
};
struct GatherRows {
    const int* slot_tok; const int* rinfo;
    __device__ __forceinline__ int row(const Unit& u, int r) const {
        const int nblk = rinfo[0];
        if (u.pm < nblk) { const int t = slot_tok[u.pm * 256 + r]; return t < 0 ? 0 : t; }
        return (u.pm - nblk) * 256 + r;
    }
};

struct Ctx { LAS unsigned char* lds; int tid, lane, wave, G, bid; };

template <class RowMap>
__device__ __forceinline__ void transpose_item(const float* W, int N, int k0, int n0, bf16_t* WT, int ldk, const RowMap& rm, LAS float* scr, int lane) {
    const int nn = n0 + (lane & 31);
#pragma unroll 8
    for (int i = 0; i < 32; ++i) { const int kk = 2 * i + (lane >> 5); scr[kk * 33 + (lane & 31)] = (nn < N) ? W[(size_t)(k0 + kk) * N + nn] : 0.f; }
    LDS_WAIT();
    const int c = lane & 7;
#pragma unroll
    for (int j = 0; j < 4; ++j) { const int n = (lane >> 3) + 8 * j; const LAS float* s = scr + (8 * c) * 33 + n;
        u32x4 o; o.x = pk2(s[0 * 33], s[1 * 33]); o.y = pk2(s[2 * 33], s[3 * 33]); o.z = pk2(s[4 * 33], s[5 * 33]); o.w = pk2(s[6 * 33], s[7 * 33]);
        const int dr = (n0 + n < N) ? rm(n0 + n) : -1;
        if (dr >= 0) *(u32x4*)(WT + (size_t)dr * ldk + k0 + 8 * c) = o; }
    LDS_WAIT();
}
struct RmIdent { __device__ __forceinline__ int operator()(int n) const { return n; } };
struct RmWin { __device__ __forceinline__ int operator()(int n) const { return n < 2560 ? n : (n < 2576 ? -1 : n - 16); } };
struct RmGate { __device__ __forceinline__ int operator()(int n) const { return (n >> 7) * 256 + (n & 127); } };
struct RmUp { __device__ __forceinline__ int operator()(int n) const { return (n >> 7) * 256 + 128 + (n & 127); } };

__device__ __forceinline__ void phase_prep_io(const Params& p, const Ctx& c) {
    LAS float* scr = (LAS float*)(c.lds + c.wave * 16384);
    const int gw = c.bid * NWAVES + c.wave, NGW = c.G * NWAVES;
    constexpr int I_IN = 16 * 177, I_OUT = 32 * 32, PER_L = I_IN + I_OUT;
    for (int it = gw; it < NLAYER * PER_L; it += NGW) {
        const int l = it / PER_L; int r = it % PER_L;
        if (r < I_IN) { const int kb = r / 177, nb = r % 177;
            transpose_item(p.in[I_WIN] + (size_t)l * DM * DIN, DIN, kb * 64, nb * 32, (bf16_t*)(p.ws + WS_WIN) + (size_t)l * NU * DM, DM, RmWin(), scr, c.lane); }
        else { r -= I_IN; const int kb = r / 32, nb = r % 32;
            transpose_item(p.in[I_WOUT] + (size_t)l * 2048 * DM, DM, kb * 64, nb * 32, (bf16_t*)(p.ws + WS_WOUT) + (size_t)l * DM * 2048, 2048, RmIdent(), scr, c.lane); }
    }
}
__device__ __forceinline__ void phase_prep_experts(const Params& p, const Ctx& c, int l) {
    LAS float* scr = (LAS float*)(c.lds + c.wave * 16384);
    const int gw = c.bid * NWAVES + c.wave, NGW = c.G * NWAVES;
    constexpr int PER_E = 3 * 128;
    bf16_t* GU = (bf16_t*)(p.ws + WS_GU); bf16_t* DN = (bf16_t*)(p.ws + WS_DN);
    for (int it = gw; it < 65 * PER_E; it += NGW) {
        const int e = it / PER_E; int r = it % PER_E; const int which = r / 128; r %= 128;
        if (which < 2) {
            const float* src = (e < NEXP) ? p.in[which == 0 ? I_EG : I_EU] + ((size_t)l * NEXP + e) * DM * 256 : p.in[which == 0 ? I_SG : I_SU] + (size_t)l * DM * 256;
            const int kb = r / 8, nb = r % 8;
            if (which == 0) transpose_item(src, 256, kb * 64, nb * 32, GU + (size_t)e * 512 * DM, DM, RmGate(), scr, c.lane);
            else transpose_item(src, 256, kb * 64, nb * 32, GU + (size_t)e * 512 * DM, DM, RmUp(), scr, c.lane);
        } else {
            const float* src = (e < NEXP) ? p.in[I_ED] + ((size_t)l * NEXP + e) * 256 * DM : p.in[I_SDN] + (size_t)l * 256 * DM;
            const int kb = r / 32, nb = r % 32;
            transpose_item(src, DM, kb * 64, nb * 32, DN + (size_t)e * DM * 256, 256, RmIdent(), scr, c.lane);
        }
    }
}
__device__ __forceinline__ void phase_prep_small(const Params& p, const Ctx& c) {
    LAS float* sc = (LAS float*)c.lds;
    LAS float* red = (LAS float*)(c.lds + 32768);
    float* mod = (float*)(p.ws + WS_MOD);
    bool have_sc = false;
    for (int it = c.bid; it < NLAYER * 96; it += c.G) {
        if (!have_sc) { for (int i = c.tid; i < 8 * 1024; i += NTHREADS) sc[i] = siluf_(p.in[I_C][i]); have_sc = true; }
        __syncthreads();
        const int l = it / 96, j0 = (it % 96) * 64, j = c.tid & 63, kg = c.tid >> 6;
        const float* W = p.in[I_ADAW] + (size_t)l * DM * NMOD + j0 + j;
        float a[8];
#pragma unroll
        for (int b = 0; b < 8; ++b) a[b] = 0.f;
        for (int k = kg * 128; k < kg * 128 + 128; ++k) { const float w = W[(size_t)k * NMOD];
#pragma unroll
            for (int b = 0; b < 8; ++b) a[b] += sc[b * 1024 + k] * w; }
#pragma unroll
        for (int b = 0; b < 8; ++b) red[(kg * 8 + b) * 64 + j] = a[b];
        __syncthreads();
        { const int b = c.tid >> 6; float s = 0.f;
#pragma unroll
          for (int g = 0; g < 8; ++g) s += red[(g * 8 + b) * 64 + j];
          mod[((size_t)l * 8 + b) * NMOD + j0 + j] = s + p.in[I_ADAB][(size_t)l * NMOD + j0 + j]; }
        __syncthreads();
    }
    if (c.bid == c.G - 1) {
        float* lb = (float*)(p.ws + WS_LB);
        for (int i = c.tid; i < 512; i += NTHREADS) { const float v0 = p.in[I_HLB][i], v1 = p.in[I_HLB][512 + i]; const float m = fmaxf(v0, v1), e0 = expf(v0 - m), e1 = expf(v1 - m);
            lb[i] = 0.f; lb[512 + i] = e1 / (e0 + e1); }
    }
    { bf16_t* LW = (bf16_t*)(p.ws + WS_LRUW);
      for (int o = c.bid * NTHREADS + c.tid; o < NLAYER * 2 * 8 * 4096; o += c.G * NTHREADS) {
          const int i = o & 63, j = (o >> 6) & 63, g = (o >> 12) & 7, mat = (o >> 15) & 1, l = o >> 16;
          const float* src = p.in[mat == 0 ? I_LWA : I_LWX] + (((size_t)l * 8 + g) * 64 + i) * 64 + j;
          LW[o] = (bf16_t)f2bf(*src); } }
}

__device__ __forceinline__ void phase_norm_mix(const Params& p, const Ctx& c, int l, const float* xin) {
    LAS float* wdt = (LAS float*)c.lds;
    const float* Win = p.in[I_WIN] + (size_t)l * DM * DIN;
    for (int i = c.tid; i < 16 * 1024; i += NTHREADS) { const int k = i >> 4, j = i & 15; wdt[j * 1024 + k] = Win[(size_t)k * DIN + 2560 + j]; }
    __syncthreads();
    const float* mod = (const float*)(p.ws + WS_MOD) + (size_t)l * 8 * NMOD;
    const float* nw = p.in[I_NMIX] + (size_t)l * DM;
    bf16_t* H = (bf16_t*)(p.ws + WS_H); float* dtraw = (float*)(p.ws + WS_DTRAW);
    const int gw = c.bid * NWAVES + c.wave, NGW = c.G * NWAVES;
    for (int tok = gw; tok < NTOK; tok += NGW) {
        const int b = tok >> 11;
        const f32x4* xr = (const f32x4*)(xin + (size_t)tok * DM) + c.lane;
        f32x4 v[4]; float ss = 0.f;
#pragma unroll
        for (int j = 0; j < 4; ++j) { v[j] = xr[64 * j]; ss += (v[j][0] * v[j][0] + v[j][1] * v[j][1]) + (v[j][2] * v[j][2] + v[j][3] * v[j][3]); }
        const float rstd = 1.0f / sqrtf(wave_sum(ss, c.lane) * (1.0f / DM) + EPS);
        f32x4 hv[4];
#pragma unroll
        for (int j = 0; j < 4; ++j) {
            const int col = 256 * j + 4 * c.lane;
            const f32x4 w4 = *(const f32x4*)(nw + col), sh = *(const f32x4*)(mod + (size_t)b * NMOD + col), sc = *(const f32x4*)(mod + (size_t)b * NMOD + 1024 + col);
            hv[j] = (v[j] * rstd * w4) * (sc + 1.0f) + sh;
            u32x2 o; o.x = pk2(hv[j][0], hv[j][1]); o.y = pk2(hv[j][2], hv[j][3]);
            *(u32x2*)(H + (size_t)tok * DM + col) = o;
        }
        float mine = 0.f;
#pragma unroll 2
        for (int q = 0; q < 16; ++q) {
            float s = 0.f;
#pragma unroll
            for (int j = 0; j < 4; ++j) { const f32x4 wq = *(const LAS f32x4*)(wdt + q * 1024 + 256 * j + 4 * c.lane); s += (hv[j][0] * wq[0] + hv[j][1] * wq[1]) + (hv[j][2] * wq[2] + hv[j][3] * wq[3]); }
            s = wave_sum(s, c.lane);
            mine = (c.lane == q) ? s : mine;
        }
        if (c.lane < 16) dtraw[(size_t)tok * 16 + c.lane] = mine;
    }
}

__device__ __forceinline__ void phase_ssd_conv(const Params& p, const Ctx& c, int l) {
    const bf16_t* U = (const bf16_t*)(p.ws + WS_U); bf16_t* XA = (bf16_t*)(p.ws + WS_XBC);
    const float* cw = p.in[I_SCW] + (size_t)l * 4 * 1536; const float* cb = p.in[I_SCB] + (size_t)l * 1536;
    const float* dtraw = (const float*)(p.ws + WS_DTRAW); float* dt = (float*)(p.ws + WS_DT); float* acum = (float*)(p.ws + WS_ACUM);
    for (int it = c.bid; it < 128; it += c.G) {
        const int b = it >> 4, ch = it & 15, tok0 = b * SEQ + ch * 128;
        for (int q = c.tid; q < 768; q += NTHREADS) {
            const int c0 = 2 * q;
            const float w00 = cw[c0], w01 = cw[1536 + c0], w02 = cw[3072 + c0], w03 = cw[4608 + c0], bb0 = cb[c0];
            const float w10 = cw[c0 + 1], w11 = cw[1536 + c0 + 1], w12 = cw[3072 + c0 + 1], w13 = cw[4608 + c0 + 1], bb1 = cb[c0 + 1];
            float a0 = 0.f, a1 = 0.f, a2 = 0.f, b0 = 0.f, b1 = 0.f, b2 = 0.f;
            if (ch > 0) { const unsigned r0 = *(const unsigned*)(U + (size_t)(tok0 - 3) * NU + UXS + c0), r1 = *(const unsigned*)(U + (size_t)(tok0 - 2) * NU + UXS + c0), r2 = *(const unsigned*)(U + (size_t)(tok0 - 1) * NU + UXS + c0);
                a0 = lo_bf(r0); b0 = hi_bf(r0); a1 = lo_bf(r1); b1 = hi_bf(r1); a2 = lo_bf(r2); b2 = hi_bf(r2); }
            for (int t = 0; t < 128; ++t) {
                const unsigned r = *(const unsigned*)(U + (size_t)(tok0 + t) * NU + UXS + c0);
                const float xa = lo_bf(r), xb = hi_bf(r);
                const float ya = bb0 + w00 * a0 + w01 * a1 + w02 * a2 + w03 * xa, yb = bb1 + w10 * b0 + w11 * b1 + w12 * b2 + w13 * xb;
                *(unsigned*)(XA + (size_t)(tok0 + t) * 1536 + c0) = pk2(siluf_(ya), siluf_(yb));
                a0 = a1; a1 = a2; a2 = xa; b0 = b1; b1 = b2; b2 = xb;
            }
        }
        if (c.tid < 16) { const int h = c.tid; const float bias = p.in[I_SDTB][l * 16 + h], A = -expf(p.in[I_SALOG][l * 16 + h]); float cum = 0.f;
            for (int t = 0; t < 128; ++t) { const float d = softplusf_(dtraw[(size_t)(tok0 + t) * 16 + h] + bias); cum += d * A; dt[(size_t)(tok0 + t) * 16 + h] = d; acum[(size_t)(tok0 + t) * 16 + h] = cum; } }
    }
}

__device__ __forceinline__ void phase_ssd_state(const Params& p, const Ctx& c) {
    LAS bf16_t* XT = (LAS bf16_t*)c.lds;
    LAS bf16_t* BT = (LAS bf16_t*)(c.lds + 64 * 136 * 2);
    const bf16_t* XA = (const bf16_t*)(p.ws + WS_XBC); const float* dt = (const float*)(p.ws + WS_DT); const float* acum = (const float*)(p.ws + WS_ACUM);
    bf16_t* ST = (bf16_t*)(p.ws + WS_SST);
    const int fr = c.lane & 15, fq = c.lane >> 4;
    for (int it = c.bid; it < 2048; it += c.G) {
        const int h = it & 15, bc = it >> 4, tok0 = bc * 128, g = h >> 3;
        const float aend = acum[(size_t)(tok0 + 127) * 16 + h];
        for (int i = c.tid; i < 128 * 32; i += NTHREADS) { const int lrow = i >> 5, pp = i & 31;
            const unsigned r = *(const unsigned*)(XA + (size_t)(tok0 + lrow) * 1536 + h * 64 + 2 * pp);
            const float f = dt[(size_t)(tok0 + lrow) * 16 + h] * __expf(aend - acum[(size_t)(tok0 + lrow) * 16 + h]);
            XT[(2 * pp) * 136 + lrow] = (bf16_t)f2bf(lo_bf(r) * f); XT[(2 * pp + 1) * 136 + lrow] = (bf16_t)f2bf(hi_bf(r) * f); }
        for (int i = c.tid; i < 128 * 64; i += NTHREADS) { const int lrow = i >> 6, nn = i & 63;
            const unsigned r = *(const unsigned*)(XA + (size_t)(tok0 + lrow) * 1536 + 1024 + g * 128 + 2 * nn);
            BT[(2 * nn) * 136 + lrow] = (bf16_t)(r & 0xffffu); BT[(2 * nn + 1) * 136 + lrow] = (bf16_t)(r >> 16); }
        __syncthreads();
        f32x4 acc[4];
#pragma unroll
        for (int m = 0; m < 4; ++m) acc[m] = (f32x4){0.f, 0.f, 0.f, 0.f};
#pragma unroll
        for (int ks = 0; ks < 4; ++ks) {
            const bf16x8 bfr = *(const LAS bf16x8*)(BT + (16 * c.wave + fr) * 136 + ks * 32 + 8 * fq);
#pragma unroll
            for (int m = 0; m < 4; ++m) { const bf16x8 afr = *(const LAS bf16x8*)(XT + (16 * m + fr) * 136 + ks * 32 + 8 * fq); acc[m] = MFMA16(afr, bfr, acc[m]); }
        }
#pragma unroll
        for (int m = 0; m < 4; ++m)
#pragma unroll
            for (int r = 0; r < 4; ++r) ST[(size_t)it * 8192 + (16 * m + 4 * fq + r) * 128 + 16 * c.wave + fr] = (bf16_t)f2bf(acc[m][r]);
        __syncthreads();
    }
}
__device__ __forceinline__ void phase_ssd_scan(const Params& p, const Ctx& c) {
    unsigned* ST = (unsigned*)(p.ws + WS_SST); const float* acum = (const float*)(p.ws + WS_ACUM);
    for (int i = c.bid * NTHREADS + c.tid; i < 128 * 4096; i += c.G * NTHREADS) {
        const int e2 = i & 4095, bh = i >> 12, b = bh >> 4, h = bh & 15;
        float r0 = 0.f, r1 = 0.f;
        for (int ch = 0; ch < 16; ++ch) {
            const size_t it = (size_t)((b * 16 + ch) * 16 + h);
            const unsigned loc = ST[it * 4096 + e2];
            ST[it * 4096 + e2] = pk2(r0, r1);
            const float d = __expf(acum[(size_t)(b * SEQ + ch * 128 + 127) * 16 + h]);
            r0 = d * r0 + lo_bf(loc); r1 = d * r1 + hi_bf(loc);
        }
    }
}
__device__ __forceinline__ void phase_ssd_out(const Params& p, const Ctx& c, int l) {
    LAS bf16_t* Cs = (LAS bf16_t*)c.lds;
    LAS bf16_t* Bs = (LAS bf16_t*)(c.lds + 34816);
    LAS bf16_t* CBD = (LAS bf16_t*)(c.lds + 2 * 34816);
    LAS bf16_t* XT = (LAS bf16_t*)(c.lds + 3 * 34816);
    LAS bf16_t* STs = (LAS bf16_t*)(c.lds + 3 * 34816 + 17408);
    LAS float* acs = (LAS float*)(c.lds + 3 * 34816 + 2 * 17408);
    const bf16_t* XA = (const bf16_t*)(p.ws + WS_XBC); const float* dt = (const float*)(p.ws + WS_DT); const float* acum = (const float*)(p.ws + WS_ACUM);
    const bf16_t* ST = (const bf16_t*)(p.ws + WS_SST); bf16_t* YP = (bf16_t*)(p.ws + WS_H);
    const int fr = c.lane & 15, fq = c.lane >> 4, w = c.wave;
    for (int it = c.bid; it < 2048; it += c.G) {
        const int h = it & 15, bc = it >> 4, tok0 = bc * 128, g = h >> 3;
        const float Dh = p.in[I_SD][l * 16 + h];
        for (int i = c.tid; i < 128 * 16; i += NTHREADS) { const int row = i >> 4, ck = i & 15;
            *(LAS u32x4*)(Bs + row * 136 + ck * 8) = *(const u32x4*)(XA + (size_t)(tok0 + row) * 1536 + 1024 + g * 128 + ck * 8);
            *(LAS u32x4*)(Cs + row * 136 + ck * 8) = *(const u32x4*)(XA + (size_t)(tok0 + row) * 1536 + 1280 + g * 128 + ck * 8); }
        for (int i = c.tid; i < 64 * 16; i += NTHREADS) { const int row = i >> 4, ck = i & 15;
            *(LAS u32x4*)(STs + row * 136 + ck * 8) = *(const u32x4*)(ST + (size_t)it * 8192 + row * 128 + ck * 8); }
        for (int i = c.tid; i < 128 * 32; i += NTHREADS) { const int lrow = i >> 5, pp = i & 31;
            const unsigned r = *(const unsigned*)(XA + (size_t)(tok0 + lrow) * 1536 + h * 64 + 2 * pp);
            const float f = dt[(size_t)(tok0 + lrow) * 16 + h];
            XT[(2 * pp) * 136 + lrow] = (bf16_t)f2bf(lo_bf(r) * f); XT[(2 * pp + 1) * 136 + lrow] = (bf16_t)f2bf(hi_bf(r) * f); }
        if (c.tid < 128) acs[c.tid] = acum[(size_t)(tok0 + c.tid) * 16 + h];
        __syncthreads();
        {
            f32x4 cb[8];
#pragma unroll
            for (int n = 0; n < 8; ++n) cb[n] = (f32x4){0.f, 0.f, 0.f, 0.f};
#pragma unroll
            for (int ks = 0; ks < 4; ++ks) {
                const bf16x8 afr = *(const LAS bf16x8*)(Cs + (16 * w + fr) * 136 + ks * 32 + 8 * fq);
#pragma unroll
                for (int n = 0; n < 8; ++n) { const bf16x8 bfr = *(const LAS bf16x8*)(Bs + (16 * n + fr) * 136 + ks * 32 + 8 * fq); cb[n] = MFMA16(afr, bfr, cb[n]); }
            }
#pragma unroll
            for (int n = 0; n < 8; ++n)
#pragma unroll
                for (int r = 0; r < 4; ++r) { const int lr = 16 * w + 4 * fq + r, sc = 16 * n + fr;
                    const float v = (sc <= lr) ? cb[n][r] * __expf(acs[lr] - acs[sc]) : 0.f;
                    CBD[lr * 136 + sc] = (bf16_t)f2bf(v); }
        }
        __syncthreads();
        {
            f32x4 a1[4], a2[4];
#pragma unroll
            for (int n = 0; n < 4; ++n) { a1[n] = (f32x4){0.f, 0.f, 0.f, 0.f}; a2[n] = (f32x4){0.f, 0.f, 0.f, 0.f}; }
#pragma unroll
            for (int ks = 0; ks < 4; ++ks) {
                const bf16x8 ad = *(const LAS bf16x8*)(CBD + (16 * w + fr) * 136 + ks * 32 + 8 * fq);
                const bf16x8 ac = *(const LAS bf16x8*)(Cs + (16 * w + fr) * 136 + ks * 32 + 8 * fq);
#pragma unroll
                for (int n = 0; n < 4; ++n) {
                    const bf16x8 bx = *(const LAS bf16x8*)(XT + (16 * n + fr) * 136 + ks * 32 + 8 * fq);
                    const bf16x8 bs = *(const LAS bf16x8*)(STs + (16 * n + fr) * 136 + ks * 32 + 8 * fq);
                    a1[n] = MFMA16(ad, bx, a1[n]); a2[n] = MFMA16(ac, bs, a2[n]); }
            }
#pragma unroll
            for (int n = 0; n < 4; ++n)
#pragma unroll
                for (int r = 0; r < 4; ++r) { const int lr = 16 * w + 4 * fq + r, pc = 16 * n + fr;
                    const float xs = bf2f(XA[(size_t)(tok0 + lr) * 1536 + h * 64 + pc]);
                    const float y = a1[n][r] + __expf(acs[lr]) * a2[n][r] + Dh * xs;
                    YP[(size_t)(tok0 + lr) * DM + h * 64 + pc] = (bf16_t)f2bf(y); }
        }
        __syncthreads();
    }
}
__device__ __forceinline__ void phase_ssd_gate(const Params& p, const Ctx& c, int l) {
    const bf16_t* YP = (const bf16_t*)(p.ws + WS_H); const bf16_t* U = (const bf16_t*)(p.ws + WS_U); bf16_t* YC = (bf16_t*)(p.ws + WS_YCAT);
    const float* nw = p.in[I_SNW] + (size_t)l * 1024;
    const int gw = c.bid * NWAVES + c.wave, NGW = c.G * NWAVES;
    for (int i = gw; i < NTOK * 2; i += NGW) {
        const int tok = i >> 1, g = i & 1, col = g * 512 + 8 * c.lane;
        const u32x4 yv = *(const u32x4*)(YP + (size_t)tok * DM + col), zv = *(const u32x4*)(U + (size_t)tok * NU + UZ + col);
        float v[8]; float ss = 0.f;
#pragma unroll
        for (int j = 0; j < 4; ++j) { v[2 * j] = lo_bf(yv[j]) * siluf_(lo_bf(zv[j])); v[2 * j + 1] = hi_bf(yv[j]) * siluf_(hi_bf(zv[j])); ss += v[2 * j] * v[2 * j] + v[2 * j + 1] * v[2 * j + 1]; }
        const float rstd = 1.0f / sqrtf(wave_sum(ss, c.lane) * (1.0f / 512.0f) + EPS);
        const f32x4 w0 = *(const f32x4*)(nw + col), w1 = *(const f32x4*)(nw + col + 4);
        u32x4 o; o.x = pk2(v[0] * rstd * w0[0], v[1] * rstd * w0[1]); o.y = pk2(v[2] * rstd * w0[2], v[3] * rstd * w0[3]);
        o.z = pk2(v[4] * rstd * w1[0], v[5] * rstd * w1[1]); o.w = pk2(v[6] * rstd * w1[2], v[7] * rstd * w1[3]);
        *(u32x4*)(YC + (size_t)tok * 2048 + col) = o;
    }
}

__device__ __forceinline__ void phase_hg_state(const Params& p, const Ctx& c, int l) {
    LAS float* Bf = (LAS float*)c.lds;
    LAS float* KK = (LAS float*)(c.lds + 33792);
    LAS bf16_t* KDT = (LAS bf16_t*)(c.lds + 2 * 33792);
    LAS bf16_t* VT = (LAS bf16_t*)(c.lds + 2 * 33792 + 18432);
    const bf16_t* U = (const bf16_t*)(p.ws + WS_U); const float* lb = (const float*)(p.ws + WS_LB) + l * 512;
    bf16_t* ST = (bf16_t*)(p.ws + WS_HST); float* BL = (float*)(p.ws + WS_HGBL);
    const int fr = c.lane & 15, fq = c.lane >> 4, w = c.wave;
    for (int it = c.bid; it < 1024; it += c.G) {
        const int ch = it & 31, bh = it >> 5, h = bh & 3, b = bh >> 2, tok0 = b * SEQ + ch * 64;
        for (int i = c.tid; i < 64 * 64; i += NTHREADS) { const int s = i >> 6, kp = i & 63;
            const unsigned rf = *(const unsigned*)(U + (size_t)(tok0 + s) * NU + UHF + h * 128 + 2 * kp);
            const unsigned rv = *(const unsigned*)(U + (size_t)(tok0 + s) * NU + UHV + h * 128 + 2 * kp);
            const float k0 = (1.0f - lb[h * 128 + 2 * kp]) * sigmoidf_(-lo_bf(rf)), k1 = (1.0f - lb[h * 128 + 2 * kp + 1]) * sigmoidf_(-hi_bf(rf));
            KK[s * 132 + 2 * kp] = k0; KK[s * 132 + 2 * kp + 1] = k1;
            Bf[s * 132 + 2 * kp] = log1pf(-k0); Bf[s * 132 + 2 * kp + 1] = log1pf(-k1);
            VT[(2 * kp) * 72 + s] = (bf16_t)(rv & 0xffffu); VT[(2 * kp + 1) * 72 + s] = (bf16_t)(rv >> 16); }
        __syncthreads();
        if (c.tid < 128) { float cum = 0.f; for (int s = 0; s < 64; ++s) { cum += Bf[s * 132 + c.tid]; Bf[s * 132 + c.tid] = cum; } BL[(size_t)it * 128 + c.tid] = cum; }
        __syncthreads();
        for (int i = c.tid; i < 64 * 128; i += NTHREADS) { const int s = i >> 7, k = i & 127;
            KDT[k * 72 + s] = (bf16_t)f2bf(KK[s * 132 + k] * __expf(Bf[63 * 132 + k] - Bf[s * 132 + k])); }
        __syncthreads();
        f32x4 acc[8];
#pragma unroll
        for (int n = 0; n < 8; ++n) acc[n] = (f32x4){0.f, 0.f, 0.f, 0.f};
#pragma unroll
        for (int ks = 0; ks < 2; ++ks) {
            const bf16x8 afr = *(const LAS bf16x8*)(VT + (16 * w + fr) * 72 + ks * 32 + 8 * fq);
#pragma unroll
            for (int n = 0; n < 8; ++n) { const bf16x8 bfr = *(const LAS bf16x8*)(KDT + (16 * n + fr) * 72 + ks * 32 + 8 * fq); acc[n] = MFMA16(afr, bfr, acc[n]); }
        }
#pragma unroll
        for (int n = 0; n < 8; ++n)
#pragma unroll
            for (int r = 0; r < 4; ++r) ST[(size_t)it * 16384 + (16 * w + 4 * fq + r) * 128 + 16 * n + fr] = (bf16_t)f2bf(acc[n][r]);
        __syncthreads();
    }
}
__device__ __forceinline__ void phase_hg_scan(const Params& p, const Ctx& c) {
    unsigned* ST = (unsigned*)(p.ws + WS_HST); const float* BL = (const float*)(p.ws + WS_HGBL);
    for (int i = c.bid * NTHREADS + c.tid; i < 32 * 8192; i += c.G * NTHREADS) {
        const int e2 = i & 8191, bh = i >> 13, k0 = (2 * e2) & 127;
        float r0 = 0.f, r1 = 0.f;
        for (int ch = 0; ch < 32; ++ch) {
            const size_t it = (size_t)(bh * 32 + ch);
            const unsigned loc = ST[it * 8192 + e2];
            ST[it * 8192 + e2] = pk2(r0, r1);
            const float d0 = __expf(BL[it * 128 + k0]), d1 = __expf(BL[it * 128 + k0 + 1]);
            r0 = d0 * r0 + lo_bf(loc); r1 = d1 * r1 + hi_bf(loc);
        }
    }
}
__device__ __forceinline__ void phase_hg_out(const Params& p, const Ctx& c, int l) {
    LAS bf16_t* Qs = (LAS bf16_t*)c.lds;
    LAS bf16_t* Ks = (LAS bf16_t*)(c.lds + 17408);
    LAS float* Bf = (LAS float*)(c.lds + 2 * 17408);
    LAS bf16_t* QB = (LAS bf16_t*)(c.lds + 2 * 17408 + 33792);
    LAS bf16_t* STs = (LAS bf16_t*)(c.lds + 3 * 17408 + 33792);
    LAS bf16_t* ATT = (LAS bf16_t*)(c.lds + 3 * 17408 + 33792 + 34816);
    LAS bf16_t* VT = (LAS bf16_t*)(c.lds + 3 * 17408 + 33792 + 34816 + 9216);
    const bf16_t* U = (const bf16_t*)(p.ws + WS_U); const float* lb = (const float*)(p.ws + WS_LB) + l * 512;
    const bf16_t* ST = (const bf16_t*)(p.ws + WS_HST); bf16_t* YC = (bf16_t*)(p.ws + WS_YCAT);
    const float* nw = p.in[I_HNW] + (size_t)l * 512;
    const int fr = c.lane & 15, fq = c.lane >> 4, w = c.wave;
    for (int it = c.bid; it < 1024; it += c.G) {
        const int ch = it & 31, bh = it >> 5, h = bh & 3, b = bh >> 2, tok0 = b * SEQ + ch * 64;
        for (int i = c.tid; i < 64 * 64; i += NTHREADS) { const int s = i >> 6, kp = i & 63;
            const size_t ro = (size_t)(tok0 + s) * NU + h * 128 + 2 * kp;
            const unsigned rq = *(const unsigned*)(U + ro + UHQ), rf = *(const unsigned*)(U + ro + UHF), rv = *(const unsigned*)(U + ro + UHV);
            const float k0 = (1.0f - lb[h * 128 + 2 * kp]) * sigmoidf_(-lo_bf(rf)), k1 = (1.0f - lb[h * 128 + 2 * kp + 1]) * sigmoidf_(-hi_bf(rf));
            *(LAS unsigned*)(Ks + s * 136 + 2 * kp) = pk2(k0, k1);
            *(LAS unsigned*)(Qs + s * 136 + 2 * kp) = pk2(siluf_(lo_bf(rq)), siluf_(hi_bf(rq)));
            Bf[s * 132 + 2 * kp] = log1pf(-k0); Bf[s * 132 + 2 * kp + 1] = log1pf(-k1);
            VT[(2 * kp) * 72 + s] = (bf16_t)(rv & 0xffffu); VT[(2 * kp + 1) * 72 + s] = (bf16_t)(rv >> 16); }
        for (int i = c.tid; i < 128 * 16; i += NTHREADS) { const int row = i >> 4, ck = i & 15;
            *(LAS u32x4*)(STs + row * 136 + ck * 8) = *(const u32x4*)(ST + (size_t)it * 16384 + row * 128 + ck * 8); }
        __syncthreads();
        if (c.tid < 128) { float cum = 0.f; for (int s = 0; s < 64; ++s) { cum += Bf[s * 132 + c.tid]; Bf[s * 132 + c.tid] = cum; } }
        __syncthreads();
        for (int i = c.tid; i < 64 * 64; i += NTHREADS) { const int t = i >> 6, kp = i & 63;
            const unsigned q2 = *(const LAS unsigned*)(Qs + t * 136 + 2 * kp);
            *(LAS unsigned*)(QB + t * 136 + 2 * kp) = pk2(lo_bf(q2) * __expf(Bf[t * 132 + 2 * kp]), hi_bf(q2) * __expf(Bf[t * 132 + 2 * kp + 1])); }
        for (int t = w; t < 64; t += 8) {
            const int s = c.lane; float a = 0.f;
            if (s <= t) {
                for (int k = 0; k < 128; k += 4) {
                    const f32x4 bt = *(const LAS f32x4*)(Bf + t * 132 + k), bs = *(const LAS f32x4*)(Bf + s * 132 + k);
                    const u32x2 qv = *(const LAS u32x2*)(Qs + t * 136 + k), kv = *(const LAS u32x2*)(Ks + s * 136 + k);
                    a += lo_bf(qv.x) * lo_bf(kv.x) * __expf(bt[0] - bs[0]) + hi_bf(qv.x) * hi_bf(kv.x) * __expf(bt[1] - bs[1])
                       + lo_bf(qv.y) * lo_bf(kv.y) * __expf(bt[2] - bs[2]) + hi_bf(qv.y) * hi_bf(kv.y) * __expf(bt[3] - bs[3]);
                }
            }
            ATT[t * 72 + s] = (bf16_t)f2bf(a);
        }
        __syncthreads();
        f32x4 acc[4];
#pragma unroll
        for (int m = 0; m < 4; ++m) acc[m] = (f32x4){0.f, 0.f, 0.f, 0.f};
#pragma unroll
        for (int ks = 0; ks < 4; ++ks) {
            const bf16x8 bfr = *(const LAS bf16x8*)(STs + (16 * w + fr) * 136 + ks * 32 + 8 * fq);
#pragma unroll
            for (int m = 0; m < 4; ++m) { const bf16x8 afr = *(const LAS bf16x8*)(QB + (16 * m + fr) * 136 + ks * 32 + 8 * fq); acc[m] = MFMA16(afr, bfr, acc[m]); }
        }
#pragma unroll
        for (int ks = 0; ks < 2; ++ks) {
            const bf16x8 bfr = *(const LAS bf16x8*)(VT + (16 * w + fr) * 72 + ks * 32 + 8 * fq);
#pragma unroll
            for (int m = 0; m < 4; ++m) { const bf16x8 afr = *(const LAS bf16x8*)(ATT + (16 * m + fr) * 72 + ks * 32 + 8 * fq); acc[m] = MFMA16(afr, bfr, acc[m]); }
        }
#pragma unroll
        for (int m = 0; m < 4; ++m)
#pragma unroll
            for (int r = 0; r < 4; ++r) Bf[(16 * m + 4 * fq + r) * 132 + 16 * w + fr] = acc[m][r];
        __syncthreads();
        for (int t = w * 8; t < w * 8 + 8; ++t) {
            const f32x2 o = *(const LAS f32x2*)(Bf + t * 132 + 2 * c.lane);
            const float rstd = 1.0f / sqrtf(wave_sum(o.x * o.x + o.y * o.y, c.lane) * (1.0f / 128.0f) + EPS);
            const unsigned gv = *(const unsigned*)(U + (size_t)(tok0 + t) * NU + UHG + h * 128 + 2 * c.lane);
            const f32x2 wv = *(const f32x2*)(nw + h * 128 + 2 * c.lane);
            *(unsigned*)(YC + (size_t)(tok0 + t) * 2048 + 1024 + h * 128 + 2 * c.lane) = pk2(o.x * rstd * wv.x * siluf_(lo_bf(gv)), o.y * rstd * wv.y * siluf_(hi_bf(gv)));
        }
        __syncthreads();
    }
}

__device__ __forceinline__ void phase_lru1(const Params& p, const Ctx& c, int l) {
    LAS unsigned char* wl = c.lds + c.wave * 12288;
    LAS bf16_t* XB = (LAS bf16_t*)wl;
    LAS float* As = (LAS float*)(wl + 2304);
    LAS float* Us = (LAS float*)(wl + 2304 + 4096);
    const bf16_t* U = (const bf16_t*)(p.ws + WS_U); bf16_t* LA = (bf16_t*)(p.ws + WS_LA); bf16_t* LH = (bf16_t*)(p.ws + WS_LH);
    const bf16_t* LW = (const bf16_t*)(p.ws + WS_LRUW) + (size_t)l * 2 * 8 * 4096;
    const int fr = c.lane & 15, fq = c.lane >> 4, g = c.wave, chn = g * 64 + c.lane;
    const float cw0 = p.in[I_LCW][(size_t)l * 2048 + chn], cw1 = p.in[I_LCW][(size_t)l * 2048 + 512 + chn], cw2 = p.in[I_LCW][(size_t)l * 2048 + 1024 + chn], cw3 = p.in[I_LCW][(size_t)l * 2048 + 1536 + chn];
    const float cbias = p.in[I_LCB][l * 512 + chn];
    bf16x8 wfa[4][2], wfx[4][2];
#pragma unroll
    for (int n = 0; n < 4; ++n)
#pragma unroll
        for (int ks = 0; ks < 2; ++ks) { wfa[n][ks] = *(const bf16x8*)(LW + (size_t)(0 * 8 + g) * 4096 + (16 * n + fr) * 64 + ks * 32 + 8 * fq);
                                         wfx[n][ks] = *(const bf16x8*)(LW + (size_t)(1 * 8 + g) * 4096 + (16 * n + fr) * 64 + ks * 32 + 8 * fq); }
    float bav[4], bxv[4], spl[4];
#pragma unroll
    for (int n = 0; n < 4; ++n) { const int j = g * 64 + 16 * n + fr; bav[n] = p.in[I_LBA][l * 512 + j]; bxv[n] = p.in[I_LBX][l * 512 + j]; spl[n] = softplusf_(-p.in[I_LLAM][l * 512 + j]); }
    for (int it = c.bid; it < 128; it += c.G) {
        const int seg = it & 15, tok0 = (it >> 4) * SEQ + seg * 128;
        float x0 = 0.f, x1 = 0.f, x2 = 0.f;
        if (seg > 0) { x0 = bf2f(U[(size_t)(tok0 - 3) * NU + ULX + chn]); x1 = bf2f(U[(size_t)(tok0 - 2) * NU + ULX + chn]); x2 = bf2f(U[(size_t)(tok0 - 1) * NU + ULX + chn]); }
        float hrun = 0.f, arun = 1.f;
        for (int st = 0; st < 8; ++st) {
            const int t0 = tok0 + st * 16;
#pragma unroll
            for (int tt = 0; tt < 16; ++tt) { const float xr = bf2f(U[(size_t)(t0 + tt) * NU + ULX + chn]);
                const float xb = cbias + cw0 * x0 + cw1 * x1 + cw2 * x2 + cw3 * xr; x0 = x1; x1 = x2; x2 = xr;
                XB[tt * 72 + c.lane] = (bf16_t)f2bf(xb); }
            LDS_WAIT();
            f32x4 ar[4], ai[4];
#pragma unroll
            for (int n = 0; n < 4; ++n) { ar[n] = (f32x4){0.f, 0.f, 0.f, 0.f}; ai[n] = (f32x4){0.f, 0.f, 0.f, 0.f}; }
#pragma unroll
            for (int ks = 0; ks < 2; ++ks) { const bf16x8 afr = *(const LAS bf16x8*)(XB + fr * 72 + ks * 32 + 8 * fq);
#pragma unroll
                for (int n = 0; n < 4; ++n) { ar[n] = MFMA16(afr, wfa[n][ks], ar[n]); ai[n] = MFMA16(afr, wfx[n][ks], ai[n]); } }
#pragma unroll
            for (int n = 0; n < 4; ++n)
#pragma unroll
                for (int r = 0; r < 4; ++r) { const int t = 4 * fq + r, j = 16 * n + fr;
                    const float rg = sigmoidf_(ar[n][r] + bav[n]), ig = sigmoidf_(ai[n][r] + bxv[n]);
                    const float la = -8.0f * rg * spl[n], a = __expf(la), mult = sqrtf(-expm1f(2.0f * la));
                    As[t * 64 + j] = a; Us[t * 64 + j] = mult * ig * bf2f(XB[t * 72 + j]); }
            LDS_WAIT();
#pragma unroll
            for (int tt = 0; tt < 16; ++tt) { const float a = As[tt * 64 + c.lane], uu = Us[tt * 64 + c.lane];
                hrun = a * hrun + uu; arun = a * arun;
                LA[(size_t)(t0 + tt) * 512 + chn] = (bf16_t)f2bf(arun); LH[(size_t)(t0 + tt) * 512 + chn] = (bf16_t)f2bf(hrun); }
            LDS_WAIT();
        }
    }
}
__device__ __forceinline__ void phase_lru2(const Params& p, const Ctx& c, int l) {
    LAS float* YS = (LAS float*)c.lds;
    LAS float* PART = (LAS float*)(c.lds + 65536);
    const bf16_t* U = (const bf16_t*)(p.ws + WS_U); const bf16_t* LA = (const bf16_t*)(p.ws + WS_LA); const bf16_t* LH = (const bf16_t*)(p.ws + WS_LH);
    bf16_t* YC = (bf16_t*)(p.ws + WS_YCAT);
    const int g = c.wave, chn = g * 64 + c.lane;
    const float nwv = p.in[I_LNW][l * 512 + chn];
    for (int it = c.bid; it < 128; it += c.G) {
        const int seg = it & 15, b = it >> 4, tok0 = b * SEQ + seg * 128;
        float hin = 0.f;
        for (int s2 = 0; s2 < seg; ++s2) { const size_t row = (size_t)(b * SEQ + s2 * 128 + 127); hin = bf2f(LH[row * 512 + chn]) + bf2f(LA[row * 512 + chn]) * hin; }
        for (int sb = 0; sb < 4; ++sb) {
#pragma unroll 4
            for (int tt = 0; tt < 32; ++tt) { const size_t tok = (size_t)(tok0 + sb * 32 + tt);
                const float hh = bf2f(LH[tok * 512 + chn]) + bf2f(LA[tok * 512 + chn]) * hin;
                const float y = hh * gelu_tanhf_(bf2f(U[tok * NU + ULG + chn]));
                YS[tt * 512 + chn] = y;
                const float ss = wave_sum(y * y, c.lane);
                if (c.lane == 0) PART[tt * 8 + g] = ss; }
            __syncthreads();
#pragma unroll 4
            for (int tt = 0; tt < 32; ++tt) { const f32x4 p0 = *(const LAS f32x4*)(PART + tt * 8), p1 = *(const LAS f32x4*)(PART + tt * 8 + 4);
                const float tot = ((p0[0] + p0[1]) + (p0[2] + p0[3])) + ((p1[0] + p1[1]) + (p1[2] + p1[3]));
                const float rstd = 1.0f / sqrtf(tot * (1.0f / 512.0f) + EPS);
                YC[(size_t)(tok0 + sb * 32 + tt) * 2048 + 1536 + chn] = (bf16_t)f2bf(YS[tt * 512 + chn] * rstd * nwv); }
            __syncthreads();
        }
    }
}

__device__ __forceinline__ void phase_norm_router(const Params& p, const Ctx& c, int l, const float* xin) {
    LAS float* HS = (LAS float*)(c.lds + c.wave * 16384);
    const float* mod = (const float*)(p.ws + WS_MOD) + (size_t)l * 8 * NMOD;
    const float* nw = p.in[I_NFFN] + (size_t)l * DM;
    const float* RWt = p.in[I_RW] + (size_t)l * DM * NEXP;
    const float rbias = p.in[I_RB][l * NEXP + c.lane];
    bf16_t* H = (bf16_t*)(p.ws + WS_H);
    unsigned long long* selm = (unsigned long long*)(p.ws + WS_SELM); float* rw = (float*)(p.ws + WS_RW);
    const int gw = c.bid * NWAVES + c.wave, NGW = c.G * NWAVES;
    for (int t4 = gw; t4 < NTOK / 4; t4 += NGW) {
        const int tokb = t4 * 4, b = tokb >> 11;
#pragma unroll
        for (int q = 0; q < 4; ++q) {
            const int tok = tokb + q;
            const f32x4* xr = (const f32x4*)(xin + (size_t)tok * DM) + c.lane;
            f32x4 v[4]; float ss = 0.f;
#pragma unroll
            for (int j = 0; j < 4; ++j) { v[j] = xr[64 * j]; ss += (v[j][0] * v[j][0] + v[j][1] * v[j][1]) + (v[j][2] * v[j][2] + v[j][3] * v[j][3]); }
            const float rstd = 1.0f / sqrtf(wave_sum(ss, c.lane) * (1.0f / DM) + EPS);
#pragma unroll
            for (int j = 0; j < 4; ++j) {
                const int col = 256 * j + 4 * c.lane;
                const f32x4 w4 = *(const f32x4*)(nw + col), sh = *(const f32x4*)(mod + (size_t)b * NMOD + 3072 + col), sc = *(const f32x4*)(mod + (size_t)b * NMOD + 4096 + col);
                const f32x4 h = (v[j] * rstd * w4) * (sc + 1.0f) + sh;
                u32x2 o; o.x = pk2(h[0], h[1]); o.y = pk2(h[2], h[3]);
                *(u32x2*)(H + (size_t)tok * DM + col) = o;
                *(LAS f32x4*)(HS + q * 1024 + col) = h;
            }
        }
        LDS_WAIT();
        float lg[4] = {0.f, 0.f, 0.f, 0.f};
        for (int k = 0; k < 1024; k += 4) {
            const float w0 = RWt[(size_t)(k + 0) * NEXP + c.lane], w1 = RWt[(size_t)(k + 1) * NEXP + c.lane], w2 = RWt[(size_t)(k + 2) * NEXP + c.lane], w3 = RWt[(size_t)(k + 3) * NEXP + c.lane];
#pragma unroll
            for (int q = 0; q < 4; ++q) { const f32x4 hv = *(const LAS f32x4*)(HS + q * 1024 + k); lg[q] += (hv[0] * w0 + hv[1] * w1) + (hv[2] * w2 + hv[3] * w3); }
        }
#pragma unroll
        for (int q = 0; q < 4; ++q) {
            const int tok = tokb + q;
            const float s = sigmoidf_(lg[q]), v = s + rbias;
            float m1 = v;
            m1 = fmaxf(m1, shfl_xor_l(m1, 1, c.lane)); m1 = fmaxf(m1, shfl_xor_l(m1, 2, c.lane)); m1 = fmaxf(m1, shfl_xor_l(m1, 4, c.lane));
            const unsigned long long eq = __ballot(v == m1);
            const int gbase = c.lane & ~7;
            const unsigned gm = (unsigned)((eq >> gbase) & 0xffull);
            const int first = gbase + __builtin_ctz(gm);
            float m2 = (c.lane == first) ? -3.0e38f : v;
            m2 = fmaxf(m2, shfl_xor_l(m2, 1, c.lane)); m2 = fmaxf(m2, shfl_xor_l(m2, 2, c.lane)); m2 = fmaxf(m2, shfl_xor_l(m2, 4, c.lane));
            const float gs = m1 + m2;
            const int mygrp = c.lane >> 3; int grank = 0;
#pragma unroll
            for (int g2 = 0; g2 < 8; ++g2) { const float o = rdlane_f(gs, g2 * 8); grank += (o > gs || (o == gs && g2 < mygrp)) ? 1 : 0; }
            const float vm = (grank < 4) ? v : -1.0e4f;
            int erank = 0;
            for (int e2 = 0; e2 < 64; ++e2) { const float o = rdlane_f(vm, e2); erank += (o > vm || (o == vm && e2 < c.lane)) ? 1 : 0; }
            const bool sel = erank < TOPK;
            const unsigned long long mask = __ballot(sel);
            const float wsum = wave_sum(sel ? s : 0.f, c.lane);
            if (sel) { const int kk = __builtin_popcountll(mask & ((1ull << c.lane) - 1ull)); rw[(size_t)tok * 8 + kk] = s / wsum * 2.5f; }
            if (c.lane == 0) selm[tok] = mask;
        }
        LDS_WAIT();
    }
}
__device__ __forceinline__ void phase_route_count(const Params& p, const Ctx& c) {
    const unsigned long long* selm = (const unsigned long long*)(p.ws + WS_SELM); int* cnt = (int*)(p.ws + WS_CNT);
    const int gw = c.bid * NWAVES + c.wave, NGW = c.G * NWAVES;
    for (int ch = gw; ch < 256; ch += NGW) {
        const unsigned long long mine = selm[ch * 64 + c.lane]; int n = 0;
        for (int i = 0; i < 64; ++i) { const unsigned long long m = rdlane_u64(mine, i); n += (int)((m >> c.lane) & 1ull); }
        cnt[ch * 64 + c.lane] = n;
    }
}
__device__ __forceinline__ void phase_route_assign(const Params& p, const Ctx& c) {
    const unsigned long long* selm = (const unsigned long long*)(p.ws + WS_SELM); const int* cnt = (const int*)(p.ws + WS_CNT);
    int* slot_tok = (int*)(p.ws + WS_SLOTTOK); int* slot_of = (int*)(p.ws + WS_SLOTOF); int* rinfo = (int*)(p.ws + WS_RINFO);
    const int gw = c.bid * NWAVES + c.wave, NGW = c.G * NWAVES;
    for (int ch = gw; ch < 256; ch += NGW) {
        int total = 0, before = 0;
        for (int j = 0; j < 256; ++j) { const int v = cnt[j * 64 + c.lane]; total += v; before += (j < ch) ? v : 0; }
        const int pad = (total + 255) & ~255;
        int incl = pad;
#pragma unroll
        for (int o = 1; o < 64; o <<= 1) { const int t = shfl_up_l(incl, o, c.lane); if (c.lane >= o) incl += t; }
        const int pstart = incl - pad;
        int run = pstart + before;
        const unsigned long long mine = selm[ch * 64 + c.lane];
        for (int i = 0; i < 64; ++i) {
            const unsigned long long m = rdlane_u64(mine, i); const int tok = ch * 64 + i;
            if ((m >> c.lane) & 1ull) { const int kk = __builtin_popcountll(m & ((1ull << c.lane) - 1ull)); slot_tok[run] = tok; slot_of[tok * 8 + kk] = run; ++run; }
        }
        if (ch == 0) {
            for (int s = pstart + total; s < pstart + pad; ++s) slot_tok[s] = -1;
            for (int bk = pstart >> 8; bk < (pstart + pad) >> 8; ++bk) rinfo[64 + bk] = c.lane;
            if (c.lane == 63) rinfo[0] = incl >> 8;
        }
    }
}
__device__ __forceinline__ void phase_combine(const Params& p, const Ctx& c, int l) {
    const float* gate = (const float*)(p.ws + WS_MOD) + (size_t)l * 8 * NMOD + 5120;
    const bf16_t* Y = (const bf16_t*)(p.ws + WS_Y); const bf16_t* YS = (const bf16_t*)(p.ws + WS_H); const int* slot_of = (const int*)(p.ws + WS_SLOTOF); const float* rw = (const float*)(p.ws + WS_RW);
    const float* fw = p.in[I_FNW];
    const int gw = c.bid * NWAVES + c.wave, NGW = c.G * NWAVES;
    for (int tok = gw; tok < NTOK; tok += NGW) {
        const int b = tok >> 11;
        f32x4 acc[4];
#pragma unroll
        for (int j = 0; j < 4; ++j) acc[j] = (f32x4){0.f, 0.f, 0.f, 0.f};
#pragma unroll
        for (int k = 0; k < 8; ++k) { const int sl = slot_of[tok * 8 + k]; const float wk = rw[tok * 8 + k];
#pragma unroll
            for (int j = 0; j < 4; ++j) { const u32x2 yv = *(const u32x2*)(Y + (size_t)sl * DM + 256 * j + 4 * c.lane);
                acc[j][0] += wk * lo_bf(yv.x); acc[j][1] += wk * hi_bf(yv.x); acc[j][2] += wk * lo_bf(yv.y); acc[j][3] += wk * hi_bf(yv.y); } }
#pragma unroll
        for (int j = 0; j < 4; ++j) { const u32x2 yv = *(const u32x2*)(YS + (size_t)tok * DM + 256 * j + 4 * c.lane);
            acc[j][0] += lo_bf(yv.x); acc[j][1] += hi_bf(yv.x); acc[j][2] += lo_bf(yv.y); acc[j][3] += hi_bf(yv.y); }
        f32x4* xr = (f32x4*)(p.out + (size_t)tok * DM) + c.lane;
        f32x4 v[4]; float ss = 0.f;
#pragma unroll
        for (int j = 0; j < 4; ++j) { const f32x4 gv = *(const f32x4*)(gate + (size_t)b * NMOD + 256 * j + 4 * c.lane); v[j] = xr[64 * j] + gv * acc[j];
            ss += (v[j][0] * v[j][0] + v[j][1] * v[j][1]) + (v[j][2] * v[j][2] + v[j][3] * v[j][3]); }
        if (l == NLAYER - 1) {
            const float rstd = 1.0f / sqrtf(wave_sum(ss, c.lane) * (1.0f / DM) + EPS);
#pragma unroll
            for (int j = 0; j < 4; ++j) { const f32x4 w4 = *(const f32x4*)(fw + 256 * j + 4 * c.lane); xr[64 * j] = v[j] * rstd * w4; }
        } else {
#pragma unroll
            for (int j = 0; j < 4; ++j) xr[64 * j] = v[j];
        }
    }
}

constexpr int NQ_PHASE = 14;
__device__ __forceinline__ unsigned long long uni64(unsigned long long v) {
    const unsigned lo = (unsigned)__builtin_amdgcn_readfirstlane((int)(unsigned)v), hi = (unsigned)__builtin_amdgcn_readfirstlane((int)(unsigned)(v >> 32)); return ((unsigned long long)hi << 32) | lo; }
#if MK_MEGA
__device__ __forceinline__ void params_to_lds(const Params& p, LAS unsigned char* lds) {
    LAS unsigned long long* tab = (LAS unsigned long long*)(lds + LDS_PTAB);
#pragma unroll
    for (int i = 0; i < 33; ++i) tab[i] = (unsigned long long)p.in[i];
    tab[33] = (unsigned long long)p.out; tab[34] = (unsigned long long)p.ws;
}
__device__ __forceinline__ Params params_from_lds(LAS unsigned char* lds) {
    const LAS unsigned long long* tab = (const LAS unsigned long long*)(lds + LDS_PTAB);
    Params p;
#pragma unroll
    for (int i = 0; i < 33; ++i) p.in[i] = (const float*)(const __attribute__((address_space(1))) float*)uni64(tab[i]);
    p.out = (float*)(__attribute__((address_space(1))) float*)uni64(tab[33]); p.ws = (unsigned char*)(__attribute__((address_space(1))) unsigned char*)uni64(tab[34]); p.layer = 0; p.pad = 0;
    return p;
}
#endif
template <int Q> __device__ __forceinline__ void run_q(const Params& p_in, const Ctx& c_in, int l) {
    Ctx c = c_in;
    asm volatile("" : "+s"(c.wave), "+s"(c.bid), "+s"(c.G), "+s"(l));
    c.lane = fresh_lane(); c.tid = c.wave * 64 + c.lane;
#if MK_MEGA
    const Params p = params_from_lds(c.lds);
#else
    const Params& p = p_in;
#endif
    const float* xin = (l == 0) ? p.in[I_X] : p.out;
    if constexpr (Q == 14) { phase_prep_io(p, c); __syncthreads(); phase_prep_small(p, c); __syncthreads(); phase_prep_experts(p, c, 0); }
    if constexpr (Q == 0) { if (l > 0) { phase_prep_experts(p, c, l); __syncthreads(); } phase_norm_mix(p, c, l, xin); }
    if constexpr (Q == 1) { pg8::Gemm g{(const bf16_t*)(p.ws + WS_H), (const bf16_t*)(p.ws + WS_WIN) + (size_t)l * NU * DM, DM, 0};
              pg8::DenseOrder S; S.init(NTOK, NU, c.G, c.bid); EpiU E{(bf16_t*)(p.ws + WS_U), NU};
              pg8::gemm_phase<EpiU, pg8::DenseOrder, pg8::DenseRows, true, true>(c.lds, g, S, E, pg8::DenseRows(), c.wave); }
    if constexpr (Q == 2) { phase_ssd_conv(p, c, l); __syncthreads(); phase_hg_state(p, c, l); __syncthreads(); phase_lru1(p, c, l); }
    if constexpr (Q == 3) { phase_ssd_state(p, c); __syncthreads(); phase_hg_scan(p, c); __syncthreads(); phase_lru2(p, c, l); }
    if constexpr (Q == 4) { phase_ssd_scan(p, c); __syncthreads(); phase_hg_out(p, c, l); }
    if constexpr (Q == 5) phase_ssd_out(p, c, l);
    if constexpr (Q == 6) phase_ssd_gate(p, c, l);
    if constexpr (Q == 7) { pg8::Gemm g{(const bf16_t*)(p.ws + WS_YCAT), (const bf16_t*)(p.ws + WS_WOUT) + (size_t)l * DM * 2048, 2048, 0};
              pg8::DenseOrder S; S.init(NTOK, DM, c.G, c.bid); EpiOut E{xin, p.out, (const float*)(p.ws + WS_MOD) + (size_t)l * 8 * NMOD + 2048};
              pg8::gemm_phase<EpiOut, pg8::DenseOrder, pg8::DenseRows, false, true>(c.lds, g, S, E, pg8::DenseRows(), c.wave); }
    if constexpr (Q == 8) phase_norm_router(p, c, l, p.out);
    if constexpr (Q == 9) phase_route_count(p, c);
    if constexpr (Q == 10) phase_route_assign(p, c);
    if constexpr (Q == 11) { pg8::Gemm g{(const bf16_t*)(p.ws + WS_H), (const bf16_t*)(p.ws + WS_GU), DM, (size_t)512 * DM * 2};
               MoeOrder S{(const int*)(p.ws + WS_RINFO), 2, c.G, c.bid}; EpiH E{(bf16_t*)(p.ws + WS_HMID)};
               GatherRows AM{(const int*)(p.ws + WS_SLOTTOK), (const int*)(p.ws + WS_RINFO)};
               pg8::gemm_phase<EpiH, MoeOrder, GatherRows, true, true>(c.lds, g, S, E, AM, c.wave); }
    if constexpr (Q == 12) { pg8::Gemm g{(const bf16_t*)(p.ws + WS_HMID), (const bf16_t*)(p.ws + WS_DN), 256, (size_t)DM * 256 * 2};
               MoeOrder S{(const int*)(p.ws + WS_RINFO), 4, c.G, c.bid};
               EpiY E{(bf16_t*)(p.ws + WS_Y), (bf16_t*)(p.ws + WS_H), (const int*)(p.ws + WS_RINFO)};
               pg8::gemm_phase<EpiY, MoeOrder, pg8::DenseRows, true, true>(c.lds, g, S, E, pg8::DenseRows(), c.wave); }
    if constexpr (Q == 13) phase_combine(p, c, l);
}

#if MK_MEGA
__global__ void __launch_bounds__(NTHREADS, 2) trunk_kernel(Params p) {
    extern __shared__ __attribute__((aligned(16))) unsigned char lds_raw[];
    Ctx c; c.lds = (LAS unsigned char*)lds_raw; c.tid = 0; c.lane = 0; c.wave = __builtin_amdgcn_readfirstlane(threadIdx.x >> 6); c.G = gridDim.x; c.bid = blockIdx.x;
    cg::grid_group grid = cg::this_grid();
#define GSYNC() do { __syncthreads(); grid.sync(); } while (0)
    if (threadIdx.x == 0) params_to_lds(p, c.lds);
    __syncthreads();
#define LAYER(l) do { \
        run_q<0>(p, c, l); GSYNC(); run_q<1>(p, c, l); GSYNC(); run_q<2>(p, c, l); GSYNC(); run_q<3>(p, c, l); GSYNC(); run_q<4>(p, c, l); GSYNC(); \
        run_q<5>(p, c, l); GSYNC(); run_q<6>(p, c, l); GSYNC(); run_q<7>(p, c, l); GSYNC(); run_q<8>(p, c, l); GSYNC(); run_q<9>(p, c, l); GSYNC(); \
        run_q<10>(p, c, l); GSYNC(); run_q<11>(p, c, l); GSYNC(); run_q<12>(p, c, l); GSYNC(); run_q<13>(p, c, l); } while (0)
    run_q<14>(p, c, 0); GSYNC();
    LAYER(0); GSYNC();
    LAYER(1);
}
#else
template <int Q> __global__ void __launch_bounds__(NTHREADS, 2) phase_kernel(Params p) {
    extern __shared__ __attribute__((aligned(16))) unsigned char lds_raw[];
    Ctx c; c.lds = (LAS unsigned char*)lds_raw; c.tid = 0; c.lane = 0; c.wave = __builtin_amdgcn_readfirstlane(threadIdx.x >> 6); c.G = gridDim.x; c.bid = blockIdx.x;
    run_q<Q>(p, c, p.layer);
}
template <int Q> static void launch_q(const Params& p, int grid, hipStream_t stream) {
    static bool attr = false;
    if (!attr) { (void)hipFuncSetAttribute((const void*)phase_kernel<Q>, hipFuncAttributeMaxDynamicSharedMemorySize, LDS_BYTES); attr = true; }
    hipLaunchKernelGGL(phase_kernel<Q>, dim3(grid), dim3(NTHREADS), LDS_BYTES, stream, p);
}
#endif

extern "C" void kernel_launch(void* const* d_in, const int* in_sizes, int n_in, void* d_out, int out_size, void* d_ws, size_t ws_size, hipStream_t stream) {
    static int grid = 0;
    if (grid == 0) {
        if (n_in != 33 || out_size != NTOK * DM || ws_size < WS_END) { fprintf(stderr, "kernel_launch: unexpected shapes (n_in %d out %d ws %zu)\n", n_in, out_size, ws_size); grid = -1; return; }
        int dev = 0, cus = 0;
        (void)hipGetDevice(&dev); (void)hipDeviceGetAttribute(&cus, hipDeviceAttributeMultiprocessorCount, dev);
        grid = cus > 0 ? cus : 256;
#if MK_MEGA
        int per_cu = 0;
        if (hipFuncSetAttribute((const void*)trunk_kernel, hipFuncAttributeMaxDynamicSharedMemorySize, LDS_BYTES) != hipSuccess) { fprintf(stderr, "kernel_launch: hipFuncSetAttribute failed\n"); grid = -1; return; }
        if (hipOccupancyMaxActiveBlocksPerMultiprocessor(&per_cu, (const void*)trunk_kernel, NTHREADS, LDS_BYTES) != hipSuccess || per_cu < 1) { fprintf(stderr, "kernel_launch: occupancy query says %d blocks/CU\n", per_cu); grid = -1; return; }
        (void)hipGetLastError();
#endif
    }
    if (grid < 0) return;
    (void)hipMemsetAsync((char*)d_ws + WS_CTL, 0, CTL_ZERO_BYTES, stream);
    Params p{};
    for (int i = 0; i < 33; ++i) p.in[i] = (const float*)d_in[i];
    p.out = (float*)d_out; p.ws = (unsigned char*)d_ws;
#if MK_MEGA
    void* args[] = {&p};
    hipError_t e = hipLaunchCooperativeKernel((const void*)trunk_kernel, dim3(grid), dim3(NTHREADS), args, LDS_BYTES, stream);
    if (e != hipSuccess) fprintf(stderr, "cooperative launch failed: %s (grid %d)\n", hipGetErrorString(e), grid);
#else
    p.layer = 0; launch_q<14>(p, grid, stream);
    for (int l = 0; l < NLAYER; ++l) {
        p.layer = l;
        launch_q<0>(p, grid, stream); launch_q<1>(p, grid, stream); launch_q<2>(p, grid, stream); launch_q<3>(p, grid, stream); launch_q<4>(p, grid, stream);
        launch_q<5>(p, grid, stream); launch_q<6>(p, grid, stream); launch_q<7>(p, grid, stream); launch_q<8>(p, grid, stream); launch_q<9>(p, grid, stream);
        launch_q<10>(p, grid, stream); launch_q<11>(p, grid, stream); launch_q<12>(p, grid, stream); launch_q<13>(p, grid, stream);
    }
#endif
}
```

```cpp
#include <hip/hip_runtime.h>
#include <hip/hip_cooperative_groups.h>
#include <cstdio>
#include <cstdint>
namespace cg = cooperative_groups;

#ifndef MK_MEGA
#define MK_MEGA 1
#endif

#define LAS __attribute__((address_space(3)))
typedef unsigned short bf16_t;
typedef short bf16x8 __attribute__((ext_vector_type(8)));
typedef float f32x4 __attribute__((ext_vector_type(4)));
typedef float f32x2 __attribute__((ext_vector_type(2)));
typedef unsigned u32x4 __attribute__((ext_vector_type(4)));
typedef unsigned u32x2 __attribute__((ext_vector_type(2)));

constexpr int NTOK = 16384, DM = 1024, SEQ = 2048, NBATCH = 8, NLAYER = 2;
constexpr int DIN = 5648, NU = 5632;
constexpr int UZ = 0, UXS = 1024, UB = 2048, UC = 2304, UHQ = 2560, UHF = 3072, UHV = 3584, UHG = 4096, ULG = 4608, ULX = 5120;
constexpr int NMOD = 6144;
constexpr float EPS = 1e-6f;
constexpr int NEXP = 64, TOPK = 8;
constexpr int MAXSLOT = 147456;
constexpr int NTHREADS = 512, NWAVES = 8;
constexpr int LDS_BYTES = 160 * 1024;
constexpr int LDS_PTAB = LDS_BYTES - 512;

constexpr size_t MiB = (size_t)1 << 20;
constexpr size_t WS_CTL = 0, CTL_ZERO_BYTES = 1 * MiB;
constexpr size_t WS_MOD = 1 * MiB;
constexpr size_t WS_LB = WS_MOD + 512 * 1024;
constexpr size_t WS_LRUW = WS_LB + 8192;
constexpr size_t WS_DTRAW = 2 * MiB, WS_DT = 3 * MiB, WS_ACUM = 4 * MiB;
constexpr size_t WS_HGBL = 5 * MiB;
constexpr size_t WS_SELM = 5 * MiB + 512 * 1024;
constexpr size_t WS_RW = 6 * MiB;
constexpr size_t WS_SLOTOF = 6 * MiB + 512 * 1024;
constexpr size_t WS_SLOTTOK = 7 * MiB;
constexpr size_t WS_RINFO = 7 * MiB + 768 * 1024;
constexpr size_t WS_CNT = 8 * MiB;
constexpr size_t WS_WIN = 12 * MiB;
constexpr size_t WS_WOUT = 34 * MiB;
constexpr size_t WS_GU = 42 * MiB;
constexpr size_t WS_DN = 107 * MiB;
constexpr size_t WS_H = 140 * MiB;
constexpr size_t WS_U = 172 * MiB;
constexpr size_t WS_SST = 348 * MiB;
constexpr size_t WS_HST = 380 * MiB;
constexpr size_t WS_LA = 412 * MiB, WS_LH = 428 * MiB;
constexpr size_t WS_XBC = 444 * MiB;
constexpr size_t WS_YCAT = 492 * MiB;
constexpr size_t WS_HMID = 172 * MiB;
constexpr size_t WS_Y = 252 * MiB;
constexpr size_t WS_END = 556 * MiB;

__device__ __forceinline__ float bf2f(bf16_t b) { return __uint_as_float(((unsigned)b) << 16); }
__device__ __forceinline__ unsigned f2bf(float f) { unsigned u = __float_as_uint(f); return (u + 0x7fffu + ((u >> 16) & 1u)) >> 16; }
__device__ __forceinline__ unsigned pk2(float lo, float hi) { return f2bf(lo) | (f2bf(hi) << 16); }
__device__ __forceinline__ float lo_bf(unsigned w) { return __uint_as_float(w << 16); }
__device__ __forceinline__ float hi_bf(unsigned w) { return __uint_as_float(w & 0xffff0000u); }
__device__ __forceinline__ float sigmoidf_(float x) { return 1.0f / (1.0f + __expf(-x)); }
__device__ __forceinline__ float siluf_(float x) { return x / (1.0f + __expf(-x)); }
__device__ __forceinline__ float softplusf_(float x) { return fmaxf(x, 0.f) + log1pf(__expf(-fabsf(x))); }
__device__ __forceinline__ float gelu_tanhf_(float x) { const float t = tanhf(0.7978845608028654f * (x + 0.044715f * x * x * x)); return 0.5f * x * (1.0f + t); }
__device__ __forceinline__ float shfl_xor_l(float v, int mask, int lane) { return __builtin_bit_cast(float, __builtin_amdgcn_ds_bpermute((lane ^ mask) << 2, __builtin_bit_cast(int, v))); }
__device__ __forceinline__ int shfl_up_l(int v, int d, int lane) { return __builtin_amdgcn_ds_bpermute((lane - d) << 2, v); }
__device__ __forceinline__ float shfl_up_f(float v, int d, int lane) { return __builtin_bit_cast(float, __builtin_amdgcn_ds_bpermute((lane - d) << 2, __builtin_bit_cast(int, v))); }
__device__ __forceinline__ float rdlane_f(float v, int src) { return __builtin_bit_cast(float, __builtin_amdgcn_readlane(__builtin_bit_cast(int, v), src)); }
__device__ __forceinline__ unsigned long long rdlane_u64(unsigned long long v, int src) {
    const unsigned lo = (unsigned)__builtin_amdgcn_readlane((int)(unsigned)v, src), hi = (unsigned)__builtin_amdgcn_readlane((int)(unsigned)(v >> 32), src); return ((unsigned long long)hi << 32) | lo; }
__device__ __forceinline__ float wave_sum(float v, int lane) {
#pragma unroll
    for (int o = 1; o < 64; o <<= 1) v += shfl_xor_l(v, o, lane);
    return v;
}
#define LDS_WAIT() asm volatile("s_waitcnt lgkmcnt(0)" ::: "memory")
__device__ __forceinline__ int fresh_lane() { unsigned ones = ~0u; asm volatile("" : "+s"(ones)); return (int)__builtin_amdgcn_mbcnt_hi(ones, __builtin_amdgcn_mbcnt_lo(ones, 0u)); }
#define MFMA16(a, b, c) __builtin_amdgcn_mfma_f32_16x16x32_bf16((a), (b), (c), 0, 0, 0)

namespace pg8 {
constexpr int BM = 256, BK = 64, HALF = 128, HTB = HALF * BK * 2, STAGE_BYTES = 8 * HTB, NXCD = 8, WGM = 8;
__device__ __forceinline__ int lds_byte(int r, int c) { const int st = (r >> 4) * 2 + (c >> 5), rr = r & 15, cc = c & 31, ob = rr * 64 + cc * 2; return st * 1024 + (ob ^ (((ob >> 9) & 1) << 5)); }
__device__ __forceinline__ void stage_rc(int b, int& R, int& C) { const int st = b / 1024, sb = b % 1024, swz = sb ^ (((sb >> 9) & 1) << 5); R = (st >> 1) * 16 + swz / 64; C = (st & 1) * 32 + (swz % 64) / 2; }
__device__ __forceinline__ int perm32(int rho) { const int n = rho >> 4, i = rho & 15; return 8 * (i >> 2) + 4 * n + (i & 3); }

struct Unit { int pm, pn, e; };
struct Gemm { const bf16_t* A; const bf16_t* Bt; int K; size_t estride; };

struct DenseOrder {
    int nM, nN, nwg, G, c;
    __device__ void init(int M, int N, int G_, int c_) { nM = M / BM; nN = N / BM; nwg = nM * nN; G = G_; c = c_; }
    __device__ bool next(int i, Unit& u) const {
        const long L = (long)i * G + c; if (L >= nwg) return false;
        int wgid = (int)L; { const int q = nwg / NXCD, r = nwg % NXCD, xcd = wgid % NXCD, off = wgid / NXCD; wgid = (xcd < r ? xcd * (q + 1) : r * (q + 1) + (xcd - r) * q) + off; }
        const int nig = WGM * nN, gid = wgid / nig, fm = gid * WGM, gsz = (nM - fm) < WGM ? (nM - fm) : WGM;
        u.pm = fm + ((wgid % nig) % gsz); u.pn = (wgid % nig) / gsz; u.e = 0; return true;
    }
};
struct DenseRows { __device__ __forceinline__ int row(const Unit& u, int r) const { return u.pm * BM + r; } };

template <class Epi, class Sched, class AMap, bool ALIGN_EPI, bool SP2>
__device__ __forceinline__ void gemm_phase(LAS unsigned char* lds, const Gemm g, const Sched& S, const Epi& E, const AMap& AM, int wave_id) {
    const int wid = wave_id, lane = fresh_lane(), tid = wid * 64 + lane, wr = wid >> 2, wc = wid & 3, fr = lane & 15, fq = lane >> 4;
    const int K = g.K, nt = K / BK;
    unsigned voffB0;
    { int R, C; stage_rc(tid * 16, R, C); const int Rb = Epi::PERM ? ((R & ~31) + perm32(R & 31)) : R; voffB0 = (unsigned)(Rb * K + C) * 2u; }
    const size_t p1step = (size_t)64 * K * 2;
    const size_t kstep = (size_t)(BK * 2);
    const size_t hstep = (size_t)HALF * K * 2;
    const size_t tstep = 2 * hstep;
    const unsigned ldsw = (unsigned)wid * 1024u;
    const int aoff = lds_byte(wr * 64 + fr, fq * 8), boff = lds_byte(wc * 32 + fr, fq * 8);
#define PG8_SA(b, h) (((b) * 2 + (h)) * HTB)
#define PG8_SB(b, h) ((4 + (b) * 2 + (h)) * HTB)
#define PG8_STAGE2(bufoff, gbase, v0, v1) do { \
        __builtin_amdgcn_global_load_lds((const unsigned*)((const char*)(gbase) + (v0)), (LAS unsigned*)(lds + (bufoff) + ldsw), 16, 0, 0); \
        __builtin_amdgcn_global_load_lds((const unsigned*)((const char*)(gbase) + (v1)), (LAS unsigned*)(lds + (bufoff) + ldsw + 8192), 16, 0, 0); } while (0)
#define PG8_STAGEB(bufoff, gbase) do { \
        __builtin_amdgcn_global_load_lds((const unsigned*)((const char*)(gbase) + voffB0), (LAS unsigned*)(lds + (bufoff) + ldsw), 16, 0, 0); \
        __builtin_amdgcn_global_load_lds((const unsigned*)((const char*)(gbase) + p1step + voffB0), (LAS unsigned*)(lds + (bufoff) + ldsw + 8192), 16, 0, 0); } while (0)
#define PG8_LDA(dst, b, h) do { _Pragma("unroll") for (int m = 0; m < 4; ++m) _Pragma("unroll") for (int k = 0; k < 2; ++k) dst[m][k] = *(const LAS bf16x8*)(lds + PG8_SA(b, h) + aoff + m * 2048 + k * 1024); } while (0)
#define PG8_LDB(dst, b, h) do { _Pragma("unroll") for (int n = 0; n < 2; ++n) _Pragma("unroll") for (int k = 0; k < 2; ++k) dst[n][k] = *(const LAS bf16x8*)(lds + PG8_SB(b, h) + boff + n * 2048 + k * 1024); } while (0)
#define PG8_MMA(ai, bj, At, Bt) do { __builtin_amdgcn_s_setprio(1); _Pragma("unroll") for (int m = 0; m < 4; ++m) _Pragma("unroll") for (int n = 0; n < 2; ++n) _Pragma("unroll") for (int k = 0; k < 2; ++k) \
        acc[ai][bj][m][n] = __builtin_amdgcn_mfma_f32_16x16x32_bf16(Bt[n][k], At[m][k], acc[ai][bj][m][n], 0, 0, 0); __builtin_amdgcn_s_setprio(0); } while (0)
#define PG8_WAIT_V(n) asm volatile("s_waitcnt vmcnt(" #n ")" ::: "memory")
#define PG8_WAIT_L(n) asm volatile("s_waitcnt lgkmcnt(" #n ")" ::: "memory")
#define PG8_BAR __builtin_amdgcn_s_barrier()
#define PG8_SCHED __builtin_amdgcn_sched_barrier(0)
#define PG8_AOFFS(u, v00, v01, v10, v11) do { int R_, C_; stage_rc(tid * 16, R_, C_); \
        v00 = (unsigned)(AM.row(u, R_) * K + C_) * 2u; v01 = (unsigned)(AM.row(u, R_ + 64) * K + C_) * 2u; \
        v10 = (unsigned)(AM.row(u, HALF + R_) * K + C_) * 2u; v11 = (unsigned)(AM.row(u, HALF + R_ + 64) * K + C_) * 2u; } while (0)
    Unit cur, nxt; int ui = 0;
    if (!S.next(0, cur)) return;
    f32x4 acc[2][2][4][2];
#pragma unroll
    for (int a = 0; a < 2; ++a)
#pragma unroll
        for (int b = 0; b < 2; ++b)
#pragma unroll
            for (int m = 0; m < 4; ++m)
#pragma unroll
                for (int n = 0; n < 2; ++n) acc[a][b][m][n] = (f32x4){0.f, 0.f, 0.f, 0.f};
    bf16x8 At[4][2], B0[2][2], B1[2][2];
    const char* const Abase = (const char*)g.A;
    const char* cB = (const char*)g.Bt + (size_t)cur.e * g.estride + (size_t)cur.pn * tstep;
    unsigned c00, c01, c10, c11, n00, n01, n10, n11;
    PG8_AOFFS(cur, c00, c01, c10, c11);
    n00 = c00; n01 = c01; n10 = c10; n11 = c11;
    if constexpr (SP2) {
        PG8_STAGEB(PG8_SB(0, 0), cB); PG8_STAGEB(PG8_SB(0, 1), cB + hstep); PG8_STAGE2(PG8_SA(0, 0), Abase, c00, c01); PG8_STAGE2(PG8_SA(0, 1), Abase, c10, c11);
        if (wr == 1) PG8_BAR;
        PG8_WAIT_V(2); PG8_BAR;
        PG8_STAGEB(PG8_SB(1, 0), cB + kstep); PG8_STAGE2(PG8_SA(1, 0), Abase + kstep, c00, c01); PG8_STAGEB(PG8_SB(1, 1), cB + hstep + kstep);
        PG8_WAIT_V(6); PG8_BAR;
    } else {
        PG8_STAGEB(PG8_SB(0, 0), cB); PG8_STAGE2(PG8_SA(0, 0), Abase, c00, c01); PG8_STAGEB(PG8_SB(0, 1), cB + hstep); PG8_STAGE2(PG8_SA(0, 1), Abase, c10, c11);
        if (wr == 1) PG8_BAR;
        PG8_WAIT_V(4); PG8_BAR;
        PG8_STAGEB(PG8_SB(1, 0), cB + kstep); PG8_STAGE2(PG8_SA(1, 0), Abase + kstep, c00, c01); PG8_STAGEB(PG8_SB(1, 1), cB + hstep + kstep);
        PG8_WAIT_V(6); PG8_BAR;
    }
    for (;;) {
        const bool has_next = S.next(ui + 1, nxt);
        const char* nB = cB;
        if (has_next) { nB = (const char*)g.Bt + (size_t)nxt.e * g.estride + (size_t)nxt.pn * tstep; PG8_AOFFS(nxt, n00, n01, n10, n11); }
        else { n00 = c00; n01 = c01; n10 = c10; n11 = c11; }
        for (int t = 0; t < nt; t += 2) {
            const bool last = (t == nt - 2);
            const char* a1 = Abase + (size_t)(t + 1) * kstep;
            const char* a2 = last ? Abase : Abase + (size_t)(t + 2) * kstep;
            const char* b2 = last ? nB : cB + (size_t)(t + 2) * kstep;
            const char* a3 = a2 + kstep; const char* b3 = b2 + kstep;
            const unsigned x00 = last ? n00 : c00, x01 = last ? n01 : c01, x10 = last ? n10 : c10, x11 = last ? n11 : c11;
            if constexpr (SP2) {
            PG8_LDB(B0, 0, 0); PG8_LDB(B1, 0, 1); PG8_SCHED; PG8_LDA(At, 0, 0); PG8_STAGE2(PG8_SA(1, 1), a1, c10, c11);
            PG8_WAIT_V(8); PG8_WAIT_L(0); PG8_BAR; PG8_MMA(0, 0, At, B0); PG8_MMA(0, 1, At, B1); PG8_BAR; PG8_SCHED;
            PG8_LDA(At, 0, 1); PG8_STAGEB(PG8_SB(0, 0), b2); PG8_STAGEB(PG8_SB(0, 1), b2 + hstep); PG8_STAGE2(PG8_SA(0, 0), a2, x00, x01);
            PG8_WAIT_V(8); PG8_WAIT_L(0); PG8_BAR; PG8_MMA(1, 0, At, B0); PG8_MMA(1, 1, At, B1); PG8_BAR; PG8_SCHED;
            PG8_LDB(B0, 1, 0); PG8_LDB(B1, 1, 1); PG8_SCHED; PG8_LDA(At, 1, 0); PG8_STAGE2(PG8_SA(0, 1), a2, x10, x11);
            PG8_WAIT_V(8); PG8_WAIT_L(0); PG8_BAR; PG8_MMA(0, 0, At, B0); PG8_MMA(0, 1, At, B1); PG8_BAR; PG8_SCHED;
            PG8_LDA(At, 1, 1); PG8_STAGEB(PG8_SB(1, 0), b3); PG8_STAGEB(PG8_SB(1, 1), b3 + hstep); PG8_STAGE2(PG8_SA(1, 0), a3, x00, x01);
            PG8_WAIT_V(8); PG8_WAIT_L(0); PG8_BAR; PG8_MMA(1, 0, At, B0); PG8_MMA(1, 1, At, B1); PG8_BAR; PG8_SCHED;
            } else {
            PG8_LDB(B0, 0, 0); PG8_SCHED; PG8_LDA(At, 0, 0); PG8_STAGE2(PG8_SA(1, 1), a1, c10, c11);
            PG8_WAIT_L(8); PG8_BAR; PG8_WAIT_L(0); PG8_MMA(0, 0, At, B0); PG8_BAR; PG8_SCHED;
            PG8_LDB(B1, 0, 1); PG8_STAGEB(PG8_SB(0, 0), b2);
            PG8_BAR; PG8_WAIT_L(0); PG8_MMA(0, 1, At, B1); PG8_BAR;
            PG8_LDA(At, 0, 1); PG8_STAGE2(PG8_SA(0, 0), a2, x00, x01);
            PG8_BAR; PG8_WAIT_L(0); PG8_MMA(1, 0, At, B0); PG8_BAR; PG8_SCHED;
            PG8_STAGEB(PG8_SB(0, 1), b2 + hstep);
            PG8_WAIT_V(6); PG8_BAR; PG8_MMA(1, 1, At, B1); PG8_BAR;
            PG8_LDB(B0, 1, 0); PG8_SCHED; PG8_LDA(At, 1, 0); PG8_STAGE2(PG8_SA(0, 1), a2, x10, x11);
            PG8_WAIT_L(8); PG8_BAR; PG8_WAIT_L(0); PG8_MMA(0, 0, At, B0); PG8_BAR; PG8_SCHED;
            PG8_LDB(B1, 1, 1); PG8_STAGEB(PG8_SB(1, 0), b3);
            PG8_BAR; PG8_WAIT_L(0); PG8_MMA(0, 1, At, B1); PG8_BAR;
            PG8_LDA(At, 1, 1); PG8_STAGE2(PG8_SA(1, 0), a3, x00, x01);
            PG8_BAR; PG8_WAIT_L(0); PG8_MMA(1, 0, At, B0); PG8_BAR; PG8_SCHED;
            PG8_STAGEB(PG8_SB(1, 1), b3 + hstep);
            PG8_WAIT_V(6); PG8_BAR; PG8_MMA(1, 1, At, B1); PG8_BAR;
            }
        }
        if constexpr (ALIGN_EPI) { if (wr == 0) PG8_BAR; }
        E(acc, cur, wr, wc);
        if (!has_next) break;
#pragma unroll
        for (int a = 0; a < 2; ++a)
#pragma unroll
            for (int b = 0; b < 2; ++b)
#pragma unroll
                for (int m = 0; m < 4; ++m)
#pragma unroll
                    for (int n = 0; n < 2; ++n) acc[a][b][m][n] = (f32x4){0.f, 0.f, 0.f, 0.f};
        cur = nxt; cB = nB; c00 = n00; c01 = n01; c10 = n10; c11 = n11; ++ui;
        if constexpr (ALIGN_EPI) { if (wr == 1) PG8_BAR; }
    }
    PG8_WAIT_V(0);
    if constexpr (!ALIGN_EPI) { if (wr == 0) PG8_BAR; }
    PG8_BAR;
#undef PG8_SA
#undef PG8_SB
#undef PG8_STAGE2
#undef PG8_STAGEB
#undef PG8_LDA
#undef PG8_LDB
#undef PG8_MMA
#undef PG8_WAIT_V
#undef PG8_WAIT_L
#undef PG8_BAR
#undef PG8_SCHED
#undef PG8_AOFFS
}
}

struct Params {
    const float* in[33];
    float* out;
    unsigned char* ws;
    int layer, pad;
};
enum { I_X = 0, I_C, I_ADAW, I_ADAB, I_NMIX, I_NFFN, I_WIN, I_SCW, I_SCB, I_SDTB, I_SALOG, I_SD, I_SNW, I_HLB, I_HNW, I_LCW, I_LCB, I_LWA, I_LBA, I_LWX, I_LBX, I_LLAM, I_LNW,
       I_WOUT, I_RW, I_RB, I_EG, I_EU, I_ED, I_SG, I_SU, I_SDN, I_FNW };

using pg8::Unit;
struct EpiU {
    static constexpr bool PERM = true;
    bf16_t* O; int ldc;
    __device__ __forceinline__ void operator()(const f32x4 (&acc)[2][2][4][2], const Unit& u, int wr, int wc) const {
        const int lane_ = fresh_lane(), fr = lane_ & 15, fq = lane_ >> 4;
        const int row0 = u.pm * 256 + wr * 64 + fr, col0 = u.pn * 256 + wc * 32 + 8 * fq;
#pragma unroll
        for (int ai = 0; ai < 2; ++ai)
#pragma unroll
            for (int m = 0; m < 4; ++m) { bf16_t* rowp = O + (size_t)(row0 + ai * 128 + m * 16) * ldc + col0;
#pragma unroll
                for (int bj = 0; bj < 2; ++bj) { const f32x4 v0 = acc[ai][bj][m][0], v1 = acc[ai][bj][m][1];
                    u32x4 w; w.x = pk2(v0[0], v0[1]); w.y = pk2(v0[2], v0[3]); w.z = pk2(v1[0], v1[1]); w.w = pk2(v1[2], v1[3]);
                    *(u32x4*)(rowp + bj * 128) = w; } }
    }
};
struct EpiOut {
    static constexpr bool PERM = false;
    const float* xin; float* xout; const float* gate;
    __device__ __forceinline__ void operator()(const f32x4 (&acc)[2][2][4][2], const Unit& u, int wr, int wc) const {
        const int lane_ = fresh_lane(), fr = lane_ & 15, fq = lane_ >> 4;
        const int row0 = u.pm * 256 + wr * 64 + fr, col0 = u.pn * 256 + wc * 32 + 4 * fq, b = u.pm >> 3;
        f32x4 gv[2][2];
#pragma unroll
        for (int bj = 0; bj < 2; ++bj)
#pragma unroll
            for (int n = 0; n < 2; ++n) gv[bj][n] = *(const f32x4*)(gate + (size_t)b * NMOD + col0 + bj * 128 + n * 16);
#pragma unroll
        for (int ai = 0; ai < 2; ++ai)
#pragma unroll
            for (int m = 0; m < 4; ++m) { const size_t off = (size_t)(row0 + ai * 128 + m * 16) * DM + col0;
#pragma unroll
                for (int bj = 0; bj < 2; ++bj)
#pragma unroll
                    for (int n = 0; n < 2; ++n) { const f32x4 xi = *(const f32x4*)(xin + off + bj * 128 + n * 16);
                        *(f32x4*)(xout + off + bj * 128 + n * 16) = xi + gv[bj][n] * acc[ai][bj][m][n]; }
                asm volatile("" ::: "memory"); }
    }
};
struct EpiH {
    static constexpr bool PERM = true;
    bf16_t* Hm;
    __device__ __forceinline__ void operator()(const f32x4 (&acc)[2][2][4][2], const Unit& u, int wr, int wc) const {
        const int lane_ = fresh_lane(), fr = lane_ & 15, fq = lane_ >> 4;
        const int row0 = u.pm * 256 + wr * 64 + fr, col0 = u.pn * 128 + wc * 32 + 8 * fq;
#pragma unroll
        for (int ai = 0; ai < 2; ++ai)
#pragma unroll
            for (int m = 0; m < 4; ++m) { bf16_t* rowp = Hm + (size_t)(row0 + ai * 128 + m * 16) * 256 + col0;
                f32x4 h0, h1;
#pragma unroll
                for (int j = 0; j < 4; ++j) { h0[j] = siluf_(acc[ai][0][m][0][j]) * acc[ai][1][m][0][j]; h1[j] = siluf_(acc[ai][0][m][1][j]) * acc[ai][1][m][1][j]; }
                u32x4 w; w.x = pk2(h0[0], h0[1]); w.y = pk2(h0[2], h0[3]); w.z = pk2(h1[0], h1[1]); w.w = pk2(h1[2], h1[3]);
                *(u32x4*)rowp = w; }
    }
};
struct EpiY {
    static constexpr bool PERM = true;
    bf16_t* Y; bf16_t* Ysh; const int* rinfo;
    __device__ __forceinline__ void operator()(const f32x4 (&acc)[2][2][4][2], const Unit& u, int wr, int wc) const {
        const int lane_ = fresh_lane(), fr = lane_ & 15, fq = lane_ >> 4;
        const int col0 = u.pn * 256 + wc * 32 + 8 * fq;
        bf16_t* base = Y + (size_t)u.pm * 256 * DM;
        if (u.e >= NEXP) base = Ysh + (size_t)(u.pm - rinfo[0]) * 256 * DM;
        base += (size_t)(wr * 64 + fr) * DM + col0;
#pragma unroll
        for (int ai = 0; ai < 2; ++ai)
#pragma unroll
            for (int m = 0; m < 4; ++m) { bf16_t* rowp = base + (size_t)(ai * 128 + m * 16) * DM;
#pragma unroll
                for (int bj = 0; bj < 2; ++bj) { const f32x4 v0 = acc[ai][bj][m][0], v1 = acc[ai][bj][m][1];
                    u32x4 w; w.x = pk2(v0[0], v0[1]); w.y = pk2(v0[2], v0[3]); w.z = pk2(v1[0], v1[1]); w.w = pk2(v1[2], v1[3]);
                    *(u32x4*)(rowp + bj * 128) = w; } }
    }
};
struct MoeOrder {
    const int* rinfo; int NQ, G, c;
    __device__ bool next(int i, Unit& u) const {
        const int nblk = rinfo[0]; const long L = (long)i * G + c;
        if (L >= (long)(nblk + 64) * NQ) return false;
        const int rb = (int)(L / NQ); u.pm = rb; u.pn = (int)(L % NQ); u.e = (rb < nblk) ? rinfo[64 + rb] : NEXP; return true;
    }
};
struct GatherRows {
    const int* slot_tok; const int* rinfo;
    __device__ __forceinline__ int row(const Unit& u, int r) const {
        const int nblk = rinfo[0];
        if (u.pm < nblk) { const int t = slot_tok[u.pm * 256 + r]; return t < 0 ? 0 : t; }
        return (u.pm - nblk) * 256 + r;
    }
};

struct Ctx { LAS unsigned char* lds; int tid, lane, wave, G, bid; };

template <class RowMap>
__device__ __forceinline__ void transpose_item(const float* W, int N, int k0, int n0, bf16_t* WT, int ldk, const RowMap& rm, LAS float* scr, int lane) {
    const int nn = n0 + (lane & 31);
#pragma unroll 8
    for (int i = 0; i < 32; ++i) { const int kk = 2 * i + (lane >> 5); scr[kk * 33 + (lane & 31)] = (nn < N) ? W[(size_t)(k0 + kk) * N + nn] : 0.f; }
    LDS_WAIT();
    const int c = lane & 7;
#pragma unroll
    for (int j = 0; j < 4; ++j) { const int n = (lane >> 3) + 8 * j; const LAS float* s = scr + (8 * c) * 33 + n;
        u32x4 o; o.x = pk2(s[0 * 33], s[1 * 33]); o.y = pk2(s[2 * 33], s[3 * 33]); o.z = pk2(s[4 * 33], s[5 * 33]); o.w = pk2(s[6 * 33], s[7 * 33]);
        const int dr = (n0 + n < N) ? rm(n0 + n) : -1;
        if (dr >= 0) *(u32x4*)(WT + (size_t)dr * ldk + k0 + 8 * c) = o; }
    LDS_WAIT();
}
struct RmIdent { __device__ __forceinline__ int operator()(int n) const { return n; } };
struct RmWin { __device__ __forceinline__ int operator()(int n) const { return n < 2560 ? n : (n < 2576 ? -1 : n - 16); } };
struct RmGate { __device__ __forceinline__ int operator()(int n) const { return (n >> 7) * 256 + (n & 127); } };
struct RmUp { __device__ __forceinline__ int operator()(int n) const { return (n >> 7) * 256 + 128 + (n & 127); } };

__device__ __forceinline__ void phase_prep_io(const Params& p, const Ctx& c) {
    LAS float* scr = (LAS float*)(c.lds + c.wave * 16384);
    const int gw = c.bid * NWAVES + c.wave, NGW = c.G * NWAVES;
    constexpr int I_IN = 16 * 177, I_OUT = 32 * 32, PER_L = I_IN + I_OUT;
    for (int it = gw; it < NLAYER * PER_L; it += NGW) {
        const int l = it / PER_L; int r = it % PER_L;
        if (r < I_IN) { const int kb = r / 177, nb = r % 177;
            transpose_item(p.in[I_WIN] + (size_t)l * DM * DIN, DIN, kb * 64, nb * 32, (bf16_t*)(p.ws + WS_WIN) + (size_t)l * NU * DM, DM, RmWin(), scr, c.lane); }
        else { r -= I_IN; const int kb = r / 32, nb = r % 32;
            transpose_item(p.in[I_WOUT] + (size_t)l * 2048 * DM, DM, kb * 64, nb * 32, (bf16_t*)(p.ws + WS_WOUT) + (size_t)l * DM * 2048, 2048, RmIdent(), scr, c.lane); }
    }
}
__device__ __forceinline__ void phase_prep_experts(const Params& p, const Ctx& c, int l) {
    LAS float* scr = (LAS float*)(c.lds + c.wave * 16384);
    const int gw = c.bid * NWAVES + c.wave, NGW = c.G * NWAVES;
    constexpr int PER_E = 3 * 128;
    bf16_t* GU = (bf16_t*)(p.ws + WS_GU); bf16_t* DN = (bf16_t*)(p.ws + WS_DN);
    for (int it = gw; it < 65 * PER_E; it += NGW) {
        const int e = it / PER_E; int r = it % PER_E; const int which = r / 128; r %= 128;
        if (which < 2) {
            const float* src = (e < NEXP) ? p.in[which == 0 ? I_EG : I_EU] + ((size_t)l * NEXP + e) * DM * 256 : p.in[which == 0 ? I_SG : I_SU] + (size_t)l * DM * 256;
            const int kb = r / 8, nb = r % 8;
            if (which == 0) transpose_item(src, 256, kb * 64, nb * 32, GU + (size_t)e * 512 * DM, DM, RmGate(), scr, c.lane);
            else transpose_item(src, 256, kb * 64, nb * 32, GU + (size_t)e * 512 * DM, DM, RmUp(), scr, c.lane);
        } else {
            const float* src = (e < NEXP) ? p.in[I_ED] + ((size_t)l * NEXP + e) * 256 * DM : p.in[I_SDN] + (size_t)l * 256 * DM;
            const int kb = r / 32, nb = r % 32;
            transpose_item(src, DM, kb * 64, nb * 32, DN + (size_t)e * DM * 256, 256, RmIdent(), scr, c.lane);
        }
    }
}
__device__ __forceinline__ void phase_prep_small(const Params& p, const Ctx& c) {
    LAS float* sc = (LAS float*)c.lds;
    LAS float* red = (LAS float*)(c.lds + 32768);
    float* mod = (float*)(p.ws + WS_MOD);
    bool have_sc = false;
    for (int it = c.bid; it < NLAYER * 96; it += c.G) {
        if (!have_sc) { for (int i = c.tid; i < 8 * 1024; i += NTHREADS) sc[i] = siluf_(p.in[I_C][i]); have_sc = true; }
        __syncthreads();
        const int l = it / 96, j0 = (it % 96) * 64, j = c.tid & 63, kg = c.tid >> 6;
        const float* W = p.in[I_ADAW] + (size_t)l * DM * NMOD + j0 + j;
        float a[8];
#pragma unroll
        for (int b = 0; b < 8; ++b) a[b] = 0.f;
        for (int k = kg * 128; k < kg * 128 + 128; ++k) { const float w = W[(size_t)k * NMOD];
#pragma unroll
            for (int b = 0; b < 8; ++b) a[b] += sc[b * 1024 + k] * w; }
#pragma unroll
        for (int b = 0; b < 8; ++b) red[(kg * 8 + b) * 64 + j] = a[b];
        __syncthreads();
        { const int b = c.tid >> 6; float s = 0.f;
#pragma unroll
          for (int g = 0; g < 8; ++g) s += red[(g * 8 + b) * 64 + j];
          mod[((size_t)l * 8 + b) * NMOD + j0 + j] = s + p.in[I_ADAB][(size_t)l * NMOD + j0 + j]; }
        __syncthreads();
    }
    if (c.bid == c.G - 1) {
        float* lb = (float*)(p.ws + WS_LB);
        for (int i = c.tid; i < 512; i += NTHREADS) { const float v0 = p.in[I_HLB][i], v1 = p.in[I_HLB][512 + i]; const float m = fmaxf(v0, v1), e0 = expf(v0 - m), e1 = expf(v1 - m);
            lb[i] = 0.f; lb[512 + i] = e1 / (e0 + e1); }
    }
    { bf16_t* LW = (bf16_t*)(p.ws + WS_LRUW);
      for (int o = c.bid * NTHREADS + c.tid; o < NLAYER * 2 * 8 * 4096; o += c.G * NTHREADS) {
          const int i = o & 63, j = (o >> 6) & 63, g = (o >> 12) & 7, mat = (o >> 15) & 1, l = o >> 16;
          const float* src = p.in[mat == 0 ? I_LWA : I_LWX] + (((size_t)l * 8 + g) * 64 + i) * 64 + j;
          LW[o] = (bf16_t)f2bf(*src); } }
}

__device__ __forceinline__ void phase_norm_mix(const Params& p, const Ctx& c, int l, const float* xin) {
    LAS float* wdt = (LAS float*)c.lds;
    const float* Win = p.in[I_WIN] + (size_t)l * DM * DIN;
    for (int i = c.tid; i < 16 * 1024; i += NTHREADS) { const int k = i >> 4, j = i & 15; wdt[j * 1024 + k] = Win[(size_t)k * DIN + 2560 + j]; }
    __syncthreads();
    const float* mod = (const float*)(p.ws + WS_MOD) + (size_t)l * 8 * NMOD;
    const float* nw = p.in[I_NMIX] + (size_t)l * DM;
    bf16_t* H = (bf16_t*)(p.ws + WS_H); float* dtraw = (float*)(p.ws + WS_DTRAW);
    const int gw = c.bid * NWAVES + c.wave, NGW = c.G * NWAVES;
    for (int tok = gw; tok < NTOK; tok += NGW) {
        const int b = tok >> 11;
        const f32x4* xr = (const f32x4*)(xin + (size_t)tok * DM) + c.lane;
        f32x4 v[4]; float ss = 0.f;
#pragma unroll
        for (int j = 0; j < 4; ++j) { v[j] = xr[64 * j]; ss += (v[j][0] * v[j][0] + v[j][1] * v[j][1]) + (v[j][2] * v[j][2] + v[j][3] * v[j][3]); }
        const float rstd = 1.0f / sqrtf(wave_sum(ss, c.lane) * (1.0f / DM) + EPS);
        f32x4 hv[4];
#pragma unroll
        for (int j = 0; j < 4; ++j) {
            const int col = 256 * j + 4 * c.lane;
            const f32x4 w4 = *(const f32x4*)(nw + col), sh = *(const f32x4*)(mod + (size_t)b * NMOD + col), sc = *(const f32x4*)(mod + (size_t)b * NMOD + 1024 + col);
            hv[j] = (v[j] * rstd * w4) * (sc + 1.0f) + sh;
            u32x2 o; o.x = pk2(hv[j][0], hv[j][1]); o.y = pk2(hv[j][2], hv[j][3]);
            *(u32x2*)(H + (size_t)tok * DM + col) = o;
        }
        float mine = 0.f;
#pragma unroll 2
        for (int q = 0; q < 16; ++q) {
            float s = 0.f;
#pragma unroll
            for (int j = 0; j < 4; ++j) { const f32x4 wq = *(const LAS f32x4*)(wdt + q * 1024 + 256 * j + 4 * c.lane); s += (hv[j][0] * wq[0] + hv[j][1] * wq[1]) + (hv[j][2] * wq[2] + hv[j][3] * wq[3]); }
            s = wave_sum(s, c.lane);
            mine = (c.lane == q) ? s : mine;
        }
        if (c.lane < 16) dtraw[(size_t)tok * 16 + c.lane] = mine;
    }
}

__device__ __forceinline__ void phase_ssd_conv(const Params& p, const Ctx& c, int l) {
    const bf16_t* U = (const bf16_t*)(p.ws + WS_U); bf16_t* XA = (bf16_t*)(p.ws + WS_XBC);
    const float* cw = p.in[I_SCW] + (size_t)l * 4 * 1536; const float* cb = p.in[I_SCB] + (size_t)l * 1536;
    const float* dtraw = (const float*)(p.ws + WS_DTRAW); float* dt = (float*)(p.ws + WS_DT); float* acum = (float*)(p.ws + WS_ACUM);
    for (int idx = c.bid * NTHREADS + c.tid; idx < (NTOK / 4) * 192; idx += c.G * NTHREADS) {
        const int oct = idx % 192, tg = idx / 192, tok0 = tg * 4, t0 = tok0 & (SEQ - 1), c0 = oct * 8;
        float w[4][8], bb[8];
#pragma unroll
        for (int k = 0; k < 4; ++k) { const f32x4 a = *(const f32x4*)(cw + k * 1536 + c0), b2 = *(const f32x4*)(cw + k * 1536 + c0 + 4);
            w[k][0] = a[0]; w[k][1] = a[1]; w[k][2] = a[2]; w[k][3] = a[3]; w[k][4] = b2[0]; w[k][5] = b2[1]; w[k][6] = b2[2]; w[k][7] = b2[3]; }
        { const f32x4 a = *(const f32x4*)(cb + c0), b2 = *(const f32x4*)(cb + c0 + 4); bb[0] = a[0]; bb[1] = a[1]; bb[2] = a[2]; bb[3] = a[3]; bb[4] = b2[0]; bb[5] = b2[1]; bb[6] = b2[2]; bb[7] = b2[3]; }
        float x[7][8];
#pragma unroll
        for (int r = 0; r < 7; ++r) {
            u32x4 v = (u32x4){0u, 0u, 0u, 0u};
            if (t0 + r - 3 >= 0) v = *(const u32x4*)(U + (size_t)(tok0 + r - 3) * NU + UXS + c0);
#pragma unroll
            for (int j = 0; j < 4; ++j) { x[r][2 * j] = lo_bf(v[j]); x[r][2 * j + 1] = hi_bf(v[j]); }
        }
#pragma unroll
        for (int t = 0; t < 4; ++t) {
            float y[8];
#pragma unroll
            for (int j = 0; j < 8; ++j) y[j] = siluf_(bb[j] + w[0][j] * x[t][j] + w[1][j] * x[t + 1][j] + w[2][j] * x[t + 2][j] + w[3][j] * x[t + 3][j]);
            u32x4 o; o.x = pk2(y[0], y[1]); o.y = pk2(y[2], y[3]); o.z = pk2(y[4], y[5]); o.w = pk2(y[6], y[7]);
            *(u32x4*)(XA + (size_t)(tok0 + t) * 1536 + c0) = o;
        }
    }
    const int gw = c.bid * NWAVES + c.wave, NGW = c.G * NWAVES;
    for (int it = gw; it < 128; it += NGW) {
        const int tok0 = it * 128, h = c.lane & 15, qtr = c.lane >> 4;
        const float bias = p.in[I_SDTB][l * 16 + h], A = -expf(p.in[I_SALOG][l * 16 + h]);
        float d[32]; float cum = 0.f;
#pragma unroll
        for (int i = 0; i < 32; ++i) d[i] = softplusf_(dtraw[(size_t)(tok0 + qtr * 32 + i) * 16 + h] + bias);
#pragma unroll
        for (int i = 0; i < 32; ++i) cum += d[i] * A;
        const float c1 = shfl_up_f(cum, 16, c.lane), c2 = shfl_up_f(cum, 32, c.lane), c3 = shfl_up_f(cum, 48, c.lane);
        float off = 0.f; if (qtr >= 1) off += c1; if (qtr >= 2) off += c2; if (qtr >= 3) off += c3;
        float run = off;
#pragma unroll
        for (int i = 0; i < 32; ++i) { run += d[i] * A; dt[(size_t)(tok0 + qtr * 32 + i) * 16 + h] = d[i]; acum[(size_t)(tok0 + qtr * 32 + i) * 16 + h] = run; }
    }
}

__device__ __forceinline__ void phase_ssd_state(const Params& p, const Ctx& c) {
    LAS bf16_t* XT = (LAS bf16_t*)c.lds;
    LAS bf16_t* BT = (LAS bf16_t*)(c.lds + 64 * 136 * 2);
    const bf16_t* XA = (const bf16_t*)(p.ws + WS_XBC); const float* dt = (const float*)(p.ws + WS_DT); const float* acum = (const float*)(p.ws + WS_ACUM);
    bf16_t* ST = (bf16_t*)(p.ws + WS_SST);
    const int fr = c.lane & 15, fq = c.lane >> 4;
    for (int it = c.bid; it < 2048; it += c.G) {
        const int h = it & 15, bc = it >> 4, tok0 = bc * 128, g = h >> 3;
        const float aend = acum[(size_t)(tok0 + 127) * 16 + h];
        for (int i = c.tid; i < 128 * 32; i += NTHREADS) { const int lrow = i >> 5, pp = i & 31;
            const unsigned r = *(const unsigned*)(XA + (size_t)(tok0 + lrow) * 1536 + h * 64 + 2 * pp);
            const float f = dt[(size_t)(tok0 + lrow) * 16 + h] * __expf(aend - acum[(size_t)(tok0 + lrow) * 16 + h]);
            XT[(2 * pp) * 136 + lrow] = (bf16_t)f2bf(lo_bf(r) * f); XT[(2 * pp + 1) * 136 + lrow] = (bf16_t)f2bf(hi_bf(r) * f); }
        for (int i = c.tid; i < 128 * 64; i += NTHREADS) { const int lrow = i >> 6, nn = i & 63;
            const unsigned r = *(const unsigned*)(XA + (size_t)(tok0 + lrow) * 1536 + 1024 + g * 128 + 2 * nn);
            BT[(2 * nn) * 136 + lrow] = (bf16_t)(r & 0xffffu); BT[(2 * nn + 1) * 136 + lrow] = (bf16_t)(r >> 16); }
        __syncthreads();
        f32x4 acc[4];
#pragma unroll
        for (int m = 0; m < 4; ++m) acc[m] = (f32x4){0.f, 0.f, 0.f, 0.f};
#pragma unroll
        for (int ks = 0; ks < 4; ++ks) {
            const bf16x8 bfr = *(const LAS bf16x8*)(BT + (16 * c.wave + fr) * 136 + ks * 32 + 8 * fq);
#pragma unroll
            for (int m = 0; m < 4; ++m) { const bf16x8 afr = *(const LAS bf16x8*)(XT + (16 * m + fr) * 136 + ks * 32 + 8 * fq); acc[m] = MFMA16(afr, bfr, acc[m]); }
        }
#pragma unroll
        for (int m = 0; m < 4; ++m)
#pragma unroll
            for (int r = 0; r < 4; ++r) ST[(size_t)it * 8192 + (16 * m + 4 * fq + r) * 128 + 16 * c.wave + fr] = (bf16_t)f2bf(acc[m][r]);
        __syncthreads();
    }
}
__device__ __forceinline__ void phase_ssd_scan(const Params& p, const Ctx& c) {
    unsigned* ST = (unsigned*)(p.ws + WS_SST); const float* acum = (const float*)(p.ws + WS_ACUM);
    for (int i = c.bid * NTHREADS + c.tid; i < 128 * 4096; i += c.G * NTHREADS) {
        const int e2 = i & 4095, bh = i >> 12, b = bh >> 4, h = bh & 15;
        float r0 = 0.f, r1 = 0.f;
        for (int ch = 0; ch < 16; ++ch) {
            const size_t it = (size_t)((b * 16 + ch) * 16 + h);
            const unsigned loc = ST[it * 4096 + e2];
            ST[it * 4096 + e2] = pk2(r0, r1);
            const float d = __expf(acum[(size_t)(b * SEQ + ch * 128 + 127) * 16 + h]);
            r0 = d * r0 + lo_bf(loc); r1 = d * r1 + hi_bf(loc);
        }
    }
}
__device__ __forceinline__ void phase_ssd_out(const Params& p, const Ctx& c, int l) {
    LAS bf16_t* Cs = (LAS bf16_t*)c.lds;
    LAS bf16_t* Bs = (LAS bf16_t*)(c.lds + 34816);
    LAS bf16_t* CBD = (LAS bf16_t*)(c.lds + 2 * 34816);
    LAS bf16_t* XT = (LAS bf16_t*)(c.lds + 3 * 34816);
    LAS bf16_t* STs = (LAS bf16_t*)(c.lds + 3 * 34816 + 17408);
    LAS float* acs = (LAS float*)(c.lds + 3 * 34816 + 2 * 17408);
    const bf16_t* XA = (const bf16_t*)(p.ws + WS_XBC); const float* dt = (const float*)(p.ws + WS_DT); const float* acum = (const float*)(p.ws + WS_ACUM);
    const bf16_t* ST = (const bf16_t*)(p.ws + WS_SST); bf16_t* YP = (bf16_t*)(p.ws + WS_H);
    const int fr = c.lane & 15, fq = c.lane >> 4, w = c.wave;
    for (int it = c.bid; it < 2048; it += c.G) {
        const int h = it & 15, bc = it >> 4, tok0 = bc * 128, g = h >> 3;
        const float Dh = p.in[I_SD][l * 16 + h];
        for (int i = c.tid; i < 128 * 16; i += NTHREADS) { const int row = i >> 4, ck = i & 15;
            *(LAS u32x4*)(Bs + row * 136 + ck * 8) = *(const u32x4*)(XA + (size_t)(tok0 + row) * 1536 + 1024 + g * 128 + ck * 8);
            *(LAS u32x4*)(Cs + row * 136 + ck * 8) = *(const u32x4*)(XA + (size_t)(tok0 + row) * 1536 + 1280 + g * 128 + ck * 8); }
        for (int i = c.tid; i < 64 * 16; i += NTHREADS) { const int row = i >> 4, ck = i & 15;
            *(LAS u32x4*)(STs + row * 136 + ck * 8) = *(const u32x4*)(ST + (size_t)it * 8192 + row * 128 + ck * 8); }
        for (int i = c.tid; i < 128 * 32; i += NTHREADS) { const int lrow = i >> 5, pp = i & 31;
            const unsigned r = *(const unsigned*)(XA + (size_t)(tok0 + lrow) * 1536 + h * 64 + 2 * pp);
            const float f = dt[(size_t)(tok0 + lrow) * 16 + h];
            XT[(2 * pp) * 136 + lrow] = (bf16_t)f2bf(lo_bf(r) * f); XT[(2 * pp + 1) * 136 + lrow] = (bf16_t)f2bf(hi_bf(r) * f); }
        if (c.tid < 128) acs[c.tid] = acum[(size_t)(tok0 + c.tid) * 16 + h];
        __syncthreads();
        {
            f32x4 cb[8];
#pragma unroll
            for (int n = 0; n < 8; ++n) cb[n] = (f32x4){0.f, 0.f, 0.f, 0.f};
#pragma unroll
            for (int ks = 0; ks < 4; ++ks) {
                const bf16x8 afr = *(const LAS bf16x8*)(Cs + (16 * w + fr) * 136 + ks * 32 + 8 * fq);
#pragma unroll
                for (int n = 0; n < 8; ++n) { const bf16x8 bfr = *(const LAS bf16x8*)(Bs + (16 * n + fr) * 136 + ks * 32 + 8 * fq); cb[n] = MFMA16(afr, bfr, cb[n]); }
            }
#pragma unroll
            for (int n = 0; n < 8; ++n)
#pragma unroll
                for (int r = 0; r < 4; ++r) { const int lr = 16 * w + 4 * fq + r, sc = 16 * n + fr;
                    const float v = (sc <= lr) ? cb[n][r] * __expf(acs[lr] - acs[sc]) : 0.f;
                    CBD[lr * 136 + sc] = (bf16_t)f2bf(v); }
        }
        __syncthreads();
        {
            f32x4 a1[4], a2[4];
#pragma unroll
            for (int n = 0; n < 4; ++n) { a1[n] = (f32x4){0.f, 0.f, 0.f, 0.f}; a2[n] = (f32x4){0.f, 0.f, 0.f, 0.f}; }
#pragma unroll
            for (int ks = 0; ks < 4; ++ks) {
                const bf16x8 ad = *(const LAS bf16x8*)(CBD + (16 * w + fr) * 136 + ks * 32 + 8 * fq);
                const bf16x8 ac = *(const LAS bf16x8*)(Cs + (16 * w + fr) * 136 + ks * 32 + 8 * fq);
#pragma unroll
                for (int n = 0; n < 4; ++n) {
                    const bf16x8 bx = *(const LAS bf16x8*)(XT + (16 * n + fr) * 136 + ks * 32 + 8 * fq);
                    const bf16x8 bs = *(const LAS bf16x8*)(STs + (16 * n + fr) * 136 + ks * 32 + 8 * fq);
                    a1[n] = MFMA16(ad, bx, a1[n]); a2[n] = MFMA16(ac, bs, a2[n]); }
            }
#pragma unroll
            for (int n = 0; n < 4; ++n)
#pragma unroll
                for (int r = 0; r < 4; ++r) { const int lr = 16 * w + 4 * fq + r, pc = 16 * n + fr;
                    const float xs = bf2f(XA[(size_t)(tok0 + lr) * 1536 + h * 64 + pc]);
                    const float y = a1[n][r] + __expf(acs[lr]) * a2[n][r] + Dh * xs;
                    YP[(size_t)(tok0 + lr) * DM + h * 64 + pc] = (bf16_t)f2bf(y); }
        }
        __syncthreads();
    }
}
__device__ __forceinline__ void phase_ssd_gate(const Params& p, const Ctx& c, int l) {
    const bf16_t* YP = (const bf16_t*)(p.ws + WS_H); const bf16_t* U = (const bf16_t*)(p.ws + WS_U); bf16_t* YC = (bf16_t*)(p.ws + WS_YCAT);
    const float* nw = p.in[I_SNW] + (size_t)l * 1024;
    const int gw = c.bid * NWAVES + c.wave, NGW = c.G * NWAVES;
    for (int i = gw; i < NTOK * 2; i += NGW) {
        const int tok = i >> 1, g = i & 1, col = g * 512 + 8 * c.lane;
        const u32x4 yv = *(const u32x4*)(YP + (size_t)tok * DM + col), zv = *(const u32x4*)(U + (size_t)tok * NU + UZ + col);
        float v[8]; float ss = 0.f;
#pragma unroll
        for (int j = 0; j < 4; ++j) { v[2 * j] = lo_bf(yv[j]) * siluf_(lo_bf(zv[j])); v[2 * j + 1] = hi_bf(yv[j]) * siluf_(hi_bf(zv[j])); ss += v[2 * j] * v[2 * j] + v[2 * j + 1] * v[2 * j + 1]; }
        const float rstd = 1.0f / sqrtf(wave_sum(ss, c.lane) * (1.0f / 512.0f) + EPS);
        const f32x4 w0 = *(const f32x4*)(nw + col), w1 = *(const f32x4*)(nw + col + 4);
        u32x4 o; o.x = pk2(v[0] * rstd * w0[0], v[1] * rstd * w0[1]); o.y = pk2(v[2] * rstd * w0[2], v[3] * rstd * w0[3]);
        o.z = pk2(v[4] * rstd * w1[0], v[5] * rstd * w1[1]); o.w = pk2(v[6] * rstd * w1[2], v[7] * rstd * w1[3]);
        *(u32x4*)(YC + (size_t)tok * 2048 + col) = o;
    }
}

__device__ __forceinline__ void phase_hg_state(const Params& p, const Ctx& c, int l) {
    LAS float* Bf = (LAS float*)c.lds;
    LAS float* KK = (LAS float*)(c.lds + 33792);
    LAS bf16_t* KDT = (LAS bf16_t*)(c.lds + 2 * 33792);
    LAS bf16_t* VT = (LAS bf16_t*)(c.lds + 2 * 33792 + 18432);
    const bf16_t* U = (const bf16_t*)(p.ws + WS_U); const float* lb = (const float*)(p.ws + WS_LB) + l * 512;
    bf16_t* ST = (bf16_t*)(p.ws + WS_HST); float* BL = (float*)(p.ws + WS_HGBL);
    const int fr = c.lane & 15, fq = c.lane >> 4, w = c.wave;
    for (int it = c.bid; it < 1024; it += c.G) {
        const int ch = it & 31, bh = it >> 5, h = bh & 3, b = bh >> 2, tok0 = b * SEQ + ch * 64;
        for (int i = c.tid; i < 64 * 64; i += NTHREADS) { const int s = i >> 6, kp = i & 63;
            const unsigned rf = *(const unsigned*)(U + (size_t)(tok0 + s) * NU + UHF + h * 128 + 2 * kp);
            const unsigned rv = *(const unsigned*)(U + (size_t)(tok0 + s) * NU + UHV + h * 128 + 2 * kp);
            const float k0 = (1.0f - lb[h * 128 + 2 * kp]) * sigmoidf_(-lo_bf(rf)), k1 = (1.0f - lb[h * 128 + 2 * kp + 1]) * sigmoidf_(-hi_bf(rf));
            KK[s * 132 + 2 * kp] = k0; KK[s * 132 + 2 * kp + 1] = k1;
            Bf[s * 132 + 2 * kp] = log1pf(-k0); Bf[s * 132 + 2 * kp + 1] = log1pf(-k1);
            VT[(2 * kp) * 72 + s] = (bf16_t)(rv & 0xffffu); VT[(2 * kp + 1) * 72 + s] = (bf16_t)(rv >> 16); }
        __syncthreads();
        if (c.tid < 128) { float cum = 0.f; for (int s = 0; s < 64; ++s) { cum += Bf[s * 132 + c.tid]; Bf[s * 132 + c.tid] = cum; } BL[(size_t)it * 128 + c.tid] = cum; }
        __syncthreads();
        for (int i = c.tid; i < 64 * 128; i += NTHREADS) { const int s = i >> 7, k = i & 127;
            KDT[k * 72 + s] = (bf16_t)f2bf(KK[s * 132 + k] * __expf(Bf[63 * 132 + k] - Bf[s * 132 + k])); }
        __syncthreads();
        f32x4 acc[8];
#pragma unroll
        for (int n = 0; n < 8; ++n) acc[n] = (f32x4){0.f, 0.f, 0.f, 0.f};
#pragma unroll
        for (int ks = 0; ks < 2; ++ks) {
            const bf16x8 afr = *(const LAS bf16x8*)(VT + (16 * w + fr) * 72 + ks * 32 + 8 * fq);
#pragma unroll
            for (int n = 0; n < 8; ++n) { const bf16x8 bfr = *(const LAS bf16x8*)(KDT + (16 * n + fr) * 72 + ks * 32 + 8 * fq); acc[n] = MFMA16(afr, bfr, acc[n]); }
        }
#pragma unroll
        for (int n = 0; n < 8; ++n)
#pragma unroll
            for (int r = 0; r < 4; ++r) ST[(size_t)it * 16384 + (16 * w + 4 * fq + r) * 128 + 16 * n + fr] = (bf16_t)f2bf(acc[n][r]);
        __syncthreads();
    }
}
__device__ __forceinline__ void phase_hg_scan(const Params& p, const Ctx& c) {
    unsigned* ST = (unsigned*)(p.ws + WS_HST); const float* BL = (const float*)(p.ws + WS_HGBL);
    for (int i = c.bid * NTHREADS + c.tid; i < 32 * 8192; i += c.G * NTHREADS) {
        const int e2 = i & 8191, bh = i >> 13, k0 = (2 * e2) & 127;
        float r0 = 0.f, r1 = 0.f;
        for (int ch = 0; ch < 32; ++ch) {
            const size_t it = (size_t)(bh * 32 + ch);
            const unsigned loc = ST[it * 8192 + e2];
            ST[it * 8192 + e2] = pk2(r0, r1);
            const float d0 = __expf(BL[it * 128 + k0]), d1 = __expf(BL[it * 128 + k0 + 1]);
            r0 = d0 * r0 + lo_bf(loc); r1 = d1 * r1 + hi_bf(loc);
        }
    }
}
__device__ __forceinline__ void phase_hg_out(const Params& p, const Ctx& c, int l) {
    LAS bf16_t* Qs = (LAS bf16_t*)c.lds;
    LAS bf16_t* Ks = (LAS bf16_t*)(c.lds + 17408);
    LAS float* Bf = (LAS float*)(c.lds + 2 * 17408);
    LAS bf16_t* QB = Qs;
    LAS bf16_t* STs = (LAS bf16_t*)(c.lds + 2 * 17408 + 33792);
    LAS bf16_t* ATT = (LAS bf16_t*)(c.lds + 2 * 17408 + 33792 + 34816);
    LAS bf16_t* VT = (LAS bf16_t*)(c.lds + 2 * 17408 + 33792 + 34816 + 9216);
    LAS bf16_t* QI = (LAS bf16_t*)(c.lds + 2 * 17408 + 33792 + 34816 + 9216 + 18432);
    LAS bf16_t* KKI = (LAS bf16_t*)(c.lds + 2 * 17408 + 33792 + 34816 + 9216 + 18432 + 4352);
    const bf16_t* U = (const bf16_t*)(p.ws + WS_U); const float* lb = (const float*)(p.ws + WS_LB) + l * 512;
    const bf16_t* ST = (const bf16_t*)(p.ws + WS_HST); bf16_t* YC = (bf16_t*)(p.ws + WS_YCAT);
    const float* nw = p.in[I_HNW] + (size_t)l * 512;
    const int fr = c.lane & 15, fq = c.lane >> 4, w = c.wave;
    for (int it = c.bid; it < 1024; it += c.G) {
        const int ch = it & 31, bh = it >> 5, h = bh & 3, b = bh >> 2, tok0 = b * SEQ + ch * 64;
        for (int i = c.tid; i < 64 * 64; i += NTHREADS) { const int s = i >> 6, kp = i & 63;
            const size_t ro = (size_t)(tok0 + s) * NU + h * 128 + 2 * kp;
            const unsigned rq = *(const unsigned*)(U + ro + UHQ), rf = *(const unsigned*)(U + ro + UHF), rv = *(const unsigned*)(U + ro + UHV);
            const float k0 = (1.0f - lb[h * 128 + 2 * kp]) * sigmoidf_(-lo_bf(rf)), k1 = (1.0f - lb[h * 128 + 2 * kp + 1]) * sigmoidf_(-hi_bf(rf));
            *(LAS unsigned*)(Ks + s * 136 + 2 * kp) = pk2(k0, k1);
            *(LAS unsigned*)(Qs + s * 136 + 2 * kp) = pk2(siluf_(lo_bf(rq)), siluf_(hi_bf(rq)));
            Bf[s * 132 + 2 * kp] = log1pf(-k0); Bf[s * 132 + 2 * kp + 1] = log1pf(-k1);
            VT[(2 * kp) * 72 + s] = (bf16_t)(rv & 0xffffu); VT[(2 * kp + 1) * 72 + s] = (bf16_t)(rv >> 16); }
        for (int i = c.tid; i < 128 * 16; i += NTHREADS) { const int row = i >> 4, ck = i & 15;
            *(LAS u32x4*)(STs + row * 136 + ck * 8) = *(const u32x4*)(ST + (size_t)it * 16384 + row * 128 + ck * 8); }
        __syncthreads();
        if (c.tid < 128) { float cum = 0.f; for (int s = 0; s < 64; ++s) { cum += Bf[s * 132 + c.tid]; Bf[s * 132 + c.tid] = cum; } }
        __syncthreads();
        for (int pidx = c.tid; pidx < 1024; pidx += NTHREADS) {
            const int ib = pidx >> 8, tq = (pidx >> 4) & 15, sq = pidx & 15, t = 16 * ib + tq, s2 = 16 * ib + sq; float a = 0.f;
            if (sq <= tq) {
                for (int k = 0; k < 128; k += 4) {
                    const f32x4 bt = *(const LAS f32x4*)(Bf + t * 132 + k), bs = *(const LAS f32x4*)(Bf + s2 * 132 + k);
                    const u32x2 qv = *(const LAS u32x2*)(Qs + t * 136 + k), kv = *(const LAS u32x2*)(Ks + s2 * 136 + k);
                    a += lo_bf(qv.x) * lo_bf(kv.x) * __expf(bt[0] - bs[0]) + hi_bf(qv.x) * hi_bf(kv.x) * __expf(bt[1] - bs[1])
                       + lo_bf(qv.y) * lo_bf(kv.y) * __expf(bt[2] - bs[2]) + hi_bf(qv.y) * hi_bf(kv.y) * __expf(bt[3] - bs[3]);
                }
            }
            ATT[t * 72 + s2] = (bf16_t)f2bf(a);
        }
        for (int i = c.tid; i < 6 * 256; i += NTHREADS) { const int blk = i >> 8, e = i & 255; const int bi = (blk < 3) ? 0 : (blk < 5 ? 1 : 2), bj = (blk < 3) ? blk + 1 : (blk < 5 ? blk - 1 : 3);
            ATT[(16 * bi + (e >> 4)) * 72 + 16 * bj + (e & 15)] = (bf16_t)0; }
        for (int ib = 1; ib < 4; ++ib) {
            const int rref = 16 * ib - 1;
            for (int i = c.tid; i < 16 * 64; i += NTHREADS) { const int tq = i >> 6, kp = i & 63, t = 16 * ib + tq;
                const unsigned q2 = *(const LAS unsigned*)(Qs + t * 136 + 2 * kp);
                *(LAS unsigned*)(QI + tq * 136 + 2 * kp) = pk2(lo_bf(q2) * __expf(Bf[t * 132 + 2 * kp] - Bf[rref * 132 + 2 * kp]), hi_bf(q2) * __expf(Bf[t * 132 + 2 * kp + 1] - Bf[rref * 132 + 2 * kp + 1])); }
            for (int i = c.tid; i < 16 * ib * 64; i += NTHREADS) { const int s2 = i >> 6, kp = i & 63;
                const unsigned k2 = *(const LAS unsigned*)(Ks + s2 * 136 + 2 * kp);
                *(LAS unsigned*)(KKI + s2 * 136 + 2 * kp) = pk2(lo_bf(k2) * __expf(Bf[rref * 132 + 2 * kp] - Bf[s2 * 132 + 2 * kp]), hi_bf(k2) * __expf(Bf[rref * 132 + 2 * kp + 1] - Bf[s2 * 132 + 2 * kp + 1])); }
            __syncthreads();
            if (w < ib) {
                f32x4 a4 = (f32x4){0.f, 0.f, 0.f, 0.f};
#pragma unroll
                for (int ks = 0; ks < 4; ++ks) { const bf16x8 afr = *(const LAS bf16x8*)(QI + fr * 136 + ks * 32 + 8 * fq), bfr = *(const LAS bf16x8*)(KKI + (16 * w + fr) * 136 + ks * 32 + 8 * fq); a4 = MFMA16(afr, bfr, a4); }
#pragma unroll
                for (int r = 0; r < 4; ++r) ATT[(16 * ib + 4 * fq + r) * 72 + 16 * w + fr] = (bf16_t)f2bf(a4[r]);
            }
            __syncthreads();
        }
        for (int i = c.tid; i < 64 * 64; i += NTHREADS) { const int t = i >> 6, kp = i & 63;
            const unsigned q2 = *(const LAS unsigned*)(Qs + t * 136 + 2 * kp);
            *(LAS unsigned*)(Qs + t * 136 + 2 * kp) = pk2(lo_bf(q2) * __expf(Bf[t * 132 + 2 * kp]), hi_bf(q2) * __expf(Bf[t * 132 + 2 * kp + 1])); }
        __syncthreads();
        f32x4 acc[4];
#pragma unroll
        for (int m = 0; m < 4; ++m) acc[m] = (f32x4){0.f, 0.f, 0.f, 0.f};
#pragma unroll
        for (int ks = 0; ks < 4; ++ks) {
            const bf16x8 bfr = *(const LAS bf16x8*)(STs + (16 * w + fr) * 136 + ks * 32 + 8 * fq);
#pragma unroll
            for (int m = 0; m < 4; ++m) { const bf16x8 afr = *(const LAS bf16x8*)(QB + (16 * m + fr) * 136 + ks * 32 + 8 * fq); acc[m] = MFMA16(afr, bfr, acc[m]); }
        }
#pragma unroll
        for (int ks = 0; ks < 2; ++ks) {
            const bf16x8 bfr = *(const LAS bf16x8*)(VT + (16 * w + fr) * 72 + ks * 32 + 8 * fq);
#pragma unroll
            for (int m = 0; m < 4; ++m) { const bf16x8 afr = *(const LAS bf16x8*)(ATT + (16 * m + fr) * 72 + ks * 32 + 8 * fq); acc[m] = MFMA16(afr, bfr, acc[m]); }
        }
#pragma unroll
        for (int m = 0; m < 4; ++m)
#pragma unroll
            for (int r = 0; r < 4; ++r) Bf[(16 * m + 4 * fq + r) * 132 + 16 * w + fr] = acc[m][r];
        __syncthreads();
        for (int t = w * 8; t < w * 8 + 8; ++t) {
            const f32x2 o = *(const LAS f32x2*)(Bf + t * 132 + 2 * c.lane);
            const float rstd = 1.0f / sqrtf(wave_sum(o.x * o.x + o.y * o.y, c.lane) * (1.0f / 128.0f) + EPS);
            const unsigned gv = *(const unsigned*)(U + (size_t)(tok0 + t) * NU + UHG + h * 128 + 2 * c.lane);
            const f32x2 wv = *(const f32x2*)(nw + h * 128 + 2 * c.lane);
            *(unsigned*)(YC + (size_t)(tok0 + t) * 2048 + 1024 + h * 128 + 2 * c.lane) = pk2(o.x * rstd * wv.x * siluf_(lo_bf(gv)), o.y * rstd * wv.y * siluf_(hi_bf(gv)));
        }
        __syncthreads();
    }
}

__device__ __forceinline__ void phase_lru1(const Params& p, const Ctx& c, int l) {
    LAS unsigned char* wl = c.lds + c.wave * 12288;
    LAS bf16_t* XB = (LAS bf16_t*)wl;
    LAS float* As = (LAS float*)(wl + 2304);
    LAS float* Us = (LAS float*)(wl + 2304 + 4096);
    const bf16_t* U = (const bf16_t*)(p.ws + WS_U); bf16_t* LA = (bf16_t*)(p.ws + WS_LA); bf16_t* LH = (bf16_t*)(p.ws + WS_LH);
    const bf16_t* LW = (const bf16_t*)(p.ws + WS_LRUW) + (size_t)l * 2 * 8 * 4096;
    const int fr = c.lane & 15, fq = c.lane >> 4, g = c.wave, chn = g * 64 + c.lane;
    const float cw0 = p.in[I_LCW][(size_t)l * 2048 + chn], cw1 = p.in[I_LCW][(size_t)l * 2048 + 512 + chn], cw2 = p.in[I_LCW][(size_t)l * 2048 + 1024 + chn], cw3 = p.in[I_LCW][(size_t)l * 2048 + 1536 + chn];
    const float cbias = p.in[I_LCB][l * 512 + chn];
    bf16x8 wfa[4][2], wfx[4][2];
#pragma unroll
    for (int n = 0; n < 4; ++n)
#pragma unroll
        for (int ks = 0; ks < 2; ++ks) { wfa[n][ks] = *(const bf16x8*)(LW + (size_t)(0 * 8 + g) * 4096 + (16 * n + fr) * 64 + ks * 32 + 8 * fq);
                                         wfx[n][ks] = *(const bf16x8*)(LW + (size_t)(1 * 8 + g) * 4096 + (16 * n + fr) * 64 + ks * 32 + 8 * fq); }
    float bav[4], bxv[4], spl[4];
#pragma unroll
    for (int n = 0; n < 4; ++n) { const int j = g * 64 + 16 * n + fr; bav[n] = p.in[I_LBA][l * 512 + j]; bxv[n] = p.in[I_LBX][l * 512 + j]; spl[n] = softplusf_(-p.in[I_LLAM][l * 512 + j]); }
    for (int it = c.bid; it < 256; it += c.G) {
        const int seg = it & 31, tok0 = (it >> 5) * SEQ + seg * 64;
        float x0 = 0.f, x1 = 0.f, x2 = 0.f;
        if (seg > 0) { x0 = bf2f(U[(size_t)(tok0 - 3) * NU + ULX + chn]); x1 = bf2f(U[(size_t)(tok0 - 2) * NU + ULX + chn]); x2 = bf2f(U[(size_t)(tok0 - 1) * NU + ULX + chn]); }
        float hrun = 0.f, arun = 1.f;
        for (int st = 0; st < 4; ++st) {
            const int t0 = tok0 + st * 16;
#pragma unroll
            for (int tt = 0; tt < 16; ++tt) { const float xr = bf2f(U[(size_t)(t0 + tt) * NU + ULX + chn]);
                const float xb = cbias + cw0 * x0 + cw1 * x1 + cw2 * x2 + cw3 * xr; x0 = x1; x1 = x2; x2 = xr;
                XB[tt * 72 + c.lane] = (bf16_t)f2bf(xb); }
            LDS_WAIT();
            f32x4 ar[4], ai[4];
#pragma unroll
            for (int n = 0; n < 4; ++n) { ar[n] = (f32x4){0.f, 0.f, 0.f, 0.f}; ai[n] = (f32x4){0.f, 0.f, 0.f, 0.f}; }
#pragma unroll
            for (int ks = 0; ks < 2; ++ks) { const bf16x8 afr = *(const LAS bf16x8*)(XB + fr * 72 + ks * 32 + 8 * fq);
#pragma unroll
                for (int n = 0; n < 4; ++n) { ar[n] = MFMA16(afr, wfa[n][ks], ar[n]); ai[n] = MFMA16(afr, wfx[n][ks], ai[n]); } }
#pragma unroll
            for (int n = 0; n < 4; ++n)
#pragma unroll
                for (int r = 0; r < 4; ++r) { const int t = 4 * fq + r, j = 16 * n + fr;
                    const float rg = sigmoidf_(ar[n][r] + bav[n]), ig = sigmoidf_(ai[n][r] + bxv[n]);
                    const float la = -8.0f * rg * spl[n], a = __expf(la), mult = sqrtf(-expm1f(2.0f * la));
                    As[t * 64 + j] = a; Us[t * 64 + j] = mult * ig * bf2f(XB[t * 72 + j]); }
            LDS_WAIT();
#pragma unroll
            for (int tt = 0; tt < 16; ++tt) { const float a = As[tt * 64 + c.lane], uu = Us[tt * 64 + c.lane];
                hrun = a * hrun + uu; arun = a * arun;
                LA[(size_t)(t0 + tt) * 512 + chn] = (bf16_t)f2bf(arun); LH[(size_t)(t0 + tt) * 512 + chn] = (bf16_t)f2bf(hrun); }
            LDS_WAIT();
        }
    }
}
__device__ __forceinline__ void phase_lru2(const Params& p, const Ctx& c, int l) {
    LAS float* YS = (LAS float*)c.lds;
    LAS float* PART = (LAS float*)(c.lds + 65536);
    const bf16_t* U = (const bf16_t*)(p.ws + WS_U); const bf16_t* LA = (const bf16_t*)(p.ws + WS_LA); const bf16_t* LH = (const bf16_t*)(p.ws + WS_LH);
    bf16_t* YC = (bf16_t*)(p.ws + WS_YCAT);
    const int g = c.wave, chn = g * 64 + c.lane;
    const float nwv = p.in[I_LNW][l * 512 + chn];
    for (int it = c.bid; it < 256; it += c.G) {
        const int seg = it & 31, b = it >> 5, tok0 = b * SEQ + seg * 64;
        float hin = 0.f;
        for (int s2 = 0; s2 < seg; ++s2) { const size_t row = (size_t)(b * SEQ + s2 * 64 + 63); hin = bf2f(LH[row * 512 + chn]) + bf2f(LA[row * 512 + chn]) * hin; }
        for (int sb = 0; sb < 2; ++sb) {
#pragma unroll 4
            for (int tt = 0; tt < 32; ++tt) { const size_t tok = (size_t)(tok0 + sb * 32 + tt);
                const float hh = bf2f(LH[tok * 512 + chn]) + bf2f(LA[tok * 512 + chn]) * hin;
                const float y = hh * gelu_tanhf_(bf2f(U[tok * NU + ULG + chn]));
                YS[tt * 512 + chn] = y;
                const float ss = wave_sum(y * y, c.lane);
                if (c.lane == 0) PART[tt * 8 + g] = ss; }
            __syncthreads();
#pragma unroll 4
            for (int tt = 0; tt < 32; ++tt) { const f32x4 p0 = *(const LAS f32x4*)(PART + tt * 8), p1 = *(const LAS f32x4*)(PART + tt * 8 + 4);
                const float tot = ((p0[0] + p0[1]) + (p0[2] + p0[3])) + ((p1[0] + p1[1]) + (p1[2] + p1[3]));
                const float rstd = 1.0f / sqrtf(tot * (1.0f / 512.0f) + EPS);
                YC[(size_t)(tok0 + sb * 32 + tt) * 2048 + 1536 + chn] = (bf16_t)f2bf(YS[tt * 512 + chn] * rstd * nwv); }
            __syncthreads();
        }
    }
}

__device__ __forceinline__ void phase_norm_router(const Params& p, const Ctx& c, int l, const float* xin) {
    LAS float* HS = (LAS float*)(c.lds + c.wave * 16384);
    const float* mod = (const float*)(p.ws + WS_MOD) + (size_t)l * 8 * NMOD;
    const float* nw = p.in[I_NFFN] + (size_t)l * DM;
    const float* RWt = p.in[I_RW] + (size_t)l * DM * NEXP;
    const float rbias = p.in[I_RB][l * NEXP + c.lane];
    bf16_t* H = (bf16_t*)(p.ws + WS_H);
    unsigned long long* selm = (unsigned long long*)(p.ws + WS_SELM); float* rw = (float*)(p.ws + WS_RW);
    const int gw = c.bid * NWAVES + c.wave, NGW = c.G * NWAVES;
    for (int t4 = gw; t4 < NTOK / 4; t4 += NGW) {
        const int tokb = t4 * 4, b = tokb >> 11;
#pragma unroll
        for (int q = 0; q < 4; ++q) {
            const int tok = tokb + q;
            const f32x4* xr = (const f32x4*)(xin + (size_t)tok * DM) + c.lane;
            f32x4 v[4]; float ss = 0.f;
#pragma unroll
            for (int j = 0; j < 4; ++j) { v[j] = xr[64 * j]; ss += (v[j][0] * v[j][0] + v[j][1] * v[j][1]) + (v[j][2] * v[j][2] + v[j][3] * v[j][3]); }
            const float rstd = 1.0f / sqrtf(wave_sum(ss, c.lane) * (1.0f / DM) + EPS);
#pragma unroll
            for (int j = 0; j < 4; ++j) {
                const int col = 256 * j + 4 * c.lane;
                const f32x4 w4 = *(const f32x4*)(nw + col), sh = *(const f32x4*)(mod + (size_t)b * NMOD + 3072 + col), sc = *(const f32x4*)(mod + (size_t)b * NMOD + 4096 + col);
                const f32x4 h = (v[j] * rstd * w4) * (sc + 1.0f) + sh;
                u32x2 o; o.x = pk2(h[0], h[1]); o.y = pk2(h[2], h[3]);
                *(u32x2*)(H + (size_t)tok * DM + col) = o;
                *(LAS f32x4*)(HS + q * 1024 + col) = h;
            }
        }
        LDS_WAIT();
        float lg[4] = {0.f, 0.f, 0.f, 0.f};
        for (int k = 0; k < 1024; k += 32) {
            float wv[32];
#pragma unroll
            for (int i = 0; i < 32; ++i) wv[i] = RWt[(size_t)(k + i) * NEXP + c.lane];
#pragma unroll
            for (int i = 0; i < 32; i += 4)
#pragma unroll
                for (int q = 0; q < 4; ++q) { const f32x4 hv = *(const LAS f32x4*)(HS + q * 1024 + k + i); lg[q] += (hv[0] * wv[i] + hv[1] * wv[i + 1]) + (hv[2] * wv[i + 2] + hv[3] * wv[i + 3]); }
        }
#pragma unroll
        for (int q = 0; q < 4; ++q) {
            const int tok = tokb + q;
            const float s = sigmoidf_(lg[q]), v = s + rbias;
            float m1 = v;
            m1 = fmaxf(m1, shfl_xor_l(m1, 1, c.lane)); m1 = fmaxf(m1, shfl_xor_l(m1, 2, c.lane)); m1 = fmaxf(m1, shfl_xor_l(m1, 4, c.lane));
            const unsigned long long eq = __ballot(v == m1);
            const int gbase = c.lane & ~7;
            const unsigned gm = (unsigned)((eq >> gbase) & 0xffull);
            const int first = gbase + __builtin_ctz(gm);
            float m2 = (c.lane == first) ? -3.0e38f : v;
            m2 = fmaxf(m2, shfl_xor_l(m2, 1, c.lane)); m2 = fmaxf(m2, shfl_xor_l(m2, 2, c.lane)); m2 = fmaxf(m2, shfl_xor_l(m2, 4, c.lane));
            const float gs = m1 + m2;
            const int mygrp = c.lane >> 3; int grank = 0;
#pragma unroll
            for (int g2 = 0; g2 < 8; ++g2) { const float o = rdlane_f(gs, g2 * 8); grank += (o > gs || (o == gs && g2 < mygrp)) ? 1 : 0; }
            const float vm = (grank < 4) ? v : -1.0e4f;
            int erank = 0;
            for (int e2 = 0; e2 < 64; ++e2) { const float o = rdlane_f(vm, e2); erank += (o > vm || (o == vm && e2 < c.lane)) ? 1 : 0; }
            const bool sel = erank < TOPK;
            const unsigned long long mask = __ballot(sel);
            const float wsum = wave_sum(sel ? s : 0.f, c.lane);
            if (sel) { const int kk = __builtin_popcountll(mask & ((1ull << c.lane) - 1ull)); rw[(size_t)tok * 8 + kk] = s / wsum * 2.5f; }
            if (c.lane == 0) selm[tok] = mask;
        }
        LDS_WAIT();
    }
}
__device__ __forceinline__ void phase_route_count(const Params& p, const Ctx& c) {
    const unsigned long long* selm = (const unsigned long long*)(p.ws + WS_SELM); int* cnt = (int*)(p.ws + WS_CNT);
    const int gw = c.bid * NWAVES + c.wave, NGW = c.G * NWAVES;
    for (int ch = gw; ch < 256; ch += NGW) {
        const unsigned long long mine = selm[ch * 64 + c.lane]; int n = 0;
        for (int i = 0; i < 64; ++i) { const unsigned long long m = rdlane_u64(mine, i); n += (int)((m >> c.lane) & 1ull); }
        cnt[ch * 64 + c.lane] = n;
    }
}
__device__ __forceinline__ void phase_route_assign(const Params& p, const Ctx& c) {
    const unsigned long long* selm = (const unsigned long long*)(p.ws + WS_SELM); const int* cnt = (const int*)(p.ws + WS_CNT);
    int* slot_tok = (int*)(p.ws + WS_SLOTTOK); int* slot_of = (int*)(p.ws + WS_SLOTOF); int* rinfo = (int*)(p.ws + WS_RINFO);
    const int gw = c.bid * NWAVES + c.wave, NGW = c.G * NWAVES;
    for (int ch = gw; ch < 256; ch += NGW) {
        int total = 0, before = 0;
        for (int j = 0; j < 256; ++j) { const int v = cnt[j * 64 + c.lane]; total += v; before += (j < ch) ? v : 0; }
        const int pad = (total + 255) & ~255;
        int incl = pad;
#pragma unroll
        for (int o = 1; o < 64; o <<= 1) { const int t = shfl_up_l(incl, o, c.lane); if (c.lane >= o) incl += t; }
        const int pstart = incl - pad;
        int run = pstart + before;
        const unsigned long long mine = selm[ch * 64 + c.lane];
        for (int i = 0; i < 64; ++i) {
            const unsigned long long m = rdlane_u64(mine, i); const int tok = ch * 64 + i;
            if ((m >> c.lane) & 1ull) { const int kk = __builtin_popcountll(m & ((1ull << c.lane) - 1ull)); slot_tok[run] = tok; slot_of[tok * 8 + kk] = run; ++run; }
        }
        if (ch == 0) {
            for (int s = pstart + total; s < pstart + pad; ++s) slot_tok[s] = -1;
            for (int bk = pstart >> 8; bk < (pstart + pad) >> 8; ++bk) rinfo[64 + bk] = c.lane;
            if (c.lane == 63) rinfo[0] = incl >> 8;
        }
    }
}
__device__ __forceinline__ void phase_combine(const Params& p, const Ctx& c, int l) {
    const float* gate = (const float*)(p.ws + WS_MOD) + (size_t)l * 8 * NMOD + 5120;
    const bf16_t* Y = (const bf16_t*)(p.ws + WS_Y); const bf16_t* YS = (const bf16_t*)(p.ws + WS_H); const int* slot_of = (const int*)(p.ws + WS_SLOTOF); const float* rw = (const float*)(p.ws + WS_RW);
    const float* fw = p.in[I_FNW];
    const int gw = c.bid * NWAVES + c.wave, NGW = c.G * NWAVES;
    for (int tok = gw; tok < NTOK; tok += NGW) {
        const int b = tok >> 11;
        f32x4 acc[4];
#pragma unroll
        for (int j = 0; j < 4; ++j) acc[j] = (f32x4){0.f, 0.f, 0.f, 0.f};
#pragma unroll
        for (int k = 0; k < 8; ++k) { const int sl = slot_of[tok * 8 + k]; const float wk = rw[tok * 8 + k];
#pragma unroll
            for (int j = 0; j < 4; ++j) { const u32x2 yv = *(const u32x2*)(Y + (size_t)sl * DM + 256 * j + 4 * c.lane);
                acc[j][0] += wk * lo_bf(yv.x); acc[j][1] += wk * hi_bf(yv.x); acc[j][2] += wk * lo_bf(yv.y); acc[j][3] += wk * hi_bf(yv.y); } }
#pragma unroll
        for (int j = 0; j < 4; ++j) { const u32x2 yv = *(const u32x2*)(YS + (size_t)tok * DM + 256 * j + 4 * c.lane);
            acc[j][0] += lo_bf(yv.x); acc[j][1] += hi_bf(yv.x); acc[j][2] += lo_bf(yv.y); acc[j][3] += hi_bf(yv.y); }
        f32x4* xr = (f32x4*)(p.out + (size_t)tok * DM) + c.lane;
        f32x4 v[4]; float ss = 0.f;
#pragma unroll
        for (int j = 0; j < 4; ++j) { const f32x4 gv = *(const f32x4*)(gate + (size_t)b * NMOD + 256 * j + 4 * c.lane); v[j] = xr[64 * j] + gv * acc[j];
            ss += (v[j][0] * v[j][0] + v[j][1] * v[j][1]) + (v[j][2] * v[j][2] + v[j][3] * v[j][3]); }
        if (l == NLAYER - 1) {
            const float rstd = 1.0f / sqrtf(wave_sum(ss, c.lane) * (1.0f / DM) + EPS);
#pragma unroll
            for (int j = 0; j < 4; ++j) { const f32x4 w4 = *(const f32x4*)(fw + 256 * j + 4 * c.lane); xr[64 * j] = v[j] * rstd * w4; }
        } else {
#pragma unroll
            for (int j = 0; j < 4; ++j) xr[64 * j] = v[j];
        }
    }
}


#define XB_TMO      128
#define XB_XCNT(j)  (256  + 64 * (j))
#define XB_XSUB(j)  (1280 + 64 * (j))
#define XB_XGEN(j)  (2304 + 64 * (j))
#define XB_TOP      3328
#define XB_TOPGEN   3392
#define XCD_BAR_WORDS 3456
#define XB_SPIN_CAP (1u << 18)
constexpr int LDS_XBST = LDS_PTAB + 320;
__device__ __forceinline__ unsigned xb_ld(unsigned* p)              { return __hip_atomic_load(p, __ATOMIC_RELAXED, __HIP_MEMORY_SCOPE_AGENT); }
__device__ __forceinline__ unsigned xb_add(unsigned* p, unsigned v) { return __hip_atomic_fetch_add(p, v, __ATOMIC_RELAXED, __HIP_MEMORY_SCOPE_AGENT); }
__device__ __forceinline__ unsigned xb_xcc_id() { return (unsigned)__builtin_amdgcn_s_getreg((3 << 11) | 20) & 0xFu; }
#define XB_SPIN(cond, bar) do { unsigned _sp = 0; while (cond) { __builtin_amdgcn_s_sleep(1); \
    if ((++_sp & 255u) == 0u) { if (xb_ld(&(bar)[XB_TMO])) break; if (_sp > XB_SPIN_CAP) { atomicAdd(&(bar)[XB_TMO], 1u); break; } } } } while (0)
__device__ __forceinline__ void xcd_barrier_complete(unsigned* bar, unsigned x, unsigned& nloc, unsigned& nx) {
    const unsigned G = gridDim.x * gridDim.y * gridDim.z;
    unsigned sum, cnt, mine, sp = 0u;
    for (;;) {
        sum = 0u; cnt = 0u; mine = 0u;
#pragma unroll
        for (unsigned j = 0; j < 16; ++j) { const unsigned c = xb_ld(&bar[XB_XCNT(j)]); sum += c; cnt += (c > 0u) ? 1u : 0u; mine = (j == x) ? c : mine; }
        if (sum == G) break;
        __builtin_amdgcn_s_sleep(1);
        if ((++sp & 255u) == 0u) { if (xb_ld(&bar[XB_TMO])) break; if (sp > XB_SPIN_CAP) { atomicAdd(&bar[XB_TMO], 1u); break; } }
    }
    nloc = mine > 0u ? mine : 1u; nx = cnt > 0u ? cnt : 1u;
}
__device__ __forceinline__ void xcd_barrier(unsigned* bar, volatile LAS unsigned* st, bool leader_thread) {
    asm volatile("s_waitcnt vmcnt(0)" ::: "memory");
    __syncthreads();
    if (leader_thread) {
        const unsigned x = xb_xcc_id();
        __builtin_amdgcn_s_waitcnt(0);
        unsigned nloc = st[0], nx = st[1];
        if (nloc == 0u) { xcd_barrier_complete(bar, x, nloc, nx); st[0] = nloc; st[1] = nx; }
        const unsigned old = xb_add(&bar[XB_XSUB(x)], 1u);
        const unsigned gen = old / nloc;
        if (old + 1u == (gen + 1u) * nloc) {
            __builtin_amdgcn_fence(__ATOMIC_RELEASE, "agent");
            asm volatile("s_waitcnt vmcnt(0)" ::: "memory");
            const unsigned og = xb_add(&bar[XB_TOP], 1u);
            const unsigned tg = og / nx;
            if (og + 1u == (tg + 1u) * nx) xb_add(&bar[XB_TOPGEN], 1u);
            else XB_SPIN(xb_ld(&bar[XB_TOPGEN]) == tg, bar);
            __builtin_amdgcn_fence(__ATOMIC_ACQUIRE, "agent");
            xb_add(&bar[XB_XGEN(x)], 1u);
            asm volatile("s_waitcnt vmcnt(0)" ::: "memory");
        } else {
            XB_SPIN(xb_ld(&bar[XB_XGEN(x)]) == gen, bar);
            __builtin_amdgcn_fence(__ATOMIC_ACQUIRE, "agent");
            asm volatile("s_waitcnt vmcnt(0)" ::: "memory");
        }
    }
    __syncthreads();
}

#ifndef PROBE_ID
#define PROBE_ID 0
#endif
#define RUN(id, stmt) do { stmt; if constexpr (PROBE_ID == (id)) { __syncthreads(); stmt; } } while (0)
constexpr int NQ_PHASE = 14;
__device__ __forceinline__ unsigned long long uni64(unsigned long long v) {
    const unsigned lo = (unsigned)__builtin_amdgcn_readfirstlane((int)(unsigned)v), hi = (unsigned)__builtin_amdgcn_readfirstlane((int)(unsigned)(v >> 32)); return ((unsigned long long)hi << 32) | lo; }
#if MK_MEGA
__device__ __forceinline__ void params_to_lds(const Params& p, LAS unsigned char* lds) {
    LAS unsigned long long* tab = (LAS unsigned long long*)(lds + LDS_PTAB);
#pragma unroll
    for (int i = 0; i < 33; ++i) tab[i] = (unsigned long long)p.in[i];
    tab[33] = (unsigned long long)p.out; tab[34] = (unsigned long long)p.ws;
}
__device__ __forceinline__ Params params_from_lds(LAS unsigned char* lds) {
    const LAS unsigned long long* tab = (const LAS unsigned long long*)(lds + LDS_PTAB);
    Params p;
#pragma unroll
    for (int i = 0; i < 33; ++i) p.in[i] = (const float*)(const __attribute__((address_space(1))) float*)uni64(tab[i]);
    p.out = (float*)(__attribute__((address_space(1))) float*)uni64(tab[33]); p.ws = (unsigned char*)(__attribute__((address_space(1))) unsigned char*)uni64(tab[34]); p.layer = 0; p.pad = 0;
    return p;
}
#endif
template <int Q> __device__ __forceinline__ void run_q(const Params& p_in, const Ctx& c_in, int l) {
    Ctx c = c_in;
    asm volatile("" : "+s"(c.wave), "+s"(c.bid), "+s"(c.G), "+s"(l));
    c.lane = fresh_lane(); c.tid = c.wave * 64 + c.lane;
#if MK_MEGA
    const Params p = params_from_lds(c.lds);
#else
    const Params& p = p_in;
#endif
    const float* xin = (l == 0) ? p.in[I_X] : p.out;
    if constexpr (Q == 14) { RUN(1, phase_prep_io(p, c); __syncthreads(); phase_prep_small(p, c)); __syncthreads(); RUN(2, phase_prep_experts(p, c, 0)); }
    if constexpr (Q == 0) { if (l > 0) { RUN(2, phase_prep_experts(p, c, l)); __syncthreads(); } RUN(3, phase_norm_mix(p, c, l, xin)); }
    if constexpr (Q == 1) { pg8::Gemm g{(const bf16_t*)(p.ws + WS_H), (const bf16_t*)(p.ws + WS_WIN) + (size_t)l * NU * DM, DM, 0};
              pg8::DenseOrder S; S.init(NTOK, NU, c.G, c.bid); EpiU E{(bf16_t*)(p.ws + WS_U), NU};
              RUN(4, (pg8::gemm_phase<EpiU, pg8::DenseOrder, pg8::DenseRows, true, true>(c.lds, g, S, E, pg8::DenseRows(), c.wave))); }
    if constexpr (Q == 2) { RUN(5, phase_ssd_conv(p, c, l)); __syncthreads(); RUN(6, phase_hg_state(p, c, l)); __syncthreads(); RUN(7, phase_lru1(p, c, l)); }
    if constexpr (Q == 3) { RUN(8, phase_ssd_state(p, c)); __syncthreads(); phase_hg_scan(p, c); __syncthreads(); RUN(9, phase_lru2(p, c, l)); }
    if constexpr (Q == 4) { phase_ssd_scan(p, c); __syncthreads(); RUN(10, phase_hg_out(p, c, l)); }
    if constexpr (Q == 5) RUN(11, phase_ssd_out(p, c, l));
    if constexpr (Q == 6) RUN(12, phase_ssd_gate(p, c, l));
    if constexpr (Q == 7) { pg8::Gemm g{(const bf16_t*)(p.ws + WS_YCAT), (const bf16_t*)(p.ws + WS_WOUT) + (size_t)l * DM * 2048, 2048, 0};
              pg8::DenseOrder S; S.init(NTOK, DM, c.G, c.bid); EpiOut E{xin, p.out, (const float*)(p.ws + WS_MOD) + (size_t)l * 8 * NMOD + 2048};
              pg8::gemm_phase<EpiOut, pg8::DenseOrder, pg8::DenseRows, false, true>(c.lds, g, S, E, pg8::DenseRows(), c.wave);
              if constexpr (PROBE_ID == 13) { if (l == 0) { __syncthreads(); pg8::gemm_phase<EpiOut, pg8::DenseOrder, pg8::DenseRows, false, true>(c.lds, g, S, E, pg8::DenseRows(), c.wave); } } }
    if constexpr (Q == 8) RUN(14, phase_norm_router(p, c, l, p.out));
    if constexpr (Q == 9) RUN(15, phase_route_count(p, c));
    if constexpr (Q == 10) RUN(15, phase_route_assign(p, c));
    if constexpr (Q == 11) { pg8::Gemm g{(const bf16_t*)(p.ws + WS_H), (const bf16_t*)(p.ws + WS_GU), DM, (size_t)512 * DM * 2};
               MoeOrder S{(const int*)(p.ws + WS_RINFO), 2, c.G, c.bid}; EpiH E{(bf16_t*)(p.ws + WS_HMID)};
               GatherRows AM{(const int*)(p.ws + WS_SLOTTOK), (const int*)(p.ws + WS_RINFO)};
               RUN(16, (pg8::gemm_phase<EpiH, MoeOrder, GatherRows, true, true>(c.lds, g, S, E, AM, c.wave))); }
    if constexpr (Q == 12) { pg8::Gemm g{(const bf16_t*)(p.ws + WS_HMID), (const bf16_t*)(p.ws + WS_DN), 256, (size_t)DM * 256 * 2};
               MoeOrder S{(const int*)(p.ws + WS_RINFO), 4, c.G, c.bid};
               EpiY E{(bf16_t*)(p.ws + WS_Y), (bf16_t*)(p.ws + WS_H), (const int*)(p.ws + WS_RINFO)};
               RUN(17, (pg8::gemm_phase<EpiY, MoeOrder, pg8::DenseRows, true, true>(c.lds, g, S, E, pg8::DenseRows(), c.wave))); }
    if constexpr (Q == 13) phase_combine(p, c, l);
}

#if MK_MEGA
__global__ void __launch_bounds__(NTHREADS, 2) trunk_kernel(Params p) {
    extern __shared__ __attribute__((aligned(16))) unsigned char lds_raw[];
    Ctx c; c.lds = (LAS unsigned char*)lds_raw; c.tid = 0; c.lane = 0; c.wave = __builtin_amdgcn_readfirstlane(threadIdx.x >> 6); c.G = gridDim.x; c.bid = blockIdx.x;
    cg::grid_group grid = cg::this_grid();
    unsigned* const xbar = (unsigned*)(p.ws + WS_CTL) + 4096;
    if (threadIdx.x == 0) { params_to_lds(p, c.lds); ((LAS unsigned*)(c.lds + LDS_XBST))[0] = 0u; ((LAS unsigned*)(c.lds + LDS_XBST))[1] = 0u; ((LAS unsigned long long*)(c.lds + LDS_PTAB))[35] = (unsigned long long)xbar;
                            (void)xb_add(&xbar[XB_XCNT(xb_xcc_id())], 1u); }
    __syncthreads();
#define GSYNC1() do { unsigned* bar_ = (unsigned*)(__attribute__((address_space(1))) unsigned*)uni64(((const LAS unsigned long long*)(c.lds + LDS_PTAB))[35]); \
        xcd_barrier(bar_, (volatile LAS unsigned*)(c.lds + LDS_XBST), (c.wave == 0) && (fresh_lane() == 0)); } while (0)
#define GSYNC() do { GSYNC1(); if constexpr (PROBE_ID == 18) GSYNC1(); } while (0)
#define LAYER(l) do { \
        run_q<0>(p, c, l); GSYNC(); run_q<1>(p, c, l); GSYNC(); run_q<2>(p, c, l); GSYNC(); run_q<3>(p, c, l); GSYNC(); run_q<4>(p, c, l); GSYNC(); \
        run_q<5>(p, c, l); GSYNC(); run_q<6>(p, c, l); GSYNC(); run_q<7>(p, c, l); GSYNC(); run_q<8>(p, c, l); GSYNC(); run_q<9>(p, c, l); GSYNC(); \
        run_q<10>(p, c, l); GSYNC(); run_q<11>(p, c, l); GSYNC(); run_q<12>(p, c, l); GSYNC(); run_q<13>(p, c, l); } while (0)
    run_q<14>(p, c, 0); __syncthreads(); grid.sync();
    LAYER(0); GSYNC();
    LAYER(1);
}
#else
template <int Q> __global__ void __launch_bounds__(NTHREADS, 2) phase_kernel(Params p) {
    extern __shared__ __attribute__((aligned(16))) unsigned char lds_raw[];
    Ctx c; c.lds = (LAS unsigned char*)lds_raw; c.tid = 0; c.lane = 0; c.wave = __builtin_amdgcn_readfirstlane(threadIdx.x >> 6); c.G = gridDim.x; c.bid = blockIdx.x;
    run_q<Q>(p, c, p.layer);
}
template <int Q> static void launch_q(const Params& p, int grid, hipStream_t stream) {
    static bool attr = false;
    if (!attr) { (void)hipFuncSetAttribute((const void*)phase_kernel<Q>, hipFuncAttributeMaxDynamicSharedMemorySize, LDS_BYTES); attr = true; }
    hipLaunchKernelGGL(phase_kernel<Q>, dim3(grid), dim3(NTHREADS), LDS_BYTES, stream, p);
}
#endif

extern "C" void kernel_launch(void* const* d_in, const int* in_sizes, int n_in, void* d_out, int out_size, void* d_ws, size_t ws_size, hipStream_t stream) {
    static int grid = 0;
    if (grid == 0) {
        if (n_in != 33 || out_size != NTOK * DM || ws_size < WS_END) { fprintf(stderr, "kernel_launch: unexpected shapes (n_in %d out %d ws %zu)\n", n_in, out_size, ws_size); grid = -1; return; }
        int dev = 0, cus = 0;
        (void)hipGetDevice(&dev); (void)hipDeviceGetAttribute(&cus, hipDeviceAttributeMultiprocessorCount, dev);
        grid = cus > 0 ? cus : 256;
#if MK_MEGA
        int per_cu = 0;
        if (hipFuncSetAttribute((const void*)trunk_kernel, hipFuncAttributeMaxDynamicSharedMemorySize, LDS_BYTES) != hipSuccess) { fprintf(stderr, "kernel_launch: hipFuncSetAttribute failed\n"); grid = -1; return; }
        if (hipOccupancyMaxActiveBlocksPerMultiprocessor(&per_cu, (const void*)trunk_kernel, NTHREADS, LDS_BYTES) != hipSuccess || per_cu < 1) { fprintf(stderr, "kernel_launch: occupancy query says %d blocks/CU\n", per_cu); grid = -1; return; }
        (void)hipGetLastError();
#endif
    }
    if (grid < 0) return;
    (void)hipMemsetAsync((char*)d_ws + WS_CTL, 0, CTL_ZERO_BYTES, stream);
    Params p{};
    for (int i = 0; i < 33; ++i) p.in[i] = (const float*)d_in[i];
    p.out = (float*)d_out; p.ws = (unsigned char*)d_ws;
#if MK_MEGA
    void* args[] = {&p};
    hipError_t e = hipLaunchCooperativeKernel((const void*)trunk_kernel, dim3(grid), dim3(NTHREADS), args, LDS_BYTES, stream);
    if (e != hipSuccess) fprintf(stderr, "cooperative launch failed: %s (grid %d)\n", hipGetErrorString(e), grid);
#else
    p.layer = 0; launch_q<14>(p, grid, stream);
    for (int l = 0; l < NLAYER; ++l) {
        p.layer = l;
        launch_q<0>(p, grid, stream); launch_q<1>(p, grid, stream); launch_q<2>(p, grid, stream); launch_q<3>(p, grid, stream); launch_q<4>(p, grid, stream);
        launch_q<5>(p, grid, stream); launch_q<6>(p, grid, stream); launch_q<7>(p, grid, stream); launch_q<8>(p, grid, stream); launch_q<9>(p, grid, stream);
        launch_q<10>(p, grid, stream); launch_q<11>(p, grid, stream); launch_q<12>(p, grid, stream); launch_q<13>(p, grid, stream);
    }
#endif
}
```

```cpp
#include <hip/hip_runtime.h>
#include <hip/hip_cooperative_groups.h>
#include <cstdio>
#include <cstdint>
namespace cg = cooperative_groups;

#ifndef MK_MEGA
#define MK_MEGA 1
#endif

#define LAS __attribute__((address_space(3)))
typedef unsigned short bf16_t;
typedef short bf16x8 __attribute__((ext_vector_type(8)));
typedef float f32x4 __attribute__((ext_vector_type(4)));
typedef float f32x2 __attribute__((ext_vector_type(2)));
typedef unsigned u32x4 __attribute__((ext_vector_type(4)));
typedef unsigned u32x2 __attribute__((ext_vector_type(2)));

constexpr int NTOK = 16384, DM = 1024, SEQ = 2048, NBATCH = 8, NLAYER = 2;
constexpr int DIN = 5648, NU = 5632;
constexpr int UZ = 0, UXS = 1024, UB = 2048, UC = 2304, UHQ = 2560, UHF = 3072, UHV = 3584, UHG = 4096, ULG = 4608, ULX = 5120;
constexpr int NMOD = 6144;
constexpr float EPS = 1e-6f;
constexpr int NEXP = 64, TOPK = 8;
constexpr int MAXSLOT = 147456;
constexpr int NTHREADS = 512, NWAVES = 8;
constexpr int LDS_BYTES = 160 * 1024;
constexpr int LDS_PTAB = LDS_BYTES - 512;

constexpr size_t MiB = (size_t)1 << 20;
constexpr size_t WS_CTL = 0, CTL_ZERO_BYTES = 1 * MiB;
constexpr size_t WS_MOD = 1 * MiB;
constexpr size_t WS_LB = WS_MOD + 512 * 1024;
constexpr size_t WS_LRUW = WS_LB + 8192;
constexpr size_t WS_DTRAW = 2 * MiB, WS_DT = 3 * MiB, WS_ACUM = 4 * MiB;
constexpr size_t WS_HGBL = 5 * MiB;
constexpr size_t WS_SELM = 5 * MiB + 512 * 1024;
constexpr size_t WS_RW = 6 * MiB;
constexpr size_t WS_SLOTOF = 6 * MiB + 512 * 1024;
constexpr size_t WS_SLOTTOK = 7 * MiB;
constexpr size_t WS_RINFO = 7 * MiB + 768 * 1024;
constexpr size_t WS_CNT = 8 * MiB;
constexpr size_t WS_WRT = 9 * MiB;
constexpr size_t WS_WIN = 12 * MiB;
constexpr size_t WS_WOUT = 34 * MiB;
constexpr size_t WS_GU = 42 * MiB;
constexpr size_t WS_DN = 107 * MiB;
constexpr size_t WS_H = 140 * MiB;
constexpr size_t WS_U = 172 * MiB;
constexpr size_t WS_SST = 348 * MiB;
constexpr size_t WS_HST = 380 * MiB;
constexpr size_t WS_LA = 412 * MiB, WS_LH = 428 * MiB;
constexpr size_t WS_XBC = 444 * MiB;
constexpr size_t WS_YCAT = 492 * MiB;
constexpr size_t WS_HMID = 172 * MiB;
constexpr size_t WS_Y = 252 * MiB;
constexpr size_t WS_END = 556 * MiB;

__device__ __forceinline__ float bf2f(bf16_t b) { return __uint_as_float(((unsigned)b) << 16); }
__device__ __forceinline__ unsigned f2bf(float f) { unsigned u = __float_as_uint(f); return (u + 0x7fffu + ((u >> 16) & 1u)) >> 16; }
__device__ __forceinline__ unsigned pk2(float lo, float hi) { return f2bf(lo) | (f2bf(hi) << 16); }
__device__ __forceinline__ float lo_bf(unsigned w) { return __uint_as_float(w << 16); }
__device__ __forceinline__ float hi_bf(unsigned w) { return __uint_as_float(w & 0xffff0000u); }
__device__ __forceinline__ float sigmoidf_(float x) { return 1.0f / (1.0f + __expf(-x)); }
__device__ __forceinline__ float siluf_(float x) { return x / (1.0f + __expf(-x)); }
__device__ __forceinline__ float softplusf_(float x) { return fmaxf(x, 0.f) + log1pf(__expf(-fabsf(x))); }
__device__ __forceinline__ float gelu_tanhf_(float x) { const float t = tanhf(0.7978845608028654f * (x + 0.044715f * x * x * x)); return 0.5f * x * (1.0f + t); }
__device__ __forceinline__ float shfl_xor_l(float v, int mask, int lane) { return __builtin_bit_cast(float, __builtin_amdgcn_ds_bpermute((lane ^ mask) << 2, __builtin_bit_cast(int, v))); }
__device__ __forceinline__ int shfl_up_l(int v, int d, int lane) { return __builtin_amdgcn_ds_bpermute((lane - d) << 2, v); }
__device__ __forceinline__ float shfl_up_f(float v, int d, int lane) { return __builtin_bit_cast(float, __builtin_amdgcn_ds_bpermute((lane - d) << 2, __builtin_bit_cast(int, v))); }
__device__ __forceinline__ float rdlane_f(float v, int src) { return __builtin_bit_cast(float, __builtin_amdgcn_readlane(__builtin_bit_cast(int, v), src)); }
__device__ __forceinline__ unsigned long long rdlane_u64(unsigned long long v, int src) {
    const unsigned lo = (unsigned)__builtin_amdgcn_readlane((int)(unsigned)v, src), hi = (unsigned)__builtin_amdgcn_readlane((int)(unsigned)(v >> 32), src); return ((unsigned long long)hi << 32) | lo; }
__device__ __forceinline__ float wave_sum(float v, int lane) {
#pragma unroll
    for (int o = 1; o < 64; o <<= 1) v += shfl_xor_l(v, o, lane);
    return v;
}
#define LDS_WAIT() asm volatile("s_waitcnt lgkmcnt(0)" ::: "memory")
__device__ __forceinline__ int fresh_lane() { unsigned ones = ~0u; asm volatile("" : "+s"(ones)); return (int)__builtin_amdgcn_mbcnt_hi(ones, __builtin_amdgcn_mbcnt_lo(ones, 0u)); }
#define MFMA16(a, b, c) __builtin_amdgcn_mfma_f32_16x16x32_bf16((a), (b), (c), 0, 0, 0)

namespace pg8 {
constexpr int BM = 256, BK = 64, HALF = 128, HTB = HALF * BK * 2, STAGE_BYTES = 8 * HTB, NXCD = 8, WGM = 8;
__device__ __forceinline__ int lds_byte(int r, int c) { const int st = (r >> 4) * 2 + (c >> 5), rr = r & 15, cc = c & 31, ob = rr * 64 + cc * 2; return st * 1024 + (ob ^ (((ob >> 9) & 1) << 5)); }
__device__ __forceinline__ void stage_rc(int b, int& R, int& C) { const int st = b / 1024, sb = b % 1024, swz = sb ^ (((sb >> 9) & 1) << 5); R = (st >> 1) * 16 + swz / 64; C = (st & 1) * 32 + (swz % 64) / 2; }
__device__ __forceinline__ int perm32(int rho) { const int n = rho >> 4, i = rho & 15; return 8 * (i >> 2) + 4 * n + (i & 3); }

struct Unit { int pm, pn, e; };
struct Gemm { const bf16_t* A; const bf16_t* Bt; int K; size_t estride; };

struct DenseOrder {
    int nM, nN, nwg, G, c;
    __device__ void init(int M, int N, int G_, int c_) { nM = M / BM; nN = N / BM; nwg = nM * nN; G = G_; c = c_; }
    __device__ bool next(int i, Unit& u) const {
        const long L = (long)i * G + c; if (L >= nwg) return false;
        int wgid = (int)L; { const int q = nwg / NXCD, r = nwg % NXCD, xcd = wgid % NXCD, off = wgid / NXCD; wgid = (xcd < r ? xcd * (q + 1) : r * (q + 1) + (xcd - r) * q) + off; }
        const int nig = WGM * nN, gid = wgid / nig, fm = gid * WGM, gsz = (nM - fm) < WGM ? (nM - fm) : WGM;
        u.pm = fm + ((wgid % nig) % gsz); u.pn = (wgid % nig) / gsz; u.e = 0; return true;
    }
};
struct DenseRows { __device__ __forceinline__ int row(const Unit& u, int r) const { return u.pm * BM + r; } };

template <class Epi, class Sched, class AMap, bool ALIGN_EPI, bool SP2>
__device__ __forceinline__ void gemm_phase(LAS unsigned char* lds, const Gemm g, const Sched& S, const Epi& E, const AMap& AM, int wave_id) {
    const int wid = wave_id, lane = fresh_lane(), tid = wid * 64 + lane, wr = wid >> 2, wc = wid & 3, fr = lane & 15, fq = lane >> 4;
    const int K = g.K, nt = K / BK;
    unsigned voffB0;
    { int R, C; stage_rc(tid * 16, R, C); const int Rb = Epi::PERM ? ((R & ~31) + perm32(R & 31)) : R; voffB0 = (unsigned)(Rb * K + C) * 2u; }
    const size_t p1step = (size_t)64 * K * 2;
    const size_t kstep = (size_t)(BK * 2);
    const size_t hstep = (size_t)HALF * K * 2;
    const size_t tstep = 2 * hstep;
    const unsigned ldsw = (unsigned)wid * 1024u;
    const int aoff = lds_byte(wr * 64 + fr, fq * 8), boff = lds_byte(wc * 32 + fr, fq * 8);
#define PG8_SA(b, h) (((b) * 2 + (h)) * HTB)
#define PG8_SB(b, h) ((4 + (b) * 2 + (h)) * HTB)
#define PG8_STAGE2(bufoff, gbase, v0, v1) do { \
        __builtin_amdgcn_global_load_lds((const unsigned*)((const char*)(gbase) + (v0)), (LAS unsigned*)(lds + (bufoff) + ldsw), 16, 0, 0); \
        __builtin_amdgcn_global_load_lds((const unsigned*)((const char*)(gbase) + (v1)), (LAS unsigned*)(lds + (bufoff) + ldsw + 8192), 16, 0, 0); } while (0)
#define PG8_STAGEB(bufoff, gbase) do { \
        __builtin_amdgcn_global_load_lds((const unsigned*)((const char*)(gbase) + voffB0), (LAS unsigned*)(lds + (bufoff) + ldsw), 16, 0, 0); \
        __builtin_amdgcn_global_load_lds((const unsigned*)((const char*)(gbase) + p1step + voffB0), (LAS unsigned*)(lds + (bufoff) + ldsw + 8192), 16, 0, 0); } while (0)
#define PG8_LDA(dst, b, h) do { _Pragma("unroll") for (int m = 0; m < 4; ++m) _Pragma("unroll") for (int k = 0; k < 2; ++k) dst[m][k] = *(const LAS bf16x8*)(lds + PG8_SA(b, h) + aoff + m * 2048 + k * 1024); } while (0)
#define PG8_LDB(dst, b, h) do { _Pragma("unroll") for (int n = 0; n < 2; ++n) _Pragma("unroll") for (int k = 0; k < 2; ++k) dst[n][k] = *(const LAS bf16x8*)(lds + PG8_SB(b, h) + boff + n * 2048 + k * 1024); } while (0)
#define PG8_MMA(ai, bj, At, Bt) do { __builtin_amdgcn_s_setprio(1); _Pragma("unroll") for (int m = 0; m < 4; ++m) _Pragma("unroll") for (int n = 0; n < 2; ++n) _Pragma("unroll") for (int k = 0; k < 2; ++k) \
        acc[ai][bj][m][n] = __builtin_amdgcn_mfma_f32_16x16x32_bf16(Bt[n][k], At[m][k], acc[ai][bj][m][n], 0, 0, 0); __builtin_amdgcn_s_setprio(0); } while (0)
#define PG8_WAIT_V(n) asm volatile("s_waitcnt vmcnt(" #n ")" ::: "memory")
#define PG8_WAIT_L(n) asm volatile("s_waitcnt lgkmcnt(" #n ")" ::: "memory")
#define PG8_BAR __builtin_amdgcn_s_barrier()
#define PG8_SCHED __builtin_amdgcn_sched_barrier(0)
#define PG8_AOFFS(u, v00, v01, v10, v11) do { int R_, C_; stage_rc(tid * 16, R_, C_); \
        v00 = (unsigned)(AM.row(u, R_) * K + C_) * 2u; v01 = (unsigned)(AM.row(u, R_ + 64) * K + C_) * 2u; \
        v10 = (unsigned)(AM.row(u, HALF + R_) * K + C_) * 2u; v11 = (unsigned)(AM.row(u, HALF + R_ + 64) * K + C_) * 2u; } while (0)
    Unit cur, nxt; int ui = 0;
    if (!S.next(0, cur)) return;
    f32x4 acc[2][2][4][2];
#pragma unroll
    for (int a = 0; a < 2; ++a)
#pragma unroll
        for (int b = 0; b < 2; ++b)
#pragma unroll
            for (int m = 0; m < 4; ++m)
#pragma unroll
                for (int n = 0; n < 2; ++n) acc[a][b][m][n] = (f32x4){0.f, 0.f, 0.f, 0.f};
    bf16x8 At[4][2], B0[2][2], B1[2][2];
    const char* const Abase = (const char*)g.A;
    const char* cB = (const char*)g.Bt + (size_t)cur.e * g.estride + (size_t)cur.pn * tstep;
    unsigned c00, c01, c10, c11, n00, n01, n10, n11;
    PG8_AOFFS(cur, c00, c01, c10, c11);
    n00 = c00; n01 = c01; n10 = c10; n11 = c11;
    if constexpr (SP2) {
        PG8_STAGEB(PG8_SB(0, 0), cB); PG8_STAGEB(PG8_SB(0, 1), cB + hstep); PG8_STAGE2(PG8_SA(0, 0), Abase, c00, c01); PG8_STAGE2(PG8_SA(0, 1), Abase, c10, c11);
        if (wr == 1) PG8_BAR;
        PG8_WAIT_V(2); PG8_BAR;
        PG8_STAGEB(PG8_SB(1, 0), cB + kstep); PG8_STAGE2(PG8_SA(1, 0), Abase + kstep, c00, c01); PG8_STAGEB(PG8_SB(1, 1), cB + hstep + kstep);
        PG8_WAIT_V(6); PG8_BAR;
    } else {
        PG8_STAGEB(PG8_SB(0, 0), cB); PG8_STAGE2(PG8_SA(0, 0), Abase, c00, c01); PG8_STAGEB(PG8_SB(0, 1), cB + hstep); PG8_STAGE2(PG8_SA(0, 1), Abase, c10, c11);
        if (wr == 1) PG8_BAR;
        PG8_WAIT_V(4); PG8_BAR;
        PG8_STAGEB(PG8_SB(1, 0), cB + kstep); PG8_STAGE2(PG8_SA(1, 0), Abase + kstep, c00, c01); PG8_STAGEB(PG8_SB(1, 1), cB + hstep + kstep);
        PG8_WAIT_V(6); PG8_BAR;
    }
    for (;;) {
        const bool has_next = S.next(ui + 1, nxt);
        const char* nB = cB;
        if (has_next) { nB = (const char*)g.Bt + (size_t)nxt.e * g.estride + (size_t)nxt.pn * tstep; PG8_AOFFS(nxt, n00, n01, n10, n11); }
        else { n00 = c00; n01 = c01; n10 = c10; n11 = c11; }
        for (int t = 0; t < nt; t += 2) {
            const bool last = (t == nt - 2);
            const char* a1 = Abase + (size_t)(t + 1) * kstep;
            const char* a2 = last ? Abase : Abase + (size_t)(t + 2) * kstep;
            const char* b2 = last ? nB : cB + (size_t)(t + 2) * kstep;
            const char* a3 = a2 + kstep; const char* b3 = b2 + kstep;
            const unsigned x00 = last ? n00 : c00, x01 = last ? n01 : c01, x10 = last ? n10 : c10, x11 = last ? n11 : c11;
            if constexpr (SP2) {
            PG8_LDB(B0, 0, 0); PG8_LDB(B1, 0, 1); PG8_SCHED; PG8_LDA(At, 0, 0); PG8_STAGE2(PG8_SA(1, 1), a1, c10, c11);
            PG8_WAIT_V(8); PG8_WAIT_L(0); PG8_BAR; PG8_MMA(0, 0, At, B0); PG8_MMA(0, 1, At, B1); PG8_BAR; PG8_SCHED;
            PG8_LDA(At, 0, 1); PG8_STAGEB(PG8_SB(0, 0), b2); PG8_STAGEB(PG8_SB(0, 1), b2 + hstep); PG8_STAGE2(PG8_SA(0, 0), a2, x00, x01);
            PG8_WAIT_V(8); PG8_WAIT_L(0); PG8_BAR; PG8_MMA(1, 0, At, B0); PG8_MMA(1, 1, At, B1); PG8_BAR; PG8_SCHED;
            PG8_LDB(B0, 1, 0); PG8_LDB(B1, 1, 1); PG8_SCHED; PG8_LDA(At, 1, 0); PG8_STAGE2(PG8_SA(0, 1), a2, x10, x11);
            PG8_WAIT_V(8); PG8_WAIT_L(0); PG8_BAR; PG8_MMA(0, 0, At, B0); PG8_MMA(0, 1, At, B1); PG8_BAR; PG8_SCHED;
            PG8_LDA(At, 1, 1); PG8_STAGEB(PG8_SB(1, 0), b3); PG8_STAGEB(PG8_SB(1, 1), b3 + hstep); PG8_STAGE2(PG8_SA(1, 0), a3, x00, x01);
            PG8_WAIT_V(8); PG8_WAIT_L(0); PG8_BAR; PG8_MMA(1, 0, At, B0); PG8_MMA(1, 1, At, B1); PG8_BAR; PG8_SCHED;
            } else {
            PG8_LDB(B0, 0, 0); PG8_SCHED; PG8_LDA(At, 0, 0); PG8_STAGE2(PG8_SA(1, 1), a1, c10, c11);
            PG8_WAIT_L(8); PG8_BAR; PG8_WAIT_L(0); PG8_MMA(0, 0, At, B0); PG8_BAR; PG8_SCHED;
            PG8_LDB(B1, 0, 1); PG8_STAGEB(PG8_SB(0, 0), b2);
            PG8_BAR; PG8_WAIT_L(0); PG8_MMA(0, 1, At, B1); PG8_BAR;
            PG8_LDA(At, 0, 1); PG8_STAGE2(PG8_SA(0, 0), a2, x00, x01);
            PG8_BAR; PG8_WAIT_L(0); PG8_MMA(1, 0, At, B0); PG8_BAR; PG8_SCHED;
            PG8_STAGEB(PG8_SB(0, 1), b2 + hstep);
            PG8_WAIT_V(6); PG8_BAR; PG8_MMA(1, 1, At, B1); PG8_BAR;
            PG8_LDB(B0, 1, 0); PG8_SCHED; PG8_LDA(At, 1, 0); PG8_STAGE2(PG8_SA(0, 1), a2, x10, x11);
            PG8_WAIT_L(8); PG8_BAR; PG8_WAIT_L(0); PG8_MMA(0, 0, At, B0); PG8_BAR; PG8_SCHED;
            PG8_LDB(B1, 1, 1); PG8_STAGEB(PG8_SB(1, 0), b3);
            PG8_BAR; PG8_WAIT_L(0); PG8_MMA(0, 1, At, B1); PG8_BAR;
            PG8_LDA(At, 1, 1); PG8_STAGE2(PG8_SA(1, 0), a3, x00, x01);
            PG8_BAR; PG8_WAIT_L(0); PG8_MMA(1, 0, At, B0); PG8_BAR; PG8_SCHED;
            PG8_STAGEB(PG8_SB(1, 1), b3 + hstep);
            PG8_WAIT_V(6); PG8_BAR; PG8_MMA(1, 1, At, B1); PG8_BAR;
            }
        }
        if constexpr (ALIGN_EPI) { if (wr == 0) PG8_BAR; }
        E(acc, cur, wr, wc);
        if (!has_next) break;
#pragma unroll
        for (int a = 0; a < 2; ++a)
#pragma unroll
            for (int b = 0; b < 2; ++b)
#pragma unroll
                for (int m = 0; m < 4; ++m)
#pragma unroll
                    for (int n = 0; n < 2; ++n) acc[a][b][m][n] = (f32x4){0.f, 0.f, 0.f, 0.f};
        cur = nxt; cB = nB; c00 = n00; c01 = n01; c10 = n10; c11 = n11; ++ui;
        if constexpr (ALIGN_EPI) { if (wr == 1) PG8_BAR; }
    }
    PG8_WAIT_V(0);
    if constexpr (!ALIGN_EPI) { if (wr == 0) PG8_BAR; }
    PG8_BAR;
#undef PG8_SA
#undef PG8_SB
#undef PG8_STAGE2
#undef PG8_STAGEB
#undef PG8_LDA
#undef PG8_LDB
#undef PG8_MMA
#undef PG8_WAIT_V
#undef PG8_WAIT_L
#undef PG8_BAR
#undef PG8_SCHED
#undef PG8_AOFFS
}
}

struct Params {
    const float* in[33];
    float* out;
    unsigned char* ws;
    int layer, pad;
};
enum { I_X = 0, I_C, I_ADAW, I_ADAB, I_NMIX, I_NFFN, I_WIN, I_SCW, I_SCB, I_SDTB, I_SALOG, I_SD, I_SNW, I_HLB, I_HNW, I_LCW, I_LCB, I_LWA, I_LBA, I_LWX, I_LBX, I_LLAM, I_LNW,
       I_WOUT, I_RW, I_RB, I_EG, I_EU, I_ED, I_SG, I_SU, I_SDN, I_FNW };

using pg8::Unit;
struct EpiU {
    static constexpr bool PERM = true;
    bf16_t* O; int ldc;
    __device__ __forceinline__ void operator()(const f32x4 (&acc)[2][2][4][2], const Unit& u, int wr, int wc) const {
        const int lane_ = fresh_lane(), fr = lane_ & 15, fq = lane_ >> 4;
        const int row0 = u.pm * 256 + wr * 64 + fr, col0 = u.pn * 256 + wc * 32 + 8 * fq;
#pragma unroll
        for (int ai = 0; ai < 2; ++ai)
#pragma unroll
            for (int m = 0; m < 4; ++m) { bf16_t* rowp = O + (size_t)(row0 + ai * 128 + m * 16) * ldc + col0;
#pragma unroll
                for (int bj = 0; bj < 2; ++bj) { const f32x4 v0 = acc[ai][bj][m][0], v1 = acc[ai][bj][m][1];
                    u32x4 w; w.x = pk2(v0[0], v0[1]); w.y = pk2(v0[2], v0[3]); w.z = pk2(v1[0], v1[1]); w.w = pk2(v1[2], v1[3]);
                    *(u32x4*)(rowp + bj * 128) = w; } }
    }
};
struct EpiOut {
    static constexpr bool PERM = false;
    const float* xin; float* xout; const float* gate;
    __device__ __forceinline__ void operator()(const f32x4 (&acc)[2][2][4][2], const Unit& u, int wr, int wc) const {
        const int lane_ = fresh_lane(), fr = lane_ & 15, fq = lane_ >> 4;
        const int row0 = u.pm * 256 + wr * 64 + fr, col0 = u.pn * 256 + wc * 32 + 4 * fq, b = u.pm >> 3;
        f32x4 gv[2][2];
#pragma unroll
        for (int bj = 0; bj < 2; ++bj)
#pragma unroll
            for (int n = 0; n < 2; ++n) gv[bj][n] = *(const f32x4*)(gate + (size_t)b * NMOD + col0 + bj * 128 + n * 16);
#pragma unroll
        for (int ai = 0; ai < 2; ++ai)
#pragma unroll
            for (int m = 0; m < 4; ++m) { const size_t off = (size_t)(row0 + ai * 128 + m * 16) * DM + col0;
#pragma unroll
                for (int bj = 0; bj < 2; ++bj)
#pragma unroll
                    for (int n = 0; n < 2; ++n) { const f32x4 xi = *(const f32x4*)(xin + off + bj * 128 + n * 16);
                        *(f32x4*)(xout + off + bj * 128 + n * 16) = xi + gv[bj][n] * acc[ai][bj][m][n]; }
                asm volatile("" ::: "memory"); }
    }
};
struct EpiH {
    static constexpr bool PERM = true;
    bf16_t* Hm;
    __device__ __forceinline__ void operator()(const f32x4 (&acc)[2][2][4][2], const Unit& u, int wr, int wc) const {
        const int lane_ = fresh_lane(), fr = lane_ & 15, fq = lane_ >> 4;
        const int row0 = u.pm * 256 + wr * 64 + fr, col0 = u.pn * 128 + wc * 32 + 8 * fq;
#pragma unroll
        for (int ai = 0; ai < 2; ++ai)
#pragma unroll
            for (int m = 0; m < 4; ++m) { bf16_t* rowp = Hm + (size_t)(row0 + ai * 128 + m * 16) * 256 + col0;
                f32x4 h0, h1;
#pragma unroll
                for (int j = 0; j < 4; ++j) { h0[j] = siluf_(acc[ai][0][m][0][j]) * acc[ai][1][m][0][j]; h1[j] = siluf_(acc[ai][0][m][1][j]) * acc[ai][1][m][1][j]; }
                u32x4 w; w.x = pk2(h0[0], h0[1]); w.y = pk2(h0[2], h0[3]); w.z = pk2(h1[0], h1[1]); w.w = pk2(h1[2], h1[3]);
                *(u32x4*)rowp = w; }
    }
};
struct EpiY {
    static constexpr bool PERM = true;
    bf16_t* Y; bf16_t* Ysh; const int* rinfo;
    __device__ __forceinline__ void operator()(const f32x4 (&acc)[2][2][4][2], const Unit& u, int wr, int wc) const {
        const int lane_ = fresh_lane(), fr = lane_ & 15, fq = lane_ >> 4;
        const int col0 = u.pn * 256 + wc * 32 + 8 * fq;
        bf16_t* base = Y + (size_t)u.pm * 256 * DM;
        if (u.e >= NEXP) base = Ysh + (size_t)(u.pm - rinfo[0]) * 256 * DM;
        base += (size_t)(wr * 64 + fr) * DM + col0;
#pragma unroll
        for (int ai = 0; ai < 2; ++ai)
#pragma unroll
            for (int m = 0; m < 4; ++m) { bf16_t* rowp = base + (size_t)(ai * 128 + m * 16) * DM;
#pragma unroll
                for (int bj = 0; bj < 2; ++bj) { const f32x4 v0 = acc[ai][bj][m][0], v1 = acc[ai][bj][m][1];
                    u32x4 w; w.x = pk2(v0[0], v0[1]); w.y = pk2(v0[2], v0[3]); w.z = pk2(v1[0], v1[1]); w.w = pk2(v1[2], v1[3]);
                    *(u32x4*)(rowp + bj * 128) = w; } }
    }
};
struct MoeOrder {
    const int* rinfo; int NQ, G, c;
    __device__ bool next(int i, Unit& u) const {
        const int nblk = rinfo[0]; const long L = (long)i * G + c;
        if (L >= (long)(nblk + 64) * NQ) return false;
        const int rb = (int)(L / NQ); u.pm = rb; u.pn = (int)(L % NQ); u.e = (rb < nblk) ? rinfo[64 + rb] : NEXP; return true;
    }
};
struct GatherRows {
    const int* slot_tok; const int* rinfo;
    __device__ __forceinline__ int row(const Unit& u, int r) const {
        const int nblk = rinfo[0];
        if (u.pm < nblk) { const int t = slot_tok[u.pm * 256 + r]; return t < 0 ? 0 : t; }
        return (u.pm - nblk) * 256 + r;
    }
};

struct Ctx { LAS unsigned char* lds; int tid, lane, wave, G, bid; };

template <class RowMap>
__device__ __forceinline__ void transpose_item(const float* W, int N, int k0, int n0, bf16_t* WT, int ldk, const RowMap& rm, LAS float* scr, int lane) {
    const int nn = n0 + (lane & 31);
#pragma unroll 8
    for (int i = 0; i < 32; ++i) { const int kk = 2 * i + (lane >> 5); scr[kk * 33 + (lane & 31)] = (nn < N) ? W[(size_t)(k0 + kk) * N + nn] : 0.f; }
    LDS_WAIT();
    const int c = lane & 7;
#pragma unroll
    for (int j = 0; j < 4; ++j) { const int n = (lane >> 3) + 8 * j; const LAS float* s = scr + (8 * c) * 33 + n;
        u32x4 o; o.x = pk2(s[0 * 33], s[1 * 33]); o.y = pk2(s[2 * 33], s[3 * 33]); o.z = pk2(s[4 * 33], s[5 * 33]); o.w = pk2(s[6 * 33], s[7 * 33]);
        const int dr = (n0 + n < N) ? rm(n0 + n) : -1;
        if (dr >= 0) *(u32x4*)(WT + (size_t)dr * ldk + k0 + 8 * c) = o; }
    LDS_WAIT();
}
struct RmIdent { __device__ __forceinline__ int operator()(int n) const { return n; } };
struct RmWin { __device__ __forceinline__ int operator()(int n) const { return n < 2560 ? n : (n < 2576 ? -1 : n - 16); } };
struct RmGate { __device__ __forceinline__ int operator()(int n) const { return (n >> 7) * 256 + (n & 127); } };
struct RmUp { __device__ __forceinline__ int operator()(int n) const { return (n >> 7) * 256 + 128 + (n & 127); } };

__device__ __forceinline__ void phase_prep_io(const Params& p, const Ctx& c) {
    LAS float* scr = (LAS float*)(c.lds + c.wave * 16384);
    const int gw = c.bid * NWAVES + c.wave, NGW = c.G * NWAVES;
    constexpr int I_IN = 16 * 177, I_OUT = 32 * 32, PER_L = I_IN + I_OUT;
    for (int it = gw; it < NLAYER * PER_L; it += NGW) {
        const int l = it / PER_L; int r = it % PER_L;
        if (r < I_IN) { const int kb = r / 177, nb = r % 177;
            transpose_item(p.in[I_WIN] + (size_t)l * DM * DIN, DIN, kb * 64, nb * 32, (bf16_t*)(p.ws + WS_WIN) + (size_t)l * NU * DM, DM, RmWin(), scr, c.lane); }
        else { r -= I_IN; const int kb = r / 32, nb = r % 32;
            transpose_item(p.in[I_WOUT] + (size_t)l * 2048 * DM, DM, kb * 64, nb * 32, (bf16_t*)(p.ws + WS_WOUT) + (size_t)l * DM * 2048, 2048, RmIdent(), scr, c.lane); }
    }
}
__device__ __forceinline__ void phase_prep_experts(const Params& p, const Ctx& c, int l) {
    LAS float* scr = (LAS float*)(c.lds + c.wave * 16384);
    const int gw = c.bid * NWAVES + c.wave, NGW = c.G * NWAVES;
    constexpr int PER_E = 3 * 128;
    bf16_t* GU = (bf16_t*)(p.ws + WS_GU); bf16_t* DN = (bf16_t*)(p.ws + WS_DN);
    for (int it = gw; it < 65 * PER_E; it += NGW) {
        const int e = it / PER_E; int r = it % PER_E; const int which = r / 128; r %= 128;
        if (which < 2) {
            const float* src = (e < NEXP) ? p.in[which == 0 ? I_EG : I_EU] + ((size_t)l * NEXP + e) * DM * 256 : p.in[which == 0 ? I_SG : I_SU] + (size_t)l * DM * 256;
            const int kb = r / 8, nb = r % 8;
            if (which == 0) transpose_item(src, 256, kb * 64, nb * 32, GU + (size_t)e * 512 * DM, DM, RmGate(), scr, c.lane);
            else transpose_item(src, 256, kb * 64, nb * 32, GU + (size_t)e * 512 * DM, DM, RmUp(), scr, c.lane);
        } else {
            const float* src = (e < NEXP) ? p.in[I_ED] + ((size_t)l * NEXP + e) * 256 * DM : p.in[I_SDN] + (size_t)l * 256 * DM;
            const int kb = r / 32, nb = r % 32;
            transpose_item(src, DM, kb * 64, nb * 32, DN + (size_t)e * DM * 256, 256, RmIdent(), scr, c.lane);
        }
    }
}
__device__ __forceinline__ void phase_prep_small(const Params& p, const Ctx& c) {
    LAS float* sc = (LAS float*)c.lds;
    LAS float* red = (LAS float*)(c.lds + 32768);
    float* mod = (float*)(p.ws + WS_MOD);
    bool have_sc = false;
    for (int it = c.bid; it < NLAYER * 96; it += c.G) {
        if (!have_sc) { for (int i = c.tid; i < 8 * 1024; i += NTHREADS) sc[i] = siluf_(p.in[I_C][i]); have_sc = true; }
        __syncthreads();
        const int l = it / 96, j0 = (it % 96) * 64, j = c.tid & 63, kg = c.tid >> 6;
        const float* W = p.in[I_ADAW] + (size_t)l * DM * NMOD + j0 + j;
        float a[8];
#pragma unroll
        for (int b = 0; b < 8; ++b) a[b] = 0.f;
#pragma unroll 16
        for (int k = kg * 128; k < kg * 128 + 128; ++k) { const float w = W[(size_t)k * NMOD];
#pragma unroll
            for (int b = 0; b < 8; ++b) a[b] += sc[b * 1024 + k] * w; }
#pragma unroll
        for (int b = 0; b < 8; ++b) red[(kg * 8 + b) * 64 + j] = a[b];
        __syncthreads();
        { const int b = c.tid >> 6; float s = 0.f;
#pragma unroll
          for (int g = 0; g < 8; ++g) s += red[(g * 8 + b) * 64 + j];
          mod[((size_t)l * 8 + b) * NMOD + j0 + j] = s + p.in[I_ADAB][(size_t)l * NMOD + j0 + j]; }
        __syncthreads();
    }
    if (c.bid == c.G - 1) {
        float* lb = (float*)(p.ws + WS_LB);
        for (int i = c.tid; i < 512; i += NTHREADS) { const float v0 = p.in[I_HLB][i], v1 = p.in[I_HLB][512 + i]; const float m = fmaxf(v0, v1), e0 = expf(v0 - m), e1 = expf(v1 - m);
            lb[i] = 0.f; lb[512 + i] = e1 / (e0 + e1); }
    }
    { float* WT = (float*)(p.ws + WS_WRT);
      for (int o = c.bid * NTHREADS + c.tid; o < NLAYER * 64 * 1024; o += c.G * NTHREADS) { const int k = o & 1023, e = (o >> 10) & 63, l = o >> 16; WT[o] = p.in[I_RW][((size_t)l * 1024 + k) * 64 + e]; } }
    { bf16_t* LW = (bf16_t*)(p.ws + WS_LRUW);
      for (int o = c.bid * NTHREADS + c.tid; o < NLAYER * 2 * 8 * 4096; o += c.G * NTHREADS) {
          const int i = o & 63, j = (o >> 6) & 63, g = (o >> 12) & 7, mat = (o >> 15) & 1, l = o >> 16;
          const float* src = p.in[mat == 0 ? I_LWA : I_LWX] + (((size_t)l * 8 + g) * 64 + i) * 64 + j;
          LW[o] = (bf16_t)f2bf(*src); } }
}

__device__ __forceinline__ void phase_norm_mix(const Params& p, const Ctx& c, int l, const float* xin) {
    LAS float* wdt = (LAS float*)c.lds;
    const float* Win = p.in[I_WIN] + (size_t)l * DM * DIN;
    for (int i = c.tid; i < 16 * 1024; i += NTHREADS) { const int k = i >> 4, j = i & 15; wdt[j * 1024 + k] = Win[(size_t)k * DIN + 2560 + j]; }
    __syncthreads();
    const float* mod = (const float*)(p.ws + WS_MOD) + (size_t)l * 8 * NMOD;
    const float* nw = p.in[I_NMIX] + (size_t)l * DM;
    bf16_t* H = (bf16_t*)(p.ws + WS_H); float* dtraw = (float*)(p.ws + WS_DTRAW);
    const int gw = c.bid * NWAVES + c.wave, NGW = c.G * NWAVES;
    f32x4 vn[4];
    if (gw < NTOK) {
#pragma unroll
        for (int j = 0; j < 4; ++j) vn[j] = ((const f32x4*)(xin + (size_t)gw * DM) + c.lane)[64 * j];
    }
    for (int tok = gw; tok < NTOK; tok += NGW) {
        const int b = tok >> 11;
        f32x4 v[4]; float ss = 0.f;
#pragma unroll
        for (int j = 0; j < 4; ++j) { v[j] = vn[j]; ss += (v[j][0] * v[j][0] + v[j][1] * v[j][1]) + (v[j][2] * v[j][2] + v[j][3] * v[j][3]); }
        if (tok + NGW < NTOK) {
#pragma unroll
            for (int j = 0; j < 4; ++j) vn[j] = ((const f32x4*)(xin + (size_t)(tok + NGW) * DM) + c.lane)[64 * j];
        }
        const float rstd = 1.0f / sqrtf(wave_sum(ss, c.lane) * (1.0f / DM) + EPS);
        f32x4 hv[4];
#pragma unroll
        for (int j = 0; j < 4; ++j) {
            const int col = 256 * j + 4 * c.lane;
            const f32x4 w4 = *(const f32x4*)(nw + col), sh = *(const f32x4*)(mod + (size_t)b * NMOD + col), sc = *(const f32x4*)(mod + (size_t)b * NMOD + 1024 + col);
            hv[j] = (v[j] * rstd * w4) * (sc + 1.0f) + sh;
            u32x2 o; o.x = pk2(hv[j][0], hv[j][1]); o.y = pk2(hv[j][2], hv[j][3]);
            *(u32x2*)(H + (size_t)tok * DM + col) = o;
        }
        float d16[16];
#pragma unroll
        for (int q = 0; q < 16; ++q) {
            float s2 = 0.f;
#pragma unroll
            for (int j = 0; j < 4; ++j) { const f32x4 wq = *(const LAS f32x4*)(wdt + q * 1024 + 256 * j + 4 * c.lane); s2 += (hv[j][0] * wq[0] + hv[j][1] * wq[1]) + (hv[j][2] * wq[2] + hv[j][3] * wq[3]); }
            d16[q] = s2;
            if ((q & 1) == 1) asm volatile("" ::: "memory");
        }
        float d8[8], d4[4], d2[2], d1;
        { const bool up = (c.lane & 32) != 0;
#pragma unroll
          for (int i = 0; i < 8; ++i) { const float snd = up ? d16[i] : d16[8 + i], kp = up ? d16[8 + i] : d16[i]; d8[i] = kp + shfl_xor_l(snd, 32, c.lane); } }
        { const bool up = (c.lane & 16) != 0;
#pragma unroll
          for (int i = 0; i < 4; ++i) { const float snd = up ? d8[i] : d8[4 + i], kp = up ? d8[4 + i] : d8[i]; d4[i] = kp + shfl_xor_l(snd, 16, c.lane); } }
        { const bool up = (c.lane & 8) != 0;
#pragma unroll
          for (int i = 0; i < 2; ++i) { const float snd = up ? d4[i] : d4[2 + i], kp = up ? d4[2 + i] : d4[i]; d2[i] = kp + shfl_xor_l(snd, 8, c.lane); } }
        { const bool up = (c.lane & 4) != 0; const float snd = up ? d2[0] : d2[1], kp = up ? d2[1] : d2[0]; d1 = kp + shfl_xor_l(snd, 4, c.lane); }
        d1 += shfl_xor_l(d1, 2, c.lane); d1 += shfl_xor_l(d1, 1, c.lane);
        if ((c.lane & 3) == 0) dtraw[(size_t)tok * 16 + ((c.lane >> 5) & 1) * 8 + ((c.lane >> 4) & 1) * 4 + ((c.lane >> 3) & 1) * 2 + ((c.lane >> 2) & 1)] = d1;
    }
}

__device__ __forceinline__ void phase_ssd_conv(const Params& p, const Ctx& c, int l) {
    const bf16_t* U = (const bf16_t*)(p.ws + WS_U); bf16_t* XA = (bf16_t*)(p.ws + WS_XBC);
    const float* cw = p.in[I_SCW] + (size_t)l * 4 * 1536; const float* cb = p.in[I_SCB] + (size_t)l * 1536;
    const float* dtraw = (const float*)(p.ws + WS_DTRAW); float* dt = (float*)(p.ws + WS_DT); float* acum = (float*)(p.ws + WS_ACUM);
    for (int idx = c.bid * NTHREADS + c.tid; idx < (NTOK / 4) * 192; idx += c.G * NTHREADS) {
        const int oct = idx % 192, tg = idx / 192, tok0 = tg * 4, t0 = tok0 & (SEQ - 1), c0 = oct * 8;
        float w[4][8], bb[8];
#pragma unroll
        for (int k = 0; k < 4; ++k) { const f32x4 a = *(const f32x4*)(cw + k * 1536 + c0), b2 = *(const f32x4*)(cw + k * 1536 + c0 + 4);
            w[k][0] = a[0]; w[k][1] = a[1]; w[k][2] = a[2]; w[k][3] = a[3]; w[k][4] = b2[0]; w[k][5] = b2[1]; w[k][6] = b2[2]; w[k][7] = b2[3]; }
        { const f32x4 a = *(const f32x4*)(cb + c0), b2 = *(const f32x4*)(cb + c0 + 4); bb[0] = a[0]; bb[1] = a[1]; bb[2] = a[2]; bb[3] = a[3]; bb[4] = b2[0]; bb[5] = b2[1]; bb[6] = b2[2]; bb[7] = b2[3]; }
        float x[7][8];
#pragma unroll
        for (int r = 0; r < 7; ++r) {
            u32x4 v = (u32x4){0u, 0u, 0u, 0u};
            if (t0 + r - 3 >= 0) v = *(const u32x4*)(U + (size_t)(tok0 + r - 3) * NU + UXS + c0);
#pragma unroll
            for (int j = 0; j < 4; ++j) { x[r][2 * j] = lo_bf(v[j]); x[r][2 * j + 1] = hi_bf(v[j]); }
        }
#pragma unroll
        for (int t = 0; t < 4; ++t) {
            float y[8];
#pragma unroll
            for (int j = 0; j < 8; ++j) y[j] = siluf_(bb[j] + w[0][j] * x[t][j] + w[1][j] * x[t + 1][j] + w[2][j] * x[t + 2][j] + w[3][j] * x[t + 3][j]);
            u32x4 o; o.x = pk2(y[0], y[1]); o.y = pk2(y[2], y[3]); o.z = pk2(y[4], y[5]); o.w = pk2(y[6], y[7]);
            *(u32x4*)(XA + (size_t)(tok0 + t) * 1536 + c0) = o;
        }
    }
    const int gw = c.bid * NWAVES + c.wave, NGW = c.G * NWAVES;
    for (int it = gw; it < 128; it += NGW) {
        const int tok0 = it * 128, h = c.lane & 15, qtr = c.lane >> 4;
        const float bias = p.in[I_SDTB][l * 16 + h], A = -expf(p.in[I_SALOG][l * 16 + h]);
        float d[32]; float cum = 0.f;
#pragma unroll
        for (int i = 0; i < 32; ++i) d[i] = softplusf_(dtraw[(size_t)(tok0 + qtr * 32 + i) * 16 + h] + bias);
#pragma unroll
        for (int i = 0; i < 32; ++i) cum += d[i] * A;
        const float c1 = shfl_up_f(cum, 16, c.lane), c2 = shfl_up_f(cum, 32, c.lane), c3 = shfl_up_f(cum, 48, c.lane);
        float off = 0.f; if (qtr >= 1) off += c1; if (qtr >= 2) off += c2; if (qtr >= 3) off += c3;
        float run = off;
#pragma unroll
        for (int i = 0; i < 32; ++i) { run += d[i] * A; dt[(size_t)(tok0 + qtr * 32 + i) * 16 + h] = d[i]; acum[(size_t)(tok0 + qtr * 32 + i) * 16 + h] = run; }
    }
}

__device__ __forceinline__ void phase_ssd_state(const Params& p, const Ctx& c) {
    LAS bf16_t* XT = (LAS bf16_t*)c.lds;
    LAS bf16_t* BT = (LAS bf16_t*)(c.lds + 64 * 136 * 2);
    const bf16_t* XA = (const bf16_t*)(p.ws + WS_XBC); const float* dt = (const float*)(p.ws + WS_DT); const float* acum = (const float*)(p.ws + WS_ACUM);
    bf16_t* ST = (bf16_t*)(p.ws + WS_SST);
    const int fr = c.lane & 15, fq = c.lane >> 4;
    for (int it = c.bid; it < 2048; it += c.G) {
        const int h = it & 15, bc = it >> 4, tok0 = bc * 128, g = h >> 3;
        const float aend = acum[(size_t)(tok0 + 127) * 16 + h];
        for (int i = c.tid; i < 128 * 32; i += NTHREADS) { const int lrow = i >> 5, pp = i & 31;
            const unsigned r = *(const unsigned*)(XA + (size_t)(tok0 + lrow) * 1536 + h * 64 + 2 * pp);
            const float f = dt[(size_t)(tok0 + lrow) * 16 + h] * __expf(aend - acum[(size_t)(tok0 + lrow) * 16 + h]);
            XT[(2 * pp) * 136 + lrow] = (bf16_t)f2bf(lo_bf(r) * f); XT[(2 * pp + 1) * 136 + lrow] = (bf16_t)f2bf(hi_bf(r) * f); }
        for (int i = c.tid; i < 128 * 64; i += NTHREADS) { const int lrow = i >> 6, nn = i & 63;
            const unsigned r = *(const unsigned*)(XA + (size_t)(tok0 + lrow) * 1536 + 1024 + g * 128 + 2 * nn);
            BT[(2 * nn) * 136 + lrow] = (bf16_t)(r & 0xffffu); BT[(2 * nn + 1) * 136 + lrow] = (bf16_t)(r >> 16); }
        __syncthreads();
        f32x4 acc[4];
#pragma unroll
        for (int m = 0; m < 4; ++m) acc[m] = (f32x4){0.f, 0.f, 0.f, 0.f};
#pragma unroll
        for (int ks = 0; ks < 4; ++ks) {
            const bf16x8 bfr = *(const LAS bf16x8*)(BT + (16 * c.wave + fr) * 136 + ks * 32 + 8 * fq);
#pragma unroll
            for (int m = 0; m < 4; ++m) { const bf16x8 afr = *(const LAS bf16x8*)(XT + (16 * m + fr) * 136 + ks * 32 + 8 * fq); acc[m] = MFMA16(afr, bfr, acc[m]); }
        }
#pragma unroll
        for (int m = 0; m < 4; ++m)
#pragma unroll
            for (int r = 0; r < 4; ++r) ST[(size_t)it * 8192 + (16 * m + 4 * fq + r) * 128 + 16 * c.wave + fr] = (bf16_t)f2bf(acc[m][r]);
        __syncthreads();
    }
}
__device__ __forceinline__ void phase_ssd_scan(const Params& p, const Ctx& c) {
    unsigned* ST = (unsigned*)(p.ws + WS_SST); const float* acum = (const float*)(p.ws + WS_ACUM);
    for (int i = c.bid * NTHREADS + c.tid; i < 128 * 4096; i += c.G * NTHREADS) {
        const int e2 = i & 4095, bh = i >> 12, b = bh >> 4, h = bh & 15;
        float r0 = 0.f, r1 = 0.f;
        for (int ch = 0; ch < 16; ++ch) {
            const size_t it = (size_t)((b * 16 + ch) * 16 + h);
            const unsigned loc = ST[it * 4096 + e2];
            ST[it * 4096 + e2] = pk2(r0, r1);
            const float d = __expf(acum[(size_t)(b * SEQ + ch * 128 + 127) * 16 + h]);
            r0 = d * r0 + lo_bf(loc); r1 = d * r1 + hi_bf(loc);
        }
    }
}
__device__ __forceinline__ void phase_ssd_out(const Params& p, const Ctx& c, int l) {
    LAS bf16_t* Cs = (LAS bf16_t*)c.lds;
    LAS bf16_t* Bs = (LAS bf16_t*)(c.lds + 34816);
    LAS bf16_t* CBD = (LAS bf16_t*)(c.lds + 2 * 34816);
    LAS bf16_t* XT = (LAS bf16_t*)(c.lds + 3 * 34816);
    LAS bf16_t* STs = (LAS bf16_t*)(c.lds + 3 * 34816 + 17408);
    LAS float* acs = (LAS float*)(c.lds + 3 * 34816 + 2 * 17408);
    const bf16_t* XA = (const bf16_t*)(p.ws + WS_XBC); const float* dt = (const float*)(p.ws + WS_DT); const float* acum = (const float*)(p.ws + WS_ACUM);
    const bf16_t* ST = (const bf16_t*)(p.ws + WS_SST); bf16_t* YP = (bf16_t*)(p.ws + WS_H);
    const int fr = c.lane & 15, fq = c.lane >> 4, w = c.wave;
    for (int it = c.bid; it < 2048; it += c.G) {
        const int h = it & 15, bc = it >> 4, tok0 = bc * 128, g = h >> 3;
        const float Dh = p.in[I_SD][l * 16 + h];
        for (int i = c.tid; i < 128 * 16; i += NTHREADS) { const int row = i >> 4, ck = i & 15;
            *(LAS u32x4*)(Bs + row * 136 + ck * 8) = *(const u32x4*)(XA + (size_t)(tok0 + row) * 1536 + 1024 + g * 128 + ck * 8);
            *(LAS u32x4*)(Cs + row * 136 + ck * 8) = *(const u32x4*)(XA + (size_t)(tok0 + row) * 1536 + 1280 + g * 128 + ck * 8); }
        for (int i = c.tid; i < 64 * 16; i += NTHREADS) { const int row = i >> 4, ck = i & 15;
            *(LAS u32x4*)(STs + row * 136 + ck * 8) = *(const u32x4*)(ST + (size_t)it * 8192 + row * 128 + ck * 8); }
        for (int i = c.tid; i < 128 * 32; i += NTHREADS) { const int lrow = i >> 5, pp = i & 31;
            const unsigned r = *(const unsigned*)(XA + (size_t)(tok0 + lrow) * 1536 + h * 64 + 2 * pp);
            const float f = dt[(size_t)(tok0 + lrow) * 16 + h];
            XT[(2 * pp) * 136 + lrow] = (bf16_t)f2bf(lo_bf(r) * f); XT[(2 * pp + 1) * 136 + lrow] = (bf16_t)f2bf(hi_bf(r) * f); }
        if (c.tid < 128) acs[c.tid] = acum[(size_t)(tok0 + c.tid) * 16 + h];
        __syncthreads();
        {
            f32x4 cb[8];
#pragma unroll
            for (int n = 0; n < 8; ++n) cb[n] = (f32x4){0.f, 0.f, 0.f, 0.f};
#pragma unroll
            for (int ks = 0; ks < 4; ++ks) {
                const bf16x8 afr = *(const LAS bf16x8*)(Cs + (16 * w + fr) * 136 + ks * 32 + 8 * fq);
#pragma unroll
                for (int n = 0; n < 8; ++n) { const bf16x8 bfr = *(const LAS bf16x8*)(Bs + (16 * n + fr) * 136 + ks * 32 + 8 * fq); cb[n] = MFMA16(afr, bfr, cb[n]); }
            }
#pragma unroll
            for (int n = 0; n < 8; ++n)
#pragma unroll
                for (int r = 0; r < 4; ++r) { const int lr = 16 * w + 4 * fq + r, sc = 16 * n + fr;
                    const float v = (sc <= lr) ? cb[n][r] * __expf(acs[lr] - acs[sc]) : 0.f;
                    CBD[lr * 136 + sc] = (bf16_t)f2bf(v); }
        }
        __syncthreads();
        {
            f32x4 a1[4], a2[4];
#pragma unroll
            for (int n = 0; n < 4; ++n) { a1[n] = (f32x4){0.f, 0.f, 0.f, 0.f}; a2[n] = (f32x4){0.f, 0.f, 0.f, 0.f}; }
#pragma unroll
            for (int ks = 0; ks < 4; ++ks) {
                const bf16x8 ad = *(const LAS bf16x8*)(CBD + (16 * w + fr) * 136 + ks * 32 + 8 * fq);
                const bf16x8 ac = *(const LAS bf16x8*)(Cs + (16 * w + fr) * 136 + ks * 32 + 8 * fq);
#pragma unroll
                for (int n = 0; n < 4; ++n) {
                    const bf16x8 bx = *(const LAS bf16x8*)(XT + (16 * n + fr) * 136 + ks * 32 + 8 * fq);
                    const bf16x8 bs = *(const LAS bf16x8*)(STs + (16 * n + fr) * 136 + ks * 32 + 8 * fq);
                    a1[n] = MFMA16(ad, bx, a1[n]); a2[n] = MFMA16(ac, bs, a2[n]); }
            }
#pragma unroll
            for (int n = 0; n < 4; ++n)
#pragma unroll
                for (int r = 0; r < 4; ++r) { const int lr = 16 * w + 4 * fq + r, pc = 16 * n + fr;
                    const float xs = bf2f(XA[(size_t)(tok0 + lr) * 1536 + h * 64 + pc]);
                    const float y = a1[n][r] + __expf(acs[lr]) * a2[n][r] + Dh * xs;
                    YP[(size_t)(tok0 + lr) * DM + h * 64 + pc] = (bf16_t)f2bf(y); }
        }
        __syncthreads();
    }
}
__device__ __forceinline__ void phase_ssd_gate(const Params& p, const Ctx& c, int l) {
    const bf16_t* YP = (const bf16_t*)(p.ws + WS_H); const bf16_t* U = (const bf16_t*)(p.ws + WS_U); bf16_t* YC = (bf16_t*)(p.ws + WS_YCAT);
    const float* nw = p.in[I_SNW] + (size_t)l * 1024;
    const int gw = c.bid * NWAVES + c.wave, NGW = c.G * NWAVES;
    for (int i = gw; i < NTOK * 2; i += NGW) {
        const int tok = i >> 1, g = i & 1, col = g * 512 + 8 * c.lane;
        const u32x4 yv = *(const u32x4*)(YP + (size_t)tok * DM + col), zv = *(const u32x4*)(U + (size_t)tok * NU + UZ + col);
        float v[8]; float ss = 0.f;
#pragma unroll
        for (int j = 0; j < 4; ++j) { v[2 * j] = lo_bf(yv[j]) * siluf_(lo_bf(zv[j])); v[2 * j + 1] = hi_bf(yv[j]) * siluf_(hi_bf(zv[j])); ss += v[2 * j] * v[2 * j] + v[2 * j + 1] * v[2 * j + 1]; }
        const float rstd = 1.0f / sqrtf(wave_sum(ss, c.lane) * (1.0f / 512.0f) + EPS);
        const f32x4 w0 = *(const f32x4*)(nw + col), w1 = *(const f32x4*)(nw + col + 4);
        u32x4 o; o.x = pk2(v[0] * rstd * w0[0], v[1] * rstd * w0[1]); o.y = pk2(v[2] * rstd * w0[2], v[3] * rstd * w0[3]);
        o.z = pk2(v[4] * rstd * w1[0], v[5] * rstd * w1[1]); o.w = pk2(v[6] * rstd * w1[2], v[7] * rstd * w1[3]);
        *(u32x4*)(YC + (size_t)tok * 2048 + col) = o;
    }
}

__device__ __forceinline__ void phase_hg_state(const Params& p, const Ctx& c, int l) {
    LAS float* Bf = (LAS float*)c.lds;
    LAS float* KK = (LAS float*)(c.lds + 33792);
    LAS bf16_t* KDT = (LAS bf16_t*)(c.lds + 2 * 33792);
    LAS bf16_t* VT = (LAS bf16_t*)(c.lds + 2 * 33792 + 18432);
    const bf16_t* U = (const bf16_t*)(p.ws + WS_U); const float* lb = (const float*)(p.ws + WS_LB) + l * 512;
    bf16_t* ST = (bf16_t*)(p.ws + WS_HST); float* BL = (float*)(p.ws + WS_HGBL);
    const int fr = c.lane & 15, fq = c.lane >> 4, w = c.wave;
    for (int it = c.bid; it < 1024; it += c.G) {
        const int ch = it & 31, bh = it >> 5, h = bh & 3, b = bh >> 2, tok0 = b * SEQ + ch * 64;
        for (int i = c.tid; i < 64 * 64; i += NTHREADS) { const int s = i >> 6, kp = i & 63;
            const unsigned rf = *(const unsigned*)(U + (size_t)(tok0 + s) * NU + UHF + h * 128 + 2 * kp);
            const unsigned rv = *(const unsigned*)(U + (size_t)(tok0 + s) * NU + UHV + h * 128 + 2 * kp);
            const float k0 = (1.0f - lb[h * 128 + 2 * kp]) * sigmoidf_(-lo_bf(rf)), k1 = (1.0f - lb[h * 128 + 2 * kp + 1]) * sigmoidf_(-hi_bf(rf));
            KK[s * 132 + 2 * kp] = k0; KK[s * 132 + 2 * kp + 1] = k1;
            Bf[s * 132 + 2 * kp] = log1pf(-k0); Bf[s * 132 + 2 * kp + 1] = log1pf(-k1);
            VT[(2 * kp) * 72 + s] = (bf16_t)(rv & 0xffffu); VT[(2 * kp + 1) * 72 + s] = (bf16_t)(rv >> 16); }
        __syncthreads();
        if (c.tid < 128) { float cum = 0.f; for (int s = 0; s < 64; ++s) { cum += Bf[s * 132 + c.tid]; Bf[s * 132 + c.tid] = cum; } BL[(size_t)it * 128 + c.tid] = cum; }
        __syncthreads();
        for (int i = c.tid; i < 64 * 128; i += NTHREADS) { const int s = i >> 7, k = i & 127;
            KDT[k * 72 + s] = (bf16_t)f2bf(KK[s * 132 + k] * __expf(Bf[63 * 132 + k] - Bf[s * 132 + k])); }
        __syncthreads();
        f32x4 acc[8];
#pragma unroll
        for (int n = 0; n < 8; ++n) acc[n] = (f32x4){0.f, 0.f, 0.f, 0.f};
#pragma unroll
        for (int ks = 0; ks < 2; ++ks) {
            const bf16x8 afr = *(const LAS bf16x8*)(VT + (16 * w + fr) * 72 + ks * 32 + 8 * fq);
#pragma unroll
            for (int n = 0; n < 8; ++n) { const bf16x8 bfr = *(const LAS bf16x8*)(KDT + (16 * n + fr) * 72 + ks * 32 + 8 * fq); acc[n] = MFMA16(afr, bfr, acc[n]); }
        }
#pragma unroll
        for (int n = 0; n < 8; ++n)
#pragma unroll
            for (int r = 0; r < 4; ++r) ST[(size_t)it * 16384 + (16 * w + 4 * fq + r) * 128 + 16 * n + fr] = (bf16_t)f2bf(acc[n][r]);
        __syncthreads();
    }
}
__device__ __forceinline__ void phase_hg_scan(const Params& p, const Ctx& c) {
    unsigned* ST = (unsigned*)(p.ws + WS_HST); const float* BL = (const float*)(p.ws + WS_HGBL);
    for (int i = c.bid * NTHREADS + c.tid; i < 32 * 8192; i += c.G * NTHREADS) {
        const int e2 = i & 8191, bh = i >> 13, k0 = (2 * e2) & 127;
        float r0 = 0.f, r1 = 0.f;
        for (int ch = 0; ch < 32; ++ch) {
            const size_t it = (size_t)(bh * 32 + ch);
            const unsigned loc = ST[it * 8192 + e2];
            ST[it * 8192 + e2] = pk2(r0, r1);
            const float d0 = __expf(BL[it * 128 + k0]), d1 = __expf(BL[it * 128 + k0 + 1]);
            r0 = d0 * r0 + lo_bf(loc); r1 = d1 * r1 + hi_bf(loc);
        }
    }
}
__device__ __forceinline__ void phase_hg_out(const Params& p, const Ctx& c, int l) {
    LAS bf16_t* Qs = (LAS bf16_t*)c.lds;
    LAS bf16_t* Ks = (LAS bf16_t*)(c.lds + 17408);
    LAS float* Bf = (LAS float*)(c.lds + 2 * 17408);
    LAS bf16_t* QB = Qs;
    LAS bf16_t* STs = (LAS bf16_t*)(c.lds + 2 * 17408 + 33792);
    LAS bf16_t* ATT = (LAS bf16_t*)(c.lds + 2 * 17408 + 33792 + 34816);
    LAS bf16_t* VT = (LAS bf16_t*)(c.lds + 2 * 17408 + 33792 + 34816 + 9216);
    LAS bf16_t* QI = (LAS bf16_t*)(c.lds + 2 * 17408 + 33792 + 34816 + 9216 + 18432);
    LAS bf16_t* KKI = (LAS bf16_t*)(c.lds + 2 * 17408 + 33792 + 34816 + 9216 + 18432 + 4352);
    const bf16_t* U = (const bf16_t*)(p.ws + WS_U); const float* lb = (const float*)(p.ws + WS_LB) + l * 512;
    const bf16_t* ST = (const bf16_t*)(p.ws + WS_HST); bf16_t* YC = (bf16_t*)(p.ws + WS_YCAT);
    const float* nw = p.in[I_HNW] + (size_t)l * 512;
    const int fr = c.lane & 15, fq = c.lane >> 4, w = c.wave;
    for (int it = c.bid; it < 1024; it += c.G) {
        const int ch = it & 31, bh = it >> 5, h = bh & 3, b = bh >> 2, tok0 = b * SEQ + ch * 64;
        for (int i = c.tid; i < 64 * 64; i += NTHREADS) { const int s = i >> 6, kp = i & 63;
            const size_t ro = (size_t)(tok0 + s) * NU + h * 128 + 2 * kp;
            const unsigned rq = *(const unsigned*)(U + ro + UHQ), rf = *(const unsigned*)(U + ro + UHF), rv = *(const unsigned*)(U + ro + UHV);
            const float k0 = (1.0f - lb[h * 128 + 2 * kp]) * sigmoidf_(-lo_bf(rf)), k1 = (1.0f - lb[h * 128 + 2 * kp + 1]) * sigmoidf_(-hi_bf(rf));
            *(LAS unsigned*)(Ks + s * 136 + 2 * kp) = pk2(k0, k1);
            *(LAS unsigned*)(Qs + s * 136 + 2 * kp) = pk2(siluf_(lo_bf(rq)), siluf_(hi_bf(rq)));
            Bf[s * 132 + 2 * kp] = log1pf(-k0); Bf[s * 132 + 2 * kp + 1] = log1pf(-k1);
            VT[(2 * kp) * 72 + s] = (bf16_t)(rv & 0xffffu); VT[(2 * kp + 1) * 72 + s] = (bf16_t)(rv >> 16); }
        for (int i = c.tid; i < 128 * 16; i += NTHREADS) { const int row = i >> 4, ck = i & 15;
            *(LAS u32x4*)(STs + row * 136 + ck * 8) = *(const u32x4*)(ST + (size_t)it * 16384 + row * 128 + ck * 8); }
        __syncthreads();
        if (c.tid < 128) { float cum = 0.f; for (int s = 0; s < 64; ++s) { cum += Bf[s * 132 + c.tid]; Bf[s * 132 + c.tid] = cum; } }
        __syncthreads();
        for (int pidx = c.tid; pidx < 1024; pidx += NTHREADS) {
            const int ib = pidx >> 8, tq = (pidx >> 4) & 15, sq = pidx & 15, t = 16 * ib + tq, s2 = 16 * ib + sq; float a = 0.f;
            if (sq <= tq) {
                for (int k = 0; k < 128; k += 4) {
                    const f32x4 bt = *(const LAS f32x4*)(Bf + t * 132 + k), bs = *(const LAS f32x4*)(Bf + s2 * 132 + k);
                    const u32x2 qv = *(const LAS u32x2*)(Qs + t * 136 + k), kv = *(const LAS u32x2*)(Ks + s2 * 136 + k);
                    a += lo_bf(qv.x) * lo_bf(kv.x) * __expf(bt[0] - bs[0]) + hi_bf(qv.x) * hi_bf(kv.x) * __expf(bt[1] - bs[1])
                       + lo_bf(qv.y) * lo_bf(kv.y) * __expf(bt[2] - bs[2]) + hi_bf(qv.y) * hi_bf(kv.y) * __expf(bt[3] - bs[3]);
                }
            }
            ATT[t * 72 + s2] = (bf16_t)f2bf(a);
        }
        for (int i = c.tid; i < 6 * 256; i += NTHREADS) { const int blk = i >> 8, e = i & 255; const int bi = (blk < 3) ? 0 : (blk < 5 ? 1 : 2), bj = (blk < 3) ? blk + 1 : (blk < 5 ? blk - 1 : 3);
            ATT[(16 * bi + (e >> 4)) * 72 + 16 * bj + (e & 15)] = (bf16_t)0; }
        for (int ib = 1; ib < 4; ++ib) {
            const int rref = 16 * ib - 1;
            for (int i = c.tid; i < 16 * 64; i += NTHREADS) { const int tq = i >> 6, kp = i & 63, t = 16 * ib + tq;
                const unsigned q2 = *(const LAS unsigned*)(Qs + t * 136 + 2 * kp);
                *(LAS unsigned*)(QI + tq * 136 + 2 * kp) = pk2(lo_bf(q2) * __expf(Bf[t * 132 + 2 * kp] - Bf[rref * 132 + 2 * kp]), hi_bf(q2) * __expf(Bf[t * 132 + 2 * kp + 1] - Bf[rref * 132 + 2 * kp + 1])); }
            for (int i = c.tid; i < 16 * ib * 64; i += NTHREADS) { const int s2 = i >> 6, kp = i & 63;
                const unsigned k2 = *(const LAS unsigned*)(Ks + s2 * 136 + 2 * kp);
                *(LAS unsigned*)(KKI + s2 * 136 + 2 * kp) = pk2(lo_bf(k2) * __expf(Bf[rref * 132 + 2 * kp] - Bf[s2 * 132 + 2 * kp]), hi_bf(k2) * __expf(Bf[rref * 132 + 2 * kp + 1] - Bf[s2 * 132 + 2 * kp + 1])); }
            __syncthreads();
            if (w < ib) {
                f32x4 a4 = (f32x4){0.f, 0.f, 0.f, 0.f};
#pragma unroll
                for (int ks = 0; ks < 4; ++ks) { const bf16x8 afr = *(const LAS bf16x8*)(QI + fr * 136 + ks * 32 + 8 * fq), bfr = *(const LAS bf16x8*)(KKI + (16 * w + fr) * 136 + ks * 32 + 8 * fq); a4 = MFMA16(afr, bfr, a4); }
#pragma unroll
                for (int r = 0; r < 4; ++r) ATT[(16 * ib + 4 * fq + r) * 72 + 16 * w + fr] = (bf16_t)f2bf(a4[r]);
            }
            __syncthreads();
        }
        for (int i = c.tid; i < 64 * 64; i += NTHREADS) { const int t = i >> 6, kp = i & 63;
            const unsigned q2 = *(const LAS unsigned*)(Qs + t * 136 + 2 * kp);
            *(LAS unsigned*)(Qs + t * 136 + 2 * kp) = pk2(lo_bf(q2) * __expf(Bf[t * 132 + 2 * kp]), hi_bf(q2) * __expf(Bf[t * 132 + 2 * kp + 1])); }
        __syncthreads();
        f32x4 acc[4];
#pragma unroll
        for (int m = 0; m < 4; ++m) acc[m] = (f32x4){0.f, 0.f, 0.f, 0.f};
#pragma unroll
        for (int ks = 0; ks < 4; ++ks) {
            const bf16x8 bfr = *(const LAS bf16x8*)(STs + (16 * w + fr) * 136 + ks * 32 + 8 * fq);
#pragma unroll
            for (int m = 0; m < 4; ++m) { const bf16x8 afr = *(const LAS bf16x8*)(QB + (16 * m + fr) * 136 + ks * 32 + 8 * fq); acc[m] = MFMA16(afr, bfr, acc[m]); }
        }
#pragma unroll
        for (int ks = 0; ks < 2; ++ks) {
            const bf16x8 bfr = *(const LAS bf16x8*)(VT + (16 * w + fr) * 72 + ks * 32 + 8 * fq);
#pragma unroll
            for (int m = 0; m < 4; ++m) { const bf16x8 afr = *(const LAS bf16x8*)(ATT + (16 * m + fr) * 72 + ks * 32 + 8 * fq); acc[m] = MFMA16(afr, bfr, acc[m]); }
        }
#pragma unroll
        for (int m = 0; m < 4; ++m)
#pragma unroll
            for (int r = 0; r < 4; ++r) Bf[(16 * m + 4 * fq + r) * 132 + 16 * w + fr] = acc[m][r];
        __syncthreads();
        for (int t = w * 8; t < w * 8 + 8; ++t) {
            const f32x2 o = *(const LAS f32x2*)(Bf + t * 132 + 2 * c.lane);
            const float rstd = 1.0f / sqrtf(wave_sum(o.x * o.x + o.y * o.y, c.lane) * (1.0f / 128.0f) + EPS);
            const unsigned gv = *(const unsigned*)(U + (size_t)(tok0 + t) * NU + UHG + h * 128 + 2 * c.lane);
            const f32x2 wv = *(const f32x2*)(nw + h * 128 + 2 * c.lane);
            *(unsigned*)(YC + (size_t)(tok0 + t) * 2048 + 1024 + h * 128 + 2 * c.lane) = pk2(o.x * rstd * wv.x * siluf_(lo_bf(gv)), o.y * rstd * wv.y * siluf_(hi_bf(gv)));
        }
        __syncthreads();
    }
}

__device__ __forceinline__ void phase_lru1(const Params& p, const Ctx& c, int l) {
    LAS unsigned char* wl = c.lds + c.wave * 12288;
    LAS bf16_t* XB = (LAS bf16_t*)wl;
    LAS float* As = (LAS float*)(wl + 2304);
    LAS float* Us = (LAS float*)(wl + 2304 + 4096);
    const bf16_t* U = (const bf16_t*)(p.ws + WS_U); bf16_t* LA = (bf16_t*)(p.ws + WS_LA); bf16_t* LH = (bf16_t*)(p.ws + WS_LH);
    const bf16_t* LW = (const bf16_t*)(p.ws + WS_LRUW) + (size_t)l * 2 * 8 * 4096;
    const int fr = c.lane & 15, fq = c.lane >> 4, g = c.wave, chn = g * 64 + c.lane;
    const float cw0 = p.in[I_LCW][(size_t)l * 2048 + chn], cw1 = p.in[I_LCW][(size_t)l * 2048 + 512 + chn], cw2 = p.in[I_LCW][(size_t)l * 2048 + 1024 + chn], cw3 = p.in[I_LCW][(size_t)l * 2048 + 1536 + chn];
    const float cbias = p.in[I_LCB][l * 512 + chn];
    bf16x8 wfa[4][2], wfx[4][2];
#pragma unroll
    for (int n = 0; n < 4; ++n)
#pragma unroll
        for (int ks = 0; ks < 2; ++ks) { wfa[n][ks] = *(const bf16x8*)(LW + (size_t)(0 * 8 + g) * 4096 + (16 * n + fr) * 64 + ks * 32 + 8 * fq);
                                         wfx[n][ks] = *(const bf16x8*)(LW + (size_t)(1 * 8 + g) * 4096 + (16 * n + fr) * 64 + ks * 32 + 8 * fq); }
    float bav[4], bxv[4], spl[4];
#pragma unroll
    for (int n = 0; n < 4; ++n) { const int j = g * 64 + 16 * n + fr; bav[n] = p.in[I_LBA][l * 512 + j]; bxv[n] = p.in[I_LBX][l * 512 + j]; spl[n] = softplusf_(-p.in[I_LLAM][l * 512 + j]); }
    for (int it = c.bid; it < 256; it += c.G) {
        const int seg = it & 31, tok0 = (it >> 5) * SEQ + seg * 64;
        float x0 = 0.f, x1 = 0.f, x2 = 0.f;
        if (seg > 0) { x0 = bf2f(U[(size_t)(tok0 - 3) * NU + ULX + chn]); x1 = bf2f(U[(size_t)(tok0 - 2) * NU + ULX + chn]); x2 = bf2f(U[(size_t)(tok0 - 1) * NU + ULX + chn]); }
        float hrun = 0.f, arun = 1.f;
        for (int st = 0; st < 4; ++st) {
            const int t0 = tok0 + st * 16;
#pragma unroll
            for (int tt = 0; tt < 16; ++tt) { const float xr = bf2f(U[(size_t)(t0 + tt) * NU + ULX + chn]);
                const float xb = cbias + cw0 * x0 + cw1 * x1 + cw2 * x2 + cw3 * xr; x0 = x1; x1 = x2; x2 = xr;
                XB[tt * 72 + c.lane] = (bf16_t)f2bf(xb); }
            LDS_WAIT();
            f32x4 ar[4], ai[4];
#pragma unroll
            for (int n = 0; n < 4; ++n) { ar[n] = (f32x4){0.f, 0.f, 0.f, 0.f}; ai[n] = (f32x4){0.f, 0.f, 0.f, 0.f}; }
#pragma unroll
            for (int ks = 0; ks < 2; ++ks) { const bf16x8 afr = *(const LAS bf16x8*)(XB + fr * 72 + ks * 32 + 8 * fq);
#pragma unroll
                for (int n = 0; n < 4; ++n) { ar[n] = MFMA16(afr, wfa[n][ks], ar[n]); ai[n] = MFMA16(afr, wfx[n][ks], ai[n]); } }
#pragma unroll
            for (int n = 0; n < 4; ++n)
#pragma unroll
                for (int r = 0; r < 4; ++r) { const int t = 4 * fq + r, j = 16 * n + fr;
                    const float rg = sigmoidf_(ar[n][r] + bav[n]), ig = sigmoidf_(ai[n][r] + bxv[n]);
                    const float la = -8.0f * rg * spl[n], a = __expf(la), mult = sqrtf(fmaxf(fmaf(-a, a, 1.0f), 0.f));
                    As[t * 64 + j] = a; Us[t * 64 + j] = mult * ig * bf2f(XB[t * 72 + j]); }
            LDS_WAIT();
#pragma unroll
            for (int tt = 0; tt < 16; ++tt) { const float a = As[tt * 64 + c.lane], uu = Us[tt * 64 + c.lane];
                hrun = a * hrun + uu; arun = a * arun;
                LA[(size_t)(t0 + tt) * 512 + chn] = (bf16_t)f2bf(arun); LH[(size_t)(t0 + tt) * 512 + chn] = (bf16_t)f2bf(hrun); }
            LDS_WAIT();
        }
    }
}
__device__ __forceinline__ void phase_lru2(const Params& p, const Ctx& c, int l) {
    LAS float* YS = (LAS float*)c.lds;
    LAS float* PART = (LAS float*)(c.lds + 65536);
    const bf16_t* U = (const bf16_t*)(p.ws + WS_U); const bf16_t* LA = (const bf16_t*)(p.ws + WS_LA); const bf16_t* LH = (const bf16_t*)(p.ws + WS_LH);
    bf16_t* YC = (bf16_t*)(p.ws + WS_YCAT);
    const int g = c.wave, chn = g * 64 + c.lane;
    const float nwv = p.in[I_LNW][l * 512 + chn];
    for (int it = c.bid; it < 256; it += c.G) {
        const int seg = it & 31, b = it >> 5, tok0 = b * SEQ + seg * 64;
        float hin = 0.f;
        for (int s2 = 0; s2 < seg; ++s2) { const size_t row = (size_t)(b * SEQ + s2 * 64 + 63); hin = bf2f(LH[row * 512 + chn]) + bf2f(LA[row * 512 + chn]) * hin; }
        for (int sb = 0; sb < 2; ++sb) {
#pragma unroll 4
            for (int tt = 0; tt < 32; ++tt) { const size_t tok = (size_t)(tok0 + sb * 32 + tt);
                const float hh = bf2f(LH[tok * 512 + chn]) + bf2f(LA[tok * 512 + chn]) * hin;
                const float y = hh * gelu_tanhf_(bf2f(U[tok * NU + ULG + chn]));
                YS[tt * 512 + chn] = y;
                const float ss = wave_sum(y * y, c.lane);
                if (c.lane == 0) PART[tt * 8 + g] = ss; }
            __syncthreads();
#pragma unroll 4
            for (int tt = 0; tt < 32; ++tt) { const f32x4 p0 = *(const LAS f32x4*)(PART + tt * 8), p1 = *(const LAS f32x4*)(PART + tt * 8 + 4);
                const float tot = ((p0[0] + p0[1]) + (p0[2] + p0[3])) + ((p1[0] + p1[1]) + (p1[2] + p1[3]));
                const float rstd = 1.0f / sqrtf(tot * (1.0f / 512.0f) + EPS);
                YC[(size_t)(tok0 + sb * 32 + tt) * 2048 + 1536 + chn] = (bf16_t)f2bf(YS[tt * 512 + chn] * rstd * nwv); }
            __syncthreads();
        }
    }
}

__device__ __forceinline__ void phase_norm_router(const Params& p, const Ctx& c, int l, const float* xin) {
    constexpr int HSTR = 1028;
    LAS float* HS = (LAS float*)c.lds;
    LAS float* PL = (LAS float*)(c.lds + 16 * HSTR * 4);
    LAS float* LG = (LAS float*)(c.lds + 16 * HSTR * 4 + 32768);
    const float* mod = (const float*)(p.ws + WS_MOD) + (size_t)l * 8 * NMOD;
    const float* nw = p.in[I_NFFN] + (size_t)l * DM;
    const float* WT = (const float*)(p.ws + WS_WRT) + (size_t)l * 64 * 1024;
    const float rbias = p.in[I_RB][l * NEXP + c.lane];
    bf16_t* H = (bf16_t*)(p.ws + WS_H);
    unsigned long long* selm = (unsigned long long*)(p.ws + WS_SELM); float* rw = (float*)(p.ws + WS_RW);
    const int fr = c.lane & 15, fq = c.lane >> 4, w = c.wave;
    int* cnt = (int*)(p.ws + WS_CNT);
    f32x4 bw[8][4];
#pragma unroll
    for (int j = 0; j < 8; ++j)
#pragma unroll
        for (int n = 0; n < 4; ++n) bw[j][n] = *(const f32x4*)(WT + (size_t)(16 * n + fr) * 1024 + 128 * w + 16 * j + 4 * fq);
    int ecount = 0;
    f32x4 xn[2][4];
    if (c.bid < NTOK / 16) {
#pragma unroll
        for (int q = 0; q < 2; ++q)
#pragma unroll
            for (int j = 0; j < 4; ++j) xn[q][j] = ((const f32x4*)(xin + (size_t)(c.bid * 16 + 2 * w + q) * DM) + c.lane)[64 * j];
    }
    for (int t16 = c.bid; t16 < NTOK / 16; t16 += c.G) {
        const int tokb = t16 * 16, b = tokb >> 11;
#pragma unroll
        for (int q = 0; q < 2; ++q) {
            const int tl = 2 * w + q, tok = tokb + tl;
            f32x4 v[4]; float ss = 0.f;
#pragma unroll
            for (int j = 0; j < 4; ++j) { v[j] = xn[q][j]; ss += (v[j][0] * v[j][0] + v[j][1] * v[j][1]) + (v[j][2] * v[j][2] + v[j][3] * v[j][3]); }
            const float rstd = 1.0f / sqrtf(wave_sum(ss, c.lane) * (1.0f / DM) + EPS);
#pragma unroll
            for (int j = 0; j < 4; ++j) {
                const int col = 256 * j + 4 * c.lane;
                const f32x4 w4 = *(const f32x4*)(nw + col), sh = *(const f32x4*)(mod + (size_t)b * NMOD + 3072 + col), sc = *(const f32x4*)(mod + (size_t)b * NMOD + 4096 + col);
                const f32x4 h = (v[j] * rstd * w4) * (sc + 1.0f) + sh;
                u32x2 o; o.x = pk2(h[0], h[1]); o.y = pk2(h[2], h[3]);
                *(u32x2*)(H + (size_t)tok * DM + col) = o;
                *(LAS f32x4*)(HS + tl * HSTR + col) = h;
            }
        }
        if (t16 + c.G < NTOK / 16) {
#pragma unroll
            for (int q = 0; q < 2; ++q)
#pragma unroll
                for (int j = 0; j < 4; ++j) xn[q][j] = ((const f32x4*)(xin + (size_t)((t16 + c.G) * 16 + 2 * w + q) * DM) + c.lane)[64 * j];
        }
        __syncthreads();
        {
            f32x4 acc[4];
#pragma unroll
            for (int n = 0; n < 4; ++n) acc[n] = (f32x4){0.f, 0.f, 0.f, 0.f};
#pragma unroll
            for (int j = 0; j < 8; ++j) {
                const int kk = 128 * w + 16 * j + 4 * fq;
                const f32x4 a4 = *(const LAS f32x4*)(HS + fr * HSTR + kk);
#pragma unroll
                for (int i = 0; i < 4; ++i)
#pragma unroll
                    for (int n = 0; n < 4; ++n) acc[n] = __builtin_amdgcn_mfma_f32_16x16x4f32(a4[i], bw[j][n][i], acc[n], 0, 0, 0);
            }
#pragma unroll
            for (int n = 0; n < 4; ++n)
#pragma unroll
                for (int r = 0; r < 4; ++r) PL[(w * 16 + 4 * fq + r) * 64 + 16 * n + fr] = acc[n][r];
        }
        __syncthreads();
        for (int i = c.tid; i < 1024; i += NTHREADS) { float s2 = 0.f;
#pragma unroll
            for (int ww = 0; ww < 8; ++ww) s2 += PL[ww * 1024 + i];
            LG[i] = s2; }
        __syncthreads();
#pragma unroll
        for (int q = 0; q < 2; ++q) {
            const int tl = 2 * w + q, tok = tokb + tl;
            const float s = sigmoidf_(LG[tl * 64 + c.lane]), v = s + rbias;
            float m1 = v;
            m1 = fmaxf(m1, shfl_xor_l(m1, 1, c.lane)); m1 = fmaxf(m1, shfl_xor_l(m1, 2, c.lane)); m1 = fmaxf(m1, shfl_xor_l(m1, 4, c.lane));
            const unsigned long long eq = __ballot(v == m1);
            const int gbase = c.lane & ~7;
            const unsigned gm = (unsigned)((eq >> gbase) & 0xffull);
            const int first = gbase + __builtin_ctz(gm);
            float m2 = (c.lane == first) ? -3.0e38f : v;
            m2 = fmaxf(m2, shfl_xor_l(m2, 1, c.lane)); m2 = fmaxf(m2, shfl_xor_l(m2, 2, c.lane)); m2 = fmaxf(m2, shfl_xor_l(m2, 4, c.lane));
            const float gs = m1 + m2;
            const int mygrp = c.lane >> 3; int grank = 0;
#pragma unroll
            for (int g2 = 0; g2 < 8; ++g2) { const float o = rdlane_f(gs, g2 * 8); grank += (o > gs || (o == gs && g2 < mygrp)) ? 1 : 0; }
            const float vm = (grank < 4) ? v : -1.0e4f;
            int erank = 0;
            for (int e2 = 0; e2 < 64; ++e2) { const float o = rdlane_f(vm, e2); erank += (o > vm || (o == vm && e2 < c.lane)) ? 1 : 0; }
            const bool sel = erank < TOPK;
            const unsigned long long mask = __ballot(sel);
            const float wsum = wave_sum(sel ? s : 0.f, c.lane);
            if (sel) { const int kk = __builtin_popcountll(mask & ((1ull << c.lane) - 1ull)); rw[(size_t)tok * 8 + kk] = s / wsum * 2.5f; }
            if (c.lane == 0) selm[tok] = mask;
            ecount += sel ? 1 : 0;
        }
        __syncthreads();
    }
    { LAS int* CW = (LAS int*)c.lds; CW[w * 64 + c.lane] = ecount; __syncthreads();
      if (w == 0) { int tot = 0;
#pragma unroll
          for (int ww = 0; ww < 8; ++ww) tot += CW[ww * 64 + c.lane];
          cnt[c.bid * 64 + c.lane] = tot; }
      __syncthreads(); }
}
__device__ __forceinline__ void phase_route_assign(const Params& p, const Ctx& c) {
    const unsigned long long* selm = (const unsigned long long*)(p.ws + WS_SELM); const int* cnt = (const int*)(p.ws + WS_CNT);
    int* slot_tok = (int*)(p.ws + WS_SLOTTOK); int* slot_of = (int*)(p.ws + WS_SLOTOF); int* rinfo = (int*)(p.ws + WS_RINFO);
    const int gw = c.bid * NWAVES + c.wave, NGW = c.G * NWAVES;
    for (int ch = gw; ch < c.G; ch += NGW) {
        int total = 0, before = 0;
        for (int j = 0; j < c.G; ++j) { const int v = cnt[j * 64 + c.lane]; total += v; before += (j < ch) ? v : 0; }
        const int pad = (total + 255) & ~255;
        int incl = pad;
#pragma unroll
        for (int o = 1; o < 64; o <<= 1) { const int t = shfl_up_l(incl, o, c.lane); if (c.lane >= o) incl += t; }
        const int pstart = incl - pad;
        int run = pstart + before;
        for (int t16 = ch; t16 < NTOK / 16; t16 += c.G) {
            const unsigned long long mine = (c.lane < 16) ? selm[t16 * 16 + c.lane] : 0ull;
            for (int i = 0; i < 16; ++i) {
                const unsigned long long m = rdlane_u64(mine, i); const int tok = t16 * 16 + i;
                if ((m >> c.lane) & 1ull) { const int kk = __builtin_popcountll(m & ((1ull << c.lane) - 1ull)); slot_tok[run] = tok; slot_of[tok * 8 + kk] = run; ++run; }
            }
        }
        if (ch == 0) {
            for (int s2 = pstart + total; s2 < pstart + pad; ++s2) slot_tok[s2] = -1;
            for (int bk = pstart >> 8; bk < (pstart + pad) >> 8; ++bk) rinfo[64 + bk] = c.lane;
            if (c.lane == 63) rinfo[0] = incl >> 8;
        }
    }
}
__device__ __forceinline__ void phase_combine(const Params& p, const Ctx& c, int l) {
    const float* gate = (const float*)(p.ws + WS_MOD) + (size_t)l * 8 * NMOD + 5120;
    const bf16_t* Y = (const bf16_t*)(p.ws + WS_Y); const bf16_t* YS = (const bf16_t*)(p.ws + WS_H); const int* slot_of = (const int*)(p.ws + WS_SLOTOF); const float* rw = (const float*)(p.ws + WS_RW);
    const float* fw = p.in[I_FNW];
    const int gw = c.bid * NWAVES + c.wave, NGW = c.G * NWAVES;
    for (int tok = gw; tok < NTOK; tok += NGW) {
        const int b = tok >> 11;
        f32x4 acc[4];
#pragma unroll
        for (int j = 0; j < 4; ++j) acc[j] = (f32x4){0.f, 0.f, 0.f, 0.f};
#pragma unroll
        for (int k = 0; k < 8; ++k) { const int sl = slot_of[tok * 8 + k]; const float wk = rw[tok * 8 + k];
#pragma unroll
            for (int j = 0; j < 4; ++j) { const u32x2 yv = *(const u32x2*)(Y + (size_t)sl * DM + 256 * j + 4 * c.lane);
                acc[j][0] += wk * lo_bf(yv.x); acc[j][1] += wk * hi_bf(yv.x); acc[j][2] += wk * lo_bf(yv.y); acc[j][3] += wk * hi_bf(yv.y); } }
#pragma unroll
        for (int j = 0; j < 4; ++j) { const u32x2 yv = *(const u32x2*)(YS + (size_t)tok * DM + 256 * j + 4 * c.lane);
            acc[j][0] += lo_bf(yv.x); acc[j][1] += hi_bf(yv.x); acc[j][2] += lo_bf(yv.y); acc[j][3] += hi_bf(yv.y); }
        f32x4* xr = (f32x4*)(p.out + (size_t)tok * DM) + c.lane;
        f32x4 v[4]; float ss = 0.f;
#pragma unroll
        for (int j = 0; j < 4; ++j) { const f32x4 gv = *(const f32x4*)(gate + (size_t)b * NMOD + 256 * j + 4 * c.lane); v[j] = xr[64 * j] + gv * acc[j];
            ss += (v[j][0] * v[j][0] + v[j][1] * v[j][1]) + (v[j][2] * v[j][2] + v[j][3] * v[j][3]); }
        if (l == NLAYER - 1) {
            const float rstd = 1.0f / sqrtf(wave_sum(ss, c.lane) * (1.0f / DM) + EPS);
#pragma unroll
            for (int j = 0; j < 4; ++j) { const f32x4 w4 = *(const f32x4*)(fw + 256 * j + 4 * c.lane); xr[64 * j] = v[j] * rstd * w4; }
        } else {
#pragma unroll
            for (int j = 0; j < 4; ++j) xr[64 * j] = v[j];
        }
    }
}


#define XB_TMO      128
#define XB_XCNT(j)  (256  + 64 * (j))
#define XB_XSUB(j)  (1280 + 64 * (j))
#define XB_XGEN(j)  (2304 + 64 * (j))
#define XB_TOP      3328
#define XB_TOPGEN   3392
#define XCD_BAR_WORDS 3456
#define XB_SPIN_CAP (1u << 18)
constexpr int LDS_XBST = LDS_PTAB + 320;
__device__ __forceinline__ unsigned xb_ld(unsigned* p)              { return __hip_atomic_load(p, __ATOMIC_RELAXED, __HIP_MEMORY_SCOPE_AGENT); }
__device__ __forceinline__ unsigned xb_add(unsigned* p, unsigned v) { return __hip_atomic_fetch_add(p, v, __ATOMIC_RELAXED, __HIP_MEMORY_SCOPE_AGENT); }
__device__ __forceinline__ unsigned xb_xcc_id() { return (unsigned)__builtin_amdgcn_s_getreg((3 << 11) | 20) & 0xFu; }
#define XB_SPIN(cond, bar) do { unsigned _sp = 0; while (cond) { __builtin_amdgcn_s_sleep(1); \
    if ((++_sp & 255u) == 0u) { if (xb_ld(&(bar)[XB_TMO])) break; if (_sp > XB_SPIN_CAP) { atomicAdd(&(bar)[XB_TMO], 1u); break; } } } } while (0)
__device__ __forceinline__ void xcd_barrier_complete(unsigned* bar, unsigned x, unsigned& nloc, unsigned& nx) {
    const unsigned G = gridDim.x * gridDim.y * gridDim.z;
    unsigned sum, cnt, mine, sp = 0u;
    for (;;) {
        sum = 0u; cnt = 0u; mine = 0u;
#pragma unroll
        for (unsigned j = 0; j < 16; ++j) { const unsigned c = xb_ld(&bar[XB_XCNT(j)]); sum += c; cnt += (c > 0u) ? 1u : 0u; mine = (j == x) ? c : mine; }
        if (sum == G) break;
        __builtin_amdgcn_s_sleep(1);
        if ((++sp & 255u) == 0u) { if (xb_ld(&bar[XB_TMO])) break; if (sp > XB_SPIN_CAP) { atomicAdd(&bar[XB_TMO], 1u); break; } }
    }
    nloc = mine > 0u ? mine : 1u; nx = cnt > 0u ? cnt : 1u;
}
__device__ __forceinline__ void xcd_barrier(unsigned* bar, volatile LAS unsigned* st, bool leader_thread) {
    asm volatile("s_waitcnt vmcnt(0)" ::: "memory");
    __syncthreads();
    if (leader_thread) {
        const unsigned x = xb_xcc_id();
        __builtin_amdgcn_s_waitcnt(0);
        unsigned nloc = st[0], nx = st[1];
        if (nloc == 0u) { xcd_barrier_complete(bar, x, nloc, nx); st[0] = nloc; st[1] = nx; }
        const unsigned old = xb_add(&bar[XB_XSUB(x)], 1u);
        const unsigned gen = old / nloc;
        if (old + 1u == (gen + 1u) * nloc) {
            __builtin_amdgcn_fence(__ATOMIC_RELEASE, "agent");
            asm volatile("s_waitcnt vmcnt(0)" ::: "memory");
            const unsigned og = xb_add(&bar[XB_TOP], 1u);
            const unsigned tg = og / nx;
            if (og + 1u == (tg + 1u) * nx) xb_add(&bar[XB_TOPGEN], 1u);
            else XB_SPIN(xb_ld(&bar[XB_TOPGEN]) == tg, bar);
            __builtin_amdgcn_fence(__ATOMIC_ACQUIRE, "agent");
            xb_add(&bar[XB_XGEN(x)], 1u);
            asm volatile("s_waitcnt vmcnt(0)" ::: "memory");
        } else {
            XB_SPIN(xb_ld(&bar[XB_XGEN(x)]) == gen, bar);
            __builtin_amdgcn_fence(__ATOMIC_ACQUIRE, "agent");
            asm volatile("s_waitcnt vmcnt(0)" ::: "memory");
        }
    }
    __syncthreads();
}

#ifndef PROBE_ID
#define PROBE_ID 0
#endif
#define RUN(id, stmt) do { stmt; if constexpr (PROBE_ID == (id)) { __syncthreads(); stmt; } } while (0)
constexpr int NQ_PHASE = 14;
__device__ __forceinline__ unsigned long long uni64(unsigned long long v) {
    const unsigned lo = (unsigned)__builtin_amdgcn_readfirstlane((int)(unsigned)v), hi = (unsigned)__builtin_amdgcn_readfirstlane((int)(unsigned)(v >> 32)); return ((unsigned long long)hi << 32) | lo; }
#if MK_MEGA
__device__ __forceinline__ void params_to_lds(const Params& p, LAS unsigned char* lds) {
    LAS unsigned long long* tab = (LAS unsigned long long*)(lds + LDS_PTAB);
#pragma unroll
    for (int i = 0; i < 33; ++i) tab[i] = (unsigned long long)p.in[i];
    tab[33] = (unsigned long long)p.out; tab[34] = (unsigned long long)p.ws;
}
__device__ __forceinline__ Params params_from_lds(LAS unsigned char* lds) {
    const LAS unsigned long long* tab = (const LAS unsigned long long*)(lds + LDS_PTAB);
    Params p;
#pragma unroll
    for (int i = 0; i < 33; ++i) p.in[i] = (const float*)(const __attribute__((address_space(1))) float*)uni64(tab[i]);
    p.out = (float*)(__attribute__((address_space(1))) float*)uni64(tab[33]); p.ws = (unsigned char*)(__attribute__((address_space(1))) unsigned char*)uni64(tab[34]); p.layer = 0; p.pad = 0;
    return p;
}
#endif
template <int Q> __device__ __forceinline__ void run_q(const Params& p_in, const Ctx& c_in, int l) {
    Ctx c = c_in;
    asm volatile("" : "+s"(c.wave), "+s"(c.bid), "+s"(c.G), "+s"(l));
    c.lane = fresh_lane(); c.tid = c.wave * 64 + c.lane;
#if MK_MEGA
    const Params p = params_from_lds(c.lds);
#else
    const Params& p = p_in;
#endif
    const float* xin = (l == 0) ? p.in[I_X] : p.out;
    if constexpr (Q == 14) { RUN(1, phase_prep_io(p, c); __syncthreads(); phase_prep_small(p, c)); __syncthreads(); RUN(2, phase_prep_experts(p, c, 0)); }
    if constexpr (Q == 0) { if (l > 0) { RUN(2, phase_prep_experts(p, c, l)); __syncthreads(); } RUN(3, phase_norm_mix(p, c, l, xin)); }
    if constexpr (Q == 1) { pg8::Gemm g{(const bf16_t*)(p.ws + WS_H), (const bf16_t*)(p.ws + WS_WIN) + (size_t)l * NU * DM, DM, 0};
              pg8::DenseOrder S; S.init(NTOK, NU, c.G, c.bid); EpiU E{(bf16_t*)(p.ws + WS_U), NU};
              RUN(4, (pg8::gemm_phase<EpiU, pg8::DenseOrder, pg8::DenseRows, true, true>(c.lds, g, S, E, pg8::DenseRows(), c.wave))); }
    if constexpr (Q == 2) { RUN(5, phase_ssd_conv(p, c, l)); __syncthreads(); RUN(6, phase_hg_state(p, c, l)); __syncthreads(); RUN(7, phase_lru1(p, c, l)); }
    if constexpr (Q == 3) { RUN(8, phase_ssd_state(p, c)); __syncthreads(); phase_hg_scan(p, c); __syncthreads(); RUN(9, phase_lru2(p, c, l)); }
    if constexpr (Q == 4) { phase_ssd_scan(p, c); __syncthreads(); RUN(10, phase_hg_out(p, c, l)); }
    if constexpr (Q == 5) RUN(11, phase_ssd_out(p, c, l));
    if constexpr (Q == 6) RUN(12, phase_ssd_gate(p, c, l));
    if constexpr (Q == 7) { pg8::Gemm g{(const bf16_t*)(p.ws + WS_YCAT), (const bf16_t*)(p.ws + WS_WOUT) + (size_t)l * DM * 2048, 2048, 0};
              pg8::DenseOrder S; S.init(NTOK, DM, c.G, c.bid); EpiOut E{xin, p.out, (const float*)(p.ws + WS_MOD) + (size_t)l * 8 * NMOD + 2048};
              pg8::gemm_phase<EpiOut, pg8::DenseOrder, pg8::DenseRows, false, true>(c.lds, g, S, E, pg8::DenseRows(), c.wave);
              if constexpr (PROBE_ID == 13) { if (l == 0) { __syncthreads(); pg8::gemm_phase<EpiOut, pg8::DenseOrder, pg8::DenseRows, false, true>(c.lds, g, S, E, pg8::DenseRows(), c.wave); } } }
    if constexpr (Q == 8) RUN(14, phase_norm_router(p, c, l, p.out));
    if constexpr (Q == 9) RUN(15, phase_route_assign(p, c));
    if constexpr (Q == 11) { pg8::Gemm g{(const bf16_t*)(p.ws + WS_H), (const bf16_t*)(p.ws + WS_GU), DM, (size_t)512 * DM * 2};
               MoeOrder S{(const int*)(p.ws + WS_RINFO), 2, c.G, c.bid}; EpiH E{(bf16_t*)(p.ws + WS_HMID)};
               GatherRows AM{(const int*)(p.ws + WS_SLOTTOK), (const int*)(p.ws + WS_RINFO)};
               RUN(16, (pg8::gemm_phase<EpiH, MoeOrder, GatherRows, true, true>(c.lds, g, S, E, AM, c.wave))); }
    if constexpr (Q == 12) { pg8::Gemm g{(const bf16_t*)(p.ws + WS_HMID), (const bf16_t*)(p.ws + WS_DN), 256, (size_t)DM * 256 * 2};
               MoeOrder S{(const int*)(p.ws + WS_RINFO), 4, c.G, c.bid};
               EpiY E{(bf16_t*)(p.ws + WS_Y), (bf16_t*)(p.ws + WS_H), (const int*)(p.ws + WS_RINFO)};
               RUN(17, (pg8::gemm_phase<EpiY, MoeOrder, pg8::DenseRows, true, true>(c.lds, g, S, E, pg8::DenseRows(), c.wave))); }
    if constexpr (Q == 13) phase_combine(p, c, l);
}

#if MK_MEGA
__global__ void __launch_bounds__(NTHREADS, 2) trunk_kernel(Params p) {
    extern __shared__ __attribute__((aligned(16))) unsigned char lds_raw[];
    Ctx c; c.lds = (LAS unsigned char*)lds_raw; c.tid = 0; c.lane = 0; c.wave = __builtin_amdgcn_readfirstlane(threadIdx.x >> 6); c.G = gridDim.x; c.bid = blockIdx.x;
    cg::grid_group grid = cg::this_grid();
    unsigned* const xbar = (unsigned*)(p.ws + WS_CTL) + 4096;
    if (threadIdx.x == 0) { params_to_lds(p, c.lds); ((LAS unsigned*)(c.lds + LDS_XBST))[0] = 0u; ((LAS unsigned*)(c.lds + LDS_XBST))[1] = 0u; ((LAS unsigned long long*)(c.lds + LDS_PTAB))[35] = (unsigned long long)xbar;
                            (void)xb_add(&xbar[XB_XCNT(xb_xcc_id())], 1u); }
    __syncthreads();
#define GSYNC1() do { unsigned* bar_ = (unsigned*)(__attribute__((address_space(1))) unsigned*)uni64(((const LAS unsigned long long*)(c.lds + LDS_PTAB))[35]); \
        xcd_barrier(bar_, (volatile LAS unsigned*)(c.lds + LDS_XBST), (c.wave == 0) && (fresh_lane() == 0)); } while (0)
#define GSYNC() do { GSYNC1(); if constexpr (PROBE_ID == 18) GSYNC1(); } while (0)
#define LAYER(l) do { \
        run_q<0>(p, c, l); GSYNC(); run_q<1>(p, c, l); GSYNC(); run_q<2>(p, c, l); GSYNC(); run_q<3>(p, c, l); GSYNC(); run_q<4>(p, c, l); GSYNC(); \
        run_q<5>(p, c, l); GSYNC(); run_q<6>(p, c, l); GSYNC(); run_q<7>(p, c, l); GSYNC(); run_q<8>(p, c, l); GSYNC(); run_q<9>(p, c, l); GSYNC(); \
        run_q<11>(p, c, l); GSYNC(); run_q<12>(p, c, l); GSYNC(); run_q<13>(p, c, l); } while (0)
    run_q<14>(p, c, 0); __syncthreads(); grid.sync();
    LAYER(0); GSYNC();
    LAYER(1);
}
#else
template <int Q> __global__ void __launch_bounds__(NTHREADS, 2) phase_kernel(Params p) {
    extern __shared__ __attribute__((aligned(16))) unsigned char lds_raw[];
    Ctx c; c.lds = (LAS unsigned char*)lds_raw; c.tid = 0; c.lane = 0; c.wave = __builtin_amdgcn_readfirstlane(threadIdx.x >> 6); c.G = gridDim.x; c.bid = blockIdx.x;
    run_q<Q>(p, c, p.layer);
}
template <int Q> static void launch_q(const Params& p, int grid, hipStream_t stream) {
    static bool attr = false;
    if (!attr) { (void)hipFuncSetAttribute((const void*)phase_kernel<Q>, hipFuncAttributeMaxDynamicSharedMemorySize, LDS_BYTES); attr = true; }
    hipLaunchKernelGGL(phase_kernel<Q>, dim3(grid), dim3(NTHREADS), LDS_BYTES, stream, p);
}
#endif

extern "C" void kernel_launch(void* const* d_in, const int* in_sizes, int n_in, void* d_out, int out_size, void* d_ws, size_t ws_size, hipStream_t stream) {
    static int grid = 0;
    if (grid == 0) {
        if (n_in != 33 || out_size != NTOK * DM || ws_size < WS_END) { fprintf(stderr, "kernel_launch: unexpected shapes (n_in %d out %d ws %zu)\n", n_in, out_size, ws_size); grid = -1; return; }
        int dev = 0, cus = 0;
        (void)hipGetDevice(&dev); (void)hipDeviceGetAttribute(&cus, hipDeviceAttributeMultiprocessorCount, dev);
        grid = cus > 0 ? cus : 256;
#if MK_MEGA
        int per_cu = 0;
        if (hipFuncSetAttribute((const void*)trunk_kernel, hipFuncAttributeMaxDynamicSharedMemorySize, LDS_BYTES) != hipSuccess) { fprintf(stderr, "kernel_launch: hipFuncSetAttribute failed\n"); grid = -1; return; }
        if (hipOccupancyMaxActiveBlocksPerMultiprocessor(&per_cu, (const void*)trunk_kernel, NTHREADS, LDS_BYTES) != hipSuccess || per_cu < 1) { fprintf(stderr, "kernel_launch: occupancy query says %d blocks/CU\n", per_cu); grid = -1; return; }
        (void)hipGetLastError();
#endif
    }
    if (grid < 0) return;
    (void)hipMemsetAsync((char*)d_ws + WS_CTL, 0, CTL_ZERO_BYTES, stream);
    Params p{};
    for (int i = 0; i < 33; ++i) p.in[i] = (const float*)d_in[i];
    p.out = (float*)d_out; p.ws = (unsigned char*)d_ws;
#if MK_MEGA
    void* args[] = {&p};
    hipError_t e = hipLaunchCooperativeKernel((const void*)trunk_kernel, dim3(grid), dim3(NTHREADS), args, LDS_BYTES, stream);
    if (e != hipSuccess) fprintf(stderr, "cooperative launch failed: %s (grid %d)\n", hipGetErrorString(e), grid);
#else
    p.layer = 0; launch_q<14>(p, grid, stream);
    for (int l = 0; l < NLAYER; ++l) {
        p.layer = l;
        launch_q<0>(p, grid, stream); launch_q<1>(p, grid, stream); launch_q<2>(p, grid, stream); launch_q<3>(p, grid, stream); launch_q<4>(p, grid, stream);
        launch_q<5>(p, grid, stream); launch_q<6>(p, grid, stream); launch_q<7>(p, grid, stream); launch_q<8>(p, grid, stream); launch_q<9>(p, grid, stream);
        launch_q<10>(p, grid, stream); launch_q<11>(p, grid, stream); launch_q<12>(p, grid, stream); launch_q<13>(p, grid, stream);
    }
#endif
}
```

```cpp
#include <hip/hip_runtime.h>
#include <hip/hip_cooperative_groups.h>
#include <cstdio>
#include <cstdint>
namespace cg = cooperative_groups;

#ifndef MK_MEGA
#define MK_MEGA 1
#endif

#define LAS __attribute__((address_space(3)))
typedef unsigned short bf16_t;
typedef short bf16x8 __attribute__((ext_vector_type(8)));
typedef float f32x4 __attribute__((ext_vector_type(4)));
typedef float f32x2 __attribute__((ext_vector_type(2)));
typedef unsigned u32x4 __attribute__((ext_vector_type(4)));
typedef unsigned u32x2 __attribute__((ext_vector_type(2)));

constexpr int NTOK = 16384, DM = 1024, SEQ = 2048, NBATCH = 8, NLAYER = 2;
constexpr int DIN = 5648, NU = 5632;
constexpr int UZ = 0, UXS = 1024, UB = 2048, UC = 2304, UHQ = 2560, UHF = 3072, UHV = 3584, UHG = 4096, ULG = 4608, ULX = 5120;
constexpr int NMOD = 6144;
constexpr float EPS = 1e-6f;
constexpr int NEXP = 64, TOPK = 8;
constexpr int MAXSLOT = 147456;
constexpr int NTHREADS = 512, NWAVES = 8;
constexpr int LDS_BYTES = 160 * 1024;
constexpr int LDS_PTAB = LDS_BYTES - 512;

constexpr size_t MiB = (size_t)1 << 20;
constexpr size_t WS_CTL = 0, CTL_ZERO_BYTES = 1 * MiB;
constexpr size_t WS_MOD = 1 * MiB;
constexpr size_t WS_LB = WS_MOD + 512 * 1024;
constexpr size_t WS_LRUW = WS_LB + 8192;
constexpr size_t WS_DTRAW = 2 * MiB, WS_DT = 3 * MiB, WS_ACUM = 4 * MiB;
constexpr size_t WS_HGBL = 5 * MiB;
constexpr size_t WS_SELM = 5 * MiB + 512 * 1024;
constexpr size_t WS_RW = 6 * MiB;
constexpr size_t WS_SLOTOF = 6 * MiB + 512 * 1024;
constexpr size_t WS_SLOTTOK = 7 * MiB;
constexpr size_t WS_RINFO = 7 * MiB + 768 * 1024;
constexpr size_t WS_CNT = 8 * MiB;
constexpr size_t WS_WRT = 9 * MiB;
constexpr size_t WS_WIN = 12 * MiB;
constexpr size_t WS_WOUT = 34 * MiB;
constexpr size_t WS_GU = 42 * MiB;
constexpr size_t WS_DN = 107 * MiB;
constexpr size_t WS_H = 140 * MiB;
constexpr size_t WS_U = 172 * MiB;
constexpr size_t WS_SST = 348 * MiB;
constexpr size_t WS_HST = 380 * MiB;
constexpr size_t WS_LA = 412 * MiB, WS_LH = 428 * MiB;
constexpr size_t WS_XBC = 444 * MiB;
constexpr size_t WS_YCAT = 492 * MiB;
constexpr size_t WS_HMID = 172 * MiB;
constexpr size_t WS_Y = 252 * MiB;
constexpr size_t WS_END = 556 * MiB;

__device__ __forceinline__ float bf2f(bf16_t b) { return __uint_as_float(((unsigned)b) << 16); }
typedef __bf16 bf16x2_hw __attribute__((ext_vector_type(2)));
__device__ __forceinline__ unsigned pk2(float lo, float hi) { f32x2 v = {lo, hi}; bf16x2_hw b = __builtin_convertvector(v, bf16x2_hw); return __builtin_bit_cast(unsigned, b); }
__device__ __forceinline__ unsigned f2bf(float f) { return pk2(f, 0.f) & 0xffffu; }
__device__ __forceinline__ float lo_bf(unsigned w) { return __uint_as_float(w << 16); }
__device__ __forceinline__ float hi_bf(unsigned w) { return __uint_as_float(w & 0xffff0000u); }
__device__ __forceinline__ float rcpf_(float x) { return __builtin_amdgcn_rcpf(x); }
__device__ __forceinline__ float rsqf_(float x) { return __builtin_amdgcn_rsqf(x); }
__device__ __forceinline__ float sigmoidf_(float x) { return rcpf_(1.0f + __expf(-x)); }
__device__ __forceinline__ float siluf_(float x) { return x * rcpf_(1.0f + __expf(-x)); }
__device__ __forceinline__ float softplusf_(float x) { return fmaxf(x, 0.f) + log1pf(__expf(-fabsf(x))); }
__device__ __forceinline__ float gelu_tanhf_(float x) { const float u = 0.7978845608028654f * (x + 0.044715f * x * x * x); const float t = 1.0f - 2.0f * rcpf_(1.0f + __expf(2.0f * u)); return 0.5f * x * (1.0f + t); }
__device__ __forceinline__ float shfl_xor_l(float v, int mask, int lane) { return __builtin_bit_cast(float, __builtin_amdgcn_ds_bpermute((lane ^ mask) << 2, __builtin_bit_cast(int, v))); }
__device__ __forceinline__ int shfl_up_l(int v, int d, int lane) { return __builtin_amdgcn_ds_bpermute((lane - d) << 2, v); }
__device__ __forceinline__ float shfl_up_f(float v, int d, int lane) { return __builtin_bit_cast(float, __builtin_amdgcn_ds_bpermute((lane - d) << 2, __builtin_bit_cast(int, v))); }
__device__ __forceinline__ float rdlane_f(float v, int src) { return __builtin_bit_cast(float, __builtin_amdgcn_readlane(__builtin_bit_cast(int, v), src)); }
__device__ __forceinline__ unsigned long long rdlane_u64(unsigned long long v, int src) {
    const unsigned lo = (unsigned)__builtin_amdgcn_readlane((int)(unsigned)v, src), hi = (unsigned)__builtin_amdgcn_readlane((int)(unsigned)(v >> 32), src); return ((unsigned long long)hi << 32) | lo; }
__device__ __forceinline__ float wave_sum(float v, int lane) {
#pragma unroll
    for (int o = 1; o < 64; o <<= 1) v += shfl_xor_l(v, o, lane);
    return v;
}
#define LDS_WAIT() asm volatile("s_waitcnt lgkmcnt(0)" ::: "memory")
__device__ __forceinline__ int fresh_lane() { unsigned ones = ~0u; asm volatile("" : "+s"(ones)); return (int)__builtin_amdgcn_mbcnt_hi(ones, __builtin_amdgcn_mbcnt_lo(ones, 0u)); }
#define MFMA16(a, b, c) __builtin_amdgcn_mfma_f32_16x16x32_bf16((a), (b), (c), 0, 0, 0)
typedef short s16x4 __attribute__((ext_vector_type(4)));
__device__ __forceinline__ bf16x8 tr_frag(const LAS bf16_t* img, int ld, int k0, int c0, int lane) {
    const int g = lane >> 4, q = (lane & 15) >> 2, pp = lane & 3;
    const LAS bf16_t* a0 = img + (k0 + 8 * g + q) * ld + c0 + 4 * pp;
    const s16x4 r0 = __builtin_amdgcn_ds_read_tr16_b64_v4i16((LAS s16x4*)a0);
    const s16x4 r1 = __builtin_amdgcn_ds_read_tr16_b64_v4i16((LAS s16x4*)(a0 + 4 * ld));
    return (bf16x8){r0[0], r0[1], r0[2], r0[3], r1[0], r1[1], r1[2], r1[3]};
}

namespace pg8 {
constexpr int BM = 256, BK = 64, HALF = 128, HTB = HALF * BK * 2, STAGE_BYTES = 8 * HTB, NXCD = 8, WGM = 8;
__device__ __forceinline__ int lds_byte(int r, int c) { const int st = (r >> 4) * 2 + (c >> 5), rr = r & 15, cc = c & 31, ob = rr * 64 + cc * 2; return st * 1024 + (ob ^ (((ob >> 9) & 1) << 5)); }
__device__ __forceinline__ void stage_rc(int b, int& R, int& C) { const int st = b / 1024, sb = b % 1024, swz = sb ^ (((sb >> 9) & 1) << 5); R = (st >> 1) * 16 + swz / 64; C = (st & 1) * 32 + (swz % 64) / 2; }
__device__ __forceinline__ int perm32(int rho) { const int n = rho >> 4, i = rho & 15; return 8 * (i >> 2) + 4 * n + (i & 3); }

struct Unit { int pm, pn, e; };
struct Gemm { const bf16_t* A; const bf16_t* Bt; int K; size_t estride; };

struct DenseOrder {
    int nM, nN, nwg, G, c;
    __device__ void init(int M, int N, int G_, int c_) { nM = M / BM; nN = N / BM; nwg = nM * nN; G = G_; c = c_; }
    __device__ bool next(int i, Unit& u) const {
        const long L = (long)i * G + c; if (L >= nwg) return false;
        int wgid = (int)L; { const int q = nwg / NXCD, r = nwg % NXCD, xcd = wgid % NXCD, off = wgid / NXCD; wgid = (xcd < r ? xcd * (q + 1) : r * (q + 1) + (xcd - r) * q) + off; }
        const int nig = WGM * nN, gid = wgid / nig, fm = gid * WGM, gsz = (nM - fm) < WGM ? (nM - fm) : WGM;
        u.pm = fm + ((wgid % nig) % gsz); u.pn = (wgid % nig) / gsz; u.e = 0; return true;
    }
};
struct DenseRows { __device__ __forceinline__ int row(const Unit& u, int r) const { return u.pm * BM + r; } };

template <class Epi, class Sched, class AMap, bool ALIGN_EPI, bool SP2>
__device__ __forceinline__ void gemm_phase(LAS unsigned char* lds, const Gemm g, const Sched& S, const Epi& E, const AMap& AM, int wave_id) {
    const int wid = wave_id, lane = fresh_lane(), tid = wid * 64 + lane, wr = wid >> 2, wc = wid & 3, fr = lane & 15, fq = lane >> 4;
    const int K = g.K, nt = K / BK;
    unsigned voffB0;
    { int R, C; stage_rc(tid * 16, R, C); const int Rb = Epi::PERM ? ((R & ~31) + perm32(R & 31)) : R; voffB0 = (unsigned)(Rb * K + C) * 2u; }
    const size_t p1step = (size_t)64 * K * 2;
    const size_t kstep = (size_t)(BK * 2);
    const size_t hstep = (size_t)HALF * K * 2;
    const size_t tstep = 2 * hstep;
    const unsigned ldsw = (unsigned)wid * 1024u;
    const int aoff = lds_byte(wr * 64 + fr, fq * 8), boff = lds_byte(wc * 32 + fr, fq * 8);
#define PG8_SA(b, h) (((b) * 2 + (h)) * HTB)
#define PG8_SB(b, h) ((4 + (b) * 2 + (h)) * HTB)
#define PG8_STAGE2(bufoff, gbase, v0, v1) do { \
        __builtin_amdgcn_global_load_lds((const unsigned*)((const char*)(gbase) + (v0)), (LAS unsigned*)(lds + (bufoff) + ldsw), 16, 0, 0); \
        __builtin_amdgcn_global_load_lds((const unsigned*)((const char*)(gbase) + (v1)), (LAS unsigned*)(lds + (bufoff) + ldsw + 8192), 16, 0, 0); } while (0)
#define PG8_STAGEB(bufoff, gbase) do { \
        __builtin_amdgcn_global_load_lds((const unsigned*)((const char*)(gbase) + voffB0), (LAS unsigned*)(lds + (bufoff) + ldsw), 16, 0, 0); \
        __builtin_amdgcn_global_load_lds((const unsigned*)((const char*)(gbase) + p1step + voffB0), (LAS unsigned*)(lds + (bufoff) + ldsw + 8192), 16, 0, 0); } while (0)
#define PG8_LDA(dst, b, h) do { _Pragma("unroll") for (int m = 0; m < 4; ++m) _Pragma("unroll") for (int k = 0; k < 2; ++k) dst[m][k] = *(const LAS bf16x8*)(lds + PG8_SA(b, h) + aoff + m * 2048 + k * 1024); } while (0)
#define PG8_LDB(dst, b, h) do { _Pragma("unroll") for (int n = 0; n < 2; ++n) _Pragma("unroll") for (int k = 0; k < 2; ++k) dst[n][k] = *(const LAS bf16x8*)(lds + PG8_SB(b, h) + boff + n * 2048 + k * 1024); } while (0)
#define PG8_MMA(ai, bj, At, Bt) do { __builtin_amdgcn_s_setprio(1); _Pragma("unroll") for (int m = 0; m < 4; ++m) _Pragma("unroll") for (int n = 0; n < 2; ++n) _Pragma("unroll") for (int k = 0; k < 2; ++k) \
        acc[ai][bj][m][n] = __builtin_amdgcn_mfma_f32_16x16x32_bf16(Bt[n][k], At[m][k], acc[ai][bj][m][n], 0, 0, 0); __builtin_amdgcn_s_setprio(0); } while (0)
#define PG8_WAIT_V(n) asm volatile("s_waitcnt vmcnt(" #n ")" ::: "memory")
#define PG8_WAIT_L(n) asm volatile("s_waitcnt lgkmcnt(" #n ")" ::: "memory")
#define PG8_BAR __builtin_amdgcn_s_barrier()
#define PG8_SCHED __builtin_amdgcn_sched_barrier(0)
#define PG8_AOFFS(u, v00, v01, v10, v11) do { int R_, C_; stage_rc(tid * 16, R_, C_); \
        v00 = (unsigned)(AM.row(u, R_) * K + C_) * 2u; v01 = (unsigned)(AM.row(u, R_ + 64) * K + C_) * 2u; \
        v10 = (unsigned)(AM.row(u, HALF + R_) * K + C_) * 2u; v11 = (unsigned)(AM.row(u, HALF + R_ + 64) * K + C_) * 2u; } while (0)
    Unit cur, nxt; int ui = 0;
    if (!S.next(0, cur)) return;
    f32x4 acc[2][2][4][2];
#pragma unroll
    for (int a = 0; a < 2; ++a)
#pragma unroll
        for (int b = 0; b < 2; ++b)
#pragma unroll
            for (int m = 0; m < 4; ++m)
#pragma unroll
                for (int n = 0; n < 2; ++n) acc[a][b][m][n] = (f32x4){0.f, 0.f, 0.f, 0.f};
    bf16x8 At[4][2], B0[2][2], B1[2][2];
    const char* const Abase = (const char*)g.A;
    const char* cB = (const char*)g.Bt + (size_t)cur.e * g.estride + (size_t)cur.pn * tstep;
    unsigned c00, c01, c10, c11, n00, n01, n10, n11;
    PG8_AOFFS(cur, c00, c01, c10, c11);
    n00 = c00; n01 = c01; n10 = c10; n11 = c11;
    if constexpr (SP2) {
        PG8_STAGEB(PG8_SB(0, 0), cB); PG8_STAGEB(PG8_SB(0, 1), cB + hstep); PG8_STAGE2(PG8_SA(0, 0), Abase, c00, c01); PG8_STAGE2(PG8_SA(0, 1), Abase, c10, c11);
        if (wr == 1) PG8_BAR;
        PG8_WAIT_V(2); PG8_BAR;
        PG8_STAGEB(PG8_SB(1, 0), cB + kstep); PG8_STAGE2(PG8_SA(1, 0), Abase + kstep, c00, c01); PG8_STAGEB(PG8_SB(1, 1), cB + hstep + kstep);
        PG8_WAIT_V(6); PG8_BAR;
    } else {
        PG8_STAGEB(PG8_SB(0, 0), cB); PG8_STAGE2(PG8_SA(0, 0), Abase, c00, c01); PG8_STAGEB(PG8_SB(0, 1), cB + hstep); PG8_STAGE2(PG8_SA(0, 1), Abase, c10, c11);
        if (wr == 1) PG8_BAR;
        PG8_WAIT_V(4); PG8_BAR;
        PG8_STAGEB(PG8_SB(1, 0), cB + kstep); PG8_STAGE2(PG8_SA(1, 0), Abase + kstep, c00, c01); PG8_STAGEB(PG8_SB(1, 1), cB + hstep + kstep);
        PG8_WAIT_V(6); PG8_BAR;
    }
    for (;;) {
        const bool has_next = S.next(ui + 1, nxt);
        const char* nB = cB;
        if (has_next) { nB = (const char*)g.Bt + (size_t)nxt.e * g.estride + (size_t)nxt.pn * tstep; PG8_AOFFS(nxt, n00, n01, n10, n11); }
        else { n00 = c00; n01 = c01; n10 = c10; n11 = c11; }
        for (int t = 0; t < nt; t += 2) {
            const bool last = (t == nt - 2);
            const char* a1 = Abase + (size_t)(t + 1) * kstep;
            const char* a2 = last ? Abase : Abase + (size_t)(t + 2) * kstep;
            const char* b2 = last ? nB : cB + (size_t)(t + 2) * kstep;
            const char* a3 = a2 + kstep; const char* b3 = b2 + kstep;
            const unsigned x00 = last ? n00 : c00, x01 = last ? n01 : c01, x10 = last ? n10 : c10, x11 = last ? n11 : c11;
            if constexpr (SP2) {
            PG8_LDB(B0, 0, 0); PG8_LDB(B1, 0, 1); PG8_SCHED; PG8_LDA(At, 0, 0); PG8_STAGE2(PG8_SA(1, 1), a1, c10, c11);
            PG8_WAIT_V(8); PG8_WAIT_L(0); PG8_BAR; PG8_MMA(0, 0, At, B0); PG8_MMA(0, 1, At, B1); PG8_BAR; PG8_SCHED;
            PG8_LDA(At, 0, 1); PG8_STAGEB(PG8_SB(0, 0), b2); PG8_STAGEB(PG8_SB(0, 1), b2 + hstep); PG8_STAGE2(PG8_SA(0, 0), a2, x00, x01);
            PG8_WAIT_V(8); PG8_WAIT_L(0); PG8_BAR; PG8_MMA(1, 0, At, B0); PG8_MMA(1, 1, At, B1); PG8_BAR; PG8_SCHED;
            PG8_LDB(B0, 1, 0); PG8_LDB(B1, 1, 1); PG8_SCHED; PG8_LDA(At, 1, 0); PG8_STAGE2(PG8_SA(0, 1), a2, x10, x11);
            PG8_WAIT_V(8); PG8_WAIT_L(0); PG8_BAR; PG8_MMA(0, 0, At, B0); PG8_MMA(0, 1, At, B1); PG8_BAR; PG8_SCHED;
            PG8_LDA(At, 1, 1); PG8_STAGEB(PG8_SB(1, 0), b3); PG8_STAGEB(PG8_SB(1, 1), b3 + hstep); PG8_STAGE2(PG8_SA(1, 0), a3, x00, x01);
            PG8_WAIT_V(8); PG8_WAIT_L(0); PG8_BAR; PG8_MMA(1, 0, At, B0); PG8_MMA(1, 1, At, B1); PG8_BAR; PG8_SCHED;
            } else {
            PG8_LDB(B0, 0, 0); PG8_SCHED; PG8_LDA(At, 0, 0); PG8_STAGE2(PG8_SA(1, 1), a1, c10, c11);
            PG8_WAIT_L(8); PG8_BAR; PG8_WAIT_L(0); PG8_MMA(0, 0, At, B0); PG8_BAR; PG8_SCHED;
            PG8_LDB(B1, 0, 1); PG8_STAGEB(PG8_SB(0, 0), b2);
            PG8_BAR; PG8_WAIT_L(0); PG8_MMA(0, 1, At, B1); PG8_BAR;
            PG8_LDA(At, 0, 1); PG8_STAGE2(PG8_SA(0, 0), a2, x00, x01);
            PG8_BAR; PG8_WAIT_L(0); PG8_MMA(1, 0, At, B0); PG8_BAR; PG8_SCHED;
            PG8_STAGEB(PG8_SB(0, 1), b2 + hstep);
            PG8_WAIT_V(6); PG8_BAR; PG8_MMA(1, 1, At, B1); PG8_BAR;
            PG8_LDB(B0, 1, 0); PG8_SCHED; PG8_LDA(At, 1, 0); PG8_STAGE2(PG8_SA(0, 1), a2, x10, x11);
            PG8_WAIT_L(8); PG8_BAR; PG8_WAIT_L(0); PG8_MMA(0, 0, At, B0); PG8_BAR; PG8_SCHED;
            PG8_LDB(B1, 1, 1); PG8_STAGEB(PG8_SB(1, 0), b3);
            PG8_BAR; PG8_WAIT_L(0); PG8_MMA(0, 1, At, B1); PG8_BAR;
            PG8_LDA(At, 1, 1); PG8_STAGE2(PG8_SA(1, 0), a3, x00, x01);
            PG8_BAR; PG8_WAIT_L(0); PG8_MMA(1, 0, At, B0); PG8_BAR; PG8_SCHED;
            PG8_STAGEB(PG8_SB(1, 1), b3 + hstep);
            PG8_WAIT_V(6); PG8_BAR; PG8_MMA(1, 1, At, B1); PG8_BAR;
            }
        }
        if constexpr (ALIGN_EPI) { if (wr == 0) PG8_BAR; }
        E(acc, cur, wr, wc);
        if (!has_next) break;
#pragma unroll
        for (int a = 0; a < 2; ++a)
#pragma unroll
            for (int b = 0; b < 2; ++b)
#pragma unroll
                for (int m = 0; m < 4; ++m)
#pragma unroll
                    for (int n = 0; n < 2; ++n) acc[a][b][m][n] = (f32x4){0.f, 0.f, 0.f, 0.f};
        cur = nxt; cB = nB; c00 = n00; c01 = n01; c10 = n10; c11 = n11; ++ui;
        if constexpr (ALIGN_EPI) { if (wr == 1) PG8_BAR; }
    }
    PG8_WAIT_V(0);
    if constexpr (!ALIGN_EPI) { if (wr == 0) PG8_BAR; }
    PG8_BAR;
#undef PG8_SA
#undef PG8_SB
#undef PG8_STAGE2
#undef PG8_STAGEB
#undef PG8_LDA
#undef PG8_LDB
#undef PG8_MMA
#undef PG8_WAIT_V
#undef PG8_WAIT_L
#undef PG8_BAR
#undef PG8_SCHED
#undef PG8_AOFFS
}
}

struct Params {
    const float* in[33];
    float* out;
    unsigned char* ws;
    int layer, pad;
};
enum { I_X = 0, I_C, I_ADAW, I_ADAB, I_NMIX, I_NFFN, I_WIN, I_SCW, I_SCB, I_SDTB, I_SALOG, I_SD, I_SNW, I_HLB, I_HNW, I_LCW, I_LCB, I_LWA, I_LBA, I_LWX, I_LBX, I_LLAM, I_LNW,
       I_WOUT, I_RW, I_RB, I_EG, I_EU, I_ED, I_SG, I_SU, I_SDN, I_FNW };

using pg8::Unit;
struct EpiU {
    static constexpr bool PERM = true;
    bf16_t* O; int ldc;
    __device__ __forceinline__ void operator()(const f32x4 (&acc)[2][2][4][2], const Unit& u, int wr, int wc) const {
        const int lane_ = fresh_lane(), fr = lane_ & 15, fq = lane_ >> 4;
        const int row0 = u.pm * 256 + wr * 64 + fr, col0 = u.pn * 256 + wc * 32 + 8 * fq;
#pragma unroll
        for (int ai = 0; ai < 2; ++ai)
#pragma unroll
            for (int m = 0; m < 4; ++m) { bf16_t* rowp = O + (size_t)(row0 + ai * 128 + m * 16) * ldc + col0;
#pragma unroll
                for (int bj = 0; bj < 2; ++bj) { const f32x4 v0 = acc[ai][bj][m][0], v1 = acc[ai][bj][m][1];
                    u32x4 w; w.x = pk2(v0[0], v0[1]); w.y = pk2(v0[2], v0[3]); w.z = pk2(v1[0], v1[1]); w.w = pk2(v1[2], v1[3]);
                    *(u32x4*)(rowp + bj * 128) = w; } }
    }
};
struct EpiOut {
    static constexpr bool PERM = false;
    const float* xin; float* xout; const float* gate;
    __device__ __forceinline__ void operator()(const f32x4 (&acc)[2][2][4][2], const Unit& u, int wr, int wc) const {
        const int lane_ = fresh_lane(), fr = lane_ & 15, fq = lane_ >> 4;
        const int row0 = u.pm * 256 + wr * 64 + fr, col0 = u.pn * 256 + wc * 32 + 4 * fq, b = u.pm >> 3;
        f32x4 gv[2][2];
#pragma unroll
        for (int bj = 0; bj < 2; ++bj)
#pragma unroll
            for (int n = 0; n < 2; ++n) gv[bj][n] = *(const f32x4*)(gate + (size_t)b * NMOD + col0 + bj * 128 + n * 16);
#pragma unroll
        for (int ai = 0; ai < 2; ++ai)
#pragma unroll
            for (int m = 0; m < 4; ++m) { const size_t off = (size_t)(row0 + ai * 128 + m * 16) * DM + col0;
#pragma unroll
                for (int bj = 0; bj < 2; ++bj)
#pragma unroll
                    for (int n = 0; n < 2; ++n) { const f32x4 xi = *(const f32x4*)(xin + off + bj * 128 + n * 16);
                        *(f32x4*)(xout + off + bj * 128 + n * 16) = xi + gv[bj][n] * acc[ai][bj][m][n]; }
                asm volatile("" ::: "memory"); }
    }
};
struct EpiH {
    static constexpr bool PERM = true;
    bf16_t* Hm;
    __device__ __forceinline__ void operator()(const f32x4 (&acc)[2][2][4][2], const Unit& u, int wr, int wc) const {
        const int lane_ = fresh_lane(), fr = lane_ & 15, fq = lane_ >> 4;
        const int row0 = u.pm * 256 + wr * 64 + fr, col0 = u.pn * 128 + wc * 32 + 8 * fq;
#pragma unroll
        for (int ai = 0; ai < 2; ++ai)
#pragma unroll
            for (int m = 0; m < 4; ++m) { bf16_t* rowp = Hm + (size_t)(row0 + ai * 128 + m * 16) * 256 + col0;
                f32x4 h0, h1;
#pragma unroll
                for (int j = 0; j < 4; ++j) { h0[j] = siluf_(acc[ai][0][m][0][j]) * acc[ai][1][m][0][j]; h1[j] = siluf_(acc[ai][0][m][1][j]) * acc[ai][1][m][1][j]; }
                u32x4 w; w.x = pk2(h0[0], h0[1]); w.y = pk2(h0[2], h0[3]); w.z = pk2(h1[0], h1[1]); w.w = pk2(h1[2], h1[3]);
                *(u32x4*)rowp = w; }
    }
};
struct EpiY {
    static constexpr bool PERM = true;
    bf16_t* Y; bf16_t* Ysh; const int* rinfo;
    __device__ __forceinline__ void operator()(const f32x4 (&acc)[2][2][4][2], const Unit& u, int wr, int wc) const {
        const int lane_ = fresh_lane(), fr = lane_ & 15, fq = lane_ >> 4;
        const int col0 = u.pn * 256 + wc * 32 + 8 * fq;
        bf16_t* base = Y + (size_t)u.pm * 256 * DM;
        if (u.e >= NEXP) base = Ysh + (size_t)(u.pm - rinfo[0]) * 256 * DM;
        base += (size_t)(wr * 64 + fr) * DM + col0;
#pragma unroll
        for (int ai = 0; ai < 2; ++ai)
#pragma unroll
            for (int m = 0; m < 4; ++m) { bf16_t* rowp = base + (size_t)(ai * 128 + m * 16) * DM;
#pragma unroll
                for (int bj = 0; bj < 2; ++bj) { const f32x4 v0 = acc[ai][bj][m][0], v1 = acc[ai][bj][m][1];
                    u32x4 w; w.x = pk2(v0[0], v0[1]); w.y = pk2(v0[2], v0[3]); w.z = pk2(v1[0], v1[1]); w.w = pk2(v1[2], v1[3]);
                    *(u32x4*)(rowp + bj * 128) = w; } }
    }
};
struct MoeOrder {
    const int* rinfo; int NQ, G, c;
    __device__ bool next(int i, Unit& u) const {
        const int nblk = rinfo[0]; const long L = (long)i * G + c;
        if (L >= (long)(nblk + 64) * NQ) return false;
        const int rb = (int)(L / NQ); u.pm = rb; u.pn = (int)(L % NQ); u.e = (rb < nblk) ? rinfo[64 + rb] : NEXP; return true;
    }
};
struct GatherRows {
    const int* slot_tok; const int* rinfo;
    __device__ __forceinline__ int row(const Unit& u, int r) const {
        const int nblk = rinfo[0];
        if (u.pm < nblk) { const int t = slot_tok[u.pm * 256 + r]; return t < 0 ? 0 : t; }
        return (u.pm - nblk) * 256 + r;
    }
};

struct Ctx { LAS unsigned char* lds; int tid, lane, wave, G, bid; };

template <class RowMap>
__device__ __forceinline__ void transpose_item(const float* W, int N, int k0, int n0, bf16_t* WT, int ldk, const RowMap& rm, LAS float* scr, int lane) {
    const int nn = n0 + (lane & 31);
#pragma unroll 8
    for (int i = 0; i < 32; ++i) { const int kk = 2 * i + (lane >> 5); scr[kk * 33 + (lane & 31)] = (nn < N) ? W[(size_t)(k0 + kk) * N + nn] : 0.f; }
    LDS_WAIT();
    const int c = lane & 7;
#pragma unroll
    for (int j = 0; j < 4; ++j) { const int n = (lane >> 3) + 8 * j; const LAS float* s = scr + (8 * c) * 33 + n;
        u32x4 o; o.x = pk2(s[0 * 33], s[1 * 33]); o.y = pk2(s[2 * 33], s[3 * 33]); o.z = pk2(s[4 * 33], s[5 * 33]); o.w = pk2(s[6 * 33], s[7 * 33]);
        const int dr = (n0 + n < N) ? rm(n0 + n) : -1;
        if (dr >= 0) *(u32x4*)(WT + (size_t)dr * ldk + k0 + 8 * c) = o; }
    LDS_WAIT();
}
struct RmIdent { __device__ __forceinline__ int operator()(int n) const { return n; } };
struct RmWin { __device__ __forceinline__ int operator()(int n) const { return n < 2560 ? n : (n < 2576 ? -1 : n - 16); } };
struct RmGate { __device__ __forceinline__ int operator()(int n) const { return (n >> 7) * 256 + (n & 127); } };
struct RmUp { __device__ __forceinline__ int operator()(int n) const { return (n >> 7) * 256 + 128 + (n & 127); } };

__device__ __forceinline__ void phase_prep_io(const Params& p, const Ctx& c) {
    LAS float* scr = (LAS float*)(c.lds + c.wave * 16384);
    const int gw = c.bid * NWAVES + c.wave, NGW = c.G * NWAVES;
    constexpr int I_IN = 16 * 177, I_OUT = 32 * 32, PER_L = I_IN + I_OUT;
    for (int it = gw; it < NLAYER * PER_L; it += NGW) {
        const int l = it / PER_L; int r = it % PER_L;
        if (r < I_IN) { const int kb = r / 177, nb = r % 177;
            transpose_item(p.in[I_WIN] + (size_t)l * DM * DIN, DIN, kb * 64, nb * 32, (bf16_t*)(p.ws + WS_WIN) + (size_t)l * NU * DM, DM, RmWin(), scr, c.lane); }
        else { r -= I_IN; const int kb = r / 32, nb = r % 32;
            transpose_item(p.in[I_WOUT] + (size_t)l * 2048 * DM, DM, kb * 64, nb * 32, (bf16_t*)(p.ws + WS_WOUT) + (size_t)l * DM * 2048, 2048, RmIdent(), scr, c.lane); }
    }
}
__device__ __forceinline__ void phase_prep_experts(const Params& p, const Ctx& c, int l) {
    LAS float* scr = (LAS float*)(c.lds + c.wave * 16384);
    const int gw = c.bid * NWAVES + c.wave, NGW = c.G * NWAVES;
    constexpr int PER_E = 3 * 128;
    bf16_t* GU = (bf16_t*)(p.ws + WS_GU); bf16_t* DN = (bf16_t*)(p.ws + WS_DN);
    for (int it = gw; it < 65 * PER_E; it += NGW) {
        const int e = it / PER_E; int r = it % PER_E; const int which = r / 128; r %= 128;
        if (which < 2) {
            const float* src = (e < NEXP) ? p.in[which == 0 ? I_EG : I_EU] + ((size_t)l * NEXP + e) * DM * 256 : p.in[which == 0 ? I_SG : I_SU] + (size_t)l * DM * 256;
            const int kb = r / 8, nb = r % 8;
            if (which == 0) transpose_item(src, 256, kb * 64, nb * 32, GU + (size_t)e * 512 * DM, DM, RmGate(), scr, c.lane);
            else transpose_item(src, 256, kb * 64, nb * 32, GU + (size_t)e * 512 * DM, DM, RmUp(), scr, c.lane);
        } else {
            const float* src = (e < NEXP) ? p.in[I_ED] + ((size_t)l * NEXP + e) * 256 * DM : p.in[I_SDN] + (size_t)l * 256 * DM;
            const int kb = r / 32, nb = r % 32;
            transpose_item(src, DM, kb * 64, nb * 32, DN + (size_t)e * DM * 256, 256, RmIdent(), scr, c.lane);
        }
    }
}
__device__ __forceinline__ void phase_prep_small(const Params& p, const Ctx& c) {
    LAS float* sc = (LAS float*)c.lds;
    LAS float* red = (LAS float*)(c.lds + 32768);
    float* mod = (float*)(p.ws + WS_MOD);
    bool have_sc = false;
    for (int it = c.bid; it < NLAYER * 96; it += c.G) {
        if (!have_sc) { for (int i = c.tid; i < 8 * 1024; i += NTHREADS) sc[i] = siluf_(p.in[I_C][i]); have_sc = true; }
        __syncthreads();
        const int l = it / 96, j0 = (it % 96) * 64, j = c.tid & 63, kg = c.tid >> 6;
        const float* W = p.in[I_ADAW] + (size_t)l * DM * NMOD + j0 + j;
        float a[8];
#pragma unroll
        for (int b = 0; b < 8; ++b) a[b] = 0.f;
#pragma unroll 16
        for (int k = kg * 128; k < kg * 128 + 128; ++k) { const float w = W[(size_t)k * NMOD];
#pragma unroll
            for (int b = 0; b < 8; ++b) a[b] += sc[b * 1024 + k] * w; }
#pragma unroll
        for (int b = 0; b < 8; ++b) red[(kg * 8 + b) * 64 + j] = a[b];
        __syncthreads();
        { const int b = c.tid >> 6; float s = 0.f;
#pragma unroll
          for (int g = 0; g < 8; ++g) s += red[(g * 8 + b) * 64 + j];
          mod[((size_t)l * 8 + b) * NMOD + j0 + j] = s + p.in[I_ADAB][(size_t)l * NMOD + j0 + j]; }
        __syncthreads();
    }
    if (c.bid == c.G - 1) {
        float* lb = (float*)(p.ws + WS_LB);
        for (int i = c.tid; i < 512; i += NTHREADS) { const float v0 = p.in[I_HLB][i], v1 = p.in[I_HLB][512 + i]; const float m = fmaxf(v0, v1), e0 = expf(v0 - m), e1 = expf(v1 - m);
            lb[i] = 0.f; lb[512 + i] = e1 / (e0 + e1); }
    }
    { float* WT = (float*)(p.ws + WS_WRT);
      for (int o = c.bid * NTHREADS + c.tid; o < NLAYER * 64 * 1024; o += c.G * NTHREADS) { const int k = o & 1023, e = (o >> 10) & 63, l = o >> 16; WT[o] = p.in[I_RW][((size_t)l * 1024 + k) * 64 + e]; } }
    { bf16_t* LW = (bf16_t*)(p.ws + WS_LRUW);
      for (int o = c.bid * NTHREADS + c.tid; o < NLAYER * 2 * 8 * 4096; o += c.G * NTHREADS) {
          const int i = o & 63, j = (o >> 6) & 63, g = (o >> 12) & 7, mat = (o >> 15) & 1, l = o >> 16;
          const float* src = p.in[mat == 0 ? I_LWA : I_LWX] + (((size_t)l * 8 + g) * 64 + i) * 64 + j;
          LW[o] = (bf16_t)f2bf(*src); } }
}

__device__ __forceinline__ void phase_norm_mix(const Params& p, const Ctx& c, int l, const float* xin) {
    LAS float* wdt = (LAS float*)c.lds;
    const float* Win = p.in[I_WIN] + (size_t)l * DM * DIN;
    for (int i = c.tid; i < 16 * 1024; i += NTHREADS) { const int k = i >> 4, j = i & 15; wdt[j * 1024 + k] = Win[(size_t)k * DIN + 2560 + j]; }
    __syncthreads();
    const float* mod = (const float*)(p.ws + WS_MOD) + (size_t)l * 8 * NMOD;
    const float* nw = p.in[I_NMIX] + (size_t)l * DM;
    bf16_t* H = (bf16_t*)(p.ws + WS_H); float* dtraw = (float*)(p.ws + WS_DTRAW);
    const int gw = c.bid * NWAVES + c.wave, NGW = c.G * NWAVES;
    f32x4 vn[4];
    if (gw < NTOK) {
#pragma unroll
        for (int j = 0; j < 4; ++j) vn[j] = ((const f32x4*)(xin + (size_t)gw * DM) + c.lane)[64 * j];
    }
    for (int tok = gw; tok < NTOK; tok += NGW) {
        const int b = tok >> 11;
        f32x4 v[4]; float ss = 0.f;
#pragma unroll
        for (int j = 0; j < 4; ++j) { v[j] = vn[j]; ss += (v[j][0] * v[j][0] + v[j][1] * v[j][1]) + (v[j][2] * v[j][2] + v[j][3] * v[j][3]); }
        if (tok + NGW < NTOK) {
#pragma unroll
            for (int j = 0; j < 4; ++j) vn[j] = ((const f32x4*)(xin + (size_t)(tok + NGW) * DM) + c.lane)[64 * j];
        }
        const float rstd = rsqf_(wave_sum(ss, c.lane) * (1.0f / DM) + EPS);
        f32x4 hv[4];
#pragma unroll
        for (int j = 0; j < 4; ++j) {
            const int col = 256 * j + 4 * c.lane;
            const f32x4 w4 = *(const f32x4*)(nw + col), sh = *(const f32x4*)(mod + (size_t)b * NMOD + col), sc = *(const f32x4*)(mod + (size_t)b * NMOD + 1024 + col);
            hv[j] = (v[j] * rstd * w4) * (sc + 1.0f) + sh;
            u32x2 o; o.x = pk2(hv[j][0], hv[j][1]); o.y = pk2(hv[j][2], hv[j][3]);
            *(u32x2*)(H + (size_t)tok * DM + col) = o;
        }
        float d16[16];
#pragma unroll
        for (int q = 0; q < 16; ++q) {
            float s2 = 0.f;
#pragma unroll
            for (int j = 0; j < 4; ++j) { const f32x4 wq = *(const LAS f32x4*)(wdt + q * 1024 + 256 * j + 4 * c.lane); s2 += (hv[j][0] * wq[0] + hv[j][1] * wq[1]) + (hv[j][2] * wq[2] + hv[j][3] * wq[3]); }
            d16[q] = s2;
            if ((q & 1) == 1) asm volatile("" ::: "memory");
        }
        float d8[8], d4[4], d2[2], d1;
        { const bool up = (c.lane & 32) != 0;
#pragma unroll
          for (int i = 0; i < 8; ++i) { const float snd = up ? d16[i] : d16[8 + i], kp = up ? d16[8 + i] : d16[i]; d8[i] = kp + shfl_xor_l(snd, 32, c.lane); } }
        { const bool up = (c.lane & 16) != 0;
#pragma unroll
          for (int i = 0; i < 4; ++i) { const float snd = up ? d8[i] : d8[4 + i], kp = up ? d8[4 + i] : d8[i]; d4[i] = kp + shfl_xor_l(snd, 16, c.lane); } }
        { const bool up = (c.lane & 8) != 0;
#pragma unroll
          for (int i = 0; i < 2; ++i) { const float snd = up ? d4[i] : d4[2 + i], kp = up ? d4[2 + i] : d4[i]; d2[i] = kp + shfl_xor_l(snd, 8, c.lane); } }
        { const bool up = (c.lane & 4) != 0; const float snd = up ? d2[0] : d2[1], kp = up ? d2[1] : d2[0]; d1 = kp + shfl_xor_l(snd, 4, c.lane); }
        d1 += shfl_xor_l(d1, 2, c.lane); d1 += shfl_xor_l(d1, 1, c.lane);
        if ((c.lane & 3) == 0) dtraw[(size_t)tok * 16 + ((c.lane >> 5) & 1) * 8 + ((c.lane >> 4) & 1) * 4 + ((c.lane >> 3) & 1) * 2 + ((c.lane >> 2) & 1)] = d1;
    }
}

__device__ __forceinline__ void phase_ssd_conv(const Params& p, const Ctx& c, int l) {
    const bf16_t* U = (const bf16_t*)(p.ws + WS_U); bf16_t* XA = (bf16_t*)(p.ws + WS_XBC);
    const float* cw = p.in[I_SCW] + (size_t)l * 4 * 1536; const float* cb = p.in[I_SCB] + (size_t)l * 1536;
    const float* dtraw = (const float*)(p.ws + WS_DTRAW); float* dt = (float*)(p.ws + WS_DT); float* acum = (float*)(p.ws + WS_ACUM);
    for (int idx = c.bid * NTHREADS + c.tid; idx < (NTOK / 4) * 192; idx += c.G * NTHREADS) {
        const int oct = idx % 192, tg = idx / 192, tok0 = tg * 4, t0 = tok0 & (SEQ - 1), c0 = oct * 8;
        float w[4][8], bb[8];
#pragma unroll
        for (int k = 0; k < 4; ++k) { const f32x4 a = *(const f32x4*)(cw + k * 1536 + c0), b2 = *(const f32x4*)(cw + k * 1536 + c0 + 4);
            w[k][0] = a[0]; w[k][1] = a[1]; w[k][2] = a[2]; w[k][3] = a[3]; w[k][4] = b2[0]; w[k][5] = b2[1]; w[k][6] = b2[2]; w[k][7] = b2[3]; }
        { const f32x4 a = *(const f32x4*)(cb + c0), b2 = *(const f32x4*)(cb + c0 + 4); bb[0] = a[0]; bb[1] = a[1]; bb[2] = a[2]; bb[3] = a[3]; bb[4] = b2[0]; bb[5] = b2[1]; bb[6] = b2[2]; bb[7] = b2[3]; }
        float x[7][8];
#pragma unroll
        for (int r = 0; r < 7; ++r) {
            u32x4 v = (u32x4){0u, 0u, 0u, 0u};
            if (t0 + r - 3 >= 0) v = *(const u32x4*)(U + (size_t)(tok0 + r - 3) * NU + UXS + c0);
#pragma unroll
            for (int j = 0; j < 4; ++j) { x[r][2 * j] = lo_bf(v[j]); x[r][2 * j + 1] = hi_bf(v[j]); }
        }
#pragma unroll
        for (int t = 0; t < 4; ++t) {
            float y[8];
#pragma unroll
            for (int j = 0; j < 8; ++j) y[j] = siluf_(bb[j] + w[0][j] * x[t][j] + w[1][j] * x[t + 1][j] + w[2][j] * x[t + 2][j] + w[3][j] * x[t + 3][j]);
            u32x4 o; o.x = pk2(y[0], y[1]); o.y = pk2(y[2], y[3]); o.z = pk2(y[4], y[5]); o.w = pk2(y[6], y[7]);
            *(u32x4*)(XA + (size_t)(tok0 + t) * 1536 + c0) = o;
        }
    }
    const int gw = c.bid * NWAVES + c.wave, NGW = c.G * NWAVES;
    for (int it = gw; it < 128; it += NGW) {
        const int tok0 = it * 128, h = c.lane & 15, qtr = c.lane >> 4;
        const float bias = p.in[I_SDTB][l * 16 + h], A = -expf(p.in[I_SALOG][l * 16 + h]);
        float d[32]; float cum = 0.f;
#pragma unroll
        for (int i = 0; i < 32; ++i) d[i] = softplusf_(dtraw[(size_t)(tok0 + qtr * 32 + i) * 16 + h] + bias);
#pragma unroll
        for (int i = 0; i < 32; ++i) cum += d[i] * A;
        const float c1 = shfl_up_f(cum, 16, c.lane), c2 = shfl_up_f(cum, 32, c.lane), c3 = shfl_up_f(cum, 48, c.lane);
        float off = 0.f; if (qtr >= 1) off += c1; if (qtr >= 2) off += c2; if (qtr >= 3) off += c3;
        float run = off;
#pragma unroll
        for (int i = 0; i < 32; ++i) { run += d[i] * A; dt[(size_t)(tok0 + qtr * 32 + i) * 16 + h] = d[i]; acum[(size_t)(tok0 + qtr * 32 + i) * 16 + h] = run; }
    }
}

__device__ __forceinline__ void phase_ssd_state(const Params& p, const Ctx& c) {
    LAS bf16_t* XS = (LAS bf16_t*)c.lds;
    LAS bf16_t* BS = (LAS bf16_t*)(c.lds + 128 * 72 * 2);
    const bf16_t* XA = (const bf16_t*)(p.ws + WS_XBC); const float* dt = (const float*)(p.ws + WS_DT); const float* acum = (const float*)(p.ws + WS_ACUM);
    bf16_t* ST = (bf16_t*)(p.ws + WS_SST);
    const int fr = c.lane & 15, fq = c.lane >> 4;
    for (int it = c.bid; it < 2048; it += c.G) {
        const int h = it & 15, bc = it >> 4, tok0 = bc * 128, g = h >> 3;
        const float aend = acum[(size_t)(tok0 + 127) * 16 + h];
        for (int i = c.tid; i < 128 * 8; i += NTHREADS) { const int lrow = i >> 3, ck = i & 7;
            const u32x4 r = *(const u32x4*)(XA + (size_t)(tok0 + lrow) * 1536 + h * 64 + ck * 8);
            const float f = dt[(size_t)(tok0 + lrow) * 16 + h] * __expf(aend - acum[(size_t)(tok0 + lrow) * 16 + h]);
            u32x4 o; o.x = pk2(lo_bf(r.x) * f, hi_bf(r.x) * f); o.y = pk2(lo_bf(r.y) * f, hi_bf(r.y) * f); o.z = pk2(lo_bf(r.z) * f, hi_bf(r.z) * f); o.w = pk2(lo_bf(r.w) * f, hi_bf(r.w) * f);
            *(LAS u32x4*)(XS + lrow * 72 + ck * 8) = o; }
        for (int i = c.tid; i < 128 * 16; i += NTHREADS) { const int lrow = i >> 4, ck = i & 15;
            *(LAS u32x4*)(BS + lrow * 136 + ck * 8) = *(const u32x4*)(XA + (size_t)(tok0 + lrow) * 1536 + 1024 + g * 128 + ck * 8); }
        __syncthreads();
        f32x4 acc[4];
#pragma unroll
        for (int m = 0; m < 4; ++m) acc[m] = (f32x4){0.f, 0.f, 0.f, 0.f};
#pragma unroll
        for (int ks = 0; ks < 4; ++ks) {
            const bf16x8 bfr = tr_frag(BS, 136, 32 * ks, 16 * c.wave, c.lane);
#pragma unroll
            for (int m = 0; m < 4; ++m) { const bf16x8 afr = tr_frag(XS, 72, 32 * ks, 16 * m, c.lane); acc[m] = MFMA16(bfr, afr, acc[m]); }
        }
#pragma unroll
        for (int m = 0; m < 4; ++m) { u32x2 o; o.x = pk2(acc[m][0], acc[m][1]); o.y = pk2(acc[m][2], acc[m][3]);
            *(u32x2*)(ST + (size_t)it * 8192 + (16 * m + fr) * 128 + 16 * c.wave + 4 * fq) = o; }
        __syncthreads();
    }
}
__device__ __forceinline__ void phase_ssd_scan(const Params& p, const Ctx& c) {
    unsigned* ST = (unsigned*)(p.ws + WS_SST); const float* acum = (const float*)(p.ws + WS_ACUM);
    for (int i = c.bid * NTHREADS + c.tid; i < 128 * 4096; i += c.G * NTHREADS) {
        const int e2 = i & 4095, bh = i >> 12, b = bh >> 4, h = bh & 15;
        float r0 = 0.f, r1 = 0.f;
        for (int ch = 0; ch < 16; ++ch) {
            const size_t it = (size_t)((b * 16 + ch) * 16 + h);
            const unsigned loc = ST[it * 4096 + e2];
            ST[it * 4096 + e2] = pk2(r0, r1);
            const float d = __expf(acum[(size_t)(b * SEQ + ch * 128 + 127) * 16 + h]);
            r0 = d * r0 + lo_bf(loc); r1 = d * r1 + hi_bf(loc);
        }
    }
}
__device__ __forceinline__ void phase_ssd_out(const Params& p, const Ctx& c, int l) {
    LAS bf16_t* Cs = (LAS bf16_t*)c.lds;
    LAS bf16_t* Bs = (LAS bf16_t*)(c.lds + 34816);
    LAS bf16_t* CBD = (LAS bf16_t*)(c.lds + 2 * 34816);
    LAS bf16_t* XS = (LAS bf16_t*)(c.lds + 3 * 34816);
    LAS bf16_t* STs = (LAS bf16_t*)(c.lds + 3 * 34816 + 18432);
    LAS float* acs = (LAS float*)(c.lds + 3 * 34816 + 18432 + 17408);
    const bf16_t* XA = (const bf16_t*)(p.ws + WS_XBC); const float* dt = (const float*)(p.ws + WS_DT); const float* acum = (const float*)(p.ws + WS_ACUM);
    const bf16_t* ST = (const bf16_t*)(p.ws + WS_SST); bf16_t* YP = (bf16_t*)(p.ws + WS_H);
    const int fr = c.lane & 15, fq = c.lane >> 4, w = c.wave;
    for (int it = c.bid; it < 2048; it += c.G) {
        const int h = it & 15, bc = it >> 4, tok0 = bc * 128, g = h >> 3;
        const float Dh = p.in[I_SD][l * 16 + h];
        for (int i = c.tid; i < 128 * 16; i += NTHREADS) { const int row = i >> 4, ck = i & 15;
            *(LAS u32x4*)(Bs + row * 136 + ck * 8) = *(const u32x4*)(XA + (size_t)(tok0 + row) * 1536 + 1024 + g * 128 + ck * 8);
            *(LAS u32x4*)(Cs + row * 136 + ck * 8) = *(const u32x4*)(XA + (size_t)(tok0 + row) * 1536 + 1280 + g * 128 + ck * 8); }
        for (int i = c.tid; i < 64 * 16; i += NTHREADS) { const int row = i >> 4, ck = i & 15;
            *(LAS u32x4*)(STs + row * 136 + ck * 8) = *(const u32x4*)(ST + (size_t)it * 8192 + row * 128 + ck * 8); }
        for (int i = c.tid; i < 128 * 8; i += NTHREADS) { const int lrow = i >> 3, ck = i & 7;
            const u32x4 r = *(const u32x4*)(XA + (size_t)(tok0 + lrow) * 1536 + h * 64 + ck * 8);
            const float f = dt[(size_t)(tok0 + lrow) * 16 + h];
            u32x4 o; o.x = pk2(lo_bf(r.x) * f, hi_bf(r.x) * f); o.y = pk2(lo_bf(r.y) * f, hi_bf(r.y) * f); o.z = pk2(lo_bf(r.z) * f, hi_bf(r.z) * f); o.w = pk2(lo_bf(r.w) * f, hi_bf(r.w) * f);
            *(LAS u32x4*)(XS + lrow * 72 + ck * 8) = o; }
        if (c.tid < 128) acs[c.tid] = acum[(size_t)(tok0 + c.tid) * 16 + h];
        __syncthreads();
        {
            f32x4 cb[8];
#pragma unroll
            for (int n = 0; n < 8; ++n) cb[n] = (f32x4){0.f, 0.f, 0.f, 0.f};
#pragma unroll
            for (int ks = 0; ks < 4; ++ks) {
                const bf16x8 afr = *(const LAS bf16x8*)(Cs + (16 * w + fr) * 136 + ks * 32 + 8 * fq);
#pragma unroll
                for (int n = 0; n < 8; ++n) { const bf16x8 bfr = *(const LAS bf16x8*)(Bs + (16 * n + fr) * 136 + ks * 32 + 8 * fq); cb[n] = MFMA16(bfr, afr, cb[n]); }
            }
            const int lr = 16 * w + fr; const float al = acs[lr];
#pragma unroll
            for (int n = 0; n < 8; ++n) { float v4[4];
#pragma unroll
                for (int r = 0; r < 4; ++r) { const int sc = 16 * n + 4 * fq + r; v4[r] = (sc <= lr) ? cb[n][r] * __expf(al - acs[sc]) : 0.f; }
                u32x2 o; o.x = pk2(v4[0], v4[1]); o.y = pk2(v4[2], v4[3]);
                *(LAS u32x2*)(CBD + lr * 136 + 16 * n + 4 * fq) = o; }
        }
        __syncthreads();
        {
            f32x4 a1[4], a2[4];
#pragma unroll
            for (int n = 0; n < 4; ++n) { a1[n] = (f32x4){0.f, 0.f, 0.f, 0.f}; a2[n] = (f32x4){0.f, 0.f, 0.f, 0.f}; }
#pragma unroll
            for (int ks = 0; ks < 4; ++ks) {
                const bf16x8 ad = *(const LAS bf16x8*)(CBD + (16 * w + fr) * 136 + ks * 32 + 8 * fq);
                const bf16x8 ac = *(const LAS bf16x8*)(Cs + (16 * w + fr) * 136 + ks * 32 + 8 * fq);
#pragma unroll
                for (int n = 0; n < 4; ++n) {
                    const bf16x8 bx = tr_frag(XS, 72, 32 * ks, 16 * n, c.lane);
                    const bf16x8 bs = *(const LAS bf16x8*)(STs + (16 * n + fr) * 136 + ks * 32 + 8 * fq);
                    a1[n] = MFMA16(bx, ad, a1[n]); a2[n] = MFMA16(bs, ac, a2[n]); }
            }
            const int lr = 16 * w + fr; const float ea = __expf(acs[lr]);
#pragma unroll
            for (int n = 0; n < 4; ++n) { const int pc = 16 * n + 4 * fq;
                const u32x2 xv = *(const u32x2*)(XA + (size_t)(tok0 + lr) * 1536 + h * 64 + pc);
                const float y0 = a1[n][0] + ea * a2[n][0] + Dh * lo_bf(xv.x), y1 = a1[n][1] + ea * a2[n][1] + Dh * hi_bf(xv.x);
                const float y2 = a1[n][2] + ea * a2[n][2] + Dh * lo_bf(xv.y), y3 = a1[n][3] + ea * a2[n][3] + Dh * hi_bf(xv.y);
                u32x2 o; o.x = pk2(y0, y1); o.y = pk2(y2, y3);
                *(u32x2*)(YP + (size_t)(tok0 + lr) * DM + h * 64 + pc) = o; }
        }
        __syncthreads();
    }
}
__device__ __forceinline__ void phase_ssd_gate(const Params& p, const Ctx& c, int l) {
    const bf16_t* YP = (const bf16_t*)(p.ws + WS_H); const bf16_t* U = (const bf16_t*)(p.ws + WS_U); bf16_t* YC = (bf16_t*)(p.ws + WS_YCAT);
    const float* nw = p.in[I_SNW] + (size_t)l * 1024;
    const int gw = c.bid * NWAVES + c.wave, NGW = c.G * NWAVES;
    for (int i = gw; i < NTOK * 2; i += NGW) {
        const int tok = i >> 1, g = i & 1, col = g * 512 + 8 * c.lane;
        const u32x4 yv = *(const u32x4*)(YP + (size_t)tok * DM + col), zv = *(const u32x4*)(U + (size_t)tok * NU + UZ + col);
        float v[8]; float ss = 0.f;
#pragma unroll
        for (int j = 0; j < 4; ++j) { v[2 * j] = lo_bf(yv[j]) * siluf_(lo_bf(zv[j])); v[2 * j + 1] = hi_bf(yv[j]) * siluf_(hi_bf(zv[j])); ss += v[2 * j] * v[2 * j] + v[2 * j + 1] * v[2 * j + 1]; }
        const float rstd = rsqf_(wave_sum(ss, c.lane) * (1.0f / 512.0f) + EPS);
        const f32x4 w0 = *(const f32x4*)(nw + col), w1 = *(const f32x4*)(nw + col + 4);
        u32x4 o; o.x = pk2(v[0] * rstd * w0[0], v[1] * rstd * w0[1]); o.y = pk2(v[2] * rstd * w0[2], v[3] * rstd * w0[3]);
        o.z = pk2(v[4] * rstd * w1[0], v[5] * rstd * w1[1]); o.w = pk2(v[6] * rstd * w1[2], v[7] * rstd * w1[3]);
        *(u32x4*)(YC + (size_t)tok * 2048 + col) = o;
    }
}

__device__ __forceinline__ void phase_hg_state(const Params& p, const Ctx& c, int l) {
    LAS float* Bf = (LAS float*)c.lds;
    LAS float* KK = (LAS float*)(c.lds + 33792);
    LAS bf16_t* KD = (LAS bf16_t*)(c.lds + 2 * 33792 + 2112);
    LAS bf16_t* VS = (LAS bf16_t*)(c.lds + 2 * 33792 + 2112 + 17408);
    const bf16_t* U = (const bf16_t*)(p.ws + WS_U); const float* lb = (const float*)(p.ws + WS_LB) + l * 512;
    bf16_t* ST = (bf16_t*)(p.ws + WS_HST); float* BL = (float*)(p.ws + WS_HGBL);
    const int fr = c.lane & 15, fq = c.lane >> 4, w = c.wave;
    for (int it = c.bid; it < 1024; it += c.G) {
        const int ch = it & 31, bh = it >> 5, h = bh & 3, b = bh >> 2, tok0 = b * SEQ + ch * 64;
        for (int i = c.tid; i < 64 * 16; i += NTHREADS) { const int sr = i >> 4, ck = i & 15;
            const size_t ro = (size_t)(tok0 + sr) * NU + h * 128 + ck * 8;
            const u32x4 rf = *(const u32x4*)(U + ro + UHF);
            *(LAS u32x4*)(VS + sr * 136 + ck * 8) = *(const u32x4*)(U + ro + UHV);
            const f32x4 l0 = *(const f32x4*)(lb + h * 128 + ck * 8), l1 = *(const f32x4*)(lb + h * 128 + ck * 8 + 4);
            f32x4 k0, k1, g0, g1;
            k0[0] = (1.0f - l0[0]) * sigmoidf_(-lo_bf(rf.x)); k0[1] = (1.0f - l0[1]) * sigmoidf_(-hi_bf(rf.x)); k0[2] = (1.0f - l0[2]) * sigmoidf_(-lo_bf(rf.y)); k0[3] = (1.0f - l0[3]) * sigmoidf_(-hi_bf(rf.y));
            k1[0] = (1.0f - l1[0]) * sigmoidf_(-lo_bf(rf.z)); k1[1] = (1.0f - l1[1]) * sigmoidf_(-hi_bf(rf.z)); k1[2] = (1.0f - l1[2]) * sigmoidf_(-lo_bf(rf.w)); k1[3] = (1.0f - l1[3]) * sigmoidf_(-hi_bf(rf.w));
#pragma unroll
            for (int j = 0; j < 4; ++j) { g0[j] = __logf(1.0f - k0[j]); g1[j] = __logf(1.0f - k1[j]); }
            *(LAS f32x4*)(KK + sr * 132 + ck * 8) = k0; *(LAS f32x4*)(KK + sr * 132 + ck * 8 + 4) = k1;
            *(LAS f32x4*)(Bf + sr * 132 + ck * 8) = g0; *(LAS f32x4*)(Bf + sr * 132 + ck * 8 + 4) = g1; }
        __syncthreads();
        { const int kc = c.tid & 127, q4 = c.tid >> 7; float vals[16]; float cum = 0.f;
#pragma unroll
          for (int i = 0; i < 16; ++i) { cum += Bf[(16 * q4 + i) * 132 + kc]; vals[i] = cum; }
          KK[(64 + q4) * 132 + kc] = cum;
          __syncthreads();
          float off = 0.f;
#pragma unroll
          for (int j = 0; j < 3; ++j) off += (j < q4) ? KK[(64 + j) * 132 + kc] : 0.f;
#pragma unroll
          for (int i = 0; i < 16; ++i) Bf[(16 * q4 + i) * 132 + kc] = vals[i] + off;
          if (q4 == 3) BL[(size_t)it * 128 + kc] = vals[15] + off; }
        __syncthreads();
        for (int i = c.tid; i < 64 * 16; i += NTHREADS) { const int sr = i >> 4, ck = i & 15;
            const f32x4 ka = *(const LAS f32x4*)(KK + sr * 132 + ck * 8), kb = *(const LAS f32x4*)(KK + sr * 132 + ck * 8 + 4);
            const f32x4 ba = *(const LAS f32x4*)(Bf + sr * 132 + ck * 8), bb = *(const LAS f32x4*)(Bf + sr * 132 + ck * 8 + 4);
            const f32x4 ea = *(const LAS f32x4*)(Bf + 63 * 132 + ck * 8), eb = *(const LAS f32x4*)(Bf + 63 * 132 + ck * 8 + 4);
            u32x4 o; o.x = pk2(ka[0] * __expf(ea[0] - ba[0]), ka[1] * __expf(ea[1] - ba[1])); o.y = pk2(ka[2] * __expf(ea[2] - ba[2]), ka[3] * __expf(ea[3] - ba[3]));
            o.z = pk2(kb[0] * __expf(eb[0] - bb[0]), kb[1] * __expf(eb[1] - bb[1])); o.w = pk2(kb[2] * __expf(eb[2] - bb[2]), kb[3] * __expf(eb[3] - bb[3]));
            *(LAS u32x4*)(KD + sr * 136 + ck * 8) = o; }
        __syncthreads();
        f32x4 acc[8];
#pragma unroll
        for (int n = 0; n < 8; ++n) acc[n] = (f32x4){0.f, 0.f, 0.f, 0.f};
#pragma unroll
        for (int ks = 0; ks < 2; ++ks) {
            const bf16x8 afr = tr_frag(VS, 136, 32 * ks, 16 * w, c.lane);
#pragma unroll
            for (int n = 0; n < 8; ++n) { const bf16x8 bfr = tr_frag(KD, 136, 32 * ks, 16 * n, c.lane); acc[n] = MFMA16(bfr, afr, acc[n]); }
        }
#pragma unroll
        for (int n = 0; n < 8; ++n) { u32x2 o; o.x = pk2(acc[n][0], acc[n][1]); o.y = pk2(acc[n][2], acc[n][3]);
            *(u32x2*)(ST + (size_t)it * 16384 + (16 * w + fr) * 128 + 16 * n + 4 * fq) = o; }
        __syncthreads();
    }
}
__device__ __forceinline__ void phase_hg_scan(const Params& p, const Ctx& c) {
    unsigned* ST = (unsigned*)(p.ws + WS_HST); const float* BL = (const float*)(p.ws + WS_HGBL);
    for (int i = c.bid * NTHREADS + c.tid; i < 32 * 8192; i += c.G * NTHREADS) {
        const int e2 = i & 8191, bh = i >> 13, k0 = (2 * e2) & 127;
        float r0 = 0.f, r1 = 0.f;
        for (int ch = 0; ch < 32; ++ch) {
            const size_t it = (size_t)(bh * 32 + ch);
            const unsigned loc = ST[it * 8192 + e2];
            ST[it * 8192 + e2] = pk2(r0, r1);
            const float d0 = __expf(BL[it * 128 + k0]), d1 = __expf(BL[it * 128 + k0 + 1]);
            r0 = d0 * r0 + lo_bf(loc); r1 = d1 * r1 + hi_bf(loc);
        }
    }
}
__device__ __forceinline__ void phase_hg_out(const Params& p, const Ctx& c, int l) {
    LAS bf16_t* Qs = (LAS bf16_t*)c.lds;
    LAS bf16_t* Ks = (LAS bf16_t*)(c.lds + 17408);
    LAS float* Bf = (LAS float*)(c.lds + 2 * 17408);
    LAS bf16_t* QB = Qs;
    LAS bf16_t* STs = (LAS bf16_t*)(c.lds + 2 * 17408 + 33792);
    LAS bf16_t* ATT = (LAS bf16_t*)(c.lds + 2 * 17408 + 33792 + 34816);
    LAS bf16_t* VS = (LAS bf16_t*)(c.lds + 2 * 17408 + 33792 + 34816 + 9216);
    LAS bf16_t* QI = (LAS bf16_t*)(c.lds + 2 * 17408 + 33792 + 34816 + 9216 + 17408);
    LAS bf16_t* KKI = (LAS bf16_t*)(c.lds + 2 * 17408 + 33792 + 34816 + 9216 + 17408 + 4352);
    const bf16_t* U = (const bf16_t*)(p.ws + WS_U); const float* lb = (const float*)(p.ws + WS_LB) + l * 512;
    const bf16_t* ST = (const bf16_t*)(p.ws + WS_HST); bf16_t* YC = (bf16_t*)(p.ws + WS_YCAT);
    const float* nw = p.in[I_HNW] + (size_t)l * 512;
    const int fr = c.lane & 15, fq = c.lane >> 4, w = c.wave;
    for (int it = c.bid; it < 1024; it += c.G) {
        const int ch = it & 31, bh = it >> 5, h = bh & 3, b = bh >> 2, tok0 = b * SEQ + ch * 64;
        for (int i = c.tid; i < 64 * 16; i += NTHREADS) { const int sr = i >> 4, ck = i & 15;
            const size_t ro = (size_t)(tok0 + sr) * NU + h * 128 + ck * 8;
            const u32x4 rq = *(const u32x4*)(U + ro + UHQ), rf = *(const u32x4*)(U + ro + UHF);
            *(LAS u32x4*)(VS + sr * 136 + ck * 8) = *(const u32x4*)(U + ro + UHV);
            const f32x4 l0 = *(const f32x4*)(lb + h * 128 + ck * 8), l1 = *(const f32x4*)(lb + h * 128 + ck * 8 + 4);
            f32x4 k0, k1, g0, g1;
            k0[0] = (1.0f - l0[0]) * sigmoidf_(-lo_bf(rf.x)); k0[1] = (1.0f - l0[1]) * sigmoidf_(-hi_bf(rf.x)); k0[2] = (1.0f - l0[2]) * sigmoidf_(-lo_bf(rf.y)); k0[3] = (1.0f - l0[3]) * sigmoidf_(-hi_bf(rf.y));
            k1[0] = (1.0f - l1[0]) * sigmoidf_(-lo_bf(rf.z)); k1[1] = (1.0f - l1[1]) * sigmoidf_(-hi_bf(rf.z)); k1[2] = (1.0f - l1[2]) * sigmoidf_(-lo_bf(rf.w)); k1[3] = (1.0f - l1[3]) * sigmoidf_(-hi_bf(rf.w));
#pragma unroll
            for (int j = 0; j < 4; ++j) { g0[j] = __logf(1.0f - k0[j]); g1[j] = __logf(1.0f - k1[j]); }
            u32x4 ko; ko.x = pk2(k0[0], k0[1]); ko.y = pk2(k0[2], k0[3]); ko.z = pk2(k1[0], k1[1]); ko.w = pk2(k1[2], k1[3]);
            u32x4 qo; qo.x = pk2(siluf_(lo_bf(rq.x)), siluf_(hi_bf(rq.x))); qo.y = pk2(siluf_(lo_bf(rq.y)), siluf_(hi_bf(rq.y))); qo.z = pk2(siluf_(lo_bf(rq.z)), siluf_(hi_bf(rq.z))); qo.w = pk2(siluf_(lo_bf(rq.w)), siluf_(hi_bf(rq.w)));
            *(LAS u32x4*)(Ks + sr * 136 + ck * 8) = ko; *(LAS u32x4*)(Qs + sr * 136 + ck * 8) = qo;
            *(LAS f32x4*)(Bf + sr * 132 + ck * 8) = g0; *(LAS f32x4*)(Bf + sr * 132 + ck * 8 + 4) = g1; }
        for (int i = c.tid; i < 128 * 16; i += NTHREADS) { const int row = i >> 4, ck = i & 15;
            *(LAS u32x4*)(STs + row * 136 + ck * 8) = *(const u32x4*)(ST + (size_t)it * 16384 + row * 128 + ck * 8); }
        __syncthreads();
        { const int kc = c.tid & 127, q4 = c.tid >> 7; float vals[16]; float cum = 0.f;
#pragma unroll
          for (int i = 0; i < 16; ++i) { cum += Bf[(16 * q4 + i) * 132 + kc]; vals[i] = cum; }
          LAS float* QT = (LAS float*)KKI;
          QT[q4 * 128 + kc] = cum;
          __syncthreads();
          float off = 0.f;
#pragma unroll
          for (int j = 0; j < 3; ++j) off += (j < q4) ? QT[j * 128 + kc] : 0.f;
#pragma unroll
          for (int i = 0; i < 16; ++i) Bf[(16 * q4 + i) * 132 + kc] = vals[i] + off; }
        __syncthreads();
        for (int pidx = c.tid; pidx < 1024; pidx += NTHREADS) {
            const int ib = pidx >> 8, tq = (pidx >> 4) & 15, sq = pidx & 15, t = 16 * ib + tq, s2 = 16 * ib + sq; float a = 0.f;
            if (sq <= tq) {
                for (int k = 0; k < 128; k += 4) {
                    const f32x4 bt = *(const LAS f32x4*)(Bf + t * 132 + k), bs = *(const LAS f32x4*)(Bf + s2 * 132 + k);
                    const u32x2 qv = *(const LAS u32x2*)(Qs + t * 136 + k), kv = *(const LAS u32x2*)(Ks + s2 * 136 + k);
                    a += lo_bf(qv.x) * lo_bf(kv.x) * __expf(bt[0] - bs[0]) + hi_bf(qv.x) * hi_bf(kv.x) * __expf(bt[1] - bs[1])
                       + lo_bf(qv.y) * lo_bf(kv.y) * __expf(bt[2] - bs[2]) + hi_bf(qv.y) * hi_bf(kv.y) * __expf(bt[3] - bs[3]);
                }
            }
            ATT[t * 72 + s2] = (bf16_t)f2bf(a);
        }
        for (int i = c.tid; i < 6 * 256; i += NTHREADS) { const int blk = i >> 8, e = i & 255; const int bi = (blk < 3) ? 0 : (blk < 5 ? 1 : 2), bj = (blk < 3) ? blk + 1 : (blk < 5 ? blk - 1 : 3);
            ATT[(16 * bi + (e >> 4)) * 72 + 16 * bj + (e & 15)] = (bf16_t)0; }
        for (int ib = 1; ib < 4; ++ib) {
            const int rref = 16 * ib - 1;
            for (int i = c.tid; i < 16 * 64; i += NTHREADS) { const int tq = i >> 6, kp = i & 63, t = 16 * ib + tq;
                const unsigned q2 = *(const LAS unsigned*)(Qs + t * 136 + 2 * kp);
                *(LAS unsigned*)(QI + tq * 136 + 2 * kp) = pk2(lo_bf(q2) * __expf(Bf[t * 132 + 2 * kp] - Bf[rref * 132 + 2 * kp]), hi_bf(q2) * __expf(Bf[t * 132 + 2 * kp + 1] - Bf[rref * 132 + 2 * kp + 1])); }
            for (int i = c.tid; i < 16 * ib * 64; i += NTHREADS) { const int s2 = i >> 6, kp = i & 63;
                const unsigned k2 = *(const LAS unsigned*)(Ks + s2 * 136 + 2 * kp);
                *(LAS unsigned*)(KKI + s2 * 136 + 2 * kp) = pk2(lo_bf(k2) * __expf(Bf[rref * 132 + 2 * kp] - Bf[s2 * 132 + 2 * kp]), hi_bf(k2) * __expf(Bf[rref * 132 + 2 * kp + 1] - Bf[s2 * 132 + 2 * kp + 1])); }
            __syncthreads();
            if (w < ib) {
                f32x4 a4 = (f32x4){0.f, 0.f, 0.f, 0.f};
#pragma unroll
                for (int ks = 0; ks < 4; ++ks) { const bf16x8 afr = *(const LAS bf16x8*)(QI + fr * 136 + ks * 32 + 8 * fq), bfr = *(const LAS bf16x8*)(KKI + (16 * w + fr) * 136 + ks * 32 + 8 * fq); a4 = MFMA16(afr, bfr, a4); }
#pragma unroll
                for (int r = 0; r < 4; ++r) ATT[(16 * ib + 4 * fq + r) * 72 + 16 * w + fr] = (bf16_t)f2bf(a4[r]);
            }
            __syncthreads();
        }
        for (int i = c.tid; i < 64 * 64; i += NTHREADS) { const int t = i >> 6, kp = i & 63;
            const unsigned q2 = *(const LAS unsigned*)(Qs + t * 136 + 2 * kp);
            *(LAS unsigned*)(Qs + t * 136 + 2 * kp) = pk2(lo_bf(q2) * __expf(Bf[t * 132 + 2 * kp]), hi_bf(q2) * __expf(Bf[t * 132 + 2 * kp + 1])); }
        __syncthreads();
        f32x4 acc[4];
#pragma unroll
        for (int m = 0; m < 4; ++m) acc[m] = (f32x4){0.f, 0.f, 0.f, 0.f};
#pragma unroll
        for (int ks = 0; ks < 4; ++ks) {
            const bf16x8 bfr = *(const LAS bf16x8*)(STs + (16 * w + fr) * 136 + ks * 32 + 8 * fq);
#pragma unroll
            for (int m = 0; m < 4; ++m) { const bf16x8 afr = *(const LAS bf16x8*)(QB + (16 * m + fr) * 136 + ks * 32 + 8 * fq); acc[m] = MFMA16(afr, bfr, acc[m]); }
        }
#pragma unroll
        for (int ks = 0; ks < 2; ++ks) {
            const bf16x8 bfr = tr_frag(VS, 136, 32 * ks, 16 * w, c.lane);
#pragma unroll
            for (int m = 0; m < 4; ++m) { const bf16x8 afr = *(const LAS bf16x8*)(ATT + (16 * m + fr) * 72 + ks * 32 + 8 * fq); acc[m] = MFMA16(afr, bfr, acc[m]); }
        }
#pragma unroll
        for (int m = 0; m < 4; ++m)
#pragma unroll
            for (int r = 0; r < 4; ++r) Bf[(16 * m + 4 * fq + r) * 132 + 16 * w + fr] = acc[m][r];
        __syncthreads();
        for (int t = w * 8; t < w * 8 + 8; ++t) {
            const f32x2 o = *(const LAS f32x2*)(Bf + t * 132 + 2 * c.lane);
            const float rstd = rsqf_(wave_sum(o.x * o.x + o.y * o.y, c.lane) * (1.0f / 128.0f) + EPS);
            const unsigned gv = *(const unsigned*)(U + (size_t)(tok0 + t) * NU + UHG + h * 128 + 2 * c.lane);
            const f32x2 wv = *(const f32x2*)(nw + h * 128 + 2 * c.lane);
            *(unsigned*)(YC + (size_t)(tok0 + t) * 2048 + 1024 + h * 128 + 2 * c.lane) = pk2(o.x * rstd * wv.x * siluf_(lo_bf(gv)), o.y * rstd * wv.y * siluf_(hi_bf(gv)));
        }
        __syncthreads();
    }
}

__device__ __forceinline__ void phase_lru1(const Params& p, const Ctx& c, int l) {
    LAS unsigned char* wl = c.lds + c.wave * 12288;
    LAS bf16_t* XB = (LAS bf16_t*)wl;
    LAS float* As = (LAS float*)(wl + 2304);
    LAS float* Us = (LAS float*)(wl + 2304 + 4096);
    const bf16_t* U = (const bf16_t*)(p.ws + WS_U); bf16_t* LA = (bf16_t*)(p.ws + WS_LA); bf16_t* LH = (bf16_t*)(p.ws + WS_LH);
    const bf16_t* LW = (const bf16_t*)(p.ws + WS_LRUW) + (size_t)l * 2 * 8 * 4096;
    const int fr = c.lane & 15, fq = c.lane >> 4, g = c.wave, chn = g * 64 + c.lane;
    const float cw0 = p.in[I_LCW][(size_t)l * 2048 + chn], cw1 = p.in[I_LCW][(size_t)l * 2048 + 512 + chn], cw2 = p.in[I_LCW][(size_t)l * 2048 + 1024 + chn], cw3 = p.in[I_LCW][(size_t)l * 2048 + 1536 + chn];
    const float cbias = p.in[I_LCB][l * 512 + chn];
    bf16x8 wfa[4][2], wfx[4][2];
#pragma unroll
    for (int n = 0; n < 4; ++n)
#pragma unroll
        for (int ks = 0; ks < 2; ++ks) { wfa[n][ks] = *(const bf16x8*)(LW + (size_t)(0 * 8 + g) * 4096 + (16 * n + fr) * 64 + ks * 32 + 8 * fq);
                                         wfx[n][ks] = *(const bf16x8*)(LW + (size_t)(1 * 8 + g) * 4096 + (16 * n + fr) * 64 + ks * 32 + 8 * fq); }
    float bav[4], bxv[4], spl[4];
#pragma unroll
    for (int n = 0; n < 4; ++n) { const int j = g * 64 + 16 * n + fr; bav[n] = p.in[I_LBA][l * 512 + j]; bxv[n] = p.in[I_LBX][l * 512 + j]; spl[n] = softplusf_(-p.in[I_LLAM][l * 512 + j]); }
    for (int it = c.bid; it < 256; it += c.G) {
        const int seg = it & 31, tok0 = (it >> 5) * SEQ + seg * 64;
        float x0 = 0.f, x1 = 0.f, x2 = 0.f;
        if (seg > 0) { x0 = bf2f(U[(size_t)(tok0 - 3) * NU + ULX + chn]); x1 = bf2f(U[(size_t)(tok0 - 2) * NU + ULX + chn]); x2 = bf2f(U[(size_t)(tok0 - 1) * NU + ULX + chn]); }
        float hrun = 0.f, arun = 1.f;
        for (int st = 0; st < 4; ++st) {
            const int t0 = tok0 + st * 16;
#pragma unroll
            for (int tt = 0; tt < 16; ++tt) { const float xr = bf2f(U[(size_t)(t0 + tt) * NU + ULX + chn]);
                const float xb = cbias + cw0 * x0 + cw1 * x1 + cw2 * x2 + cw3 * xr; x0 = x1; x1 = x2; x2 = xr;
                XB[tt * 72 + c.lane] = (bf16_t)f2bf(xb); }
            LDS_WAIT();
            f32x4 ar[4], ai[4];
#pragma unroll
            for (int n = 0; n < 4; ++n) { ar[n] = (f32x4){0.f, 0.f, 0.f, 0.f}; ai[n] = (f32x4){0.f, 0.f, 0.f, 0.f}; }
#pragma unroll
            for (int ks = 0; ks < 2; ++ks) { const bf16x8 afr = *(const LAS bf16x8*)(XB + fr * 72 + ks * 32 + 8 * fq);
#pragma unroll
                for (int n = 0; n < 4; ++n) { ar[n] = MFMA16(afr, wfa[n][ks], ar[n]); ai[n] = MFMA16(afr, wfx[n][ks], ai[n]); } }
#pragma unroll
            for (int n = 0; n < 4; ++n)
#pragma unroll
                for (int r = 0; r < 4; ++r) { const int t = 4 * fq + r, j = 16 * n + fr;
                    const float rg = sigmoidf_(ar[n][r] + bav[n]), ig = sigmoidf_(ai[n][r] + bxv[n]);
                    const float la = -8.0f * rg * spl[n], a = __expf(la), mult = sqrtf(fmaxf(fmaf(-a, a, 1.0f), 0.f));
                    As[t * 64 + j] = a; Us[t * 64 + j] = mult * ig * bf2f(XB[t * 72 + j]); }
            LDS_WAIT();
#pragma unroll
            for (int tt = 0; tt < 16; ++tt) { const float a = As[tt * 64 + c.lane], uu = Us[tt * 64 + c.lane];
                hrun = a * hrun + uu; arun = a * arun;
                LA[(size_t)(t0 + tt) * 512 + chn] = (bf16_t)f2bf(arun); LH[(size_t)(t0 + tt) * 512 + chn] = (bf16_t)f2bf(hrun); }
            LDS_WAIT();
        }
    }
}
__device__ __forceinline__ void phase_lru2(const Params& p, const Ctx& c, int l) {
    LAS float* YS = (LAS float*)c.lds;
    LAS float* PART = (LAS float*)(c.lds + 65536);
    const bf16_t* U = (const bf16_t*)(p.ws + WS_U); const bf16_t* LA = (const bf16_t*)(p.ws + WS_LA); const bf16_t* LH = (const bf16_t*)(p.ws + WS_LH);
    bf16_t* YC = (bf16_t*)(p.ws + WS_YCAT);
    const int g = c.wave, chn = g * 64 + c.lane;
    const float nwv = p.in[I_LNW][l * 512 + chn];
    for (int it = c.bid; it < 256; it += c.G) {
        const int seg = it & 31, b = it >> 5, tok0 = b * SEQ + seg * 64;
        float hin = 0.f;
        for (int s2 = 0; s2 < seg; ++s2) { const size_t row = (size_t)(b * SEQ + s2 * 64 + 63); hin = bf2f(LH[row * 512 + chn]) + bf2f(LA[row * 512 + chn]) * hin; }
        for (int sb = 0; sb < 2; ++sb) {
#pragma unroll 4
            for (int tt = 0; tt < 32; ++tt) { const size_t tok = (size_t)(tok0 + sb * 32 + tt);
                const float hh = bf2f(LH[tok * 512 + chn]) + bf2f(LA[tok * 512 + chn]) * hin;
                const float y = hh * gelu_tanhf_(bf2f(U[tok * NU + ULG + chn]));
                YS[tt * 512 + chn] = y;
                const float ss = wave_sum(y * y, c.lane);
                if (c.lane == 0) PART[tt * 8 + g] = ss; }
            __syncthreads();
#pragma unroll 4
            for (int tt = 0; tt < 32; ++tt) { const f32x4 p0 = *(const LAS f32x4*)(PART + tt * 8), p1 = *(const LAS f32x4*)(PART + tt * 8 + 4);
                const float tot = ((p0[0] + p0[1]) + (p0[2] + p0[3])) + ((p1[0] + p1[1]) + (p1[2] + p1[3]));
                const float rstd = rsqf_(tot * (1.0f / 512.0f) + EPS);
                YC[(size_t)(tok0 + sb * 32 + tt) * 2048 + 1536 + chn] = (bf16_t)f2bf(YS[tt * 512 + chn] * rstd * nwv); }
            __syncthreads();
        }
    }
}

__device__ __forceinline__ void phase_norm_router(const Params& p, const Ctx& c, int l, const float* xin) {
    constexpr int HSTR = 1028;
    LAS float* HS = (LAS float*)c.lds;
    LAS float* PL = (LAS float*)(c.lds + 16 * HSTR * 4);
    LAS float* LG = (LAS float*)(c.lds + 16 * HSTR * 4 + 32768);
    const float* mod = (const float*)(p.ws + WS_MOD) + (size_t)l * 8 * NMOD;
    const float* nw = p.in[I_NFFN] + (size_t)l * DM;
    const float* WT = (const float*)(p.ws + WS_WRT) + (size_t)l * 64 * 1024;
    const float rbias = p.in[I_RB][l * NEXP + c.lane];
    bf16_t* H = (bf16_t*)(p.ws + WS_H);
    unsigned long long* selm = (unsigned long long*)(p.ws + WS_SELM); float* rw = (float*)(p.ws + WS_RW);
    const int fr = c.lane & 15, fq = c.lane >> 4, w = c.wave;
    int* cnt = (int*)(p.ws + WS_CNT);
    f32x4 bw[8][4];
#pragma unroll
    for (int j = 0; j < 8; ++j)
#pragma unroll
        for (int n = 0; n < 4; ++n) bw[j][n] = *(const f32x4*)(WT + (size_t)(16 * n + fr) * 1024 + 128 * w + 16 * j + 4 * fq);
    int ecount = 0;
    f32x4 xn[2][4];
    if (c.bid < NTOK / 16) {
#pragma unroll
        for (int q = 0; q < 2; ++q)
#pragma unroll
            for (int j = 0; j < 4; ++j) xn[q][j] = ((const f32x4*)(xin + (size_t)(c.bid * 16 + 2 * w + q) * DM) + c.lane)[64 * j];
    }
    for (int t16 = c.bid; t16 < NTOK / 16; t16 += c.G) {
        const int tokb = t16 * 16, b = tokb >> 11;
#pragma unroll
        for (int q = 0; q < 2; ++q) {
            const int tl = 2 * w + q, tok = tokb + tl;
            f32x4 v[4]; float ss = 0.f;
#pragma unroll
            for (int j = 0; j < 4; ++j) { v[j] = xn[q][j]; ss += (v[j][0] * v[j][0] + v[j][1] * v[j][1]) + (v[j][2] * v[j][2] + v[j][3] * v[j][3]); }
            const float rstd = rsqf_(wave_sum(ss, c.lane) * (1.0f / DM) + EPS);
#pragma unroll
            for (int j = 0; j < 4; ++j) {
                const int col = 256 * j + 4 * c.lane;
                const f32x4 w4 = *(const f32x4*)(nw + col), sh = *(const f32x4*)(mod + (size_t)b * NMOD + 3072 + col), sc = *(const f32x4*)(mod + (size_t)b * NMOD + 4096 + col);
                const f32x4 h = (v[j] * rstd * w4) * (sc + 1.0f) + sh;
                u32x2 o; o.x = pk2(h[0], h[1]); o.y = pk2(h[2], h[3]);
                *(u32x2*)(H + (size_t)tok * DM + col) = o;
                *(LAS f32x4*)(HS + tl * HSTR + col) = h;
            }
        }
        if (t16 + c.G < NTOK / 16) {
#pragma unroll
            for (int q = 0; q < 2; ++q)
#pragma unroll
                for (int j = 0; j < 4; ++j) xn[q][j] = ((const f32x4*)(xin + (size_t)((t16 + c.G) * 16 + 2 * w + q) * DM) + c.lane)[64 * j];
        }
        __syncthreads();
        {
            f32x4 acc[4];
#pragma unroll
            for (int n = 0; n < 4; ++n) acc[n] = (f32x4){0.f, 0.f, 0.f, 0.f};
#pragma unroll
            for (int j = 0; j < 8; ++j) {
                const int kk = 128 * w + 16 * j + 4 * fq;
                const f32x4 a4 = *(const LAS f32x4*)(HS + fr * HSTR + kk);
#pragma unroll
                for (int i = 0; i < 4; ++i)
#pragma unroll
                    for (int n = 0; n < 4; ++n) acc[n] = __builtin_amdgcn_mfma_f32_16x16x4f32(a4[i], bw[j][n][i], acc[n], 0, 0, 0);
            }
#pragma unroll
            for (int n = 0; n < 4; ++n)
#pragma unroll
                for (int r = 0; r < 4; ++r) PL[(w * 16 + 4 * fq + r) * 64 + 16 * n + fr] = acc[n][r];
        }
        __syncthreads();
        for (int i = c.tid; i < 1024; i += NTHREADS) { float s2 = 0.f;
#pragma unroll
            for (int ww = 0; ww < 8; ++ww) s2 += PL[ww * 1024 + i];
            LG[i] = s2; }
        __syncthreads();
#pragma unroll
        for (int q = 0; q < 2; ++q) {
            const int tl = 2 * w + q, tok = tokb + tl;
            const float s = sigmoidf_(LG[tl * 64 + c.lane]), v = s + rbias;
            float m1 = v;
            m1 = fmaxf(m1, shfl_xor_l(m1, 1, c.lane)); m1 = fmaxf(m1, shfl_xor_l(m1, 2, c.lane)); m1 = fmaxf(m1, shfl_xor_l(m1, 4, c.lane));
            const unsigned long long eq = __ballot(v == m1);
            const int gbase = c.lane & ~7;
            const unsigned gm = (unsigned)((eq >> gbase) & 0xffull);
            const int first = gbase + __builtin_ctz(gm);
            float m2 = (c.lane == first) ? -3.0e38f : v;
            m2 = fmaxf(m2, shfl_xor_l(m2, 1, c.lane)); m2 = fmaxf(m2, shfl_xor_l(m2, 2, c.lane)); m2 = fmaxf(m2, shfl_xor_l(m2, 4, c.lane));
            const float gs = m1 + m2;
            const int mygrp = c.lane >> 3; int grank = 0;
#pragma unroll
            for (int g2 = 0; g2 < 8; ++g2) { const float o = rdlane_f(gs, g2 * 8); grank += (o > gs || (o == gs && g2 < mygrp)) ? 1 : 0; }
            const float vm = (grank < 4) ? v : -1.0e4f;
            int erank = 0;
            for (int e2 = 0; e2 < 64; ++e2) { const float o = rdlane_f(vm, e2); erank += (o > vm || (o == vm && e2 < c.lane)) ? 1 : 0; }
            const bool sel = erank < TOPK;
            const unsigned long long mask = __ballot(sel);
            const float wsum = wave_sum(sel ? s : 0.f, c.lane);
            if (sel) { const int kk = __builtin_popcountll(mask & ((1ull << c.lane) - 1ull)); rw[(size_t)tok * 8 + kk] = s * rcpf_(wsum) * 2.5f; }
            if (c.lane == 0) selm[tok] = mask;
            ecount += sel ? 1 : 0;
        }
        __syncthreads();
    }
    { LAS int* CW = (LAS int*)c.lds; CW[w * 64 + c.lane] = ecount; __syncthreads();
      if (w == 0) { int tot = 0;
#pragma unroll
          for (int ww = 0; ww < 8; ++ww) tot += CW[ww * 64 + c.lane];
          cnt[c.bid * 64 + c.lane] = tot; }
      __syncthreads(); }
}
__device__ __forceinline__ void phase_route_assign(const Params& p, const Ctx& c) {
    const unsigned long long* selm = (const unsigned long long*)(p.ws + WS_SELM); const int* cnt = (const int*)(p.ws + WS_CNT);
    int* slot_tok = (int*)(p.ws + WS_SLOTTOK); int* slot_of = (int*)(p.ws + WS_SLOTOF); int* rinfo = (int*)(p.ws + WS_RINFO);
    const int gw = c.bid * NWAVES + c.wave, NGW = c.G * NWAVES;
    for (int ch = gw; ch < c.G; ch += NGW) {
        int total = 0, before = 0;
        for (int j = 0; j < c.G; ++j) { const int v = cnt[j * 64 + c.lane]; total += v; before += (j < ch) ? v : 0; }
        const int pad = (total + 255) & ~255;
        int incl = pad;
#pragma unroll
        for (int o = 1; o < 64; o <<= 1) { const int t = shfl_up_l(incl, o, c.lane); if (c.lane >= o) incl += t; }
        const int pstart = incl - pad;
        int run = pstart + before;
        for (int t16 = ch; t16 < NTOK / 16; t16 += c.G) {
            const unsigned long long mine = (c.lane < 16) ? selm[t16 * 16 + c.lane] : 0ull;
            for (int i = 0; i < 16; ++i) {
                const unsigned long long m = rdlane_u64(mine, i); const int tok = t16 * 16 + i;
                if ((m >> c.lane) & 1ull) { const int kk = __builtin_popcountll(m & ((1ull << c.lane) - 1ull)); slot_tok[run] = tok; slot_of[tok * 8 + kk] = run; ++run; }
            }
        }
        if (ch == 0) {
            for (int s2 = pstart + total; s2 < pstart + pad; ++s2) slot_tok[s2] = -1;
            for (int bk = pstart >> 8; bk < (pstart + pad) >> 8; ++bk) rinfo[64 + bk] = c.lane;
            if (c.lane == 63) rinfo[0] = incl >> 8;
        }
    }
}
__device__ __forceinline__ void phase_combine(const Params& p, const Ctx& c, int l) {
    const float* gate = (const float*)(p.ws + WS_MOD) + (size_t)l * 8 * NMOD + 5120;
    const bf16_t* Y = (const bf16_t*)(p.ws + WS_Y); const bf16_t* YS = (const bf16_t*)(p.ws + WS_H); const int* slot_of = (const int*)(p.ws + WS_SLOTOF); const float* rw = (const float*)(p.ws + WS_RW);
    const float* fw = p.in[I_FNW];
    const int gw = c.bid * NWAVES + c.wave, NGW = c.G * NWAVES;
    for (int tok = gw; tok < NTOK; tok += NGW) {
        const int b = tok >> 11;
        f32x4 acc[4];
#pragma unroll
        for (int j = 0; j < 4; ++j) acc[j] = (f32x4){0.f, 0.f, 0.f, 0.f};
#pragma unroll
        for (int k = 0; k < 8; ++k) { const int sl = slot_of[tok * 8 + k]; const float wk = rw[tok * 8 + k];
#pragma unroll
            for (int j = 0; j < 4; ++j) { const u32x2 yv = *(const u32x2*)(Y + (size_t)sl * DM + 256 * j + 4 * c.lane);
                acc[j][0] += wk * lo_bf(yv.x); acc[j][1] += wk * hi_bf(yv.x); acc[j][2] += wk * lo_bf(yv.y); acc[j][3] += wk * hi_bf(yv.y); } }
#pragma unroll
        for (int j = 0; j < 4; ++j) { const u32x2 yv = *(const u32x2*)(YS + (size_t)tok * DM + 256 * j + 4 * c.lane);
            acc[j][0] += lo_bf(yv.x); acc[j][1] += hi_bf(yv.x); acc[j][2] += lo_bf(yv.y); acc[j][3] += hi_bf(yv.y); }
        f32x4* xr = (f32x4*)(p.out + (size_t)tok * DM) + c.lane;
        f32x4 v[4]; float ss = 0.f;
#pragma unroll
        for (int j = 0; j < 4; ++j) { const f32x4 gv = *(const f32x4*)(gate + (size_t)b * NMOD + 256 * j + 4 * c.lane); v[j] = xr[64 * j] + gv * acc[j];
            ss += (v[j][0] * v[j][0] + v[j][1] * v[j][1]) + (v[j][2] * v[j][2] + v[j][3] * v[j][3]); }
        if (l == NLAYER - 1) {
            const float rstd = rsqf_(wave_sum(ss, c.lane) * (1.0f / DM) + EPS);
#pragma unroll
            for (int j = 0; j < 4; ++j) { const f32x4 w4 = *(const f32x4*)(fw + 256 * j + 4 * c.lane); xr[64 * j] = v[j] * rstd * w4; }
        } else {
#pragma unroll
            for (int j = 0; j < 4; ++j) xr[64 * j] = v[j];
        }
    }
}


#define XB_TMO      128
#define XB_XCNT(j)  (256  + 64 * (j))
#define XB_XSUB(j)  (1280 + 64 * (j))
#define XB_XGEN(j)  (2304 + 64 * (j))
#define XB_TOP      3328
#define XB_TOPGEN   3392
#define XCD_BAR_WORDS 3456
#define XB_SPIN_CAP (1u << 18)
constexpr int LDS_XBST = LDS_PTAB + 320;
__device__ __forceinline__ unsigned xb_ld(unsigned* p)              { return __hip_atomic_load(p, __ATOMIC_RELAXED, __HIP_MEMORY_SCOPE_AGENT); }
__device__ __forceinline__ unsigned xb_add(unsigned* p, unsigned v) { return __hip_atomic_fetch_add(p, v, __ATOMIC_RELAXED, __HIP_MEMORY_SCOPE_AGENT); }
__device__ __forceinline__ unsigned xb_xcc_id() { return (unsigned)__builtin_amdgcn_s_getreg((3 << 11) | 20) & 0xFu; }
#define XB_SPIN(cond, bar) do { unsigned _sp = 0; while (cond) { __builtin_amdgcn_s_sleep(1); \
    if ((++_sp & 255u) == 0u) { if (xb_ld(&(bar)[XB_TMO])) break; if (_sp > XB_SPIN_CAP) { atomicAdd(&(bar)[XB_TMO], 1u); break; } } } } while (0)
__device__ __forceinline__ void xcd_barrier_complete(unsigned* bar, unsigned x, unsigned& nloc, unsigned& nx) {
    const unsigned G = gridDim.x * gridDim.y * gridDim.z;
    unsigned sum, cnt, mine, sp = 0u;
    for (;;) {
        sum = 0u; cnt = 0u; mine = 0u;
#pragma unroll
        for (unsigned j = 0; j < 16; ++j) { const unsigned c = xb_ld(&bar[XB_XCNT(j)]); sum += c; cnt += (c > 0u) ? 1u : 0u; mine = (j == x) ? c : mine; }
        if (sum == G) break;
        __builtin_amdgcn_s_sleep(1);
        if ((++sp & 255u) == 0u) { if (xb_ld(&bar[XB_TMO])) break; if (sp > XB_SPIN_CAP) { atomicAdd(&bar[XB_TMO], 1u); break; } }
    }
    nloc = mine > 0u ? mine : 1u; nx = cnt > 0u ? cnt : 1u;
}
__device__ __forceinline__ void xcd_barrier(unsigned* bar, volatile LAS unsigned* st, bool leader_thread) {
    asm volatile("s_waitcnt vmcnt(0)" ::: "memory");
    __syncthreads();
    if (leader_thread) {
        const unsigned x = xb_xcc_id();
        __builtin_amdgcn_s_waitcnt(0);
        unsigned nloc = st[0], nx = st[1];
        if (nloc == 0u) { xcd_barrier_complete(bar, x, nloc, nx); st[0] = nloc; st[1] = nx; }
        const unsigned old = xb_add(&bar[XB_XSUB(x)], 1u);
        const unsigned gen = old / nloc;
        if (old + 1u == (gen + 1u) * nloc) {
            __builtin_amdgcn_fence(__ATOMIC_RELEASE, "agent");
            asm volatile("s_waitcnt vmcnt(0)" ::: "memory");
            const unsigned og = xb_add(&bar[XB_TOP], 1u);
            const unsigned tg = og / nx;
            if (og + 1u == (tg + 1u) * nx) xb_add(&bar[XB_TOPGEN], 1u);
            else XB_SPIN(xb_ld(&bar[XB_TOPGEN]) == tg, bar);
            __builtin_amdgcn_fence(__ATOMIC_ACQUIRE, "agent");
            xb_add(&bar[XB_XGEN(x)], 1u);
            asm volatile("s_waitcnt vmcnt(0)" ::: "memory");
        } else {
            XB_SPIN(xb_ld(&bar[XB_XGEN(x)]) == gen, bar);
            __builtin_amdgcn_fence(__ATOMIC_ACQUIRE, "agent");
            asm volatile("s_waitcnt vmcnt(0)" ::: "memory");
        }
    }
    __syncthreads();
}

#ifndef PROBE_ID
#define PROBE_ID 0
#endif
#define RUN(id, stmt) do { stmt; if constexpr (PROBE_ID == (id)) { __syncthreads(); stmt; } } while (0)
constexpr int NQ_PHASE = 14;
__device__ __forceinline__ unsigned long long uni64(unsigned long long v) {
    const unsigned lo = (unsigned)__builtin_amdgcn_readfirstlane((int)(unsigned)v), hi = (unsigned)__builtin_amdgcn_readfirstlane((int)(unsigned)(v >> 32)); return ((unsigned long long)hi << 32) | lo; }
#if MK_MEGA
__device__ __forceinline__ void params_to_lds(const Params& p, LAS unsigned char* lds) {
    LAS unsigned long long* tab = (LAS unsigned long long*)(lds + LDS_PTAB);
#pragma unroll
    for (int i = 0; i < 33; ++i) tab[i] = (unsigned long long)p.in[i];
    tab[33] = (unsigned long long)p.out; tab[34] = (unsigned long long)p.ws;
}
__device__ __forceinline__ Params params_from_lds(LAS unsigned char* lds) {
    const LAS unsigned long long* tab = (const LAS unsigned long long*)(lds + LDS_PTAB);
    Params p;
#pragma unroll
    for (int i = 0; i < 33; ++i) p.in[i] = (const float*)(const __attribute__((address_space(1))) float*)uni64(tab[i]);
    p.out = (float*)(__attribute__((address_space(1))) float*)uni64(tab[33]); p.ws = (unsigned char*)(__attribute__((address_space(1))) unsigned char*)uni64(tab[34]); p.layer = 0; p.pad = 0;
    return p;
}
#endif
template <int Q> __device__ __forceinline__ void run_q(const Params& p_in, const Ctx& c_in, int l) {
    Ctx c = c_in;
    asm volatile("" : "+s"(c.wave), "+s"(c.bid), "+s"(c.G), "+s"(l));
    c.lane = fresh_lane(); c.tid = c.wave * 64 + c.lane;
#if MK_MEGA
    const Params p = params_from_lds(c.lds);
#else
    const Params& p = p_in;
#endif
    const float* xin = (l == 0) ? p.in[I_X] : p.out;
    if constexpr (Q == 14) { RUN(1, phase_prep_io(p, c); __syncthreads(); phase_prep_small(p, c)); __syncthreads(); RUN(2, phase_prep_experts(p, c, 0)); }
    if constexpr (Q == 0) { if (l > 0) { RUN(2, phase_prep_experts(p, c, l)); __syncthreads(); } RUN(3, phase_norm_mix(p, c, l, xin)); }
    if constexpr (Q == 1) { pg8::Gemm g{(const bf16_t*)(p.ws + WS_H), (const bf16_t*)(p.ws + WS_WIN) + (size_t)l * NU * DM, DM, 0};
              pg8::DenseOrder S; S.init(NTOK, NU, c.G, c.bid); EpiU E{(bf16_t*)(p.ws + WS_U), NU};
              RUN(4, (pg8::gemm_phase<EpiU, pg8::DenseOrder, pg8::DenseRows, true, true>(c.lds, g, S, E, pg8::DenseRows(), c.wave))); }
    if constexpr (Q == 2) { RUN(5, phase_ssd_conv(p, c, l)); __syncthreads(); RUN(6, phase_hg_state(p, c, l)); __syncthreads(); RUN(7, phase_lru1(p, c, l)); }
    if constexpr (Q == 3) { RUN(8, phase_ssd_state(p, c)); __syncthreads(); phase_hg_scan(p, c); __syncthreads(); RUN(9, phase_lru2(p, c, l)); }
    if constexpr (Q == 4) { phase_ssd_scan(p, c); __syncthreads(); RUN(10, phase_hg_out(p, c, l)); }
    if constexpr (Q == 5) RUN(11, phase_ssd_out(p, c, l));
    if constexpr (Q == 6) RUN(12, phase_ssd_gate(p, c, l));
    if constexpr (Q == 7) { pg8::Gemm g{(const bf16_t*)(p.ws + WS_YCAT), (const bf16_t*)(p.ws + WS_WOUT) + (size_t)l * DM * 2048, 2048, 0};
              pg8::DenseOrder S; S.init(NTOK, DM, c.G, c.bid); EpiOut E{xin, p.out, (const float*)(p.ws + WS_MOD) + (size_t)l * 8 * NMOD + 2048};
              pg8::gemm_phase<EpiOut, pg8::DenseOrder, pg8::DenseRows, false, true>(c.lds, g, S, E, pg8::DenseRows(), c.wave);
              if constexpr (PROBE_ID == 13) { if (l == 0) { __syncthreads(); pg8::gemm_phase<EpiOut, pg8::DenseOrder, pg8::DenseRows, false, true>(c.lds, g, S, E, pg8::DenseRows(), c.wave); } } }
    if constexpr (Q == 8) RUN(14, phase_norm_router(p, c, l, p.out));
    if constexpr (Q == 9) RUN(15, phase_route_assign(p, c));
    if constexpr (Q == 11) { pg8::Gemm g{(const bf16_t*)(p.ws + WS_H), (const bf16_t*)(p.ws + WS_GU), DM, (size_t)512 * DM * 2};
               MoeOrder S{(const int*)(p.ws + WS_RINFO), 2, c.G, (c.G % 8 == 0) ? (c.bid % 8) * (c.G / 8) + c.bid / 8 : c.bid}; EpiH E{(bf16_t*)(p.ws + WS_HMID)};
               GatherRows AM{(const int*)(p.ws + WS_SLOTTOK), (const int*)(p.ws + WS_RINFO)};
               RUN(16, (pg8::gemm_phase<EpiH, MoeOrder, GatherRows, true, true>(c.lds, g, S, E, AM, c.wave))); }
    if constexpr (Q == 12) { pg8::Gemm g{(const bf16_t*)(p.ws + WS_HMID), (const bf16_t*)(p.ws + WS_DN), 256, (size_t)DM * 256 * 2};
               MoeOrder S{(const int*)(p.ws + WS_RINFO), 4, c.G, (c.G % 8 == 0) ? (c.bid % 8) * (c.G / 8) + c.bid / 8 : c.bid};
               EpiY E{(bf16_t*)(p.ws + WS_Y), (bf16_t*)(p.ws + WS_H), (const int*)(p.ws + WS_RINFO)};
               RUN(17, (pg8::gemm_phase<EpiY, MoeOrder, pg8::DenseRows, true, true>(c.lds, g, S, E, pg8::DenseRows(), c.wave))); }
    if constexpr (Q == 13) phase_combine(p, c, l);
}

#if MK_MEGA
__global__ void __launch_bounds__(NTHREADS, 2) trunk_kernel(Params p) {
    extern __shared__ __attribute__((aligned(16))) unsigned char lds_raw[];
    Ctx c; c.lds = (LAS unsigned char*)lds_raw; c.tid = 0; c.lane = 0; c.wave = __builtin_amdgcn_readfirstlane(threadIdx.x >> 6); c.G = gridDim.x; c.bid = blockIdx.x;
    cg::grid_group grid = cg::this_grid();
    unsigned* const xbar = (unsigned*)(p.ws + WS_CTL) + 4096;
    if (threadIdx.x == 0) { params_to_lds(p, c.lds); ((LAS unsigned*)(c.lds + LDS_XBST))[0] = 0u; ((LAS unsigned*)(c.lds + LDS_XBST))[1] = 0u; ((LAS unsigned long long*)(c.lds + LDS_PTAB))[35] = (unsigned long long)xbar;
                            (void)xb_add(&xbar[XB_XCNT(xb_xcc_id())], 1u); }
    __syncthreads();
#define GSYNC1() do { unsigned* bar_ = (unsigned*)(__attribute__((address_space(1))) unsigned*)uni64(((const LAS unsigned long long*)(c.lds + LDS_PTAB))[35]); \
        xcd_barrier(bar_, (volatile LAS unsigned*)(c.lds + LDS_XBST), (c.wave == 0) && (fresh_lane() == 0)); } while (0)
#define GSYNC() do { GSYNC1(); if constexpr (PROBE_ID == 18) GSYNC1(); } while (0)
#define LAYER(l) do { \
        run_q<0>(p, c, l); GSYNC(); run_q<1>(p, c, l); GSYNC(); run_q<2>(p, c, l); GSYNC(); run_q<3>(p, c, l); GSYNC(); run_q<4>(p, c, l); GSYNC(); \
        run_q<5>(p, c, l); GSYNC(); run_q<6>(p, c, l); GSYNC(); run_q<7>(p, c, l); GSYNC(); run_q<8>(p, c, l); GSYNC(); run_q<9>(p, c, l); GSYNC(); \
        run_q<11>(p, c, l); GSYNC(); run_q<12>(p, c, l); GSYNC(); run_q<13>(p, c, l); } while (0)
    run_q<14>(p, c, 0); __syncthreads(); grid.sync();
    LAYER(0); GSYNC();
    LAYER(1);
}
#else
template <int Q> __global__ void __launch_bounds__(NTHREADS, 2) phase_kernel(Params p) {
    extern __shared__ __attribute__((aligned(16))) unsigned char lds_raw[];
    Ctx c; c.lds = (LAS unsigned char*)lds_raw; c.tid = 0; c.lane = 0; c.wave = __builtin_amdgcn_readfirstlane(threadIdx.x >> 6); c.G = gridDim.x; c.bid = blockIdx.x;
    run_q<Q>(p, c, p.layer);
}
template <int Q> static void launch_q(const Params& p, int grid, hipStream_t stream) {
    static bool attr = false;
    if (!attr) { (void)hipFuncSetAttribute((const void*)phase_kernel<Q>, hipFuncAttributeMaxDynamicSharedMemorySize, LDS_BYTES); attr = true; }
    hipLaunchKernelGGL(phase_kernel<Q>, dim3(grid), dim3(NTHREADS), LDS_BYTES, stream, p);
}
#endif

extern "C" void kernel_launch(void* const* d_in, const int* in_sizes, int n_in, void* d_out, int out_size, void* d_ws, size_t ws_size, hipStream_t stream) {
    static int grid = 0;
    if (grid == 0) {
        if (n_in != 33 || out_size != NTOK * DM || ws_size < WS_END) { fprintf(stderr, "kernel_launch: unexpected shapes (n_in %d out %d ws %zu)\n", n_in, out_size, ws_size); grid = -1; return; }
        int dev = 0, cus = 0;
        (void)hipGetDevice(&dev); (void)hipDeviceGetAttribute(&cus, hipDeviceAttributeMultiprocessorCount, dev);
        grid = cus > 0 ? cus : 256;
#if MK_MEGA
        int per_cu = 0;
        if (hipFuncSetAttribute((const void*)trunk_kernel, hipFuncAttributeMaxDynamicSharedMemorySize, LDS_BYTES) != hipSuccess) { fprintf(stderr, "kernel_launch: hipFuncSetAttribute failed\n"); grid = -1; return; }
        if (hipOccupancyMaxActiveBlocksPerMultiprocessor(&per_cu, (const void*)trunk_kernel, NTHREADS, LDS_BYTES) != hipSuccess || per_cu < 1) { fprintf(stderr, "kernel_launch: occupancy query says %d blocks/CU\n", per_cu); grid = -1; return; }
        (void)hipGetLastError();
#endif
    }
    if (grid < 0) return;
    (void)hipMemsetAsync((char*)d_ws + WS_CTL, 0, CTL_ZERO_BYTES, stream);
    Params p{};
    for (int i = 0; i < 33; ++i) p.in[i] = (const float*)d_in[i];
    p.out = (float*)d_out; p.ws = (unsigned char*)d_ws;
#if MK_MEGA
    void* args[] = {&p};
    hipError_t e = hipLaunchCooperativeKernel((const void*)trunk_kernel, dim3(grid), dim3(NTHREADS), args, LDS_BYTES, stream);
    if (e != hipSuccess) fprintf(stderr, "cooperative launch failed: %s (grid %d)\n", hipGetErrorString(e), grid);
#else
    p.layer = 0; launch_q<14>(p, grid, stream);
    for (int l = 0; l < NLAYER; ++l) {
        p.layer = l;
        launch_q<0>(p, grid, stream); launch_q<1>(p, grid, stream); launch_q<2>(p, grid, stream); launch_q<3>(p, grid, stream); launch_q<4>(p, grid, stream);
        launch_q<5>(p, grid, stream); launch_q<6>(p, grid, stream); launch_q<7>(p, grid, stream); launch_q<8>(p, grid, stream); launch_q<9>(p, grid, stream);
        launch_q<10>(p, grid, stream); launch_q<11>(p, grid, stream); launch_q<12>(p, grid, stream); launch_q<13>(p, grid, stream);
    }
#endif
}
```

```cpp
#include <hip/hip_runtime.h>
#include <hip/hip_cooperative_groups.h>
#include <cstdio>
#include <cstdint>
namespace cg = cooperative_groups;

#ifndef MK_MEGA
#define MK_MEGA 1
#endif

#define LAS __attribute__((address_space(3)))
typedef unsigned short bf16_t;
typedef short bf16x8 __attribute__((ext_vector_type(8)));
typedef float f32x4 __attribute__((ext_vector_type(4)));
typedef float f32x2 __attribute__((ext_vector_type(2)));
typedef unsigned u32x4 __attribute__((ext_vector_type(4)));
typedef unsigned u32x2 __attribute__((ext_vector_type(2)));

constexpr int NTOK = 16384, DM = 1024, SEQ = 2048, NBATCH = 8, NLAYER = 2;
constexpr int DIN = 5648, NU = 5632;
constexpr int UZ = 0, UXS = 1024, UB = 2048, UC = 2304, UHQ = 2560, UHF = 3072, UHV = 3584, UHG = 4096, ULG = 4608, ULX = 5120;
constexpr int NMOD = 6144;
constexpr float EPS = 1e-6f;
constexpr int NEXP = 64, TOPK = 8;
constexpr int MAXSLOT = 147456;
constexpr int NTHREADS = 512, NWAVES = 8;
constexpr int LDS_BYTES = 160 * 1024;
constexpr int LDS_PTAB = LDS_BYTES - 512;

constexpr size_t MiB = (size_t)1 << 20;
constexpr size_t WS_CTL = 0, CTL_ZERO_BYTES = 1 * MiB;
constexpr size_t WS_MOD = 1 * MiB;
constexpr size_t WS_LB = WS_MOD + 512 * 1024;
constexpr size_t WS_LRUW = WS_LB + 8192;
constexpr size_t WS_DTRAW = 2 * MiB, WS_DT = 3 * MiB, WS_ACUM = 4 * MiB;
constexpr size_t WS_HGBL = 5 * MiB;
constexpr size_t WS_SELM = 5 * MiB + 512 * 1024;
constexpr size_t WS_RW = 6 * MiB;
constexpr size_t WS_SLOTOF = 6 * MiB + 512 * 1024;
constexpr size_t WS_SLOTTOK = 7 * MiB;
constexpr size_t WS_RINFO = 7 * MiB + 768 * 1024;
constexpr size_t WS_CNT = 8 * MiB;
constexpr size_t WS_WRT = 9 * MiB;
constexpr size_t WS_WIN = 12 * MiB;
constexpr size_t WS_WOUT = 34 * MiB;
constexpr size_t WS_GU = 42 * MiB;
constexpr size_t WS_DN = 107 * MiB;
constexpr size_t WS_H = 140 * MiB;
constexpr size_t WS_U = 172 * MiB;
constexpr size_t WS_SST = 348 * MiB;
constexpr size_t WS_HST = 380 * MiB;
constexpr size_t WS_LA = 412 * MiB, WS_LH = 428 * MiB;
constexpr size_t WS_XBC = 444 * MiB;
constexpr size_t WS_YCAT = 492 * MiB;
constexpr size_t WS_HMID = 172 * MiB;
constexpr size_t WS_Y = 252 * MiB;
constexpr size_t WS_END = 556 * MiB;

__device__ __forceinline__ float bf2f(bf16_t b) { return __uint_as_float(((unsigned)b) << 16); }
typedef __bf16 bf16x2_hw __attribute__((ext_vector_type(2)));
__device__ __forceinline__ unsigned pk2(float lo, float hi) { f32x2 v = {lo, hi}; bf16x2_hw b = __builtin_convertvector(v, bf16x2_hw); return __builtin_bit_cast(unsigned, b); }
__device__ __forceinline__ unsigned f2bf(float f) { return pk2(f, 0.f) & 0xffffu; }
__device__ __forceinline__ float lo_bf(unsigned w) { return __uint_as_float(w << 16); }
__device__ __forceinline__ float hi_bf(unsigned w) { return __uint_as_float(w & 0xffff0000u); }
__device__ __forceinline__ float rcpf_(float x) { return __builtin_amdgcn_rcpf(x); }
__device__ __forceinline__ float rsqf_(float x) { return __builtin_amdgcn_rsqf(x); }
__device__ __forceinline__ float sigmoidf_(float x) { return rcpf_(1.0f + __expf(-x)); }
__device__ __forceinline__ float siluf_(float x) { return x * rcpf_(1.0f + __expf(-x)); }
__device__ __forceinline__ float softplusf_(float x) { return fmaxf(x, 0.f) + log1pf(__expf(-fabsf(x))); }
__device__ __forceinline__ float gelu_tanhf_(float x) { const float u = 0.7978845608028654f * (x + 0.044715f * x * x * x); const float t = 1.0f - 2.0f * rcpf_(1.0f + __expf(2.0f * u)); return 0.5f * x * (1.0f + t); }
__device__ __forceinline__ float shfl_xor_l(float v, int mask, int lane) { return __builtin_bit_cast(float, __builtin_amdgcn_ds_bpermute((lane ^ mask) << 2, __builtin_bit_cast(int, v))); }
__device__ __forceinline__ int shfl_up_l(int v, int d, int lane) { return __builtin_amdgcn_ds_bpermute((lane - d) << 2, v); }
__device__ __forceinline__ float shfl_up_f(float v, int d, int lane) { return __builtin_bit_cast(float, __builtin_amdgcn_ds_bpermute((lane - d) << 2, __builtin_bit_cast(int, v))); }
__device__ __forceinline__ float rdlane_f(float v, int src) { return __builtin_bit_cast(float, __builtin_amdgcn_readlane(__builtin_bit_cast(int, v), src)); }
__device__ __forceinline__ unsigned long long rdlane_u64(unsigned long long v, int src) {
    const unsigned lo = (unsigned)__builtin_amdgcn_readlane((int)(unsigned)v, src), hi = (unsigned)__builtin_amdgcn_readlane((int)(unsigned)(v >> 32), src); return ((unsigned long long)hi << 32) | lo; }
__device__ __forceinline__ float wave_sum(float v, int lane) {
#pragma unroll
    for (int o = 1; o < 64; o <<= 1) v += shfl_xor_l(v, o, lane);
    return v;
}
#define LDS_WAIT() asm volatile("s_waitcnt lgkmcnt(0)" ::: "memory")
__device__ __forceinline__ int fresh_lane() { unsigned ones = ~0u; asm volatile("" : "+s"(ones)); return (int)__builtin_amdgcn_mbcnt_hi(ones, __builtin_amdgcn_mbcnt_lo(ones, 0u)); }
#define MFMA16(a, b, c) __builtin_amdgcn_mfma_f32_16x16x32_bf16((a), (b), (c), 0, 0, 0)
typedef short s16x4 __attribute__((ext_vector_type(4)));
__device__ __forceinline__ bf16x8 tr_frag(const LAS bf16_t* img, int ld, int k0, int c0, int lane) {
    const int g = lane >> 4, q = (lane & 15) >> 2, pp = lane & 3;
    const LAS bf16_t* a0 = img + (k0 + 8 * g + q) * ld + c0 + 4 * pp;
    const s16x4 r0 = __builtin_amdgcn_ds_read_tr16_b64_v4i16((LAS s16x4*)a0);
    const s16x4 r1 = __builtin_amdgcn_ds_read_tr16_b64_v4i16((LAS s16x4*)(a0 + 4 * ld));
    return (bf16x8){r0[0], r0[1], r0[2], r0[3], r1[0], r1[1], r1[2], r1[3]};
}

namespace pg8 {
constexpr int BM = 256, BK = 64, HALF = 128, HTB = HALF * BK * 2, STAGE_BYTES = 8 * HTB, NXCD = 8, WGM = 8;
__device__ __forceinline__ int lds_byte(int r, int c) { const int st = (r >> 4) * 2 + (c >> 5), rr = r & 15, cc = c & 31, ob = rr * 64 + cc * 2; return st * 1024 + (ob ^ (((ob >> 9) & 1) << 5)); }
__device__ __forceinline__ void stage_rc(int b, int& R, int& C) { const int st = b / 1024, sb = b % 1024, swz = sb ^ (((sb >> 9) & 1) << 5); R = (st >> 1) * 16 + swz / 64; C = (st & 1) * 32 + (swz % 64) / 2; }
__device__ __forceinline__ int perm32(int rho) { const int n = rho >> 4, i = rho & 15; return 8 * (i >> 2) + 4 * n + (i & 3); }

struct Unit { int pm, pn, e; };
struct Gemm { const bf16_t* A; const bf16_t* Bt; int K; size_t estride; };

struct DenseOrder {
    int nM, nN, nwg, G, c;
    __device__ void init(int M, int N, int G_, int c_) { nM = M / BM; nN = N / BM; nwg = nM * nN; G = G_; c = c_; }
    __device__ bool next(int i, Unit& u) const {
        const long L = (long)i * G + c; if (L >= nwg) return false;
        int wgid = (int)L; { const int q = nwg / NXCD, r = nwg % NXCD, xcd = wgid % NXCD, off = wgid / NXCD; wgid = (xcd < r ? xcd * (q + 1) : r * (q + 1) + (xcd - r) * q) + off; }
        const int nig = WGM * nN, gid = wgid / nig, fm = gid * WGM, gsz = (nM - fm) < WGM ? (nM - fm) : WGM;
        u.pm = fm + ((wgid % nig) % gsz); u.pn = (wgid % nig) / gsz; u.e = 0; return true;
    }
};
struct DenseRows { __device__ __forceinline__ int row(const Unit& u, int r) const { return u.pm * BM + r; } };

template <class Epi, class Sched, class AMap, bool ALIGN_EPI, bool SP2>
__device__ __forceinline__ void gemm_phase(LAS unsigned char* lds, const Gemm g, const Sched& S, const Epi& E, const AMap& AM, int wave_id) {
    const int wid = wave_id, lane = fresh_lane(), tid = wid * 64 + lane, wr = wid >> 2, wc = wid & 3, fr = lane & 15, fq = lane >> 4;
    const int K = g.K, nt = K / BK;
    unsigned voffB0;
    { int R, C; stage_rc(tid * 16, R, C); const int Rb = Epi::PERM ? ((R & ~31) + perm32(R & 31)) : R; voffB0 = (unsigned)(Rb * K + C) * 2u; }
    const size_t p1step = (size_t)64 * K * 2;
    const size_t kstep = (size_t)(BK * 2);
    const size_t hstep = (size_t)HALF * K * 2;
    const size_t tstep = 2 * hstep;
    const unsigned ldsw = (unsigned)wid * 1024u;
    const int aoff = lds_byte(wr * 64 + fr, fq * 8), boff = lds_byte(wc * 32 + fr, fq * 8);
#define PG8_SA(b, h) (((b) * 2 + (h)) * HTB)
#define PG8_SB(b, h) ((4 + (b) * 2 + (h)) * HTB)
#define PG8_STAGE2(bufoff, gbase, v0, v1) do { \
        __builtin_amdgcn_global_load_lds((const unsigned*)((const char*)(gbase) + (v0)), (LAS unsigned*)(lds + (bufoff) + ldsw), 16, 0, 0); \
        __builtin_amdgcn_global_load_lds((const unsigned*)((const char*)(gbase) + (v1)), (LAS unsigned*)(lds + (bufoff) + ldsw + 8192), 16, 0, 0); } while (0)
#define PG8_STAGEB(bufoff, gbase) do { \
        __builtin_amdgcn_global_load_lds((const unsigned*)((const char*)(gbase) + voffB0), (LAS unsigned*)(lds + (bufoff) + ldsw), 16, 0, 0); \
        __builtin_amdgcn_global_load_lds((const unsigned*)((const char*)(gbase) + p1step + voffB0), (LAS unsigned*)(lds + (bufoff) + ldsw + 8192), 16, 0, 0); } while (0)
#define PG8_LDA(dst, b, h) do { _Pragma("unroll") for (int m = 0; m < 4; ++m) _Pragma("unroll") for (int k = 0; k < 2; ++k) dst[m][k] = *(const LAS bf16x8*)(lds + PG8_SA(b, h) + aoff + m * 2048 + k * 1024); } while (0)
#define PG8_LDB(dst, b, h) do { _Pragma("unroll") for (int n = 0; n < 2; ++n) _Pragma("unroll") for (int k = 0; k < 2; ++k) dst[n][k] = *(const LAS bf16x8*)(lds + PG8_SB(b, h) + boff + n * 2048 + k * 1024); } while (0)
#define PG8_MMA(ai, bj, At, Bt) do { __builtin_amdgcn_s_setprio(1); _Pragma("unroll") for (int m = 0; m < 4; ++m) _Pragma("unroll") for (int n = 0; n < 2; ++n) _Pragma("unroll") for (int k = 0; k < 2; ++k) \
        acc[ai][bj][m][n] = __builtin_amdgcn_mfma_f32_16x16x32_bf16(Bt[n][k], At[m][k], acc[ai][bj][m][n], 0, 0, 0); __builtin_amdgcn_s_setprio(0); } while (0)
#define PG8_WAIT_V(n) asm volatile("s_waitcnt vmcnt(" #n ")" ::: "memory")
#define PG8_WAIT_L(n) asm volatile("s_waitcnt lgkmcnt(" #n ")" ::: "memory")
#define PG8_BAR __builtin_amdgcn_s_barrier()
#define PG8_SCHED __builtin_amdgcn_sched_barrier(0)
#define PG8_AOFFS(u, v00, v01, v10, v11) do { int R_, C_; stage_rc(tid * 16, R_, C_); \
        v00 = (unsigned)(AM.row(u, R_) * K + C_) * 2u; v01 = (unsigned)(AM.row(u, R_ + 64) * K + C_) * 2u; \
        v10 = (unsigned)(AM.row(u, HALF + R_) * K + C_) * 2u; v11 = (unsigned)(AM.row(u, HALF + R_ + 64) * K + C_) * 2u; } while (0)
    Unit cur, nxt; int ui = 0;
    if (!S.next(0, cur)) return;
    f32x4 acc[2][2][4][2];
#pragma unroll
    for (int a = 0; a < 2; ++a)
#pragma unroll
        for (int b = 0; b < 2; ++b)
#pragma unroll
            for (int m = 0; m < 4; ++m)
#pragma unroll
                for (int n = 0; n < 2; ++n) acc[a][b][m][n] = (f32x4){0.f, 0.f, 0.f, 0.f};
    bf16x8 At[4][2], B0[2][2], B1[2][2];
    const char* const Abase = (const char*)g.A;
    const char* cB = (const char*)g.Bt + (size_t)cur.e * g.estride + (size_t)cur.pn * tstep;
    unsigned c00, c01, c10, c11, n00, n01, n10, n11;
    PG8_AOFFS(cur, c00, c01, c10, c11);
    n00 = c00; n01 = c01; n10 = c10; n11 = c11;
    if constexpr (SP2) {
        PG8_STAGEB(PG8_SB(0, 0), cB); PG8_STAGEB(PG8_SB(0, 1), cB + hstep); PG8_STAGE2(PG8_SA(0, 0), Abase, c00, c01); PG8_STAGE2(PG8_SA(0, 1), Abase, c10, c11);
        if (wr == 1) PG8_BAR;
        PG8_WAIT_V(2); PG8_BAR;
        PG8_STAGEB(PG8_SB(1, 0), cB + kstep); PG8_STAGE2(PG8_SA(1, 0), Abase + kstep, c00, c01); PG8_STAGEB(PG8_SB(1, 1), cB + hstep + kstep);
        PG8_WAIT_V(6); PG8_BAR;
    } else {
        PG8_STAGEB(PG8_SB(0, 0), cB); PG8_STAGE2(PG8_SA(0, 0), Abase, c00, c01); PG8_STAGEB(PG8_SB(0, 1), cB + hstep); PG8_STAGE2(PG8_SA(0, 1), Abase, c10, c11);
        if (wr == 1) PG8_BAR;
        PG8_WAIT_V(4); PG8_BAR;
        PG8_STAGEB(PG8_SB(1, 0), cB + kstep); PG8_STAGE2(PG8_SA(1, 0), Abase + kstep, c00, c01); PG8_STAGEB(PG8_SB(1, 1), cB + hstep + kstep);
        PG8_WAIT_V(6); PG8_BAR;
    }
    for (;;) {
        const bool has_next = S.next(ui + 1, nxt);
        const char* nB = cB;
        if (has_next) { nB = (const char*)g.Bt + (size_t)nxt.e * g.estride + (size_t)nxt.pn * tstep; PG8_AOFFS(nxt, n00, n01, n10, n11); }
        else { n00 = c00; n01 = c01; n10 = c10; n11 = c11; }
        for (int t = 0; t < nt; t += 2) {
            const bool last = (t == nt - 2);
            const char* a1 = Abase + (size_t)(t + 1) * kstep;
            const char* a2 = last ? Abase : Abase + (size_t)(t + 2) * kstep;
            const char* b2 = last ? nB : cB + (size_t)(t + 2) * kstep;
            const char* a3 = a2 + kstep; const char* b3 = b2 + kstep;
            const unsigned x00 = last ? n00 : c00, x01 = last ? n01 : c01, x10 = last ? n10 : c10, x11 = last ? n11 : c11;
            if constexpr (SP2) {
            PG8_LDB(B0, 0, 0); PG8_LDB(B1, 0, 1); PG8_SCHED; PG8_LDA(At, 0, 0); PG8_STAGE2(PG8_SA(1, 1), a1, c10, c11);
            PG8_WAIT_V(8); PG8_WAIT_L(0); PG8_BAR; PG8_MMA(0, 0, At, B0); PG8_MMA(0, 1, At, B1); PG8_BAR; PG8_SCHED;
            PG8_LDA(At, 0, 1); PG8_STAGEB(PG8_SB(0, 0), b2); PG8_STAGEB(PG8_SB(0, 1), b2 + hstep); PG8_STAGE2(PG8_SA(0, 0), a2, x00, x01);
            PG8_WAIT_V(8); PG8_WAIT_L(0); PG8_BAR; PG8_MMA(1, 0, At, B0); PG8_MMA(1, 1, At, B1); PG8_BAR; PG8_SCHED;
            PG8_LDB(B0, 1, 0); PG8_LDB(B1, 1, 1); PG8_SCHED; PG8_LDA(At, 1, 0); PG8_STAGE2(PG8_SA(0, 1), a2, x10, x11);
            PG8_WAIT_V(8); PG8_WAIT_L(0); PG8_BAR; PG8_MMA(0, 0, At, B0); PG8_MMA(0, 1, At, B1); PG8_BAR; PG8_SCHED;
            PG8_LDA(At, 1, 1); PG8_STAGEB(PG8_SB(1, 0), b3); PG8_STAGEB(PG8_SB(1, 1), b3 + hstep); PG8_STAGE2(PG8_SA(1, 0), a3, x00, x01);
            PG8_WAIT_V(8); PG8_WAIT_L(0); PG8_BAR; PG8_MMA(1, 0, At, B0); PG8_MMA(1, 1, At, B1); PG8_BAR; PG8_SCHED;
            } else {
            PG8_LDB(B0, 0, 0); PG8_SCHED; PG8_LDA(At, 0, 0); PG8_STAGE2(PG8_SA(1, 1), a1, c10, c11);
            PG8_WAIT_L(8); PG8_BAR; PG8_WAIT_L(0); PG8_MMA(0, 0, At, B0); PG8_BAR; PG8_SCHED;
            PG8_LDB(B1, 0, 1); PG8_STAGEB(PG8_SB(0, 0), b2);
            PG8_BAR; PG8_WAIT_L(0); PG8_MMA(0, 1, At, B1); PG8_BAR;
            PG8_LDA(At, 0, 1); PG8_STAGE2(PG8_SA(0, 0), a2, x00, x01);
            PG8_BAR; PG8_WAIT_L(0); PG8_MMA(1, 0, At, B0); PG8_BAR; PG8_SCHED;
            PG8_STAGEB(PG8_SB(0, 1), b2 + hstep);
            PG8_WAIT_V(6); PG8_BAR; PG8_MMA(1, 1, At, B1); PG8_BAR;
            PG8_LDB(B0, 1, 0); PG8_SCHED; PG8_LDA(At, 1, 0); PG8_STAGE2(PG8_SA(0, 1), a2, x10, x11);
            PG8_WAIT_L(8); PG8_BAR; PG8_WAIT_L(0); PG8_MMA(0, 0, At, B0); PG8_BAR; PG8_SCHED;
            PG8_LDB(B1, 1, 1); PG8_STAGEB(PG8_SB(1, 0), b3);
            PG8_BAR; PG8_WAIT_L(0); PG8_MMA(0, 1, At, B1); PG8_BAR;
            PG8_LDA(At, 1, 1); PG8_STAGE2(PG8_SA(1, 0), a3, x00, x01);
            PG8_BAR; PG8_WAIT_L(0); PG8_MMA(1, 0, At, B0); PG8_BAR; PG8_SCHED;
            PG8_STAGEB(PG8_SB(1, 1), b3 + hstep);
            PG8_WAIT_V(6); PG8_BAR; PG8_MMA(1, 1, At, B1); PG8_BAR;
            }
        }
        if constexpr (ALIGN_EPI) { if (wr == 0) PG8_BAR; }
        E(acc, cur, wr, wc);
        if (!has_next) break;
#pragma unroll
        for (int a = 0; a < 2; ++a)
#pragma unroll
            for (int b = 0; b < 2; ++b)
#pragma unroll
                for (int m = 0; m < 4; ++m)
#pragma unroll
                    for (int n = 0; n < 2; ++n) acc[a][b][m][n] = (f32x4){0.f, 0.f, 0.f, 0.f};
        cur = nxt; cB = nB; c00 = n00; c01 = n01; c10 = n10; c11 = n11; ++ui;
        if constexpr (ALIGN_EPI) { if (wr == 1) PG8_BAR; }
    }
    PG8_WAIT_V(0);
    if constexpr (!ALIGN_EPI) { if (wr == 0) PG8_BAR; }
    PG8_BAR;
#undef PG8_SA
#undef PG8_SB
#undef PG8_STAGE2
#undef PG8_STAGEB
#undef PG8_LDA
#undef PG8_LDB
#undef PG8_MMA
#undef PG8_WAIT_V
#undef PG8_WAIT_L
#undef PG8_BAR
#undef PG8_SCHED
#undef PG8_AOFFS
}
}

struct Params {
    const float* in[33];
    float* out;
    unsigned char* ws;
    int layer, pad;
};
enum { I_X = 0, I_C, I_ADAW, I_ADAB, I_NMIX, I_NFFN, I_WIN, I_SCW, I_SCB, I_SDTB, I_SALOG, I_SD, I_SNW, I_HLB, I_HNW, I_LCW, I_LCB, I_LWA, I_LBA, I_LWX, I_LBX, I_LLAM, I_LNW,
       I_WOUT, I_RW, I_RB, I_EG, I_EU, I_ED, I_SG, I_SU, I_SDN, I_FNW };

using pg8::Unit;
struct EpiU {
    static constexpr bool PERM = true;
    bf16_t* O; int ldc;
    __device__ __forceinline__ void operator()(const f32x4 (&acc)[2][2][4][2], const Unit& u, int wr, int wc) const {
        const int lane_ = fresh_lane(), fr = lane_ & 15, fq = lane_ >> 4;
        const int row0 = u.pm * 256 + wr * 64 + fr, col0 = u.pn * 256 + wc * 32 + 8 * fq;
#pragma unroll
        for (int ai = 0; ai < 2; ++ai)
#pragma unroll
            for (int m = 0; m < 4; ++m) { bf16_t* rowp = O + (size_t)(row0 + ai * 128 + m * 16) * ldc + col0;
#pragma unroll
                for (int bj = 0; bj < 2; ++bj) { const f32x4 v0 = acc[ai][bj][m][0], v1 = acc[ai][bj][m][1];
                    u32x4 w; w.x = pk2(v0[0], v0[1]); w.y = pk2(v0[2], v0[3]); w.z = pk2(v1[0], v1[1]); w.w = pk2(v1[2], v1[3]);
                    *(u32x4*)(rowp + bj * 128) = w; } }
    }
};
struct EpiOut {
    static constexpr bool PERM = false;
    const float* xin; float* xout; const float* gate;
    __device__ __forceinline__ void operator()(const f32x4 (&acc)[2][2][4][2], const Unit& u, int wr, int wc) const {
        const int lane_ = fresh_lane(), fr = lane_ & 15, fq = lane_ >> 4;
        const int row0 = u.pm * 256 + wr * 64 + fr, col0 = u.pn * 256 + wc * 32 + 4 * fq, b = u.pm >> 3;
        f32x4 gv[2][2];
#pragma unroll
        for (int bj = 0; bj < 2; ++bj)
#pragma unroll
            for (int n = 0; n < 2; ++n) gv[bj][n] = *(const f32x4*)(gate + (size_t)b * NMOD + col0 + bj * 128 + n * 16);
#pragma unroll
        for (int ai = 0; ai < 2; ++ai)
#pragma unroll
            for (int m = 0; m < 4; ++m) { const size_t off = (size_t)(row0 + ai * 128 + m * 16) * DM + col0;
#pragma unroll
                for (int bj = 0; bj < 2; ++bj)
#pragma unroll
                    for (int n = 0; n < 2; ++n) { const f32x4 xi = *(const f32x4*)(xin + off + bj * 128 + n * 16);
                        *(f32x4*)(xout + off + bj * 128 + n * 16) = xi + gv[bj][n] * acc[ai][bj][m][n]; }
                asm volatile("" ::: "memory"); }
    }
};
struct EpiH {
    static constexpr bool PERM = true;
    bf16_t* Hm;
    __device__ __forceinline__ void operator()(const f32x4 (&acc)[2][2][4][2], const Unit& u, int wr, int wc) const {
        const int lane_ = fresh_lane(), fr = lane_ & 15, fq = lane_ >> 4;
        const int row0 = u.pm * 256 + wr * 64 + fr, col0 = u.pn * 128 + wc * 32 + 8 * fq;
#pragma unroll
        for (int ai = 0; ai < 2; ++ai)
#pragma unroll
            for (int m = 0; m < 4; ++m) { bf16_t* rowp = Hm + (size_t)(row0 + ai * 128 + m * 16) * 256 + col0;
                f32x4 h0, h1;
#pragma unroll
                for (int j = 0; j < 4; ++j) { h0[j] = siluf_(acc[ai][0][m][0][j]) * acc[ai][1][m][0][j]; h1[j] = siluf_(acc[ai][0][m][1][j]) * acc[ai][1][m][1][j]; }
                u32x4 w; w.x = pk2(h0[0], h0[1]); w.y = pk2(h0[2], h0[3]); w.z = pk2(h1[0], h1[1]); w.w = pk2(h1[2], h1[3]);
                *(u32x4*)rowp = w; }
    }
};
struct EpiY {
    static constexpr bool PERM = true;
    bf16_t* Y; bf16_t* Ysh; const int* rinfo;
    __device__ __forceinline__ void operator()(const f32x4 (&acc)[2][2][4][2], const Unit& u, int wr, int wc) const {
        const int lane_ = fresh_lane(), fr = lane_ & 15, fq = lane_ >> 4;
        const int col0 = u.pn * 256 + wc * 32 + 8 * fq;
        bf16_t* base = Y + (size_t)u.pm * 256 * DM;
        if (u.e >= NEXP) base = Ysh + (size_t)(u.pm - rinfo[0]) * 256 * DM;
        base += (size_t)(wr * 64 + fr) * DM + col0;
#pragma unroll
        for (int ai = 0; ai < 2; ++ai)
#pragma unroll
            for (int m = 0; m < 4; ++m) { bf16_t* rowp = base + (size_t)(ai * 128 + m * 16) * DM;
#pragma unroll
                for (int bj = 0; bj < 2; ++bj) { const f32x4 v0 = acc[ai][bj][m][0], v1 = acc[ai][bj][m][1];
                    u32x4 w; w.x = pk2(v0[0], v0[1]); w.y = pk2(v0[2], v0[3]); w.z = pk2(v1[0], v1[1]); w.w = pk2(v1[2], v1[3]);
                    *(u32x4*)(rowp + bj * 128) = w; } }
    }
};
constexpr int LDS_UTAB = 131072, MAX_UNITS = 24;
__device__ __forceinline__ void moe_build_units(LAS unsigned char* lds, const int* rinfo, int NQ, int G, int cidx, int tid) {
    LAS int* tab = (LAS int*)(lds + LDS_UTAB);
    if (tid < MAX_UNITS) {
        const int nblk = rinfo[0]; const long L = (long)tid * G + cidx;
        int pm = -1, pn = 0, e = 0;
        if (L < (long)(nblk + 64) * NQ) { const int rb = (int)(L / NQ); pm = rb; pn = (int)(L % NQ); e = (rb < nblk) ? rinfo[64 + rb] : NEXP; }
        tab[tid * 4 + 0] = pm; tab[tid * 4 + 1] = pn; tab[tid * 4 + 2] = e; tab[tid * 4 + 3] = 0;
    }
    __syncthreads();
}
struct MoeOrder {
    const LAS int* tab;
    __device__ bool next(int i, Unit& u) const {
        if (i >= MAX_UNITS) return false;
        const int pm = __builtin_amdgcn_readfirstlane(tab[i * 4 + 0]); if (pm < 0) return false;
        u.pm = pm; u.pn = __builtin_amdgcn_readfirstlane(tab[i * 4 + 1]); u.e = __builtin_amdgcn_readfirstlane(tab[i * 4 + 2]); return true;
    }
};
struct GatherRows {
    const int* slot_tok; const int* rinfo;
    __device__ __forceinline__ int row(const Unit& u, int r) const {
        const int nblk = rinfo[0];
        if (u.pm < nblk) { const int t = slot_tok[u.pm * 256 + r]; return t < 0 ? 0 : t; }
        return (u.pm - nblk) * 256 + r;
    }
};

struct Ctx { LAS unsigned char* lds; int tid, lane, wave, G, bid; };

template <class RowMap>
__device__ __forceinline__ void transpose_item(const float* W, int N, int k0, int n0, bf16_t* WT, int ldk, const RowMap& rm, LAS float* scr, int lane) {
    const int nn = n0 + (lane & 31);
#pragma unroll 8
    for (int i = 0; i < 32; ++i) { const int kk = 2 * i + (lane >> 5); scr[kk * 33 + (lane & 31)] = (nn < N) ? W[(size_t)(k0 + kk) * N + nn] : 0.f; }
    LDS_WAIT();
    const int c = lane & 7;
#pragma unroll
    for (int j = 0; j < 4; ++j) { const int n = (lane >> 3) + 8 * j; const LAS float* s = scr + (8 * c) * 33 + n;
        u32x4 o; o.x = pk2(s[0 * 33], s[1 * 33]); o.y = pk2(s[2 * 33], s[3 * 33]); o.z = pk2(s[4 * 33], s[5 * 33]); o.w = pk2(s[6 * 33], s[7 * 33]);
        const int dr = (n0 + n < N) ? rm(n0 + n) : -1;
        if (dr >= 0) *(u32x4*)(WT + (size_t)dr * ldk + k0 + 8 * c) = o; }
    LDS_WAIT();
}
struct RmIdent { __device__ __forceinline__ int operator()(int n) const { return n; } };
struct RmWin { __device__ __forceinline__ int operator()(int n) const { return n < 2560 ? n : (n < 2576 ? -1 : n - 16); } };
struct RmGate { __device__ __forceinline__ int operator()(int n) const { return (n >> 7) * 256 + (n & 127); } };
struct RmUp { __device__ __forceinline__ int operator()(int n) const { return (n >> 7) * 256 + 128 + (n & 127); } };

__device__ __forceinline__ void phase_prep_io(const Params& p, const Ctx& c) {
    LAS float* scr = (LAS float*)(c.lds + c.wave * 16384);
    const int gw = c.bid * NWAVES + c.wave, NGW = c.G * NWAVES;
    constexpr int I_IN = 16 * 177, I_OUT = 32 * 32, PER_L = I_IN + I_OUT;
    for (int it = gw; it < NLAYER * PER_L; it += NGW) {
        const int l = it / PER_L; int r = it % PER_L;
        if (r < I_IN) { const int kb = r / 177, nb = r % 177;
            transpose_item(p.in[I_WIN] + (size_t)l * DM * DIN, DIN, kb * 64, nb * 32, (bf16_t*)(p.ws + WS_WIN) + (size_t)l * NU * DM, DM, RmWin(), scr, c.lane); }
        else { r -= I_IN; const int kb = r / 32, nb = r % 32;
            transpose_item(p.in[I_WOUT] + (size_t)l * 2048 * DM, DM, kb * 64, nb * 32, (bf16_t*)(p.ws + WS_WOUT) + (size_t)l * DM * 2048, 2048, RmIdent(), scr, c.lane); }
    }
}
__device__ __forceinline__ void phase_prep_experts(const Params& p, const Ctx& c, int l) {
    LAS float* scr = (LAS float*)(c.lds + c.wave * 16384);
    const int gw = c.bid * NWAVES + c.wave, NGW = c.G * NWAVES;
    constexpr int PER_E = 3 * 128;
    bf16_t* GU = (bf16_t*)(p.ws + WS_GU); bf16_t* DN = (bf16_t*)(p.ws + WS_DN);
    for (int it = gw; it < 65 * PER_E; it += NGW) {
        const int e = it / PER_E; int r = it % PER_E; const int which = r / 128; r %= 128;
        if (which < 2) {
            const float* src = (e < NEXP) ? p.in[which == 0 ? I_EG : I_EU] + ((size_t)l * NEXP + e) * DM * 256 : p.in[which == 0 ? I_SG : I_SU] + (size_t)l * DM * 256;
            const int kb = r / 8, nb = r % 8;
            if (which == 0) transpose_item(src, 256, kb * 64, nb * 32, GU + (size_t)e * 512 * DM, DM, RmGate(), scr, c.lane);
            else transpose_item(src, 256, kb * 64, nb * 32, GU + (size_t)e * 512 * DM, DM, RmUp(), scr, c.lane);
        } else {
            const float* src = (e < NEXP) ? p.in[I_ED] + ((size_t)l * NEXP + e) * 256 * DM : p.in[I_SDN] + (size_t)l * 256 * DM;
            const int kb = r / 32, nb = r % 32;
            transpose_item(src, DM, kb * 64, nb * 32, DN + (size_t)e * DM * 256, 256, RmIdent(), scr, c.lane);
        }
    }
}
__device__ __forceinline__ void phase_prep_small(const Params& p, const Ctx& c) {
    LAS float* sc = (LAS float*)c.lds;
    LAS float* red = (LAS float*)(c.lds + 32768);
    float* mod = (float*)(p.ws + WS_MOD);
    bool have_sc = false;
    for (int it = c.bid; it < NLAYER * 96; it += c.G) {
        if (!have_sc) { for (int i = c.tid; i < 8 * 1024; i += NTHREADS) sc[i] = siluf_(p.in[I_C][i]); have_sc = true; }
        __syncthreads();
        const int l = it / 96, j0 = (it % 96) * 64, j = c.tid & 63, kg = c.tid >> 6;
        const float* W = p.in[I_ADAW] + (size_t)l * DM * NMOD + j0 + j;
        float a[8];
#pragma unroll
        for (int b = 0; b < 8; ++b) a[b] = 0.f;
#pragma unroll 16
        for (int k = kg * 128; k < kg * 128 + 128; ++k) { const float w = W[(size_t)k * NMOD];
#pragma unroll
            for (int b = 0; b < 8; ++b) a[b] += sc[b * 1024 + k] * w; }
#pragma unroll
        for (int b = 0; b < 8; ++b) red[(kg * 8 + b) * 64 + j] = a[b];
        __syncthreads();
        { const int b = c.tid >> 6; float s = 0.f;
#pragma unroll
          for (int g = 0; g < 8; ++g) s += red[(g * 8 + b) * 64 + j];
          mod[((size_t)l * 8 + b) * NMOD + j0 + j] = s + p.in[I_ADAB][(size_t)l * NMOD + j0 + j]; }
        __syncthreads();
    }
    if (c.bid == c.G - 1) {
        float* lb = (float*)(p.ws + WS_LB);
        for (int i = c.tid; i < 512; i += NTHREADS) { const float v0 = p.in[I_HLB][i], v1 = p.in[I_HLB][512 + i]; const float m = fmaxf(v0, v1), e0 = expf(v0 - m), e1 = expf(v1 - m);
            lb[i] = 0.f; lb[512 + i] = e1 / (e0 + e1); }
    }
    { float* WT = (float*)(p.ws + WS_WRT);
      for (int o = c.bid * NTHREADS + c.tid; o < NLAYER * 64 * 1024; o += c.G * NTHREADS) { const int k = o & 1023, e = (o >> 10) & 63, l = o >> 16; WT[o] = p.in[I_RW][((size_t)l * 1024 + k) * 64 + e]; } }
    { bf16_t* LW = (bf16_t*)(p.ws + WS_LRUW);
      for (int o = c.bid * NTHREADS + c.tid; o < NLAYER * 2 * 8 * 4096; o += c.G * NTHREADS) {
          const int i = o & 63, j = (o >> 6) & 63, g = (o >> 12) & 7, mat = (o >> 15) & 1, l = o >> 16;
          const float* src = p.in[mat == 0 ? I_LWA : I_LWX] + (((size_t)l * 8 + g) * 64 + i) * 64 + j;
          LW[o] = (bf16_t)f2bf(*src); } }
}

__device__ __forceinline__ void phase_norm_mix(const Params& p, const Ctx& c, int l, const float* xin) {
    LAS float* wdt = (LAS float*)c.lds;
    const float* Win = p.in[I_WIN] + (size_t)l * DM * DIN;
    for (int i = c.tid; i < 16 * 1024; i += NTHREADS) { const int k = i >> 4, j = i & 15; wdt[j * 1024 + k] = Win[(size_t)k * DIN + 2560 + j]; }
    __syncthreads();
    const float* mod = (const float*)(p.ws + WS_MOD) + (size_t)l * 8 * NMOD;
    const float* nw = p.in[I_NMIX] + (size_t)l * DM;
    bf16_t* H = (bf16_t*)(p.ws + WS_H); float* dtraw = (float*)(p.ws + WS_DTRAW);
    const int gw = c.bid * NWAVES + c.wave, NGW = c.G * NWAVES;
    f32x4 vn[4];
    if (gw < NTOK) {
#pragma unroll
        for (int j = 0; j < 4; ++j) vn[j] = ((const f32x4*)(xin + (size_t)gw * DM) + c.lane)[64 * j];
    }
    for (int tok = gw; tok < NTOK; tok += NGW) {
        const int b = tok >> 11;
        f32x4 v[4]; float ss = 0.f;
#pragma unroll
        for (int j = 0; j < 4; ++j) { v[j] = vn[j]; ss += (v[j][0] * v[j][0] + v[j][1] * v[j][1]) + (v[j][2] * v[j][2] + v[j][3] * v[j][3]); }
        if (tok + NGW < NTOK) {
#pragma unroll
            for (int j = 0; j < 4; ++j) vn[j] = ((const f32x4*)(xin + (size_t)(tok + NGW) * DM) + c.lane)[64 * j];
        }
        const float rstd = rsqf_(wave_sum(ss, c.lane) * (1.0f / DM) + EPS);
        f32x4 hv[4], w4v[4], shv[4], scv[4];
#pragma unroll
        for (int j = 0; j < 4; ++j) { const int col = 256 * j + 4 * c.lane;
            w4v[j] = *(const f32x4*)(nw + col); shv[j] = *(const f32x4*)(mod + (size_t)b * NMOD + col); scv[j] = *(const f32x4*)(mod + (size_t)b * NMOD + 1024 + col); }
#pragma unroll
        for (int j = 0; j < 4; ++j) {
            const int col = 256 * j + 4 * c.lane;
            const f32x4 w4 = w4v[j], sh = shv[j], sc = scv[j];
            hv[j] = (v[j] * rstd * w4) * (sc + 1.0f) + sh;
            u32x2 o; o.x = pk2(hv[j][0], hv[j][1]); o.y = pk2(hv[j][2], hv[j][3]);
            *(u32x2*)(H + (size_t)tok * DM + col) = o;
        }
        float d16[16];
#pragma unroll
        for (int q = 0; q < 16; ++q) {
            float s2 = 0.f;
#pragma unroll
            for (int j = 0; j < 4; ++j) { const f32x4 wq = *(const LAS f32x4*)(wdt + q * 1024 + 256 * j + 4 * c.lane); s2 += (hv[j][0] * wq[0] + hv[j][1] * wq[1]) + (hv[j][2] * wq[2] + hv[j][3] * wq[3]); }
            d16[q] = s2;
            if ((q & 1) == 1) asm volatile("" ::: "memory");
        }
        float d8[8], d4[4], d2[2], d1;
        { const bool up = (c.lane & 32) != 0;
#pragma unroll
          for (int i = 0; i < 8; ++i) { const float snd = up ? d16[i] : d16[8 + i], kp = up ? d16[8 + i] : d16[i]; d8[i] = kp + shfl_xor_l(snd, 32, c.lane); } }
        { const bool up = (c.lane & 16) != 0;
#pragma unroll
          for (int i = 0; i < 4; ++i) { const float snd = up ? d8[i] : d8[4 + i], kp = up ? d8[4 + i] : d8[i]; d4[i] = kp + shfl_xor_l(snd, 16, c.lane); } }
        { const bool up = (c.lane & 8) != 0;
#pragma unroll
          for (int i = 0; i < 2; ++i) { const float snd = up ? d4[i] : d4[2 + i], kp = up ? d4[2 + i] : d4[i]; d2[i] = kp + shfl_xor_l(snd, 8, c.lane); } }
        { const bool up = (c.lane & 4) != 0; const float snd = up ? d2[0] : d2[1], kp = up ? d2[1] : d2[0]; d1 = kp + shfl_xor_l(snd, 4, c.lane); }
        d1 += shfl_xor_l(d1, 2, c.lane); d1 += shfl_xor_l(d1, 1, c.lane);
        if ((c.lane & 3) == 0) dtraw[(size_t)tok * 16 + ((c.lane >> 5) & 1) * 8 + ((c.lane >> 4) & 1) * 4 + ((c.lane >> 3) & 1) * 2 + ((c.lane >> 2) & 1)] = d1;
    }
}

__device__ __forceinline__ void phase_ssd_conv(const Params& p, const Ctx& c, int l) {
    const bf16_t* U = (const bf16_t*)(p.ws + WS_U); bf16_t* XA = (bf16_t*)(p.ws + WS_XBC);
    const float* cw = p.in[I_SCW] + (size_t)l * 4 * 1536; const float* cb = p.in[I_SCB] + (size_t)l * 1536;
    const float* dtraw = (const float*)(p.ws + WS_DTRAW); float* dt = (float*)(p.ws + WS_DT); float* acum = (float*)(p.ws + WS_ACUM);
    for (int idx = c.bid * NTHREADS + c.tid; idx < (NTOK / 4) * 192; idx += c.G * NTHREADS) {
        const int oct = idx % 192, tg = idx / 192, tok0 = tg * 4, t0 = tok0 & (SEQ - 1), c0 = oct * 8;
        float w[4][8], bb[8];
#pragma unroll
        for (int k = 0; k < 4; ++k) { const f32x4 a = *(const f32x4*)(cw + k * 1536 + c0), b2 = *(const f32x4*)(cw + k * 1536 + c0 + 4);
            w[k][0] = a[0]; w[k][1] = a[1]; w[k][2] = a[2]; w[k][3] = a[3]; w[k][4] = b2[0]; w[k][5] = b2[1]; w[k][6] = b2[2]; w[k][7] = b2[3]; }
        { const f32x4 a = *(const f32x4*)(cb + c0), b2 = *(const f32x4*)(cb + c0 + 4); bb[0] = a[0]; bb[1] = a[1]; bb[2] = a[2]; bb[3] = a[3]; bb[4] = b2[0]; bb[5] = b2[1]; bb[6] = b2[2]; bb[7] = b2[3]; }
        float x[7][8];
#pragma unroll
        for (int r = 0; r < 7; ++r) {
            u32x4 v = (u32x4){0u, 0u, 0u, 0u};
            if (t0 + r - 3 >= 0) v = *(const u32x4*)(U + (size_t)(tok0 + r - 3) * NU + UXS + c0);
#pragma unroll
            for (int j = 0; j < 4; ++j) { x[r][2 * j] = lo_bf(v[j]); x[r][2 * j + 1] = hi_bf(v[j]); }
        }
#pragma unroll
        for (int t = 0; t < 4; ++t) {
            float y[8];
#pragma unroll
            for (int j = 0; j < 8; ++j) y[j] = siluf_(bb[j] + w[0][j] * x[t][j] + w[1][j] * x[t + 1][j] + w[2][j] * x[t + 2][j] + w[3][j] * x[t + 3][j]);
            u32x4 o; o.x = pk2(y[0], y[1]); o.y = pk2(y[2], y[3]); o.z = pk2(y[4], y[5]); o.w = pk2(y[6], y[7]);
            *(u32x4*)(XA + (size_t)(tok0 + t) * 1536 + c0) = o;
        }
    }
    const int gw = c.bid * NWAVES + c.wave, NGW = c.G * NWAVES;
    for (int it = gw; it < 128; it += NGW) {
        const int tok0 = it * 128, h = c.lane & 15, qtr = c.lane >> 4;
        const float bias = p.in[I_SDTB][l * 16 + h], A = -expf(p.in[I_SALOG][l * 16 + h]);
        float d[32]; float cum = 0.f;
#pragma unroll
        for (int i = 0; i < 32; ++i) d[i] = softplusf_(dtraw[(size_t)(tok0 + qtr * 32 + i) * 16 + h] + bias);
#pragma unroll
        for (int i = 0; i < 32; ++i) cum += d[i] * A;
        const float c1 = shfl_up_f(cum, 16, c.lane), c2 = shfl_up_f(cum, 32, c.lane), c3 = shfl_up_f(cum, 48, c.lane);
        float off = 0.f; if (qtr >= 1) off += c1; if (qtr >= 2) off += c2; if (qtr >= 3) off += c3;
        float run = off;
#pragma unroll
        for (int i = 0; i < 32; ++i) { run += d[i] * A; dt[(size_t)(tok0 + qtr * 32 + i) * 16 + h] = d[i]; acum[(size_t)(tok0 + qtr * 32 + i) * 16 + h] = run; }
    }
}

__device__ __forceinline__ void phase_ssd_state(const Params& p, const Ctx& c) {
    LAS bf16_t* XS = (LAS bf16_t*)c.lds;
    LAS bf16_t* BS = (LAS bf16_t*)(c.lds + 128 * 72 * 2);
    const bf16_t* XA = (const bf16_t*)(p.ws + WS_XBC); const float* dt = (const float*)(p.ws + WS_DT); const float* acum = (const float*)(p.ws + WS_ACUM);
    bf16_t* ST = (bf16_t*)(p.ws + WS_SST);
    const int fr = c.lane & 15, fq = c.lane >> 4;
    for (int it = c.bid; it < 2048; it += c.G) {
        const int h = it & 15, bc = it >> 4, tok0 = bc * 128, g = h >> 3;
        const float aend = acum[(size_t)(tok0 + 127) * 16 + h];
        for (int i = c.tid; i < 128 * 8; i += NTHREADS) { const int lrow = i >> 3, ck = i & 7;
            const u32x4 r = *(const u32x4*)(XA + (size_t)(tok0 + lrow) * 1536 + h * 64 + ck * 8);
            const float f = dt[(size_t)(tok0 + lrow) * 16 + h] * __expf(aend - acum[(size_t)(tok0 + lrow) * 16 + h]);
            u32x4 o; o.x = pk2(lo_bf(r.x) * f, hi_bf(r.x) * f); o.y = pk2(lo_bf(r.y) * f, hi_bf(r.y) * f); o.z = pk2(lo_bf(r.z) * f, hi_bf(r.z) * f); o.w = pk2(lo_bf(r.w) * f, hi_bf(r.w) * f);
            *(LAS u32x4*)(XS + lrow * 72 + ck * 8) = o; }
        for (int i = c.tid; i < 128 * 16; i += NTHREADS) { const int lrow = i >> 4, ck = i & 15;
            *(LAS u32x4*)(BS + lrow * 136 + ck * 8) = *(const u32x4*)(XA + (size_t)(tok0 + lrow) * 1536 + 1024 + g * 128 + ck * 8); }
        __syncthreads();
        f32x4 acc[4];
#pragma unroll
        for (int m = 0; m < 4; ++m) acc[m] = (f32x4){0.f, 0.f, 0.f, 0.f};
#pragma unroll
        for (int ks = 0; ks < 4; ++ks) {
            const bf16x8 bfr = tr_frag(BS, 136, 32 * ks, 16 * c.wave, c.lane);
#pragma unroll
            for (int m = 0; m < 4; ++m) { const bf16x8 afr = tr_frag(XS, 72, 32 * ks, 16 * m, c.lane); acc[m] = MFMA16(bfr, afr, acc[m]); }
        }
#pragma unroll
        for (int m = 0; m < 4; ++m) { u32x2 o; o.x = pk2(acc[m][0], acc[m][1]); o.y = pk2(acc[m][2], acc[m][3]);
            *(u32x2*)(ST + (size_t)it * 8192 + (16 * m + fr) * 128 + 16 * c.wave + 4 * fq) = o; }
        __syncthreads();
    }
}
__device__ __forceinline__ void phase_ssd_scan(const Params& p, const Ctx& c) {
    unsigned* ST = (unsigned*)(p.ws + WS_SST); const float* acum = (const float*)(p.ws + WS_ACUM);
    for (int i = c.bid * NTHREADS + c.tid; i < 128 * 4096; i += c.G * NTHREADS) {
        const int e2 = i & 4095, bh = i >> 12, b = bh >> 4, h = bh & 15;
        float r0 = 0.f, r1 = 0.f;
        for (int ch = 0; ch < 16; ++ch) {
            const size_t it = (size_t)((b * 16 + ch) * 16 + h);
            const unsigned loc = ST[it * 4096 + e2];
            ST[it * 4096 + e2] = pk2(r0, r1);
            const float d = __expf(acum[(size_t)(b * SEQ + ch * 128 + 127) * 16 + h]);
            r0 = d * r0 + lo_bf(loc); r1 = d * r1 + hi_bf(loc);
        }
    }
}
__device__ __forceinline__ void phase_ssd_out(const Params& p, const Ctx& c, int l) {
    LAS bf16_t* Cs = (LAS bf16_t*)c.lds;
    LAS bf16_t* Bs = (LAS bf16_t*)(c.lds + 34816);
    LAS bf16_t* CBD = (LAS bf16_t*)(c.lds + 2 * 34816);
    LAS bf16_t* XS = (LAS bf16_t*)(c.lds + 3 * 34816);
    LAS bf16_t* STs = (LAS bf16_t*)(c.lds + 3 * 34816 + 18432);
    LAS float* acs = (LAS float*)(c.lds + 3 * 34816 + 18432 + 17408);
    const bf16_t* XA = (const bf16_t*)(p.ws + WS_XBC); const float* dt = (const float*)(p.ws + WS_DT); const float* acum = (const float*)(p.ws + WS_ACUM);
    const bf16_t* ST = (const bf16_t*)(p.ws + WS_SST); bf16_t* YP = (bf16_t*)(p.ws + WS_H);
    const int fr = c.lane & 15, fq = c.lane >> 4, w = c.wave;
    for (int it = c.bid; it < 2048; it += c.G) {
        const int h = it & 15, bc = it >> 4, tok0 = bc * 128, g = h >> 3;
        const float Dh = p.in[I_SD][l * 16 + h];
        for (int i = c.tid; i < 128 * 16; i += NTHREADS) { const int row = i >> 4, ck = i & 15;
            *(LAS u32x4*)(Bs + row * 136 + ck * 8) = *(const u32x4*)(XA + (size_t)(tok0 + row) * 1536 + 1024 + g * 128 + ck * 8);
            *(LAS u32x4*)(Cs + row * 136 + ck * 8) = *(const u32x4*)(XA + (size_t)(tok0 + row) * 1536 + 1280 + g * 128 + ck * 8); }
        for (int i = c.tid; i < 64 * 16; i += NTHREADS) { const int row = i >> 4, ck = i & 15;
            *(LAS u32x4*)(STs + row * 136 + ck * 8) = *(const u32x4*)(ST + (size_t)it * 8192 + row * 128 + ck * 8); }
        for (int i = c.tid; i < 128 * 8; i += NTHREADS) { const int lrow = i >> 3, ck = i & 7;
            const u32x4 r = *(const u32x4*)(XA + (size_t)(tok0 + lrow) * 1536 + h * 64 + ck * 8);
            const float f = dt[(size_t)(tok0 + lrow) * 16 + h];
            u32x4 o; o.x = pk2(lo_bf(r.x) * f, hi_bf(r.x) * f); o.y = pk2(lo_bf(r.y) * f, hi_bf(r.y) * f); o.z = pk2(lo_bf(r.z) * f, hi_bf(r.z) * f); o.w = pk2(lo_bf(r.w) * f, hi_bf(r.w) * f);
            *(LAS u32x4*)(XS + lrow * 72 + ck * 8) = o; }
        if (c.tid < 128) acs[c.tid] = acum[(size_t)(tok0 + c.tid) * 16 + h];
        __syncthreads();
        {
            f32x4 cb[8];
#pragma unroll
            for (int n = 0; n < 8; ++n) cb[n] = (f32x4){0.f, 0.f, 0.f, 0.f};
#pragma unroll
            for (int ks = 0; ks < 4; ++ks) {
                const bf16x8 afr = *(const LAS bf16x8*)(Cs + (16 * w + fr) * 136 + ks * 32 + 8 * fq);
#pragma unroll
                for (int n = 0; n < 8; ++n) { const bf16x8 bfr = *(const LAS bf16x8*)(Bs + (16 * n + fr) * 136 + ks * 32 + 8 * fq); cb[n] = MFMA16(bfr, afr, cb[n]); }
            }
            const int lr = 16 * w + fr; const float al = acs[lr];
#pragma unroll
            for (int n = 0; n < 8; ++n) { float v4[4];
#pragma unroll
                for (int r = 0; r < 4; ++r) { const int sc = 16 * n + 4 * fq + r; v4[r] = (sc <= lr) ? cb[n][r] * __expf(al - acs[sc]) : 0.f; }
                u32x2 o; o.x = pk2(v4[0], v4[1]); o.y = pk2(v4[2], v4[3]);
                *(LAS u32x2*)(CBD + lr * 136 + 16 * n + 4 * fq) = o; }
        }
        __syncthreads();
        {
            f32x4 a1[4], a2[4];
#pragma unroll
            for (int n = 0; n < 4; ++n) { a1[n] = (f32x4){0.f, 0.f, 0.f, 0.f}; a2[n] = (f32x4){0.f, 0.f, 0.f, 0.f}; }
#pragma unroll
            for (int ks = 0; ks < 4; ++ks) {
                const bf16x8 ad = *(const LAS bf16x8*)(CBD + (16 * w + fr) * 136 + ks * 32 + 8 * fq);
                const bf16x8 ac = *(const LAS bf16x8*)(Cs + (16 * w + fr) * 136 + ks * 32 + 8 * fq);
#pragma unroll
                for (int n = 0; n < 4; ++n) {
                    const bf16x8 bx = tr_frag(XS, 72, 32 * ks, 16 * n, c.lane);
                    const bf16x8 bs = *(const LAS bf16x8*)(STs + (16 * n + fr) * 136 + ks * 32 + 8 * fq);
                    a1[n] = MFMA16(bx, ad, a1[n]); a2[n] = MFMA16(bs, ac, a2[n]); }
            }
            const int lr = 16 * w + fr; const float ea = __expf(acs[lr]);
#pragma unroll
            for (int n = 0; n < 4; ++n) { const int pc = 16 * n + 4 * fq;
                const u32x2 xv = *(const u32x2*)(XA + (size_t)(tok0 + lr) * 1536 + h * 64 + pc);
                const float y0 = a1[n][0] + ea * a2[n][0] + Dh * lo_bf(xv.x), y1 = a1[n][1] + ea * a2[n][1] + Dh * hi_bf(xv.x);
                const float y2 = a1[n][2] + ea * a2[n][2] + Dh * lo_bf(xv.y), y3 = a1[n][3] + ea * a2[n][3] + Dh * hi_bf(xv.y);
                u32x2 o; o.x = pk2(y0, y1); o.y = pk2(y2, y3);
                *(u32x2*)(YP + (size_t)(tok0 + lr) * DM + h * 64 + pc) = o; }
        }
        __syncthreads();
    }
}
__device__ __forceinline__ void phase_ssd_gate(const Params& p, const Ctx& c, int l) {
    const bf16_t* YP = (const bf16_t*)(p.ws + WS_H); const bf16_t* U = (const bf16_t*)(p.ws + WS_U); bf16_t* YC = (bf16_t*)(p.ws + WS_YCAT);
    const float* nw = p.in[I_SNW] + (size_t)l * 1024;
    for (int r0 = c.bid * 64; r0 < NTOK * 2; r0 += c.G * 64) {
        const int row = r0 + (c.tid >> 3), part = c.tid & 7, tok = row >> 1, g = row & 1, col = g * 512 + part * 64;
        u32x4 yv[8], zv[8];
#pragma unroll
        for (int i = 0; i < 8; ++i) { yv[i] = *(const u32x4*)(YP + (size_t)tok * DM + col + 8 * i); zv[i] = *(const u32x4*)(U + (size_t)tok * NU + UZ + col + 8 * i); }
        float v[64]; float ss = 0.f;
#pragma unroll
        for (int i = 0; i < 8; ++i)
#pragma unroll
            for (int j = 0; j < 4; ++j) { const float a = lo_bf(yv[i][j]) * siluf_(lo_bf(zv[i][j])), b2 = hi_bf(yv[i][j]) * siluf_(hi_bf(zv[i][j])); v[8 * i + 2 * j] = a; v[8 * i + 2 * j + 1] = b2; ss += a * a + b2 * b2; }
        ss += shfl_xor_l(ss, 1, c.lane); ss += shfl_xor_l(ss, 2, c.lane); ss += shfl_xor_l(ss, 4, c.lane);
        const float rstd = rsqf_(ss * (1.0f / 512.0f) + EPS);
#pragma unroll
        for (int i = 0; i < 8; ++i) { const f32x4 w0 = *(const f32x4*)(nw + col + 8 * i), w1 = *(const f32x4*)(nw + col + 8 * i + 4);
            u32x4 o; o.x = pk2(v[8 * i] * rstd * w0[0], v[8 * i + 1] * rstd * w0[1]); o.y = pk2(v[8 * i + 2] * rstd * w0[2], v[8 * i + 3] * rstd * w0[3]);
            o.z = pk2(v[8 * i + 4] * rstd * w1[0], v[8 * i + 5] * rstd * w1[1]); o.w = pk2(v[8 * i + 6] * rstd * w1[2], v[8 * i + 7] * rstd * w1[3]);
            *(u32x4*)(YC + (size_t)tok * 2048 + col + 8 * i) = o; }
    }
}
__device__ __forceinline__ void phase_hg_state(const Params& p, const Ctx& c, int l) {
    LAS float* Bf = (LAS float*)c.lds;
    LAS float* KK = (LAS float*)(c.lds + 33792);
    LAS bf16_t* KD = (LAS bf16_t*)(c.lds + 2 * 33792 + 2112);
    LAS bf16_t* VS = (LAS bf16_t*)(c.lds + 2 * 33792 + 2112 + 17408);
    const bf16_t* U = (const bf16_t*)(p.ws + WS_U); const float* lb = (const float*)(p.ws + WS_LB) + l * 512;
    bf16_t* ST = (bf16_t*)(p.ws + WS_HST); float* BL = (float*)(p.ws + WS_HGBL);
    const int fr = c.lane & 15, fq = c.lane >> 4, w = c.wave;
    for (int it = c.bid; it < 1024; it += c.G) {
        const int ch = it & 31, bh = it >> 5, h = bh & 3, b = bh >> 2, tok0 = b * SEQ + ch * 64;
        for (int i = c.tid; i < 64 * 16; i += NTHREADS) { const int sr = i >> 4, ck = i & 15;
            const size_t ro = (size_t)(tok0 + sr) * NU + h * 128 + ck * 8;
            const u32x4 rf = *(const u32x4*)(U + ro + UHF);
            *(LAS u32x4*)(VS + sr * 136 + ck * 8) = *(const u32x4*)(U + ro + UHV);
            const f32x4 l0 = *(const f32x4*)(lb + h * 128 + ck * 8), l1 = *(const f32x4*)(lb + h * 128 + ck * 8 + 4);
            f32x4 k0, k1, g0, g1;
            k0[0] = (1.0f - l0[0]) * sigmoidf_(-lo_bf(rf.x)); k0[1] = (1.0f - l0[1]) * sigmoidf_(-hi_bf(rf.x)); k0[2] = (1.0f - l0[2]) * sigmoidf_(-lo_bf(rf.y)); k0[3] = (1.0f - l0[3]) * sigmoidf_(-hi_bf(rf.y));
            k1[0] = (1.0f - l1[0]) * sigmoidf_(-lo_bf(rf.z)); k1[1] = (1.0f - l1[1]) * sigmoidf_(-hi_bf(rf.z)); k1[2] = (1.0f - l1[2]) * sigmoidf_(-lo_bf(rf.w)); k1[3] = (1.0f - l1[3]) * sigmoidf_(-hi_bf(rf.w));
#pragma unroll
            for (int j = 0; j < 4; ++j) { g0[j] = __logf(1.0f - k0[j]); g1[j] = __logf(1.0f - k1[j]); }
            *(LAS f32x4*)(KK + sr * 132 + ck * 8) = k0; *(LAS f32x4*)(KK + sr * 132 + ck * 8 + 4) = k1;
            *(LAS f32x4*)(Bf + sr * 132 + ck * 8) = g0; *(LAS f32x4*)(Bf + sr * 132 + ck * 8 + 4) = g1; }
        __syncthreads();
        { const int kc = c.tid & 127, q4 = c.tid >> 7; float vals[16]; float cum = 0.f;
#pragma unroll
          for (int i = 0; i < 16; ++i) { cum += Bf[(16 * q4 + i) * 132 + kc]; vals[i] = cum; }
          KK[(64 + q4) * 132 + kc] = cum;
          __syncthreads();
          float off = 0.f;
#pragma unroll
          for (int j = 0; j < 3; ++j) off += (j < q4) ? KK[(64 + j) * 132 + kc] : 0.f;
#pragma unroll
          for (int i = 0; i < 16; ++i) Bf[(16 * q4 + i) * 132 + kc] = vals[i] + off;
          if (q4 == 3) BL[(size_t)it * 128 + kc] = vals[15] + off; }
        __syncthreads();
        for (int i = c.tid; i < 64 * 16; i += NTHREADS) { const int sr = i >> 4, ck = i & 15;
            const f32x4 ka = *(const LAS f32x4*)(KK + sr * 132 + ck * 8), kb = *(const LAS f32x4*)(KK + sr * 132 + ck * 8 + 4);
            const f32x4 ba = *(const LAS f32x4*)(Bf + sr * 132 + ck * 8), bb = *(const LAS f32x4*)(Bf + sr * 132 + ck * 8 + 4);
            const f32x4 ea = *(const LAS f32x4*)(Bf + 63 * 132 + ck * 8), eb = *(const LAS f32x4*)(Bf + 63 * 132 + ck * 8 + 4);
            u32x4 o; o.x = pk2(ka[0] * __expf(ea[0] - ba[0]), ka[1] * __expf(ea[1] - ba[1])); o.y = pk2(ka[2] * __expf(ea[2] - ba[2]), ka[3] * __expf(ea[3] - ba[3]));
            o.z = pk2(kb[0] * __expf(eb[0] - bb[0]), kb[1] * __expf(eb[1] - bb[1])); o.w = pk2(kb[2] * __expf(eb[2] - bb[2]), kb[3] * __expf(eb[3] - bb[3]));
            *(LAS u32x4*)(KD + sr * 136 + ck * 8) = o; }
        __syncthreads();
        f32x4 acc[8];
#pragma unroll
        for (int n = 0; n < 8; ++n) acc[n] = (f32x4){0.f, 0.f, 0.f, 0.f};
#pragma unroll
        for (int ks = 0; ks < 2; ++ks) {
            const bf16x8 afr = tr_frag(VS, 136, 32 * ks, 16 * w, c.lane);
#pragma unroll
            for (int n = 0; n < 8; ++n) { const bf16x8 bfr = tr_frag(KD, 136, 32 * ks, 16 * n, c.lane); acc[n] = MFMA16(bfr, afr, acc[n]); }
        }
#pragma unroll
        for (int n = 0; n < 8; ++n) { u32x2 o; o.x = pk2(acc[n][0], acc[n][1]); o.y = pk2(acc[n][2], acc[n][3]);
            *(u32x2*)(ST + (size_t)it * 16384 + (16 * w + fr) * 128 + 16 * n + 4 * fq) = o; }
        __syncthreads();
    }
}
__device__ __forceinline__ void phase_hg_scan(const Params& p, const Ctx& c) {
    unsigned* ST = (unsigned*)(p.ws + WS_HST); const float* BL = (const float*)(p.ws + WS_HGBL);
    for (int i = c.bid * NTHREADS + c.tid; i < 32 * 8192; i += c.G * NTHREADS) {
        const int e2 = i & 8191, bh = i >> 13, k0 = (2 * e2) & 127;
        float r0 = 0.f, r1 = 0.f;
        for (int ch = 0; ch < 32; ++ch) {
            const size_t it = (size_t)(bh * 32 + ch);
            const unsigned loc = ST[it * 8192 + e2];
            ST[it * 8192 + e2] = pk2(r0, r1);
            const float d0 = __expf(BL[it * 128 + k0]), d1 = __expf(BL[it * 128 + k0 + 1]);
            r0 = d0 * r0 + lo_bf(loc); r1 = d1 * r1 + hi_bf(loc);
        }
    }
}
__device__ __forceinline__ void phase_hg_out(const Params& p, const Ctx& c, int l) {
    LAS bf16_t* Qs = (LAS bf16_t*)c.lds;
    LAS bf16_t* Ks = (LAS bf16_t*)(c.lds + 17408);
    LAS float* Bf = (LAS float*)(c.lds + 2 * 17408);
    LAS bf16_t* QB = Qs;
    LAS bf16_t* STs = (LAS bf16_t*)(c.lds + 2 * 17408 + 33792);
    LAS bf16_t* ATT = (LAS bf16_t*)(c.lds + 2 * 17408 + 33792 + 34816);
    LAS bf16_t* VS = (LAS bf16_t*)(c.lds + 2 * 17408 + 33792 + 34816 + 9216);
    LAS bf16_t* QI = (LAS bf16_t*)(c.lds + 2 * 17408 + 33792 + 34816 + 9216 + 17408);
    LAS bf16_t* KKI = (LAS bf16_t*)(c.lds + 2 * 17408 + 33792 + 34816 + 9216 + 17408 + 4352);
    const bf16_t* U = (const bf16_t*)(p.ws + WS_U); const float* lb = (const float*)(p.ws + WS_LB) + l * 512;
    const bf16_t* ST = (const bf16_t*)(p.ws + WS_HST); bf16_t* YC = (bf16_t*)(p.ws + WS_YCAT);
    const float* nw = p.in[I_HNW] + (size_t)l * 512;
    const int fr = c.lane & 15, fq = c.lane >> 4, w = c.wave;
    for (int it = c.bid; it < 1024; it += c.G) {
        const int ch = it & 31, bh = it >> 5, h = bh & 3, b = bh >> 2, tok0 = b * SEQ + ch * 64;
        for (int i = c.tid; i < 64 * 16; i += NTHREADS) { const int sr = i >> 4, ck = i & 15;
            const size_t ro = (size_t)(tok0 + sr) * NU + h * 128 + ck * 8;
            const u32x4 rq = *(const u32x4*)(U + ro + UHQ), rf = *(const u32x4*)(U + ro + UHF);
            *(LAS u32x4*)(VS + sr * 136 + ck * 8) = *(const u32x4*)(U + ro + UHV);
            const f32x4 l0 = *(const f32x4*)(lb + h * 128 + ck * 8), l1 = *(const f32x4*)(lb + h * 128 + ck * 8 + 4);
            f32x4 k0, k1, g0, g1;
            k0[0] = (1.0f - l0[0]) * sigmoidf_(-lo_bf(rf.x)); k0[1] = (1.0f - l0[1]) * sigmoidf_(-hi_bf(rf.x)); k0[2] = (1.0f - l0[2]) * sigmoidf_(-lo_bf(rf.y)); k0[3] = (1.0f - l0[3]) * sigmoidf_(-hi_bf(rf.y));
            k1[0] = (1.0f - l1[0]) * sigmoidf_(-lo_bf(rf.z)); k1[1] = (1.0f - l1[1]) * sigmoidf_(-hi_bf(rf.z)); k1[2] = (1.0f - l1[2]) * sigmoidf_(-lo_bf(rf.w)); k1[3] = (1.0f - l1[3]) * sigmoidf_(-hi_bf(rf.w));
#pragma unroll
            for (int j = 0; j < 4; ++j) { g0[j] = __logf(1.0f - k0[j]); g1[j] = __logf(1.0f - k1[j]); }
            u32x4 ko; ko.x = pk2(k0[0], k0[1]); ko.y = pk2(k0[2], k0[3]); ko.z = pk2(k1[0], k1[1]); ko.w = pk2(k1[2], k1[3]);
            u32x4 qo; qo.x = pk2(siluf_(lo_bf(rq.x)), siluf_(hi_bf(rq.x))); qo.y = pk2(siluf_(lo_bf(rq.y)), siluf_(hi_bf(rq.y))); qo.z = pk2(siluf_(lo_bf(rq.z)), siluf_(hi_bf(rq.z))); qo.w = pk2(siluf_(lo_bf(rq.w)), siluf_(hi_bf(rq.w)));
            *(LAS u32x4*)(Ks + sr * 136 + ck * 8) = ko; *(LAS u32x4*)(Qs + sr * 136 + ck * 8) = qo;
            *(LAS f32x4*)(Bf + sr * 132 + ck * 8) = g0; *(LAS f32x4*)(Bf + sr * 132 + ck * 8 + 4) = g1; }
        for (int i = c.tid; i < 128 * 16; i += NTHREADS) { const int row = i >> 4, ck = i & 15;
            *(LAS u32x4*)(STs + row * 136 + ck * 8) = *(const u32x4*)(ST + (size_t)it * 16384 + row * 128 + ck * 8); }
        __syncthreads();
        { const int kc = c.tid & 127, q4 = c.tid >> 7; float vals[16]; float cum = 0.f;
#pragma unroll
          for (int i = 0; i < 16; ++i) { cum += Bf[(16 * q4 + i) * 132 + kc]; vals[i] = cum; }
          LAS float* QT = (LAS float*)KKI;
          QT[q4 * 128 + kc] = cum;
          __syncthreads();
          float off = 0.f;
#pragma unroll
          for (int j = 0; j < 3; ++j) off += (j < q4) ? QT[j * 128 + kc] : 0.f;
#pragma unroll
          for (int i = 0; i < 16; ++i) Bf[(16 * q4 + i) * 132 + kc] = vals[i] + off; }
        __syncthreads();
        for (int pidx = c.tid; pidx < 1024; pidx += NTHREADS) {
            const int ib = pidx >> 8, tq = (pidx >> 4) & 15, sq = pidx & 15, t = 16 * ib + tq, s2 = 16 * ib + sq; float a = 0.f;
            if (sq <= tq) {
                for (int k = 0; k < 128; k += 4) {
                    const f32x4 bt = *(const LAS f32x4*)(Bf + t * 132 + k), bs = *(const LAS f32x4*)(Bf + s2 * 132 + k);
                    const u32x2 qv = *(const LAS u32x2*)(Qs + t * 136 + k), kv = *(const LAS u32x2*)(Ks + s2 * 136 + k);
                    a += lo_bf(qv.x) * lo_bf(kv.x) * __expf(bt[0] - bs[0]) + hi_bf(qv.x) * hi_bf(kv.x) * __expf(bt[1] - bs[1])
                       + lo_bf(qv.y) * lo_bf(kv.y) * __expf(bt[2] - bs[2]) + hi_bf(qv.y) * hi_bf(kv.y) * __expf(bt[3] - bs[3]);
                }
            }
            ATT[t * 72 + s2] = (bf16_t)f2bf(a);
        }
        for (int i = c.tid; i < 6 * 256; i += NTHREADS) { const int blk = i >> 8, e = i & 255; const int bi = (blk < 3) ? 0 : (blk < 5 ? 1 : 2), bj = (blk < 3) ? blk + 1 : (blk < 5 ? blk - 1 : 3);
            ATT[(16 * bi + (e >> 4)) * 72 + 16 * bj + (e & 15)] = (bf16_t)0; }
        for (int ib = 1; ib < 4; ++ib) {
            const int rref = 16 * ib - 1;
            for (int i = c.tid; i < 16 * 64; i += NTHREADS) { const int tq = i >> 6, kp = i & 63, t = 16 * ib + tq;
                const unsigned q2 = *(const LAS unsigned*)(Qs + t * 136 + 2 * kp);
                *(LAS unsigned*)(QI + tq * 136 + 2 * kp) = pk2(lo_bf(q2) * __expf(Bf[t * 132 + 2 * kp] - Bf[rref * 132 + 2 * kp]), hi_bf(q2) * __expf(Bf[t * 132 + 2 * kp + 1] - Bf[rref * 132 + 2 * kp + 1])); }
            for (int i = c.tid; i < 16 * ib * 64; i += NTHREADS) { const int s2 = i >> 6, kp = i & 63;
                const unsigned k2 = *(const LAS unsigned*)(Ks + s2 * 136 + 2 * kp);
                *(LAS unsigned*)(KKI + s2 * 136 + 2 * kp) = pk2(lo_bf(k2) * __expf(Bf[rref * 132 + 2 * kp] - Bf[s2 * 132 + 2 * kp]), hi_bf(k2) * __expf(Bf[rref * 132 + 2 * kp + 1] - Bf[s2 * 132 + 2 * kp + 1])); }
            __syncthreads();
            if (w < ib) {
                f32x4 a4 = (f32x4){0.f, 0.f, 0.f, 0.f};
#pragma unroll
                for (int ks = 0; ks < 4; ++ks) { const bf16x8 afr = *(const LAS bf16x8*)(QI + fr * 136 + ks * 32 + 8 * fq), bfr = *(const LAS bf16x8*)(KKI + (16 * w + fr) * 136 + ks * 32 + 8 * fq); a4 = MFMA16(afr, bfr, a4); }
#pragma unroll
                for (int r = 0; r < 4; ++r) ATT[(16 * ib + 4 * fq + r) * 72 + 16 * w + fr] = (bf16_t)f2bf(a4[r]);
            }
            __syncthreads();
        }
        for (int i = c.tid; i < 64 * 64; i += NTHREADS) { const int t = i >> 6, kp = i & 63;
            const unsigned q2 = *(const LAS unsigned*)(Qs + t * 136 + 2 * kp);
            *(LAS unsigned*)(Qs + t * 136 + 2 * kp) = pk2(lo_bf(q2) * __expf(Bf[t * 132 + 2 * kp]), hi_bf(q2) * __expf(Bf[t * 132 + 2 * kp + 1])); }
        __syncthreads();
        f32x4 acc[4];
#pragma unroll
        for (int m = 0; m < 4; ++m) acc[m] = (f32x4){0.f, 0.f, 0.f, 0.f};
#pragma unroll
        for (int ks = 0; ks < 4; ++ks) {
            const bf16x8 bfr = *(const LAS bf16x8*)(STs + (16 * w + fr) * 136 + ks * 32 + 8 * fq);
#pragma unroll
            for (int m = 0; m < 4; ++m) { const bf16x8 afr = *(const LAS bf16x8*)(QB + (16 * m + fr) * 136 + ks * 32 + 8 * fq); acc[m] = MFMA16(afr, bfr, acc[m]); }
        }
#pragma unroll
        for (int ks = 0; ks < 2; ++ks) {
            const bf16x8 bfr = tr_frag(VS, 136, 32 * ks, 16 * w, c.lane);
#pragma unroll
            for (int m = 0; m < 4; ++m) { const bf16x8 afr = *(const LAS bf16x8*)(ATT + (16 * m + fr) * 72 + ks * 32 + 8 * fq); acc[m] = MFMA16(afr, bfr, acc[m]); }
        }
#pragma unroll
        for (int m = 0; m < 4; ++m)
#pragma unroll
            for (int r = 0; r < 4; ++r) Bf[(16 * m + 4 * fq + r) * 132 + 16 * w + fr] = acc[m][r];
        __syncthreads();
        {
            const int t = c.tid >> 3, part = c.tid & 7;
            f32x4 o4[4]; float ss = 0.f;
#pragma unroll
            for (int i = 0; i < 4; ++i) { o4[i] = *(const LAS f32x4*)(Bf + t * 132 + part * 16 + 4 * i); ss += (o4[i][0] * o4[i][0] + o4[i][1] * o4[i][1]) + (o4[i][2] * o4[i][2] + o4[i][3] * o4[i][3]); }
            const u32x4 g0 = *(const u32x4*)(U + (size_t)(tok0 + t) * NU + UHG + h * 128 + part * 16), g1 = *(const u32x4*)(U + (size_t)(tok0 + t) * NU + UHG + h * 128 + part * 16 + 8);
            ss += shfl_xor_l(ss, 1, c.lane); ss += shfl_xor_l(ss, 2, c.lane); ss += shfl_xor_l(ss, 4, c.lane);
            const float rstd = rsqf_(ss * (1.0f / 128.0f) + EPS);
            const float* nwp = nw + h * 128 + part * 16;
            const f32x4 n0 = *(const f32x4*)(nwp), n1 = *(const f32x4*)(nwp + 4), n2 = *(const f32x4*)(nwp + 8), n3 = *(const f32x4*)(nwp + 12);
            u32x4 r0, r1;
            r0.x = pk2(o4[0][0] * rstd * n0[0] * siluf_(lo_bf(g0.x)), o4[0][1] * rstd * n0[1] * siluf_(hi_bf(g0.x))); r0.y = pk2(o4[0][2] * rstd * n0[2] * siluf_(lo_bf(g0.y)), o4[0][3] * rstd * n0[3] * siluf_(hi_bf(g0.y)));
            r0.z = pk2(o4[1][0] * rstd * n1[0] * siluf_(lo_bf(g0.z)), o4[1][1] * rstd * n1[1] * siluf_(hi_bf(g0.z))); r0.w = pk2(o4[1][2] * rstd * n1[2] * siluf_(lo_bf(g0.w)), o4[1][3] * rstd * n1[3] * siluf_(hi_bf(g0.w)));
            r1.x = pk2(o4[2][0] * rstd * n2[0] * siluf_(lo_bf(g1.x)), o4[2][1] * rstd * n2[1] * siluf_(hi_bf(g1.x))); r1.y = pk2(o4[2][2] * rstd * n2[2] * siluf_(lo_bf(g1.y)), o4[2][3] * rstd * n2[3] * siluf_(hi_bf(g1.y)));
            r1.z = pk2(o4[3][0] * rstd * n3[0] * siluf_(lo_bf(g1.z)), o4[3][1] * rstd * n3[1] * siluf_(hi_bf(g1.z))); r1.w = pk2(o4[3][2] * rstd * n3[2] * siluf_(lo_bf(g1.w)), o4[3][3] * rstd * n3[3] * siluf_(hi_bf(g1.w)));
            bf16_t* yo = YC + (size_t)(tok0 + t) * 2048 + 1024 + h * 128 + part * 16;
            *(u32x4*)yo = r0; *(u32x4*)(yo + 8) = r1;
        }
        __syncthreads();
    }
}

__device__ __forceinline__ void phase_lru1(const Params& p, const Ctx& c, int l) {
    LAS unsigned char* wl = c.lds + c.wave * 12288;
    LAS bf16_t* XB = (LAS bf16_t*)wl;
    LAS float* As = (LAS float*)(wl + 2304);
    LAS float* Us = (LAS float*)(wl + 2304 + 4096);
    const bf16_t* U = (const bf16_t*)(p.ws + WS_U); bf16_t* LA = (bf16_t*)(p.ws + WS_LA); bf16_t* LH = (bf16_t*)(p.ws + WS_LH);
    const bf16_t* LW = (const bf16_t*)(p.ws + WS_LRUW) + (size_t)l * 2 * 8 * 4096;
    const int fr = c.lane & 15, fq = c.lane >> 4, g = c.wave, chn = g * 64 + c.lane;
    const float cw0 = p.in[I_LCW][(size_t)l * 2048 + chn], cw1 = p.in[I_LCW][(size_t)l * 2048 + 512 + chn], cw2 = p.in[I_LCW][(size_t)l * 2048 + 1024 + chn], cw3 = p.in[I_LCW][(size_t)l * 2048 + 1536 + chn];
    const float cbias = p.in[I_LCB][l * 512 + chn];
    bf16x8 wfa[4][2], wfx[4][2];
#pragma unroll
    for (int n = 0; n < 4; ++n)
#pragma unroll
        for (int ks = 0; ks < 2; ++ks) { wfa[n][ks] = *(const bf16x8*)(LW + (size_t)(0 * 8 + g) * 4096 + (16 * n + fr) * 64 + ks * 32 + 8 * fq);
                                         wfx[n][ks] = *(const bf16x8*)(LW + (size_t)(1 * 8 + g) * 4096 + (16 * n + fr) * 64 + ks * 32 + 8 * fq); }
    float bav[4], bxv[4], spl[4];
#pragma unroll
    for (int n = 0; n < 4; ++n) { const int j = g * 64 + 16 * n + fr; bav[n] = p.in[I_LBA][l * 512 + j]; bxv[n] = p.in[I_LBX][l * 512 + j]; spl[n] = softplusf_(-p.in[I_LLAM][l * 512 + j]); }
    for (int it = c.bid; it < 256; it += c.G) {
        const int seg = it & 31, tok0 = (it >> 5) * SEQ + seg * 64;
        float x0 = 0.f, x1 = 0.f, x2 = 0.f;
        if (seg > 0) { x0 = bf2f(U[(size_t)(tok0 - 3) * NU + ULX + chn]); x1 = bf2f(U[(size_t)(tok0 - 2) * NU + ULX + chn]); x2 = bf2f(U[(size_t)(tok0 - 1) * NU + ULX + chn]); }
        float hrun = 0.f, arun = 1.f;
        for (int st = 0; st < 4; ++st) {
            const int t0 = tok0 + st * 16;
#pragma unroll
            for (int tt = 0; tt < 16; ++tt) { const float xr = bf2f(U[(size_t)(t0 + tt) * NU + ULX + chn]);
                const float xb = cbias + cw0 * x0 + cw1 * x1 + cw2 * x2 + cw3 * xr; x0 = x1; x1 = x2; x2 = xr;
                XB[tt * 72 + c.lane] = (bf16_t)f2bf(xb); }
            LDS_WAIT();
            f32x4 ar[4], ai[4];
#pragma unroll
            for (int n = 0; n < 4; ++n) { ar[n] = (f32x4){0.f, 0.f, 0.f, 0.f}; ai[n] = (f32x4){0.f, 0.f, 0.f, 0.f}; }
#pragma unroll
            for (int ks = 0; ks < 2; ++ks) { const bf16x8 afr = *(const LAS bf16x8*)(XB + fr * 72 + ks * 32 + 8 * fq);
#pragma unroll
                for (int n = 0; n < 4; ++n) { ar[n] = MFMA16(afr, wfa[n][ks], ar[n]); ai[n] = MFMA16(afr, wfx[n][ks], ai[n]); } }
#pragma unroll
            for (int n = 0; n < 4; ++n)
#pragma unroll
                for (int r = 0; r < 4; ++r) { const int t = 4 * fq + r, j = 16 * n + fr;
                    const float rg = sigmoidf_(ar[n][r] + bav[n]), ig = sigmoidf_(ai[n][r] + bxv[n]);
                    const float la = -8.0f * rg * spl[n], a = __expf(la), mult = sqrtf(fmaxf(fmaf(-a, a, 1.0f), 0.f));
                    As[t * 64 + j] = a; Us[t * 64 + j] = mult * ig * bf2f(XB[t * 72 + j]); }
            LDS_WAIT();
#pragma unroll
            for (int tt = 0; tt < 16; ++tt) { const float a = As[tt * 64 + c.lane], uu = Us[tt * 64 + c.lane];
                hrun = a * hrun + uu; arun = a * arun;
                LA[(size_t)(t0 + tt) * 512 + chn] = (bf16_t)f2bf(arun); LH[(size_t)(t0 + tt) * 512 + chn] = (bf16_t)f2bf(hrun); }
            LDS_WAIT();
        }
    }
}
__device__ __forceinline__ void phase_lru2(const Params& p, const Ctx& c, int l) {
    LAS float* YS = (LAS float*)c.lds;
    LAS float* RS = (LAS float*)(c.lds + 64 * 516 * 4);
    const bf16_t* U = (const bf16_t*)(p.ws + WS_U); const bf16_t* LA = (const bf16_t*)(p.ws + WS_LA); const bf16_t* LH = (const bf16_t*)(p.ws + WS_LH);
    bf16_t* YC = (bf16_t*)(p.ws + WS_YCAT);
    const int g = c.wave, chn = g * 64 + c.lane;
    const float nwv = p.in[I_LNW][l * 512 + chn];
    for (int it = c.bid; it < 256; it += c.G) {
        const int seg = it & 31, b = it >> 5, tok0 = b * SEQ + seg * 64;
        float hin = 0.f;
        for (int s2 = 0; s2 < seg; ++s2) { const size_t row = (size_t)(b * SEQ + s2 * 64 + 63); hin = bf2f(LH[row * 512 + chn]) + bf2f(LA[row * 512 + chn]) * hin; }
#pragma unroll 8
        for (int tt = 0; tt < 64; ++tt) { const size_t tok = (size_t)(tok0 + tt);
            const float hh = bf2f(LH[tok * 512 + chn]) + bf2f(LA[tok * 512 + chn]) * hin;
            YS[tt * 516 + chn] = hh * gelu_tanhf_(bf2f(U[tok * NU + ULG + chn])); }
        __syncthreads();
        {
            const int t = c.tid >> 3, part = c.tid & 7; float ss = 0.f;
#pragma unroll
            for (int i = 0; i < 16; ++i) { const f32x4 v = *(const LAS f32x4*)(YS + t * 516 + part * 64 + 4 * i); ss += (v[0] * v[0] + v[1] * v[1]) + (v[2] * v[2] + v[3] * v[3]); }
            ss += shfl_xor_l(ss, 1, c.lane); ss += shfl_xor_l(ss, 2, c.lane); ss += shfl_xor_l(ss, 4, c.lane);
            if (part == 0) RS[t] = rsqf_(ss * (1.0f / 512.0f) + EPS);
        }
        __syncthreads();
#pragma unroll 8
        for (int tt = 0; tt < 64; ++tt) YC[(size_t)(tok0 + tt) * 2048 + 1536 + chn] = (bf16_t)f2bf(YS[tt * 516 + chn] * RS[tt] * nwv);
        __syncthreads();
    }
}

__device__ __forceinline__ void phase_norm_router(const Params& p, const Ctx& c, int l, const float* xin) {
    constexpr int HSTR = 1028;
    LAS float* HS = (LAS float*)c.lds;
    LAS float* PL = (LAS float*)(c.lds + 16 * HSTR * 4);
    LAS float* LG = (LAS float*)(c.lds + 16 * HSTR * 4 + 32768);
    const float* mod = (const float*)(p.ws + WS_MOD) + (size_t)l * 8 * NMOD;
    const float* nw = p.in[I_NFFN] + (size_t)l * DM;
    const float* WT = (const float*)(p.ws + WS_WRT) + (size_t)l * 64 * 1024;
    const float rbias = p.in[I_RB][l * NEXP + c.lane];
    bf16_t* H = (bf16_t*)(p.ws + WS_H);
    unsigned long long* selm = (unsigned long long*)(p.ws + WS_SELM); float* rw = (float*)(p.ws + WS_RW);
    const int fr = c.lane & 15, fq = c.lane >> 4, w = c.wave;
    int* cnt = (int*)(p.ws + WS_CNT);
    f32x4 bw[8][4];
#pragma unroll
    for (int j = 0; j < 8; ++j)
#pragma unroll
        for (int n = 0; n < 4; ++n) bw[j][n] = *(const f32x4*)(WT + (size_t)(16 * n + fr) * 1024 + 128 * w + 16 * j + 4 * fq);
    int ecount = 0;
    f32x4 xn[2][4];
    if (c.bid < NTOK / 16) {
#pragma unroll
        for (int q = 0; q < 2; ++q)
#pragma unroll
            for (int j = 0; j < 4; ++j) xn[q][j] = ((const f32x4*)(xin + (size_t)(c.bid * 16 + 2 * w + q) * DM) + c.lane)[64 * j];
    }
    for (int t16 = c.bid; t16 < NTOK / 16; t16 += c.G) {
        const int tokb = t16 * 16, b = tokb >> 11;
        f32x4 pa[4], pb[4];
#pragma unroll
        for (int j = 0; j < 4; ++j) { const int col = 256 * j + 4 * c.lane;
            const f32x4 w4 = *(const f32x4*)(nw + col), sc = *(const f32x4*)(mod + (size_t)b * NMOD + 4096 + col); pb[j] = *(const f32x4*)(mod + (size_t)b * NMOD + 3072 + col); pa[j] = w4 * (sc + 1.0f); }
#pragma unroll
        for (int q = 0; q < 2; ++q) {
            const int tl = 2 * w + q, tok = tokb + tl;
            f32x4 v[4]; float ss = 0.f;
#pragma unroll
            for (int j = 0; j < 4; ++j) { v[j] = xn[q][j]; ss += (v[j][0] * v[j][0] + v[j][1] * v[j][1]) + (v[j][2] * v[j][2] + v[j][3] * v[j][3]); }
            const float rstd = rsqf_(wave_sum(ss, c.lane) * (1.0f / DM) + EPS);
#pragma unroll
            for (int j = 0; j < 4; ++j) {
                const int col = 256 * j + 4 * c.lane;
                const f32x4 h = (v[j] * rstd) * pa[j] + pb[j];
                u32x2 o; o.x = pk2(h[0], h[1]); o.y = pk2(h[2], h[3]);
                *(u32x2*)(H + (size_t)tok * DM + col) = o;
                *(LAS f32x4*)(HS + tl * HSTR + col) = h;
            }
        }
        if (t16 + c.G < NTOK / 16) {
#pragma unroll
            for (int q = 0; q < 2; ++q)
#pragma unroll
                for (int j = 0; j < 4; ++j) xn[q][j] = ((const f32x4*)(xin + (size_t)((t16 + c.G) * 16 + 2 * w + q) * DM) + c.lane)[64 * j];
        }
        __syncthreads();
        {
            f32x4 acc[4];
#pragma unroll
            for (int n = 0; n < 4; ++n) acc[n] = (f32x4){0.f, 0.f, 0.f, 0.f};
#pragma unroll
            for (int j = 0; j < 8; ++j) {
                const int kk = 128 * w + 16 * j + 4 * fq;
                const f32x4 a4 = *(const LAS f32x4*)(HS + fr * HSTR + kk);
#pragma unroll
                for (int i = 0; i < 4; ++i)
#pragma unroll
                    for (int n = 0; n < 4; ++n) acc[n] = __builtin_amdgcn_mfma_f32_16x16x4f32(a4[i], bw[j][n][i], acc[n], 0, 0, 0);
            }
#pragma unroll
            for (int n = 0; n < 4; ++n)
#pragma unroll
                for (int r = 0; r < 4; ++r) PL[(w * 16 + 4 * fq + r) * 64 + 16 * n + fr] = acc[n][r];
        }
        __syncthreads();
        for (int i = c.tid; i < 1024; i += NTHREADS) { float s2 = 0.f;
#pragma unroll
            for (int ww = 0; ww < 8; ++ww) s2 += PL[ww * 1024 + i];
            LG[i] = s2; }
        __syncthreads();
#pragma unroll
        for (int q = 0; q < 2; ++q) {
            const int tl = 2 * w + q, tok = tokb + tl;
            const float s = sigmoidf_(LG[tl * 64 + c.lane]), v = s + rbias;
            float m1 = v;
            m1 = fmaxf(m1, shfl_xor_l(m1, 1, c.lane)); m1 = fmaxf(m1, shfl_xor_l(m1, 2, c.lane)); m1 = fmaxf(m1, shfl_xor_l(m1, 4, c.lane));
            const unsigned long long eq = __ballot(v == m1);
            const int gbase = c.lane & ~7;
            const unsigned gm = (unsigned)((eq >> gbase) & 0xffull);
            const int first = gbase + __builtin_ctz(gm);
            float m2 = (c.lane == first) ? -3.0e38f : v;
            m2 = fmaxf(m2, shfl_xor_l(m2, 1, c.lane)); m2 = fmaxf(m2, shfl_xor_l(m2, 2, c.lane)); m2 = fmaxf(m2, shfl_xor_l(m2, 4, c.lane));
            const float gs = m1 + m2;
            const int mygrp = c.lane >> 3; int grank = 0;
#pragma unroll
            for (int g2 = 0; g2 < 8; ++g2) { const float o = rdlane_f(gs, g2 * 8); grank += (o > gs || (o == gs && g2 < mygrp)) ? 1 : 0; }
            const float vm = (grank < 4) ? v : -1.0e4f;
            int erank = 0;
            for (int e2 = 0; e2 < 64; ++e2) { const float o = rdlane_f(vm, e2); erank += (int)(o > vm) + (int)((o == vm) & (e2 < c.lane)); }
            const bool sel = erank < TOPK;
            const unsigned long long mask = __ballot(sel);
            const float wsum = wave_sum(sel ? s : 0.f, c.lane);
            if (sel) { const int kk = __builtin_popcountll(mask & ((1ull << c.lane) - 1ull)); rw[(size_t)tok * 8 + kk] = s * rcpf_(wsum) * 2.5f; }
            if (c.lane == 0) selm[tok] = mask;
            ecount += sel ? 1 : 0;
        }
        __syncthreads();
    }
    { LAS int* CW = (LAS int*)c.lds; CW[w * 64 + c.lane] = ecount; __syncthreads();
      if (w == 0) { int tot = 0;
#pragma unroll
          for (int ww = 0; ww < 8; ++ww) tot += CW[ww * 64 + c.lane];
          cnt[c.bid * 64 + c.lane] = tot; }
      __syncthreads(); }
}
__device__ __forceinline__ void phase_route_assign(const Params& p, const Ctx& c) {
    const unsigned long long* selm = (const unsigned long long*)(p.ws + WS_SELM); const int* cnt = (const int*)(p.ws + WS_CNT);
    int* slot_tok = (int*)(p.ws + WS_SLOTTOK); int* slot_of = (int*)(p.ws + WS_SLOTOF); int* rinfo = (int*)(p.ws + WS_RINFO);
    const int gw = c.bid * NWAVES + c.wave, NGW = c.G * NWAVES;
    for (int ch = gw; ch < c.G; ch += NGW) {
        int total = 0, before = 0;
        for (int j = 0; j < c.G; ++j) { const int v = cnt[j * 64 + c.lane]; total += v; before += (j < ch) ? v : 0; }
        const int pad = (total + 255) & ~255;
        int incl = pad;
#pragma unroll
        for (int o = 1; o < 64; o <<= 1) { const int t = shfl_up_l(incl, o, c.lane); if (c.lane >= o) incl += t; }
        const int pstart = incl - pad;
        int run = pstart + before;
        for (int t16 = ch; t16 < NTOK / 16; t16 += c.G) {
            const unsigned long long mine = (c.lane < 16) ? selm[t16 * 16 + c.lane] : 0ull;
            for (int i = 0; i < 16; ++i) {
                const unsigned long long m = rdlane_u64(mine, i); const int tok = t16 * 16 + i;
                if ((m >> c.lane) & 1ull) { const int kk = __builtin_popcountll(m & ((1ull << c.lane) - 1ull)); slot_tok[run] = tok; slot_of[tok * 8 + kk] = run; ++run; }
            }
        }
        if (ch == 0) {
            for (int s2 = pstart + total; s2 < pstart + pad; ++s2) slot_tok[s2] = -1;
            for (int bk = pstart >> 8; bk < (pstart + pad) >> 8; ++bk) rinfo[64 + bk] = c.lane;
            if (c.lane == 63) rinfo[0] = incl >> 8;
        }
    }
}
__device__ __forceinline__ void phase_combine(const Params& p, const Ctx& c, int l) {
    const float* gate = (const float*)(p.ws + WS_MOD) + (size_t)l * 8 * NMOD + 5120;
    const bf16_t* Y = (const bf16_t*)(p.ws + WS_Y); const bf16_t* YS = (const bf16_t*)(p.ws + WS_H); const int* slot_of = (const int*)(p.ws + WS_SLOTOF); const float* rw = (const float*)(p.ws + WS_RW);
    const float* fw = p.in[I_FNW];
    const int gw = c.bid * NWAVES + c.wave, NGW = c.G * NWAVES;
    for (int tok = gw; tok < NTOK; tok += NGW) {
        const int b = tok >> 11;
        f32x4 acc[4], gvv[4], xv0[4];
        f32x4* xr = (f32x4*)(p.out + (size_t)tok * DM) + c.lane;
#pragma unroll
        for (int j = 0; j < 4; ++j) { acc[j] = (f32x4){0.f, 0.f, 0.f, 0.f}; gvv[j] = *(const f32x4*)(gate + (size_t)b * NMOD + 256 * j + 4 * c.lane); xv0[j] = xr[64 * j]; }
#pragma unroll
        for (int k = 0; k < 8; ++k) { const int sl = slot_of[tok * 8 + k]; const float wk = rw[tok * 8 + k];
#pragma unroll
            for (int j = 0; j < 4; ++j) { const u32x2 yv = *(const u32x2*)(Y + (size_t)sl * DM + 256 * j + 4 * c.lane);
                acc[j][0] += wk * lo_bf(yv.x); acc[j][1] += wk * hi_bf(yv.x); acc[j][2] += wk * lo_bf(yv.y); acc[j][3] += wk * hi_bf(yv.y); } }
#pragma unroll
        for (int j = 0; j < 4; ++j) { const u32x2 yv = *(const u32x2*)(YS + (size_t)tok * DM + 256 * j + 4 * c.lane);
            acc[j][0] += lo_bf(yv.x); acc[j][1] += hi_bf(yv.x); acc[j][2] += lo_bf(yv.y); acc[j][3] += hi_bf(yv.y); }
        f32x4 v[4]; float ss = 0.f;
#pragma unroll
        for (int j = 0; j < 4; ++j) { v[j] = xv0[j] + gvv[j] * acc[j];
            ss += (v[j][0] * v[j][0] + v[j][1] * v[j][1]) + (v[j][2] * v[j][2] + v[j][3] * v[j][3]); }
        if (l == NLAYER - 1) {
            const float rstd = rsqf_(wave_sum(ss, c.lane) * (1.0f / DM) + EPS);
#pragma unroll
            for (int j = 0; j < 4; ++j) { const f32x4 w4 = *(const f32x4*)(fw + 256 * j + 4 * c.lane); xr[64 * j] = v[j] * rstd * w4; }
        } else {
#pragma unroll
            for (int j = 0; j < 4; ++j) xr[64 * j] = v[j];
        }
    }
}


#define XB_TMO      128
#define XB_XCNT(j)  (256  + 64 * (j))
#define XB_XSUB(j)  (1280 + 64 * (j))
#define XB_XGEN(j)  (2304 + 64 * (j))
#define XB_TOP      3328
#define XB_TOPGEN   3392
#define XCD_BAR_WORDS 3456
#define XB_SPIN_CAP (1u << 18)
constexpr int LDS_XBST = LDS_PTAB + 320;
__device__ __forceinline__ unsigned xb_ld(unsigned* p)              { return __hip_atomic_load(p, __ATOMIC_RELAXED, __HIP_MEMORY_SCOPE_AGENT); }
__device__ __forceinline__ unsigned xb_add(unsigned* p, unsigned v) { return __hip_atomic_fetch_add(p, v, __ATOMIC_RELAXED, __HIP_MEMORY_SCOPE_AGENT); }
__device__ __forceinline__ unsigned xb_xcc_id() { return (unsigned)__builtin_amdgcn_s_getreg((3 << 11) | 20) & 0xFu; }
#define XB_SPIN(cond, bar) do { unsigned _sp = 0; while (cond) { __builtin_amdgcn_s_sleep(1); \
    if ((++_sp & 255u) == 0u) { if (xb_ld(&(bar)[XB_TMO])) break; if (_sp > XB_SPIN_CAP) { atomicAdd(&(bar)[XB_TMO], 1u); break; } } } } while (0)
__device__ __forceinline__ void xcd_barrier_complete(unsigned* bar, unsigned x, unsigned& nloc, unsigned& nx) {
    const unsigned G = gridDim.x * gridDim.y * gridDim.z;
    unsigned sum, cnt, mine, sp = 0u;
    for (;;) {
        sum = 0u; cnt = 0u; mine = 0u;
#pragma unroll
        for (unsigned j = 0; j < 16; ++j) { const unsigned c = xb_ld(&bar[XB_XCNT(j)]); sum += c; cnt += (c > 0u) ? 1u : 0u; mine = (j == x) ? c : mine; }
        if (sum == G) break;
        __builtin_amdgcn_s_sleep(1);
        if ((++sp & 255u) == 0u) { if (xb_ld(&bar[XB_TMO])) break; if (sp > XB_SPIN_CAP) { atomicAdd(&bar[XB_TMO], 1u); break; } }
    }
    nloc = mine > 0u ? mine : 1u; nx = cnt > 0u ? cnt : 1u;
}
__device__ __forceinline__ void xcd_barrier(unsigned* bar, volatile LAS unsigned* st, bool leader_thread) {
    asm volatile("s_waitcnt vmcnt(0)" ::: "memory");
    __syncthreads();
    if (leader_thread) {
        const unsigned x = xb_xcc_id();
        __builtin_amdgcn_s_waitcnt(0);
        unsigned nloc = st[0], nx = st[1];
        if (nloc == 0u) { xcd_barrier_complete(bar, x, nloc, nx); st[0] = nloc; st[1] = nx; }
        const unsigned old = xb_add(&bar[XB_XSUB(x)], 1u);
        const unsigned gen = old / nloc;
        if (old + 1u == (gen + 1u) * nloc) {
            __builtin_amdgcn_fence(__ATOMIC_RELEASE, "agent");
            asm volatile("s_waitcnt vmcnt(0)" ::: "memory");
            const unsigned og = xb_add(&bar[XB_TOP], 1u);
            const unsigned tg = og / nx;
            if (og + 1u == (tg + 1u) * nx) xb_add(&bar[XB_TOPGEN], 1u);
            else XB_SPIN(xb_ld(&bar[XB_TOPGEN]) == tg, bar);
            __builtin_amdgcn_fence(__ATOMIC_ACQUIRE, "agent");
            xb_add(&bar[XB_XGEN(x)], 1u);
            asm volatile("s_waitcnt vmcnt(0)" ::: "memory");
        } else {
            XB_SPIN(xb_ld(&bar[XB_XGEN(x)]) == gen, bar);
            __builtin_amdgcn_fence(__ATOMIC_ACQUIRE, "agent");
            asm volatile("s_waitcnt vmcnt(0)" ::: "memory");
        }
    }
    __syncthreads();
}

#ifndef PROBE_ID
#define PROBE_ID 0
#endif
#define RUN(id, stmt) do { stmt; if constexpr (PROBE_ID == (id)) { __syncthreads(); stmt; } } while (0)
constexpr int NQ_PHASE = 14;
__device__ __forceinline__ unsigned long long uni64(unsigned long long v) {
    const unsigned lo = (unsigned)__builtin_amdgcn_readfirstlane((int)(unsigned)v), hi = (unsigned)__builtin_amdgcn_readfirstlane((int)(unsigned)(v >> 32)); return ((unsigned long long)hi << 32) | lo; }
#if MK_MEGA
__device__ __forceinline__ void params_to_lds(const Params& p, LAS unsigned char* lds) {
    LAS unsigned long long* tab = (LAS unsigned long long*)(lds + LDS_PTAB);
#pragma unroll
    for (int i = 0; i < 33; ++i) tab[i] = (unsigned long long)p.in[i];
    tab[33] = (unsigned long long)p.out; tab[34] = (unsigned long long)p.ws;
}
__device__ __forceinline__ Params params_from_lds(LAS unsigned char* lds) {
    const LAS unsigned long long* tab = (const LAS unsigned long long*)(lds + LDS_PTAB);
    Params p;
#pragma unroll
    for (int i = 0; i < 33; ++i) p.in[i] = (const float*)(const __attribute__((address_space(1))) float*)uni64(tab[i]);
    p.out = (float*)(__attribute__((address_space(1))) float*)uni64(tab[33]); p.ws = (unsigned char*)(__attribute__((address_space(1))) unsigned char*)uni64(tab[34]); p.layer = 0; p.pad = 0;
    return p;
}
#endif
template <int Q> __device__ __forceinline__ void run_q(const Params& p_in, const Ctx& c_in, int l) {
    Ctx c = c_in;
    asm volatile("" : "+s"(c.wave), "+s"(c.bid), "+s"(c.G), "+s"(l));
    c.lane = fresh_lane(); c.tid = c.wave * 64 + c.lane;
#if MK_MEGA
    const Params p = params_from_lds(c.lds);
#else
    const Params& p = p_in;
#endif
    const float* xin = (l == 0) ? p.in[I_X] : p.out;
    if constexpr (Q == 14) { RUN(1, phase_prep_io(p, c); __syncthreads(); phase_prep_small(p, c)); __syncthreads(); RUN(2, phase_prep_experts(p, c, 0)); }
    if constexpr (Q == 0) { if (l > 0) { RUN(2, phase_prep_experts(p, c, l)); __syncthreads(); } RUN(3, phase_norm_mix(p, c, l, xin)); }
    if constexpr (Q == 1) { pg8::Gemm g{(const bf16_t*)(p.ws + WS_H), (const bf16_t*)(p.ws + WS_WIN) + (size_t)l * NU * DM, DM, 0};
              pg8::DenseOrder S; S.init(NTOK, NU, c.G, c.bid); EpiU E{(bf16_t*)(p.ws + WS_U), NU};
              RUN(4, (pg8::gemm_phase<EpiU, pg8::DenseOrder, pg8::DenseRows, true, true>(c.lds, g, S, E, pg8::DenseRows(), c.wave))); }
    if constexpr (Q == 2) { RUN(5, phase_ssd_conv(p, c, l)); __syncthreads(); RUN(6, phase_hg_state(p, c, l)); __syncthreads(); RUN(7, phase_lru1(p, c, l)); }
    if constexpr (Q == 3) { RUN(8, phase_ssd_state(p, c)); __syncthreads(); phase_hg_scan(p, c); __syncthreads(); RUN(9, phase_lru2(p, c, l)); }
    if constexpr (Q == 4) { phase_ssd_scan(p, c); __syncthreads(); RUN(10, phase_hg_out(p, c, l)); }
    if constexpr (Q == 5) RUN(11, phase_ssd_out(p, c, l));
    if constexpr (Q == 6) RUN(12, phase_ssd_gate(p, c, l));
    if constexpr (Q == 7) { pg8::Gemm g{(const bf16_t*)(p.ws + WS_YCAT), (const bf16_t*)(p.ws + WS_WOUT) + (size_t)l * DM * 2048, 2048, 0};
              pg8::DenseOrder S; S.init(NTOK, DM, c.G, c.bid); EpiOut E{xin, p.out, (const float*)(p.ws + WS_MOD) + (size_t)l * 8 * NMOD + 2048};
              pg8::gemm_phase<EpiOut, pg8::DenseOrder, pg8::DenseRows, false, true>(c.lds, g, S, E, pg8::DenseRows(), c.wave);
              if constexpr (PROBE_ID == 13) { if (l == 0) { __syncthreads(); pg8::gemm_phase<EpiOut, pg8::DenseOrder, pg8::DenseRows, false, true>(c.lds, g, S, E, pg8::DenseRows(), c.wave); } } }
    if constexpr (Q == 8) RUN(14, phase_norm_router(p, c, l, p.out));
    if constexpr (Q == 9) RUN(15, phase_route_assign(p, c));
    if constexpr (Q == 11) { pg8::Gemm g{(const bf16_t*)(p.ws + WS_H), (const bf16_t*)(p.ws + WS_GU), DM, (size_t)512 * DM * 2};
               moe_build_units(c.lds, (const int*)(p.ws + WS_RINFO), 2, c.G, (c.G % 8 == 0) ? (c.bid % 8) * (c.G / 8) + c.bid / 8 : c.bid, c.tid);
               MoeOrder S{(const LAS int*)(c.lds + LDS_UTAB)}; EpiH E{(bf16_t*)(p.ws + WS_HMID)};
               GatherRows AM{(const int*)(p.ws + WS_SLOTTOK), (const int*)(p.ws + WS_RINFO)};
               RUN(16, (pg8::gemm_phase<EpiH, MoeOrder, GatherRows, true, true>(c.lds, g, S, E, AM, c.wave))); }
    if constexpr (Q == 12) { pg8::Gemm g{(const bf16_t*)(p.ws + WS_HMID), (const bf16_t*)(p.ws + WS_DN), 256, (size_t)DM * 256 * 2};
               moe_build_units(c.lds, (const int*)(p.ws + WS_RINFO), 4, c.G, (c.G % 8 == 0) ? (c.bid % 8) * (c.G / 8) + c.bid / 8 : c.bid, c.tid);
               MoeOrder S{(const LAS int*)(c.lds + LDS_UTAB)};
               EpiY E{(bf16_t*)(p.ws + WS_Y), (bf16_t*)(p.ws + WS_H), (const int*)(p.ws + WS_RINFO)};
               RUN(17, (pg8::gemm_phase<EpiY, MoeOrder, pg8::DenseRows, true, true>(c.lds, g, S, E, pg8::DenseRows(), c.wave))); }
    if constexpr (Q == 13) phase_combine(p, c, l);
}

#if MK_MEGA
__global__ void __launch_bounds__(NTHREADS, 2) trunk_kernel(Params p) {
    extern __shared__ __attribute__((aligned(16))) unsigned char lds_raw[];
    Ctx c; c.lds = (LAS unsigned char*)lds_raw; c.tid = 0; c.lane = 0; c.wave = __builtin_amdgcn_readfirstlane(threadIdx.x >> 6); c.G = gridDim.x; c.bid = blockIdx.x;
    cg::grid_group grid = cg::this_grid();
    unsigned* const xbar = (unsigned*)(p.ws + WS_CTL) + 4096;
    if (threadIdx.x == 0) { params_to_lds(p, c.lds); ((LAS unsigned*)(c.lds + LDS_XBST))[0] = 0u; ((LAS unsigned*)(c.lds + LDS_XBST))[1] = 0u; ((LAS unsigned long long*)(c.lds + LDS_PTAB))[35] = (unsigned long long)xbar;
                            (void)xb_add(&xbar[XB_XCNT(xb_xcc_id())], 1u); }
    __syncthreads();
#define GSYNC1() do { unsigned* bar_ = (unsigned*)(__attribute__((address_space(1))) unsigned*)uni64(((const LAS unsigned long long*)(c.lds + LDS_PTAB))[35]); \
        xcd_barrier(bar_, (volatile LAS unsigned*)(c.lds + LDS_XBST), (c.wave == 0) && (fresh_lane() == 0)); } while (0)
#define GSYNC() do { GSYNC1(); if constexpr (PROBE_ID == 18) GSYNC1(); } while (0)
#define LAYER(l) do { \
        run_q<0>(p, c, l); GSYNC(); run_q<1>(p, c, l); GSYNC(); run_q<2>(p, c, l); GSYNC(); run_q<3>(p, c, l); GSYNC(); run_q<4>(p, c, l); GSYNC(); \
        run_q<5>(p, c, l); GSYNC(); run_q<6>(p, c, l); GSYNC(); run_q<7>(p, c, l); GSYNC(); run_q<8>(p, c, l); GSYNC(); run_q<9>(p, c, l); GSYNC(); \
        run_q<11>(p, c, l); GSYNC(); run_q<12>(p, c, l); GSYNC(); run_q<13>(p, c, l); } while (0)
    run_q<14>(p, c, 0); __syncthreads(); grid.sync();
    LAYER(0); GSYNC();
    LAYER(1);
}
#else
template <int Q> __global__ void __launch_bounds__(NTHREADS, 2) phase_kernel(Params p) {
    extern __shared__ __attribute__((aligned(16))) unsigned char lds_raw[];
    Ctx c; c.lds = (LAS unsigned char*)lds_raw; c.tid = 0; c.lane = 0; c.wave = __builtin_amdgcn_readfirstlane(threadIdx.x >> 6); c.G = gridDim.x; c.bid = blockIdx.x;
    run_q<Q>(p, c, p.layer);
}
template <int Q> static void launch_q(const Params& p, int grid, hipStream_t stream) {
    static bool attr = false;
    if (!attr) { (void)hipFuncSetAttribute((const void*)phase_kernel<Q>, hipFuncAttributeMaxDynamicSharedMemorySize, LDS_BYTES); attr = true; }
    hipLaunchKernelGGL(phase_kernel<Q>, dim3(grid), dim3(NTHREADS), LDS_BYTES, stream, p);
}
#endif

extern "C" void kernel_launch(void* const* d_in, const int* in_sizes, int n_in, void* d_out, int out_size, void* d_ws, size_t ws_size, hipStream_t stream) {
    static int grid = 0;
    if (grid == 0) {
        if (n_in != 33 || out_size != NTOK * DM || ws_size < WS_END) { fprintf(stderr, "kernel_launch: unexpected shapes (n_in %d out %d ws %zu)\n", n_in, out_size, ws_size); grid = -1; return; }
        int dev = 0, cus = 0;
        (void)hipGetDevice(&dev); (void)hipDeviceGetAttribute(&cus, hipDeviceAttributeMultiprocessorCount, dev);
        grid = cus > 0 ? cus : 256;
#if MK_MEGA
        int per_cu = 0;
        if (hipFuncSetAttribute((const void*)trunk_kernel, hipFuncAttributeMaxDynamicSharedMemorySize, LDS_BYTES) != hipSuccess) { fprintf(stderr, "kernel_launch: hipFuncSetAttribute failed\n"); grid = -1; return; }
        if (hipOccupancyMaxActiveBlocksPerMultiprocessor(&per_cu, (const void*)trunk_kernel, NTHREADS, LDS_BYTES) != hipSuccess || per_cu < 1) { fprintf(stderr, "kernel_launch: occupancy query says %d blocks/CU\n", per_cu); grid = -1; return; }
        (void)hipGetLastError();
#endif
    }
    if (grid < 0) return;
    (void)hipMemsetAsync((char*)d_ws + WS_CTL, 0, CTL_ZERO_BYTES, stream);
    Params p{};
    for (int i = 0; i < 33; ++i) p.in[i] = (const float*)d_in[i];
    p.out = (float*)d_out; p.ws = (unsigned char*)d_ws;
#if MK_MEGA
    void* args[] = {&p};
    hipError_t e = hipLaunchCooperativeKernel((const void*)trunk_kernel, dim3(grid), dim3(NTHREADS), args, LDS_BYTES, stream);
    if (e != hipSuccess) fprintf(stderr, "cooperative launch failed: %s (grid %d)\n", hipGetErrorString(e), grid);
#else
    p.layer = 0; launch_q<14>(p, grid, stream);
    for (int l = 0; l < NLAYER; ++l) {
        p.layer = l;
        launch_q<0>(p, grid, stream); launch_q<1>(p, grid, stream); launch_q<2>(p, grid, stream); launch_q<3>(p, grid, stream); launch_q<4>(p, grid, stream);
        launch_q<5>(p, grid, stream); launch_q<6>(p, grid, stream); launch_q<7>(p, grid, stream); launch_q<8>(p, grid, stream); launch_q<9>(p, grid, stream);
        launch_q<10>(p, grid, stream); launch_q<11>(p, grid, stream); launch_q<12>(p, grid, stream); launch_q<13>(p, grid, stream);
    }
#endif
}
```

```cpp
#include <hip/hip_runtime.h>
#include <hip/hip_cooperative_groups.h>
#include <cstdio>
#include <cstdint>
namespace cg = cooperative_groups;

#ifndef MK_MEGA
#define MK_MEGA 1
#endif

#define LAS __attribute__((address_space(3)))
typedef unsigned short bf16_t;
typedef short bf16x8 __attribute__((ext_vector_type(8)));
typedef float f32x4 __attribute__((ext_vector_type(4)));
typedef float f32x2 __attribute__((ext_vector_type(2)));
typedef unsigned u32x4 __attribute__((ext_vector_type(4)));
typedef unsigned u32x2 __attribute__((ext_vector_type(2)));

constexpr int NTOK = 16384, DM = 1024, SEQ = 2048, NBATCH = 8, NLAYER = 2;
constexpr int DIN = 5648, NU = 5632;
constexpr int UZ = 0, UXS = 1024, UB = 2048, UC = 2304, UHQ = 2560, UHF = 3072, UHV = 3584, UHG = 4096, ULG = 4608, ULX = 5120;
constexpr int NMOD = 6144;
constexpr float EPS = 1e-6f;
constexpr int NEXP = 64, TOPK = 8;
constexpr int MAXSLOT = 147456;
constexpr int NTHREADS = 512, NWAVES = 8;
constexpr int LDS_BYTES = 160 * 1024;
constexpr int LDS_PTAB = LDS_BYTES - 512;

constexpr size_t MiB = (size_t)1 << 20;
constexpr size_t WS_CTL = 0, CTL_ZERO_BYTES = 1 * MiB;
constexpr size_t WS_MOD = 1 * MiB;
constexpr size_t WS_LB = WS_MOD + 512 * 1024;
constexpr size_t WS_LRUW = WS_LB + 8192;
constexpr size_t WS_DTRAW = 2 * MiB, WS_DT = 3 * MiB, WS_ACUM = 4 * MiB;
constexpr size_t WS_HGBL = 5 * MiB;
constexpr size_t WS_SELM = 5 * MiB + 512 * 1024;
constexpr size_t WS_RW = 6 * MiB;
constexpr size_t WS_SLOTOF = 6 * MiB + 512 * 1024;
constexpr size_t WS_SLOTTOK = 7 * MiB;
constexpr size_t WS_RINFO = 7 * MiB + 768 * 1024;
constexpr size_t WS_CNT = 8 * MiB;
constexpr size_t WS_WRT = 9 * MiB;
constexpr size_t WS_WIN = 12 * MiB;
constexpr size_t WS_WOUT = 34 * MiB;
constexpr size_t WS_GU = 42 * MiB;
constexpr size_t WS_DN = 107 * MiB;
constexpr size_t WS_H = 140 * MiB;
constexpr size_t WS_U = 172 * MiB;
constexpr size_t WS_SST = 348 * MiB;
constexpr size_t WS_HST = 380 * MiB;
constexpr size_t WS_LA = 412 * MiB, WS_LH = 428 * MiB;
constexpr size_t WS_XBC = 444 * MiB;
constexpr size_t WS_YCAT = 492 * MiB;
constexpr size_t WS_HMID = 172 * MiB;
constexpr size_t WS_Y = 252 * MiB;
constexpr size_t WS_END = 556 * MiB;

__device__ __forceinline__ float bf2f(bf16_t b) { return __uint_as_float(((unsigned)b) << 16); }
typedef __bf16 bf16x2_hw __attribute__((ext_vector_type(2)));
__device__ __forceinline__ unsigned pk2(float lo, float hi) { f32x2 v = {lo, hi}; bf16x2_hw b = __builtin_convertvector(v, bf16x2_hw); return __builtin_bit_cast(unsigned, b); }
__device__ __forceinline__ unsigned f2bf(float f) { return pk2(f, 0.f) & 0xffffu; }
constexpr float Y8_SCALE = 16.0f, Y8_INV = 1.0f / 16.0f;
__device__ __forceinline__ unsigned pk4_fp8(float a, float b, float c2, float d) { int w = 0; w = __builtin_amdgcn_cvt_pk_fp8_f32(a, b, w, false); w = __builtin_amdgcn_cvt_pk_fp8_f32(c2, d, w, true); return (unsigned)w; }
__device__ __forceinline__ float lo_bf(unsigned w) { return __uint_as_float(w << 16); }
__device__ __forceinline__ float hi_bf(unsigned w) { return __uint_as_float(w & 0xffff0000u); }
__device__ __forceinline__ float rcpf_(float x) { return __builtin_amdgcn_rcpf(x); }
__device__ __forceinline__ float rsqf_(float x) { return __builtin_amdgcn_rsqf(x); }
__device__ __forceinline__ float sigmoidf_(float x) { return rcpf_(1.0f + __expf(-x)); }
__device__ __forceinline__ float siluf_(float x) { return x * rcpf_(1.0f + __expf(-x)); }
__device__ __forceinline__ float softplusf_(float x) { return fmaxf(x, 0.f) + log1pf(__expf(-fabsf(x))); }
__device__ __forceinline__ float gelu_tanhf_(float x) { const float u = 0.7978845608028654f * (x + 0.044715f * x * x * x); const float t = 1.0f - 2.0f * rcpf_(1.0f + __expf(2.0f * u)); return 0.5f * x * (1.0f + t); }
__device__ __forceinline__ float shfl_xor_l(float v, int mask, int lane) { return __builtin_bit_cast(float, __builtin_amdgcn_ds_bpermute((lane ^ mask) << 2, __builtin_bit_cast(int, v))); }
__device__ __forceinline__ int shfl_up_l(int v, int d, int lane) { return __builtin_amdgcn_ds_bpermute((lane - d) << 2, v); }
__device__ __forceinline__ float shfl_up_f(float v, int d, int lane) { return __builtin_bit_cast(float, __builtin_amdgcn_ds_bpermute((lane - d) << 2, __builtin_bit_cast(int, v))); }
__device__ __forceinline__ float rdlane_f(float v, int src) { return __builtin_bit_cast(float, __builtin_amdgcn_readlane(__builtin_bit_cast(int, v), src)); }
__device__ __forceinline__ unsigned long long rdlane_u64(unsigned long long v, int src) {
    const unsigned lo = (unsigned)__builtin_amdgcn_readlane((int)(unsigned)v, src), hi = (unsigned)__builtin_amdgcn_readlane((int)(unsigned)(v >> 32), src); return ((unsigned long long)hi << 32) | lo; }
__device__ __forceinline__ float wave_sum(float v, int lane) {
#pragma unroll
    for (int o = 1; o < 64; o <<= 1) v += shfl_xor_l(v, o, lane);
    return v;
}
#define LDS_WAIT() asm volatile("s_waitcnt lgkmcnt(0)" ::: "memory")
__device__ __forceinline__ int fresh_lane() { unsigned ones = ~0u; asm volatile("" : "+s"(ones)); return (int)__builtin_amdgcn_mbcnt_hi(ones, __builtin_amdgcn_mbcnt_lo(ones, 0u)); }
#define MFMA16(a, b, c) __builtin_amdgcn_mfma_f32_16x16x32_bf16((a), (b), (c), 0, 0, 0)
typedef short s16x4 __attribute__((ext_vector_type(4)));
__device__ __forceinline__ bf16x8 tr_frag(const LAS bf16_t* img, int ld, int k0, int c0, int lane) {
    const int g = lane >> 4, q = (lane & 15) >> 2, pp = lane & 3;
    const LAS bf16_t* a0 = img + (k0 + 8 * g + q) * ld + c0 + 4 * pp;
    const s16x4 r0 = __builtin_amdgcn_ds_read_tr16_b64_v4i16((LAS s16x4*)a0);
    const s16x4 r1 = __builtin_amdgcn_ds_read_tr16_b64_v4i16((LAS s16x4*)(a0 + 4 * ld));
    return (bf16x8){r0[0], r0[1], r0[2], r0[3], r1[0], r1[1], r1[2], r1[3]};
}

namespace pg8 {
constexpr int BM = 256, BK = 64, HALF = 128, HTB = HALF * BK * 2, STAGE_BYTES = 8 * HTB, NXCD = 8, WGM = 8;
__device__ __forceinline__ int lds_byte(int r, int c) { const int st = (r >> 4) * 2 + (c >> 5), rr = r & 15, cc = c & 31, ob = rr * 64 + cc * 2; return st * 1024 + (ob ^ (((ob >> 9) & 1) << 5)); }
__device__ __forceinline__ void stage_rc(int b, int& R, int& C) { const int st = b / 1024, sb = b % 1024, swz = sb ^ (((sb >> 9) & 1) << 5); R = (st >> 1) * 16 + swz / 64; C = (st & 1) * 32 + (swz % 64) / 2; }
__device__ __forceinline__ int perm32(int rho) { const int n = rho >> 4, i = rho & 15; return 8 * (i >> 2) + 4 * n + (i & 3); }

struct Unit { int pm, pn, e; };
struct Gemm { const bf16_t* A; const bf16_t* Bt; int K; size_t estride; };

struct DenseOrder {
    int nM, nN, nwg, G, c;
    __device__ void init(int M, int N, int G_, int c_) { nM = M / BM; nN = N / BM; nwg = nM * nN; G = G_; c = c_; }
    __device__ bool next(int i, Unit& u) const {
        const long L = (long)i * G + c; if (L >= nwg) return false;
        int wgid = (int)L; { const int q = nwg / NXCD, r = nwg % NXCD, xcd = wgid % NXCD, off = wgid / NXCD; wgid = (xcd < r ? xcd * (q + 1) : r * (q + 1) + (xcd - r) * q) + off; }
        const int nig = WGM * nN, gid = wgid / nig, fm = gid * WGM, gsz = (nM - fm) < WGM ? (nM - fm) : WGM;
        u.pm = fm + ((wgid % nig) % gsz); u.pn = (wgid % nig) / gsz; u.e = 0; return true;
    }
};
struct DenseRows { __device__ __forceinline__ int row(const Unit& u, int r) const { return u.pm * BM + r; } };

template <class Epi, class Sched, class AMap, bool ALIGN_EPI, bool SP2>
__device__ __forceinline__ void gemm_phase(LAS unsigned char* lds, const Gemm g, const Sched& S, const Epi& E, const AMap& AM, int wave_id) {
    const int wid = wave_id, lane = fresh_lane(), tid = wid * 64 + lane, wr = wid >> 2, wc = wid & 3, fr = lane & 15, fq = lane >> 4;
    const int K = g.K, nt = K / BK;
    unsigned voffB0;
    { int R, C; stage_rc(tid * 16, R, C); const int Rb = Epi::PERM ? ((R & ~31) + perm32(R & 31)) : R; voffB0 = (unsigned)(Rb * K + C) * 2u; }
    const size_t p1step = (size_t)64 * K * 2;
    const size_t kstep = (size_t)(BK * 2);
    const size_t hstep = (size_t)HALF * K * 2;
    const size_t tstep = 2 * hstep;
    const unsigned ldsw = (unsigned)wid * 1024u;
    const int aoff = lds_byte(wr * 64 + fr, fq * 8), boff = lds_byte(wc * 32 + fr, fq * 8);
#define PG8_SA(b, h) (((b) * 2 + (h)) * HTB)
#define PG8_SB(b, h) ((4 + (b) * 2 + (h)) * HTB)
#define PG8_STAGE2(bufoff, gbase, v0, v1) do { \
        __builtin_amdgcn_global_load_lds((const unsigned*)((const char*)(gbase) + (v0)), (LAS unsigned*)(lds + (bufoff) + ldsw), 16, 0, 0); \
        __builtin_amdgcn_global_load_lds((const unsigned*)((const char*)(gbase) + (v1)), (LAS unsigned*)(lds + (bufoff) + ldsw + 8192), 16, 0, 0); } while (0)
#define PG8_STAGEB(bufoff, gbase) do { \
        __builtin_amdgcn_global_load_lds((const unsigned*)((const char*)(gbase) + voffB0), (LAS unsigned*)(lds + (bufoff) + ldsw), 16, 0, 0); \
        __builtin_amdgcn_global_load_lds((const unsigned*)((const char*)(gbase) + p1step + voffB0), (LAS unsigned*)(lds + (bufoff) + ldsw + 8192), 16, 0, 0); } while (0)
#define PG8_LDA(dst, b, h) do { _Pragma("unroll") for (int m = 0; m < 4; ++m) _Pragma("unroll") for (int k = 0; k < 2; ++k) dst[m][k] = *(const LAS bf16x8*)(lds + PG8_SA(b, h) + aoff + m * 2048 + k * 1024); } while (0)
#define PG8_LDB(dst, b, h) do { _Pragma("unroll") for (int n = 0; n < 2; ++n) _Pragma("unroll") for (int k = 0; k < 2; ++k) dst[n][k] = *(const LAS bf16x8*)(lds + PG8_SB(b, h) + boff + n * 2048 + k * 1024); } while (0)
#define PG8_MMA(ai, bj, At, Bt) do { __builtin_amdgcn_s_setprio(1); _Pragma("unroll") for (int m = 0; m < 4; ++m) _Pragma("unroll") for (int n = 0; n < 2; ++n) _Pragma("unroll") for (int k = 0; k < 2; ++k) \
        acc[ai][bj][m][n] = __builtin_amdgcn_mfma_f32_16x16x32_bf16(Bt[n][k], At[m][k], acc[ai][bj][m][n], 0, 0, 0); __builtin_amdgcn_s_setprio(0); } while (0)
#define PG8_WAIT_V(n) asm volatile("s_waitcnt vmcnt(" #n ")" ::: "memory")
#define PG8_WAIT_L(n) asm volatile("s_waitcnt lgkmcnt(" #n ")" ::: "memory")
#define PG8_BAR __builtin_amdgcn_s_barrier()
#define PG8_SCHED __builtin_amdgcn_sched_barrier(0)
#define PG8_AOFFS(u, v00, v01, v10, v11) do { int R_, C_; stage_rc(tid * 16, R_, C_); \
        v00 = (unsigned)(AM.row(u, R_) * K + C_) * 2u; v01 = (unsigned)(AM.row(u, R_ + 64) * K + C_) * 2u; \
        v10 = (unsigned)(AM.row(u, HALF + R_) * K + C_) * 2u; v11 = (unsigned)(AM.row(u, HALF + R_ + 64) * K + C_) * 2u; } while (0)
    Unit cur, nxt; int ui = 0;
    if (!S.next(0, cur)) return;
    f32x4 acc[2][2][4][2];
#pragma unroll
    for (int a = 0; a < 2; ++a)
#pragma unroll
        for (int b = 0; b < 2; ++b)
#pragma unroll
            for (int m = 0; m < 4; ++m)
#pragma unroll
                for (int n = 0; n < 2; ++n) acc[a][b][m][n] = (f32x4){0.f, 0.f, 0.f, 0.f};
    bf16x8 At[4][2], B0[2][2], B1[2][2];
    const char* const Abase = (const char*)g.A;
    const char* cB = (const char*)g.Bt + (size_t)cur.e * g.estride + (size_t)cur.pn * tstep;
    unsigned c00, c01, c10, c11, n00, n01, n10, n11;
    PG8_AOFFS(cur, c00, c01, c10, c11);
    n00 = c00; n01 = c01; n10 = c10; n11 = c11;
    if constexpr (SP2) {
        PG8_STAGEB(PG8_SB(0, 0), cB); PG8_STAGEB(PG8_SB(0, 1), cB + hstep); PG8_STAGE2(PG8_SA(0, 0), Abase, c00, c01); PG8_STAGE2(PG8_SA(0, 1), Abase, c10, c11);
        if (wr == 1) PG8_BAR;
        PG8_WAIT_V(2); PG8_BAR;
        PG8_STAGEB(PG8_SB(1, 0), cB + kstep); PG8_STAGE2(PG8_SA(1, 0), Abase + kstep, c00, c01); PG8_STAGEB(PG8_SB(1, 1), cB + hstep + kstep);
        PG8_WAIT_V(6); PG8_BAR;
    } else {
        PG8_STAGEB(PG8_SB(0, 0), cB); PG8_STAGE2(PG8_SA(0, 0), Abase, c00, c01); PG8_STAGEB(PG8_SB(0, 1), cB + hstep); PG8_STAGE2(PG8_SA(0, 1), Abase, c10, c11);
        if (wr == 1) PG8_BAR;
        PG8_WAIT_V(4); PG8_BAR;
        PG8_STAGEB(PG8_SB(1, 0), cB + kstep); PG8_STAGE2(PG8_SA(1, 0), Abase + kstep, c00, c01); PG8_STAGEB(PG8_SB(1, 1), cB + hstep + kstep);
        PG8_WAIT_V(6); PG8_BAR;
    }
    for (;;) {
        const bool has_next = S.next(ui + 1, nxt);
        const char* nB = cB;
        if (has_next) { nB = (const char*)g.Bt + (size_t)nxt.e * g.estride + (size_t)nxt.pn * tstep; PG8_AOFFS(nxt, n00, n01, n10, n11); }
        else { n00 = c00; n01 = c01; n10 = c10; n11 = c11; }
        for (int t = 0; t < nt; t += 2) {
            const bool last = (t == nt - 2);
            const char* a1 = Abase + (size_t)(t + 1) * kstep;
            const char* a2 = last ? Abase : Abase + (size_t)(t + 2) * kstep;
            const char* b2 = last ? nB : cB + (size_t)(t + 2) * kstep;
            const char* a3 = a2 + kstep; const char* b3 = b2 + kstep;
            const unsigned x00 = last ? n00 : c00, x01 = last ? n01 : c01, x10 = last ? n10 : c10, x11 = last ? n11 : c11;
            if constexpr (SP2) {
            PG8_LDB(B0, 0, 0); PG8_LDB(B1, 0, 1); PG8_SCHED; PG8_LDA(At, 0, 0); PG8_STAGE2(PG8_SA(1, 1), a1, c10, c11);
            PG8_WAIT_V(8); PG8_WAIT_L(0); PG8_BAR; PG8_MMA(0, 0, At, B0); PG8_MMA(0, 1, At, B1); PG8_BAR; PG8_SCHED;
            PG8_LDA(At, 0, 1); PG8_STAGEB(PG8_SB(0, 0), b2); PG8_STAGEB(PG8_SB(0, 1), b2 + hstep); PG8_STAGE2(PG8_SA(0, 0), a2, x00, x01);
            PG8_WAIT_V(8); PG8_WAIT_L(0); PG8_BAR; PG8_MMA(1, 0, At, B0); PG8_MMA(1, 1, At, B1); PG8_BAR; PG8_SCHED;
            PG8_LDB(B0, 1, 0); PG8_LDB(B1, 1, 1); PG8_SCHED; PG8_LDA(At, 1, 0); PG8_STAGE2(PG8_SA(0, 1), a2, x10, x11);
            PG8_WAIT_V(8); PG8_WAIT_L(0); PG8_BAR; PG8_MMA(0, 0, At, B0); PG8_MMA(0, 1, At, B1); PG8_BAR; PG8_SCHED;
            PG8_LDA(At, 1, 1); PG8_STAGEB(PG8_SB(1, 0), b3); PG8_STAGEB(PG8_SB(1, 1), b3 + hstep); PG8_STAGE2(PG8_SA(1, 0), a3, x00, x01);
            PG8_WAIT_V(8); PG8_WAIT_L(0); PG8_BAR; PG8_MMA(1, 0, At, B0); PG8_MMA(1, 1, At, B1); PG8_BAR; PG8_SCHED;
            } else {
            PG8_LDB(B0, 0, 0); PG8_SCHED; PG8_LDA(At, 0, 0); PG8_STAGE2(PG8_SA(1, 1), a1, c10, c11);
            PG8_WAIT_L(8); PG8_BAR; PG8_WAIT_L(0); PG8_MMA(0, 0, At, B0); PG8_BAR; PG8_SCHED;
            PG8_LDB(B1, 0, 1); PG8_STAGEB(PG8_SB(0, 0), b2);
            PG8_BAR; PG8_WAIT_L(0); PG8_MMA(0, 1, At, B1); PG8_BAR;
            PG8_LDA(At, 0, 1); PG8_STAGE2(PG8_SA(0, 0), a2, x00, x01);
            PG8_BAR; PG8_WAIT_L(0); PG8_MMA(1, 0, At, B0); PG8_BAR; PG8_SCHED;
            PG8_STAGEB(PG8_SB(0, 1), b2 + hstep);
            PG8_WAIT_V(6); PG8_BAR; PG8_MMA(1, 1, At, B1); PG8_BAR;
            PG8_LDB(B0, 1, 0); PG8_SCHED; PG8_LDA(At, 1, 0); PG8_STAGE2(PG8_SA(0, 1), a2, x10, x11);
            PG8_WAIT_L(8); PG8_BAR; PG8_WAIT_L(0); PG8_MMA(0, 0, At, B0); PG8_BAR; PG8_SCHED;
            PG8_LDB(B1, 1, 1); PG8_STAGEB(PG8_SB(1, 0), b3);
            PG8_BAR; PG8_WAIT_L(0); PG8_MMA(0, 1, At, B1); PG8_BAR;
            PG8_LDA(At, 1, 1); PG8_STAGE2(PG8_SA(1, 0), a3, x00, x01);
            PG8_BAR; PG8_WAIT_L(0); PG8_MMA(1, 0, At, B0); PG8_BAR; PG8_SCHED;
            PG8_STAGEB(PG8_SB(1, 1), b3 + hstep);
            PG8_WAIT_V(6); PG8_BAR; PG8_MMA(1, 1, At, B1); PG8_BAR;
            }
        }
        if constexpr (ALIGN_EPI) { if (wr == 0) PG8_BAR; }
        E(acc, cur, wr, wc);
        if (!has_next) break;
#pragma unroll
        for (int a = 0; a < 2; ++a)
#pragma unroll
            for (int b = 0; b < 2; ++b)
#pragma unroll
                for (int m = 0; m < 4; ++m)
#pragma unroll
                    for (int n = 0; n < 2; ++n) acc[a][b][m][n] = (f32x4){0.f, 0.f, 0.f, 0.f};
        cur = nxt; cB = nB; c00 = n00; c01 = n01; c10 = n10; c11 = n11; ++ui;
        if constexpr (ALIGN_EPI) { if (wr == 1) PG8_BAR; }
    }
    PG8_WAIT_V(0);
    if constexpr (!ALIGN_EPI) { if (wr == 0) PG8_BAR; }
    PG8_BAR;
#undef PG8_SA
#undef PG8_SB
#undef PG8_STAGE2
#undef PG8_STAGEB
#undef PG8_LDA
#undef PG8_LDB
#undef PG8_MMA
#undef PG8_WAIT_V
#undef PG8_WAIT_L
#undef PG8_BAR
#undef PG8_SCHED
#undef PG8_AOFFS
}
}

struct Params {
    const float* in[33];
    float* out;
    unsigned char* ws;
    int layer, pad;
};
enum { I_X = 0, I_C, I_ADAW, I_ADAB, I_NMIX, I_NFFN, I_WIN, I_SCW, I_SCB, I_SDTB, I_SALOG, I_SD, I_SNW, I_HLB, I_HNW, I_LCW, I_LCB, I_LWA, I_LBA, I_LWX, I_LBX, I_LLAM, I_LNW,
       I_WOUT, I_RW, I_RB, I_EG, I_EU, I_ED, I_SG, I_SU, I_SDN, I_FNW };

using pg8::Unit;
struct EpiU {
    static constexpr bool PERM = true;
    bf16_t* O; int ldc;
    __device__ __forceinline__ void operator()(const f32x4 (&acc)[2][2][4][2], const Unit& u, int wr, int wc) const {
        const int lane_ = fresh_lane(), fr = lane_ & 15, fq = lane_ >> 4;
        const int row0 = u.pm * 256 + wr * 64 + fr, col0 = u.pn * 256 + wc * 32 + 8 * fq;
#pragma unroll
        for (int ai = 0; ai < 2; ++ai)
#pragma unroll
            for (int m = 0; m < 4; ++m) { bf16_t* rowp = O + (size_t)(row0 + ai * 128 + m * 16) * ldc + col0;
#pragma unroll
                for (int bj = 0; bj < 2; ++bj) { const f32x4 v0 = acc[ai][bj][m][0], v1 = acc[ai][bj][m][1];
                    u32x4 w; w.x = pk2(v0[0], v0[1]); w.y = pk2(v0[2], v0[3]); w.z = pk2(v1[0], v1[1]); w.w = pk2(v1[2], v1[3]);
                    *(u32x4*)(rowp + bj * 128) = w; } }
    }
};
struct EpiOut {
    static constexpr bool PERM = false;
    const float* xin; float* xout; const float* gate;
    __device__ __forceinline__ void operator()(const f32x4 (&acc)[2][2][4][2], const Unit& u, int wr, int wc) const {
        const int lane_ = fresh_lane(), fr = lane_ & 15, fq = lane_ >> 4;
        const int row0 = u.pm * 256 + wr * 64 + fr, col0 = u.pn * 256 + wc * 32 + 4 * fq, b = u.pm >> 3;
        f32x4 gv[2][2];
#pragma unroll
        for (int bj = 0; bj < 2; ++bj)
#pragma unroll
            for (int n = 0; n < 2; ++n) gv[bj][n] = *(const f32x4*)(gate + (size_t)b * NMOD + col0 + bj * 128 + n * 16);
#pragma unroll
        for (int ai = 0; ai < 2; ++ai)
#pragma unroll
            for (int m = 0; m < 4; ++m) { const size_t off = (size_t)(row0 + ai * 128 + m * 16) * DM + col0;
#pragma unroll
                for (int bj = 0; bj < 2; ++bj)
#pragma unroll
                    for (int n = 0; n < 2; ++n) { const f32x4 xi = *(const f32x4*)(xin + off + bj * 128 + n * 16);
                        *(f32x4*)(xout + off + bj * 128 + n * 16) = xi + gv[bj][n] * acc[ai][bj][m][n]; }
                asm volatile("" ::: "memory"); }
    }
};
struct EpiH {
    static constexpr bool PERM = true;
    bf16_t* Hm;
    __device__ __forceinline__ void operator()(const f32x4 (&acc)[2][2][4][2], const Unit& u, int wr, int wc) const {
        const int lane_ = fresh_lane(), fr = lane_ & 15, fq = lane_ >> 4;
        const int row0 = u.pm * 256 + wr * 64 + fr, col0 = u.pn * 128 + wc * 32 + 8 * fq;
#pragma unroll
        for (int ai = 0; ai < 2; ++ai)
#pragma unroll
            for (int m = 0; m < 4; ++m) { bf16_t* rowp = Hm + (size_t)(row0 + ai * 128 + m * 16) * 256 + col0;
                f32x4 h0, h1;
#pragma unroll
                for (int j = 0; j < 4; ++j) { h0[j] = siluf_(acc[ai][0][m][0][j]) * acc[ai][1][m][0][j]; h1[j] = siluf_(acc[ai][0][m][1][j]) * acc[ai][1][m][1][j]; }
                u32x4 w; w.x = pk2(h0[0], h0[1]); w.y = pk2(h0[2], h0[3]); w.z = pk2(h1[0], h1[1]); w.w = pk2(h1[2], h1[3]);
                *(u32x4*)rowp = w; }
    }
};
struct EpiY {
    static constexpr bool PERM = true;
    unsigned char* Y; unsigned char* Ysh; const int* rinfo;
    __device__ __forceinline__ void operator()(const f32x4 (&acc)[2][2][4][2], const Unit& u, int wr, int wc) const {
        const int lane_ = fresh_lane(), fr = lane_ & 15, fq = lane_ >> 4;
        const int col0 = u.pn * 256 + wc * 32 + 8 * fq;
        unsigned char* base = Y + (size_t)u.pm * 256 * DM;
        if (u.e >= NEXP) base = Ysh + (size_t)(u.pm - rinfo[0]) * 256 * DM;
        base += (size_t)(wr * 64 + fr) * DM + col0;
#pragma unroll
        for (int ai = 0; ai < 2; ++ai)
#pragma unroll
            for (int m = 0; m < 4; ++m) { unsigned char* rowp = base + (size_t)(ai * 128 + m * 16) * DM;
#pragma unroll
                for (int bj = 0; bj < 2; ++bj) { const f32x4 v0 = acc[ai][bj][m][0] * Y8_SCALE, v1 = acc[ai][bj][m][1] * Y8_SCALE;
                    u32x2 w; w.x = pk4_fp8(v0[0], v0[1], v0[2], v0[3]); w.y = pk4_fp8(v1[0], v1[1], v1[2], v1[3]);
                    *(u32x2*)(rowp + bj * 128) = w; } }
    }
};
constexpr int LDS_UTAB = 131072, MAX_UNITS = 24;
__device__ __forceinline__ void moe_build_units(LAS unsigned char* lds, const int* rinfo, int NQ, int G, int cidx, int tid) {
    LAS int* tab = (LAS int*)(lds + LDS_UTAB);
    if (tid < MAX_UNITS) {
        const int nblk = rinfo[0]; const long L = (long)tid * G + cidx;
        int pm = -1, pn = 0, e = 0;
        if (L < (long)(nblk + 64) * NQ) { const int rb = (int)(L / NQ); pm = rb; pn = (int)(L % NQ); e = (rb < nblk) ? rinfo[64 + rb] : NEXP; }
        tab[tid * 4 + 0] = pm; tab[tid * 4 + 1] = pn; tab[tid * 4 + 2] = e; tab[tid * 4 + 3] = 0;
    }
    __syncthreads();
}
struct MoeOrder {
    const LAS int* tab;
    __device__ bool next(int i, Unit& u) const {
        if (i >= MAX_UNITS) return false;
        const int pm = __builtin_amdgcn_readfirstlane(tab[i * 4 + 0]); if (pm < 0) return false;
        u.pm = pm; u.pn = __builtin_amdgcn_readfirstlane(tab[i * 4 + 1]); u.e = __builtin_amdgcn_readfirstlane(tab[i * 4 + 2]); return true;
    }
};
struct GatherRows {
    const int* slot_tok; const int* rinfo;
    __device__ __forceinline__ int row(const Unit& u, int r) const {
        const int nblk = rinfo[0];
        if (u.pm < nblk) { const int t = slot_tok[u.pm * 256 + r]; return t < 0 ? 0 : t; }
        return (u.pm - nblk) * 256 + r;
    }
};

struct Ctx { LAS unsigned char* lds; int tid, lane, wave, G, bid; };

template <class RowMap>
__device__ __forceinline__ void transpose_item(const float* W, int N, int k0, int n0, bf16_t* WT, int ldk, const RowMap& rm, LAS float* scr, int lane) {
    const int nn = n0 + (lane & 31);
#pragma unroll 8
    for (int i = 0; i < 32; ++i) { const int kk = 2 * i + (lane >> 5); scr[kk * 33 + (lane & 31)] = (nn < N) ? W[(size_t)(k0 + kk) * N + nn] : 0.f; }
    LDS_WAIT();
    const int c = lane & 7;
#pragma unroll
    for (int j = 0; j < 4; ++j) { const int n = (lane >> 3) + 8 * j; const LAS float* s = scr + (8 * c) * 33 + n;
        u32x4 o; o.x = pk2(s[0 * 33], s[1 * 33]); o.y = pk2(s[2 * 33], s[3 * 33]); o.z = pk2(s[4 * 33], s[5 * 33]); o.w = pk2(s[6 * 33], s[7 * 33]);
        const int dr = (n0 + n < N) ? rm(n0 + n) : -1;
        if (dr >= 0) *(u32x4*)(WT + (size_t)dr * ldk + k0 + 8 * c) = o; }
    LDS_WAIT();
}
struct RmIdent { __device__ __forceinline__ int operator()(int n) const { return n; } };
struct RmWin { __device__ __forceinline__ int operator()(int n) const { return n < 2560 ? n : (n < 2576 ? -1 : n - 16); } };
struct RmGate { __device__ __forceinline__ int operator()(int n) const { return (n >> 7) * 256 + (n & 127); } };
struct RmUp { __device__ __forceinline__ int operator()(int n) const { return (n >> 7) * 256 + 128 + (n & 127); } };

__device__ __forceinline__ void phase_prep_io(const Params& p, const Ctx& c) {
    LAS float* scr = (LAS float*)(c.lds + c.wave * 16384);
    const int gw = c.bid * NWAVES + c.wave, NGW = c.G * NWAVES;
    constexpr int I_IN = 16 * 177, I_OUT = 32 * 32, PER_L = I_IN + I_OUT;
    for (int it = gw; it < NLAYER * PER_L; it += NGW) {
        const int l = it / PER_L; int r = it % PER_L;
        if (r < I_IN) { const int kb = r / 177, nb = r % 177;
            transpose_item(p.in[I_WIN] + (size_t)l * DM * DIN, DIN, kb * 64, nb * 32, (bf16_t*)(p.ws + WS_WIN) + (size_t)l * NU * DM, DM, RmWin(), scr, c.lane); }
        else { r -= I_IN; const int kb = r / 32, nb = r % 32;
            transpose_item(p.in[I_WOUT] + (size_t)l * 2048 * DM, DM, kb * 64, nb * 32, (bf16_t*)(p.ws + WS_WOUT) + (size_t)l * DM * 2048, 2048, RmIdent(), scr, c.lane); }
    }
}
__device__ __forceinline__ void phase_prep_experts(const Params& p, const Ctx& c, int l) {
    LAS float* scr = (LAS float*)(c.lds + c.wave * 16384);
    const int gw = c.bid * NWAVES + c.wave, NGW = c.G * NWAVES;
    constexpr int PER_E = 3 * 128;
    bf16_t* GU = (bf16_t*)(p.ws + WS_GU); bf16_t* DN = (bf16_t*)(p.ws + WS_DN);
    for (int it = gw; it < 65 * PER_E; it += NGW) {
        const int e = it / PER_E; int r = it % PER_E; const int which = r / 128; r %= 128;
        if (which < 2) {
            const float* src = (e < NEXP) ? p.in[which == 0 ? I_EG : I_EU] + ((size_t)l * NEXP + e) * DM * 256 : p.in[which == 0 ? I_SG : I_SU] + (size_t)l * DM * 256;
            const int kb = r / 8, nb = r % 8;
            if (which == 0) transpose_item(src, 256, kb * 64, nb * 32, GU + (size_t)e * 512 * DM, DM, RmGate(), scr, c.lane);
            else transpose_item(src, 256, kb * 64, nb * 32, GU + (size_t)e * 512 * DM, DM, RmUp(), scr, c.lane);
        } else {
            const float* src = (e < NEXP) ? p.in[I_ED] + ((size_t)l * NEXP + e) * 256 * DM : p.in[I_SDN] + (size_t)l * 256 * DM;
            const int kb = r / 32, nb = r % 32;
            transpose_item(src, DM, kb * 64, nb * 32, DN + (size_t)e * DM * 256, 256, RmIdent(), scr, c.lane);
        }
    }
}
__device__ __forceinline__ void phase_prep_small(const Params& p, const Ctx& c) {
    LAS float* sc = (LAS float*)c.lds;
    LAS float* red = (LAS float*)(c.lds + 32768);
    float* mod = (float*)(p.ws + WS_MOD);
    bool have_sc = false;
    for (int it = c.bid; it < NLAYER * 96; it += c.G) {
        if (!have_sc) { for (int i = c.tid; i < 8 * 1024; i += NTHREADS) sc[i] = siluf_(p.in[I_C][i]); have_sc = true; }
        __syncthreads();
        const int l = it / 96, j0 = (it % 96) * 64, j = c.tid & 63, kg = c.tid >> 6;
        const float* W = p.in[I_ADAW] + (size_t)l * DM * NMOD + j0 + j;
        float a[8];
#pragma unroll
        for (int b = 0; b < 8; ++b) a[b] = 0.f;
#pragma unroll 16
        for (int k = kg * 128; k < kg * 128 + 128; ++k) { const float w = W[(size_t)k * NMOD];
#pragma unroll
            for (int b = 0; b < 8; ++b) a[b] += sc[b * 1024 + k] * w; }
#pragma unroll
        for (int b = 0; b < 8; ++b) red[(kg * 8 + b) * 64 + j] = a[b];
        __syncthreads();
        { const int b = c.tid >> 6; float s = 0.f;
#pragma unroll
          for (int g = 0; g < 8; ++g) s += red[(g * 8 + b) * 64 + j];
          mod[((size_t)l * 8 + b) * NMOD + j0 + j] = s + p.in[I_ADAB][(size_t)l * NMOD + j0 + j]; }
        __syncthreads();
    }
    if (c.bid == c.G - 1) {
        float* lb = (float*)(p.ws + WS_LB);
        for (int i = c.tid; i < 512; i += NTHREADS) { const float v0 = p.in[I_HLB][i], v1 = p.in[I_HLB][512 + i]; const float m = fmaxf(v0, v1), e0 = expf(v0 - m), e1 = expf(v1 - m);
            lb[i] = 0.f; lb[512 + i] = e1 / (e0 + e1); }
    }
    { float* WT = (float*)(p.ws + WS_WRT);
      for (int o = c.bid * NTHREADS + c.tid; o < NLAYER * 64 * 1024; o += c.G * NTHREADS) { const int k = o & 1023, e = (o >> 10) & 63, l = o >> 16; WT[o] = p.in[I_RW][((size_t)l * 1024 + k) * 64 + e]; } }
    { bf16_t* LW = (bf16_t*)(p.ws + WS_LRUW);
      for (int o = c.bid * NTHREADS + c.tid; o < NLAYER * 2 * 8 * 4096; o += c.G * NTHREADS) {
          const int i = o & 63, j = (o >> 6) & 63, g = (o >> 12) & 7, mat = (o >> 15) & 1, l = o >> 16;
          const float* src = p.in[mat == 0 ? I_LWA : I_LWX] + (((size_t)l * 8 + g) * 64 + i) * 64 + j;
          LW[o] = (bf16_t)f2bf(*src); } }
}

__device__ __forceinline__ void phase_norm_mix(const Params& p, const Ctx& c, int l, const float* xin) {
    LAS float* wdt = (LAS float*)c.lds;
    const float* Win = p.in[I_WIN] + (size_t)l * DM * DIN;
    for (int i = c.tid; i < 16 * 1024; i += NTHREADS) { const int k = i >> 4, j = i & 15; wdt[j * 1024 + k] = Win[(size_t)k * DIN + 2560 + j]; }
    __syncthreads();
    const float* mod = (const float*)(p.ws + WS_MOD) + (size_t)l * 8 * NMOD;
    const float* nw = p.in[I_NMIX] + (size_t)l * DM;
    bf16_t* H = (bf16_t*)(p.ws + WS_H); float* dtraw = (float*)(p.ws + WS_DTRAW);
    const int gw = c.bid * NWAVES + c.wave, NGW = c.G * NWAVES;
    f32x4 vn[4];
    if (gw < NTOK) {
#pragma unroll
        for (int j = 0; j < 4; ++j) vn[j] = ((const f32x4*)(xin + (size_t)gw * DM) + c.lane)[64 * j];
    }
    for (int tok = gw; tok < NTOK; tok += NGW) {
        const int b = tok >> 11;
        f32x4 v[4]; float ss = 0.f;
#pragma unroll
        for (int j = 0; j < 4; ++j) { v[j] = vn[j]; ss += (v[j][0] * v[j][0] + v[j][1] * v[j][1]) + (v[j][2] * v[j][2] + v[j][3] * v[j][3]); }
        if (tok + NGW < NTOK) {
#pragma unroll
            for (int j = 0; j < 4; ++j) vn[j] = ((const f32x4*)(xin + (size_t)(tok + NGW) * DM) + c.lane)[64 * j];
        }
        const float rstd = rsqf_(wave_sum(ss, c.lane) * (1.0f / DM) + EPS);
        f32x4 hv[4], w4v[4], shv[4], scv[4];
#pragma unroll
        for (int j = 0; j < 4; ++j) { const int col = 256 * j + 4 * c.lane;
            w4v[j] = *(const f32x4*)(nw + col); shv[j] = *(const f32x4*)(mod + (size_t)b * NMOD + col); scv[j] = *(const f32x4*)(mod + (size_t)b * NMOD + 1024 + col); }
#pragma unroll
        for (int j = 0; j < 4; ++j) {
            const int col = 256 * j + 4 * c.lane;
            const f32x4 w4 = w4v[j], sh = shv[j], sc = scv[j];
            hv[j] = (v[j] * rstd * w4) * (sc + 1.0f) + sh;
            u32x2 o; o.x = pk2(hv[j][0], hv[j][1]); o.y = pk2(hv[j][2], hv[j][3]);
            *(u32x2*)(H + (size_t)tok * DM + col) = o;
        }
        float d16[16];
#pragma unroll
        for (int q = 0; q < 16; ++q) {
            float s2 = 0.f;
#pragma unroll
            for (int j = 0; j < 4; ++j) { const f32x4 wq = *(const LAS f32x4*)(wdt + q * 1024 + 256 * j + 4 * c.lane); s2 += (hv[j][0] * wq[0] + hv[j][1] * wq[1]) + (hv[j][2] * wq[2] + hv[j][3] * wq[3]); }
            d16[q] = s2;
            if ((q & 1) == 1) asm volatile("" ::: "memory");
        }
        float d8[8], d4[4], d2[2], d1;
        { const bool up = (c.lane & 32) != 0;
#pragma unroll
          for (int i = 0; i < 8; ++i) { const float snd = up ? d16[i] : d16[8 + i], kp = up ? d16[8 + i] : d16[i]; d8[i] = kp + shfl_xor_l(snd, 32, c.lane); } }
        { const bool up = (c.lane & 16) != 0;
#pragma unroll
          for (int i = 0; i < 4; ++i) { const float snd = up ? d8[i] : d8[4 + i], kp = up ? d8[4 + i] : d8[i]; d4[i] = kp + shfl_xor_l(snd, 16, c.lane); } }
        { const bool up = (c.lane & 8) != 0;
#pragma unroll
          for (int i = 0; i < 2; ++i) { const float snd = up ? d4[i] : d4[2 + i], kp = up ? d4[2 + i] : d4[i]; d2[i] = kp + shfl_xor_l(snd, 8, c.lane); } }
        { const bool up = (c.lane & 4) != 0; const float snd = up ? d2[0] : d2[1], kp = up ? d2[1] : d2[0]; d1 = kp + shfl_xor_l(snd, 4, c.lane); }
        d1 += shfl_xor_l(d1, 2, c.lane); d1 += shfl_xor_l(d1, 1, c.lane);
        if ((c.lane & 3) == 0) dtraw[(size_t)tok * 16 + ((c.lane >> 5) & 1) * 8 + ((c.lane >> 4) & 1) * 4 + ((c.lane >> 3) & 1) * 2 + ((c.lane >> 2) & 1)] = d1;
    }
}

__device__ __forceinline__ void phase_ssd_conv(const Params& p, const Ctx& c, int l) {
    const bf16_t* U = (const bf16_t*)(p.ws + WS_U); bf16_t* XA = (bf16_t*)(p.ws + WS_XBC);
    const float* cw = p.in[I_SCW] + (size_t)l * 4 * 1536; const float* cb = p.in[I_SCB] + (size_t)l * 1536;
    const float* dtraw = (const float*)(p.ws + WS_DTRAW); float* dt = (float*)(p.ws + WS_DT); float* acum = (float*)(p.ws + WS_ACUM);
    for (int idx = c.bid * NTHREADS + c.tid; idx < (NTOK / 4) * 192; idx += c.G * NTHREADS) {
        const int oct = idx % 192, tg = idx / 192, tok0 = tg * 4, t0 = tok0 & (SEQ - 1), c0 = oct * 8;
        float w[4][8], bb[8];
#pragma unroll
        for (int k = 0; k < 4; ++k) { const f32x4 a = *(const f32x4*)(cw + k * 1536 + c0), b2 = *(const f32x4*)(cw + k * 1536 + c0 + 4);
            w[k][0] = a[0]; w[k][1] = a[1]; w[k][2] = a[2]; w[k][3] = a[3]; w[k][4] = b2[0]; w[k][5] = b2[1]; w[k][6] = b2[2]; w[k][7] = b2[3]; }
        { const f32x4 a = *(const f32x4*)(cb + c0), b2 = *(const f32x4*)(cb + c0 + 4); bb[0] = a[0]; bb[1] = a[1]; bb[2] = a[2]; bb[3] = a[3]; bb[4] = b2[0]; bb[5] = b2[1]; bb[6] = b2[2]; bb[7] = b2[3]; }
        float x[7][8];
#pragma unroll
        for (int r = 0; r < 7; ++r) {
            u32x4 v = (u32x4){0u, 0u, 0u, 0u};
            if (t0 + r - 3 >= 0) v = *(const u32x4*)(U + (size_t)(tok0 + r - 3) * NU + UXS + c0);
#pragma unroll
            for (int j = 0; j < 4; ++j) { x[r][2 * j] = lo_bf(v[j]); x[r][2 * j + 1] = hi_bf(v[j]); }
        }
#pragma unroll
        for (int t = 0; t < 4; ++t) {
            float y[8];
#pragma unroll
            for (int j = 0; j < 8; ++j) y[j] = siluf_(bb[j] + w[0][j] * x[t][j] + w[1][j] * x[t + 1][j] + w[2][j] * x[t + 2][j] + w[3][j] * x[t + 3][j]);
            u32x4 o; o.x = pk2(y[0], y[1]); o.y = pk2(y[2], y[3]); o.z = pk2(y[4], y[5]); o.w = pk2(y[6], y[7]);
            *(u32x4*)(XA + (size_t)(tok0 + t) * 1536 + c0) = o;
        }
    }
    const int gw = c.bid * NWAVES + c.wave, NGW = c.G * NWAVES;
    for (int it = gw; it < 128; it += NGW) {
        const int tok0 = it * 128, h = c.lane & 15, qtr = c.lane >> 4;
        const float bias = p.in[I_SDTB][l * 16 + h], A = -expf(p.in[I_SALOG][l * 16 + h]);
        float d[32]; float cum = 0.f;
#pragma unroll
        for (int i = 0; i < 32; ++i) d[i] = softplusf_(dtraw[(size_t)(tok0 + qtr * 32 + i) * 16 + h] + bias);
#pragma unroll
        for (int i = 0; i < 32; ++i) cum += d[i] * A;
        const float c1 = shfl_up_f(cum, 16, c.lane), c2 = shfl_up_f(cum, 32, c.lane), c3 = shfl_up_f(cum, 48, c.lane);
        float off = 0.f; if (qtr >= 1) off += c1; if (qtr >= 2) off += c2; if (qtr >= 3) off += c3;
        float run = off;
#pragma unroll
        for (int i = 0; i < 32; ++i) { run += d[i] * A; dt[(size_t)(tok0 + qtr * 32 + i) * 16 + h] = d[i]; acum[(size_t)(tok0 + qtr * 32 + i) * 16 + h] = run; }
    }
}

__device__ __forceinline__ void phase_ssd_state(const Params& p, const Ctx& c) {
    LAS bf16_t* XS = (LAS bf16_t*)c.lds;
    LAS bf16_t* BS = (LAS bf16_t*)(c.lds + 128 * 72 * 2);
    const bf16_t* XA = (const bf16_t*)(p.ws + WS_XBC); const float* dt = (const float*)(p.ws + WS_DT); const float* acum = (const float*)(p.ws + WS_ACUM);
    bf16_t* ST = (bf16_t*)(p.ws + WS_SST);
    const int fr = c.lane & 15, fq = c.lane >> 4;
    for (int it = c.bid; it < 2048; it += c.G) {
        const int h = it & 15, bc = it >> 4, tok0 = bc * 128, g = h >> 3;
        const float aend = acum[(size_t)(tok0 + 127) * 16 + h];
        for (int i = c.tid; i < 128 * 8; i += NTHREADS) { const int lrow = i >> 3, ck = i & 7;
            const u32x4 r = *(const u32x4*)(XA + (size_t)(tok0 + lrow) * 1536 + h * 64 + ck * 8);
            const float f = dt[(size_t)(tok0 + lrow) * 16 + h] * __expf(aend - acum[(size_t)(tok0 + lrow) * 16 + h]);
            u32x4 o; o.x = pk2(lo_bf(r.x) * f, hi_bf(r.x) * f); o.y = pk2(lo_bf(r.y) * f, hi_bf(r.y) * f); o.z = pk2(lo_bf(r.z) * f, hi_bf(r.z) * f); o.w = pk2(lo_bf(r.w) * f, hi_bf(r.w) * f);
            *(LAS u32x4*)(XS + lrow * 72 + ck * 8) = o; }
        for (int i = c.tid; i < 128 * 16; i += NTHREADS) { const int lrow = i >> 4, ck = i & 15;
            *(LAS u32x4*)(BS + lrow * 136 + ck * 8) = *(const u32x4*)(XA + (size_t)(tok0 + lrow) * 1536 + 1024 + g * 128 + ck * 8); }
        __syncthreads();
        f32x4 acc[4];
#pragma unroll
        for (int m = 0; m < 4; ++m) acc[m] = (f32x4){0.f, 0.f, 0.f, 0.f};
#pragma unroll
        for (int ks = 0; ks < 4; ++ks) {
            const bf16x8 bfr = tr_frag(BS, 136, 32 * ks, 16 * c.wave, c.lane);
#pragma unroll
            for (int m = 0; m < 4; ++m) { const bf16x8 afr = tr_frag(XS, 72, 32 * ks, 16 * m, c.lane); acc[m] = MFMA16(bfr, afr, acc[m]); }
        }
#pragma unroll
        for (int m = 0; m < 4; ++m) { u32x2 o; o.x = pk2(acc[m][0], acc[m][1]); o.y = pk2(acc[m][2], acc[m][3]);
            *(u32x2*)(ST + (size_t)it * 8192 + (16 * m + fr) * 128 + 16 * c.wave + 4 * fq) = o; }
        __syncthreads();
    }
}
__device__ __forceinline__ void phase_ssd_scan(const Params& p, const Ctx& c) {
    unsigned* ST = (unsigned*)(p.ws + WS_SST); const float* acum = (const float*)(p.ws + WS_ACUM);
    for (int i = c.bid * NTHREADS + c.tid; i < 128 * 4096; i += c.G * NTHREADS) {
        const int e2 = i & 4095, bh = i >> 12, b = bh >> 4, h = bh & 15;
        float r0 = 0.f, r1 = 0.f;
        for (int ch = 0; ch < 16; ++ch) {
            const size_t it = (size_t)((b * 16 + ch) * 16 + h);
            const unsigned loc = ST[it * 4096 + e2];
            ST[it * 4096 + e2] = pk2(r0, r1);
            const float d = __expf(acum[(size_t)(b * SEQ + ch * 128 + 127) * 16 + h]);
            r0 = d * r0 + lo_bf(loc); r1 = d * r1 + hi_bf(loc);
        }
    }
}
__device__ __forceinline__ void phase_ssd_out(const Params& p, const Ctx& c, int l) {
    LAS bf16_t* Cs = (LAS bf16_t*)c.lds;
    LAS bf16_t* Bs = (LAS bf16_t*)(c.lds + 34816);
    LAS bf16_t* CBD = (LAS bf16_t*)(c.lds + 2 * 34816);
    LAS bf16_t* XS = (LAS bf16_t*)(c.lds + 3 * 34816);
    LAS bf16_t* STs = (LAS bf16_t*)(c.lds + 3 * 34816 + 18432);
    LAS float* acs = (LAS float*)(c.lds + 3 * 34816 + 18432 + 17408);
    const bf16_t* XA = (const bf16_t*)(p.ws + WS_XBC); const float* dt = (const float*)(p.ws + WS_DT); const float* acum = (const float*)(p.ws + WS_ACUM);
    const bf16_t* ST = (const bf16_t*)(p.ws + WS_SST); bf16_t* YP = (bf16_t*)(p.ws + WS_H);
    const int fr = c.lane & 15, fq = c.lane >> 4, w = c.wave;
    for (int it = c.bid; it < 2048; it += c.G) {
        const int h = it & 15, bc = it >> 4, tok0 = bc * 128, g = h >> 3;
        const float Dh = p.in[I_SD][l * 16 + h];
        for (int i = c.tid; i < 128 * 16; i += NTHREADS) { const int row = i >> 4, ck = i & 15;
            *(LAS u32x4*)(Bs + row * 136 + ck * 8) = *(const u32x4*)(XA + (size_t)(tok0 + row) * 1536 + 1024 + g * 128 + ck * 8);
            *(LAS u32x4*)(Cs + row * 136 + ck * 8) = *(const u32x4*)(XA + (size_t)(tok0 + row) * 1536 + 1280 + g * 128 + ck * 8); }
        for (int i = c.tid; i < 64 * 16; i += NTHREADS) { const int row = i >> 4, ck = i & 15;
            *(LAS u32x4*)(STs + row * 136 + ck * 8) = *(const u32x4*)(ST + (size_t)it * 8192 + row * 128 + ck * 8); }
        for (int i = c.tid; i < 128 * 8; i += NTHREADS) { const int lrow = i >> 3, ck = i & 7;
            const u32x4 r = *(const u32x4*)(XA + (size_t)(tok0 + lrow) * 1536 + h * 64 + ck * 8);
            const float f = dt[(size_t)(tok0 + lrow) * 16 + h];
            u32x4 o; o.x = pk2(lo_bf(r.x) * f, hi_bf(r.x) * f); o.y = pk2(lo_bf(r.y) * f, hi_bf(r.y) * f); o.z = pk2(lo_bf(r.z) * f, hi_bf(r.z) * f); o.w = pk2(lo_bf(r.w) * f, hi_bf(r.w) * f);
            *(LAS u32x4*)(XS + lrow * 72 + ck * 8) = o; }
        if (c.tid < 128) acs[c.tid] = acum[(size_t)(tok0 + c.tid) * 16 + h];
        __syncthreads();
        {
            f32x4 cb[8];
#pragma unroll
            for (int n = 0; n < 8; ++n) cb[n] = (f32x4){0.f, 0.f, 0.f, 0.f};
#pragma unroll
            for (int ks = 0; ks < 4; ++ks) {
                const bf16x8 afr = *(const LAS bf16x8*)(Cs + (16 * w + fr) * 136 + ks * 32 + 8 * fq);
#pragma unroll
                for (int n = 0; n < 8; ++n) { const bf16x8 bfr = *(const LAS bf16x8*)(Bs + (16 * n + fr) * 136 + ks * 32 + 8 * fq); cb[n] = MFMA16(bfr, afr, cb[n]); }
            }
            const int lr = 16 * w + fr; const float al = acs[lr];
#pragma unroll
            for (int n = 0; n < 8; ++n) { float v4[4];
#pragma unroll
                for (int r = 0; r < 4; ++r) { const int sc = 16 * n + 4 * fq + r; v4[r] = (sc <= lr) ? cb[n][r] * __expf(al - acs[sc]) : 0.f; }
                u32x2 o; o.x = pk2(v4[0], v4[1]); o.y = pk2(v4[2], v4[3]);
                *(LAS u32x2*)(CBD + lr * 136 + 16 * n + 4 * fq) = o; }
        }
        __syncthreads();
        {
            f32x4 a1[4], a2[4];
#pragma unroll
            for (int n = 0; n < 4; ++n) { a1[n] = (f32x4){0.f, 0.f, 0.f, 0.f}; a2[n] = (f32x4){0.f, 0.f, 0.f, 0.f}; }
#pragma unroll
            for (int ks = 0; ks < 4; ++ks) {
                const bf16x8 ad = *(const LAS bf16x8*)(CBD + (16 * w + fr) * 136 + ks * 32 + 8 * fq);
                const bf16x8 ac = *(const LAS bf16x8*)(Cs + (16 * w + fr) * 136 + ks * 32 + 8 * fq);
#pragma unroll
                for (int n = 0; n < 4; ++n) {
                    const bf16x8 bx = tr_frag(XS, 72, 32 * ks, 16 * n, c.lane);
                    const bf16x8 bs = *(const LAS bf16x8*)(STs + (16 * n + fr) * 136 + ks * 32 + 8 * fq);
                    a1[n] = MFMA16(bx, ad, a1[n]); a2[n] = MFMA16(bs, ac, a2[n]); }
            }
            const int lr = 16 * w + fr; const float ea = __expf(acs[lr]);
#pragma unroll
            for (int n = 0; n < 4; ++n) { const int pc = 16 * n + 4 * fq;
                const u32x2 xv = *(const u32x2*)(XA + (size_t)(tok0 + lr) * 1536 + h * 64 + pc);
                const float y0 = a1[n][0] + ea * a2[n][0] + Dh * lo_bf(xv.x), y1 = a1[n][1] + ea * a2[n][1] + Dh * hi_bf(xv.x);
                const float y2 = a1[n][2] + ea * a2[n][2] + Dh * lo_bf(xv.y), y3 = a1[n][3] + ea * a2[n][3] + Dh * hi_bf(xv.y);
                u32x2 o; o.x = pk2(y0, y1); o.y = pk2(y2, y3);
                *(u32x2*)(YP + (size_t)(tok0 + lr) * DM + h * 64 + pc) = o; }
        }
        __syncthreads();
    }
}
__device__ __forceinline__ void phase_ssd_gate(const Params& p, const Ctx& c, int l) {
    const bf16_t* YP = (const bf16_t*)(p.ws + WS_H); const bf16_t* U = (const bf16_t*)(p.ws + WS_U); bf16_t* YC = (bf16_t*)(p.ws + WS_YCAT);
    const float* nw = p.in[I_SNW] + (size_t)l * 1024;
    for (int r0 = c.bid * 64; r0 < NTOK * 2; r0 += c.G * 64) {
        const int row = r0 + (c.tid >> 3), part = c.tid & 7, tok = row >> 1, g = row & 1, col = g * 512 + part * 64;
        u32x4 yv[8], zv[8];
#pragma unroll
        for (int i = 0; i < 8; ++i) { yv[i] = *(const u32x4*)(YP + (size_t)tok * DM + col + 8 * i); zv[i] = *(const u32x4*)(U + (size_t)tok * NU + UZ + col + 8 * i); }
        float v[64]; float ss = 0.f;
#pragma unroll
        for (int i = 0; i < 8; ++i)
#pragma unroll
            for (int j = 0; j < 4; ++j) { const float a = lo_bf(yv[i][j]) * siluf_(lo_bf(zv[i][j])), b2 = hi_bf(yv[i][j]) * siluf_(hi_bf(zv[i][j])); v[8 * i + 2 * j] = a; v[8 * i + 2 * j + 1] = b2; ss += a * a + b2 * b2; }
        ss += shfl_xor_l(ss, 1, c.lane); ss += shfl_xor_l(ss, 2, c.lane); ss += shfl_xor_l(ss, 4, c.lane);
        const float rstd = rsqf_(ss * (1.0f / 512.0f) + EPS);
#pragma unroll
        for (int i = 0; i < 8; ++i) { const f32x4 w0 = *(const f32x4*)(nw + col + 8 * i), w1 = *(const f32x4*)(nw + col + 8 * i + 4);
            u32x4 o; o.x = pk2(v[8 * i] * rstd * w0[0], v[8 * i + 1] * rstd * w0[1]); o.y = pk2(v[8 * i + 2] * rstd * w0[2], v[8 * i + 3] * rstd * w0[3]);
            o.z = pk2(v[8 * i + 4] * rstd * w1[0], v[8 * i + 5] * rstd * w1[1]); o.w = pk2(v[8 * i + 6] * rstd * w1[2], v[8 * i + 7] * rstd * w1[3]);
            *(u32x4*)(YC + (size_t)tok * 2048 + col + 8 * i) = o; }
    }
}
__device__ __forceinline__ void phase_hg_state(const Params& p, const Ctx& c, int l) {
    LAS float* Bf = (LAS float*)c.lds;
    LAS float* KK = (LAS float*)(c.lds + 33792);
    LAS bf16_t* KD = (LAS bf16_t*)(c.lds + 2 * 33792 + 2112);
    LAS bf16_t* VS = (LAS bf16_t*)(c.lds + 2 * 33792 + 2112 + 17408);
    const bf16_t* U = (const bf16_t*)(p.ws + WS_U); const float* lb = (const float*)(p.ws + WS_LB) + l * 512;
    bf16_t* ST = (bf16_t*)(p.ws + WS_HST); float* BL = (float*)(p.ws + WS_HGBL);
    const int fr = c.lane & 15, fq = c.lane >> 4, w = c.wave;
    for (int it = c.bid; it < 1024; it += c.G) {
        const int ch = it & 31, bh = it >> 5, h = bh & 3, b = bh >> 2, tok0 = b * SEQ + ch * 64;
        for (int i = c.tid; i < 64 * 16; i += NTHREADS) { const int sr = i >> 4, ck = i & 15;
            const size_t ro = (size_t)(tok0 + sr) * NU + h * 128 + ck * 8;
            const u32x4 rf = *(const u32x4*)(U + ro + UHF);
            *(LAS u32x4*)(VS + sr * 136 + ck * 8) = *(const u32x4*)(U + ro + UHV);
            const f32x4 l0 = *(const f32x4*)(lb + h * 128 + ck * 8), l1 = *(const f32x4*)(lb + h * 128 + ck * 8 + 4);
            f32x4 k0, k1, g0, g1;
            k0[0] = (1.0f - l0[0]) * sigmoidf_(-lo_bf(rf.x)); k0[1] = (1.0f - l0[1]) * sigmoidf_(-hi_bf(rf.x)); k0[2] = (1.0f - l0[2]) * sigmoidf_(-lo_bf(rf.y)); k0[3] = (1.0f - l0[3]) * sigmoidf_(-hi_bf(rf.y));
            k1[0] = (1.0f - l1[0]) * sigmoidf_(-lo_bf(rf.z)); k1[1] = (1.0f - l1[1]) * sigmoidf_(-hi_bf(rf.z)); k1[2] = (1.0f - l1[2]) * sigmoidf_(-lo_bf(rf.w)); k1[3] = (1.0f - l1[3]) * sigmoidf_(-hi_bf(rf.w));
#pragma unroll
            for (int j = 0; j < 4; ++j) { g0[j] = __logf(1.0f - k0[j]); g1[j] = __logf(1.0f - k1[j]); }
            *(LAS f32x4*)(KK + sr * 132 + ck * 8) = k0; *(LAS f32x4*)(KK + sr * 132 + ck * 8 + 4) = k1;
            *(LAS f32x4*)(Bf + sr * 132 + ck * 8) = g0; *(LAS f32x4*)(Bf + sr * 132 + ck * 8 + 4) = g1; }
        __syncthreads();
        { const int kc = c.tid & 127, q4 = c.tid >> 7; float vals[16]; float cum = 0.f;
#pragma unroll
          for (int i = 0; i < 16; ++i) { cum += Bf[(16 * q4 + i) * 132 + kc]; vals[i] = cum; }
          KK[(64 + q4) * 132 + kc] = cum;
          __syncthreads();
          float off = 0.f;
#pragma unroll
          for (int j = 0; j < 3; ++j) off += (j < q4) ? KK[(64 + j) * 132 + kc] : 0.f;
#pragma unroll
          for (int i = 0; i < 16; ++i) Bf[(16 * q4 + i) * 132 + kc] = vals[i] + off;
          if (q4 == 3) BL[(size_t)it * 128 + kc] = vals[15] + off; }
        __syncthreads();
        for (int i = c.tid; i < 64 * 16; i += NTHREADS) { const int sr = i >> 4, ck = i & 15;
            const f32x4 ka = *(const LAS f32x4*)(KK + sr * 132 + ck * 8), kb = *(const LAS f32x4*)(KK + sr * 132 + ck * 8 + 4);
            const f32x4 ba = *(const LAS f32x4*)(Bf + sr * 132 + ck * 8), bb = *(const LAS f32x4*)(Bf + sr * 132 + ck * 8 + 4);
            const f32x4 ea = *(const LAS f32x4*)(Bf + 63 * 132 + ck * 8), eb = *(const LAS f32x4*)(Bf + 63 * 132 + ck * 8 + 4);
            u32x4 o; o.x = pk2(ka[0] * __expf(ea[0] - ba[0]), ka[1] * __expf(ea[1] - ba[1])); o.y = pk2(ka[2] * __expf(ea[2] - ba[2]), ka[3] * __expf(ea[3] - ba[3]));
            o.z = pk2(kb[0] * __expf(eb[0] - bb[0]), kb[1] * __expf(eb[1] - bb[1])); o.w = pk2(kb[2] * __expf(eb[2] - bb[2]), kb[3] * __expf(eb[3] - bb[3]));
            *(LAS u32x4*)(KD + sr * 136 + ck * 8) = o; }
        __syncthreads();
        f32x4 acc[8];
#pragma unroll
        for (int n = 0; n < 8; ++n) acc[n] = (f32x4){0.f, 0.f, 0.f, 0.f};
#pragma unroll
        for (int ks = 0; ks < 2; ++ks) {
            const bf16x8 afr = tr_frag(VS, 136, 32 * ks, 16 * w, c.lane);
#pragma unroll
            for (int n = 0; n < 8; ++n) { const bf16x8 bfr = tr_frag(KD, 136, 32 * ks, 16 * n, c.lane); acc[n] = MFMA16(bfr, afr, acc[n]); }
        }
#pragma unroll
        for (int n = 0; n < 8; ++n) { u32x2 o; o.x = pk2(acc[n][0], acc[n][1]); o.y = pk2(acc[n][2], acc[n][3]);
            *(u32x2*)(ST + (size_t)it * 16384 + (16 * w + fr) * 128 + 16 * n + 4 * fq) = o; }
        __syncthreads();
    }
}
__device__ __forceinline__ void phase_hg_scan(const Params& p, const Ctx& c) {
    unsigned* ST = (unsigned*)(p.ws + WS_HST); const float* BL = (const float*)(p.ws + WS_HGBL);
    for (int i = c.bid * NTHREADS + c.tid; i < 32 * 8192; i += c.G * NTHREADS) {
        const int e2 = i & 8191, bh = i >> 13, k0 = (2 * e2) & 127;
        float r0 = 0.f, r1 = 0.f;
        for (int ch = 0; ch < 32; ++ch) {
            const size_t it = (size_t)(bh * 32 + ch);
            const unsigned loc = ST[it * 8192 + e2];
            ST[it * 8192 + e2] = pk2(r0, r1);
            const float d0 = __expf(BL[it * 128 + k0]), d1 = __expf(BL[it * 128 + k0 + 1]);
            r0 = d0 * r0 + lo_bf(loc); r1 = d1 * r1 + hi_bf(loc);
        }
    }
}
__device__ __forceinline__ void phase_hg_out(const Params& p, const Ctx& c, int l) {
    LAS bf16_t* Qs = (LAS bf16_t*)c.lds;
    LAS bf16_t* Ks = (LAS bf16_t*)(c.lds + 17408);
    LAS float* Bf = (LAS float*)(c.lds + 2 * 17408);
    LAS bf16_t* QB = Qs;
    LAS bf16_t* STs = (LAS bf16_t*)(c.lds + 2 * 17408 + 33792);
    LAS bf16_t* ATT = (LAS bf16_t*)(c.lds + 2 * 17408 + 33792 + 34816);
    LAS bf16_t* VS = (LAS bf16_t*)(c.lds + 2 * 17408 + 33792 + 34816 + 9216);
    LAS bf16_t* QI = (LAS bf16_t*)(c.lds + 2 * 17408 + 33792 + 34816 + 9216 + 17408);
    LAS bf16_t* KKI = (LAS bf16_t*)(c.lds + 2 * 17408 + 33792 + 34816 + 9216 + 17408 + 4352);
    const bf16_t* U = (const bf16_t*)(p.ws + WS_U); const float* lb = (const float*)(p.ws + WS_LB) + l * 512;
    const bf16_t* ST = (const bf16_t*)(p.ws + WS_HST); bf16_t* YC = (bf16_t*)(p.ws + WS_YCAT);
    const float* nw = p.in[I_HNW] + (size_t)l * 512;
    const int fr = c.lane & 15, fq = c.lane >> 4, w = c.wave;
    for (int it = c.bid; it < 1024; it += c.G) {
        const int ch = it & 31, bh = it >> 5, h = bh & 3, b = bh >> 2, tok0 = b * SEQ + ch * 64;
        for (int i = c.tid; i < 64 * 16; i += NTHREADS) { const int sr = i >> 4, ck = i & 15;
            const size_t ro = (size_t)(tok0 + sr) * NU + h * 128 + ck * 8;
            const u32x4 rq = *(const u32x4*)(U + ro + UHQ), rf = *(const u32x4*)(U + ro + UHF);
            *(LAS u32x4*)(VS + sr * 136 + ck * 8) = *(const u32x4*)(U + ro + UHV);
            const f32x4 l0 = *(const f32x4*)(lb + h * 128 + ck * 8), l1 = *(const f32x4*)(lb + h * 128 + ck * 8 + 4);
            f32x4 k0, k1, g0, g1;
            k0[0] = (1.0f - l0[0]) * sigmoidf_(-lo_bf(rf.x)); k0[1] = (1.0f - l0[1]) * sigmoidf_(-hi_bf(rf.x)); k0[2] = (1.0f - l0[2]) * sigmoidf_(-lo_bf(rf.y)); k0[3] = (1.0f - l0[3]) * sigmoidf_(-hi_bf(rf.y));
            k1[0] = (1.0f - l1[0]) * sigmoidf_(-lo_bf(rf.z)); k1[1] = (1.0f - l1[1]) * sigmoidf_(-hi_bf(rf.z)); k1[2] = (1.0f - l1[2]) * sigmoidf_(-lo_bf(rf.w)); k1[3] = (1.0f - l1[3]) * sigmoidf_(-hi_bf(rf.w));
#pragma unroll
            for (int j = 0; j < 4; ++j) { g0[j] = __logf(1.0f - k0[j]); g1[j] = __logf(1.0f - k1[j]); }
            u32x4 ko; ko.x = pk2(k0[0], k0[1]); ko.y = pk2(k0[2], k0[3]); ko.z = pk2(k1[0], k1[1]); ko.w = pk2(k1[2], k1[3]);
            u32x4 qo; qo.x = pk2(siluf_(lo_bf(rq.x)), siluf_(hi_bf(rq.x))); qo.y = pk2(siluf_(lo_bf(rq.y)), siluf_(hi_bf(rq.y))); qo.z = pk2(siluf_(lo_bf(rq.z)), siluf_(hi_bf(rq.z))); qo.w = pk2(siluf_(lo_bf(rq.w)), siluf_(hi_bf(rq.w)));
            *(LAS u32x4*)(Ks + sr * 136 + ck * 8) = ko; *(LAS u32x4*)(Qs + sr * 136 + ck * 8) = qo;
            *(LAS f32x4*)(Bf + sr * 132 + ck * 8) = g0; *(LAS f32x4*)(Bf + sr * 132 + ck * 8 + 4) = g1; }
        for (int i = c.tid; i < 128 * 16; i += NTHREADS) { const int row = i >> 4, ck = i & 15;
            *(LAS u32x4*)(STs + row * 136 + ck * 8) = *(const u32x4*)(ST + (size_t)it * 16384 + row * 128 + ck * 8); }
        __syncthreads();
        { const int kc = c.tid & 127, q4 = c.tid >> 7; float vals[16]; float cum = 0.f;
#pragma unroll
          for (int i = 0; i < 16; ++i) { cum += Bf[(16 * q4 + i) * 132 + kc]; vals[i] = cum; }
          LAS float* QT = (LAS float*)KKI;
          QT[q4 * 128 + kc] = cum;
          __syncthreads();
          float off = 0.f;
#pragma unroll
          for (int j = 0; j < 3; ++j) off += (j < q4) ? QT[j * 128 + kc] : 0.f;
#pragma unroll
          for (int i = 0; i < 16; ++i) Bf[(16 * q4 + i) * 132 + kc] = vals[i] + off; }
        __syncthreads();
        for (int pidx = c.tid; pidx < 1024; pidx += NTHREADS) {
            const int ib = pidx >> 8, tq = (pidx >> 4) & 15, sq = pidx & 15, t = 16 * ib + tq, s2 = 16 * ib + sq; float a = 0.f;
            if (sq <= tq) {
                for (int k = 0; k < 128; k += 4) {
                    const f32x4 bt = *(const LAS f32x4*)(Bf + t * 132 + k), bs = *(const LAS f32x4*)(Bf + s2 * 132 + k);
                    const u32x2 qv = *(const LAS u32x2*)(Qs + t * 136 + k), kv = *(const LAS u32x2*)(Ks + s2 * 136 + k);
                    a += lo_bf(qv.x) * lo_bf(kv.x) * __expf(bt[0] - bs[0]) + hi_bf(qv.x) * hi_bf(kv.x) * __expf(bt[1] - bs[1])
                       + lo_bf(qv.y) * lo_bf(kv.y) * __expf(bt[2] - bs[2]) + hi_bf(qv.y) * hi_bf(kv.y) * __expf(bt[3] - bs[3]);
                }
            }
            ATT[t * 72 + s2] = (bf16_t)f2bf(a);
        }
        for (int i = c.tid; i < 6 * 256; i += NTHREADS) { const int blk = i >> 8, e = i & 255; const int bi = (blk < 3) ? 0 : (blk < 5 ? 1 : 2), bj = (blk < 3) ? blk + 1 : (blk < 5 ? blk - 1 : 3);
            ATT[(16 * bi + (e >> 4)) * 72 + 16 * bj + (e & 15)] = (bf16_t)0; }
        for (int ib = 1; ib < 4; ++ib) {
            const int rref = 16 * ib - 1;
            for (int i = c.tid; i < 16 * 64; i += NTHREADS) { const int tq = i >> 6, kp = i & 63, t = 16 * ib + tq;
                const unsigned q2 = *(const LAS unsigned*)(Qs + t * 136 + 2 * kp);
                *(LAS unsigned*)(QI + tq * 136 + 2 * kp) = pk2(lo_bf(q2) * __expf(Bf[t * 132 + 2 * kp] - Bf[rref * 132 + 2 * kp]), hi_bf(q2) * __expf(Bf[t * 132 + 2 * kp + 1] - Bf[rref * 132 + 2 * kp + 1])); }
            for (int i = c.tid; i < 16 * ib * 64; i += NTHREADS) { const int s2 = i >> 6, kp = i & 63;
                const unsigned k2 = *(const LAS unsigned*)(Ks + s2 * 136 + 2 * kp);
                *(LAS unsigned*)(KKI + s2 * 136 + 2 * kp) = pk2(lo_bf(k2) * __expf(Bf[rref * 132 + 2 * kp] - Bf[s2 * 132 + 2 * kp]), hi_bf(k2) * __expf(Bf[rref * 132 + 2 * kp + 1] - Bf[s2 * 132 + 2 * kp + 1])); }
            __syncthreads();
            if (w < ib) {
                f32x4 a4 = (f32x4){0.f, 0.f, 0.f, 0.f};
#pragma unroll
                for (int ks = 0; ks < 4; ++ks) { const bf16x8 afr = *(const LAS bf16x8*)(QI + fr * 136 + ks * 32 + 8 * fq), bfr = *(const LAS bf16x8*)(KKI + (16 * w + fr) * 136 + ks * 32 + 8 * fq); a4 = MFMA16(afr, bfr, a4); }
#pragma unroll
                for (int r = 0; r < 4; ++r) ATT[(16 * ib + 4 * fq + r) * 72 + 16 * w + fr] = (bf16_t)f2bf(a4[r]);
            }
            __syncthreads();
        }
        for (int i = c.tid; i < 64 * 64; i += NTHREADS) { const int t = i >> 6, kp = i & 63;
            const unsigned q2 = *(const LAS unsigned*)(Qs + t * 136 + 2 * kp);
            *(LAS unsigned*)(Qs + t * 136 + 2 * kp) = pk2(lo_bf(q2) * __expf(Bf[t * 132 + 2 * kp]), hi_bf(q2) * __expf(Bf[t * 132 + 2 * kp + 1])); }
        __syncthreads();
        f32x4 acc[4];
#pragma unroll
        for (int m = 0; m < 4; ++m) acc[m] = (f32x4){0.f, 0.f, 0.f, 0.f};
#pragma unroll
        for (int ks = 0; ks < 4; ++ks) {
            const bf16x8 bfr = *(const LAS bf16x8*)(STs + (16 * w + fr) * 136 + ks * 32 + 8 * fq);
#pragma unroll
            for (int m = 0; m < 4; ++m) { const bf16x8 afr = *(const LAS bf16x8*)(QB + (16 * m + fr) * 136 + ks * 32 + 8 * fq); acc[m] = MFMA16(afr, bfr, acc[m]); }
        }
#pragma unroll
        for (int ks = 0; ks < 2; ++ks) {
            const bf16x8 bfr = tr_frag(VS, 136, 32 * ks, 16 * w, c.lane);
#pragma unroll
            for (int m = 0; m < 4; ++m) { const bf16x8 afr = *(const LAS bf16x8*)(ATT + (16 * m + fr) * 72 + ks * 32 + 8 * fq); acc[m] = MFMA16(afr, bfr, acc[m]); }
        }
#pragma unroll
        for (int m = 0; m < 4; ++m)
#pragma unroll
            for (int r = 0; r < 4; ++r) Bf[(16 * m + 4 * fq + r) * 132 + 16 * w + fr] = acc[m][r];
        __syncthreads();
        {
            const int t = c.tid >> 3, part = c.tid & 7;
            f32x4 o4[4]; float ss = 0.f;
#pragma unroll
            for (int i = 0; i < 4; ++i) { o4[i] = *(const LAS f32x4*)(Bf + t * 132 + part * 16 + 4 * i); ss += (o4[i][0] * o4[i][0] + o4[i][1] * o4[i][1]) + (o4[i][2] * o4[i][2] + o4[i][3] * o4[i][3]); }
            const u32x4 g0 = *(const u32x4*)(U + (size_t)(tok0 + t) * NU + UHG + h * 128 + part * 16), g1 = *(const u32x4*)(U + (size_t)(tok0 + t) * NU + UHG + h * 128 + part * 16 + 8);
            ss += shfl_xor_l(ss, 1, c.lane); ss += shfl_xor_l(ss, 2, c.lane); ss += shfl_xor_l(ss, 4, c.lane);
            const float rstd = rsqf_(ss * (1.0f / 128.0f) + EPS);
            const float* nwp = nw + h * 128 + part * 16;
            const f32x4 n0 = *(const f32x4*)(nwp), n1 = *(const f32x4*)(nwp + 4), n2 = *(const f32x4*)(nwp + 8), n3 = *(const f32x4*)(nwp + 12);
            u32x4 r0, r1;
            r0.x = pk2(o4[0][0] * rstd * n0[0] * siluf_(lo_bf(g0.x)), o4[0][1] * rstd * n0[1] * siluf_(hi_bf(g0.x))); r0.y = pk2(o4[0][2] * rstd * n0[2] * siluf_(lo_bf(g0.y)), o4[0][3] * rstd * n0[3] * siluf_(hi_bf(g0.y)));
            r0.z = pk2(o4[1][0] * rstd * n1[0] * siluf_(lo_bf(g0.z)), o4[1][1] * rstd * n1[1] * siluf_(hi_bf(g0.z))); r0.w = pk2(o4[1][2] * rstd * n1[2] * siluf_(lo_bf(g0.w)), o4[1][3] * rstd * n1[3] * siluf_(hi_bf(g0.w)));
            r1.x = pk2(o4[2][0] * rstd * n2[0] * siluf_(lo_bf(g1.x)), o4[2][1] * rstd * n2[1] * siluf_(hi_bf(g1.x))); r1.y = pk2(o4[2][2] * rstd * n2[2] * siluf_(lo_bf(g1.y)), o4[2][3] * rstd * n2[3] * siluf_(hi_bf(g1.y)));
            r1.z = pk2(o4[3][0] * rstd * n3[0] * siluf_(lo_bf(g1.z)), o4[3][1] * rstd * n3[1] * siluf_(hi_bf(g1.z))); r1.w = pk2(o4[3][2] * rstd * n3[2] * siluf_(lo_bf(g1.w)), o4[3][3] * rstd * n3[3] * siluf_(hi_bf(g1.w)));
            bf16_t* yo = YC + (size_t)(tok0 + t) * 2048 + 1024 + h * 128 + part * 16;
            *(u32x4*)yo = r0; *(u32x4*)(yo + 8) = r1;
        }
        __syncthreads();
    }
}

__device__ __forceinline__ void phase_lru1(const Params& p, const Ctx& c, int l) {
    LAS unsigned char* wl = c.lds + c.wave * 12288;
    LAS bf16_t* XB = (LAS bf16_t*)wl;
    LAS float* As = (LAS float*)(wl + 2304);
    LAS float* Us = (LAS float*)(wl + 2304 + 4096);
    const bf16_t* U = (const bf16_t*)(p.ws + WS_U); bf16_t* LA = (bf16_t*)(p.ws + WS_LA); bf16_t* LH = (bf16_t*)(p.ws + WS_LH);
    const bf16_t* LW = (const bf16_t*)(p.ws + WS_LRUW) + (size_t)l * 2 * 8 * 4096;
    const int fr = c.lane & 15, fq = c.lane >> 4, g = c.wave, chn = g * 64 + c.lane;
    const float cw0 = p.in[I_LCW][(size_t)l * 2048 + chn], cw1 = p.in[I_LCW][(size_t)l * 2048 + 512 + chn], cw2 = p.in[I_LCW][(size_t)l * 2048 + 1024 + chn], cw3 = p.in[I_LCW][(size_t)l * 2048 + 1536 + chn];
    const float cbias = p.in[I_LCB][l * 512 + chn];
    bf16x8 wfa[4][2], wfx[4][2];
#pragma unroll
    for (int n = 0; n < 4; ++n)
#pragma unroll
        for (int ks = 0; ks < 2; ++ks) { wfa[n][ks] = *(const bf16x8*)(LW + (size_t)(0 * 8 + g) * 4096 + (16 * n + fr) * 64 + ks * 32 + 8 * fq);
                                         wfx[n][ks] = *(const bf16x8*)(LW + (size_t)(1 * 8 + g) * 4096 + (16 * n + fr) * 64 + ks * 32 + 8 * fq); }
    float bav[4], bxv[4], spl[4];
#pragma unroll
    for (int n = 0; n < 4; ++n) { const int j = g * 64 + 16 * n + fr; bav[n] = p.in[I_LBA][l * 512 + j]; bxv[n] = p.in[I_LBX][l * 512 + j]; spl[n] = softplusf_(-p.in[I_LLAM][l * 512 + j]); }
    for (int it = c.bid; it < 256; it += c.G) {
        const int seg = it & 31, tok0 = (it >> 5) * SEQ + seg * 64;
        float x0 = 0.f, x1 = 0.f, x2 = 0.f;
        if (seg > 0) { x0 = bf2f(U[(size_t)(tok0 - 3) * NU + ULX + chn]); x1 = bf2f(U[(size_t)(tok0 - 2) * NU + ULX + chn]); x2 = bf2f(U[(size_t)(tok0 - 1) * NU + ULX + chn]); }
        float hrun = 0.f, arun = 1.f;
        for (int st = 0; st < 4; ++st) {
            const int t0 = tok0 + st * 16;
#pragma unroll
            for (int tt = 0; tt < 16; ++tt) { const float xr = bf2f(U[(size_t)(t0 + tt) * NU + ULX + chn]);
                const float xb = cbias + cw0 * x0 + cw1 * x1 + cw2 * x2 + cw3 * xr; x0 = x1; x1 = x2; x2 = xr;
                XB[tt * 72 + c.lane] = (bf16_t)f2bf(xb); }
            LDS_WAIT();
            f32x4 ar[4], ai[4];
#pragma unroll
            for (int n = 0; n < 4; ++n) { ar[n] = (f32x4){0.f, 0.f, 0.f, 0.f}; ai[n] = (f32x4){0.f, 0.f, 0.f, 0.f}; }
#pragma unroll
            for (int ks = 0; ks < 2; ++ks) { const bf16x8 afr = *(const LAS bf16x8*)(XB + fr * 72 + ks * 32 + 8 * fq);
#pragma unroll
                for (int n = 0; n < 4; ++n) { ar[n] = MFMA16(afr, wfa[n][ks], ar[n]); ai[n] = MFMA16(afr, wfx[n][ks], ai[n]); } }
#pragma unroll
            for (int n = 0; n < 4; ++n)
#pragma unroll
                for (int r = 0; r < 4; ++r) { const int t = 4 * fq + r, j = 16 * n + fr;
                    const float rg = sigmoidf_(ar[n][r] + bav[n]), ig = sigmoidf_(ai[n][r] + bxv[n]);
                    const float la = -8.0f * rg * spl[n], a = __expf(la), mult = sqrtf(fmaxf(fmaf(-a, a, 1.0f), 0.f));
                    As[t * 64 + j] = a; Us[t * 64 + j] = mult * ig * bf2f(XB[t * 72 + j]); }
            LDS_WAIT();
#pragma unroll
            for (int tt = 0; tt < 16; ++tt) { const float a = As[tt * 64 + c.lane], uu = Us[tt * 64 + c.lane];
                hrun = a * hrun + uu; arun = a * arun;
                LA[(size_t)(t0 + tt) * 512 + chn] = (bf16_t)f2bf(arun); LH[(size_t)(t0 + tt) * 512 + chn] = (bf16_t)f2bf(hrun); }
            LDS_WAIT();
        }
    }
}
__device__ __forceinline__ void phase_lru2(const Params& p, const Ctx& c, int l) {
    LAS float* YS = (LAS float*)c.lds;
    LAS float* RS = (LAS float*)(c.lds + 64 * 516 * 4);
    const bf16_t* U = (const bf16_t*)(p.ws + WS_U); const bf16_t* LA = (const bf16_t*)(p.ws + WS_LA); const bf16_t* LH = (const bf16_t*)(p.ws + WS_LH);
    bf16_t* YC = (bf16_t*)(p.ws + WS_YCAT);
    const int g = c.wave, chn = g * 64 + c.lane;
    const float nwv = p.in[I_LNW][l * 512 + chn];
    for (int it = c.bid; it < 256; it += c.G) {
        const int seg = it & 31, b = it >> 5, tok0 = b * SEQ + seg * 64;
        float hin = 0.f;
        for (int s2 = 0; s2 < seg; ++s2) { const size_t row = (size_t)(b * SEQ + s2 * 64 + 63); hin = bf2f(LH[row * 512 + chn]) + bf2f(LA[row * 512 + chn]) * hin; }
#pragma unroll 8
        for (int tt = 0; tt < 64; ++tt) { const size_t tok = (size_t)(tok0 + tt);
            const float hh = bf2f(LH[tok * 512 + chn]) + bf2f(LA[tok * 512 + chn]) * hin;
            YS[tt * 516 + chn] = hh * gelu_tanhf_(bf2f(U[tok * NU + ULG + chn])); }
        __syncthreads();
        {
            const int t = c.tid >> 3, part = c.tid & 7; float ss = 0.f;
#pragma unroll
            for (int i = 0; i < 16; ++i) { const f32x4 v = *(const LAS f32x4*)(YS + t * 516 + part * 64 + 4 * i); ss += (v[0] * v[0] + v[1] * v[1]) + (v[2] * v[2] + v[3] * v[3]); }
            ss += shfl_xor_l(ss, 1, c.lane); ss += shfl_xor_l(ss, 2, c.lane); ss += shfl_xor_l(ss, 4, c.lane);
            if (part == 0) RS[t] = rsqf_(ss * (1.0f / 512.0f) + EPS);
        }
        __syncthreads();
#pragma unroll 8
        for (int tt = 0; tt < 64; ++tt) YC[(size_t)(tok0 + tt) * 2048 + 1536 + chn] = (bf16_t)f2bf(YS[tt * 516 + chn] * RS[tt] * nwv);
        __syncthreads();
    }
}

__device__ __forceinline__ void phase_norm_router(const Params& p, const Ctx& c, int l, const float* xin) {
    constexpr int HSTR = 1028;
    LAS float* HS = (LAS float*)c.lds;
    LAS float* PL = (LAS float*)(c.lds + 16 * HSTR * 4);
    LAS float* LG = (LAS float*)(c.lds + 16 * HSTR * 4 + 32768);
    const float* mod = (const float*)(p.ws + WS_MOD) + (size_t)l * 8 * NMOD;
    const float* nw = p.in[I_NFFN] + (size_t)l * DM;
    const float* WT = (const float*)(p.ws + WS_WRT) + (size_t)l * 64 * 1024;
    const float rbias = p.in[I_RB][l * NEXP + c.lane];
    bf16_t* H = (bf16_t*)(p.ws + WS_H);
    unsigned long long* selm = (unsigned long long*)(p.ws + WS_SELM); float* rw = (float*)(p.ws + WS_RW);
    const int fr = c.lane & 15, fq = c.lane >> 4, w = c.wave;
    int* cnt = (int*)(p.ws + WS_CNT);
    f32x4 bw[8][4];
#pragma unroll
    for (int j = 0; j < 8; ++j)
#pragma unroll
        for (int n = 0; n < 4; ++n) bw[j][n] = *(const f32x4*)(WT + (size_t)(16 * n + fr) * 1024 + 128 * w + 16 * j + 4 * fq);
    int ecount = 0;
    f32x4 xn[2][4];
    if (c.bid < NTOK / 16) {
#pragma unroll
        for (int q = 0; q < 2; ++q)
#pragma unroll
            for (int j = 0; j < 4; ++j) xn[q][j] = ((const f32x4*)(xin + (size_t)(c.bid * 16 + 2 * w + q) * DM) + c.lane)[64 * j];
    }
    for (int t16 = c.bid; t16 < NTOK / 16; t16 += c.G) {
        const int tokb = t16 * 16, b = tokb >> 11;
        f32x4 pa[4], pb[4];
#pragma unroll
        for (int j = 0; j < 4; ++j) { const int col = 256 * j + 4 * c.lane;
            const f32x4 w4 = *(const f32x4*)(nw + col), sc = *(const f32x4*)(mod + (size_t)b * NMOD + 4096 + col); pb[j] = *(const f32x4*)(mod + (size_t)b * NMOD + 3072 + col); pa[j] = w4 * (sc + 1.0f); }
#pragma unroll
        for (int q = 0; q < 2; ++q) {
            const int tl = 2 * w + q, tok = tokb + tl;
            f32x4 v[4]; float ss = 0.f;
#pragma unroll
            for (int j = 0; j < 4; ++j) { v[j] = xn[q][j]; ss += (v[j][0] * v[j][0] + v[j][1] * v[j][1]) + (v[j][2] * v[j][2] + v[j][3] * v[j][3]); }
            const float rstd = rsqf_(wave_sum(ss, c.lane) * (1.0f / DM) + EPS);
#pragma unroll
            for (int j = 0; j < 4; ++j) {
                const int col = 256 * j + 4 * c.lane;
                const f32x4 h = (v[j] * rstd) * pa[j] + pb[j];
                u32x2 o; o.x = pk2(h[0], h[1]); o.y = pk2(h[2], h[3]);
                *(u32x2*)(H + (size_t)tok * DM + col) = o;
                *(LAS f32x4*)(HS + tl * HSTR + col) = h;
            }
        }
        if (t16 + c.G < NTOK / 16) {
#pragma unroll
            for (int q = 0; q < 2; ++q)
#pragma unroll
                for (int j = 0; j < 4; ++j) xn[q][j] = ((const f32x4*)(xin + (size_t)((t16 + c.G) * 16 + 2 * w + q) * DM) + c.lane)[64 * j];
        }
        __syncthreads();
        {
            f32x4 acc[4];
#pragma unroll
            for (int n = 0; n < 4; ++n) acc[n] = (f32x4){0.f, 0.f, 0.f, 0.f};
#pragma unroll
            for (int j = 0; j < 8; ++j) {
                const int kk = 128 * w + 16 * j + 4 * fq;
                const f32x4 a4 = *(const LAS f32x4*)(HS + fr * HSTR + kk);
#pragma unroll
                for (int i = 0; i < 4; ++i)
#pragma unroll
                    for (int n = 0; n < 4; ++n) acc[n] = __builtin_amdgcn_mfma_f32_16x16x4f32(a4[i], bw[j][n][i], acc[n], 0, 0, 0);
            }
#pragma unroll
            for (int n = 0; n < 4; ++n)
#pragma unroll
                for (int r = 0; r < 4; ++r) PL[(w * 16 + 4 * fq + r) * 64 + 16 * n + fr] = acc[n][r];
        }
        __syncthreads();
        for (int i = c.tid; i < 1024; i += NTHREADS) { float s2 = 0.f;
#pragma unroll
            for (int ww = 0; ww < 8; ++ww) s2 += PL[ww * 1024 + i];
            LG[i] = s2; }
        __syncthreads();
#pragma unroll
        for (int q = 0; q < 2; ++q) {
            const int tl = 2 * w + q, tok = tokb + tl;
            const float s = sigmoidf_(LG[tl * 64 + c.lane]), v = s + rbias;
            float m1 = v;
            m1 = fmaxf(m1, shfl_xor_l(m1, 1, c.lane)); m1 = fmaxf(m1, shfl_xor_l(m1, 2, c.lane)); m1 = fmaxf(m1, shfl_xor_l(m1, 4, c.lane));
            const unsigned long long eq = __ballot(v == m1);
            const int gbase = c.lane & ~7;
            const unsigned gm = (unsigned)((eq >> gbase) & 0xffull);
            const int first = gbase + __builtin_ctz(gm);
            float m2 = (c.lane == first) ? -3.0e38f : v;
            m2 = fmaxf(m2, shfl_xor_l(m2, 1, c.lane)); m2 = fmaxf(m2, shfl_xor_l(m2, 2, c.lane)); m2 = fmaxf(m2, shfl_xor_l(m2, 4, c.lane));
            const float gs = m1 + m2;
            const int mygrp = c.lane >> 3; int grank = 0;
#pragma unroll
            for (int g2 = 0; g2 < 8; ++g2) { const float o = rdlane_f(gs, g2 * 8); grank += (o > gs || (o == gs && g2 < mygrp)) ? 1 : 0; }
            const float vm = (grank < 4) ? v : -1.0e4f;
            int erank = 0;
            for (int e2 = 0; e2 < 64; ++e2) { const float o = rdlane_f(vm, e2); erank += (int)(o > vm) + (int)((o == vm) & (e2 < c.lane)); }
            const bool sel = erank < TOPK;
            const unsigned long long mask = __ballot(sel);
            const float wsum = wave_sum(sel ? s : 0.f, c.lane);
            if (sel) { const int kk = __builtin_popcountll(mask & ((1ull << c.lane) - 1ull)); rw[(size_t)tok * 8 + kk] = s * rcpf_(wsum) * 2.5f; }
            if (c.lane == 0) selm[tok] = mask;
            ecount += sel ? 1 : 0;
        }
        __syncthreads();
    }
    { LAS int* CW = (LAS int*)c.lds; CW[w * 64 + c.lane] = ecount; __syncthreads();
      if (w == 0) { int tot = 0;
#pragma unroll
          for (int ww = 0; ww < 8; ++ww) tot += CW[ww * 64 + c.lane];
          cnt[c.bid * 64 + c.lane] = tot; }
      __syncthreads(); }
}
__device__ __forceinline__ void phase_route_assign(const Params& p, const Ctx& c) {
    const unsigned long long* selm = (const unsigned long long*)(p.ws + WS_SELM); const int* cnt = (const int*)(p.ws + WS_CNT);
    int* slot_tok = (int*)(p.ws + WS_SLOTTOK); int* slot_of = (int*)(p.ws + WS_SLOTOF); int* rinfo = (int*)(p.ws + WS_RINFO);
    const int gw = c.bid * NWAVES + c.wave, NGW = c.G * NWAVES;
    for (int ch = gw; ch < c.G; ch += NGW) {
        int total = 0, before = 0;
        for (int j = 0; j < c.G; ++j) { const int v = cnt[j * 64 + c.lane]; total += v; before += (j < ch) ? v : 0; }
        const int pad = (total + 255) & ~255;
        int incl = pad;
#pragma unroll
        for (int o = 1; o < 64; o <<= 1) { const int t = shfl_up_l(incl, o, c.lane); if (c.lane >= o) incl += t; }
        const int pstart = incl - pad;
        int run = pstart + before;
        for (int t16 = ch; t16 < NTOK / 16; t16 += c.G) {
            const unsigned long long mine = (c.lane < 16) ? selm[t16 * 16 + c.lane] : 0ull;
            for (int i = 0; i < 16; ++i) {
                const unsigned long long m = rdlane_u64(mine, i); const int tok = t16 * 16 + i;
                if ((m >> c.lane) & 1ull) { const int kk = __builtin_popcountll(m & ((1ull << c.lane) - 1ull)); slot_tok[run] = tok; slot_of[tok * 8 + kk] = run; ++run; }
            }
        }
        if (ch == 0) {
            for (int s2 = pstart + total; s2 < pstart + pad; ++s2) slot_tok[s2] = -1;
            for (int bk = pstart >> 8; bk < (pstart + pad) >> 8; ++bk) rinfo[64 + bk] = c.lane;
            if (c.lane == 63) rinfo[0] = incl >> 8;
        }
    }
}
__device__ __forceinline__ void phase_combine(const Params& p, const Ctx& c, int l) {
    const float* gate = (const float*)(p.ws + WS_MOD) + (size_t)l * 8 * NMOD + 5120;
    const unsigned char* Y = (const unsigned char*)(p.ws + WS_Y); const unsigned char* YS = (const unsigned char*)(p.ws + WS_H); const int* slot_of = (const int*)(p.ws + WS_SLOTOF); const float* rw = (const float*)(p.ws + WS_RW);
    const float* fw = p.in[I_FNW];
    const int gw = c.bid * NWAVES + c.wave, NGW = c.G * NWAVES;
    for (int tok = gw; tok < NTOK; tok += NGW) {
        const int b = tok >> 11;
        f32x4 acc[4], gvv[4], xv0[4];
        f32x4* xr = (f32x4*)(p.out + (size_t)tok * DM) + c.lane;
#pragma unroll
        for (int j = 0; j < 4; ++j) { acc[j] = (f32x4){0.f, 0.f, 0.f, 0.f}; gvv[j] = *(const f32x4*)(gate + (size_t)b * NMOD + 256 * j + 4 * c.lane); xv0[j] = xr[64 * j]; }
#pragma unroll
        for (int k = 0; k < 8; ++k) { const int sl = slot_of[tok * 8 + k]; const float wk = rw[tok * 8 + k] * Y8_INV;
#pragma unroll
            for (int j = 0; j < 4; ++j) { const int yw = (int)*(const unsigned*)(Y + (size_t)sl * DM + 256 * j + 4 * c.lane);
                const f32x2 y01 = __builtin_amdgcn_cvt_pk_f32_fp8(yw, false), y23 = __builtin_amdgcn_cvt_pk_f32_fp8(yw, true);
                acc[j][0] += wk * y01[0]; acc[j][1] += wk * y01[1]; acc[j][2] += wk * y23[0]; acc[j][3] += wk * y23[1]; } }
#pragma unroll
        for (int j = 0; j < 4; ++j) { const int yw = (int)*(const unsigned*)(YS + (size_t)tok * DM + 256 * j + 4 * c.lane);
            const f32x2 y01 = __builtin_amdgcn_cvt_pk_f32_fp8(yw, false), y23 = __builtin_amdgcn_cvt_pk_f32_fp8(yw, true);
            acc[j][0] += Y8_INV * y01[0]; acc[j][1] += Y8_INV * y01[1]; acc[j][2] += Y8_INV * y23[0]; acc[j][3] += Y8_INV * y23[1]; }
        f32x4 v[4]; float ss = 0.f;
#pragma unroll
        for (int j = 0; j < 4; ++j) { v[j] = xv0[j] + gvv[j] * acc[j];
            ss += (v[j][0] * v[j][0] + v[j][1] * v[j][1]) + (v[j][2] * v[j][2] + v[j][3] * v[j][3]); }
        if (l == NLAYER - 1) {
            const float rstd = rsqf_(wave_sum(ss, c.lane) * (1.0f / DM) + EPS);
#pragma unroll
            for (int j = 0; j < 4; ++j) { const f32x4 w4 = *(const f32x4*)(fw + 256 * j + 4 * c.lane); xr[64 * j] = v[j] * rstd * w4; }
        } else {
#pragma unroll
            for (int j = 0; j < 4; ++j) xr[64 * j] = v[j];
        }
    }
}


#define XB_TMO      128
#define XB_XCNT(j)  (256  + 64 * (j))
#define XB_XSUB(j)  (1280 + 64 * (j))
#define XB_XGEN(j)  (2304 + 64 * (j))
#define XB_TOP      3328
#define XB_TOPGEN   3392
#define XCD_BAR_WORDS 3456
#define XB_SPIN_CAP (1u << 18)
constexpr int LDS_XBST = LDS_PTAB + 320;
__device__ __forceinline__ unsigned xb_ld(unsigned* p)              { return __hip_atomic_load(p, __ATOMIC_RELAXED, __HIP_MEMORY_SCOPE_AGENT); }
__device__ __forceinline__ unsigned xb_add(unsigned* p, unsigned v) { return __hip_atomic_fetch_add(p, v, __ATOMIC_RELAXED, __HIP_MEMORY_SCOPE_AGENT); }
__device__ __forceinline__ unsigned xb_xcc_id() { return (unsigned)__builtin_amdgcn_s_getreg((3 << 11) | 20) & 0xFu; }
#define XB_SPIN(cond, bar) do { unsigned _sp = 0; while (cond) { __builtin_amdgcn_s_sleep(1); \
    if ((++_sp & 255u) == 0u) { if (xb_ld(&(bar)[XB_TMO])) break; if (_sp > XB_SPIN_CAP) { atomicAdd(&(bar)[XB_TMO], 1u); break; } } } } while (0)
__device__ __forceinline__ void xcd_barrier_complete(unsigned* bar, unsigned x, unsigned& nloc, unsigned& nx) {
    const unsigned G = gridDim.x * gridDim.y * gridDim.z;
    unsigned sum, cnt, mine, sp = 0u;
    for (;;) {
        sum = 0u; cnt = 0u; mine = 0u;
#pragma unroll
        for (unsigned j = 0; j < 16; ++j) { const unsigned c = xb_ld(&bar[XB_XCNT(j)]); sum += c; cnt += (c > 0u) ? 1u : 0u; mine = (j == x) ? c : mine; }
        if (sum == G) break;
        __builtin_amdgcn_s_sleep(1);
        if ((++sp & 255u) == 0u) { if (xb_ld(&bar[XB_TMO])) break; if (sp > XB_SPIN_CAP) { atomicAdd(&bar[XB_TMO], 1u); break; } }
    }
    nloc = mine > 0u ? mine : 1u; nx = cnt > 0u ? cnt : 1u;
}
__device__ __forceinline__ void xcd_barrier(unsigned* bar, volatile LAS unsigned* st, bool leader_thread) {
    asm volatile("s_waitcnt vmcnt(0)" ::: "memory");
    __syncthreads();
    if (leader_thread) {
        const unsigned x = xb_xcc_id();
        __builtin_amdgcn_s_waitcnt(0);
        unsigned nloc = st[0], nx = st[1];
        if (nloc == 0u) { xcd_barrier_complete(bar, x, nloc, nx); st[0] = nloc; st[1] = nx; }
        const unsigned old = xb_add(&bar[XB_XSUB(x)], 1u);
        const unsigned gen = old / nloc;
        if (old + 1u == (gen + 1u) * nloc) {
            __builtin_amdgcn_fence(__ATOMIC_RELEASE, "agent");
            asm volatile("s_waitcnt vmcnt(0)" ::: "memory");
            const unsigned og = xb_add(&bar[XB_TOP], 1u);
            const unsigned tg = og / nx;
            if (og + 1u == (tg + 1u) * nx) xb_add(&bar[XB_TOPGEN], 1u);
            else XB_SPIN(xb_ld(&bar[XB_TOPGEN]) == tg, bar);
            __builtin_amdgcn_fence(__ATOMIC_ACQUIRE, "agent");
            xb_add(&bar[XB_XGEN(x)], 1u);
            asm volatile("s_waitcnt vmcnt(0)" ::: "memory");
        } else {
            XB_SPIN(xb_ld(&bar[XB_XGEN(x)]) == gen, bar);
            __builtin_amdgcn_fence(__ATOMIC_ACQUIRE, "agent");
            asm volatile("s_waitcnt vmcnt(0)" ::: "memory");
        }
    }
    __syncthreads();
}

#ifndef PROBE_ID
#define PROBE_ID 0
#endif
#define RUN(id, stmt) do { stmt; if constexpr (PROBE_ID == (id)) { __syncthreads(); stmt; } } while (0)
constexpr int NQ_PHASE = 14;
__device__ __forceinline__ unsigned long long uni64(unsigned long long v) {
    const unsigned lo = (unsigned)__builtin_amdgcn_readfirstlane((int)(unsigned)v), hi = (unsigned)__builtin_amdgcn_readfirstlane((int)(unsigned)(v >> 32)); return ((unsigned long long)hi << 32) | lo; }
#if MK_MEGA
__device__ __forceinline__ void params_to_lds(const Params& p, LAS unsigned char* lds) {
    LAS unsigned long long* tab = (LAS unsigned long long*)(lds + LDS_PTAB);
#pragma unroll
    for (int i = 0; i < 33; ++i) tab[i] = (unsigned long long)p.in[i];
    tab[33] = (unsigned long long)p.out; tab[34] = (unsigned long long)p.ws;
}
__device__ __forceinline__ Params params_from_lds(LAS unsigned char* lds) {
    const LAS unsigned long long* tab = (const LAS unsigned long long*)(lds + LDS_PTAB);
    Params p;
#pragma unroll
    for (int i = 0; i < 33; ++i) p.in[i] = (const float*)(const __attribute__((address_space(1))) float*)uni64(tab[i]);
    p.out = (float*)(__attribute__((address_space(1))) float*)uni64(tab[33]); p.ws = (unsigned char*)(__attribute__((address_space(1))) unsigned char*)uni64(tab[34]); p.layer = 0; p.pad = 0;
    return p;
}
#endif
template <int Q> __device__ __forceinline__ void run_q(const Params& p_in, const Ctx& c_in, int l) {
    Ctx c = c_in;
    asm volatile("" : "+s"(c.wave), "+s"(c.bid), "+s"(c.G), "+s"(l));
    c.lane = fresh_lane(); c.tid = c.wave * 64 + c.lane;
#if MK_MEGA
    const Params p = params_from_lds(c.lds);
#else
    const Params& p = p_in;
#endif
    const float* xin = (l == 0) ? p.in[I_X] : p.out;
    if constexpr (Q == 14) { RUN(1, phase_prep_io(p, c); __syncthreads(); phase_prep_small(p, c)); __syncthreads(); RUN(2, phase_prep_experts(p, c, 0)); }
    if constexpr (Q == 0) { if (l > 0) { RUN(2, phase_prep_experts(p, c, l)); __syncthreads(); } RUN(3, phase_norm_mix(p, c, l, xin)); }
    if constexpr (Q == 1) { pg8::Gemm g{(const bf16_t*)(p.ws + WS_H), (const bf16_t*)(p.ws + WS_WIN) + (size_t)l * NU * DM, DM, 0};
              pg8::DenseOrder S; S.init(NTOK, NU, c.G, c.bid); EpiU E{(bf16_t*)(p.ws + WS_U), NU};
              RUN(4, (pg8::gemm_phase<EpiU, pg8::DenseOrder, pg8::DenseRows, true, true>(c.lds, g, S, E, pg8::DenseRows(), c.wave))); }
    if constexpr (Q == 2) { RUN(5, phase_ssd_conv(p, c, l)); __syncthreads(); RUN(6, phase_hg_state(p, c, l)); __syncthreads(); RUN(7, phase_lru1(p, c, l)); }
    if constexpr (Q == 3) { RUN(8, phase_ssd_state(p, c)); __syncthreads(); phase_hg_scan(p, c); __syncthreads(); RUN(9, phase_lru2(p, c, l)); }
    if constexpr (Q == 4) { phase_ssd_scan(p, c); __syncthreads(); RUN(10, phase_hg_out(p, c, l)); }
    if constexpr (Q == 5) RUN(11, phase_ssd_out(p, c, l));
    if constexpr (Q == 6) RUN(12, phase_ssd_gate(p, c, l));
    if constexpr (Q == 7) { pg8::Gemm g{(const bf16_t*)(p.ws + WS_YCAT), (const bf16_t*)(p.ws + WS_WOUT) + (size_t)l * DM * 2048, 2048, 0};
              pg8::DenseOrder S; S.init(NTOK, DM, c.G, c.bid); EpiOut E{xin, p.out, (const float*)(p.ws + WS_MOD) + (size_t)l * 8 * NMOD + 2048};
              pg8::gemm_phase<EpiOut, pg8::DenseOrder, pg8::DenseRows, false, true>(c.lds, g, S, E, pg8::DenseRows(), c.wave);
              if constexpr (PROBE_ID == 13) { if (l == 0) { __syncthreads(); pg8::gemm_phase<EpiOut, pg8::DenseOrder, pg8::DenseRows, false, true>(c.lds, g, S, E, pg8::DenseRows(), c.wave); } } }
    if constexpr (Q == 8) RUN(14, phase_norm_router(p, c, l, p.out));
    if constexpr (Q == 9) RUN(15, phase_route_assign(p, c));
    if constexpr (Q == 11) { pg8::Gemm g{(const bf16_t*)(p.ws + WS_H), (const bf16_t*)(p.ws + WS_GU), DM, (size_t)512 * DM * 2};
               moe_build_units(c.lds, (const int*)(p.ws + WS_RINFO), 2, c.G, (c.G % 8 == 0) ? (c.bid % 8) * (c.G / 8) + c.bid / 8 : c.bid, c.tid);
               MoeOrder S{(const LAS int*)(c.lds + LDS_UTAB)}; EpiH E{(bf16_t*)(p.ws + WS_HMID)};
               GatherRows AM{(const int*)(p.ws + WS_SLOTTOK), (const int*)(p.ws + WS_RINFO)};
               RUN(16, (pg8::gemm_phase<EpiH, MoeOrder, GatherRows, true, true>(c.lds, g, S, E, AM, c.wave))); }
    if constexpr (Q == 12) { pg8::Gemm g{(const bf16_t*)(p.ws + WS_HMID), (const bf16_t*)(p.ws + WS_DN), 256, (size_t)DM * 256 * 2};
               moe_build_units(c.lds, (const int*)(p.ws + WS_RINFO), 4, c.G, (c.G % 8 == 0) ? (c.bid % 8) * (c.G / 8) + c.bid / 8 : c.bid, c.tid);
               MoeOrder S{(const LAS int*)(c.lds + LDS_UTAB)};
               EpiY E{(unsigned char*)(p.ws + WS_Y), (unsigned char*)(p.ws + WS_H), (const int*)(p.ws + WS_RINFO)};
               RUN(17, (pg8::gemm_phase<EpiY, MoeOrder, pg8::DenseRows, true, true>(c.lds, g, S, E, pg8::DenseRows(), c.wave))); }
    if constexpr (Q == 13) phase_combine(p, c, l);
}

#if MK_MEGA
__global__ void __launch_bounds__(NTHREADS, 2) trunk_kernel(Params p) {
    extern __shared__ __attribute__((aligned(16))) unsigned char lds_raw[];
    Ctx c; c.lds = (LAS unsigned char*)lds_raw; c.tid = 0; c.lane = 0; c.wave = __builtin_amdgcn_readfirstlane(threadIdx.x >> 6); c.G = gridDim.x; c.bid = blockIdx.x;
    cg::grid_group grid = cg::this_grid();
    unsigned* const xbar = (unsigned*)(p.ws + WS_CTL) + 4096;
    if (threadIdx.x == 0) { params_to_lds(p, c.lds); ((LAS unsigned*)(c.lds + LDS_XBST))[0] = 0u; ((LAS unsigned*)(c.lds + LDS_XBST))[1] = 0u; ((LAS unsigned long long*)(c.lds + LDS_PTAB))[35] = (unsigned long long)xbar;
                            (void)xb_add(&xbar[XB_XCNT(xb_xcc_id())], 1u); }
    __syncthreads();
#define GSYNC1() do { unsigned* bar_ = (unsigned*)(__attribute__((address_space(1))) unsigned*)uni64(((const LAS unsigned long long*)(c.lds + LDS_PTAB))[35]); \
        xcd_barrier(bar_, (volatile LAS unsigned*)(c.lds + LDS_XBST), (c.wave == 0) && (fresh_lane() == 0)); } while (0)
#define GSYNC() do { GSYNC1(); if constexpr (PROBE_ID == 18) GSYNC1(); } while (0)
#define LAYER(l) do { \
        run_q<0>(p, c, l); GSYNC(); run_q<1>(p, c, l); GSYNC(); run_q<2>(p, c, l); GSYNC(); run_q<3>(p, c, l); GSYNC(); run_q<4>(p, c, l); GSYNC(); \
        run_q<5>(p, c, l); GSYNC(); run_q<6>(p, c, l); GSYNC(); run_q<7>(p, c, l); GSYNC(); run_q<8>(p, c, l); GSYNC(); run_q<9>(p, c, l); GSYNC(); \
        run_q<11>(p, c, l); GSYNC(); run_q<12>(p, c, l); GSYNC(); run_q<13>(p, c, l); } while (0)
    run_q<14>(p, c, 0); __syncthreads(); grid.sync();
    LAYER(0); GSYNC();
    LAYER(1);
}
#else
template <int Q> __global__ void __launch_bounds__(NTHREADS, 2) phase_kernel(Params p) {
    extern __shared__ __attribute__((aligned(16))) unsigned char lds_raw[];
    Ctx c; c.lds = (LAS unsigned char*)lds_raw; c.tid = 0; c.lane = 0; c.wave = __builtin_amdgcn_readfirstlane(threadIdx.x >> 6); c.G = gridDim.x; c.bid = blockIdx.x;
    run_q<Q>(p, c, p.layer);
}
template <int Q> static void launch_q(const Params& p, int grid, hipStream_t stream) {
    static bool attr = false;
    if (!attr) { (void)hipFuncSetAttribute((const void*)phase_kernel<Q>, hipFuncAttributeMaxDynamicSharedMemorySize, LDS_BYTES); attr = true; }
    hipLaunchKernelGGL(phase_kernel<Q>, dim3(grid), dim3(NTHREADS), LDS_BYTES, stream, p);
}
#endif

extern "C" void kernel_launch(void* const* d_in, const int* in_sizes, int n_in, void* d_out, int out_size, void* d_ws, size_t ws_size, hipStream_t stream) {
    static int grid = 0;
    if (grid == 0) {
        if (n_in != 33 || out_size != NTOK * DM || ws_size < WS_END) { fprintf(stderr, "kernel_launch: unexpected shapes (n_in %d out %d ws %zu)\n", n_in, out_size, ws_size); grid = -1; return; }
        int dev = 0, cus = 0;
        (void)hipGetDevice(&dev); (void)hipDeviceGetAttribute(&cus, hipDeviceAttributeMultiprocessorCount, dev);
        grid = cus > 0 ? cus : 256;
#if MK_MEGA
        int per_cu = 0;
        if (hipFuncSetAttribute((const void*)trunk_kernel, hipFuncAttributeMaxDynamicSharedMemorySize, LDS_BYTES) != hipSuccess) { fprintf(stderr, "kernel_launch: hipFuncSetAttribute failed\n"); grid = -1; return; }
        if (hipOccupancyMaxActiveBlocksPerMultiprocessor(&per_cu, (const void*)trunk_kernel, NTHREADS, LDS_BYTES) != hipSuccess || per_cu < 1) { fprintf(stderr, "kernel_launch: occupancy query says %d blocks/CU\n", per_cu); grid = -1; return; }
        (void)hipGetLastError();
#endif
    }
    if (grid < 0) return;
    (void)hipMemsetAsync((char*)d_ws + WS_CTL, 0, CTL_ZERO_BYTES, stream);
    Params p{};
    for (int i = 0; i < 33; ++i) p.in[i] = (const float*)d_in[i];
    p.out = (float*)d_out; p.ws = (unsigned char*)d_ws;
#if MK_MEGA
    void* args[] = {&p};
    hipError_t e = hipLaunchCooperativeKernel((const void*)trunk_kernel, dim3(grid), dim3(NTHREADS), args, LDS_BYTES, stream);
    if (e != hipSuccess) fprintf(stderr, "cooperative launch failed: %s (grid %d)\n", hipGetErrorString(e), grid);
#else
    p.layer = 0; launch_q<14>(p, grid, stream);
    for (int l = 0; l < NLAYER; ++l) {
        p.layer = l;
        launch_q<0>(p, grid, stream); launch_q<1>(p, grid, stream); launch_q<2>(p, grid, stream); launch_q<3>(p, grid, stream); launch_q<4>(p, grid, stream);
        launch_q<5>(p, grid, stream); launch_q<6>(p, grid, stream); launch_q<7>(p, grid, stream); launch_q<8>(p, grid, stream); launch_q<9>(p, grid, stream);
        launch_q<10>(p, grid, stream); launch_q<11>(p, grid, stream); launch_q<12>(p, grid, stream); launch_q<13>(p, grid, stream);
    }
#endif
}
```

```cpp
#include <hip/hip_runtime.h>
#include <hip/hip_cooperative_groups.h>
#include <cstdio>
#include <cstdint>
namespace cg = cooperative_groups;

#ifndef MK_MEGA
#define MK_MEGA 1
#endif

#define LAS __attribute__((address_space(3)))
typedef unsigned short bf16_t;
typedef short bf16x8 __attribute__((ext_vector_type(8)));
typedef float f32x4 __attribute__((ext_vector_type(4)));
typedef float f32x2 __attribute__((ext_vector_type(2)));
typedef unsigned u32x4 __attribute__((ext_vector_type(4)));
typedef unsigned u32x2 __attribute__((ext_vector_type(2)));

constexpr int NTOK = 16384, DM = 1024, SEQ = 2048, NBATCH = 8, NLAYER = 2;
constexpr int DIN = 5648, NU = 5632;
constexpr int UZ = 0, UXS = 1024, UB = 2048, UC = 2304, UHQ = 2560, UHF = 3072, UHV = 3584, UHG = 4096, ULG = 4608, ULX = 5120;
constexpr int NMOD = 6144;
constexpr float EPS = 1e-6f;
constexpr int NEXP = 64, TOPK = 8;
constexpr int MAXSLOT = 147456;
constexpr int NTHREADS = 512, NWAVES = 8;
constexpr int LDS_BYTES = 160 * 1024;
constexpr int LDS_PTAB = LDS_BYTES - 512;

constexpr size_t MiB = (size_t)1 << 20;
constexpr size_t WS_CTL = 0, CTL_ZERO_BYTES = 1 * MiB;
constexpr size_t WS_MOD = 1 * MiB;
constexpr size_t WS_LB = WS_MOD + 512 * 1024;
constexpr size_t WS_LRUW = WS_LB + 8192;
constexpr size_t WS_DTRAW = 2 * MiB, WS_DT = 3 * MiB, WS_ACUM = 4 * MiB;
constexpr size_t WS_HGBL = 5 * MiB;
constexpr size_t WS_SELM = 5 * MiB + 512 * 1024;
constexpr size_t WS_RW = 6 * MiB;
constexpr size_t WS_SLOTOF = 6 * MiB + 512 * 1024;
constexpr size_t WS_SLOTTOK = 7 * MiB;
constexpr size_t WS_RINFO = 7 * MiB + 768 * 1024;
constexpr size_t WS_CNT = 8 * MiB;
constexpr size_t WS_WRT = 9 * MiB;
constexpr size_t WS_WIN = 12 * MiB;
constexpr size_t WS_WOUT = 34 * MiB;
constexpr size_t WS_GU = 42 * MiB;
constexpr size_t WS_DN = 107 * MiB;
constexpr size_t WS_H = 140 * MiB;
constexpr size_t WS_U = 172 * MiB;
constexpr size_t WS_SST = 348 * MiB;
constexpr size_t WS_HST = 380 * MiB;
constexpr size_t WS_LA = 412 * MiB, WS_LH = 428 * MiB;
constexpr size_t WS_XBC = 444 * MiB;
constexpr size_t WS_YCAT = 492 * MiB;
constexpr size_t WS_HMID = 172 * MiB;
constexpr size_t WS_Y = 252 * MiB;
constexpr size_t WS_YSH = WS_Y + 160 * MiB;
constexpr size_t WS_END = 556 * MiB;

__device__ __forceinline__ float bf2f(bf16_t b) { return __uint_as_float(((unsigned)b) << 16); }
typedef __bf16 bf16x2_hw __attribute__((ext_vector_type(2)));
__device__ __forceinline__ unsigned pk2(float lo, float hi) { f32x2 v = {lo, hi}; bf16x2_hw b = __builtin_convertvector(v, bf16x2_hw); return __builtin_bit_cast(unsigned, b); }
__device__ __forceinline__ unsigned f2bf(float f) { return pk2(f, 0.f) & 0xffffu; }
constexpr float Y8_SCALE = 16.0f, Y8_INV = 1.0f / 16.0f;
__device__ __forceinline__ unsigned pk4_fp8(float a, float b, float c2, float d) { int w = 0; w = __builtin_amdgcn_cvt_pk_fp8_f32(a, b, w, false); w = __builtin_amdgcn_cvt_pk_fp8_f32(c2, d, w, true); return (unsigned)w; }
__device__ __forceinline__ float lo_bf(unsigned w) { return __uint_as_float(w << 16); }
__device__ __forceinline__ float hi_bf(unsigned w) { return __uint_as_float(w & 0xffff0000u); }
__device__ __forceinline__ float rcpf_(float x) { return __builtin_amdgcn_rcpf(x); }
__device__ __forceinline__ float rsqf_(float x) { return __builtin_amdgcn_rsqf(x); }
__device__ __forceinline__ float sigmoidf_(float x) { return rcpf_(1.0f + __expf(-x)); }
__device__ __forceinline__ float siluf_(float x) { return x * rcpf_(1.0f + __expf(-x)); }
__device__ __forceinline__ float softplusf_(float x) { return fmaxf(x, 0.f) + log1pf(__expf(-fabsf(x))); }
__device__ __forceinline__ float gelu_tanhf_(float x) { const float u = 0.7978845608028654f * (x + 0.044715f * x * x * x); const float t = 1.0f - 2.0f * rcpf_(1.0f + __expf(2.0f * u)); return 0.5f * x * (1.0f + t); }
__device__ __forceinline__ float shfl_xor_l(float v, int mask, int lane) { return __builtin_bit_cast(float, __builtin_amdgcn_ds_bpermute((lane ^ mask) << 2, __builtin_bit_cast(int, v))); }
__device__ __forceinline__ int shfl_up_l(int v, int d, int lane) { return __builtin_amdgcn_ds_bpermute((lane - d) << 2, v); }
__device__ __forceinline__ float shfl_up_f(float v, int d, int lane) { return __builtin_bit_cast(float, __builtin_amdgcn_ds_bpermute((lane - d) << 2, __builtin_bit_cast(int, v))); }
__device__ __forceinline__ float rdlane_f(float v, int src) { return __builtin_bit_cast(float, __builtin_amdgcn_readlane(__builtin_bit_cast(int, v), src)); }
__device__ __forceinline__ unsigned long long rdlane_u64(unsigned long long v, int src) {
    const unsigned lo = (unsigned)__builtin_amdgcn_readlane((int)(unsigned)v, src), hi = (unsigned)__builtin_amdgcn_readlane((int)(unsigned)(v >> 32), src); return ((unsigned long long)hi << 32) | lo; }
__device__ __forceinline__ float wave_sum(float v, int lane) {
#pragma unroll
    for (int o = 1; o < 64; o <<= 1) v += shfl_xor_l(v, o, lane);
    return v;
}
#define LDS_WAIT() asm volatile("s_waitcnt lgkmcnt(0)" ::: "memory")
__device__ __forceinline__ int fresh_lane() { unsigned ones = ~0u; asm volatile("" : "+s"(ones)); return (int)__builtin_amdgcn_mbcnt_hi(ones, __builtin_amdgcn_mbcnt_lo(ones, 0u)); }
#define LDS_BARRIER() do { asm volatile("s_waitcnt lgkmcnt(0)" ::: "memory"); __builtin_amdgcn_s_barrier(); asm volatile("" ::: "memory"); } while (0)
#define MFMA16(a, b, c) __builtin_amdgcn_mfma_f32_16x16x32_bf16((a), (b), (c), 0, 0, 0)
typedef short s16x4 __attribute__((ext_vector_type(4)));
__device__ __forceinline__ bf16x8 tr_frag(const LAS bf16_t* img, int ld, int k0, int c0, int lane) {
    const int g = lane >> 4, q = (lane & 15) >> 2, pp = lane & 3;
    const LAS bf16_t* a0 = img + (k0 + 8 * g + q) * ld + c0 + 4 * pp;
    const s16x4 r0 = __builtin_amdgcn_ds_read_tr16_b64_v4i16((LAS s16x4*)a0);
    const s16x4 r1 = __builtin_amdgcn_ds_read_tr16_b64_v4i16((LAS s16x4*)(a0 + 4 * ld));
    return (bf16x8){r0[0], r0[1], r0[2], r0[3], r1[0], r1[1], r1[2], r1[3]};
}

namespace pg8 {
constexpr int BM = 256, BK = 64, HALF = 128, HTB = HALF * BK * 2, STAGE_BYTES = 8 * HTB, NXCD = 8, WGM = 8;
__device__ __forceinline__ int lds_byte(int r, int c) { const int st = (r >> 4) * 2 + (c >> 5), rr = r & 15, cc = c & 31, ob = rr * 64 + cc * 2; return st * 1024 + (ob ^ (((ob >> 9) & 1) << 5)); }
__device__ __forceinline__ void stage_rc(int b, int& R, int& C) { const int st = b / 1024, sb = b % 1024, swz = sb ^ (((sb >> 9) & 1) << 5); R = (st >> 1) * 16 + swz / 64; C = (st & 1) * 32 + (swz % 64) / 2; }
__device__ __forceinline__ int perm32(int rho) { const int n = rho >> 4, i = rho & 15; return 8 * (i >> 2) + 4 * n + (i & 3); }

struct Unit { int pm, pn, e; };
struct Gemm { const bf16_t* A; const bf16_t* Bt; int K; size_t estride; };

struct DenseOrder {
    int nM, nN, nwg, G, c;
    __device__ void init(int M, int N, int G_, int c_) { nM = M / BM; nN = N / BM; nwg = nM * nN; G = G_; c = c_; }
    __device__ bool next(int i, Unit& u) const {
        const long L = (long)i * G + c; if (L >= nwg) return false;
        int wgid = (int)L; { const int q = nwg / NXCD, r = nwg % NXCD, xcd = wgid % NXCD, off = wgid / NXCD; wgid = (xcd < r ? xcd * (q + 1) : r * (q + 1) + (xcd - r) * q) + off; }
        const int nig = WGM * nN, gid = wgid / nig, fm = gid * WGM, gsz = (nM - fm) < WGM ? (nM - fm) : WGM;
        u.pm = fm + ((wgid % nig) % gsz); u.pn = (wgid % nig) / gsz; u.e = 0; return true;
    }
};
struct DenseRows { __device__ __forceinline__ int row(const Unit& u, int r) const { return u.pm * BM + r; } };

template <class Epi, class Sched, class AMap, bool ALIGN_EPI, bool SP2>
__device__ __forceinline__ void gemm_phase(LAS unsigned char* lds, const Gemm g, const Sched& S, const Epi& E, const AMap& AM, int wave_id) {
    const int wid = wave_id, lane = fresh_lane(), tid = wid * 64 + lane, wr = wid >> 2, wc = wid & 3, fr = lane & 15, fq = lane >> 4;
    const int K = g.K, nt = K / BK;
    unsigned voffB0;
    { int R, C; stage_rc(tid * 16, R, C); const int Rb = Epi::PERM ? ((R & ~31) + perm32(R & 31)) : R; voffB0 = (unsigned)(Rb * K + C) * 2u; }
    const size_t p1step = (size_t)64 * K * 2;
    const size_t kstep = (size_t)(BK * 2);
    const size_t hstep = (size_t)HALF * K * 2;
    const size_t tstep = 2 * hstep;
    const unsigned ldsw = (unsigned)wid * 1024u;
    const int aoff = lds_byte(wr * 64 + fr, fq * 8), boff = lds_byte(wc * 32 + fr, fq * 8);
#define PG8_SA(b, h) (((b) * 2 + (h)) * HTB)
#define PG8_SB(b, h) ((4 + (b) * 2 + (h)) * HTB)
#define PG8_STAGE2(bufoff, gbase, v0, v1) do { \
        __builtin_amdgcn_global_load_lds((const unsigned*)((const char*)(gbase) + (v0)), (LAS unsigned*)(lds + (bufoff) + ldsw), 16, 0, 0); \
        __builtin_amdgcn_global_load_lds((const unsigned*)((const char*)(gbase) + (v1)), (LAS unsigned*)(lds + (bufoff) + ldsw + 8192), 16, 0, 0); } while (0)
#define PG8_STAGEB(bufoff, gbase) do { \
        __builtin_amdgcn_global_load_lds((const unsigned*)((const char*)(gbase) + voffB0), (LAS unsigned*)(lds + (bufoff) + ldsw), 16, 0, 0); \
        __builtin_amdgcn_global_load_lds((const unsigned*)((const char*)(gbase) + p1step + voffB0), (LAS unsigned*)(lds + (bufoff) + ldsw + 8192), 16, 0, 0); } while (0)
#define PG8_LDA(dst, b, h) do { _Pragma("unroll") for (int m = 0; m < 4; ++m) _Pragma("unroll") for (int k = 0; k < 2; ++k) dst[m][k] = *(const LAS bf16x8*)(lds + PG8_SA(b, h) + aoff + m * 2048 + k * 1024); } while (0)
#define PG8_LDB(dst, b, h) do { _Pragma("unroll") for (int n = 0; n < 2; ++n) _Pragma("unroll") for (int k = 0; k < 2; ++k) dst[n][k] = *(const LAS bf16x8*)(lds + PG8_SB(b, h) + boff + n * 2048 + k * 1024); } while (0)
#define PG8_MMA(ai, bj, At, Bt) do { __builtin_amdgcn_s_setprio(1); _Pragma("unroll") for (int m = 0; m < 4; ++m) _Pragma("unroll") for (int n = 0; n < 2; ++n) _Pragma("unroll") for (int k = 0; k < 2; ++k) \
        acc[ai][bj][m][n] = __builtin_amdgcn_mfma_f32_16x16x32_bf16(Bt[n][k], At[m][k], acc[ai][bj][m][n], 0, 0, 0); __builtin_amdgcn_s_setprio(0); } while (0)
#define PG8_WAIT_V(n) asm volatile("s_waitcnt vmcnt(" #n ")" ::: "memory")
#define PG8_WAIT_L(n) asm volatile("s_waitcnt lgkmcnt(" #n ")" ::: "memory")
#define PG8_BAR __builtin_amdgcn_s_barrier()
#define PG8_SCHED __builtin_amdgcn_sched_barrier(0)
#define PG8_AOFFS(u, v00, v01, v10, v11) do { int R_, C_; stage_rc(tid * 16, R_, C_); \
        v00 = (unsigned)(AM.row(u, R_) * K + C_) * 2u; v01 = (unsigned)(AM.row(u, R_ + 64) * K + C_) * 2u; \
        v10 = (unsigned)(AM.row(u, HALF + R_) * K + C_) * 2u; v11 = (unsigned)(AM.row(u, HALF + R_ + 64) * K + C_) * 2u; } while (0)
    Unit cur, nxt; int ui = 0;
    if (!S.next(0, cur)) return;
    f32x4 acc[2][2][4][2];
#pragma unroll
    for (int a = 0; a < 2; ++a)
#pragma unroll
        for (int b = 0; b < 2; ++b)
#pragma unroll
            for (int m = 0; m < 4; ++m)
#pragma unroll
                for (int n = 0; n < 2; ++n) acc[a][b][m][n] = (f32x4){0.f, 0.f, 0.f, 0.f};
    bf16x8 At[4][2], B0[2][2], B1[2][2];
    const char* const Abase = (const char*)g.A;
    const char* cB = (const char*)g.Bt + (size_t)cur.e * g.estride + (size_t)cur.pn * tstep;
    unsigned c00, c01, c10, c11, n00, n01, n10, n11;
    PG8_AOFFS(cur, c00, c01, c10, c11);
    n00 = c00; n01 = c01; n10 = c10; n11 = c11;
    if constexpr (SP2) {
        PG8_STAGEB(PG8_SB(0, 0), cB); PG8_STAGEB(PG8_SB(0, 1), cB + hstep); PG8_STAGE2(PG8_SA(0, 0), Abase, c00, c01); PG8_STAGE2(PG8_SA(0, 1), Abase, c10, c11);
        if (wr == 1) PG8_BAR;
        PG8_WAIT_V(2); PG8_BAR;
        PG8_STAGEB(PG8_SB(1, 0), cB + kstep); PG8_STAGE2(PG8_SA(1, 0), Abase + kstep, c00, c01); PG8_STAGEB(PG8_SB(1, 1), cB + hstep + kstep);
        PG8_WAIT_V(6); PG8_BAR;
    } else {
        PG8_STAGEB(PG8_SB(0, 0), cB); PG8_STAGE2(PG8_SA(0, 0), Abase, c00, c01); PG8_STAGEB(PG8_SB(0, 1), cB + hstep); PG8_STAGE2(PG8_SA(0, 1), Abase, c10, c11);
        if (wr == 1) PG8_BAR;
        PG8_WAIT_V(4); PG8_BAR;
        PG8_STAGEB(PG8_SB(1, 0), cB + kstep); PG8_STAGE2(PG8_SA(1, 0), Abase + kstep, c00, c01); PG8_STAGEB(PG8_SB(1, 1), cB + hstep + kstep);
        PG8_WAIT_V(6); PG8_BAR;
    }
    for (;;) {
        const bool has_next = S.next(ui + 1, nxt);
        const char* nB = cB;
        if (has_next) { nB = (const char*)g.Bt + (size_t)nxt.e * g.estride + (size_t)nxt.pn * tstep; PG8_AOFFS(nxt, n00, n01, n10, n11); }
        else { n00 = c00; n01 = c01; n10 = c10; n11 = c11; }
        for (int t = 0; t < nt; t += 2) {
            const bool last = (t == nt - 2);
            const char* a1 = Abase + (size_t)(t + 1) * kstep;
            const char* a2 = last ? Abase : Abase + (size_t)(t + 2) * kstep;
            const char* b2 = last ? nB : cB + (size_t)(t + 2) * kstep;
            const char* a3 = a2 + kstep; const char* b3 = b2 + kstep;
            const unsigned x00 = last ? n00 : c00, x01 = last ? n01 : c01, x10 = last ? n10 : c10, x11 = last ? n11 : c11;
            if constexpr (SP2) {
            PG8_LDB(B0, 0, 0); PG8_LDB(B1, 0, 1); PG8_SCHED; PG8_LDA(At, 0, 0); PG8_STAGE2(PG8_SA(1, 1), a1, c10, c11);
            PG8_WAIT_V(8); PG8_WAIT_L(0); PG8_BAR; PG8_MMA(0, 0, At, B0); PG8_MMA(0, 1, At, B1); PG8_BAR; PG8_SCHED;
            PG8_LDA(At, 0, 1); PG8_STAGEB(PG8_SB(0, 0), b2); PG8_STAGEB(PG8_SB(0, 1), b2 + hstep); PG8_STAGE2(PG8_SA(0, 0), a2, x00, x01);
            PG8_WAIT_V(8); PG8_WAIT_L(0); PG8_BAR; PG8_MMA(1, 0, At, B0); PG8_MMA(1, 1, At, B1); PG8_BAR; PG8_SCHED;
            PG8_LDB(B0, 1, 0); PG8_LDB(B1, 1, 1); PG8_SCHED; PG8_LDA(At, 1, 0); PG8_STAGE2(PG8_SA(0, 1), a2, x10, x11);
            PG8_WAIT_V(8); PG8_WAIT_L(0); PG8_BAR; PG8_MMA(0, 0, At, B0); PG8_MMA(0, 1, At, B1); PG8_BAR; PG8_SCHED;
            PG8_LDA(At, 1, 1); PG8_STAGEB(PG8_SB(1, 0), b3); PG8_STAGEB(PG8_SB(1, 1), b3 + hstep); PG8_STAGE2(PG8_SA(1, 0), a3, x00, x01);
            PG8_WAIT_V(8); PG8_WAIT_L(0); PG8_BAR; PG8_MMA(1, 0, At, B0); PG8_MMA(1, 1, At, B1); PG8_BAR; PG8_SCHED;
            } else {
            PG8_LDB(B0, 0, 0); PG8_SCHED; PG8_LDA(At, 0, 0); PG8_STAGE2(PG8_SA(1, 1), a1, c10, c11);
            PG8_WAIT_L(8); PG8_BAR; PG8_WAIT_L(0); PG8_MMA(0, 0, At, B0); PG8_BAR; PG8_SCHED;
            PG8_LDB(B1, 0, 1); PG8_STAGEB(PG8_SB(0, 0), b2);
            PG8_BAR; PG8_WAIT_L(0); PG8_MMA(0, 1, At, B1); PG8_BAR;
            PG8_LDA(At, 0, 1); PG8_STAGE2(PG8_SA(0, 0), a2, x00, x01);
            PG8_BAR; PG8_WAIT_L(0); PG8_MMA(1, 0, At, B0); PG8_BAR; PG8_SCHED;
            PG8_STAGEB(PG8_SB(0, 1), b2 + hstep);
            PG8_WAIT_V(6); PG8_BAR; PG8_MMA(1, 1, At, B1); PG8_BAR;
            PG8_LDB(B0, 1, 0); PG8_SCHED; PG8_LDA(At, 1, 0); PG8_STAGE2(PG8_SA(0, 1), a2, x10, x11);
            PG8_WAIT_L(8); PG8_BAR; PG8_WAIT_L(0); PG8_MMA(0, 0, At, B0); PG8_BAR; PG8_SCHED;
            PG8_LDB(B1, 1, 1); PG8_STAGEB(PG8_SB(1, 0), b3);
            PG8_BAR; PG8_WAIT_L(0); PG8_MMA(0, 1, At, B1); PG8_BAR;
            PG8_LDA(At, 1, 1); PG8_STAGE2(PG8_SA(1, 0), a3, x00, x01);
            PG8_BAR; PG8_WAIT_L(0); PG8_MMA(1, 0, At, B0); PG8_BAR; PG8_SCHED;
            PG8_STAGEB(PG8_SB(1, 1), b3 + hstep);
            PG8_WAIT_V(6); PG8_BAR; PG8_MMA(1, 1, At, B1); PG8_BAR;
            }
        }
        if constexpr (ALIGN_EPI) { if (wr == 0) PG8_BAR; }
        E(acc, cur, wr, wc);
        if (!has_next) break;
#pragma unroll
        for (int a = 0; a < 2; ++a)
#pragma unroll
            for (int b = 0; b < 2; ++b)
#pragma unroll
                for (int m = 0; m < 4; ++m)
#pragma unroll
                    for (int n = 0; n < 2; ++n) acc[a][b][m][n] = (f32x4){0.f, 0.f, 0.f, 0.f};
        cur = nxt; cB = nB; c00 = n00; c01 = n01; c10 = n10; c11 = n11; ++ui;
        if constexpr (ALIGN_EPI) { if (wr == 1) PG8_BAR; }
    }
    PG8_WAIT_V(0);
    if constexpr (!ALIGN_EPI) { if (wr == 0) PG8_BAR; }
    PG8_BAR;
#undef PG8_SA
#undef PG8_SB
#undef PG8_STAGE2
#undef PG8_STAGEB
#undef PG8_LDA
#undef PG8_LDB
#undef PG8_MMA
#undef PG8_WAIT_V
#undef PG8_WAIT_L
#undef PG8_BAR
#undef PG8_SCHED
#undef PG8_AOFFS
}
}

struct Params {
    const float* in[33];
    float* out;
    unsigned char* ws;
    int layer, pad;
};
enum { I_X = 0, I_C, I_ADAW, I_ADAB, I_NMIX, I_NFFN, I_WIN, I_SCW, I_SCB, I_SDTB, I_SALOG, I_SD, I_SNW, I_HLB, I_HNW, I_LCW, I_LCB, I_LWA, I_LBA, I_LWX, I_LBX, I_LLAM, I_LNW,
       I_WOUT, I_RW, I_RB, I_EG, I_EU, I_ED, I_SG, I_SU, I_SDN, I_FNW };

using pg8::Unit;
struct EpiU {
    static constexpr bool PERM = true;
    bf16_t* O; int ldc;
    __device__ __forceinline__ void operator()(const f32x4 (&acc)[2][2][4][2], const Unit& u, int wr, int wc) const {
        const int lane_ = fresh_lane(), fr = lane_ & 15, fq = lane_ >> 4;
        const int row0 = u.pm * 256 + wr * 64 + fr, col0 = u.pn * 256 + wc * 32 + 8 * fq;
#pragma unroll
        for (int ai = 0; ai < 2; ++ai)
#pragma unroll
            for (int m = 0; m < 4; ++m) { bf16_t* rowp = O + (size_t)(row0 + ai * 128 + m * 16) * ldc + col0;
#pragma unroll
                for (int bj = 0; bj < 2; ++bj) { const f32x4 v0 = acc[ai][bj][m][0], v1 = acc[ai][bj][m][1];
                    u32x4 w; w.x = pk2(v0[0], v0[1]); w.y = pk2(v0[2], v0[3]); w.z = pk2(v1[0], v1[1]); w.w = pk2(v1[2], v1[3]);
                    *(u32x4*)(rowp + bj * 128) = w; } }
    }
};
struct EpiOut {
    static constexpr bool PERM = false;
    const float* xin; float* xout; const float* gate;
    __device__ __forceinline__ void operator()(const f32x4 (&acc)[2][2][4][2], const Unit& u, int wr, int wc) const {
        const int lane_ = fresh_lane(), fr = lane_ & 15, fq = lane_ >> 4;
        const int row0 = u.pm * 256 + wr * 64 + fr, col0 = u.pn * 256 + wc * 32 + 4 * fq, b = u.pm >> 3;
        f32x4 gv[2][2];
#pragma unroll
        for (int bj = 0; bj < 2; ++bj)
#pragma unroll
            for (int n = 0; n < 2; ++n) gv[bj][n] = *(const f32x4*)(gate + (size_t)b * NMOD + col0 + bj * 128 + n * 16);
#pragma unroll
        for (int ai = 0; ai < 2; ++ai)
#pragma unroll
            for (int m = 0; m < 4; ++m) { const size_t off = (size_t)(row0 + ai * 128 + m * 16) * DM + col0;
#pragma unroll
                for (int bj = 0; bj < 2; ++bj)
#pragma unroll
                    for (int n = 0; n < 2; ++n) { const f32x4 xi = *(const f32x4*)(xin + off + bj * 128 + n * 16);
                        *(f32x4*)(xout + off + bj * 128 + n * 16) = xi + gv[bj][n] * acc[ai][bj][m][n]; }
                asm volatile("" ::: "memory"); }
    }
};
struct EpiH {
    static constexpr bool PERM = true;
    bf16_t* Hm;
    __device__ __forceinline__ void operator()(const f32x4 (&acc)[2][2][4][2], const Unit& u, int wr, int wc) const {
        const int lane_ = fresh_lane(), fr = lane_ & 15, fq = lane_ >> 4;
        const int row0 = u.pm * 256 + wr * 64 + fr, col0 = u.pn * 128 + wc * 32 + 8 * fq;
#pragma unroll
        for (int ai = 0; ai < 2; ++ai)
#pragma unroll
            for (int m = 0; m < 4; ++m) { bf16_t* rowp = Hm + (size_t)(row0 + ai * 128 + m * 16) * 256 + col0;
                f32x4 h0, h1;
#pragma unroll
                for (int j = 0; j < 4; ++j) { h0[j] = siluf_(acc[ai][0][m][0][j]) * acc[ai][1][m][0][j]; h1[j] = siluf_(acc[ai][0][m][1][j]) * acc[ai][1][m][1][j]; }
                u32x4 w; w.x = pk2(h0[0], h0[1]); w.y = pk2(h0[2], h0[3]); w.z = pk2(h1[0], h1[1]); w.w = pk2(h1[2], h1[3]);
                *(u32x4*)rowp = w; }
    }
};
struct EpiY {
    static constexpr bool PERM = true;
    unsigned char* Y; unsigned char* Ysh; const int* rinfo;
    __device__ __forceinline__ void operator()(const f32x4 (&acc)[2][2][4][2], const Unit& u, int wr, int wc) const {
        const int lane_ = fresh_lane(), fr = lane_ & 15, fq = lane_ >> 4;
        const int col0 = u.pn * 256 + wc * 32 + 8 * fq;
        unsigned char* base = Y + (size_t)u.pm * 256 * DM;
        if (u.e >= NEXP) base = Ysh + (size_t)(u.pm - rinfo[0]) * 256 * DM;
        base += (size_t)(wr * 64 + fr) * DM + col0;
#pragma unroll
        for (int ai = 0; ai < 2; ++ai)
#pragma unroll
            for (int m = 0; m < 4; ++m) { unsigned char* rowp = base + (size_t)(ai * 128 + m * 16) * DM;
#pragma unroll
                for (int bj = 0; bj < 2; ++bj) { const f32x4 v0 = acc[ai][bj][m][0] * Y8_SCALE, v1 = acc[ai][bj][m][1] * Y8_SCALE;
                    u32x2 w; w.x = pk4_fp8(v0[0], v0[1], v0[2], v0[3]); w.y = pk4_fp8(v1[0], v1[1], v1[2], v1[3]);
                    *(u32x2*)(rowp + bj * 128) = w; } }
    }
};
constexpr int LDS_UTAB = 131072, MAX_UNITS = 24;
__device__ __forceinline__ void moe_build_units(LAS unsigned char* lds, const int* rinfo, int NQ, int G, int cidx, int tid) {
    LAS int* tab = (LAS int*)(lds + LDS_UTAB);
    if (tid < MAX_UNITS) {
        const int nblk = rinfo[0]; const long L = (long)tid * G + cidx;
        int pm = -1, pn = 0, e = 0;
        if (L < (long)(nblk + 64) * NQ) { const int rb = (int)(L / NQ); pm = rb; pn = (int)(L % NQ); e = (rb < nblk) ? rinfo[64 + rb] : NEXP; }
        tab[tid * 4 + 0] = pm; tab[tid * 4 + 1] = pn; tab[tid * 4 + 2] = e; tab[tid * 4 + 3] = 0;
    }
    __syncthreads();
}
struct MoeOrder {
    const LAS int* tab;
    __device__ bool next(int i, Unit& u) const {
        if (i >= MAX_UNITS) return false;
        const int pm = __builtin_amdgcn_readfirstlane(tab[i * 4 + 0]); if (pm < 0) return false;
        u.pm = pm; u.pn = __builtin_amdgcn_readfirstlane(tab[i * 4 + 1]); u.e = __builtin_amdgcn_readfirstlane(tab[i * 4 + 2]); return true;
    }
};
struct GatherRows {
    const int* slot_tok; const int* rinfo;
    __device__ __forceinline__ int row(const Unit& u, int r) const {
        const int nblk = rinfo[0];
        if (u.pm < nblk) { const int t = slot_tok[u.pm * 256 + r]; return t < 0 ? 0 : t; }
        return (u.pm - nblk) * 256 + r;
    }
};

struct Ctx { LAS unsigned char* lds; int tid, lane, wave, G, bid; };

template <class RowMap>
__device__ __forceinline__ void transpose_item(const float* W, int N, int k0, int n0, bf16_t* WT, int ldk, const RowMap& rm, LAS float* scr, int lane) {
    const int nn = n0 + (lane & 31);
#pragma unroll 8
    for (int i = 0; i < 32; ++i) { const int kk = 2 * i + (lane >> 5); scr[kk * 33 + (lane & 31)] = (nn < N) ? W[(size_t)(k0 + kk) * N + nn] : 0.f; }
    LDS_WAIT();
    const int c = lane & 7;
#pragma unroll
    for (int j = 0; j < 4; ++j) { const int n = (lane >> 3) + 8 * j; const LAS float* s = scr + (8 * c) * 33 + n;
        u32x4 o; o.x = pk2(s[0 * 33], s[1 * 33]); o.y = pk2(s[2 * 33], s[3 * 33]); o.z = pk2(s[4 * 33], s[5 * 33]); o.w = pk2(s[6 * 33], s[7 * 33]);
        const int dr = (n0 + n < N) ? rm(n0 + n) : -1;
        if (dr >= 0) *(u32x4*)(WT + (size_t)dr * ldk + k0 + 8 * c) = o; }
    LDS_WAIT();
}
struct RmIdent { __device__ __forceinline__ int operator()(int n) const { return n; } };
struct RmWin { __device__ __forceinline__ int operator()(int n) const { return n < 2560 ? n : (n < 2576 ? -1 : n - 16); } };
struct RmGate { __device__ __forceinline__ int operator()(int n) const { return (n >> 7) * 256 + (n & 127); } };
struct RmUp { __device__ __forceinline__ int operator()(int n) const { return (n >> 7) * 256 + 128 + (n & 127); } };

__device__ __forceinline__ void phase_prep_io(const Params& p, const Ctx& c) {
    LAS float* scr = (LAS float*)(c.lds + c.wave * 16384);
    const int gw = c.bid * NWAVES + c.wave, NGW = c.G * NWAVES;
    constexpr int I_IN = 16 * 177, I_OUT = 32 * 32, PER_L = I_IN + I_OUT;
    for (int it = gw; it < NLAYER * PER_L; it += NGW) {
        const int l = it / PER_L; int r = it % PER_L;
        if (r < I_IN) { const int kb = r / 177, nb = r % 177;
            transpose_item(p.in[I_WIN] + (size_t)l * DM * DIN, DIN, kb * 64, nb * 32, (bf16_t*)(p.ws + WS_WIN) + (size_t)l * NU * DM, DM, RmWin(), scr, c.lane); }
        else { r -= I_IN; const int kb = r / 32, nb = r % 32;
            transpose_item(p.in[I_WOUT] + (size_t)l * 2048 * DM, DM, kb * 64, nb * 32, (bf16_t*)(p.ws + WS_WOUT) + (size_t)l * DM * 2048, 2048, RmIdent(), scr, c.lane); }
    }
}
__device__ __forceinline__ void phase_prep_experts(const Params& p, const Ctx& c, int l) {
    LAS float* scr = (LAS float*)(c.lds + c.wave * 16384);
    const int gw = c.bid * NWAVES + c.wave, NGW = c.G * NWAVES;
    constexpr int PER_E = 3 * 128;
    bf16_t* GU = (bf16_t*)(p.ws + WS_GU); bf16_t* DN = (bf16_t*)(p.ws + WS_DN);
    for (int it = gw; it < 65 * PER_E; it += NGW) {
        const int e = it / PER_E; int r = it % PER_E; const int which = r / 128; r %= 128;
        if (which < 2) {
            const float* src = (e < NEXP) ? p.in[which == 0 ? I_EG : I_EU] + ((size_t)l * NEXP + e) * DM * 256 : p.in[which == 0 ? I_SG : I_SU] + (size_t)l * DM * 256;
            const int kb = r / 8, nb = r % 8;
            if (which == 0) transpose_item(src, 256, kb * 64, nb * 32, GU + (size_t)e * 512 * DM, DM, RmGate(), scr, c.lane);
            else transpose_item(src, 256, kb * 64, nb * 32, GU + (size_t)e * 512 * DM, DM, RmUp(), scr, c.lane);
        } else {
            const float* src = (e < NEXP) ? p.in[I_ED] + ((size_t)l * NEXP + e) * 256 * DM : p.in[I_SDN] + (size_t)l * 256 * DM;
            const int kb = r / 32, nb = r % 32;
            transpose_item(src, DM, kb * 64, nb * 32, DN + (size_t)e * DM * 256, 256, RmIdent(), scr, c.lane);
        }
    }
}
__device__ __forceinline__ void phase_prep_small(const Params& p, const Ctx& c) {
    LAS float* sc = (LAS float*)c.lds;
    LAS float* red = (LAS float*)(c.lds + 32768);
    float* mod = (float*)(p.ws + WS_MOD);
    bool have_sc = false;
    for (int it = c.bid; it < NLAYER * 96; it += c.G) {
        if (!have_sc) { for (int i = c.tid; i < 8 * 1024; i += NTHREADS) sc[i] = siluf_(p.in[I_C][i]); have_sc = true; }
        __syncthreads();
        const int l = it / 96, j0 = (it % 96) * 64, j = c.tid & 63, kg = c.tid >> 6;
        const float* W = p.in[I_ADAW] + (size_t)l * DM * NMOD + j0 + j;
        float a[8];
#pragma unroll
        for (int b = 0; b < 8; ++b) a[b] = 0.f;
#pragma unroll 16
        for (int k = kg * 128; k < kg * 128 + 128; ++k) { const float w = W[(size_t)k * NMOD];
#pragma unroll
            for (int b = 0; b < 8; ++b) a[b] += sc[b * 1024 + k] * w; }
#pragma unroll
        for (int b = 0; b < 8; ++b) red[(kg * 8 + b) * 64 + j] = a[b];
        __syncthreads();
        { const int b = c.tid >> 6; float s = 0.f;
#pragma unroll
          for (int g = 0; g < 8; ++g) s += red[(g * 8 + b) * 64 + j];
          mod[((size_t)l * 8 + b) * NMOD + j0 + j] = s + p.in[I_ADAB][(size_t)l * NMOD + j0 + j]; }
        __syncthreads();
    }
    if (c.bid == c.G - 1) {
        float* lb = (float*)(p.ws + WS_LB);
        for (int i = c.tid; i < 512; i += NTHREADS) { const float v0 = p.in[I_HLB][i], v1 = p.in[I_HLB][512 + i]; const float m = fmaxf(v0, v1), e0 = expf(v0 - m), e1 = expf(v1 - m);
            lb[i] = 0.f; lb[512 + i] = e1 / (e0 + e1); }
    }
    { float* WT = (float*)(p.ws + WS_WRT);
      for (int o = c.bid * NTHREADS + c.tid; o < NLAYER * 64 * 1024; o += c.G * NTHREADS) { const int k = o & 1023, e = (o >> 10) & 63, l = o >> 16; WT[o] = p.in[I_RW][((size_t)l * 1024 + k) * 64 + e]; } }
    { bf16_t* LW = (bf16_t*)(p.ws + WS_LRUW);
      for (int o = c.bid * NTHREADS + c.tid; o < NLAYER * 2 * 8 * 4096; o += c.G * NTHREADS) {
          const int i = o & 63, j = (o >> 6) & 63, g = (o >> 12) & 7, mat = (o >> 15) & 1, l = o >> 16;
          const float* src = p.in[mat == 0 ? I_LWA : I_LWX] + (((size_t)l * 8 + g) * 64 + i) * 64 + j;
          LW[o] = (bf16_t)f2bf(*src); } }
}

__device__ __forceinline__ void load_wdt(const Params& p, const Ctx& c, int l, LAS float* wdt) {
    const float* Win = p.in[I_WIN] + (size_t)l * DM * DIN;
    for (int i = c.tid; i < 16 * 1024; i += NTHREADS) { const int k = i >> 4, j = i & 15; wdt[j * 1024 + k] = Win[(size_t)k * DIN + 2560 + j]; }
    __syncthreads();
}
__device__ __forceinline__ void norm_mix_row(const Ctx& c, const f32x4 (&v)[4], float ss, int tok, const float* nw, const float* mod, const LAS float* wdt, bf16_t* H, float* dtraw) {
        const int b = tok >> 11;
        const float rstd = rsqf_(wave_sum(ss, c.lane) * (1.0f / DM) + EPS);
        f32x4 hv[4], w4v[4], shv[4], scv[4];
#pragma unroll
        for (int j = 0; j < 4; ++j) { const int col = 256 * j + 4 * c.lane;
            w4v[j] = *(const f32x4*)(nw + col); shv[j] = *(const f32x4*)(mod + (size_t)b * NMOD + col); scv[j] = *(const f32x4*)(mod + (size_t)b * NMOD + 1024 + col); }
#pragma unroll
        for (int j = 0; j < 4; ++j) {
            const int col = 256 * j + 4 * c.lane;
            const f32x4 w4 = w4v[j], sh = shv[j], sc = scv[j];
            hv[j] = (v[j] * rstd * w4) * (sc + 1.0f) + sh;
            u32x2 o; o.x = pk2(hv[j][0], hv[j][1]); o.y = pk2(hv[j][2], hv[j][3]);
            *(u32x2*)(H + (size_t)tok * DM + col) = o;
        }
        float d16[16];
#pragma unroll
        for (int q = 0; q < 16; ++q) {
            float s2 = 0.f;
#pragma unroll
            for (int j = 0; j < 4; ++j) { const f32x4 wq = *(const LAS f32x4*)(wdt + q * 1024 + 256 * j + 4 * c.lane); s2 += (hv[j][0] * wq[0] + hv[j][1] * wq[1]) + (hv[j][2] * wq[2] + hv[j][3] * wq[3]); }
            d16[q] = s2;
            if ((q & 1) == 1) asm volatile("" ::: "memory");
        }
        float d8[8], d4[4], d2[2], d1;
        { const bool up = (c.lane & 32) != 0;
#pragma unroll
          for (int i = 0; i < 8; ++i) { const float snd = up ? d16[i] : d16[8 + i], kp = up ? d16[8 + i] : d16[i]; d8[i] = kp + shfl_xor_l(snd, 32, c.lane); } }
        { const bool up = (c.lane & 16) != 0;
#pragma unroll
          for (int i = 0; i < 4; ++i) { const float snd = up ? d8[i] : d8[4 + i], kp = up ? d8[4 + i] : d8[i]; d4[i] = kp + shfl_xor_l(snd, 16, c.lane); } }
        { const bool up = (c.lane & 8) != 0;
#pragma unroll
          for (int i = 0; i < 2; ++i) { const float snd = up ? d4[i] : d4[2 + i], kp = up ? d4[2 + i] : d4[i]; d2[i] = kp + shfl_xor_l(snd, 8, c.lane); } }
        { const bool up = (c.lane & 4) != 0; const float snd = up ? d2[0] : d2[1], kp = up ? d2[1] : d2[0]; d1 = kp + shfl_xor_l(snd, 4, c.lane); }
        d1 += shfl_xor_l(d1, 2, c.lane); d1 += shfl_xor_l(d1, 1, c.lane);
        if ((c.lane & 3) == 0) dtraw[(size_t)tok * 16 + ((c.lane >> 5) & 1) * 8 + ((c.lane >> 4) & 1) * 4 + ((c.lane >> 3) & 1) * 2 + ((c.lane >> 2) & 1)] = d1;
}
__device__ __forceinline__ void phase_norm_mix(const Params& p, const Ctx& c, int l, const float* xin) {
    LAS float* wdt = (LAS float*)c.lds;
    load_wdt(p, c, l, wdt);
    const float* mod = (const float*)(p.ws + WS_MOD) + (size_t)l * 8 * NMOD;
    const float* nw = p.in[I_NMIX] + (size_t)l * DM;
    bf16_t* H = (bf16_t*)(p.ws + WS_H); float* dtraw = (float*)(p.ws + WS_DTRAW);
    const int gw = c.bid * NWAVES + c.wave, NGW = c.G * NWAVES;
    f32x4 vn[4];
    if (gw < NTOK) {
#pragma unroll
        for (int j = 0; j < 4; ++j) vn[j] = ((const f32x4*)(xin + (size_t)gw * DM) + c.lane)[64 * j];
    }
    for (int tok = gw; tok < NTOK; tok += NGW) {
        f32x4 v[4]; float ss = 0.f;
#pragma unroll
        for (int j = 0; j < 4; ++j) { v[j] = vn[j]; ss += (v[j][0] * v[j][0] + v[j][1] * v[j][1]) + (v[j][2] * v[j][2] + v[j][3] * v[j][3]); }
        if (tok + NGW < NTOK) {
#pragma unroll
            for (int j = 0; j < 4; ++j) vn[j] = ((const f32x4*)(xin + (size_t)(tok + NGW) * DM) + c.lane)[64 * j];
        }
        norm_mix_row(c, v, ss, tok, nw, mod, wdt, H, dtraw);
    }
}

__device__ __forceinline__ void phase_ssd_conv(const Params& p, const Ctx& c, int l) {
    const bf16_t* U = (const bf16_t*)(p.ws + WS_U); bf16_t* XA = (bf16_t*)(p.ws + WS_XBC);
    const float* cw = p.in[I_SCW] + (size_t)l * 4 * 1536; const float* cb = p.in[I_SCB] + (size_t)l * 1536;
    const float* dtraw = (const float*)(p.ws + WS_DTRAW); float* dt = (float*)(p.ws + WS_DT); float* acum = (float*)(p.ws + WS_ACUM);
    for (int idx = c.bid * NTHREADS + c.tid; idx < (NTOK / 4) * 192; idx += c.G * NTHREADS) {
        const int oct = idx % 192, tg = idx / 192, tok0 = tg * 4, t0 = tok0 & (SEQ - 1), c0 = oct * 8;
        float w[4][8], bb[8];
#pragma unroll
        for (int k = 0; k < 4; ++k) { const f32x4 a = *(const f32x4*)(cw + k * 1536 + c0), b2 = *(const f32x4*)(cw + k * 1536 + c0 + 4);
            w[k][0] = a[0]; w[k][1] = a[1]; w[k][2] = a[2]; w[k][3] = a[3]; w[k][4] = b2[0]; w[k][5] = b2[1]; w[k][6] = b2[2]; w[k][7] = b2[3]; }
        { const f32x4 a = *(const f32x4*)(cb + c0), b2 = *(const f32x4*)(cb + c0 + 4); bb[0] = a[0]; bb[1] = a[1]; bb[2] = a[2]; bb[3] = a[3]; bb[4] = b2[0]; bb[5] = b2[1]; bb[6] = b2[2]; bb[7] = b2[3]; }
        float x[7][8];
#pragma unroll
        for (int r = 0; r < 7; ++r) {
            u32x4 v = (u32x4){0u, 0u, 0u, 0u};
            if (t0 + r - 3 >= 0) v = *(const u32x4*)(U + (size_t)(tok0 + r - 3) * NU + UXS + c0);
#pragma unroll
            for (int j = 0; j < 4; ++j) { x[r][2 * j] = lo_bf(v[j]); x[r][2 * j + 1] = hi_bf(v[j]); }
        }
#pragma unroll
        for (int t = 0; t < 4; ++t) {
            float y[8];
#pragma unroll
            for (int j = 0; j < 8; ++j) y[j] = siluf_(bb[j] + w[0][j] * x[t][j] + w[1][j] * x[t + 1][j] + w[2][j] * x[t + 2][j] + w[3][j] * x[t + 3][j]);
            u32x4 o; o.x = pk2(y[0], y[1]); o.y = pk2(y[2], y[3]); o.z = pk2(y[4], y[5]); o.w = pk2(y[6], y[7]);
            *(u32x4*)(XA + (size_t)(tok0 + t) * 1536 + c0) = o;
        }
    }
    const int gw = c.bid * NWAVES + c.wave, NGW = c.G * NWAVES;
    for (int it = gw; it < 128; it += NGW) {
        const int tok0 = it * 128, h = c.lane & 15, qtr = c.lane >> 4;
        const float bias = p.in[I_SDTB][l * 16 + h], A = -expf(p.in[I_SALOG][l * 16 + h]);
        float d[32]; float cum = 0.f;
#pragma unroll
        for (int i = 0; i < 32; ++i) d[i] = softplusf_(dtraw[(size_t)(tok0 + qtr * 32 + i) * 16 + h] + bias);
#pragma unroll
        for (int i = 0; i < 32; ++i) cum += d[i] * A;
        const float c1 = shfl_up_f(cum, 16, c.lane), c2 = shfl_up_f(cum, 32, c.lane), c3 = shfl_up_f(cum, 48, c.lane);
        float off = 0.f; if (qtr >= 1) off += c1; if (qtr >= 2) off += c2; if (qtr >= 3) off += c3;
        float run = off;
#pragma unroll
        for (int i = 0; i < 32; ++i) { run += d[i] * A; dt[(size_t)(tok0 + qtr * 32 + i) * 16 + h] = d[i]; acum[(size_t)(tok0 + qtr * 32 + i) * 16 + h] = run; }
    }
}

__device__ __forceinline__ void phase_ssd_state(const Params& p, const Ctx& c) {
    LAS bf16_t* XS = (LAS bf16_t*)c.lds;
    LAS bf16_t* BS = (LAS bf16_t*)(c.lds + 128 * 72 * 2);
    const bf16_t* XA = (const bf16_t*)(p.ws + WS_XBC); const float* dt = (const float*)(p.ws + WS_DT); const float* acum = (const float*)(p.ws + WS_ACUM);
    bf16_t* ST = (bf16_t*)(p.ws + WS_SST);
    const int fr = c.lane & 15, fq = c.lane >> 4;
    for (int it = c.bid; it < 2048; it += c.G) {
        const int h = it & 15, bc = it >> 4, tok0 = bc * 128, g = h >> 3;
        const float aend = acum[(size_t)(tok0 + 127) * 16 + h];
        for (int i = c.tid; i < 128 * 8; i += NTHREADS) { const int lrow = i >> 3, ck = i & 7;
            const u32x4 r = *(const u32x4*)(XA + (size_t)(tok0 + lrow) * 1536 + h * 64 + ck * 8);
            const float f = dt[(size_t)(tok0 + lrow) * 16 + h] * __expf(aend - acum[(size_t)(tok0 + lrow) * 16 + h]);
            u32x4 o; o.x = pk2(lo_bf(r.x) * f, hi_bf(r.x) * f); o.y = pk2(lo_bf(r.y) * f, hi_bf(r.y) * f); o.z = pk2(lo_bf(r.z) * f, hi_bf(r.z) * f); o.w = pk2(lo_bf(r.w) * f, hi_bf(r.w) * f);
            *(LAS u32x4*)(XS + lrow * 72 + ck * 8) = o; }
        for (int i = c.tid; i < 128 * 16; i += NTHREADS) { const int lrow = i >> 4, ck = i & 15;
            *(LAS u32x4*)(BS + lrow * 136 + ck * 8) = *(const u32x4*)(XA + (size_t)(tok0 + lrow) * 1536 + 1024 + g * 128 + ck * 8); }
        LDS_BARRIER();
        f32x4 acc[4];
#pragma unroll
        for (int m = 0; m < 4; ++m) acc[m] = (f32x4){0.f, 0.f, 0.f, 0.f};
#pragma unroll
        for (int ks = 0; ks < 4; ++ks) {
            const bf16x8 bfr = tr_frag(BS, 136, 32 * ks, 16 * c.wave, c.lane);
#pragma unroll
            for (int m = 0; m < 4; ++m) { const bf16x8 afr = tr_frag(XS, 72, 32 * ks, 16 * m, c.lane); acc[m] = MFMA16(bfr, afr, acc[m]); }
        }
#pragma unroll
        for (int m = 0; m < 4; ++m) { u32x2 o; o.x = pk2(acc[m][0], acc[m][1]); o.y = pk2(acc[m][2], acc[m][3]);
            *(u32x2*)(ST + (size_t)it * 8192 + (16 * m + fr) * 128 + 16 * c.wave + 4 * fq) = o; }
        LDS_BARRIER();
    }
}
__device__ __forceinline__ void phase_ssd_scan(const Params& p, const Ctx& c) {
    unsigned* ST = (unsigned*)(p.ws + WS_SST); const float* acum = (const float*)(p.ws + WS_ACUM);
    for (int i = c.bid * NTHREADS + c.tid; i < 128 * 4096; i += c.G * NTHREADS) {
        const int e2 = i & 4095, bh = i >> 12, b = bh >> 4, h = bh & 15;
        float r0 = 0.f, r1 = 0.f;
        for (int ch = 0; ch < 16; ++ch) {
            const size_t it = (size_t)((b * 16 + ch) * 16 + h);
            const unsigned loc = ST[it * 4096 + e2];
            ST[it * 4096 + e2] = pk2(r0, r1);
            const float d = __expf(acum[(size_t)(b * SEQ + ch * 128 + 127) * 16 + h]);
            r0 = d * r0 + lo_bf(loc); r1 = d * r1 + hi_bf(loc);
        }
    }
}
__device__ __forceinline__ void phase_ssd_out(const Params& p, const Ctx& c, int l) {
    LAS bf16_t* Cs = (LAS bf16_t*)c.lds;
    LAS bf16_t* Bs = (LAS bf16_t*)(c.lds + 34816);
    LAS bf16_t* CBD = (LAS bf16_t*)(c.lds + 2 * 34816);
    LAS bf16_t* XS = (LAS bf16_t*)(c.lds + 3 * 34816);
    LAS bf16_t* STs = (LAS bf16_t*)(c.lds + 3 * 34816 + 18432);
    LAS float* acs = (LAS float*)(c.lds + 3 * 34816 + 18432 + 17408);
    const bf16_t* XA = (const bf16_t*)(p.ws + WS_XBC); const float* dt = (const float*)(p.ws + WS_DT); const float* acum = (const float*)(p.ws + WS_ACUM);
    const bf16_t* ST = (const bf16_t*)(p.ws + WS_SST); bf16_t* YP = (bf16_t*)(p.ws + WS_H);
    const int fr = c.lane & 15, fq = c.lane >> 4, w = c.wave;
    for (int it = c.bid; it < 2048; it += c.G) {
        const int h = it & 15, bc = it >> 4, tok0 = bc * 128, g = h >> 3;
        const float Dh = p.in[I_SD][l * 16 + h];
        for (int i = c.tid; i < 128 * 16; i += NTHREADS) { const int row = i >> 4, ck = i & 15;
            *(LAS u32x4*)(Bs + row * 136 + ck * 8) = *(const u32x4*)(XA + (size_t)(tok0 + row) * 1536 + 1024 + g * 128 + ck * 8);
            *(LAS u32x4*)(Cs + row * 136 + ck * 8) = *(const u32x4*)(XA + (size_t)(tok0 + row) * 1536 + 1280 + g * 128 + ck * 8); }
        for (int i = c.tid; i < 64 * 16; i += NTHREADS) { const int row = i >> 4, ck = i & 15;
            *(LAS u32x4*)(STs + row * 136 + ck * 8) = *(const u32x4*)(ST + (size_t)it * 8192 + row * 128 + ck * 8); }
        for (int i = c.tid; i < 128 * 8; i += NTHREADS) { const int lrow = i >> 3, ck = i & 7;
            const u32x4 r = *(const u32x4*)(XA + (size_t)(tok0 + lrow) * 1536 + h * 64 + ck * 8);
            const float f = dt[(size_t)(tok0 + lrow) * 16 + h];
            u32x4 o; o.x = pk2(lo_bf(r.x) * f, hi_bf(r.x) * f); o.y = pk2(lo_bf(r.y) * f, hi_bf(r.y) * f); o.z = pk2(lo_bf(r.z) * f, hi_bf(r.z) * f); o.w = pk2(lo_bf(r.w) * f, hi_bf(r.w) * f);
            *(LAS u32x4*)(XS + lrow * 72 + ck * 8) = o; }
        if (c.tid < 128) acs[c.tid] = acum[(size_t)(tok0 + c.tid) * 16 + h];
        __syncthreads();
        {
            f32x4 cb[8];
#pragma unroll
            for (int n = 0; n < 8; ++n) cb[n] = (f32x4){0.f, 0.f, 0.f, 0.f};
#pragma unroll
            for (int ks = 0; ks < 4; ++ks) {
                const bf16x8 afr = *(const LAS bf16x8*)(Cs + (16 * w + fr) * 136 + ks * 32 + 8 * fq);
#pragma unroll
                for (int n = 0; n < 8; ++n) { const bf16x8 bfr = *(const LAS bf16x8*)(Bs + (16 * n + fr) * 136 + ks * 32 + 8 * fq); cb[n] = MFMA16(bfr, afr, cb[n]); }
            }
            const int lr = 16 * w + fr; const float al = acs[lr];
#pragma unroll
            for (int n = 0; n < 8; ++n) { float v4[4];
#pragma unroll
                for (int r = 0; r < 4; ++r) { const int sc = 16 * n + 4 * fq + r; v4[r] = (sc <= lr) ? cb[n][r] * __expf(al - acs[sc]) : 0.f; }
                u32x2 o; o.x = pk2(v4[0], v4[1]); o.y = pk2(v4[2], v4[3]);
                *(LAS u32x2*)(CBD + lr * 136 + 16 * n + 4 * fq) = o; }
        }
        __syncthreads();
        {
            f32x4 a1[4], a2[4];
#pragma unroll
            for (int n = 0; n < 4; ++n) { a1[n] = (f32x4){0.f, 0.f, 0.f, 0.f}; a2[n] = (f32x4){0.f, 0.f, 0.f, 0.f}; }
#pragma unroll
            for (int ks = 0; ks < 4; ++ks) {
                const bf16x8 ad = *(const LAS bf16x8*)(CBD + (16 * w + fr) * 136 + ks * 32 + 8 * fq);
                const bf16x8 ac = *(const LAS bf16x8*)(Cs + (16 * w + fr) * 136 + ks * 32 + 8 * fq);
#pragma unroll
                for (int n = 0; n < 4; ++n) {
                    const bf16x8 bx = tr_frag(XS, 72, 32 * ks, 16 * n, c.lane);
                    const bf16x8 bs = *(const LAS bf16x8*)(STs + (16 * n + fr) * 136 + ks * 32 + 8 * fq);
                    a1[n] = MFMA16(bx, ad, a1[n]); a2[n] = MFMA16(bs, ac, a2[n]); }
            }
            const int lr = 16 * w + fr; const float ea = __expf(acs[lr]);
#pragma unroll
            for (int n = 0; n < 4; ++n) { const int pc = 16 * n + 4 * fq;
                const u32x2 xv = *(const u32x2*)(XA + (size_t)(tok0 + lr) * 1536 + h * 64 + pc);
                const float y0 = a1[n][0] + ea * a2[n][0] + Dh * lo_bf(xv.x), y1 = a1[n][1] + ea * a2[n][1] + Dh * hi_bf(xv.x);
                const float y2 = a1[n][2] + ea * a2[n][2] + Dh * lo_bf(xv.y), y3 = a1[n][3] + ea * a2[n][3] + Dh * hi_bf(xv.y);
                u32x2 o; o.x = pk2(y0, y1); o.y = pk2(y2, y3);
                *(u32x2*)(YP + (size_t)(tok0 + lr) * DM + h * 64 + pc) = o; }
        }
        __syncthreads();
    }
}
__device__ __forceinline__ void phase_ssd_out_g(const Params& p, const Ctx& c, int l) {
    LAS bf16_t* Cs = (LAS bf16_t*)c.lds;
    LAS bf16_t* CB = (LAS bf16_t*)(c.lds + 34816);
    LAS bf16_t* BD = (LAS bf16_t*)(c.lds + 2 * 34816);
    LAS bf16_t* XS = (LAS bf16_t*)(c.lds + 3 * 34816);
    LAS bf16_t* STs = (LAS bf16_t*)(c.lds + 3 * 34816 + 18432);
    LAS float* acs = (LAS float*)(c.lds + 3 * 34816 + 18432 + 17408);
    LAS float* dts = acs + 1024;
    const bf16_t* XA = (const bf16_t*)(p.ws + WS_XBC); const float* dt = (const float*)(p.ws + WS_DT); const float* acum = (const float*)(p.ws + WS_ACUM);
    const bf16_t* ST = (const bf16_t*)(p.ws + WS_SST); bf16_t* YP = (bf16_t*)(p.ws + WS_H);
    const bf16_t* U = (const bf16_t*)(p.ws + WS_U); bf16_t* YC = (bf16_t*)(p.ws + WS_YCAT);
    const float* nw = p.in[I_SNW] + (size_t)l * 1024;
    const int fr = c.lane & 15, fq = c.lane >> 4, w = c.wave;
    for (int it = c.bid; it < 256; it += c.G) {
        const int g = it & 1, bc = it >> 1, tok0 = bc * 128;
        for (int i = c.tid; i < 128 * 16; i += NTHREADS) { const int row = i >> 4, ck = i & 15;
            *(LAS u32x4*)(BD + row * 136 + ck * 8) = *(const u32x4*)(XA + (size_t)(tok0 + row) * 1536 + 1024 + g * 128 + ck * 8);
            *(LAS u32x4*)(Cs + row * 136 + ck * 8) = *(const u32x4*)(XA + (size_t)(tok0 + row) * 1536 + 1280 + g * 128 + ck * 8); }
        for (int i = c.tid; i < 1024; i += NTHREADS) { const int h8 = i >> 7, lr = i & 127; acs[i] = acum[(size_t)(tok0 + lr) * 16 + g * 8 + h8]; dts[i] = dt[(size_t)(tok0 + lr) * 16 + g * 8 + h8]; }
        LDS_BARRIER();
        {
            f32x4 cb[8];
#pragma unroll
            for (int n = 0; n < 8; ++n) cb[n] = (f32x4){0.f, 0.f, 0.f, 0.f};
#pragma unroll
            for (int ks = 0; ks < 4; ++ks) {
                const bf16x8 afr = *(const LAS bf16x8*)(Cs + (16 * w + fr) * 136 + ks * 32 + 8 * fq);
#pragma unroll
                for (int n = 0; n < 8; ++n) { const bf16x8 bfr = *(const LAS bf16x8*)(BD + (16 * n + fr) * 136 + ks * 32 + 8 * fq); cb[n] = MFMA16(bfr, afr, cb[n]); }
            }
            const int lr = 16 * w + fr;
#pragma unroll
            for (int n = 0; n < 8; ++n) { u32x2 o; o.x = pk2(cb[n][0], cb[n][1]); o.y = pk2(cb[n][2], cb[n][3]); *(LAS u32x2*)(CB + lr * 136 + 16 * n + 4 * fq) = o; }
        }
        LDS_BARRIER();
        u32x4 pst[2], pxs[2];
#pragma unroll
        for (int q = 0; q < 2; ++q) { const int i = c.tid + q * NTHREADS;
            pst[q] = *(const u32x4*)(ST + (size_t)(bc * 16 + g * 8) * 8192 + (i >> 4) * 128 + (i & 15) * 8);
            pxs[q] = *(const u32x4*)(XA + (size_t)(tok0 + (i >> 3)) * 1536 + (g * 8) * 64 + (i & 7) * 8); }
        for (int h8 = 0; h8 < 8; ++h8) {
            const int h = g * 8 + h8;
            const float Dh = p.in[I_SD][l * 16 + h];
            const LAS float* ah = acs + h8 * 128; const LAS float* dh = dts + h8 * 128;
#pragma unroll
            for (int q = 0; q < 2; ++q) { const int i = c.tid + q * NTHREADS;
                *(LAS u32x4*)(STs + (i >> 4) * 136 + (i & 15) * 8) = pst[q];
                const int lrow = i >> 3, ck = i & 7; const u32x4 r = pxs[q]; const float f = dh[lrow];
                u32x4 o; o.x = pk2(lo_bf(r.x) * f, hi_bf(r.x) * f); o.y = pk2(lo_bf(r.y) * f, hi_bf(r.y) * f); o.z = pk2(lo_bf(r.z) * f, hi_bf(r.z) * f); o.w = pk2(lo_bf(r.w) * f, hi_bf(r.w) * f);
                *(LAS u32x4*)(XS + lrow * 72 + ck * 8) = o; }
            if (h8 < 7) {
#pragma unroll
                for (int q = 0; q < 2; ++q) { const int i = c.tid + q * NTHREADS;
                    pst[q] = *(const u32x4*)(ST + (size_t)(bc * 16 + h + 1) * 8192 + (i >> 4) * 128 + (i & 15) * 8);
                    pxs[q] = *(const u32x4*)(XA + (size_t)(tok0 + (i >> 3)) * 1536 + (h + 1) * 64 + (i & 7) * 8); } }
            for (int i = c.tid; i < 128 * 16; i += NTHREADS) { const int lr = i >> 4, ck = i & 15; u32x4 o = (u32x4){0u, 0u, 0u, 0u};
                if (8 * ck <= lr) { const u32x4 cv = *(const LAS u32x4*)(CB + lr * 136 + ck * 8); const float al = ah[lr];
                    const f32x4 s0 = *(const LAS f32x4*)(ah + 8 * ck), s1 = *(const LAS f32x4*)(ah + 8 * ck + 4);
                    float e[8];
#pragma unroll
                    for (int j = 0; j < 4; ++j) { e[j] = (8 * ck + j <= lr) ? __expf(al - s0[j]) : 0.f; e[4 + j] = (8 * ck + 4 + j <= lr) ? __expf(al - s1[j]) : 0.f; }
                    o.x = pk2(lo_bf(cv.x) * e[0], hi_bf(cv.x) * e[1]); o.y = pk2(lo_bf(cv.y) * e[2], hi_bf(cv.y) * e[3]); o.z = pk2(lo_bf(cv.z) * e[4], hi_bf(cv.z) * e[5]); o.w = pk2(lo_bf(cv.w) * e[6], hi_bf(cv.w) * e[7]); }
                *(LAS u32x4*)(BD + lr * 136 + ck * 8) = o; }
            LDS_BARRIER();
            {
                f32x4 a1[4], a2[4];
#pragma unroll
                for (int n = 0; n < 4; ++n) { a1[n] = (f32x4){0.f, 0.f, 0.f, 0.f}; a2[n] = (f32x4){0.f, 0.f, 0.f, 0.f}; }
#pragma unroll
                for (int ks = 0; ks < 4; ++ks) {
                    const bf16x8 ad = *(const LAS bf16x8*)(BD + (16 * w + fr) * 136 + ks * 32 + 8 * fq);
                    const bf16x8 ac = *(const LAS bf16x8*)(Cs + (16 * w + fr) * 136 + ks * 32 + 8 * fq);
#pragma unroll
                    for (int n = 0; n < 4; ++n) {
                        const bf16x8 bx = tr_frag(XS, 72, 32 * ks, 16 * n, c.lane);
                        const bf16x8 bs = *(const LAS bf16x8*)(STs + (16 * n + fr) * 136 + ks * 32 + 8 * fq);
                        a1[n] = MFMA16(bx, ad, a1[n]); a2[n] = MFMA16(bs, ac, a2[n]); }
                }
                const int lr = 16 * w + fr; const float ea = __expf(ah[lr]);
#pragma unroll
                for (int n = 0; n < 4; ++n) { const int pc = 16 * n + 4 * fq;
                    const u32x2 xv = *(const u32x2*)(XA + (size_t)(tok0 + lr) * 1536 + h * 64 + pc);
                    const float y0 = a1[n][0] + ea * a2[n][0] + Dh * lo_bf(xv.x), y1 = a1[n][1] + ea * a2[n][1] + Dh * hi_bf(xv.x);
                    const float y2 = a1[n][2] + ea * a2[n][2] + Dh * lo_bf(xv.y), y3 = a1[n][3] + ea * a2[n][3] + Dh * hi_bf(xv.y);
                    u32x2 o; o.x = pk2(y0, y1); o.y = pk2(y2, y3);
                    *(u32x2*)(YP + (size_t)(tok0 + lr) * DM + h * 64 + pc) = o; }
            }
            LDS_BARRIER();
        }
        __syncthreads();
        for (int pass = 0; pass < 2; ++pass) {
            const int tok = tok0 + pass * 64 + (c.tid >> 3), part = c.tid & 7, col = g * 512 + part * 8;
            u32x4 yv[8], zv[8];
#pragma unroll
            for (int i = 0; i < 8; ++i) { yv[i] = *(const u32x4*)(YP + (size_t)tok * DM + col + 64 * i); zv[i] = *(const u32x4*)(U + (size_t)tok * NU + UZ + col + 64 * i); }
            float v[64]; float ss = 0.f;
#pragma unroll
            for (int i = 0; i < 8; ++i)
#pragma unroll
                for (int j = 0; j < 4; ++j) { const float a = lo_bf(yv[i][j]) * siluf_(lo_bf(zv[i][j])), b2 = hi_bf(yv[i][j]) * siluf_(hi_bf(zv[i][j])); v[8 * i + 2 * j] = a; v[8 * i + 2 * j + 1] = b2; ss += a * a + b2 * b2; }
            ss += shfl_xor_l(ss, 1, c.lane); ss += shfl_xor_l(ss, 2, c.lane); ss += shfl_xor_l(ss, 4, c.lane);
            const float rstd = rsqf_(ss * (1.0f / 512.0f) + EPS);
#pragma unroll
            for (int i = 0; i < 8; ++i) { const f32x4 w0 = *(const f32x4*)(nw + col + 64 * i), w1 = *(const f32x4*)(nw + col + 64 * i + 4);
                u32x4 o; o.x = pk2(v[8 * i] * rstd * w0[0], v[8 * i + 1] * rstd * w0[1]); o.y = pk2(v[8 * i + 2] * rstd * w0[2], v[8 * i + 3] * rstd * w0[3]);
                o.z = pk2(v[8 * i + 4] * rstd * w1[0], v[8 * i + 5] * rstd * w1[1]); o.w = pk2(v[8 * i + 6] * rstd * w1[2], v[8 * i + 7] * rstd * w1[3]);
                *(u32x4*)(YC + (size_t)tok * 2048 + col + 64 * i) = o; }
        }
        LDS_BARRIER();
    }
}
__device__ __forceinline__ void phase_ssd_gate(const Params& p, const Ctx& c, int l) {
    const bf16_t* YP = (const bf16_t*)(p.ws + WS_H); const bf16_t* U = (const bf16_t*)(p.ws + WS_U); bf16_t* YC = (bf16_t*)(p.ws + WS_YCAT);
    const float* nw = p.in[I_SNW] + (size_t)l * 1024;
    for (int r0 = c.bid * 64; r0 < NTOK * 2; r0 += c.G * 64) {
        const int row = r0 + (c.tid >> 3), part = c.tid & 7, tok = row >> 1, g = row & 1, col = g * 512 + part * 8;
        u32x4 yv[8], zv[8];
#pragma unroll
        for (int i = 0; i < 8; ++i) { yv[i] = *(const u32x4*)(YP + (size_t)tok * DM + col + 64 * i); zv[i] = *(const u32x4*)(U + (size_t)tok * NU + UZ + col + 64 * i); }
        float v[64]; float ss = 0.f;
#pragma unroll
        for (int i = 0; i < 8; ++i)
#pragma unroll
            for (int j = 0; j < 4; ++j) { const float a = lo_bf(yv[i][j]) * siluf_(lo_bf(zv[i][j])), b2 = hi_bf(yv[i][j]) * siluf_(hi_bf(zv[i][j])); v[8 * i + 2 * j] = a; v[8 * i + 2 * j + 1] = b2; ss += a * a + b2 * b2; }
        ss += shfl_xor_l(ss, 1, c.lane); ss += shfl_xor_l(ss, 2, c.lane); ss += shfl_xor_l(ss, 4, c.lane);
        const float rstd = rsqf_(ss * (1.0f / 512.0f) + EPS);
#pragma unroll
        for (int i = 0; i < 8; ++i) { const f32x4 w0 = *(const f32x4*)(nw + col + 64 * i), w1 = *(const f32x4*)(nw + col + 64 * i + 4);
            u32x4 o; o.x = pk2(v[8 * i] * rstd * w0[0], v[8 * i + 1] * rstd * w0[1]); o.y = pk2(v[8 * i + 2] * rstd * w0[2], v[8 * i + 3] * rstd * w0[3]);
            o.z = pk2(v[8 * i + 4] * rstd * w1[0], v[8 * i + 5] * rstd * w1[1]); o.w = pk2(v[8 * i + 6] * rstd * w1[2], v[8 * i + 7] * rstd * w1[3]);
            *(u32x4*)(YC + (size_t)tok * 2048 + col + 64 * i) = o; }
    }
}
__device__ __forceinline__ void phase_hg_state(const Params& p, const Ctx& c, int l) {
    LAS float* Bf = (LAS float*)c.lds;
    LAS float* KK = (LAS float*)(c.lds + 33792);
    LAS bf16_t* KD = (LAS bf16_t*)(c.lds + 2 * 33792 + 2112);
    LAS bf16_t* VS = (LAS bf16_t*)(c.lds + 2 * 33792 + 2112 + 17408);
    const bf16_t* U = (const bf16_t*)(p.ws + WS_U); const float* lb = (const float*)(p.ws + WS_LB) + l * 512;
    bf16_t* ST = (bf16_t*)(p.ws + WS_HST); float* BL = (float*)(p.ws + WS_HGBL);
    const int fr = c.lane & 15, fq = c.lane >> 4, w = c.wave;
    for (int it = c.bid; it < 1024; it += c.G) {
        const int ch = it & 31, bh = it >> 5, h = bh & 3, b = bh >> 2, tok0 = b * SEQ + ch * 64;
        for (int i = c.tid; i < 64 * 16; i += NTHREADS) { const int sr = i >> 4, ck = i & 15;
            const size_t ro = (size_t)(tok0 + sr) * NU + h * 128 + ck * 8;
            const u32x4 rf = *(const u32x4*)(U + ro + UHF);
            *(LAS u32x4*)(VS + sr * 136 + ck * 8) = *(const u32x4*)(U + ro + UHV);
            const f32x4 l0 = *(const f32x4*)(lb + h * 128 + ck * 8), l1 = *(const f32x4*)(lb + h * 128 + ck * 8 + 4);
            f32x4 k0, k1, g0, g1;
            k0[0] = (1.0f - l0[0]) * sigmoidf_(-lo_bf(rf.x)); k0[1] = (1.0f - l0[1]) * sigmoidf_(-hi_bf(rf.x)); k0[2] = (1.0f - l0[2]) * sigmoidf_(-lo_bf(rf.y)); k0[3] = (1.0f - l0[3]) * sigmoidf_(-hi_bf(rf.y));
            k1[0] = (1.0f - l1[0]) * sigmoidf_(-lo_bf(rf.z)); k1[1] = (1.0f - l1[1]) * sigmoidf_(-hi_bf(rf.z)); k1[2] = (1.0f - l1[2]) * sigmoidf_(-lo_bf(rf.w)); k1[3] = (1.0f - l1[3]) * sigmoidf_(-hi_bf(rf.w));
#pragma unroll
            for (int j = 0; j < 4; ++j) { g0[j] = __logf(1.0f - k0[j]); g1[j] = __logf(1.0f - k1[j]); }
            *(LAS f32x4*)(KK + sr * 132 + ck * 8) = k0; *(LAS f32x4*)(KK + sr * 132 + ck * 8 + 4) = k1;
            *(LAS f32x4*)(Bf + sr * 132 + ck * 8) = g0; *(LAS f32x4*)(Bf + sr * 132 + ck * 8 + 4) = g1; }
        LDS_BARRIER();
        { const int kc = c.tid & 127, q4 = c.tid >> 7; float vals[16]; float cum = 0.f;
#pragma unroll
          for (int i = 0; i < 16; ++i) { cum += Bf[(16 * q4 + i) * 132 + kc]; vals[i] = cum; }
          KK[(64 + q4) * 132 + kc] = cum;
          LDS_BARRIER();
          float off = 0.f;
#pragma unroll
          for (int j = 0; j < 3; ++j) off += (j < q4) ? KK[(64 + j) * 132 + kc] : 0.f;
#pragma unroll
          for (int i = 0; i < 16; ++i) Bf[(16 * q4 + i) * 132 + kc] = vals[i] + off;
          if (q4 == 3) BL[(size_t)it * 128 + kc] = vals[15] + off; }
        LDS_BARRIER();
        for (int i = c.tid; i < 64 * 16; i += NTHREADS) { const int sr = i >> 4, ck = i & 15;
            const f32x4 ka = *(const LAS f32x4*)(KK + sr * 132 + ck * 8), kb = *(const LAS f32x4*)(KK + sr * 132 + ck * 8 + 4);
            const f32x4 ba = *(const LAS f32x4*)(Bf + sr * 132 + ck * 8), bb = *(const LAS f32x4*)(Bf + sr * 132 + ck * 8 + 4);
            const f32x4 ea = *(const LAS f32x4*)(Bf + 63 * 132 + ck * 8), eb = *(const LAS f32x4*)(Bf + 63 * 132 + ck * 8 + 4);
            u32x4 o; o.x = pk2(ka[0] * __expf(ea[0] - ba[0]), ka[1] * __expf(ea[1] - ba[1])); o.y = pk2(ka[2] * __expf(ea[2] - ba[2]), ka[3] * __expf(ea[3] - ba[3]));
            o.z = pk2(kb[0] * __expf(eb[0] - bb[0]), kb[1] * __expf(eb[1] - bb[1])); o.w = pk2(kb[2] * __expf(eb[2] - bb[2]), kb[3] * __expf(eb[3] - bb[3]));
            *(LAS u32x4*)(KD + sr * 136 + ck * 8) = o; }
        LDS_BARRIER();
        f32x4 acc[8];
#pragma unroll
        for (int n = 0; n < 8; ++n) acc[n] = (f32x4){0.f, 0.f, 0.f, 0.f};
#pragma unroll
        for (int ks = 0; ks < 2; ++ks) {
            const bf16x8 afr = tr_frag(VS, 136, 32 * ks, 16 * w, c.lane);
#pragma unroll
            for (int n = 0; n < 8; ++n) { const bf16x8 bfr = tr_frag(KD, 136, 32 * ks, 16 * n, c.lane); acc[n] = MFMA16(bfr, afr, acc[n]); }
        }
#pragma unroll
        for (int n = 0; n < 8; ++n) { u32x2 o; o.x = pk2(acc[n][0], acc[n][1]); o.y = pk2(acc[n][2], acc[n][3]);
            *(u32x2*)(ST + (size_t)it * 16384 + (16 * w + fr) * 128 + 16 * n + 4 * fq) = o; }
        LDS_BARRIER();
    }
}
__device__ __forceinline__ void phase_hg_scan(const Params& p, const Ctx& c) {
    unsigned* ST = (unsigned*)(p.ws + WS_HST); const float* BL = (const float*)(p.ws + WS_HGBL);
    for (int i = c.bid * NTHREADS + c.tid; i < 32 * 8192; i += c.G * NTHREADS) {
        const int e2 = i & 8191, bh = i >> 13, k0 = (2 * e2) & 127;
        float r0 = 0.f, r1 = 0.f;
        for (int ch = 0; ch < 32; ++ch) {
            const size_t it = (size_t)(bh * 32 + ch);
            const unsigned loc = ST[it * 8192 + e2];
            ST[it * 8192 + e2] = pk2(r0, r1);
            const float d0 = __expf(BL[it * 128 + k0]), d1 = __expf(BL[it * 128 + k0 + 1]);
            r0 = d0 * r0 + lo_bf(loc); r1 = d1 * r1 + hi_bf(loc);
        }
    }
}
__device__ __forceinline__ void phase_hg_out(const Params& p, const Ctx& c, int l) {
    LAS bf16_t* Qs = (LAS bf16_t*)c.lds;
    LAS bf16_t* Ks = (LAS bf16_t*)(c.lds + 17408);
    LAS float* Bf = (LAS float*)(c.lds + 2 * 17408);
    LAS bf16_t* QB = Qs;
    LAS bf16_t* STs = (LAS bf16_t*)(c.lds + 2 * 17408 + 33792);
    LAS bf16_t* ATT = (LAS bf16_t*)(c.lds + 2 * 17408 + 33792 + 34816);
    LAS bf16_t* VS = (LAS bf16_t*)(c.lds + 2 * 17408 + 33792 + 34816 + 9216);
    LAS bf16_t* QI = (LAS bf16_t*)(c.lds + 2 * 17408 + 33792 + 34816 + 9216 + 17408);
    LAS bf16_t* KKI = (LAS bf16_t*)(c.lds + 2 * 17408 + 33792 + 34816 + 9216 + 17408 + 4352);
    const bf16_t* U = (const bf16_t*)(p.ws + WS_U); const float* lb = (const float*)(p.ws + WS_LB) + l * 512;
    const bf16_t* ST = (const bf16_t*)(p.ws + WS_HST); bf16_t* YC = (bf16_t*)(p.ws + WS_YCAT);
    const float* nw = p.in[I_HNW] + (size_t)l * 512;
    const int fr = c.lane & 15, fq = c.lane >> 4, w = c.wave;
    for (int it = c.bid; it < 1024; it += c.G) {
        const int ch = it & 31, bh = it >> 5, h = bh & 3, b = bh >> 2, tok0 = b * SEQ + ch * 64;
        for (int i = c.tid; i < 64 * 16; i += NTHREADS) { const int sr = i >> 4, ck = i & 15;
            const size_t ro = (size_t)(tok0 + sr) * NU + h * 128 + ck * 8;
            const u32x4 rq = *(const u32x4*)(U + ro + UHQ), rf = *(const u32x4*)(U + ro + UHF);
            *(LAS u32x4*)(VS + sr * 136 + ck * 8) = *(const u32x4*)(U + ro + UHV);
            const f32x4 l0 = *(const f32x4*)(lb + h * 128 + ck * 8), l1 = *(const f32x4*)(lb + h * 128 + ck * 8 + 4);
            f32x4 k0, k1, g0, g1;
            k0[0] = (1.0f - l0[0]) * sigmoidf_(-lo_bf(rf.x)); k0[1] = (1.0f - l0[1]) * sigmoidf_(-hi_bf(rf.x)); k0[2] = (1.0f - l0[2]) * sigmoidf_(-lo_bf(rf.y)); k0[3] = (1.0f - l0[3]) * sigmoidf_(-hi_bf(rf.y));
            k1[0] = (1.0f - l1[0]) * sigmoidf_(-lo_bf(rf.z)); k1[1] = (1.0f - l1[1]) * sigmoidf_(-hi_bf(rf.z)); k1[2] = (1.0f - l1[2]) * sigmoidf_(-lo_bf(rf.w)); k1[3] = (1.0f - l1[3]) * sigmoidf_(-hi_bf(rf.w));
#pragma unroll
            for (int j = 0; j < 4; ++j) { g0[j] = __logf(1.0f - k0[j]); g1[j] = __logf(1.0f - k1[j]); }
            u32x4 ko; ko.x = pk2(k0[0], k0[1]); ko.y = pk2(k0[2], k0[3]); ko.z = pk2(k1[0], k1[1]); ko.w = pk2(k1[2], k1[3]);
            u32x4 qo; qo.x = pk2(siluf_(lo_bf(rq.x)), siluf_(hi_bf(rq.x))); qo.y = pk2(siluf_(lo_bf(rq.y)), siluf_(hi_bf(rq.y))); qo.z = pk2(siluf_(lo_bf(rq.z)), siluf_(hi_bf(rq.z))); qo.w = pk2(siluf_(lo_bf(rq.w)), siluf_(hi_bf(rq.w)));
            *(LAS u32x4*)(Ks + sr * 136 + ck * 8) = ko; *(LAS u32x4*)(Qs + sr * 136 + ck * 8) = qo;
            *(LAS f32x4*)(Bf + sr * 132 + ck * 8) = g0; *(LAS f32x4*)(Bf + sr * 132 + ck * 8 + 4) = g1; }
        for (int i = c.tid; i < 128 * 16; i += NTHREADS) { const int row = i >> 4, ck = i & 15;
            *(LAS u32x4*)(STs + row * 136 + ck * 8) = *(const u32x4*)(ST + (size_t)it * 16384 + row * 128 + ck * 8); }
        LDS_BARRIER();
        { const int kc = c.tid & 127, q4 = c.tid >> 7; float vals[16]; float cum = 0.f;
#pragma unroll
          for (int i = 0; i < 16; ++i) { cum += Bf[(16 * q4 + i) * 132 + kc]; vals[i] = cum; }
          LAS float* QT = (LAS float*)KKI;
          QT[q4 * 128 + kc] = cum;
          LDS_BARRIER();
          float off = 0.f;
#pragma unroll
          for (int j = 0; j < 3; ++j) off += (j < q4) ? QT[j * 128 + kc] : 0.f;
#pragma unroll
          for (int i = 0; i < 16; ++i) Bf[(16 * q4 + i) * 132 + kc] = vals[i] + off; }
        LDS_BARRIER();
        for (int pidx = c.tid; pidx < 1024; pidx += NTHREADS) {
            const int ib = pidx >> 8, tq = (pidx >> 4) & 15, sq = pidx & 15, t = 16 * ib + tq, s2 = 16 * ib + sq; float a = 0.f;
            if (sq <= tq) {
                for (int k = 0; k < 128; k += 4) {
                    const f32x4 bt = *(const LAS f32x4*)(Bf + t * 132 + k), bs = *(const LAS f32x4*)(Bf + s2 * 132 + k);
                    const u32x2 qv = *(const LAS u32x2*)(Qs + t * 136 + k), kv = *(const LAS u32x2*)(Ks + s2 * 136 + k);
                    a += lo_bf(qv.x) * lo_bf(kv.x) * __expf(bt[0] - bs[0]) + hi_bf(qv.x) * hi_bf(kv.x) * __expf(bt[1] - bs[1])
                       + lo_bf(qv.y) * lo_bf(kv.y) * __expf(bt[2] - bs[2]) + hi_bf(qv.y) * hi_bf(kv.y) * __expf(bt[3] - bs[3]);
                }
            }
            ATT[t * 72 + s2] = (bf16_t)f2bf(a);
        }
        for (int i = c.tid; i < 6 * 256; i += NTHREADS) { const int blk = i >> 8, e = i & 255; const int bi = (blk < 3) ? 0 : (blk < 5 ? 1 : 2), bj = (blk < 3) ? blk + 1 : (blk < 5 ? blk - 1 : 3);
            ATT[(16 * bi + (e >> 4)) * 72 + 16 * bj + (e & 15)] = (bf16_t)0; }
        for (int ib = 1; ib < 4; ++ib) {
            const int rref = 16 * ib - 1;
            for (int i = c.tid; i < 16 * 64; i += NTHREADS) { const int tq = i >> 6, kp = i & 63, t = 16 * ib + tq;
                const unsigned q2 = *(const LAS unsigned*)(Qs + t * 136 + 2 * kp);
                *(LAS unsigned*)(QI + tq * 136 + 2 * kp) = pk2(lo_bf(q2) * __expf(Bf[t * 132 + 2 * kp] - Bf[rref * 132 + 2 * kp]), hi_bf(q2) * __expf(Bf[t * 132 + 2 * kp + 1] - Bf[rref * 132 + 2 * kp + 1])); }
            for (int i = c.tid; i < 16 * ib * 64; i += NTHREADS) { const int s2 = i >> 6, kp = i & 63;
                const unsigned k2 = *(const LAS unsigned*)(Ks + s2 * 136 + 2 * kp);
                *(LAS unsigned*)(KKI + s2 * 136 + 2 * kp) = pk2(lo_bf(k2) * __expf(Bf[rref * 132 + 2 * kp] - Bf[s2 * 132 + 2 * kp]), hi_bf(k2) * __expf(Bf[rref * 132 + 2 * kp + 1] - Bf[s2 * 132 + 2 * kp + 1])); }
            LDS_BARRIER();
            if (w < ib) {
                f32x4 a4 = (f32x4){0.f, 0.f, 0.f, 0.f};
#pragma unroll
                for (int ks = 0; ks < 4; ++ks) { const bf16x8 afr = *(const LAS bf16x8*)(QI + fr * 136 + ks * 32 + 8 * fq), bfr = *(const LAS bf16x8*)(KKI + (16 * w + fr) * 136 + ks * 32 + 8 * fq); a4 = MFMA16(afr, bfr, a4); }
#pragma unroll
                for (int r = 0; r < 4; ++r) ATT[(16 * ib + 4 * fq + r) * 72 + 16 * w + fr] = (bf16_t)f2bf(a4[r]);
            }
            LDS_BARRIER();
        }
        for (int i = c.tid; i < 64 * 64; i += NTHREADS) { const int t = i >> 6, kp = i & 63;
            const unsigned q2 = *(const LAS unsigned*)(Qs + t * 136 + 2 * kp);
            *(LAS unsigned*)(Qs + t * 136 + 2 * kp) = pk2(lo_bf(q2) * __expf(Bf[t * 132 + 2 * kp]), hi_bf(q2) * __expf(Bf[t * 132 + 2 * kp + 1])); }
        LDS_BARRIER();
        f32x4 acc[4];
#pragma unroll
        for (int m = 0; m < 4; ++m) acc[m] = (f32x4){0.f, 0.f, 0.f, 0.f};
#pragma unroll
        for (int ks = 0; ks < 4; ++ks) {
            const bf16x8 bfr = *(const LAS bf16x8*)(STs + (16 * w + fr) * 136 + ks * 32 + 8 * fq);
#pragma unroll
            for (int m = 0; m < 4; ++m) { const bf16x8 afr = *(const LAS bf16x8*)(QB + (16 * m + fr) * 136 + ks * 32 + 8 * fq); acc[m] = MFMA16(afr, bfr, acc[m]); }
        }
#pragma unroll
        for (int ks = 0; ks < 2; ++ks) {
            const bf16x8 bfr = tr_frag(VS, 136, 32 * ks, 16 * w, c.lane);
#pragma unroll
            for (int m = 0; m < 4; ++m) { const bf16x8 afr = *(const LAS bf16x8*)(ATT + (16 * m + fr) * 72 + ks * 32 + 8 * fq); acc[m] = MFMA16(afr, bfr, acc[m]); }
        }
#pragma unroll
        for (int m = 0; m < 4; ++m)
#pragma unroll
            for (int r = 0; r < 4; ++r) Bf[(16 * m + 4 * fq + r) * 132 + 16 * w + fr] = acc[m][r];
        LDS_BARRIER();
        {
            const int t = c.tid >> 3, part = c.tid & 7;
            f32x4 o4[4]; float ss = 0.f;
#pragma unroll
            for (int i = 0; i < 4; ++i) { o4[i] = *(const LAS f32x4*)(Bf + t * 132 + part * 16 + 4 * i); ss += (o4[i][0] * o4[i][0] + o4[i][1] * o4[i][1]) + (o4[i][2] * o4[i][2] + o4[i][3] * o4[i][3]); }
            const u32x4 g0 = *(const u32x4*)(U + (size_t)(tok0 + t) * NU + UHG + h * 128 + part * 16), g1 = *(const u32x4*)(U + (size_t)(tok0 + t) * NU + UHG + h * 128 + part * 16 + 8);
            ss += shfl_xor_l(ss, 1, c.lane); ss += shfl_xor_l(ss, 2, c.lane); ss += shfl_xor_l(ss, 4, c.lane);
            const float rstd = rsqf_(ss * (1.0f / 128.0f) + EPS);
            const float* nwp = nw + h * 128 + part * 16;
            const f32x4 n0 = *(const f32x4*)(nwp), n1 = *(const f32x4*)(nwp + 4), n2 = *(const f32x4*)(nwp + 8), n3 = *(const f32x4*)(nwp + 12);
            u32x4 r0, r1;
            r0.x = pk2(o4[0][0] * rstd * n0[0] * siluf_(lo_bf(g0.x)), o4[0][1] * rstd * n0[1] * siluf_(hi_bf(g0.x))); r0.y = pk2(o4[0][2] * rstd * n0[2] * siluf_(lo_bf(g0.y)), o4[0][3] * rstd * n0[3] * siluf_(hi_bf(g0.y)));
            r0.z = pk2(o4[1][0] * rstd * n1[0] * siluf_(lo_bf(g0.z)), o4[1][1] * rstd * n1[1] * siluf_(hi_bf(g0.z))); r0.w = pk2(o4[1][2] * rstd * n1[2] * siluf_(lo_bf(g0.w)), o4[1][3] * rstd * n1[3] * siluf_(hi_bf(g0.w)));
            r1.x = pk2(o4[2][0] * rstd * n2[0] * siluf_(lo_bf(g1.x)), o4[2][1] * rstd * n2[1] * siluf_(hi_bf(g1.x))); r1.y = pk2(o4[2][2] * rstd * n2[2] * siluf_(lo_bf(g1.y)), o4[2][3] * rstd * n2[3] * siluf_(hi_bf(g1.y)));
            r1.z = pk2(o4[3][0] * rstd * n3[0] * siluf_(lo_bf(g1.z)), o4[3][1] * rstd * n3[1] * siluf_(hi_bf(g1.z))); r1.w = pk2(o4[3][2] * rstd * n3[2] * siluf_(lo_bf(g1.w)), o4[3][3] * rstd * n3[3] * siluf_(hi_bf(g1.w)));
            bf16_t* yo = YC + (size_t)(tok0 + t) * 2048 + 1024 + h * 128 + part * 16;
            *(u32x4*)yo = r0; *(u32x4*)(yo + 8) = r1;
        }
        LDS_BARRIER();
    }
}

__device__ __forceinline__ void phase_lru1(const Params& p, const Ctx& c, int l) {
    LAS unsigned char* wl = c.lds + c.wave * 12288;
    LAS bf16_t* XB = (LAS bf16_t*)wl;
    LAS float* As = (LAS float*)(wl + 2304);
    LAS float* Us = (LAS float*)(wl + 2304 + 4096);
    const bf16_t* U = (const bf16_t*)(p.ws + WS_U); bf16_t* LA = (bf16_t*)(p.ws + WS_LA); bf16_t* LH = (bf16_t*)(p.ws + WS_LH);
    const bf16_t* LW = (const bf16_t*)(p.ws + WS_LRUW) + (size_t)l * 2 * 8 * 4096;
    const int fr = c.lane & 15, fq = c.lane >> 4, g = c.wave, chn = g * 64 + c.lane;
    const float cw0 = p.in[I_LCW][(size_t)l * 2048 + chn], cw1 = p.in[I_LCW][(size_t)l * 2048 + 512 + chn], cw2 = p.in[I_LCW][(size_t)l * 2048 + 1024 + chn], cw3 = p.in[I_LCW][(size_t)l * 2048 + 1536 + chn];
    const float cbias = p.in[I_LCB][l * 512 + chn];
    bf16x8 wfa[4][2], wfx[4][2];
#pragma unroll
    for (int n = 0; n < 4; ++n)
#pragma unroll
        for (int ks = 0; ks < 2; ++ks) { wfa[n][ks] = *(const bf16x8*)(LW + (size_t)(0 * 8 + g) * 4096 + (16 * n + fr) * 64 + ks * 32 + 8 * fq);
                                         wfx[n][ks] = *(const bf16x8*)(LW + (size_t)(1 * 8 + g) * 4096 + (16 * n + fr) * 64 + ks * 32 + 8 * fq); }
    float bav[4], bxv[4], spl[4];
#pragma unroll
    for (int n = 0; n < 4; ++n) { const int j = g * 64 + 16 * n + fr; bav[n] = p.in[I_LBA][l * 512 + j]; bxv[n] = p.in[I_LBX][l * 512 + j]; spl[n] = softplusf_(-p.in[I_LLAM][l * 512 + j]); }
    for (int it = c.bid; it < 256; it += c.G) {
        const int seg = it & 31, tok0 = (it >> 5) * SEQ + seg * 64;
        float x0 = 0.f, x1 = 0.f, x2 = 0.f;
        if (seg > 0) { x0 = bf2f(U[(size_t)(tok0 - 3) * NU + ULX + chn]); x1 = bf2f(U[(size_t)(tok0 - 2) * NU + ULX + chn]); x2 = bf2f(U[(size_t)(tok0 - 1) * NU + ULX + chn]); }
        float hrun = 0.f, arun = 1.f;
        for (int st = 0; st < 4; ++st) {
            const int t0 = tok0 + st * 16;
#pragma unroll
            for (int tt = 0; tt < 16; ++tt) { const float xr = bf2f(U[(size_t)(t0 + tt) * NU + ULX + chn]);
                const float xb = cbias + cw0 * x0 + cw1 * x1 + cw2 * x2 + cw3 * xr; x0 = x1; x1 = x2; x2 = xr;
                XB[tt * 72 + c.lane] = (bf16_t)f2bf(xb); }
            LDS_WAIT();
            f32x4 ar[4], ai[4];
#pragma unroll
            for (int n = 0; n < 4; ++n) { ar[n] = (f32x4){0.f, 0.f, 0.f, 0.f}; ai[n] = (f32x4){0.f, 0.f, 0.f, 0.f}; }
#pragma unroll
            for (int ks = 0; ks < 2; ++ks) { const bf16x8 afr = *(const LAS bf16x8*)(XB + fr * 72 + ks * 32 + 8 * fq);
#pragma unroll
                for (int n = 0; n < 4; ++n) { ar[n] = MFMA16(afr, wfa[n][ks], ar[n]); ai[n] = MFMA16(afr, wfx[n][ks], ai[n]); } }
#pragma unroll
            for (int n = 0; n < 4; ++n)
#pragma unroll
                for (int r = 0; r < 4; ++r) { const int t = 4 * fq + r, j = 16 * n + fr;
                    const float rg = sigmoidf_(ar[n][r] + bav[n]), ig = sigmoidf_(ai[n][r] + bxv[n]);
                    const float la = -8.0f * rg * spl[n], a = __expf(la), mult = sqrtf(fmaxf(fmaf(-a, a, 1.0f), 0.f));
                    As[t * 64 + j] = a; Us[t * 64 + j] = mult * ig * bf2f(XB[t * 72 + j]); }
            LDS_WAIT();
#pragma unroll
            for (int tt = 0; tt < 16; ++tt) { const float a = As[tt * 64 + c.lane], uu = Us[tt * 64 + c.lane];
                hrun = a * hrun + uu; arun = a * arun;
                LA[(size_t)(t0 + tt) * 512 + chn] = (bf16_t)f2bf(arun); LH[(size_t)(t0 + tt) * 512 + chn] = (bf16_t)f2bf(hrun); }
            LDS_WAIT();
        }
    }
}
__device__ __forceinline__ void phase_lru2(const Params& p, const Ctx& c, int l) {
    LAS float* YS = (LAS float*)c.lds;
    LAS float* RS = (LAS float*)(c.lds + 64 * 516 * 4);
    const bf16_t* U = (const bf16_t*)(p.ws + WS_U); const bf16_t* LA = (const bf16_t*)(p.ws + WS_LA); const bf16_t* LH = (const bf16_t*)(p.ws + WS_LH);
    bf16_t* YC = (bf16_t*)(p.ws + WS_YCAT);
    const int g = c.wave, chn = g * 64 + c.lane;
    const float nwv = p.in[I_LNW][l * 512 + chn];
    for (int it = c.bid; it < 256; it += c.G) {
        const int seg = it & 31, b = it >> 5, tok0 = b * SEQ + seg * 64;
        float hin = 0.f;
        for (int s2 = 0; s2 < seg; ++s2) { const size_t row = (size_t)(b * SEQ + s2 * 64 + 63); hin = bf2f(LH[row * 512 + chn]) + bf2f(LA[row * 512 + chn]) * hin; }
#pragma unroll 8
        for (int tt = 0; tt < 64; ++tt) { const size_t tok = (size_t)(tok0 + tt);
            const float hh = bf2f(LH[tok * 512 + chn]) + bf2f(LA[tok * 512 + chn]) * hin;
            YS[tt * 516 + chn] = hh * gelu_tanhf_(bf2f(U[tok * NU + ULG + chn])); }
        LDS_BARRIER();
        {
            const int t = c.tid >> 3, part = c.tid & 7; float ss = 0.f;
#pragma unroll
            for (int i = 0; i < 16; ++i) { const f32x4 v = *(const LAS f32x4*)(YS + t * 516 + 32 * i + 4 * part); ss += (v[0] * v[0] + v[1] * v[1]) + (v[2] * v[2] + v[3] * v[3]); }
            ss += shfl_xor_l(ss, 1, c.lane); ss += shfl_xor_l(ss, 2, c.lane); ss += shfl_xor_l(ss, 4, c.lane);
            if (part == 0) RS[t] = rsqf_(ss * (1.0f / 512.0f) + EPS);
        }
        LDS_BARRIER();
#pragma unroll 8
        for (int tt = 0; tt < 64; ++tt) YC[(size_t)(tok0 + tt) * 2048 + 1536 + chn] = (bf16_t)f2bf(YS[tt * 516 + chn] * RS[tt] * nwv);
        LDS_BARRIER();
    }
}

__device__ __forceinline__ void phase_norm_router(const Params& p, const Ctx& c, int l, const float* xin) {
    constexpr int HSTR = 1028;
    LAS float* HS = (LAS float*)c.lds;
    LAS float* PL = (LAS float*)(c.lds + 16 * HSTR * 4);
    LAS float* LG = (LAS float*)(c.lds + 16 * HSTR * 4 + 32768);
    const float* mod = (const float*)(p.ws + WS_MOD) + (size_t)l * 8 * NMOD;
    const float* nw = p.in[I_NFFN] + (size_t)l * DM;
    const float* WT = (const float*)(p.ws + WS_WRT) + (size_t)l * 64 * 1024;
    const float rbias = p.in[I_RB][l * NEXP + c.lane];
    bf16_t* H = (bf16_t*)(p.ws + WS_H);
    unsigned long long* selm = (unsigned long long*)(p.ws + WS_SELM); float* rw = (float*)(p.ws + WS_RW);
    const int fr = c.lane & 15, fq = c.lane >> 4, w = c.wave;
    int* cnt = (int*)(p.ws + WS_CNT);
    f32x4 bw[8][4];
#pragma unroll
    for (int j = 0; j < 8; ++j)
#pragma unroll
        for (int n = 0; n < 4; ++n) bw[j][n] = *(const f32x4*)(WT + (size_t)(16 * n + fr) * 1024 + 128 * w + 16 * j + 4 * fq);
    int ecount = 0;
    f32x4 xn[2][4];
    if (c.bid < NTOK / 16) {
#pragma unroll
        for (int q = 0; q < 2; ++q)
#pragma unroll
            for (int j = 0; j < 4; ++j) xn[q][j] = ((const f32x4*)(xin + (size_t)(c.bid * 16 + 2 * w + q) * DM) + c.lane)[64 * j];
    }
    for (int t16 = c.bid; t16 < NTOK / 16; t16 += c.G) {
        const int tokb = t16 * 16, b = tokb >> 11;
        f32x4 pa[4], pb[4];
#pragma unroll
        for (int j = 0; j < 4; ++j) { const int col = 256 * j + 4 * c.lane;
            const f32x4 w4 = *(const f32x4*)(nw + col), sc = *(const f32x4*)(mod + (size_t)b * NMOD + 4096 + col); pb[j] = *(const f32x4*)(mod + (size_t)b * NMOD + 3072 + col); pa[j] = w4 * (sc + 1.0f); }
#pragma unroll
        for (int q = 0; q < 2; ++q) {
            const int tl = 2 * w + q, tok = tokb + tl;
            f32x4 v[4]; float ss = 0.f;
#pragma unroll
            for (int j = 0; j < 4; ++j) { v[j] = xn[q][j]; ss += (v[j][0] * v[j][0] + v[j][1] * v[j][1]) + (v[j][2] * v[j][2] + v[j][3] * v[j][3]); }
            const float rstd = rsqf_(wave_sum(ss, c.lane) * (1.0f / DM) + EPS);
#pragma unroll
            for (int j = 0; j < 4; ++j) {
                const int col = 256 * j + 4 * c.lane;
                const f32x4 h = (v[j] * rstd) * pa[j] + pb[j];
                u32x2 o; o.x = pk2(h[0], h[1]); o.y = pk2(h[2], h[3]);
                *(u32x2*)(H + (size_t)tok * DM + col) = o;
                *(LAS f32x4*)(HS + tl * HSTR + col) = h;
            }
        }
        if (t16 + c.G < NTOK / 16) {
#pragma unroll
            for (int q = 0; q < 2; ++q)
#pragma unroll
                for (int j = 0; j < 4; ++j) xn[q][j] = ((const f32x4*)(xin + (size_t)((t16 + c.G) * 16 + 2 * w + q) * DM) + c.lane)[64 * j];
        }
        LDS_BARRIER();
        {
            f32x4 acc[4];
#pragma unroll
            for (int n = 0; n < 4; ++n) acc[n] = (f32x4){0.f, 0.f, 0.f, 0.f};
#pragma unroll
            for (int j = 0; j < 8; ++j) {
                const int kk = 128 * w + 16 * j + 4 * fq;
                const f32x4 a4 = *(const LAS f32x4*)(HS + fr * HSTR + kk);
#pragma unroll
                for (int i = 0; i < 4; ++i)
#pragma unroll
                    for (int n = 0; n < 4; ++n) acc[n] = __builtin_amdgcn_mfma_f32_16x16x4f32(a4[i], bw[j][n][i], acc[n], 0, 0, 0);
            }
#pragma unroll
            for (int n = 0; n < 4; ++n)
#pragma unroll
                for (int r = 0; r < 4; ++r) PL[(w * 16 + 4 * fq + r) * 64 + 16 * n + fr] = acc[n][r];
        }
        LDS_BARRIER();
        for (int i = c.tid; i < 1024; i += NTHREADS) { float s2 = 0.f;
#pragma unroll
            for (int ww = 0; ww < 8; ++ww) s2 += PL[ww * 1024 + i];
            LG[i] = s2; }
        LDS_BARRIER();
#pragma unroll
        for (int q = 0; q < 2; ++q) {
            const int tl = 2 * w + q, tok = tokb + tl;
            const float s = sigmoidf_(LG[tl * 64 + c.lane]), v = s + rbias;
            float m1 = v;
            m1 = fmaxf(m1, shfl_xor_l(m1, 1, c.lane)); m1 = fmaxf(m1, shfl_xor_l(m1, 2, c.lane)); m1 = fmaxf(m1, shfl_xor_l(m1, 4, c.lane));
            const unsigned long long eq = __ballot(v == m1);
            const int gbase = c.lane & ~7;
            const unsigned gm = (unsigned)((eq >> gbase) & 0xffull);
            const int first = gbase + __builtin_ctz(gm);
            float m2 = (c.lane == first) ? -3.0e38f : v;
            m2 = fmaxf(m2, shfl_xor_l(m2, 1, c.lane)); m2 = fmaxf(m2, shfl_xor_l(m2, 2, c.lane)); m2 = fmaxf(m2, shfl_xor_l(m2, 4, c.lane));
            const float gs = m1 + m2;
            const int mygrp = c.lane >> 3; int grank = 0;
#pragma unroll
            for (int g2 = 0; g2 < 8; ++g2) { const float o = rdlane_f(gs, g2 * 8); grank += (o > gs || (o == gs && g2 < mygrp)) ? 1 : 0; }
            const float vm = (grank < 4) ? v : -1.0e4f;
            int erank = 0;
            for (int e2 = 0; e2 < 64; ++e2) { const float o = rdlane_f(vm, e2); erank += (int)(o > vm) + (int)((o == vm) & (e2 < c.lane)); }
            const bool sel = erank < TOPK;
            const unsigned long long mask = __ballot(sel);
            const float wsum = wave_sum(sel ? s : 0.f, c.lane);
            if (sel) { const int kk = __builtin_popcountll(mask & ((1ull << c.lane) - 1ull)); rw[(size_t)tok * 8 + kk] = s * rcpf_(wsum) * 2.5f; }
            if (c.lane == 0) selm[tok] = mask;
            ecount += sel ? 1 : 0;
        }
        LDS_BARRIER();
    }
    { LAS int* CW = (LAS int*)c.lds; CW[w * 64 + c.lane] = ecount; LDS_BARRIER();
      if (w == 0) { int tot = 0;
#pragma unroll
          for (int ww = 0; ww < 8; ++ww) tot += CW[ww * 64 + c.lane];
          cnt[c.bid * 64 + c.lane] = tot; }
      LDS_BARRIER(); }
}
__device__ __forceinline__ void phase_route_assign(const Params& p, const Ctx& c) {
    const unsigned long long* selm = (const unsigned long long*)(p.ws + WS_SELM); const int* cnt = (const int*)(p.ws + WS_CNT);
    int* slot_tok = (int*)(p.ws + WS_SLOTTOK); int* slot_of = (int*)(p.ws + WS_SLOTOF); int* rinfo = (int*)(p.ws + WS_RINFO);
    const int gw = c.bid * NWAVES + c.wave, NGW = c.G * NWAVES;
    for (int ch = gw; ch < c.G; ch += NGW) {
        int total = 0, before = 0;
        for (int j = 0; j < c.G; ++j) { const int v = cnt[j * 64 + c.lane]; total += v; before += (j < ch) ? v : 0; }
        const int pad = (total + 255) & ~255;
        int incl = pad;
#pragma unroll
        for (int o = 1; o < 64; o <<= 1) { const int t = shfl_up_l(incl, o, c.lane); if (c.lane >= o) incl += t; }
        const int pstart = incl - pad;
        int run = pstart + before;
        for (int t16 = ch; t16 < NTOK / 16; t16 += c.G) {
            const unsigned long long mine = (c.lane < 16) ? selm[t16 * 16 + c.lane] : 0ull;
            for (int i = 0; i < 16; ++i) {
                const unsigned long long m = rdlane_u64(mine, i); const int tok = t16 * 16 + i;
                if ((m >> c.lane) & 1ull) { const int kk = __builtin_popcountll(m & ((1ull << c.lane) - 1ull)); slot_tok[run] = tok; slot_of[tok * 8 + kk] = run; ++run; }
            }
        }
        if (ch == 0) {
            for (int s2 = pstart + total; s2 < pstart + pad; ++s2) slot_tok[s2] = -1;
            for (int bk = pstart >> 8; bk < (pstart + pad) >> 8; ++bk) rinfo[64 + bk] = c.lane;
            if (c.lane == 63) rinfo[0] = incl >> 8;
        }
    }
}
__device__ __forceinline__ void phase_combine(const Params& p, const Ctx& c, int l) {
    const float* gate = (const float*)(p.ws + WS_MOD) + (size_t)l * 8 * NMOD + 5120;
    const unsigned char* Y = (const unsigned char*)(p.ws + WS_Y); const unsigned char* YS = (const unsigned char*)(p.ws + WS_YSH); const int* slot_of = (const int*)(p.ws + WS_SLOTOF); const float* rw = (const float*)(p.ws + WS_RW);
    const float* fw = p.in[I_FNW];
    if (l + 1 < NLAYER) load_wdt(p, c, l + 1, (LAS float*)c.lds);
    const int gw = c.bid * NWAVES + c.wave, NGW = c.G * NWAVES;
    for (int tok = gw; tok < NTOK; tok += NGW) {
        const int b = tok >> 11;
        f32x4 acc[4], gvv[4], xv0[4];
        f32x4* xr = (f32x4*)(p.out + (size_t)tok * DM) + c.lane;
#pragma unroll
        for (int j = 0; j < 4; ++j) { acc[j] = (f32x4){0.f, 0.f, 0.f, 0.f}; gvv[j] = *(const f32x4*)(gate + (size_t)b * NMOD + 256 * j + 4 * c.lane); xv0[j] = xr[64 * j]; }
#pragma unroll
        for (int k = 0; k < 8; ++k) { const int sl = slot_of[tok * 8 + k]; const float wk = rw[tok * 8 + k] * Y8_INV;
#pragma unroll
            for (int j = 0; j < 4; ++j) { const int yw = (int)*(const unsigned*)(Y + (size_t)sl * DM + 256 * j + 4 * c.lane);
                const f32x2 y01 = __builtin_amdgcn_cvt_pk_f32_fp8(yw, false), y23 = __builtin_amdgcn_cvt_pk_f32_fp8(yw, true);
                acc[j][0] += wk * y01[0]; acc[j][1] += wk * y01[1]; acc[j][2] += wk * y23[0]; acc[j][3] += wk * y23[1]; } }
#pragma unroll
        for (int j = 0; j < 4; ++j) { const int yw = (int)*(const unsigned*)(YS + (size_t)tok * DM + 256 * j + 4 * c.lane);
            const f32x2 y01 = __builtin_amdgcn_cvt_pk_f32_fp8(yw, false), y23 = __builtin_amdgcn_cvt_pk_f32_fp8(yw, true);
            acc[j][0] += Y8_INV * y01[0]; acc[j][1] += Y8_INV * y01[1]; acc[j][2] += Y8_INV * y23[0]; acc[j][3] += Y8_INV * y23[1]; }
        f32x4 v[4]; float ss = 0.f;
#pragma unroll
        for (int j = 0; j < 4; ++j) { v[j] = xv0[j] + gvv[j] * acc[j];
            ss += (v[j][0] * v[j][0] + v[j][1] * v[j][1]) + (v[j][2] * v[j][2] + v[j][3] * v[j][3]); }
        if (l == NLAYER - 1) {
            const float rstd = rsqf_(wave_sum(ss, c.lane) * (1.0f / DM) + EPS);
#pragma unroll
            for (int j = 0; j < 4; ++j) { const f32x4 w4 = *(const f32x4*)(fw + 256 * j + 4 * c.lane); xr[64 * j] = v[j] * rstd * w4; }
        } else {
#pragma unroll
            for (int j = 0; j < 4; ++j) xr[64 * j] = v[j];
            norm_mix_row(c, v, ss, tok, p.in[I_NMIX] + (size_t)(l + 1) * DM, (const float*)(p.ws + WS_MOD) + (size_t)(l + 1) * 8 * NMOD, (const LAS float*)c.lds, (bf16_t*)(p.ws + WS_H), (float*)(p.ws + WS_DTRAW));
        }
    }
}


#define XB_TMO      128
#define XB_XCNT(j)  (256  + 64 * (j))
#define XB_XSUB(j)  (1280 + 64 * (j))
#define XB_XGEN(j)  (2304 + 64 * (j))
#define XB_TOP      3328
#define XB_TOPGEN   3392
#define XCD_BAR_WORDS 3456
#define XB_SPIN_CAP (1u << 18)
constexpr int LDS_XBST = LDS_PTAB + 320;
__device__ __forceinline__ unsigned xb_ld(unsigned* p)              { return __hip_atomic_load(p, __ATOMIC_RELAXED, __HIP_MEMORY_SCOPE_AGENT); }
__device__ __forceinline__ unsigned xb_add(unsigned* p, unsigned v) { return __hip_atomic_fetch_add(p, v, __ATOMIC_RELAXED, __HIP_MEMORY_SCOPE_AGENT); }
__device__ __forceinline__ unsigned xb_xcc_id() { return (unsigned)__builtin_amdgcn_s_getreg((3 << 11) | 20) & 0xFu; }
#define XB_SPIN(cond, bar) do { unsigned _sp = 0; while (cond) { __builtin_amdgcn_s_sleep(1); \
    if ((++_sp & 255u) == 0u) { if (xb_ld(&(bar)[XB_TMO])) break; if (_sp > XB_SPIN_CAP) { atomicAdd(&(bar)[XB_TMO], 1u); break; } } } } while (0)
__device__ __forceinline__ void xcd_barrier_complete(unsigned* bar, unsigned x, unsigned& nloc, unsigned& nx) {
    const unsigned G = gridDim.x * gridDim.y * gridDim.z;
    unsigned sum, cnt, mine, sp = 0u;
    for (;;) {
        sum = 0u; cnt = 0u; mine = 0u;
#pragma unroll
        for (unsigned j = 0; j < 16; ++j) { const unsigned c = xb_ld(&bar[XB_XCNT(j)]); sum += c; cnt += (c > 0u) ? 1u : 0u; mine = (j == x) ? c : mine; }
        if (sum == G) break;
        __builtin_amdgcn_s_sleep(1);
        if ((++sp & 255u) == 0u) { if (xb_ld(&bar[XB_TMO])) break; if (sp > XB_SPIN_CAP) { atomicAdd(&bar[XB_TMO], 1u); break; } }
    }
    nloc = mine > 0u ? mine : 1u; nx = cnt > 0u ? cnt : 1u;
}
__device__ __forceinline__ void xcd_barrier(unsigned* bar, volatile LAS unsigned* st, bool leader_thread) {
    asm volatile("s_waitcnt vmcnt(0)" ::: "memory");
    __syncthreads();
    if (leader_thread) {
        const unsigned x = xb_xcc_id();
        __builtin_amdgcn_s_waitcnt(0);
        unsigned nloc = st[0], nx = st[1];
        if (nloc == 0u) { xcd_barrier_complete(bar, x, nloc, nx); st[0] = nloc; st[1] = nx; }
        const unsigned old = xb_add(&bar[XB_XSUB(x)], 1u);
        const unsigned gen = old / nloc;
        if (old + 1u == (gen + 1u) * nloc) {
            __builtin_amdgcn_fence(__ATOMIC_RELEASE, "agent");
            asm volatile("s_waitcnt vmcnt(0)" ::: "memory");
            const unsigned og = xb_add(&bar[XB_TOP], 1u);
            const unsigned tg = og / nx;
            if (og + 1u == (tg + 1u) * nx) xb_add(&bar[XB_TOPGEN], 1u);
            else XB_SPIN(xb_ld(&bar[XB_TOPGEN]) == tg, bar);
            __builtin_amdgcn_fence(__ATOMIC_ACQUIRE, "agent");
            xb_add(&bar[XB_XGEN(x)], 1u);
            asm volatile("s_waitcnt vmcnt(0)" ::: "memory");
        } else {
            XB_SPIN(xb_ld(&bar[XB_XGEN(x)]) == gen, bar);
            __builtin_amdgcn_fence(__ATOMIC_ACQUIRE, "agent");
            asm volatile("s_waitcnt vmcnt(0)" ::: "memory");
        }
    }
    __syncthreads();
}

#ifndef PROBE_ID
#define PROBE_ID 0
#endif
#define RUN(id, stmt) do { stmt; if constexpr (PROBE_ID == (id)) { __syncthreads(); stmt; } } while (0)
constexpr int NQ_PHASE = 14;
__device__ __forceinline__ unsigned long long uni64(unsigned long long v) {
    const unsigned lo = (unsigned)__builtin_amdgcn_readfirstlane((int)(unsigned)v), hi = (unsigned)__builtin_amdgcn_readfirstlane((int)(unsigned)(v >> 32)); return ((unsigned long long)hi << 32) | lo; }
#if MK_MEGA
__device__ __forceinline__ void params_to_lds(const Params& p, LAS unsigned char* lds) {
    LAS unsigned long long* tab = (LAS unsigned long long*)(lds + LDS_PTAB);
#pragma unroll
    for (int i = 0; i < 33; ++i) tab[i] = (unsigned long long)p.in[i];
    tab[33] = (unsigned long long)p.out; tab[34] = (unsigned long long)p.ws;
}
__device__ __forceinline__ Params params_from_lds(LAS unsigned char* lds) {
    const LAS unsigned long long* tab = (const LAS unsigned long long*)(lds + LDS_PTAB);
    Params p;
#pragma unroll
    for (int i = 0; i < 33; ++i) p.in[i] = (const float*)(const __attribute__((address_space(1))) float*)uni64(tab[i]);
    p.out = (float*)(__attribute__((address_space(1))) float*)uni64(tab[33]); p.ws = (unsigned char*)(__attribute__((address_space(1))) unsigned char*)uni64(tab[34]); p.layer = 0; p.pad = 0;
    return p;
}
#endif
template <int Q> __device__ __forceinline__ void run_q(const Params& p_in, const Ctx& c_in, int l) {
    Ctx c = c_in;
    asm volatile("" : "+s"(c.wave), "+s"(c.bid), "+s"(c.G), "+s"(l));
    c.lane = fresh_lane(); c.tid = c.wave * 64 + c.lane;
#if MK_MEGA
    const Params p = params_from_lds(c.lds);
#else
    const Params& p = p_in;
#endif
    const float* xin = (l == 0) ? p.in[I_X] : p.out;
    if constexpr (Q == 14) { RUN(1, phase_prep_io(p, c); __syncthreads(); phase_prep_small(p, c)); __syncthreads(); RUN(2, phase_prep_experts(p, c, 0)); }
    if constexpr (Q == 0) { RUN(3, phase_norm_mix(p, c, l, xin)); }
    if constexpr (Q == 1) { pg8::Gemm g{(const bf16_t*)(p.ws + WS_H), (const bf16_t*)(p.ws + WS_WIN) + (size_t)l * NU * DM, DM, 0};
              pg8::DenseOrder S; S.init(NTOK, NU, c.G, c.bid); EpiU E{(bf16_t*)(p.ws + WS_U), NU};
              RUN(4, (pg8::gemm_phase<EpiU, pg8::DenseOrder, pg8::DenseRows, true, true>(c.lds, g, S, E, pg8::DenseRows(), c.wave))); }
    if constexpr (Q == 2) { RUN(5, phase_ssd_conv(p, c, l)); __syncthreads(); RUN(6, phase_hg_state(p, c, l)); __syncthreads(); RUN(7, phase_lru1(p, c, l)); }
    if constexpr (Q == 3) { RUN(8, phase_ssd_state(p, c)); __syncthreads(); phase_hg_scan(p, c); __syncthreads(); RUN(9, phase_lru2(p, c, l)); }
    if constexpr (Q == 4) { phase_ssd_scan(p, c); __syncthreads(); RUN(10, phase_hg_out(p, c, l)); }
    if constexpr (Q == 5) RUN(11, phase_ssd_out_g(p, c, l));
    if constexpr (Q == 7) { pg8::Gemm g{(const bf16_t*)(p.ws + WS_YCAT), (const bf16_t*)(p.ws + WS_WOUT) + (size_t)l * DM * 2048, 2048, 0};
              pg8::DenseOrder S; S.init(NTOK, DM, c.G, c.bid); EpiOut E{xin, p.out, (const float*)(p.ws + WS_MOD) + (size_t)l * 8 * NMOD + 2048};
              pg8::gemm_phase<EpiOut, pg8::DenseOrder, pg8::DenseRows, false, true>(c.lds, g, S, E, pg8::DenseRows(), c.wave);
              if constexpr (PROBE_ID == 13) { if (l == 0) { __syncthreads(); pg8::gemm_phase<EpiOut, pg8::DenseOrder, pg8::DenseRows, false, true>(c.lds, g, S, E, pg8::DenseRows(), c.wave); } } }
    if constexpr (Q == 8) RUN(14, phase_norm_router(p, c, l, p.out));
    if constexpr (Q == 9) RUN(15, phase_route_assign(p, c));
    if constexpr (Q == 11) { pg8::Gemm g{(const bf16_t*)(p.ws + WS_H), (const bf16_t*)(p.ws + WS_GU), DM, (size_t)512 * DM * 2};
               moe_build_units(c.lds, (const int*)(p.ws + WS_RINFO), 2, c.G, (c.G % 8 == 0) ? (c.bid % 8) * (c.G / 8) + c.bid / 8 : c.bid, c.tid);
               MoeOrder S{(const LAS int*)(c.lds + LDS_UTAB)}; EpiH E{(bf16_t*)(p.ws + WS_HMID)};
               GatherRows AM{(const int*)(p.ws + WS_SLOTTOK), (const int*)(p.ws + WS_RINFO)};
               RUN(16, (pg8::gemm_phase<EpiH, MoeOrder, GatherRows, true, true>(c.lds, g, S, E, AM, c.wave))); }
    if constexpr (Q == 12) { pg8::Gemm g{(const bf16_t*)(p.ws + WS_HMID), (const bf16_t*)(p.ws + WS_DN), 256, (size_t)DM * 256 * 2};
               moe_build_units(c.lds, (const int*)(p.ws + WS_RINFO), 4, c.G, (c.G % 8 == 0) ? (c.bid % 8) * (c.G / 8) + c.bid / 8 : c.bid, c.tid);
               MoeOrder S{(const LAS int*)(c.lds + LDS_UTAB)};
               EpiY E{(unsigned char*)(p.ws + WS_Y), (unsigned char*)(p.ws + WS_YSH), (const int*)(p.ws + WS_RINFO)};
               RUN(17, (pg8::gemm_phase<EpiY, MoeOrder, pg8::DenseRows, true, true>(c.lds, g, S, E, pg8::DenseRows(), c.wave))); }
    if constexpr (Q == 13) { phase_combine(p, c, l); if (l + 1 < NLAYER) { __syncthreads(); RUN(2, phase_prep_experts(p, c, l + 1)); } }
}

#if MK_MEGA
__global__ void __launch_bounds__(NTHREADS, 2) trunk_kernel(Params p) {
    extern __shared__ __attribute__((aligned(16))) unsigned char lds_raw[];
    Ctx c; c.lds = (LAS unsigned char*)lds_raw; c.tid = 0; c.lane = 0; c.wave = __builtin_amdgcn_readfirstlane(threadIdx.x >> 6); c.G = gridDim.x; c.bid = blockIdx.x;
    cg::grid_group grid = cg::this_grid();
    unsigned* const xbar = (unsigned*)(p.ws + WS_CTL) + 4096;
    if (threadIdx.x == 0) { params_to_lds(p, c.lds); ((LAS unsigned*)(c.lds + LDS_XBST))[0] = 0u; ((LAS unsigned*)(c.lds + LDS_XBST))[1] = 0u; ((LAS unsigned long long*)(c.lds + LDS_PTAB))[35] = (unsigned long long)xbar;
                            (void)xb_add(&xbar[XB_XCNT(xb_xcc_id())], 1u); }
    __syncthreads();
#define GSYNC1() do { unsigned* bar_ = (unsigned*)(__attribute__((address_space(1))) unsigned*)uni64(((const LAS unsigned long long*)(c.lds + LDS_PTAB))[35]); \
        xcd_barrier(bar_, (volatile LAS unsigned*)(c.lds + LDS_XBST), (c.wave == 0) && (fresh_lane() == 0)); } while (0)
#define GSYNC() do { GSYNC1(); if constexpr (PROBE_ID == 18) GSYNC1(); } while (0)
#define LAYER(l) do { \
        if ((l) == 0) { run_q<0>(p, c, l); GSYNC(); } run_q<1>(p, c, l); GSYNC(); run_q<2>(p, c, l); GSYNC(); run_q<3>(p, c, l); GSYNC(); run_q<4>(p, c, l); GSYNC(); \
        run_q<5>(p, c, l); GSYNC(); run_q<7>(p, c, l); GSYNC(); run_q<8>(p, c, l); GSYNC(); run_q<9>(p, c, l); GSYNC(); \
        run_q<11>(p, c, l); GSYNC(); run_q<12>(p, c, l); GSYNC(); run_q<13>(p, c, l); } while (0)
    run_q<14>(p, c, 0); __syncthreads(); grid.sync();
    LAYER(0); GSYNC();
    LAYER(1);
}
#else
template <int Q> __global__ void __launch_bounds__(NTHREADS, 2) phase_kernel(Params p) {
    extern __shared__ __attribute__((aligned(16))) unsigned char lds_raw[];
    Ctx c; c.lds = (LAS unsigned char*)lds_raw; c.tid = 0; c.lane = 0; c.wave = __builtin_amdgcn_readfirstlane(threadIdx.x >> 6); c.G = gridDim.x; c.bid = blockIdx.x;
    run_q<Q>(p, c, p.layer);
}
template <int Q> static void launch_q(const Params& p, int grid, hipStream_t stream) {
    static bool attr = false;
    if (!attr) { (void)hipFuncSetAttribute((const void*)phase_kernel<Q>, hipFuncAttributeMaxDynamicSharedMemorySize, LDS_BYTES); attr = true; }
    hipLaunchKernelGGL(phase_kernel<Q>, dim3(grid), dim3(NTHREADS), LDS_BYTES, stream, p);
}
#endif

extern "C" void kernel_launch(void* const* d_in, const int* in_sizes, int n_in, void* d_out, int out_size, void* d_ws, size_t ws_size, hipStream_t stream) {
    static int grid = 0;
    if (grid == 0) {
        if (n_in != 33 || out_size != NTOK * DM || ws_size < WS_END) { fprintf(stderr, "kernel_launch: unexpected shapes (n_in %d out %d ws %zu)\n", n_in, out_size, ws_size); grid = -1; return; }
        int dev = 0, cus = 0;
        (void)hipGetDevice(&dev); (void)hipDeviceGetAttribute(&cus, hipDeviceAttributeMultiprocessorCount, dev);
        grid = cus > 0 ? cus : 256;
#if MK_MEGA
        int per_cu = 0;
        if (hipFuncSetAttribute((const void*)trunk_kernel, hipFuncAttributeMaxDynamicSharedMemorySize, LDS_BYTES) != hipSuccess) { fprintf(stderr, "kernel_launch: hipFuncSetAttribute failed\n"); grid = -1; return; }
        if (hipOccupancyMaxActiveBlocksPerMultiprocessor(&per_cu, (const void*)trunk_kernel, NTHREADS, LDS_BYTES) != hipSuccess || per_cu < 1) { fprintf(stderr, "kernel_launch: occupancy query says %d blocks/CU\n", per_cu); grid = -1; return; }
        (void)hipGetLastError();
#endif
    }
    if (grid < 0) return;
    (void)hipMemsetAsync((char*)d_ws + WS_CTL, 0, CTL_ZERO_BYTES, stream);
    Params p{};
    for (int i = 0; i < 33; ++i) p.in[i] = (const float*)d_in[i];
    p.out = (float*)d_out; p.ws = (unsigned char*)d_ws;
#if MK_MEGA
    void* args[] = {&p};
    hipError_t e = hipLaunchCooperativeKernel((const void*)trunk_kernel, dim3(grid), dim3(NTHREADS), args, LDS_BYTES, stream);
    if (e != hipSuccess) fprintf(stderr, "cooperative launch failed: %s (grid %d)\n", hipGetErrorString(e), grid);
#else
    p.layer = 0; launch_q<14>(p, grid, stream);
    for (int l = 0; l < NLAYER; ++l) {
        p.layer = l;
        launch_q<0>(p, grid, stream); launch_q<1>(p, grid, stream); launch_q<2>(p, grid, stream); launch_q<3>(p, grid, stream); launch_q<4>(p, grid, stream);
        launch_q<5>(p, grid, stream); launch_q<6>(p, grid, stream); launch_q<7>(p, grid, stream); launch_q<8>(p, grid, stream); launch_q<9>(p, grid, stream);
        launch_q<10>(p, grid, stream); launch_q<11>(p, grid, stream); launch_q<12>(p, grid, stream); launch_q<13>(p, grid, stream);
    }
#endif
}
```

```cpp
#include <hip/hip_runtime.h>
#include <hip/hip_cooperative_groups.h>
#include <cstdio>
#include <cstdint>
namespace cg = cooperative_groups;

#ifndef MK_MEGA
#define MK_MEGA 1
#endif

#define LAS __attribute__((address_space(3)))
typedef unsigned short bf16_t;
typedef short bf16x8 __attribute__((ext_vector_type(8)));
typedef float f32x4 __attribute__((ext_vector_type(4)));
typedef float f32x2 __attribute__((ext_vector_type(2)));
typedef unsigned u32x4 __attribute__((ext_vector_type(4)));
typedef unsigned u32x2 __attribute__((ext_vector_type(2)));

constexpr int NTOK = 16384, DM = 1024, SEQ = 2048, NBATCH = 8, NLAYER = 2;
constexpr int DIN = 5648, NU = 5632;
constexpr int UZ = 0, UXS = 1024, UB = 2048, UC = 2304, UHQ = 2560, UHF = 3072, UHV = 3584, UHG = 4096, ULG = 4608, ULX = 5120;
constexpr int NMOD = 6144;
constexpr float EPS = 1e-6f;
constexpr int NEXP = 64, TOPK = 8;
constexpr int MAXSLOT = 147456;
constexpr int NTHREADS = 512, NWAVES = 8;
constexpr int LDS_BYTES = 160 * 1024;
constexpr int LDS_PTAB = LDS_BYTES - 512;

constexpr size_t MiB = (size_t)1 << 20;
constexpr size_t WS_CTL = 0, CTL_ZERO_BYTES = 1 * MiB;
constexpr size_t WS_MOD = 1 * MiB;
constexpr size_t WS_LB = WS_MOD + 512 * 1024;
constexpr size_t WS_LRUW = WS_LB + 8192;
constexpr size_t WS_DTRAW = 2 * MiB, WS_DT = 3 * MiB, WS_ACUM = 4 * MiB;
constexpr size_t WS_HGBL = 5 * MiB;
constexpr size_t WS_SELM = 5 * MiB + 512 * 1024;
constexpr size_t WS_RW = 6 * MiB;
constexpr size_t WS_SLOTOF = 6 * MiB + 512 * 1024;
constexpr size_t WS_SLOTTOK = 7 * MiB;
constexpr size_t WS_RINFO = 7 * MiB + 768 * 1024;
constexpr size_t WS_CNT = 8 * MiB;
constexpr size_t WS_WRT = 9 * MiB;
constexpr size_t WS_WIN = 12 * MiB;
constexpr size_t WS_WOUT = 34 * MiB;
constexpr size_t WS_GU = 42 * MiB;
constexpr size_t WS_DN = 107 * MiB;
constexpr size_t WS_H = 140 * MiB;
constexpr size_t WS_U = 172 * MiB;
constexpr size_t WS_SST = 348 * MiB;
constexpr size_t WS_HST = 380 * MiB;
constexpr size_t WS_LA = 412 * MiB, WS_LH = 428 * MiB;
constexpr size_t WS_XBC = 444 * MiB;
constexpr size_t WS_YCAT = 492 * MiB;
constexpr size_t WS_HMID = 172 * MiB;
constexpr size_t WS_Y = 252 * MiB;
constexpr size_t WS_YSH = WS_Y + 160 * MiB;
constexpr size_t WS_END = 556 * MiB;

__device__ __forceinline__ float bf2f(bf16_t b) { return __uint_as_float(((unsigned)b) << 16); }
typedef __bf16 bf16x2_hw __attribute__((ext_vector_type(2)));
__device__ __forceinline__ unsigned pk2(float lo, float hi) { f32x2 v = {lo, hi}; bf16x2_hw b = __builtin_convertvector(v, bf16x2_hw); return __builtin_bit_cast(unsigned, b); }
__device__ __forceinline__ unsigned f2bf(float f) { return pk2(f, 0.f) & 0xffffu; }
constexpr float Y8_SCALE = 16.0f, Y8_INV = 1.0f / 16.0f;
__device__ __forceinline__ unsigned pk4_fp8(float a, float b, float c2, float d) { int w = 0; w = __builtin_amdgcn_cvt_pk_fp8_f32(a, b, w, false); w = __builtin_amdgcn_cvt_pk_fp8_f32(c2, d, w, true); return (unsigned)w; }
__device__ __forceinline__ float lo_bf(unsigned w) { return __uint_as_float(w << 16); }
__device__ __forceinline__ float hi_bf(unsigned w) { return __uint_as_float(w & 0xffff0000u); }
__device__ __forceinline__ float rcpf_(float x) { return __builtin_amdgcn_rcpf(x); }
__device__ __forceinline__ float rsqf_(float x) { return __builtin_amdgcn_rsqf(x); }
__device__ __forceinline__ float sigmoidf_(float x) { return rcpf_(1.0f + __expf(-x)); }
__device__ __forceinline__ float siluf_(float x) { return x * rcpf_(1.0f + __expf(-x)); }
__device__ __forceinline__ float softplusf_(float x) { return fmaxf(x, 0.f) + log1pf(__expf(-fabsf(x))); }
__device__ __forceinline__ float gelu_tanhf_(float x) { const float u = 0.7978845608028654f * (x + 0.044715f * x * x * x); const float t = 1.0f - 2.0f * rcpf_(1.0f + __expf(2.0f * u)); return 0.5f * x * (1.0f + t); }
__device__ __forceinline__ float shfl_xor_l(float v, int mask, int lane) { return __builtin_bit_cast(float, __builtin_amdgcn_ds_bpermute((lane ^ mask) << 2, __builtin_bit_cast(int, v))); }
__device__ __forceinline__ int shfl_up_l(int v, int d, int lane) { return __builtin_amdgcn_ds_bpermute((lane - d) << 2, v); }
__device__ __forceinline__ float shfl_up_f(float v, int d, int lane) { return __builtin_bit_cast(float, __builtin_amdgcn_ds_bpermute((lane - d) << 2, __builtin_bit_cast(int, v))); }
__device__ __forceinline__ float rdlane_f(float v, int src) { return __builtin_bit_cast(float, __builtin_amdgcn_readlane(__builtin_bit_cast(int, v), src)); }
__device__ __forceinline__ unsigned long long rdlane_u64(unsigned long long v, int src) {
    const unsigned lo = (unsigned)__builtin_amdgcn_readlane((int)(unsigned)v, src), hi = (unsigned)__builtin_amdgcn_readlane((int)(unsigned)(v >> 32), src); return ((unsigned long long)hi << 32) | lo; }
__device__ __forceinline__ float wave_sum(float v, int lane) {
#pragma unroll
    for (int o = 1; o < 64; o <<= 1) v += shfl_xor_l(v, o, lane);
    return v;
}
#define LDS_WAIT() asm volatile("s_waitcnt lgkmcnt(0)" ::: "memory")
__device__ __forceinline__ int fresh_lane() { unsigned ones = ~0u; asm volatile("" : "+s"(ones)); return (int)__builtin_amdgcn_mbcnt_hi(ones, __builtin_amdgcn_mbcnt_lo(ones, 0u)); }
#define LDS_BARRIER() do { asm volatile("s_waitcnt lgkmcnt(0)" ::: "memory"); __builtin_amdgcn_s_barrier(); asm volatile("" ::: "memory"); } while (0)
#define MFMA16(a, b, c) __builtin_amdgcn_mfma_f32_16x16x32_bf16((a), (b), (c), 0, 0, 0)
typedef short s16x4 __attribute__((ext_vector_type(4)));
__device__ __forceinline__ bf16x8 tr_frag(const LAS bf16_t* img, int ld, int k0, int c0, int lane) {
    const int g = lane >> 4, q = (lane & 15) >> 2, pp = lane & 3;
    const LAS bf16_t* a0 = img + (k0 + 8 * g + q) * ld + c0 + 4 * pp;
    const s16x4 r0 = __builtin_amdgcn_ds_read_tr16_b64_v4i16((LAS s16x4*)a0);
    const s16x4 r1 = __builtin_amdgcn_ds_read_tr16_b64_v4i16((LAS s16x4*)(a0 + 4 * ld));
    return (bf16x8){r0[0], r0[1], r0[2], r0[3], r1[0], r1[1], r1[2], r1[3]};
}

namespace pg8 {
constexpr int BM = 256, BK = 64, HALF = 128, HTB = HALF * BK * 2, STAGE_BYTES = 8 * HTB, NXCD = 8, WGM = 8;
__device__ __forceinline__ int lds_byte(int r, int c) { const int st = (r >> 4) * 2 + (c >> 5), rr = r & 15, cc = c & 31, ob = rr * 64 + cc * 2; return st * 1024 + (ob ^ (((ob >> 9) & 1) << 5)); }
__device__ __forceinline__ void stage_rc(int b, int& R, int& C) { const int st = b / 1024, sb = b % 1024, swz = sb ^ (((sb >> 9) & 1) << 5); R = (st >> 1) * 16 + swz / 64; C = (st & 1) * 32 + (swz % 64) / 2; }
__device__ __forceinline__ int perm32(int rho) { const int n = rho >> 4, i = rho & 15; return 8 * (i >> 2) + 4 * n + (i & 3); }

struct Unit { int pm, pn, e; };
struct Gemm { const bf16_t* A; const bf16_t* Bt; int K; size_t estride; };

struct DenseOrder {
    int nM, nN, nwg, G, c;
    __device__ void init(int M, int N, int G_, int c_) { nM = M / BM; nN = N / BM; nwg = nM * nN; G = G_; c = c_; }
    __device__ bool next(int i, Unit& u) const {
        const long L = (long)i * G + c; if (L >= nwg) return false;
        int wgid = (int)L; { const int q = nwg / NXCD, r = nwg % NXCD, xcd = wgid % NXCD, off = wgid / NXCD; wgid = (xcd < r ? xcd * (q + 1) : r * (q + 1) + (xcd - r) * q) + off; }
        const int nig = WGM * nN, gid = wgid / nig, fm = gid * WGM, gsz = (nM - fm) < WGM ? (nM - fm) : WGM;
        u.pm = fm + ((wgid % nig) % gsz); u.pn = (wgid % nig) / gsz; u.e = 0; return true;
    }
};
struct DenseRows { __device__ __forceinline__ int row(const Unit& u, int r) const { return u.pm * BM + r; } };

template <class Epi, class Sched, class AMap, bool ALIGN_EPI, bool SP2>
__device__ __forceinline__ void gemm_phase(LAS unsigned char* lds, const Gemm g, const Sched& S, const Epi& E, const AMap& AM, int wave_id) {
    const int wid = wave_id, lane = fresh_lane(), tid = wid * 64 + lane, wr = wid >> 2, wc = wid & 3, fr = lane & 15, fq = lane >> 4;
    const int K = g.K, nt = K / BK;
    unsigned voffB0;
    { int R, C; stage_rc(tid * 16, R, C); const int Rb = Epi::PERM ? ((R & ~31) + perm32(R & 31)) : R; voffB0 = (unsigned)(Rb * K + C) * 2u; }
    const size_t p1step = (size_t)64 * K * 2;
    const size_t kstep = (size_t)(BK * 2);
    const size_t hstep = (size_t)HALF * K * 2;
    const size_t tstep = 2 * hstep;
    const unsigned ldsw = (unsigned)wid * 1024u;
    const int aoff = lds_byte(wr * 64 + fr, fq * 8), boff = lds_byte(wc * 32 + fr, fq * 8);
#define PG8_SA(b, h) (((b) * 2 + (h)) * HTB)
#define PG8_SB(b, h) ((4 + (b) * 2 + (h)) * HTB)
#define PG8_STAGE2(bufoff, gbase, v0, v1) do { \
        __builtin_amdgcn_global_load_lds((const unsigned*)((const char*)(gbase) + (v0)), (LAS unsigned*)(lds + (bufoff) + ldsw), 16, 0, 0); \
        __builtin_amdgcn_global_load_lds((const unsigned*)((const char*)(gbase) + (v1)), (LAS unsigned*)(lds + (bufoff) + ldsw + 8192), 16, 0, 0); } while (0)
#define PG8_STAGEB(bufoff, gbase) do { \
        __builtin_amdgcn_global_load_lds((const unsigned*)((const char*)(gbase) + voffB0), (LAS unsigned*)(lds + (bufoff) + ldsw), 16, 0, 0); \
        __builtin_amdgcn_global_load_lds((const unsigned*)((const char*)(gbase) + p1step + voffB0), (LAS unsigned*)(lds + (bufoff) + ldsw + 8192), 16, 0, 0); } while (0)
#define PG8_LDA(dst, b, h) do { _Pragma("unroll") for (int m = 0; m < 4; ++m) _Pragma("unroll") for (int k = 0; k < 2; ++k) dst[m][k] = *(const LAS bf16x8*)(lds + PG8_SA(b, h) + aoff + m * 2048 + k * 1024); } while (0)
#define PG8_LDB(dst, b, h) do { _Pragma("unroll") for (int n = 0; n < 2; ++n) _Pragma("unroll") for (int k = 0; k < 2; ++k) dst[n][k] = *(const LAS bf16x8*)(lds + PG8_SB(b, h) + boff + n * 2048 + k * 1024); } while (0)
#define PG8_MMA(ai, bj, At, Bt) do { __builtin_amdgcn_s_setprio(1); _Pragma("unroll") for (int m = 0; m < 4; ++m) _Pragma("unroll") for (int n = 0; n < 2; ++n) _Pragma("unroll") for (int k = 0; k < 2; ++k) \
        acc[ai][bj][m][n] = __builtin_amdgcn_mfma_f32_16x16x32_bf16(Bt[n][k], At[m][k], acc[ai][bj][m][n], 0, 0, 0); __builtin_amdgcn_s_setprio(0); } while (0)
#define PG8_WAIT_V(n) asm volatile("s_waitcnt vmcnt(" #n ")" ::: "memory")
#define PG8_WAIT_L(n) asm volatile("s_waitcnt lgkmcnt(" #n ")" ::: "memory")
#define PG8_BAR __builtin_amdgcn_s_barrier()
#define PG8_SCHED __builtin_amdgcn_sched_barrier(0)
#define PG8_AOFFS(u, v00, v01, v10, v11) do { int R_, C_; stage_rc(tid * 16, R_, C_); \
        v00 = (unsigned)(AM.row(u, R_) * K + C_) * 2u; v01 = (unsigned)(AM.row(u, R_ + 64) * K + C_) * 2u; \
        v10 = (unsigned)(AM.row(u, HALF + R_) * K + C_) * 2u; v11 = (unsigned)(AM.row(u, HALF + R_ + 64) * K + C_) * 2u; } while (0)
    Unit cur, nxt; int ui = 0;
    if (!S.next(0, cur)) return;
    f32x4 acc[2][2][4][2];
#pragma unroll
    for (int a = 0; a < 2; ++a)
#pragma unroll
        for (int b = 0; b < 2; ++b)
#pragma unroll
            for (int m = 0; m < 4; ++m)
#pragma unroll
                for (int n = 0; n < 2; ++n) acc[a][b][m][n] = (f32x4){0.f, 0.f, 0.f, 0.f};
    bf16x8 At[4][2], B0[2][2], B1[2][2];
    const char* const Abase = (const char*)g.A;
    const char* cB = (const char*)g.Bt + (size_t)cur.e * g.estride + (size_t)cur.pn * tstep;
    unsigned c00, c01, c10, c11, n00, n01, n10, n11;
    PG8_AOFFS(cur, c00, c01, c10, c11);
    n00 = c00; n01 = c01; n10 = c10; n11 = c11;
    if constexpr (SP2) {
        PG8_STAGEB(PG8_SB(0, 0), cB); PG8_STAGEB(PG8_SB(0, 1), cB + hstep); PG8_STAGE2(PG8_SA(0, 0), Abase, c00, c01); PG8_STAGE2(PG8_SA(0, 1), Abase, c10, c11);
        if (wr == 1) PG8_BAR;
        PG8_WAIT_V(2); PG8_BAR;
        PG8_STAGEB(PG8_SB(1, 0), cB + kstep); PG8_STAGE2(PG8_SA(1, 0), Abase + kstep, c00, c01); PG8_STAGEB(PG8_SB(1, 1), cB + hstep + kstep);
        PG8_WAIT_V(6); PG8_BAR;
    } else {
        PG8_STAGEB(PG8_SB(0, 0), cB); PG8_STAGE2(PG8_SA(0, 0), Abase, c00, c01); PG8_STAGEB(PG8_SB(0, 1), cB + hstep); PG8_STAGE2(PG8_SA(0, 1), Abase, c10, c11);
        if (wr == 1) PG8_BAR;
        PG8_WAIT_V(4); PG8_BAR;
        PG8_STAGEB(PG8_SB(1, 0), cB + kstep); PG8_STAGE2(PG8_SA(1, 0), Abase + kstep, c00, c01); PG8_STAGEB(PG8_SB(1, 1), cB + hstep + kstep);
        PG8_WAIT_V(6); PG8_BAR;
    }
    for (;;) {
        const bool has_next = S.next(ui + 1, nxt);
        const char* nB = cB;
        if (has_next) { nB = (const char*)g.Bt + (size_t)nxt.e * g.estride + (size_t)nxt.pn * tstep; PG8_AOFFS(nxt, n00, n01, n10, n11); }
        else { n00 = c00; n01 = c01; n10 = c10; n11 = c11; }
        for (int t = 0; t < nt; t += 2) {
            const bool last = (t == nt - 2);
            const char* a1 = Abase + (size_t)(t + 1) * kstep;
            const char* a2 = last ? Abase : Abase + (size_t)(t + 2) * kstep;
            const char* b2 = last ? nB : cB + (size_t)(t + 2) * kstep;
            const char* a3 = a2 + kstep; const char* b3 = b2 + kstep;
            const unsigned x00 = last ? n00 : c00, x01 = last ? n01 : c01, x10 = last ? n10 : c10, x11 = last ? n11 : c11;
            if constexpr (SP2) {
            PG8_LDB(B0, 0, 0); PG8_LDB(B1, 0, 1); PG8_SCHED; PG8_LDA(At, 0, 0); PG8_STAGE2(PG8_SA(1, 1), a1, c10, c11);
            PG8_WAIT_V(8); PG8_WAIT_L(0); PG8_BAR; PG8_MMA(0, 0, At, B0); PG8_MMA(0, 1, At, B1); PG8_BAR; PG8_SCHED;
            PG8_LDA(At, 0, 1); PG8_STAGEB(PG8_SB(0, 0), b2); PG8_STAGEB(PG8_SB(0, 1), b2 + hstep); PG8_STAGE2(PG8_SA(0, 0), a2, x00, x01);
            PG8_WAIT_V(8); PG8_WAIT_L(0); PG8_BAR; PG8_MMA(1, 0, At, B0); PG8_MMA(1, 1, At, B1); PG8_BAR; PG8_SCHED;
            PG8_LDB(B0, 1, 0); PG8_LDB(B1, 1, 1); PG8_SCHED; PG8_LDA(At, 1, 0); PG8_STAGE2(PG8_SA(0, 1), a2, x10, x11);
            PG8_WAIT_V(8); PG8_WAIT_L(0); PG8_BAR; PG8_MMA(0, 0, At, B0); PG8_MMA(0, 1, At, B1); PG8_BAR; PG8_SCHED;
            PG8_LDA(At, 1, 1); PG8_STAGEB(PG8_SB(1, 0), b3); PG8_STAGEB(PG8_SB(1, 1), b3 + hstep); PG8_STAGE2(PG8_SA(1, 0), a3, x00, x01);
            PG8_WAIT_V(8); PG8_WAIT_L(0); PG8_BAR; PG8_MMA(1, 0, At, B0); PG8_MMA(1, 1, At, B1); PG8_BAR; PG8_SCHED;
            } else {
            PG8_LDB(B0, 0, 0); PG8_SCHED; PG8_LDA(At, 0, 0); PG8_STAGE2(PG8_SA(1, 1), a1, c10, c11);
            PG8_WAIT_L(8); PG8_BAR; PG8_WAIT_L(0); PG8_MMA(0, 0, At, B0); PG8_BAR; PG8_SCHED;
            PG8_LDB(B1, 0, 1); PG8_STAGEB(PG8_SB(0, 0), b2);
            PG8_BAR; PG8_WAIT_L(0); PG8_MMA(0, 1, At, B1); PG8_BAR;
            PG8_LDA(At, 0, 1); PG8_STAGE2(PG8_SA(0, 0), a2, x00, x01);
            PG8_BAR; PG8_WAIT_L(0); PG8_MMA(1, 0, At, B0); PG8_BAR; PG8_SCHED;
            PG8_STAGEB(PG8_SB(0, 1), b2 + hstep);
            PG8_WAIT_V(6); PG8_BAR; PG8_MMA(1, 1, At, B1); PG8_BAR;
            PG8_LDB(B0, 1, 0); PG8_SCHED; PG8_LDA(At, 1, 0); PG8_STAGE2(PG8_SA(0, 1), a2, x10, x11);
            PG8_WAIT_L(8); PG8_BAR; PG8_WAIT_L(0); PG8_MMA(0, 0, At, B0); PG8_BAR; PG8_SCHED;
            PG8_LDB(B1, 1, 1); PG8_STAGEB(PG8_SB(1, 0), b3);
            PG8_BAR; PG8_WAIT_L(0); PG8_MMA(0, 1, At, B1); PG8_BAR;
            PG8_LDA(At, 1, 1); PG8_STAGE2(PG8_SA(1, 0), a3, x00, x01);
            PG8_BAR; PG8_WAIT_L(0); PG8_MMA(1, 0, At, B0); PG8_BAR; PG8_SCHED;
            PG8_STAGEB(PG8_SB(1, 1), b3 + hstep);
            PG8_WAIT_V(6); PG8_BAR; PG8_MMA(1, 1, At, B1); PG8_BAR;
            }
        }
        if constexpr (ALIGN_EPI) { if (wr == 0) PG8_BAR; }
        E(acc, cur, wr, wc);
        if (!has_next) break;
#pragma unroll
        for (int a = 0; a < 2; ++a)
#pragma unroll
            for (int b = 0; b < 2; ++b)
#pragma unroll
                for (int m = 0; m < 4; ++m)
#pragma unroll
                    for (int n = 0; n < 2; ++n) acc[a][b][m][n] = (f32x4){0.f, 0.f, 0.f, 0.f};
        cur = nxt; cB = nB; c00 = n00; c01 = n01; c10 = n10; c11 = n11; ++ui;
        if constexpr (ALIGN_EPI) { if (wr == 1) PG8_BAR; }
    }
    PG8_WAIT_V(0);
    if constexpr (!ALIGN_EPI) { if (wr == 0) PG8_BAR; }
    PG8_BAR;
#undef PG8_SA
#undef PG8_SB
#undef PG8_STAGE2
#undef PG8_STAGEB
#undef PG8_LDA
#undef PG8_LDB
#undef PG8_MMA
#undef PG8_WAIT_V
#undef PG8_WAIT_L
#undef PG8_BAR
#undef PG8_SCHED
#undef PG8_AOFFS
}
}

struct Params {
    const float* in[33];
    float* out;
    unsigned char* ws;
    int layer, pad;
};
enum { I_X = 0, I_C, I_ADAW, I_ADAB, I_NMIX, I_NFFN, I_WIN, I_SCW, I_SCB, I_SDTB, I_SALOG, I_SD, I_SNW, I_HLB, I_HNW, I_LCW, I_LCB, I_LWA, I_LBA, I_LWX, I_LBX, I_LLAM, I_LNW,
       I_WOUT, I_RW, I_RB, I_EG, I_EU, I_ED, I_SG, I_SU, I_SDN, I_FNW };

using pg8::Unit;
struct EpiU {
    static constexpr bool PERM = true;
    bf16_t* O; int ldc;
    __device__ __forceinline__ void operator()(const f32x4 (&acc)[2][2][4][2], const Unit& u, int wr, int wc) const {
        const int lane_ = fresh_lane(), fr = lane_ & 15, fq = lane_ >> 4;
        const int row0 = u.pm * 256 + wr * 64 + fr, col0 = u.pn * 256 + wc * 32 + 8 * fq;
#pragma unroll
        for (int ai = 0; ai < 2; ++ai)
#pragma unroll
            for (int m = 0; m < 4; ++m) { bf16_t* rowp = O + (size_t)(row0 + ai * 128 + m * 16) * ldc + col0;
#pragma unroll
                for (int bj = 0; bj < 2; ++bj) { const f32x4 v0 = acc[ai][bj][m][0], v1 = acc[ai][bj][m][1];
                    u32x4 w; w.x = pk2(v0[0], v0[1]); w.y = pk2(v0[2], v0[3]); w.z = pk2(v1[0], v1[1]); w.w = pk2(v1[2], v1[3]);
                    *(u32x4*)(rowp + bj * 128) = w; } }
    }
};
struct EpiOut {
    static constexpr bool PERM = false;
    const float* xin; float* xout; const float* gate;
    __device__ __forceinline__ void operator()(const f32x4 (&acc)[2][2][4][2], const Unit& u, int wr, int wc) const {
        const int lane_ = fresh_lane(), fr = lane_ & 15, fq = lane_ >> 4;
        const int row0 = u.pm * 256 + wr * 64 + fr, col0 = u.pn * 256 + wc * 32 + 4 * fq, b = u.pm >> 3;
        f32x4 gv[2][2];
#pragma unroll
        for (int bj = 0; bj < 2; ++bj)
#pragma unroll
            for (int n = 0; n < 2; ++n) gv[bj][n] = *(const f32x4*)(gate + (size_t)b * NMOD + col0 + bj * 128 + n * 16);
#pragma unroll
        for (int ai = 0; ai < 2; ++ai)
#pragma unroll
            for (int m = 0; m < 4; ++m) { const size_t off = (size_t)(row0 + ai * 128 + m * 16) * DM + col0;
#pragma unroll
                for (int bj = 0; bj < 2; ++bj)
#pragma unroll
                    for (int n = 0; n < 2; ++n) { const f32x4 xi = *(const f32x4*)(xin + off + bj * 128 + n * 16);
                        *(f32x4*)(xout + off + bj * 128 + n * 16) = xi + gv[bj][n] * acc[ai][bj][m][n]; }
                asm volatile("" ::: "memory"); }
    }
};
struct EpiH {
    static constexpr bool PERM = true;
    bf16_t* Hm;
    __device__ __forceinline__ void operator()(const f32x4 (&acc)[2][2][4][2], const Unit& u, int wr, int wc) const {
        const int lane_ = fresh_lane(), fr = lane_ & 15, fq = lane_ >> 4;
        const int row0 = u.pm * 256 + wr * 64 + fr, col0 = u.pn * 128 + wc * 32 + 8 * fq;
#pragma unroll
        for (int ai = 0; ai < 2; ++ai)
#pragma unroll
            for (int m = 0; m < 4; ++m) { bf16_t* rowp = Hm + (size_t)(row0 + ai * 128 + m * 16) * 256 + col0;
                f32x4 h0, h1;
#pragma unroll
                for (int j = 0; j < 4; ++j) { h0[j] = siluf_(acc[ai][0][m][0][j]) * acc[ai][1][m][0][j]; h1[j] = siluf_(acc[ai][0][m][1][j]) * acc[ai][1][m][1][j]; }
                u32x4 w; w.x = pk2(h0[0], h0[1]); w.y = pk2(h0[2], h0[3]); w.z = pk2(h1[0], h1[1]); w.w = pk2(h1[2], h1[3]);
                *(u32x4*)rowp = w; }
    }
};
struct EpiY {
    static constexpr bool PERM = true;
    unsigned char* Y; unsigned char* Ysh; const int* rinfo;
    __device__ __forceinline__ void operator()(const f32x4 (&acc)[2][2][4][2], const Unit& u, int wr, int wc) const {
        const int lane_ = fresh_lane(), fr = lane_ & 15, fq = lane_ >> 4;
        const int col0 = u.pn * 256 + wc * 32 + 8 * fq;
        unsigned char* base = Y + (size_t)u.pm * 256 * DM;
        if (u.e >= NEXP) base = Ysh + (size_t)(u.pm - rinfo[0]) * 256 * DM;
        base += (size_t)(wr * 64 + fr) * DM + col0;
#pragma unroll
        for (int ai = 0; ai < 2; ++ai)
#pragma unroll
            for (int m = 0; m < 4; ++m) { unsigned char* rowp = base + (size_t)(ai * 128 + m * 16) * DM;
#pragma unroll
                for (int bj = 0; bj < 2; ++bj) { const f32x4 v0 = acc[ai][bj][m][0] * Y8_SCALE, v1 = acc[ai][bj][m][1] * Y8_SCALE;
                    u32x2 w; w.x = pk4_fp8(v0[0], v0[1], v0[2], v0[3]); w.y = pk4_fp8(v1[0], v1[1], v1[2], v1[3]);
                    *(u32x2*)(rowp + bj * 128) = w; } }
    }
};
constexpr int LDS_UTAB = 131072, MAX_UNITS = 24;
__device__ __forceinline__ void moe_build_units(LAS unsigned char* lds, const int* rinfo, int NQ, int G, int cidx, int tid) {
    LAS int* tab = (LAS int*)(lds + LDS_UTAB);
    if (tid < MAX_UNITS) {
        const int nblk = rinfo[0]; const long L = (long)tid * G + cidx;
        int pm = -1, pn = 0, e = 0;
        if (L < (long)(nblk + 64) * NQ) { const int rb = (int)(L / NQ); pm = rb; pn = (int)(L % NQ); e = (rb < nblk) ? rinfo[64 + rb] : NEXP; }
        tab[tid * 4 + 0] = pm; tab[tid * 4 + 1] = pn; tab[tid * 4 + 2] = e; tab[tid * 4 + 3] = 0;
    }
    __syncthreads();
}
struct MoeOrder {
    const LAS int* tab;
    __device__ bool next(int i, Unit& u) const {
        if (i >= MAX_UNITS) return false;
        const int pm = __builtin_amdgcn_readfirstlane(tab[i * 4 + 0]); if (pm < 0) return false;
        u.pm = pm; u.pn = __builtin_amdgcn_readfirstlane(tab[i * 4 + 1]); u.e = __builtin_amdgcn_readfirstlane(tab[i * 4 + 2]); return true;
    }
};
struct GatherRows {
    const int* slot_tok; const int* rinfo;
    __device__ __forceinline__ int row(const Unit& u, int r) const {
        const int nblk = rinfo[0];
        if (u.pm < nblk) { const int t = slot_tok[u.pm * 256 + r]; return t < 0 ? 0 : t; }
        return (u.pm - nblk) * 256 + r;
    }
};

struct Ctx { LAS unsigned char* lds; int tid, lane, wave, G, bid; };

template <class RowMap>
__device__ __forceinline__ void transpose_item(const float* W, int N, int k0, int n0, bf16_t* WT, int ldk, const RowMap& rm, LAS float* scr, int lane) {
    const int nn = n0 + (lane & 31);
#pragma unroll 8
    for (int i = 0; i < 32; ++i) { const int kk = 2 * i + (lane >> 5); scr[kk * 33 + (lane & 31)] = (nn < N) ? W[(size_t)(k0 + kk) * N + nn] : 0.f; }
    LDS_WAIT();
    const int c = lane & 7;
#pragma unroll
    for (int j = 0; j < 4; ++j) { const int n = (lane >> 3) + 8 * j; const LAS float* s = scr + (8 * c) * 33 + n;
        u32x4 o; o.x = pk2(s[0 * 33], s[1 * 33]); o.y = pk2(s[2 * 33], s[3 * 33]); o.z = pk2(s[4 * 33], s[5 * 33]); o.w = pk2(s[6 * 33], s[7 * 33]);
        const int dr = (n0 + n < N) ? rm(n0 + n) : -1;
        if (dr >= 0) *(u32x4*)(WT + (size_t)dr * ldk + k0 + 8 * c) = o; }
    LDS_WAIT();
}
struct RmIdent { __device__ __forceinline__ int operator()(int n) const { return n; } };
struct RmWin { __device__ __forceinline__ int operator()(int n) const { return n < 2560 ? n : (n < 2576 ? -1 : n - 16); } };
struct RmGate { __device__ __forceinline__ int operator()(int n) const { return (n >> 7) * 256 + (n & 127); } };
struct RmUp { __device__ __forceinline__ int operator()(int n) const { return (n >> 7) * 256 + 128 + (n & 127); } };

__device__ __forceinline__ void phase_prep_io(const Params& p, const Ctx& c) {
    LAS float* scr = (LAS float*)(c.lds + c.wave * 16384);
    const int gw = c.bid * NWAVES + c.wave, NGW = c.G * NWAVES;
    constexpr int I_IN = 16 * 177, I_OUT = 32 * 32, PER_L = I_IN + I_OUT;
    for (int it = gw; it < NLAYER * PER_L; it += NGW) {
        const int l = it / PER_L; int r = it % PER_L;
        if (r < I_IN) { const int kb = r / 177, nb = r % 177;
            transpose_item(p.in[I_WIN] + (size_t)l * DM * DIN, DIN, kb * 64, nb * 32, (bf16_t*)(p.ws + WS_WIN) + (size_t)l * NU * DM, DM, RmWin(), scr, c.lane); }
        else { r -= I_IN; const int kb = r / 32, nb = r % 32;
            transpose_item(p.in[I_WOUT] + (size_t)l * 2048 * DM, DM, kb * 64, nb * 32, (bf16_t*)(p.ws + WS_WOUT) + (size_t)l * DM * 2048, 2048, RmIdent(), scr, c.lane); }
    }
}
__device__ __forceinline__ void phase_prep_experts(const Params& p, const Ctx& c, int l) {
    LAS float* scr = (LAS float*)(c.lds + c.wave * 16384);
    const int gw = c.bid * NWAVES + c.wave, NGW = c.G * NWAVES;
    constexpr int PER_E = 3 * 128;
    bf16_t* GU = (bf16_t*)(p.ws + WS_GU); bf16_t* DN = (bf16_t*)(p.ws + WS_DN);
    for (int it = gw; it < 65 * PER_E; it += NGW) {
        const int e = it / PER_E; int r = it % PER_E; const int which = r / 128; r %= 128;
        if (which < 2) {
            const float* src = (e < NEXP) ? p.in[which == 0 ? I_EG : I_EU] + ((size_t)l * NEXP + e) * DM * 256 : p.in[which == 0 ? I_SG : I_SU] + (size_t)l * DM * 256;
            const int kb = r / 8, nb = r % 8;
            if (which == 0) transpose_item(src, 256, kb * 64, nb * 32, GU + (size_t)e * 512 * DM, DM, RmGate(), scr, c.lane);
            else transpose_item(src, 256, kb * 64, nb * 32, GU + (size_t)e * 512 * DM, DM, RmUp(), scr, c.lane);
        } else {
            const float* src = (e < NEXP) ? p.in[I_ED] + ((size_t)l * NEXP + e) * 256 * DM : p.in[I_SDN] + (size_t)l * 256 * DM;
            const int kb = r / 32, nb = r % 32;
            transpose_item(src, DM, kb * 64, nb * 32, DN + (size_t)e * DM * 256, 256, RmIdent(), scr, c.lane);
        }
    }
}
__device__ __forceinline__ void phase_prep_small(const Params& p, const Ctx& c) {
    LAS float* sc = (LAS float*)c.lds;
    LAS float* red = (LAS float*)(c.lds + 32768);
    float* mod = (float*)(p.ws + WS_MOD);
    bool have_sc = false;
    for (int it = c.bid; it < NLAYER * 96; it += c.G) {
        if (!have_sc) { for (int i = c.tid; i < 8 * 1024; i += NTHREADS) sc[i] = siluf_(p.in[I_C][i]); have_sc = true; }
        __syncthreads();
        const int l = it / 96, j0 = (it % 96) * 64, j = c.tid & 63, kg = c.tid >> 6;
        const float* W = p.in[I_ADAW] + (size_t)l * DM * NMOD + j0 + j;
        float a[8];
#pragma unroll
        for (int b = 0; b < 8; ++b) a[b] = 0.f;
#pragma unroll 16
        for (int k = kg * 128; k < kg * 128 + 128; ++k) { const float w = W[(size_t)k * NMOD];
#pragma unroll
            for (int b = 0; b < 8; ++b) a[b] += sc[b * 1024 + k] * w; }
#pragma unroll
        for (int b = 0; b < 8; ++b) red[(kg * 8 + b) * 64 + j] = a[b];
        __syncthreads();
        { const int b = c.tid >> 6; float s = 0.f;
#pragma unroll
          for (int g = 0; g < 8; ++g) s += red[(g * 8 + b) * 64 + j];
          mod[((size_t)l * 8 + b) * NMOD + j0 + j] = s + p.in[I_ADAB][(size_t)l * NMOD + j0 + j]; }
        __syncthreads();
    }
    if (c.bid == c.G - 1) {
        float* lb = (float*)(p.ws + WS_LB);
        for (int i = c.tid; i < 512; i += NTHREADS) { const float v0 = p.in[I_HLB][i], v1 = p.in[I_HLB][512 + i]; const float m = fmaxf(v0, v1), e0 = expf(v0 - m), e1 = expf(v1 - m);
            lb[i] = 0.f; lb[512 + i] = e1 / (e0 + e1); }
    }
    { float* WT = (float*)(p.ws + WS_WRT);
      for (int o = c.bid * NTHREADS + c.tid; o < NLAYER * 64 * 1024; o += c.G * NTHREADS) { const int k = o & 1023, e = (o >> 10) & 63, l = o >> 16; WT[o] = p.in[I_RW][((size_t)l * 1024 + k) * 64 + e]; } }
    { bf16_t* LW = (bf16_t*)(p.ws + WS_LRUW);
      for (int o = c.bid * NTHREADS + c.tid; o < NLAYER * 2 * 8 * 4096; o += c.G * NTHREADS) {
          const int i = o & 63, j = (o >> 6) & 63, g = (o >> 12) & 7, mat = (o >> 15) & 1, l = o >> 16;
          const float* src = p.in[mat == 0 ? I_LWA : I_LWX] + (((size_t)l * 8 + g) * 64 + i) * 64 + j;
          LW[o] = (bf16_t)f2bf(*src); } }
}

__device__ __forceinline__ void load_wdt(const Params& p, const Ctx& c, int l, LAS float* wdt) {
    const float* Win = p.in[I_WIN] + (size_t)l * DM * DIN;
    for (int i = c.tid; i < 16 * 1024; i += NTHREADS) { const int k = i >> 4, j = i & 15; wdt[j * 1024 + k] = Win[(size_t)k * DIN + 2560 + j]; }
    __syncthreads();
}
__device__ __forceinline__ void norm_mix_row(const Ctx& c, const f32x4 (&v)[4], float ss, int tok, const float* nw, const float* mod, const LAS float* wdt, bf16_t* H, float* dtraw) {
        const int b = tok >> 11;
        const float rstd = rsqf_(wave_sum(ss, c.lane) * (1.0f / DM) + EPS);
        f32x4 hv[4], w4v[4], shv[4], scv[4];
#pragma unroll
        for (int j = 0; j < 4; ++j) { const int col = 256 * j + 4 * c.lane;
            w4v[j] = *(const f32x4*)(nw + col); shv[j] = *(const f32x4*)(mod + (size_t)b * NMOD + col); scv[j] = *(const f32x4*)(mod + (size_t)b * NMOD + 1024 + col); }
#pragma unroll
        for (int j = 0; j < 4; ++j) {
            const int col = 256 * j + 4 * c.lane;
            const f32x4 w4 = w4v[j], sh = shv[j], sc = scv[j];
            hv[j] = (v[j] * rstd * w4) * (sc + 1.0f) + sh;
            u32x2 o; o.x = pk2(hv[j][0], hv[j][1]); o.y = pk2(hv[j][2], hv[j][3]);
            *(u32x2*)(H + (size_t)tok * DM + col) = o;
        }
        float d16[16];
#pragma unroll
        for (int q = 0; q < 16; ++q) {
            float s2 = 0.f;
#pragma unroll
            for (int j = 0; j < 4; ++j) { const f32x4 wq = *(const LAS f32x4*)(wdt + q * 1024 + 256 * j + 4 * c.lane); s2 += (hv[j][0] * wq[0] + hv[j][1] * wq[1]) + (hv[j][2] * wq[2] + hv[j][3] * wq[3]); }
            d16[q] = s2;
            if ((q & 1) == 1) asm volatile("" ::: "memory");
        }
        float d8[8], d4[4], d2[2], d1;
        { const bool up = (c.lane & 32) != 0;
#pragma unroll
          for (int i = 0; i < 8; ++i) { const float snd = up ? d16[i] : d16[8 + i], kp = up ? d16[8 + i] : d16[i]; d8[i] = kp + shfl_xor_l(snd, 32, c.lane); } }
        { const bool up = (c.lane & 16) != 0;
#pragma unroll
          for (int i = 0; i < 4; ++i) { const float snd = up ? d8[i] : d8[4 + i], kp = up ? d8[4 + i] : d8[i]; d4[i] = kp + shfl_xor_l(snd, 16, c.lane); } }
        { const bool up = (c.lane & 8) != 0;
#pragma unroll
          for (int i = 0; i < 2; ++i) { const float snd = up ? d4[i] : d4[2 + i], kp = up ? d4[2 + i] : d4[i]; d2[i] = kp + shfl_xor_l(snd, 8, c.lane); } }
        { const bool up = (c.lane & 4) != 0; const float snd = up ? d2[0] : d2[1], kp = up ? d2[1] : d2[0]; d1 = kp + shfl_xor_l(snd, 4, c.lane); }
        d1 += shfl_xor_l(d1, 2, c.lane); d1 += shfl_xor_l(d1, 1, c.lane);
        if ((c.lane & 3) == 0) dtraw[(size_t)tok * 16 + ((c.lane >> 5) & 1) * 8 + ((c.lane >> 4) & 1) * 4 + ((c.lane >> 3) & 1) * 2 + ((c.lane >> 2) & 1)] = d1;
}
__device__ __forceinline__ void phase_norm_mix(const Params& p, const Ctx& c, int l, const float* xin) {
    LAS float* wdt = (LAS float*)c.lds;
    load_wdt(p, c, l, wdt);
    const float* mod = (const float*)(p.ws + WS_MOD) + (size_t)l * 8 * NMOD;
    const float* nw = p.in[I_NMIX] + (size_t)l * DM;
    bf16_t* H = (bf16_t*)(p.ws + WS_H); float* dtraw = (float*)(p.ws + WS_DTRAW);
    const int gw = c.bid * NWAVES + c.wave, NGW = c.G * NWAVES;
    f32x4 vn[4];
    if (gw < NTOK) {
#pragma unroll
        for (int j = 0; j < 4; ++j) vn[j] = ((const f32x4*)(xin + (size_t)gw * DM) + c.lane)[64 * j];
    }
    for (int tok = gw; tok < NTOK; tok += NGW) {
        f32x4 v[4]; float ss = 0.f;
#pragma unroll
        for (int j = 0; j < 4; ++j) { v[j] = vn[j]; ss += (v[j][0] * v[j][0] + v[j][1] * v[j][1]) + (v[j][2] * v[j][2] + v[j][3] * v[j][3]); }
        if (tok + NGW < NTOK) {
#pragma unroll
            for (int j = 0; j < 4; ++j) vn[j] = ((const f32x4*)(xin + (size_t)(tok + NGW) * DM) + c.lane)[64 * j];
        }
        norm_mix_row(c, v, ss, tok, nw, mod, wdt, H, dtraw);
    }
}

__device__ __forceinline__ void phase_ssd_conv(const Params& p, const Ctx& c, int l) {
    const bf16_t* U = (const bf16_t*)(p.ws + WS_U); bf16_t* XA = (bf16_t*)(p.ws + WS_XBC);
    const float* cw = p.in[I_SCW] + (size_t)l * 4 * 1536; const float* cb = p.in[I_SCB] + (size_t)l * 1536;
    const float* dtraw = (const float*)(p.ws + WS_DTRAW); float* dt = (float*)(p.ws + WS_DT); float* acum = (float*)(p.ws + WS_ACUM);
    for (int idx = c.bid * NTHREADS + c.tid; idx < (NTOK / 4) * 192; idx += c.G * NTHREADS) {
        const int oct = idx % 192, tg = idx / 192, tok0 = tg * 4, t0 = tok0 & (SEQ - 1), c0 = oct * 8;
        float w[4][8], bb[8];
#pragma unroll
        for (int k = 0; k < 4; ++k) { const f32x4 a = *(const f32x4*)(cw + k * 1536 + c0), b2 = *(const f32x4*)(cw + k * 1536 + c0 + 4);
            w[k][0] = a[0]; w[k][1] = a[1]; w[k][2] = a[2]; w[k][3] = a[3]; w[k][4] = b2[0]; w[k][5] = b2[1]; w[k][6] = b2[2]; w[k][7] = b2[3]; }
        { const f32x4 a = *(const f32x4*)(cb + c0), b2 = *(const f32x4*)(cb + c0 + 4); bb[0] = a[0]; bb[1] = a[1]; bb[2] = a[2]; bb[3] = a[3]; bb[4] = b2[0]; bb[5] = b2[1]; bb[6] = b2[2]; bb[7] = b2[3]; }
        float x[7][8];
#pragma unroll
        for (int r = 0; r < 7; ++r) {
            u32x4 v = (u32x4){0u, 0u, 0u, 0u};
            if (t0 + r - 3 >= 0) v = *(const u32x4*)(U + (size_t)(tok0 + r - 3) * NU + UXS + c0);
#pragma unroll
            for (int j = 0; j < 4; ++j) { x[r][2 * j] = lo_bf(v[j]); x[r][2 * j + 1] = hi_bf(v[j]); }
        }
#pragma unroll
        for (int t = 0; t < 4; ++t) {
            float y[8];
#pragma unroll
            for (int j = 0; j < 8; ++j) y[j] = siluf_(bb[j] + w[0][j] * x[t][j] + w[1][j] * x[t + 1][j] + w[2][j] * x[t + 2][j] + w[3][j] * x[t + 3][j]);
            u32x4 o; o.x = pk2(y[0], y[1]); o.y = pk2(y[2], y[3]); o.z = pk2(y[4], y[5]); o.w = pk2(y[6], y[7]);
            *(u32x4*)(XA + (size_t)(tok0 + t) * 1536 + c0) = o;
        }
    }
    const int gw = c.bid * NWAVES + c.wave, NGW = c.G * NWAVES;
    for (int it = gw; it < 128; it += NGW) {
        const int tok0 = it * 128, h = c.lane & 15, qtr = c.lane >> 4;
        const float bias = p.in[I_SDTB][l * 16 + h], A = -expf(p.in[I_SALOG][l * 16 + h]);
        float d[32]; float cum = 0.f;
#pragma unroll
        for (int i = 0; i < 32; ++i) d[i] = softplusf_(dtraw[(size_t)(tok0 + qtr * 32 + i) * 16 + h] + bias);
#pragma unroll
        for (int i = 0; i < 32; ++i) cum += d[i] * A;
        const float c1 = shfl_up_f(cum, 16, c.lane), c2 = shfl_up_f(cum, 32, c.lane), c3 = shfl_up_f(cum, 48, c.lane);
        float off = 0.f; if (qtr >= 1) off += c1; if (qtr >= 2) off += c2; if (qtr >= 3) off += c3;
        float run = off;
#pragma unroll
        for (int i = 0; i < 32; ++i) { run += d[i] * A; dt[(size_t)(tok0 + qtr * 32 + i) * 16 + h] = d[i]; acum[(size_t)(tok0 + qtr * 32 + i) * 16 + h] = run; }
    }
}

__device__ __forceinline__ void phase_ssd_state(const Params& p, const Ctx& c) {
    LAS bf16_t* XS = (LAS bf16_t*)c.lds;
    LAS bf16_t* BS = (LAS bf16_t*)(c.lds + 2 * 18432);
    LAS float* fac = (LAS float*)(c.lds + 2 * 18432 + 34816);
    const bf16_t* XA = (const bf16_t*)(p.ws + WS_XBC); const float* dt = (const float*)(p.ws + WS_DT); const float* acum = (const float*)(p.ws + WS_ACUM);
    bf16_t* ST = (bf16_t*)(p.ws + WS_SST);
    const int fr = c.lane & 15, fq = c.lane >> 4;
    for (int it = c.bid; it < 256; it += c.G) {
        const int g = it & 1, bc = it >> 1, tok0 = bc * 128;
        u32x4 pxs[2];
#pragma unroll
        for (int q = 0; q < 2; ++q) { const int i = c.tid + q * NTHREADS; pxs[q] = *(const u32x4*)(XA + (size_t)(tok0 + (i >> 3)) * 1536 + (g * 8) * 64 + (i & 7) * 8); }
        for (int i = c.tid; i < 128 * 16; i += NTHREADS) { const int lrow = i >> 4, ck = i & 15;
            *(LAS u32x4*)(BS + lrow * 136 + ck * 8) = *(const u32x4*)(XA + (size_t)(tok0 + lrow) * 1536 + 1024 + g * 128 + ck * 8); }
        for (int i = c.tid; i < 1024; i += NTHREADS) { const int h8 = i >> 7, lr = i & 127, h = g * 8 + h8;
            fac[i] = dt[(size_t)(tok0 + lr) * 16 + h] * __expf(acum[(size_t)(tok0 + 127) * 16 + h] - acum[(size_t)(tok0 + lr) * 16 + h]); }
        LDS_BARRIER();
        for (int h8 = 0; h8 < 8; ++h8) {
            const int h = g * 8 + h8; LAS bf16_t* X = XS + (h8 & 1) * (128 * 72);
#pragma unroll
            for (int q = 0; q < 2; ++q) { const int i = c.tid + q * NTHREADS, lrow = i >> 3, ck = i & 7; const u32x4 r = pxs[q]; const float f = fac[h8 * 128 + lrow];
                u32x4 o; o.x = pk2(lo_bf(r.x) * f, hi_bf(r.x) * f); o.y = pk2(lo_bf(r.y) * f, hi_bf(r.y) * f); o.z = pk2(lo_bf(r.z) * f, hi_bf(r.z) * f); o.w = pk2(lo_bf(r.w) * f, hi_bf(r.w) * f);
                *(LAS u32x4*)(X + lrow * 72 + ck * 8) = o; }
            if (h8 < 7) {
#pragma unroll
                for (int q = 0; q < 2; ++q) { const int i = c.tid + q * NTHREADS; pxs[q] = *(const u32x4*)(XA + (size_t)(tok0 + (i >> 3)) * 1536 + (h + 1) * 64 + (i & 7) * 8); } }
            LDS_BARRIER();
            f32x4 acc[4];
#pragma unroll
            for (int m = 0; m < 4; ++m) acc[m] = (f32x4){0.f, 0.f, 0.f, 0.f};
#pragma unroll
            for (int ks = 0; ks < 4; ++ks) {
                const bf16x8 bfr = tr_frag(BS, 136, 32 * ks, 16 * c.wave, c.lane);
#pragma unroll
                for (int m = 0; m < 4; ++m) { const bf16x8 afr = tr_frag(X, 72, 32 * ks, 16 * m, c.lane); acc[m] = MFMA16(bfr, afr, acc[m]); }
            }
            const size_t sit = (size_t)(bc * 16 + h);
#pragma unroll
            for (int m = 0; m < 4; ++m) { u32x2 o; o.x = pk2(acc[m][0], acc[m][1]); o.y = pk2(acc[m][2], acc[m][3]);
                *(u32x2*)(ST + sit * 8192 + (16 * m + fr) * 128 + 16 * c.wave + 4 * fq) = o; }
        }
        LDS_BARRIER();
    }
}
__device__ __forceinline__ void phase_ssd_scan(const Params& p, const Ctx& c) {
    u32x4* ST = (u32x4*)(p.ws + WS_SST); const float* acum = (const float*)(p.ws + WS_ACUM);
    for (int i = c.bid * NTHREADS + c.tid; i < 128 * 1024; i += c.G * NTHREADS) {
        const int e8 = i & 1023, bh = i >> 10, b = bh >> 4, h = bh & 15;
        u32x4 loc[16]; float dec[16];
#pragma unroll
        for (int ch = 0; ch < 16; ++ch) { loc[ch] = ST[(size_t)((b * 16 + ch) * 16 + h) * 1024 + e8]; dec[ch] = __expf(acum[(size_t)(b * SEQ + ch * 128 + 127) * 16 + h]); }
        float r[8];
#pragma unroll
        for (int j = 0; j < 8; ++j) r[j] = 0.f;
#pragma unroll
        for (int ch = 0; ch < 16; ++ch) {
            u32x4 o; o.x = pk2(r[0], r[1]); o.y = pk2(r[2], r[3]); o.z = pk2(r[4], r[5]); o.w = pk2(r[6], r[7]);
            ST[(size_t)((b * 16 + ch) * 16 + h) * 1024 + e8] = o;
            const float d = dec[ch];
#pragma unroll
            for (int j = 0; j < 4; ++j) { r[2 * j] = d * r[2 * j] + lo_bf(loc[ch][j]); r[2 * j + 1] = d * r[2 * j + 1] + hi_bf(loc[ch][j]); }
        }
    }
}
__device__ __forceinline__ void phase_ssd_out(const Params& p, const Ctx& c, int l) {
    LAS bf16_t* Cs = (LAS bf16_t*)c.lds;
    LAS bf16_t* Bs = (LAS bf16_t*)(c.lds + 34816);
    LAS bf16_t* CBD = (LAS bf16_t*)(c.lds + 2 * 34816);
    LAS bf16_t* XS = (LAS bf16_t*)(c.lds + 3 * 34816);
    LAS bf16_t* STs = (LAS bf16_t*)(c.lds + 3 * 34816 + 18432);
    LAS float* acs = (LAS float*)(c.lds + 3 * 34816 + 18432 + 17408);
    const bf16_t* XA = (const bf16_t*)(p.ws + WS_XBC); const float* dt = (const float*)(p.ws + WS_DT); const float* acum = (const float*)(p.ws + WS_ACUM);
    const bf16_t* ST = (const bf16_t*)(p.ws + WS_SST); bf16_t* YP = (bf16_t*)(p.ws + WS_H);
    const int fr = c.lane & 15, fq = c.lane >> 4, w = c.wave;
    for (int it = c.bid; it < 2048; it += c.G) {
        const int h = it & 15, bc = it >> 4, tok0 = bc * 128, g = h >> 3;
        const float Dh = p.in[I_SD][l * 16 + h];
        for (int i = c.tid; i < 128 * 16; i += NTHREADS) { const int row = i >> 4, ck = i & 15;
            *(LAS u32x4*)(Bs + row * 136 + ck * 8) = *(const u32x4*)(XA + (size_t)(tok0 + row) * 1536 + 1024 + g * 128 + ck * 8);
            *(LAS u32x4*)(Cs + row * 136 + ck * 8) = *(const u32x4*)(XA + (size_t)(tok0 + row) * 1536 + 1280 + g * 128 + ck * 8); }
        for (int i = c.tid; i < 64 * 16; i += NTHREADS) { const int row = i >> 4, ck = i & 15;
            *(LAS u32x4*)(STs + row * 136 + ck * 8) = *(const u32x4*)(ST + (size_t)it * 8192 + row * 128 + ck * 8); }
        for (int i = c.tid; i < 128 * 8; i += NTHREADS) { const int lrow = i >> 3, ck = i & 7;
            const u32x4 r = *(const u32x4*)(XA + (size_t)(tok0 + lrow) * 1536 + h * 64 + ck * 8);
            const float f = dt[(size_t)(tok0 + lrow) * 16 + h];
            u32x4 o; o.x = pk2(lo_bf(r.x) * f, hi_bf(r.x) * f); o.y = pk2(lo_bf(r.y) * f, hi_bf(r.y) * f); o.z = pk2(lo_bf(r.z) * f, hi_bf(r.z) * f); o.w = pk2(lo_bf(r.w) * f, hi_bf(r.w) * f);
            *(LAS u32x4*)(XS + lrow * 72 + ck * 8) = o; }
        if (c.tid < 128) acs[c.tid] = acum[(size_t)(tok0 + c.tid) * 16 + h];
        __syncthreads();
        {
            f32x4 cb[8];
#pragma unroll
            for (int n = 0; n < 8; ++n) cb[n] = (f32x4){0.f, 0.f, 0.f, 0.f};
#pragma unroll
            for (int ks = 0; ks < 4; ++ks) {
                const bf16x8 afr = *(const LAS bf16x8*)(Cs + (16 * w + fr) * 136 + ks * 32 + 8 * fq);
#pragma unroll
                for (int n = 0; n < 8; ++n) { const bf16x8 bfr = *(const LAS bf16x8*)(Bs + (16 * n + fr) * 136 + ks * 32 + 8 * fq); cb[n] = MFMA16(bfr, afr, cb[n]); }
            }
            const int lr = 16 * w + fr; const float al = acs[lr];
#pragma unroll
            for (int n = 0; n < 8; ++n) { float v4[4];
#pragma unroll
                for (int r = 0; r < 4; ++r) { const int sc = 16 * n + 4 * fq + r; v4[r] = (sc <= lr) ? cb[n][r] * __expf(al - acs[sc]) : 0.f; }
                u32x2 o; o.x = pk2(v4[0], v4[1]); o.y = pk2(v4[2], v4[3]);
                *(LAS u32x2*)(CBD + lr * 136 + 16 * n + 4 * fq) = o; }
        }
        __syncthreads();
        {
            f32x4 a1[4], a2[4];
#pragma unroll
            for (int n = 0; n < 4; ++n) { a1[n] = (f32x4){0.f, 0.f, 0.f, 0.f}; a2[n] = (f32x4){0.f, 0.f, 0.f, 0.f}; }
#pragma unroll
            for (int ks = 0; ks < 4; ++ks) {
                const bf16x8 ad = *(const LAS bf16x8*)(CBD + (16 * w + fr) * 136 + ks * 32 + 8 * fq);
                const bf16x8 ac = *(const LAS bf16x8*)(Cs + (16 * w + fr) * 136 + ks * 32 + 8 * fq);
#pragma unroll
                for (int n = 0; n < 4; ++n) {
                    const bf16x8 bx = tr_frag(XS, 72, 32 * ks, 16 * n, c.lane);
                    const bf16x8 bs = *(const LAS bf16x8*)(STs + (16 * n + fr) * 136 + ks * 32 + 8 * fq);
                    a1[n] = MFMA16(bx, ad, a1[n]); a2[n] = MFMA16(bs, ac, a2[n]); }
            }
            const int lr = 16 * w + fr; const float ea = __expf(acs[lr]);
#pragma unroll
            for (int n = 0; n < 4; ++n) { const int pc = 16 * n + 4 * fq;
                const u32x2 xv = *(const u32x2*)(XA + (size_t)(tok0 + lr) * 1536 + h * 64 + pc);
                const float y0 = a1[n][0] + ea * a2[n][0] + Dh * lo_bf(xv.x), y1 = a1[n][1] + ea * a2[n][1] + Dh * hi_bf(xv.x);
                const float y2 = a1[n][2] + ea * a2[n][2] + Dh * lo_bf(xv.y), y3 = a1[n][3] + ea * a2[n][3] + Dh * hi_bf(xv.y);
                u32x2 o; o.x = pk2(y0, y1); o.y = pk2(y2, y3);
                *(u32x2*)(YP + (size_t)(tok0 + lr) * DM + h * 64 + pc) = o; }
        }
        __syncthreads();
    }
}
__device__ __forceinline__ void phase_ssd_out_g(const Params& p, const Ctx& c, int l) {
    LAS bf16_t* Cs = (LAS bf16_t*)c.lds;
    LAS bf16_t* CB = (LAS bf16_t*)(c.lds + 34816);
    LAS bf16_t* BD = (LAS bf16_t*)(c.lds + 2 * 34816);
    LAS bf16_t* XS = (LAS bf16_t*)(c.lds + 3 * 34816);
    LAS bf16_t* STs = (LAS bf16_t*)(c.lds + 3 * 34816 + 18432);
    LAS float* acs = (LAS float*)(c.lds + 3 * 34816 + 18432 + 17408);
    LAS float* dts = acs + 1024;
    const bf16_t* XA = (const bf16_t*)(p.ws + WS_XBC); const float* dt = (const float*)(p.ws + WS_DT); const float* acum = (const float*)(p.ws + WS_ACUM);
    const bf16_t* ST = (const bf16_t*)(p.ws + WS_SST); bf16_t* YP = (bf16_t*)(p.ws + WS_H);
    const bf16_t* U = (const bf16_t*)(p.ws + WS_U); bf16_t* YC = (bf16_t*)(p.ws + WS_YCAT);
    const float* nw = p.in[I_SNW] + (size_t)l * 1024;
    const int fr = c.lane & 15, fq = c.lane >> 4, w = c.wave;
    for (int it = c.bid; it < 256; it += c.G) {
        const int g = it & 1, bc = it >> 1, tok0 = bc * 128;
        for (int i = c.tid; i < 128 * 16; i += NTHREADS) { const int row = i >> 4, ck = i & 15;
            *(LAS u32x4*)(BD + row * 136 + ck * 8) = *(const u32x4*)(XA + (size_t)(tok0 + row) * 1536 + 1024 + g * 128 + ck * 8);
            *(LAS u32x4*)(Cs + row * 136 + ck * 8) = *(const u32x4*)(XA + (size_t)(tok0 + row) * 1536 + 1280 + g * 128 + ck * 8); }
        for (int i = c.tid; i < 1024; i += NTHREADS) { const int h8 = i >> 7, lr = i & 127; acs[i] = acum[(size_t)(tok0 + lr) * 16 + g * 8 + h8]; dts[i] = dt[(size_t)(tok0 + lr) * 16 + g * 8 + h8]; }
        LDS_BARRIER();
        {
            f32x4 cb[8];
#pragma unroll
            for (int n = 0; n < 8; ++n) cb[n] = (f32x4){0.f, 0.f, 0.f, 0.f};
#pragma unroll
            for (int ks = 0; ks < 4; ++ks) {
                const bf16x8 afr = *(const LAS bf16x8*)(Cs + (16 * w + fr) * 136 + ks * 32 + 8 * fq);
#pragma unroll
                for (int n = 0; n < 8; ++n) { const bf16x8 bfr = *(const LAS bf16x8*)(BD + (16 * n + fr) * 136 + ks * 32 + 8 * fq); cb[n] = MFMA16(bfr, afr, cb[n]); }
            }
            const int lr = 16 * w + fr;
#pragma unroll
            for (int n = 0; n < 8; ++n) { u32x2 o; o.x = pk2(cb[n][0], cb[n][1]); o.y = pk2(cb[n][2], cb[n][3]); *(LAS u32x2*)(CB + lr * 136 + 16 * n + 4 * fq) = o; }
        }
        LDS_BARRIER();
        u32x4 pst[2], pxs[2];
#pragma unroll
        for (int q = 0; q < 2; ++q) { const int i = c.tid + q * NTHREADS;
            pst[q] = *(const u32x4*)(ST + (size_t)(bc * 16 + g * 8) * 8192 + (i >> 4) * 128 + (i & 15) * 8);
            pxs[q] = *(const u32x4*)(XA + (size_t)(tok0 + (i >> 3)) * 1536 + (g * 8) * 64 + (i & 7) * 8); }
        for (int h8 = 0; h8 < 8; ++h8) {
            const int h = g * 8 + h8;
            const float Dh = p.in[I_SD][l * 16 + h];
            const LAS float* ah = acs + h8 * 128; const LAS float* dh = dts + h8 * 128;
#pragma unroll
            for (int q = 0; q < 2; ++q) { const int i = c.tid + q * NTHREADS;
                *(LAS u32x4*)(STs + (i >> 4) * 136 + (i & 15) * 8) = pst[q];
                const int lrow = i >> 3, ck = i & 7; const u32x4 r = pxs[q]; const float f = dh[lrow];
                u32x4 o; o.x = pk2(lo_bf(r.x) * f, hi_bf(r.x) * f); o.y = pk2(lo_bf(r.y) * f, hi_bf(r.y) * f); o.z = pk2(lo_bf(r.z) * f, hi_bf(r.z) * f); o.w = pk2(lo_bf(r.w) * f, hi_bf(r.w) * f);
                *(LAS u32x4*)(XS + lrow * 72 + ck * 8) = o; }
            if (h8 < 7) {
#pragma unroll
                for (int q = 0; q < 2; ++q) { const int i = c.tid + q * NTHREADS;
                    pst[q] = *(const u32x4*)(ST + (size_t)(bc * 16 + h + 1) * 8192 + (i >> 4) * 128 + (i & 15) * 8);
                    pxs[q] = *(const u32x4*)(XA + (size_t)(tok0 + (i >> 3)) * 1536 + (h + 1) * 64 + (i & 7) * 8); } }
            for (int i = c.tid; i < 128 * 16; i += NTHREADS) { const int lr = i >> 4, ck = i & 15; u32x4 o = (u32x4){0u, 0u, 0u, 0u};
                if (8 * ck <= lr) { const u32x4 cv = *(const LAS u32x4*)(CB + lr * 136 + ck * 8); const float al = ah[lr];
                    const f32x4 s0 = *(const LAS f32x4*)(ah + 8 * ck), s1 = *(const LAS f32x4*)(ah + 8 * ck + 4);
                    float e[8];
#pragma unroll
                    for (int j = 0; j < 4; ++j) { e[j] = (8 * ck + j <= lr) ? __expf(al - s0[j]) : 0.f; e[4 + j] = (8 * ck + 4 + j <= lr) ? __expf(al - s1[j]) : 0.f; }
                    o.x = pk2(lo_bf(cv.x) * e[0], hi_bf(cv.x) * e[1]); o.y = pk2(lo_bf(cv.y) * e[2], hi_bf(cv.y) * e[3]); o.z = pk2(lo_bf(cv.z) * e[4], hi_bf(cv.z) * e[5]); o.w = pk2(lo_bf(cv.w) * e[6], hi_bf(cv.w) * e[7]); }
                *(LAS u32x4*)(BD + lr * 136 + ck * 8) = o; }
            LDS_BARRIER();
            {
                f32x4 a1[4], a2[4];
#pragma unroll
                for (int n = 0; n < 4; ++n) { a1[n] = (f32x4){0.f, 0.f, 0.f, 0.f}; a2[n] = (f32x4){0.f, 0.f, 0.f, 0.f}; }
#pragma unroll
                for (int ks = 0; ks < 4; ++ks) {
                    const bf16x8 ad = *(const LAS bf16x8*)(BD + (16 * w + fr) * 136 + ks * 32 + 8 * fq);
                    const bf16x8 ac = *(const LAS bf16x8*)(Cs + (16 * w + fr) * 136 + ks * 32 + 8 * fq);
#pragma unroll
                    for (int n = 0; n < 4; ++n) {
                        const bf16x8 bx = tr_frag(XS, 72, 32 * ks, 16 * n, c.lane);
                        const bf16x8 bs = *(const LAS bf16x8*)(STs + (16 * n + fr) * 136 + ks * 32 + 8 * fq);
                        a1[n] = MFMA16(bx, ad, a1[n]); a2[n] = MFMA16(bs, ac, a2[n]); }
                }
                const int lr = 16 * w + fr; const float ea = __expf(ah[lr]);
#pragma unroll
                for (int n = 0; n < 4; ++n) { const int pc = 16 * n + 4 * fq;
                    const u32x2 xv = *(const u32x2*)(XA + (size_t)(tok0 + lr) * 1536 + h * 64 + pc);
                    const float y0 = a1[n][0] + ea * a2[n][0] + Dh * lo_bf(xv.x), y1 = a1[n][1] + ea * a2[n][1] + Dh * hi_bf(xv.x);
                    const float y2 = a1[n][2] + ea * a2[n][2] + Dh * lo_bf(xv.y), y3 = a1[n][3] + ea * a2[n][3] + Dh * hi_bf(xv.y);
                    u32x2 o; o.x = pk2(y0, y1); o.y = pk2(y2, y3);
                    *(u32x2*)(YP + (size_t)(tok0 + lr) * DM + h * 64 + pc) = o; }
            }
            LDS_BARRIER();
        }
        __syncthreads();
        for (int pass = 0; pass < 2; ++pass) {
            const int tok = tok0 + pass * 64 + (c.tid >> 3), part = c.tid & 7, col = g * 512 + part * 8;
            u32x4 yv[8], zv[8];
#pragma unroll
            for (int i = 0; i < 8; ++i) { yv[i] = *(const u32x4*)(YP + (size_t)tok * DM + col + 64 * i); zv[i] = *(const u32x4*)(U + (size_t)tok * NU + UZ + col + 64 * i); }
            float v[64]; float ss = 0.f;
#pragma unroll
            for (int i = 0; i < 8; ++i)
#pragma unroll
                for (int j = 0; j < 4; ++j) { const float a = lo_bf(yv[i][j]) * siluf_(lo_bf(zv[i][j])), b2 = hi_bf(yv[i][j]) * siluf_(hi_bf(zv[i][j])); v[8 * i + 2 * j] = a; v[8 * i + 2 * j + 1] = b2; ss += a * a + b2 * b2; }
            ss += shfl_xor_l(ss, 1, c.lane); ss += shfl_xor_l(ss, 2, c.lane); ss += shfl_xor_l(ss, 4, c.lane);
            const float rstd = rsqf_(ss * (1.0f / 512.0f) + EPS);
#pragma unroll
            for (int i = 0; i < 8; ++i) { const f32x4 w0 = *(const f32x4*)(nw + col + 64 * i), w1 = *(const f32x4*)(nw + col + 64 * i + 4);
                u32x4 o; o.x = pk2(v[8 * i] * rstd * w0[0], v[8 * i + 1] * rstd * w0[1]); o.y = pk2(v[8 * i + 2] * rstd * w0[2], v[8 * i + 3] * rstd * w0[3]);
                o.z = pk2(v[8 * i + 4] * rstd * w1[0], v[8 * i + 5] * rstd * w1[1]); o.w = pk2(v[8 * i + 6] * rstd * w1[2], v[8 * i + 7] * rstd * w1[3]);
                *(u32x4*)(YC + (size_t)tok * 2048 + col + 64 * i) = o; }
        }
        LDS_BARRIER();
    }
}
__device__ __forceinline__ void phase_ssd_gate(const Params& p, const Ctx& c, int l) {
    const bf16_t* YP = (const bf16_t*)(p.ws + WS_H); const bf16_t* U = (const bf16_t*)(p.ws + WS_U); bf16_t* YC = (bf16_t*)(p.ws + WS_YCAT);
    const float* nw = p.in[I_SNW] + (size_t)l * 1024;
    for (int r0 = c.bid * 64; r0 < NTOK * 2; r0 += c.G * 64) {
        const int row = r0 + (c.tid >> 3), part = c.tid & 7, tok = row >> 1, g = row & 1, col = g * 512 + part * 8;
        u32x4 yv[8], zv[8];
#pragma unroll
        for (int i = 0; i < 8; ++i) { yv[i] = *(const u32x4*)(YP + (size_t)tok * DM + col + 64 * i); zv[i] = *(const u32x4*)(U + (size_t)tok * NU + UZ + col + 64 * i); }
        float v[64]; float ss = 0.f;
#pragma unroll
        for (int i = 0; i < 8; ++i)
#pragma unroll
            for (int j = 0; j < 4; ++j) { const float a = lo_bf(yv[i][j]) * siluf_(lo_bf(zv[i][j])), b2 = hi_bf(yv[i][j]) * siluf_(hi_bf(zv[i][j])); v[8 * i + 2 * j] = a; v[8 * i + 2 * j + 1] = b2; ss += a * a + b2 * b2; }
        ss += shfl_xor_l(ss, 1, c.lane); ss += shfl_xor_l(ss, 2, c.lane); ss += shfl_xor_l(ss, 4, c.lane);
        const float rstd = rsqf_(ss * (1.0f / 512.0f) + EPS);
#pragma unroll
        for (int i = 0; i < 8; ++i) { const f32x4 w0 = *(const f32x4*)(nw + col + 64 * i), w1 = *(const f32x4*)(nw + col + 64 * i + 4);
            u32x4 o; o.x = pk2(v[8 * i] * rstd * w0[0], v[8 * i + 1] * rstd * w0[1]); o.y = pk2(v[8 * i + 2] * rstd * w0[2], v[8 * i + 3] * rstd * w0[3]);
            o.z = pk2(v[8 * i + 4] * rstd * w1[0], v[8 * i + 5] * rstd * w1[1]); o.w = pk2(v[8 * i + 6] * rstd * w1[2], v[8 * i + 7] * rstd * w1[3]);
            *(u32x4*)(YC + (size_t)tok * 2048 + col + 64 * i) = o; }
    }
}
__device__ __forceinline__ void phase_hg_state(const Params& p, const Ctx& c, int l) {
    LAS float* Bf = (LAS float*)c.lds;
    LAS float* KK = (LAS float*)(c.lds + 33792);
    LAS bf16_t* KD = (LAS bf16_t*)(c.lds + 2 * 33792 + 2112);
    LAS bf16_t* VS = (LAS bf16_t*)(c.lds + 2 * 33792 + 2112 + 17408);
    const bf16_t* U = (const bf16_t*)(p.ws + WS_U); const float* lb = (const float*)(p.ws + WS_LB) + l * 512;
    bf16_t* ST = (bf16_t*)(p.ws + WS_HST); float* BL = (float*)(p.ws + WS_HGBL);
    const int fr = c.lane & 15, fq = c.lane >> 4, w = c.wave;
    for (int it = c.bid; it < 1024; it += c.G) {
        const int ch = it & 31, bh = it >> 5, h = bh & 3, b = bh >> 2, tok0 = b * SEQ + ch * 64;
        for (int i = c.tid; i < 64 * 16; i += NTHREADS) { const int sr = i >> 4, ck = i & 15;
            const size_t ro = (size_t)(tok0 + sr) * NU + h * 128 + ck * 8;
            const u32x4 rf = *(const u32x4*)(U + ro + UHF);
            *(LAS u32x4*)(VS + sr * 136 + ck * 8) = *(const u32x4*)(U + ro + UHV);
            const f32x4 l0 = *(const f32x4*)(lb + h * 128 + ck * 8), l1 = *(const f32x4*)(lb + h * 128 + ck * 8 + 4);
            f32x4 k0, k1, g0, g1;
            k0[0] = (1.0f - l0[0]) * sigmoidf_(-lo_bf(rf.x)); k0[1] = (1.0f - l0[1]) * sigmoidf_(-hi_bf(rf.x)); k0[2] = (1.0f - l0[2]) * sigmoidf_(-lo_bf(rf.y)); k0[3] = (1.0f - l0[3]) * sigmoidf_(-hi_bf(rf.y));
            k1[0] = (1.0f - l1[0]) * sigmoidf_(-lo_bf(rf.z)); k1[1] = (1.0f - l1[1]) * sigmoidf_(-hi_bf(rf.z)); k1[2] = (1.0f - l1[2]) * sigmoidf_(-lo_bf(rf.w)); k1[3] = (1.0f - l1[3]) * sigmoidf_(-hi_bf(rf.w));
#pragma unroll
            for (int j = 0; j < 4; ++j) { g0[j] = __logf(1.0f - k0[j]); g1[j] = __logf(1.0f - k1[j]); }
            *(LAS f32x4*)(KK + sr * 132 + ck * 8) = k0; *(LAS f32x4*)(KK + sr * 132 + ck * 8 + 4) = k1;
            *(LAS f32x4*)(Bf + sr * 132 + ck * 8) = g0; *(LAS f32x4*)(Bf + sr * 132 + ck * 8 + 4) = g1; }
        LDS_BARRIER();
        { const int kc = c.tid & 127, q4 = c.tid >> 7; float vals[16]; float cum = 0.f;
#pragma unroll
          for (int i = 0; i < 16; ++i) { cum += Bf[(16 * q4 + i) * 132 + kc]; vals[i] = cum; }
          KK[(64 + q4) * 132 + kc] = cum;
          LDS_BARRIER();
          float off = 0.f;
#pragma unroll
          for (int j = 0; j < 3; ++j) off += (j < q4) ? KK[(64 + j) * 132 + kc] : 0.f;
#pragma unroll
          for (int i = 0; i < 16; ++i) Bf[(16 * q4 + i) * 132 + kc] = vals[i] + off;
          if (q4 == 3) BL[(size_t)it * 128 + kc] = vals[15] + off; }
        LDS_BARRIER();
        for (int i = c.tid; i < 64 * 16; i += NTHREADS) { const int sr = i >> 4, ck = i & 15;
            const f32x4 ka = *(const LAS f32x4*)(KK + sr * 132 + ck * 8), kb = *(const LAS f32x4*)(KK + sr * 132 + ck * 8 + 4);
            const f32x4 ba = *(const LAS f32x4*)(Bf + sr * 132 + ck * 8), bb = *(const LAS f32x4*)(Bf + sr * 132 + ck * 8 + 4);
            const f32x4 ea = *(const LAS f32x4*)(Bf + 63 * 132 + ck * 8), eb = *(const LAS f32x4*)(Bf + 63 * 132 + ck * 8 + 4);
            u32x4 o; o.x = pk2(ka[0] * __expf(ea[0] - ba[0]), ka[1] * __expf(ea[1] - ba[1])); o.y = pk2(ka[2] * __expf(ea[2] - ba[2]), ka[3] * __expf(ea[3] - ba[3]));
            o.z = pk2(kb[0] * __expf(eb[0] - bb[0]), kb[1] * __expf(eb[1] - bb[1])); o.w = pk2(kb[2] * __expf(eb[2] - bb[2]), kb[3] * __expf(eb[3] - bb[3]));
            *(LAS u32x4*)(KD + sr * 136 + ck * 8) = o; }
        LDS_BARRIER();
        f32x4 acc[8];
#pragma unroll
        for (int n = 0; n < 8; ++n) acc[n] = (f32x4){0.f, 0.f, 0.f, 0.f};
#pragma unroll
        for (int ks = 0; ks < 2; ++ks) {
            const bf16x8 afr = tr_frag(VS, 136, 32 * ks, 16 * w, c.lane);
#pragma unroll
            for (int n = 0; n < 8; ++n) { const bf16x8 bfr = tr_frag(KD, 136, 32 * ks, 16 * n, c.lane); acc[n] = MFMA16(bfr, afr, acc[n]); }
        }
#pragma unroll
        for (int n = 0; n < 8; ++n) { u32x2 o; o.x = pk2(acc[n][0], acc[n][1]); o.y = pk2(acc[n][2], acc[n][3]);
            *(u32x2*)(ST + (size_t)it * 16384 + (16 * w + fr) * 128 + 16 * n + 4 * fq) = o; }
        LDS_BARRIER();
    }
}
__device__ __forceinline__ void phase_hg_scan(const Params& p, const Ctx& c) {
    u32x4* ST = (u32x4*)(p.ws + WS_HST); const float* BL = (const float*)(p.ws + WS_HGBL);
    for (int i = c.bid * NTHREADS + c.tid; i < 32 * 2048; i += c.G * NTHREADS) {
        const int e8 = i & 2047, bh = i >> 11, k0 = (8 * e8) & 127;
        float r[8];
#pragma unroll
        for (int j = 0; j < 8; ++j) r[j] = 0.f;
        for (int half = 0; half < 2; ++half) {
            u32x4 loc[16];
#pragma unroll
            for (int cc = 0; cc < 16; ++cc) loc[cc] = ST[(size_t)(bh * 32 + half * 16 + cc) * 2048 + e8];
#pragma unroll
            for (int cc = 0; cc < 16; ++cc) { const size_t it = (size_t)(bh * 32 + half * 16 + cc);
                const f32x4 b0 = *(const f32x4*)(BL + it * 128 + k0), b1 = *(const f32x4*)(BL + it * 128 + k0 + 4);
                u32x4 o; o.x = pk2(r[0], r[1]); o.y = pk2(r[2], r[3]); o.z = pk2(r[4], r[5]); o.w = pk2(r[6], r[7]);
                ST[it * 2048 + e8] = o;
#pragma unroll
                for (int j = 0; j < 2; ++j) { r[2 * j] = __expf(b0[2 * j]) * r[2 * j] + lo_bf(loc[cc][j]); r[2 * j + 1] = __expf(b0[2 * j + 1]) * r[2 * j + 1] + hi_bf(loc[cc][j]); }
#pragma unroll
                for (int j = 0; j < 2; ++j) { r[4 + 2 * j] = __expf(b1[2 * j]) * r[4 + 2 * j] + lo_bf(loc[cc][2 + j]); r[5 + 2 * j] = __expf(b1[2 * j + 1]) * r[5 + 2 * j] + hi_bf(loc[cc][2 + j]); }
            }
        }
    }
}
__device__ __forceinline__ void phase_hg_out(const Params& p, const Ctx& c, int l) {
    LAS bf16_t* Qs = (LAS bf16_t*)c.lds;
    LAS bf16_t* Ks = (LAS bf16_t*)(c.lds + 17408);
    LAS float* Bf = (LAS float*)(c.lds + 2 * 17408);
    LAS bf16_t* ATT = (LAS bf16_t*)(c.lds + 2 * 17408 + 33792);
    LAS bf16_t* VS = (LAS bf16_t*)(c.lds + 2 * 17408 + 33792 + 9216);
    LAS unsigned char* R5 = c.lds + 2 * 17408 + 33792 + 9216 + 17408;
    LAS bf16_t* QI3 = (LAS bf16_t*)R5;
    LAS bf16_t* KKI3 = (LAS bf16_t*)(R5 + 48 * 272);
    LAS bf16_t* STs = (LAS bf16_t*)R5;
    LAS float* QT = (LAS float*)(R5 + 40000);
    const bf16_t* U = (const bf16_t*)(p.ws + WS_U); const float* lb = (const float*)(p.ws + WS_LB) + l * 512;
    const bf16_t* ST = (const bf16_t*)(p.ws + WS_HST); bf16_t* YC = (bf16_t*)(p.ws + WS_YCAT);
    const float* nw = p.in[I_HNW] + (size_t)l * 512;
    const int fr = c.lane & 15, fq = c.lane >> 4, w = c.wave;
    u32x4 pq[2], pf[2], pv[2], pst[4];
#define HG_LOAD_QFV(item) do { const int ch_ = (item) & 31, bh_ = (item) >> 5, h_ = bh_ & 3, b_ = bh_ >> 2, tk_ = b_ * SEQ + ch_ * 64; _Pragma("unroll") for (int q_ = 0; q_ < 2; ++q_) { const int i_ = c.tid + q_ * NTHREADS; \
        const size_t ro_ = (size_t)(tk_ + (i_ >> 4)) * NU + h_ * 128 + (i_ & 15) * 8; pq[q_] = *(const u32x4*)(U + ro_ + UHQ); pf[q_] = *(const u32x4*)(U + ro_ + UHF); pv[q_] = *(const u32x4*)(U + ro_ + UHV); } } while (0)
#define HG_LOAD_ST(item) do { _Pragma("unroll") for (int q_ = 0; q_ < 4; ++q_) { const int i_ = c.tid + q_ * NTHREADS; pst[q_] = *(const u32x4*)(ST + (size_t)(item) * 16384 + (i_ >> 4) * 128 + (i_ & 15) * 8); } } while (0)
    if (c.bid < 1024) { HG_LOAD_QFV(c.bid); HG_LOAD_ST(c.bid); }
    for (int it = c.bid; it < 1024; it += c.G) {
        const int ch = it & 31, bh = it >> 5, h = bh & 3, b = bh >> 2, tok0 = b * SEQ + ch * 64;
        const bool more = (it + c.G) < 1024;
#pragma unroll
        for (int q = 0; q < 2; ++q) { const int i = c.tid + q * NTHREADS, sr = i >> 4, ck = i & 15;
            const u32x4 rq = pq[q], rf = pf[q];
            *(LAS u32x4*)(VS + sr * 136 + ck * 8) = pv[q];
            const f32x4 l0 = *(const f32x4*)(lb + h * 128 + ck * 8), l1 = *(const f32x4*)(lb + h * 128 + ck * 8 + 4);
            f32x4 k0, k1, g0, g1;
            k0[0] = (1.0f - l0[0]) * sigmoidf_(-lo_bf(rf.x)); k0[1] = (1.0f - l0[1]) * sigmoidf_(-hi_bf(rf.x)); k0[2] = (1.0f - l0[2]) * sigmoidf_(-lo_bf(rf.y)); k0[3] = (1.0f - l0[3]) * sigmoidf_(-hi_bf(rf.y));
            k1[0] = (1.0f - l1[0]) * sigmoidf_(-lo_bf(rf.z)); k1[1] = (1.0f - l1[1]) * sigmoidf_(-hi_bf(rf.z)); k1[2] = (1.0f - l1[2]) * sigmoidf_(-lo_bf(rf.w)); k1[3] = (1.0f - l1[3]) * sigmoidf_(-hi_bf(rf.w));
#pragma unroll
            for (int j = 0; j < 4; ++j) { g0[j] = __logf(1.0f - k0[j]); g1[j] = __logf(1.0f - k1[j]); }
            u32x4 ko; ko.x = pk2(k0[0], k0[1]); ko.y = pk2(k0[2], k0[3]); ko.z = pk2(k1[0], k1[1]); ko.w = pk2(k1[2], k1[3]);
            u32x4 qo; qo.x = pk2(siluf_(lo_bf(rq.x)), siluf_(hi_bf(rq.x))); qo.y = pk2(siluf_(lo_bf(rq.y)), siluf_(hi_bf(rq.y))); qo.z = pk2(siluf_(lo_bf(rq.z)), siluf_(hi_bf(rq.z))); qo.w = pk2(siluf_(lo_bf(rq.w)), siluf_(hi_bf(rq.w)));
            *(LAS u32x4*)(Ks + sr * 136 + ck * 8) = ko; *(LAS u32x4*)(Qs + sr * 136 + ck * 8) = qo;
            *(LAS f32x4*)(Bf + sr * 132 + ck * 8) = g0; *(LAS f32x4*)(Bf + sr * 132 + ck * 8 + 4) = g1; }
        if (more) HG_LOAD_QFV(it + c.G);
        LDS_BARRIER();
        { const int kc = c.tid & 127, q4 = c.tid >> 7; float vals[16]; float cum = 0.f;
#pragma unroll
          for (int i = 0; i < 16; ++i) { cum += Bf[(16 * q4 + i) * 132 + kc]; vals[i] = cum; }
          QT[q4 * 128 + kc] = cum;
          LDS_BARRIER();
          float off = 0.f;
#pragma unroll
          for (int j = 0; j < 3; ++j) off += (j < q4) ? QT[j * 128 + kc] : 0.f;
#pragma unroll
          for (int i = 0; i < 16; ++i) Bf[(16 * q4 + i) * 132 + kc] = vals[i] + off; }
        LDS_BARRIER();
        for (int i = c.tid; i < 48 * 64; i += NTHREADS) { const int rowq = i >> 6, kp = i & 63, ib = (rowq >> 4) + 1, t = 16 + rowq, rref = 16 * ib - 1;
            const unsigned q2 = *(const LAS unsigned*)(Qs + t * 136 + 2 * kp);
            *(LAS unsigned*)(QI3 + rowq * 136 + 2 * kp) = pk2(lo_bf(q2) * __expf(Bf[t * 132 + 2 * kp] - Bf[rref * 132 + 2 * kp]), hi_bf(q2) * __expf(Bf[t * 132 + 2 * kp + 1] - Bf[rref * 132 + 2 * kp + 1])); }
        for (int i = c.tid; i < 96 * 64; i += NTHREADS) { const int rowk = i >> 6, kp = i & 63; const int ib = (rowk < 16) ? 1 : (rowk < 48 ? 2 : 3), s2 = rowk - 8 * ib * (ib - 1), rref = 16 * ib - 1;
            const unsigned k2 = *(const LAS unsigned*)(Ks + s2 * 136 + 2 * kp);
            *(LAS unsigned*)(KKI3 + rowk * 136 + 2 * kp) = pk2(lo_bf(k2) * __expf(Bf[rref * 132 + 2 * kp] - Bf[s2 * 132 + 2 * kp]), hi_bf(k2) * __expf(Bf[rref * 132 + 2 * kp + 1] - Bf[s2 * 132 + 2 * kp + 1])); }
        for (int pidx = c.tid; pidx < 1024; pidx += NTHREADS) {
            const int ib = pidx >> 8, tq = (pidx >> 4) & 15, sq = pidx & 15, t = 16 * ib + tq, s2 = 16 * ib + sq; float a = 0.f;
            if (sq <= tq) {
                for (int k = 0; k < 128; k += 4) {
                    const f32x4 bt = *(const LAS f32x4*)(Bf + t * 132 + k), bs = *(const LAS f32x4*)(Bf + s2 * 132 + k);
                    const u32x2 qv = *(const LAS u32x2*)(Qs + t * 136 + k), kv = *(const LAS u32x2*)(Ks + s2 * 136 + k);
                    a += lo_bf(qv.x) * lo_bf(kv.x) * __expf(bt[0] - bs[0]) + hi_bf(qv.x) * hi_bf(kv.x) * __expf(bt[1] - bs[1])
                       + lo_bf(qv.y) * lo_bf(kv.y) * __expf(bt[2] - bs[2]) + hi_bf(qv.y) * hi_bf(kv.y) * __expf(bt[3] - bs[3]);
                }
            }
            ATT[t * 72 + s2] = (bf16_t)f2bf(a);
        }
        for (int i = c.tid; i < 6 * 256; i += NTHREADS) { const int blk = i >> 8, e = i & 255; const int bi = (blk < 3) ? 0 : (blk < 5 ? 1 : 2), bj = (blk < 3) ? blk + 1 : (blk < 5 ? blk - 1 : 3);
            ATT[(16 * bi + (e >> 4)) * 72 + 16 * bj + (e & 15)] = (bf16_t)0; }
        LDS_BARRIER();
        if (w < 6) {
            const int ib = (w == 0) ? 1 : (w < 3 ? 2 : 3), jb = w - ((ib * (ib - 1)) >> 1);
            f32x4 a4 = (f32x4){0.f, 0.f, 0.f, 0.f};
#pragma unroll
            for (int ks = 0; ks < 4; ++ks) { const bf16x8 afr = *(const LAS bf16x8*)(QI3 + (16 * (ib - 1) + fr) * 136 + ks * 32 + 8 * fq), bfr = *(const LAS bf16x8*)(KKI3 + (8 * ib * (ib - 1) + 16 * jb + fr) * 136 + ks * 32 + 8 * fq); a4 = MFMA16(afr, bfr, a4); }
#pragma unroll
            for (int r = 0; r < 4; ++r) ATT[(16 * ib + 4 * fq + r) * 72 + 16 * jb + fr] = (bf16_t)f2bf(a4[r]);
        }
        for (int i = c.tid; i < 64 * 64; i += NTHREADS) { const int t = i >> 6, kp = i & 63;
            const unsigned q2 = *(const LAS unsigned*)(Qs + t * 136 + 2 * kp);
            *(LAS unsigned*)(Qs + t * 136 + 2 * kp) = pk2(lo_bf(q2) * __expf(Bf[t * 132 + 2 * kp]), hi_bf(q2) * __expf(Bf[t * 132 + 2 * kp + 1])); }
        LDS_BARRIER();
#pragma unroll
        for (int q = 0; q < 4; ++q) { const int i = c.tid + q * NTHREADS; *(LAS u32x4*)(STs + (i >> 4) * 136 + (i & 15) * 8) = pst[q]; }
        if (more) HG_LOAD_ST(it + c.G);
        LDS_BARRIER();
        f32x4 acc[4];
#pragma unroll
        for (int m = 0; m < 4; ++m) acc[m] = (f32x4){0.f, 0.f, 0.f, 0.f};
#pragma unroll
        for (int ks = 0; ks < 4; ++ks) {
            const bf16x8 bfr = *(const LAS bf16x8*)(STs + (16 * w + fr) * 136 + ks * 32 + 8 * fq);
#pragma unroll
            for (int m = 0; m < 4; ++m) { const bf16x8 afr = *(const LAS bf16x8*)(Qs + (16 * m + fr) * 136 + ks * 32 + 8 * fq); acc[m] = MFMA16(afr, bfr, acc[m]); }
        }
#pragma unroll
        for (int ks = 0; ks < 2; ++ks) {
            const bf16x8 bfr = tr_frag(VS, 136, 32 * ks, 16 * w, c.lane);
#pragma unroll
            for (int m = 0; m < 4; ++m) { const bf16x8 afr = *(const LAS bf16x8*)(ATT + (16 * m + fr) * 72 + ks * 32 + 8 * fq); acc[m] = MFMA16(afr, bfr, acc[m]); }
        }
#pragma unroll
        for (int m = 0; m < 4; ++m)
#pragma unroll
            for (int r = 0; r < 4; ++r) Bf[(16 * m + 4 * fq + r) * 132 + 16 * w + fr] = acc[m][r];
        LDS_BARRIER();
        {
            const int t = c.tid >> 3, part = c.tid & 7;
            f32x4 o4[4]; float ss = 0.f;
#pragma unroll
            for (int i = 0; i < 4; ++i) { o4[i] = *(const LAS f32x4*)(Bf + t * 132 + part * 16 + 4 * i); ss += (o4[i][0] * o4[i][0] + o4[i][1] * o4[i][1]) + (o4[i][2] * o4[i][2] + o4[i][3] * o4[i][3]); }
            const u32x4 g0 = *(const u32x4*)(U + (size_t)(tok0 + t) * NU + UHG + h * 128 + part * 16), g1 = *(const u32x4*)(U + (size_t)(tok0 + t) * NU + UHG + h * 128 + part * 16 + 8);
            ss += shfl_xor_l(ss, 1, c.lane); ss += shfl_xor_l(ss, 2, c.lane); ss += shfl_xor_l(ss, 4, c.lane);
            const float rstd = rsqf_(ss * (1.0f / 128.0f) + EPS);
            const float* nwp = nw + h * 128 + part * 16;
            const f32x4 n0 = *(const f32x4*)(nwp), n1 = *(const f32x4*)(nwp + 4), n2 = *(const f32x4*)(nwp + 8), n3 = *(const f32x4*)(nwp + 12);
            u32x4 r0, r1;
            r0.x = pk2(o4[0][0] * rstd * n0[0] * siluf_(lo_bf(g0.x)), o4[0][1] * rstd * n0[1] * siluf_(hi_bf(g0.x))); r0.y = pk2(o4[0][2] * rstd * n0[2] * siluf_(lo_bf(g0.y)), o4[0][3] * rstd * n0[3] * siluf_(hi_bf(g0.y)));
            r0.z = pk2(o4[1][0] * rstd * n1[0] * siluf_(lo_bf(g0.z)), o4[1][1] * rstd * n1[1] * siluf_(hi_bf(g0.z))); r0.w = pk2(o4[1][2] * rstd * n1[2] * siluf_(lo_bf(g0.w)), o4[1][3] * rstd * n1[3] * siluf_(hi_bf(g0.w)));
            r1.x = pk2(o4[2][0] * rstd * n2[0] * siluf_(lo_bf(g1.x)), o4[2][1] * rstd * n2[1] * siluf_(hi_bf(g1.x))); r1.y = pk2(o4[2][2] * rstd * n2[2] * siluf_(lo_bf(g1.y)), o4[2][3] * rstd * n2[3] * siluf_(hi_bf(g1.y)));
            r1.z = pk2(o4[3][0] * rstd * n3[0] * siluf_(lo_bf(g1.z)), o4[3][1] * rstd * n3[1] * siluf_(hi_bf(g1.z))); r1.w = pk2(o4[3][2] * rstd * n3[2] * siluf_(lo_bf(g1.w)), o4[3][3] * rstd * n3[3] * siluf_(hi_bf(g1.w)));
            bf16_t* yo = YC + (size_t)(tok0 + t) * 2048 + 1024 + h * 128 + part * 16;
            *(u32x4*)yo = r0; *(u32x4*)(yo + 8) = r1;
        }
        LDS_BARRIER();
    }
#undef HG_LOAD_QFV
#undef HG_LOAD_ST
}

__device__ __forceinline__ void phase_lru1(const Params& p, const Ctx& c, int l) {
    LAS unsigned char* wl = c.lds + c.wave * 12288;
    LAS bf16_t* XB = (LAS bf16_t*)wl;
    LAS float* As = (LAS float*)(wl + 2304);
    LAS float* Us = (LAS float*)(wl + 2304 + 4096);
    const bf16_t* U = (const bf16_t*)(p.ws + WS_U); bf16_t* LA = (bf16_t*)(p.ws + WS_LA); bf16_t* LH = (bf16_t*)(p.ws + WS_LH);
    const bf16_t* LW = (const bf16_t*)(p.ws + WS_LRUW) + (size_t)l * 2 * 8 * 4096;
    const int fr = c.lane & 15, fq = c.lane >> 4, g = c.wave, chn = g * 64 + c.lane;
    const float cw0 = p.in[I_LCW][(size_t)l * 2048 + chn], cw1 = p.in[I_LCW][(size_t)l * 2048 + 512 + chn], cw2 = p.in[I_LCW][(size_t)l * 2048 + 1024 + chn], cw3 = p.in[I_LCW][(size_t)l * 2048 + 1536 + chn];
    const float cbias = p.in[I_LCB][l * 512 + chn];
    bf16x8 wfa[4][2], wfx[4][2];
#pragma unroll
    for (int n = 0; n < 4; ++n)
#pragma unroll
        for (int ks = 0; ks < 2; ++ks) { wfa[n][ks] = *(const bf16x8*)(LW + (size_t)(0 * 8 + g) * 4096 + (16 * n + fr) * 64 + ks * 32 + 8 * fq);
                                         wfx[n][ks] = *(const bf16x8*)(LW + (size_t)(1 * 8 + g) * 4096 + (16 * n + fr) * 64 + ks * 32 + 8 * fq); }
    float bav[4], bxv[4], spl[4];
#pragma unroll
    for (int n = 0; n < 4; ++n) { const int j = g * 64 + 16 * n + fr; bav[n] = p.in[I_LBA][l * 512 + j]; bxv[n] = p.in[I_LBX][l * 512 + j]; spl[n] = softplusf_(-p.in[I_LLAM][l * 512 + j]); }
    for (int it = c.bid; it < 256; it += c.G) {
        const int seg = it & 31, tok0 = (it >> 5) * SEQ + seg * 64;
        float x0 = 0.f, x1 = 0.f, x2 = 0.f;
        if (seg > 0) { x0 = bf2f(U[(size_t)(tok0 - 3) * NU + ULX + chn]); x1 = bf2f(U[(size_t)(tok0 - 2) * NU + ULX + chn]); x2 = bf2f(U[(size_t)(tok0 - 1) * NU + ULX + chn]); }
        float hrun = 0.f, arun = 1.f;
        for (int st = 0; st < 4; ++st) {
            const int t0 = tok0 + st * 16;
#pragma unroll
            for (int tt = 0; tt < 16; ++tt) { const float xr = bf2f(U[(size_t)(t0 + tt) * NU + ULX + chn]);
                const float xb = cbias + cw0 * x0 + cw1 * x1 + cw2 * x2 + cw3 * xr; x0 = x1; x1 = x2; x2 = xr;
                XB[tt * 72 + c.lane] = (bf16_t)f2bf(xb); }
            LDS_WAIT();
            f32x4 ar[4], ai[4];
#pragma unroll
            for (int n = 0; n < 4; ++n) { ar[n] = (f32x4){0.f, 0.f, 0.f, 0.f}; ai[n] = (f32x4){0.f, 0.f, 0.f, 0.f}; }
#pragma unroll
            for (int ks = 0; ks < 2; ++ks) { const bf16x8 afr = *(const LAS bf16x8*)(XB + fr * 72 + ks * 32 + 8 * fq);
#pragma unroll
                for (int n = 0; n < 4; ++n) { ar[n] = MFMA16(afr, wfa[n][ks], ar[n]); ai[n] = MFMA16(afr, wfx[n][ks], ai[n]); } }
#pragma unroll
            for (int n = 0; n < 4; ++n)
#pragma unroll
                for (int r = 0; r < 4; ++r) { const int t = 4 * fq + r, j = 16 * n + fr;
                    const float rg = sigmoidf_(ar[n][r] + bav[n]), ig = sigmoidf_(ai[n][r] + bxv[n]);
                    const float la = -8.0f * rg * spl[n], a = __expf(la), mult = __builtin_amdgcn_sqrtf(fmaxf(fmaf(-a, a, 1.0f), 0.f));
                    As[t * 64 + j] = a; Us[t * 64 + j] = mult * ig * bf2f(XB[t * 72 + j]); }
            LDS_WAIT();
#pragma unroll
            for (int tt = 0; tt < 16; ++tt) { const float a = As[tt * 64 + c.lane], uu = Us[tt * 64 + c.lane];
                hrun = a * hrun + uu; arun = a * arun;
                LA[(size_t)(t0 + tt) * 512 + chn] = (bf16_t)f2bf(arun); LH[(size_t)(t0 + tt) * 512 + chn] = (bf16_t)f2bf(hrun); }
            LDS_WAIT();
        }
    }
}
__device__ __forceinline__ void phase_lru2(const Params& p, const Ctx& c, int l) {
    LAS float* YS = (LAS float*)c.lds;
    LAS float* RS = (LAS float*)(c.lds + 64 * 516 * 4);
    const bf16_t* U = (const bf16_t*)(p.ws + WS_U); const bf16_t* LA = (const bf16_t*)(p.ws + WS_LA); const bf16_t* LH = (const bf16_t*)(p.ws + WS_LH);
    bf16_t* YC = (bf16_t*)(p.ws + WS_YCAT);
    const int g = c.wave, chn = g * 64 + c.lane;
    const float nwv = p.in[I_LNW][l * 512 + chn];
    for (int it = c.bid; it < 256; it += c.G) {
        const int seg = it & 31, b = it >> 5, tok0 = b * SEQ + seg * 64;
        float hin = 0.f;
        for (int s2 = 0; s2 < seg; ++s2) { const size_t row = (size_t)(b * SEQ + s2 * 64 + 63); hin = bf2f(LH[row * 512 + chn]) + bf2f(LA[row * 512 + chn]) * hin; }
#pragma unroll 8
        for (int tt = 0; tt < 64; ++tt) { const size_t tok = (size_t)(tok0 + tt);
            const float hh = bf2f(LH[tok * 512 + chn]) + bf2f(LA[tok * 512 + chn]) * hin;
            YS[tt * 516 + chn] = hh * gelu_tanhf_(bf2f(U[tok * NU + ULG + chn])); }
        LDS_BARRIER();
        {
            const int t = c.tid >> 3, part = c.tid & 7; float ss = 0.f;
#pragma unroll
            for (int i = 0; i < 16; ++i) { const f32x4 v = *(const LAS f32x4*)(YS + t * 516 + 32 * i + 4 * part); ss += (v[0] * v[0] + v[1] * v[1]) + (v[2] * v[2] + v[3] * v[3]); }
            ss += shfl_xor_l(ss, 1, c.lane); ss += shfl_xor_l(ss, 2, c.lane); ss += shfl_xor_l(ss, 4, c.lane);
            if (part == 0) RS[t] = rsqf_(ss * (1.0f / 512.0f) + EPS);
        }
        LDS_BARRIER();
#pragma unroll 8
        for (int tt = 0; tt < 64; ++tt) YC[(size_t)(tok0 + tt) * 2048 + 1536 + chn] = (bf16_t)f2bf(YS[tt * 516 + chn] * RS[tt] * nwv);
        LDS_BARRIER();
    }
}

__device__ __forceinline__ void phase_norm_router(const Params& p, const Ctx& c, int l, const float* xin) {
    constexpr int HSTR = 1028;
    LAS float* HS = (LAS float*)c.lds;
    LAS float* PL = (LAS float*)(c.lds + 16 * HSTR * 4);
    LAS float* LG = (LAS float*)(c.lds + 16 * HSTR * 4 + 32768);
    const float* mod = (const float*)(p.ws + WS_MOD) + (size_t)l * 8 * NMOD;
    const float* nw = p.in[I_NFFN] + (size_t)l * DM;
    const float* WT = (const float*)(p.ws + WS_WRT) + (size_t)l * 64 * 1024;
    const float rbias = p.in[I_RB][l * NEXP + c.lane];
    bf16_t* H = (bf16_t*)(p.ws + WS_H);
    unsigned long long* selm = (unsigned long long*)(p.ws + WS_SELM); float* rw = (float*)(p.ws + WS_RW);
    const int fr = c.lane & 15, fq = c.lane >> 4, w = c.wave;
    int* cnt = (int*)(p.ws + WS_CNT);
    f32x4 bw[8][4];
#pragma unroll
    for (int j = 0; j < 8; ++j)
#pragma unroll
        for (int n = 0; n < 4; ++n) bw[j][n] = *(const f32x4*)(WT + (size_t)(16 * n + fr) * 1024 + 128 * w + 16 * j + 4 * fq);
    int ecount = 0;
    f32x4 xn[2][4];
    if (c.bid < NTOK / 16) {
#pragma unroll
        for (int q = 0; q < 2; ++q)
#pragma unroll
            for (int j = 0; j < 4; ++j) xn[q][j] = ((const f32x4*)(xin + (size_t)(c.bid * 16 + 2 * w + q) * DM) + c.lane)[64 * j];
    }
    for (int t16 = c.bid; t16 < NTOK / 16; t16 += c.G) {
        const int tokb = t16 * 16, b = tokb >> 11;
        f32x4 pa[4], pb[4];
#pragma unroll
        for (int j = 0; j < 4; ++j) { const int col = 256 * j + 4 * c.lane;
            const f32x4 w4 = *(const f32x4*)(nw + col), sc = *(const f32x4*)(mod + (size_t)b * NMOD + 4096 + col); pb[j] = *(const f32x4*)(mod + (size_t)b * NMOD + 3072 + col); pa[j] = w4 * (sc + 1.0f); }
#pragma unroll
        for (int q = 0; q < 2; ++q) {
            const int tl = 2 * w + q, tok = tokb + tl;
            f32x4 v[4]; float ss = 0.f;
#pragma unroll
            for (int j = 0; j < 4; ++j) { v[j] = xn[q][j]; ss += (v[j][0] * v[j][0] + v[j][1] * v[j][1]) + (v[j][2] * v[j][2] + v[j][3] * v[j][3]); }
            const float rstd = rsqf_(wave_sum(ss, c.lane) * (1.0f / DM) + EPS);
#pragma unroll
            for (int j = 0; j < 4; ++j) {
                const int col = 256 * j + 4 * c.lane;
                const f32x4 h = (v[j] * rstd) * pa[j] + pb[j];
                u32x2 o; o.x = pk2(h[0], h[1]); o.y = pk2(h[2], h[3]);
                *(u32x2*)(H + (size_t)tok * DM + col) = o;
                *(LAS f32x4*)(HS + tl * HSTR + col) = h;
            }
        }
        if (t16 + c.G < NTOK / 16) {
#pragma unroll
            for (int q = 0; q < 2; ++q)
#pragma unroll
                for (int j = 0; j < 4; ++j) xn[q][j] = ((const f32x4*)(xin + (size_t)((t16 + c.G) * 16 + 2 * w + q) * DM) + c.lane)[64 * j];
        }
        LDS_BARRIER();
        {
            f32x4 acc[4];
#pragma unroll
            for (int n = 0; n < 4; ++n) acc[n] = (f32x4){0.f, 0.f, 0.f, 0.f};
#pragma unroll
            for (int j = 0; j < 8; ++j) {
                const int kk = 128 * w + 16 * j + 4 * fq;
                const f32x4 a4 = *(const LAS f32x4*)(HS + fr * HSTR + kk);
#pragma unroll
                for (int i = 0; i < 4; ++i)
#pragma unroll
                    for (int n = 0; n < 4; ++n) acc[n] = __builtin_amdgcn_mfma_f32_16x16x4f32(a4[i], bw[j][n][i], acc[n], 0, 0, 0);
            }
#pragma unroll
            for (int n = 0; n < 4; ++n)
#pragma unroll
                for (int r = 0; r < 4; ++r) PL[(w * 16 + 4 * fq + r) * 64 + 16 * n + fr] = acc[n][r];
        }
        LDS_BARRIER();
        for (int i = c.tid; i < 1024; i += NTHREADS) { float s2 = 0.f;
#pragma unroll
            for (int ww = 0; ww < 8; ++ww) s2 += PL[ww * 1024 + i];
            LG[i] = s2; }
        LDS_BARRIER();
#pragma unroll
        for (int q = 0; q < 2; ++q) {
            const int tl = 2 * w + q, tok = tokb + tl;
            const float s = sigmoidf_(LG[tl * 64 + c.lane]), v = s + rbias;
            float m1 = v;
            m1 = fmaxf(m1, shfl_xor_l(m1, 1, c.lane)); m1 = fmaxf(m1, shfl_xor_l(m1, 2, c.lane)); m1 = fmaxf(m1, shfl_xor_l(m1, 4, c.lane));
            const unsigned long long eq = __ballot(v == m1);
            const int gbase = c.lane & ~7;
            const unsigned gm = (unsigned)((eq >> gbase) & 0xffull);
            const int first = gbase + __builtin_ctz(gm);
            float m2 = (c.lane == first) ? -3.0e38f : v;
            m2 = fmaxf(m2, shfl_xor_l(m2, 1, c.lane)); m2 = fmaxf(m2, shfl_xor_l(m2, 2, c.lane)); m2 = fmaxf(m2, shfl_xor_l(m2, 4, c.lane));
            const float gs = m1 + m2;
            const int mygrp = c.lane >> 3; int grank = 0;
#pragma unroll
            for (int g2 = 0; g2 < 8; ++g2) { const float o = rdlane_f(gs, g2 * 8); grank += (o > gs || (o == gs && g2 < mygrp)) ? 1 : 0; }
            const float vm = (grank < 4) ? v : -1.0e4f;
            int erank = 0;
            for (int e2 = 0; e2 < 64; ++e2) { const float o = rdlane_f(vm, e2); erank += (int)(o > vm) + (int)((o == vm) & (e2 < c.lane)); }
            const bool sel = erank < TOPK;
            const unsigned long long mask = __ballot(sel);
            const float wsum = wave_sum(sel ? s : 0.f, c.lane);
            if (sel) { const int kk = __builtin_popcountll(mask & ((1ull << c.lane) - 1ull)); rw[(size_t)tok * 8 + kk] = s * rcpf_(wsum) * 2.5f; }
            if (c.lane == 0) selm[tok] = mask;
            ecount += sel ? 1 : 0;
        }
        LDS_BARRIER();
    }
    { LAS int* CW = (LAS int*)c.lds; CW[w * 64 + c.lane] = ecount; LDS_BARRIER();
      if (w == 0) { int tot = 0;
#pragma unroll
          for (int ww = 0; ww < 8; ++ww) tot += CW[ww * 64 + c.lane];
          cnt[c.bid * 64 + c.lane] = tot; }
      LDS_BARRIER(); }
}
__device__ __forceinline__ void phase_route_assign(const Params& p, const Ctx& c) {
    const unsigned long long* selm = (const unsigned long long*)(p.ws + WS_SELM); const int* cnt = (const int*)(p.ws + WS_CNT);
    int* slot_tok = (int*)(p.ws + WS_SLOTTOK); int* slot_of = (int*)(p.ws + WS_SLOTOF); int* rinfo = (int*)(p.ws + WS_RINFO);
    const int gw = c.bid * NWAVES + c.wave, NGW = c.G * NWAVES;
    for (int ch = gw; ch < c.G; ch += NGW) {
        int total = 0, before = 0;
        for (int j = 0; j < c.G; ++j) { const int v = cnt[j * 64 + c.lane]; total += v; before += (j < ch) ? v : 0; }
        const int pad = (total + 255) & ~255;
        int incl = pad;
#pragma unroll
        for (int o = 1; o < 64; o <<= 1) { const int t = shfl_up_l(incl, o, c.lane); if (c.lane >= o) incl += t; }
        const int pstart = incl - pad;
        int run = pstart + before;
        for (int t16 = ch; t16 < NTOK / 16; t16 += c.G) {
            const unsigned long long mine = (c.lane < 16) ? selm[t16 * 16 + c.lane] : 0ull;
            for (int i = 0; i < 16; ++i) {
                const unsigned long long m = rdlane_u64(mine, i); const int tok = t16 * 16 + i;
                if ((m >> c.lane) & 1ull) { const int kk = __builtin_popcountll(m & ((1ull << c.lane) - 1ull)); slot_tok[run] = tok; slot_of[tok * 8 + kk] = run; ++run; }
            }
        }
        if (ch == 0) {
            for (int s2 = pstart + total; s2 < pstart + pad; ++s2) slot_tok[s2] = -1;
            for (int bk = pstart >> 8; bk < (pstart + pad) >> 8; ++bk) rinfo[64 + bk] = c.lane;
            if (c.lane == 63) rinfo[0] = incl >> 8;
        }
    }
}
__device__ __forceinline__ void phase_combine(const Params& p, const Ctx& c, int l) {
    const float* gate = (const float*)(p.ws + WS_MOD) + (size_t)l * 8 * NMOD + 5120;
    const unsigned char* Y = (const unsigned char*)(p.ws + WS_Y); const unsigned char* YS = (const unsigned char*)(p.ws + WS_YSH); const int* slot_of = (const int*)(p.ws + WS_SLOTOF); const float* rw = (const float*)(p.ws + WS_RW);
    const float* fw = p.in[I_FNW];
    if (l + 1 < NLAYER) load_wdt(p, c, l + 1, (LAS float*)c.lds);
    const int gw = c.bid * NWAVES + c.wave, NGW = c.G * NWAVES;
    for (int tok = gw; tok < NTOK; tok += NGW) {
        const int b = tok >> 11;
        f32x4 acc[4], gvv[4], xv0[4];
        f32x4* xr = (f32x4*)(p.out + (size_t)tok * DM) + c.lane;
#pragma unroll
        for (int j = 0; j < 4; ++j) { acc[j] = (f32x4){0.f, 0.f, 0.f, 0.f}; gvv[j] = *(const f32x4*)(gate + (size_t)b * NMOD + 256 * j + 4 * c.lane); xv0[j] = xr[64 * j]; }
#pragma unroll
        for (int k = 0; k < 8; ++k) { const int sl = slot_of[tok * 8 + k]; const float wk = rw[tok * 8 + k] * Y8_INV;
#pragma unroll
            for (int j = 0; j < 4; ++j) { const int yw = (int)*(const unsigned*)(Y + (size_t)sl * DM + 256 * j + 4 * c.lane);
                const f32x2 y01 = __builtin_amdgcn_cvt_pk_f32_fp8(yw, false), y23 = __builtin_amdgcn_cvt_pk_f32_fp8(yw, true);
                acc[j][0] += wk * y01[0]; acc[j][1] += wk * y01[1]; acc[j][2] += wk * y23[0]; acc[j][3] += wk * y23[1]; } }
#pragma unroll
        for (int j = 0; j < 4; ++j) { const int yw = (int)*(const unsigned*)(YS + (size_t)tok * DM + 256 * j + 4 * c.lane);
            const f32x2 y01 = __builtin_amdgcn_cvt_pk_f32_fp8(yw, false), y23 = __builtin_amdgcn_cvt_pk_f32_fp8(yw, true);
            acc[j][0] += Y8_INV * y01[0]; acc[j][1] += Y8_INV * y01[1]; acc[j][2] += Y8_INV * y23[0]; acc[j][3] += Y8_INV * y23[1]; }
        f32x4 v[4]; float ss = 0.f;
#pragma unroll
        for (int j = 0; j < 4; ++j) { v[j] = xv0[j] + gvv[j] * acc[j];
            ss += (v[j][0] * v[j][0] + v[j][1] * v[j][1]) + (v[j][2] * v[j][2] + v[j][3] * v[j][3]); }
        if (l == NLAYER - 1) {
            const float rstd = rsqf_(wave_sum(ss, c.lane) * (1.0f / DM) + EPS);
#pragma unroll
            for (int j = 0; j < 4; ++j) { const f32x4 w4 = *(const f32x4*)(fw + 256 * j + 4 * c.lane); xr[64 * j] = v[j] * rstd * w4; }
        } else {
#pragma unroll
            for (int j = 0; j < 4; ++j) xr[64 * j] = v[j];
            norm_mix_row(c, v, ss, tok, p.in[I_NMIX] + (size_t)(l + 1) * DM, (const float*)(p.ws + WS_MOD) + (size_t)(l + 1) * 8 * NMOD, (const LAS float*)c.lds, (bf16_t*)(p.ws + WS_H), (float*)(p.ws + WS_DTRAW));
        }
    }
}


#define XB_TMO      128
#define XB_XCNT(j)  (256  + 64 * (j))
#define XB_XSUB(j)  (1280 + 64 * (j))
#define XB_XGEN(j)  (2304 + 64 * (j))
#define XB_TOP      3328
#define XB_TOPGEN   3392
#define XCD_BAR_WORDS 3456
#define XB_SPIN_CAP (1u << 18)
constexpr int LDS_XBST = LDS_PTAB + 320;
__device__ __forceinline__ unsigned xb_ld(unsigned* p)              { return __hip_atomic_load(p, __ATOMIC_RELAXED, __HIP_MEMORY_SCOPE_AGENT); }
__device__ __forceinline__ unsigned xb_add(unsigned* p, unsigned v) { return __hip_atomic_fetch_add(p, v, __ATOMIC_RELAXED, __HIP_MEMORY_SCOPE_AGENT); }
__device__ __forceinline__ unsigned xb_xcc_id() { return (unsigned)__builtin_amdgcn_s_getreg((3 << 11) | 20) & 0xFu; }
#define XB_SPIN(cond, bar) do { unsigned _sp = 0; while (cond) { __builtin_amdgcn_s_sleep(1); \
    if ((++_sp & 255u) == 0u) { if (xb_ld(&(bar)[XB_TMO])) break; if (_sp > XB_SPIN_CAP) { atomicAdd(&(bar)[XB_TMO], 1u); break; } } } } while (0)
__device__ __forceinline__ void xcd_barrier_complete(unsigned* bar, unsigned x, unsigned& nloc, unsigned& nx) {
    const unsigned G = gridDim.x * gridDim.y * gridDim.z;
    unsigned sum, cnt, mine, sp = 0u;
    for (;;) {
        sum = 0u; cnt = 0u; mine = 0u;
#pragma unroll
        for (unsigned j = 0; j < 16; ++j) { const unsigned c = xb_ld(&bar[XB_XCNT(j)]); sum += c; cnt += (c > 0u) ? 1u : 0u; mine = (j == x) ? c : mine; }
        if (sum == G) break;
        __builtin_amdgcn_s_sleep(1);
        if ((++sp & 255u) == 0u) { if (xb_ld(&bar[XB_TMO])) break; if (sp > XB_SPIN_CAP) { atomicAdd(&bar[XB_TMO], 1u); break; } }
    }
    nloc = mine > 0u ? mine : 1u; nx = cnt > 0u ? cnt : 1u;
}
__device__ __forceinline__ void xcd_barrier(unsigned* bar, volatile LAS unsigned* st, bool leader_thread) {
    asm volatile("s_waitcnt vmcnt(0)" ::: "memory");
    __syncthreads();
    if (leader_thread) {
        const unsigned x = xb_xcc_id();
        __builtin_amdgcn_s_waitcnt(0);
        unsigned nloc = st[0], nx = st[1];
        if (nloc == 0u) { xcd_barrier_complete(bar, x, nloc, nx); st[0] = nloc; st[1] = nx; }
        const unsigned old = xb_add(&bar[XB_XSUB(x)], 1u);
        const unsigned gen = old / nloc;
        if (old + 1u == (gen + 1u) * nloc) {
            __builtin_amdgcn_fence(__ATOMIC_RELEASE, "agent");
            asm volatile("s_waitcnt vmcnt(0)" ::: "memory");
            const unsigned og = xb_add(&bar[XB_TOP], 1u);
            const unsigned tg = og / nx;
            if (og + 1u == (tg + 1u) * nx) xb_add(&bar[XB_TOPGEN], 1u);
            else XB_SPIN(xb_ld(&bar[XB_TOPGEN]) == tg, bar);
            __builtin_amdgcn_fence(__ATOMIC_ACQUIRE, "agent");
            xb_add(&bar[XB_XGEN(x)], 1u);
            asm volatile("s_waitcnt vmcnt(0)" ::: "memory");
        } else {
            XB_SPIN(xb_ld(&bar[XB_XGEN(x)]) == gen, bar);
            __builtin_amdgcn_fence(__ATOMIC_ACQUIRE, "agent");
            asm volatile("s_waitcnt vmcnt(0)" ::: "memory");
        }
    }
    __syncthreads();
}

#ifndef PROBE_ID
#define PROBE_ID 0
#endif
#define RUN(id, stmt) do { stmt; if constexpr (PROBE_ID == (id)) { __syncthreads(); stmt; } } while (0)
constexpr int NQ_PHASE = 14;
__device__ __forceinline__ unsigned long long uni64(unsigned long long v) {
    const unsigned lo = (unsigned)__builtin_amdgcn_readfirstlane((int)(unsigned)v), hi = (unsigned)__builtin_amdgcn_readfirstlane((int)(unsigned)(v >> 32)); return ((unsigned long long)hi << 32) | lo; }
#if MK_MEGA
__device__ __forceinline__ void params_to_lds(const Params& p, LAS unsigned char* lds) {
    LAS unsigned long long* tab = (LAS unsigned long long*)(lds + LDS_PTAB);
#pragma unroll
    for (int i = 0; i < 33; ++i) tab[i] = (unsigned long long)p.in[i];
    tab[33] = (unsigned long long)p.out; tab[34] = (unsigned long long)p.ws;
}
__device__ __forceinline__ Params params_from_lds(LAS unsigned char* lds) {
    const LAS unsigned long long* tab = (const LAS unsigned long long*)(lds + LDS_PTAB);
    Params p;
#pragma unroll
    for (int i = 0; i < 33; ++i) p.in[i] = (const float*)(const __attribute__((address_space(1))) float*)uni64(tab[i]);
    p.out = (float*)(__attribute__((address_space(1))) float*)uni64(tab[33]); p.ws = (unsigned char*)(__attribute__((address_space(1))) unsigned char*)uni64(tab[34]); p.layer = 0; p.pad = 0;
    return p;
}
#endif
template <int Q> __device__ __forceinline__ void run_q(const Params& p_in, const Ctx& c_in, int l) {
    Ctx c = c_in;
    asm volatile("" : "+s"(c.wave), "+s"(c.bid), "+s"(c.G), "+s"(l));
    c.lane = fresh_lane(); c.tid = c.wave * 64 + c.lane;
#if MK_MEGA
    const Params p = params_from_lds(c.lds);
#else
    const Params& p = p_in;
#endif
    const float* xin = (l == 0) ? p.in[I_X] : p.out;
    if constexpr (Q == 14) { RUN(1, phase_prep_io(p, c); __syncthreads(); phase_prep_small(p, c)); __syncthreads(); RUN(2, phase_prep_experts(p, c, 0)); }
    if constexpr (Q == 0) { RUN(3, phase_norm_mix(p, c, l, xin)); }
    if constexpr (Q == 1) { pg8::Gemm g{(const bf16_t*)(p.ws + WS_H), (const bf16_t*)(p.ws + WS_WIN) + (size_t)l * NU * DM, DM, 0};
              pg8::DenseOrder S; S.init(NTOK, NU, c.G, c.bid); EpiU E{(bf16_t*)(p.ws + WS_U), NU};
              RUN(4, (pg8::gemm_phase<EpiU, pg8::DenseOrder, pg8::DenseRows, true, true>(c.lds, g, S, E, pg8::DenseRows(), c.wave))); }
    if constexpr (Q == 2) { RUN(5, phase_ssd_conv(p, c, l)); __syncthreads(); RUN(6, phase_hg_state(p, c, l)); __syncthreads(); RUN(7, phase_lru1(p, c, l)); }
    if constexpr (Q == 3) { RUN(8, phase_ssd_state(p, c)); __syncthreads(); phase_hg_scan(p, c); __syncthreads(); RUN(9, phase_lru2(p, c, l)); }
    if constexpr (Q == 4) { phase_ssd_scan(p, c); __syncthreads(); RUN(10, phase_hg_out(p, c, l)); }
    if constexpr (Q == 5) RUN(11, phase_ssd_out_g(p, c, l));
    if constexpr (Q == 7) { pg8::Gemm g{(const bf16_t*)(p.ws + WS_YCAT), (const bf16_t*)(p.ws + WS_WOUT) + (size_t)l * DM * 2048, 2048, 0};
              pg8::DenseOrder S; S.init(NTOK, DM, c.G, c.bid); EpiOut E{xin, p.out, (const float*)(p.ws + WS_MOD) + (size_t)l * 8 * NMOD + 2048};
              pg8::gemm_phase<EpiOut, pg8::DenseOrder, pg8::DenseRows, false, true>(c.lds, g, S, E, pg8::DenseRows(), c.wave);
              if constexpr (PROBE_ID == 13) { if (l == 0) { __syncthreads(); pg8::gemm_phase<EpiOut, pg8::DenseOrder, pg8::DenseRows, false, true>(c.lds, g, S, E, pg8::DenseRows(), c.wave); } } }
    if constexpr (Q == 8) RUN(14, phase_norm_router(p, c, l, p.out));
    if constexpr (Q == 9) RUN(15, phase_route_assign(p, c));
    if constexpr (Q == 11) { pg8::Gemm g{(const bf16_t*)(p.ws + WS_H), (const bf16_t*)(p.ws + WS_GU), DM, (size_t)512 * DM * 2};
               moe_build_units(c.lds, (const int*)(p.ws + WS_RINFO), 2, c.G, (c.G % 8 == 0) ? (c.bid % 8) * (c.G / 8) + c.bid / 8 : c.bid, c.tid);
               MoeOrder S{(const LAS int*)(c.lds + LDS_UTAB)}; EpiH E{(bf16_t*)(p.ws + WS_HMID)};
               GatherRows AM{(const int*)(p.ws + WS_SLOTTOK), (const int*)(p.ws + WS_RINFO)};
               RUN(16, (pg8::gemm_phase<EpiH, MoeOrder, GatherRows, true, true>(c.lds, g, S, E, AM, c.wave))); }
    if constexpr (Q == 12) { pg8::Gemm g{(const bf16_t*)(p.ws + WS_HMID), (const bf16_t*)(p.ws + WS_DN), 256, (size_t)DM * 256 * 2};
               moe_build_units(c.lds, (const int*)(p.ws + WS_RINFO), 4, c.G, (c.G % 8 == 0) ? (c.bid % 8) * (c.G / 8) + c.bid / 8 : c.bid, c.tid);
               MoeOrder S{(const LAS int*)(c.lds + LDS_UTAB)};
               EpiY E{(unsigned char*)(p.ws + WS_Y), (unsigned char*)(p.ws + WS_YSH), (const int*)(p.ws + WS_RINFO)};
               RUN(17, (pg8::gemm_phase<EpiY, MoeOrder, pg8::DenseRows, true, true>(c.lds, g, S, E, pg8::DenseRows(), c.wave))); }
    if constexpr (Q == 13) { phase_combine(p, c, l); if (l + 1 < NLAYER) { __syncthreads(); RUN(2, phase_prep_experts(p, c, l + 1)); } }
}

#if MK_MEGA
__global__ void __launch_bounds__(NTHREADS, 2) trunk_kernel(Params p) {
    extern __shared__ __attribute__((aligned(16))) unsigned char lds_raw[];
    Ctx c; c.lds = (LAS unsigned char*)lds_raw; c.tid = 0; c.lane = 0; c.wave = __builtin_amdgcn_readfirstlane(threadIdx.x >> 6); c.G = gridDim.x; c.bid = blockIdx.x;
    cg::grid_group grid = cg::this_grid();
    unsigned* const xbar = (unsigned*)(p.ws + WS_CTL) + 4096;
    if (threadIdx.x == 0) { params_to_lds(p, c.lds); ((LAS unsigned*)(c.lds + LDS_XBST))[0] = 0u; ((LAS unsigned*)(c.lds + LDS_XBST))[1] = 0u; ((LAS unsigned long long*)(c.lds + LDS_PTAB))[35] = (unsigned long long)xbar;
                            (void)xb_add(&xbar[XB_XCNT(xb_xcc_id())], 1u); }
    __syncthreads();
#define GSYNC1() do { unsigned* bar_ = (unsigned*)(__attribute__((address_space(1))) unsigned*)uni64(((const LAS unsigned long long*)(c.lds + LDS_PTAB))[35]); \
        xcd_barrier(bar_, (volatile LAS unsigned*)(c.lds + LDS_XBST), (c.wave == 0) && (fresh_lane() == 0)); } while (0)
#define GSYNC() do { GSYNC1(); if constexpr (PROBE_ID == 18) GSYNC1(); } while (0)
#define LAYER(l) do { \
        if ((l) == 0) { run_q<0>(p, c, l); GSYNC(); } run_q<1>(p, c, l); GSYNC(); run_q<2>(p, c, l); GSYNC(); run_q<3>(p, c, l); GSYNC(); run_q<4>(p, c, l); GSYNC(); \
        run_q<5>(p, c, l); GSYNC(); run_q<7>(p, c, l); GSYNC(); run_q<8>(p, c, l); GSYNC(); run_q<9>(p, c, l); GSYNC(); \
        run_q<11>(p, c, l); GSYNC(); run_q<12>(p, c, l); GSYNC(); run_q<13>(p, c, l); } while (0)
    run_q<14>(p, c, 0); __syncthreads(); grid.sync();
    LAYER(0); GSYNC();
    LAYER(1);
}
#else
template <int Q> __global__ void __launch_bounds__(NTHREADS, 2) phase_kernel(Params p) {
    extern __shared__ __attribute__((aligned(16))) unsigned char lds_raw[];
    Ctx c; c.lds = (LAS unsigned char*)lds_raw; c.tid = 0; c.lane = 0; c.wave = __builtin_amdgcn_readfirstlane(threadIdx.x >> 6); c.G = gridDim.x; c.bid = blockIdx.x;
    run_q<Q>(p, c, p.layer);
}
template <int Q> static void launch_q(const Params& p, int grid, hipStream_t stream) {
    static bool attr = false;
    if (!attr) { (void)hipFuncSetAttribute((const void*)phase_kernel<Q>, hipFuncAttributeMaxDynamicSharedMemorySize, LDS_BYTES); attr = true; }
    hipLaunchKernelGGL(phase_kernel<Q>, dim3(grid), dim3(NTHREADS), LDS_BYTES, stream, p);
}
#endif

extern "C" void kernel_launch(void* const* d_in, const int* in_sizes, int n_in, void* d_out, int out_size, void* d_ws, size_t ws_size, hipStream_t stream) {
    static int grid = 0;
    if (grid == 0) {
        if (n_in != 33 || out_size != NTOK * DM || ws_size < WS_END) { fprintf(stderr, "kernel_launch: unexpected shapes (n_in %d out %d ws %zu)\n", n_in, out_size, ws_size); grid = -1; return; }
        int dev = 0, cus = 0;
        (void)hipGetDevice(&dev); (void)hipDeviceGetAttribute(&cus, hipDeviceAttributeMultiprocessorCount, dev);
        grid = cus > 0 ? cus : 256;
#if MK_MEGA
        int per_cu = 0;
        if (hipFuncSetAttribute((const void*)trunk_kernel, hipFuncAttributeMaxDynamicSharedMemorySize, LDS_BYTES) != hipSuccess) { fprintf(stderr, "kernel_launch: hipFuncSetAttribute failed\n"); grid = -1; return; }
        if (hipOccupancyMaxActiveBlocksPerMultiprocessor(&per_cu, (const void*)trunk_kernel, NTHREADS, LDS_BYTES) != hipSuccess || per_cu < 1) { fprintf(stderr, "kernel_launch: occupancy query says %d blocks/CU\n", per_cu); grid = -1; return; }
        (void)hipGetLastError();
#endif
    }
    if (grid < 0) return;
    (void)hipMemsetAsync((char*)d_ws + WS_CTL, 0, CTL_ZERO_BYTES, stream);
    Params p{};
    for (int i = 0; i < 33; ++i) p.in[i] = (const float*)d_in[i];
    p.out = (float*)d_out; p.ws = (unsigned char*)d_ws;
#if MK_MEGA
    void* args[] = {&p};
    hipError_t e = hipLaunchCooperativeKernel((const void*)trunk_kernel, dim3(grid), dim3(NTHREADS), args, LDS_BYTES, stream);
    if (e != hipSuccess) fprintf(stderr, "cooperative launch failed: %s (grid %d)\n", hipGetErrorString(e), grid);
#else
    p.layer = 0; launch_q<14>(p, grid, stream);
    for (int l = 0; l < NLAYER; ++l) {
        p.layer = l;
        launch_q<0>(p, grid, stream); launch_q<1>(p, grid, stream); launch_q<2>(p, grid, stream); launch_q<3>(p, grid, stream); launch_q<4>(p, grid, stream);
        launch_q<5>(p, grid, stream); launch_q<6>(p, grid, stream); launch_q<7>(p, grid, stream); launch_q<8>(p, grid, stream); launch_q<9>(p, grid, stream);
        launch_q<10>(p, grid, stream); launch_q<11>(p, grid, stream); launch_q<12>(p, grid, stream); launch_q<13>(p, grid, stream);
    }
#endif
}
```

```cpp
#include <hip/hip_runtime.h>
#include <hip/hip_cooperative_groups.h>
#include <cstdio>
#include <cstdint>
namespace cg = cooperative_groups;

#ifndef MK_MEGA
#define MK_MEGA 1
#endif

#define LAS __attribute__((address_space(3)))
typedef unsigned short bf16_t;
typedef short bf16x8 __attribute__((ext_vector_type(8)));
typedef float f32x4 __attribute__((ext_vector_type(4)));
typedef float f32x2 __attribute__((ext_vector_type(2)));
typedef unsigned u32x4 __attribute__((ext_vector_type(4)));
typedef unsigned u32x2 __attribute__((ext_vector_type(2)));

constexpr int NTOK = 16384, DM = 1024, SEQ = 2048, NBATCH = 8, NLAYER = 2;
constexpr int DIN = 5648, NU = 5632;
constexpr int UZ = 0, UXS = 1024, UB = 2048, UC = 2304, UHQ = 2560, UHF = 3072, UHV = 3584, UHG = 4096, ULG = 4608, ULX = 5120;
constexpr int NMOD = 6144;
constexpr float EPS = 1e-6f;
constexpr int NEXP = 64, TOPK = 8;
constexpr int MAXSLOT = 147456;
constexpr int NTHREADS = 512, NWAVES = 8;
constexpr int LDS_BYTES = 160 * 1024;
constexpr int LDS_PTAB = LDS_BYTES - 512;

constexpr size_t MiB = (size_t)1 << 20;
constexpr size_t WS_CTL = 0, CTL_ZERO_BYTES = 1 * MiB;
constexpr size_t WS_MOD = 1 * MiB;
constexpr size_t WS_LB = WS_MOD + 512 * 1024;
constexpr size_t WS_LRUW = WS_LB + 8192;
constexpr size_t WS_DTRAW = 2 * MiB, WS_DT = 3 * MiB, WS_ACUM = 4 * MiB;
constexpr size_t WS_HGBL = 5 * MiB;
constexpr size_t WS_SELM = 5 * MiB + 512 * 1024;
constexpr size_t WS_RW = 6 * MiB;
constexpr size_t WS_SLOTOF = 6 * MiB + 512 * 1024;
constexpr size_t WS_SLOTTOK = 7 * MiB;
constexpr size_t WS_RINFO = 7 * MiB + 768 * 1024;
constexpr size_t WS_CNT = 8 * MiB;
constexpr size_t WS_WRT = 9 * MiB;
constexpr size_t WS_WIN = 12 * MiB;
constexpr size_t WS_WOUT = 34 * MiB;
constexpr size_t WS_GU = 42 * MiB;
constexpr size_t WS_DN = 107 * MiB;
constexpr size_t WS_H = 140 * MiB;
constexpr size_t WS_U = 172 * MiB;
constexpr size_t WS_SST = 348 * MiB;
constexpr size_t WS_HST = 380 * MiB;
constexpr size_t WS_LA = 412 * MiB, WS_LH = 428 * MiB;
constexpr size_t WS_XBC = 444 * MiB;
constexpr size_t WS_YCAT = 492 * MiB;
constexpr size_t WS_HMID = 172 * MiB;
constexpr size_t WS_Y = 252 * MiB;
constexpr size_t WS_YSH = WS_Y + 160 * MiB;
constexpr size_t WS_END = 556 * MiB;

__device__ __forceinline__ float bf2f(bf16_t b) { return __uint_as_float(((unsigned)b) << 16); }
typedef __bf16 bf16x2_hw __attribute__((ext_vector_type(2)));
__device__ __forceinline__ unsigned pk2(float lo, float hi) { f32x2 v = {lo, hi}; bf16x2_hw b = __builtin_convertvector(v, bf16x2_hw); return __builtin_bit_cast(unsigned, b); }
__device__ __forceinline__ unsigned f2bf(float f) { return pk2(f, 0.f) & 0xffffu; }
constexpr float Y8_SCALE = 16.0f, Y8_INV = 1.0f / 16.0f;
__device__ __forceinline__ unsigned pk4_fp8(float a, float b, float c2, float d) { int w = 0; w = __builtin_amdgcn_cvt_pk_fp8_f32(a, b, w, false); w = __builtin_amdgcn_cvt_pk_fp8_f32(c2, d, w, true); return (unsigned)w; }
__device__ __forceinline__ float lo_bf(unsigned w) { return __uint_as_float(w << 16); }
__device__ __forceinline__ float hi_bf(unsigned w) { return __uint_as_float(w & 0xffff0000u); }
__device__ __forceinline__ float rcpf_(float x) { return __builtin_amdgcn_rcpf(x); }
__device__ __forceinline__ float rsqf_(float x) { return __builtin_amdgcn_rsqf(x); }
__device__ __forceinline__ float sigmoidf_(float x) { return rcpf_(1.0f + __expf(-x)); }
__device__ __forceinline__ float siluf_(float x) { return x * rcpf_(1.0f + __expf(-x)); }
__device__ __forceinline__ float softplusf_(float x) { return fmaxf(x, 0.f) + log1pf(__expf(-fabsf(x))); }
__device__ __forceinline__ float gelu_tanhf_(float x) { const float u = 0.7978845608028654f * (x + 0.044715f * x * x * x); const float t = 1.0f - 2.0f * rcpf_(1.0f + __expf(2.0f * u)); return 0.5f * x * (1.0f + t); }
__device__ __forceinline__ float shfl_xor_l(float v, int mask, int lane) { return __builtin_bit_cast(float, __builtin_amdgcn_ds_bpermute((lane ^ mask) << 2, __builtin_bit_cast(int, v))); }
__device__ __forceinline__ int shfl_up_l(int v, int d, int lane) { return __builtin_amdgcn_ds_bpermute((lane - d) << 2, v); }
__device__ __forceinline__ float shfl_up_f(float v, int d, int lane) { return __builtin_bit_cast(float, __builtin_amdgcn_ds_bpermute((lane - d) << 2, __builtin_bit_cast(int, v))); }
__device__ __forceinline__ float rdlane_f(float v, int src) { return __builtin_bit_cast(float, __builtin_amdgcn_readlane(__builtin_bit_cast(int, v), src)); }
__device__ __forceinline__ unsigned long long rdlane_u64(unsigned long long v, int src) {
    const unsigned lo = (unsigned)__builtin_amdgcn_readlane((int)(unsigned)v, src), hi = (unsigned)__builtin_amdgcn_readlane((int)(unsigned)(v >> 32), src); return ((unsigned long long)hi << 32) | lo; }
__device__ __forceinline__ float wave_sum(float v, int lane) {
#pragma unroll
    for (int o = 1; o < 64; o <<= 1) v += shfl_xor_l(v, o, lane);
    return v;
}
#define LDS_WAIT() asm volatile("s_waitcnt lgkmcnt(0)" ::: "memory")
__device__ __forceinline__ int fresh_lane() { unsigned ones = ~0u; asm volatile("" : "+s"(ones)); return (int)__builtin_amdgcn_mbcnt_hi(ones, __builtin_amdgcn_mbcnt_lo(ones, 0u)); }
#define LDS_BARRIER() do { asm volatile("s_waitcnt lgkmcnt(0)" ::: "memory"); __builtin_amdgcn_s_barrier(); asm volatile("" ::: "memory"); } while (0)
#define MFMA16(a, b, c) __builtin_amdgcn_mfma_f32_16x16x32_bf16((a), (b), (c), 0, 0, 0)
typedef short s16x4 __attribute__((ext_vector_type(4)));
__device__ __forceinline__ bf16x8 tr_frag(const LAS bf16_t* img, int ld, int k0, int c0, int lane) {
    const int g = lane >> 4, q = (lane & 15) >> 2, pp = lane & 3;
    const LAS bf16_t* a0 = img + (k0 + 8 * g + q) * ld + c0 + 4 * pp;
    const s16x4 r0 = __builtin_amdgcn_ds_read_tr16_b64_v4i16((LAS s16x4*)a0);
    const s16x4 r1 = __builtin_amdgcn_ds_read_tr16_b64_v4i16((LAS s16x4*)(a0 + 4 * ld));
    return (bf16x8){r0[0], r0[1], r0[2], r0[3], r1[0], r1[1], r1[2], r1[3]};
}

namespace pg8 {
constexpr int BM = 256, BK = 64, HALF = 128, HTB = HALF * BK * 2, STAGE_BYTES = 8 * HTB, NXCD = 8, WGM = 8;
__device__ __forceinline__ int lds_byte(int r, int c) { const int st = (r >> 4) * 2 + (c >> 5), rr = r & 15, cc = c & 31, ob = rr * 64 + cc * 2; return st * 1024 + (ob ^ (((ob >> 9) & 1) << 5)); }
__device__ __forceinline__ void stage_rc(int b, int& R, int& C) { const int st = b / 1024, sb = b % 1024, swz = sb ^ (((sb >> 9) & 1) << 5); R = (st >> 1) * 16 + swz / 64; C = (st & 1) * 32 + (swz % 64) / 2; }
__device__ __forceinline__ int perm32(int rho) { const int n = rho >> 4, i = rho & 15; return 8 * (i >> 2) + 4 * n + (i & 3); }

struct Unit { int pm, pn, e; };
struct Gemm { const bf16_t* A; const bf16_t* Bt; int K; size_t estride; };

struct DenseOrder {
    int nM, nN, nwg, G, c;
    __device__ void init(int M, int N, int G_, int c_) { nM = M / BM; nN = N / BM; nwg = nM * nN; G = G_; c = c_; }
    __device__ bool next(int i, Unit& u) const {
        const long L = (long)i * G + c; if (L >= nwg) return false;
        int wgid = (int)L; { const int q = nwg / NXCD, r = nwg % NXCD, xcd = wgid % NXCD, off = wgid / NXCD; wgid = (xcd < r ? xcd * (q + 1) : r * (q + 1) + (xcd - r) * q) + off; }
        const int nig = WGM * nN, gid = wgid / nig, fm = gid * WGM, gsz = (nM - fm) < WGM ? (nM - fm) : WGM;
        u.pm = fm + ((wgid % nig) % gsz); u.pn = (wgid % nig) / gsz; u.e = 0; return true;
    }
};
struct DenseRows { __device__ __forceinline__ int row(const Unit& u, int r) const { return u.pm * BM + r; } };

template <class Epi, class Sched, class AMap, bool ALIGN_EPI, bool SP2>
__device__ __forceinline__ void gemm_phase(LAS unsigned char* lds, const Gemm g, const Sched& S, const Epi& E, const AMap& AM, int wave_id) {
    const int wid = wave_id, lane = fresh_lane(), tid = wid * 64 + lane, wr = wid >> 2, wc = wid & 3, fr = lane & 15, fq = lane >> 4;
    const int K = g.K, nt = K / BK;
    unsigned voffB0;
    { int R, C; stage_rc(tid * 16, R, C); const int Rb = Epi::PERM ? ((R & ~31) + perm32(R & 31)) : R; voffB0 = (unsigned)(Rb * K + C) * 2u; }
    const size_t p1step = (size_t)64 * K * 2;
    const size_t kstep = (size_t)(BK * 2);
    const size_t hstep = (size_t)HALF * K * 2;
    const size_t tstep = 2 * hstep;
    const unsigned ldsw = (unsigned)wid * 1024u;
    const int aoff = lds_byte(wr * 64 + fr, fq * 8), boff = lds_byte(wc * 32 + fr, fq * 8);
#define PG8_SA(b, h) (((b) * 2 + (h)) * HTB)
#define PG8_SB(b, h) ((4 + (b) * 2 + (h)) * HTB)
#define PG8_STAGE2(bufoff, gbase, v0, v1) do { \
        __builtin_amdgcn_global_load_lds((const unsigned*)((const char*)(gbase) + (v0)), (LAS unsigned*)(lds + (bufoff) + ldsw), 16, 0, 0); \
        __builtin_amdgcn_global_load_lds((const unsigned*)((const char*)(gbase) + (v1)), (LAS unsigned*)(lds + (bufoff) + ldsw + 8192), 16, 0, 0); } while (0)
#define PG8_STAGEB(bufoff, gbase) do { \
        __builtin_amdgcn_global_load_lds((const unsigned*)((const char*)(gbase) + voffB0), (LAS unsigned*)(lds + (bufoff) + ldsw), 16, 0, 0); \
        __builtin_amdgcn_global_load_lds((const unsigned*)((const char*)(gbase) + p1step + voffB0), (LAS unsigned*)(lds + (bufoff) + ldsw + 8192), 16, 0, 0); } while (0)
#define PG8_LDA(dst, b, h) do { _Pragma("unroll") for (int m = 0; m < 4; ++m) _Pragma("unroll") for (int k = 0; k < 2; ++k) dst[m][k] = *(const LAS bf16x8*)(lds + PG8_SA(b, h) + aoff + m * 2048 + k * 1024); } while (0)
#define PG8_LDB(dst, b, h) do { _Pragma("unroll") for (int n = 0; n < 2; ++n) _Pragma("unroll") for (int k = 0; k < 2; ++k) dst[n][k] = *(const LAS bf16x8*)(lds + PG8_SB(b, h) + boff + n * 2048 + k * 1024); } while (0)
#define PG8_MMA(ai, bj, At, Bt) do { __builtin_amdgcn_s_setprio(1); _Pragma("unroll") for (int m = 0; m < 4; ++m) _Pragma("unroll") for (int n = 0; n < 2; ++n) _Pragma("unroll") for (int k = 0; k < 2; ++k) \
        acc[ai][bj][m][n] = __builtin_amdgcn_mfma_f32_16x16x32_bf16(Bt[n][k], At[m][k], acc[ai][bj][m][n], 0, 0, 0); __builtin_amdgcn_s_setprio(0); } while (0)
#define PG8_WAIT_V(n) asm volatile("s_waitcnt vmcnt(" #n ")" ::: "memory")
#define PG8_WAIT_L(n) asm volatile("s_waitcnt lgkmcnt(" #n ")" ::: "memory")
#define PG8_BAR __builtin_amdgcn_s_barrier()
#define PG8_SCHED __builtin_amdgcn_sched_barrier(0)
#define PG8_AOFFS(u, v00, v01, v10, v11) do { int R_, C_; stage_rc(tid * 16, R_, C_); \
        v00 = (unsigned)(AM.row(u, R_) * K + C_) * 2u; v01 = (unsigned)(AM.row(u, R_ + 64) * K + C_) * 2u; \
        v10 = (unsigned)(AM.row(u, HALF + R_) * K + C_) * 2u; v11 = (unsigned)(AM.row(u, HALF + R_ + 64) * K + C_) * 2u; } while (0)
    Unit cur, nxt; int ui = 0;
    if (!S.next(0, cur)) return;
    f32x4 acc[2][2][4][2];
#pragma unroll
    for (int a = 0; a < 2; ++a)
#pragma unroll
        for (int b = 0; b < 2; ++b)
#pragma unroll
            for (int m = 0; m < 4; ++m)
#pragma unroll
                for (int n = 0; n < 2; ++n) acc[a][b][m][n] = (f32x4){0.f, 0.f, 0.f, 0.f};
    bf16x8 At[4][2], B0[2][2], B1[2][2];
    const char* const Abase = (const char*)g.A;
    const char* cB = (const char*)g.Bt + (size_t)cur.e * g.estride + (size_t)cur.pn * tstep;
    unsigned c00, c01, c10, c11, n00, n01, n10, n11;
    PG8_AOFFS(cur, c00, c01, c10, c11);
    n00 = c00; n01 = c01; n10 = c10; n11 = c11;
    if constexpr (SP2) {
        PG8_STAGEB(PG8_SB(0, 0), cB); PG8_STAGEB(PG8_SB(0, 1), cB + hstep); PG8_STAGE2(PG8_SA(0, 0), Abase, c00, c01); PG8_STAGE2(PG8_SA(0, 1), Abase, c10, c11);
        if (wr == 1) PG8_BAR;
        PG8_WAIT_V(2); PG8_BAR;
        PG8_STAGEB(PG8_SB(1, 0), cB + kstep); PG8_STAGE2(PG8_SA(1, 0), Abase + kstep, c00, c01); PG8_STAGEB(PG8_SB(1, 1), cB + hstep + kstep);
        PG8_WAIT_V(6); PG8_BAR;
    } else {
        PG8_STAGEB(PG8_SB(0, 0), cB); PG8_STAGE2(PG8_SA(0, 0), Abase, c00, c01); PG8_STAGEB(PG8_SB(0, 1), cB + hstep); PG8_STAGE2(PG8_SA(0, 1), Abase, c10, c11);
        if (wr == 1) PG8_BAR;
        PG8_WAIT_V(4); PG8_BAR;
        PG8_STAGEB(PG8_SB(1, 0), cB + kstep); PG8_STAGE2(PG8_SA(1, 0), Abase + kstep, c00, c01); PG8_STAGEB(PG8_SB(1, 1), cB + hstep + kstep);
        PG8_WAIT_V(6); PG8_BAR;
    }
    for (;;) {
        const bool has_next = S.next(ui + 1, nxt);
        const char* nB = cB;
        if (has_next) { nB = (const char*)g.Bt + (size_t)nxt.e * g.estride + (size_t)nxt.pn * tstep; PG8_AOFFS(nxt, n00, n01, n10, n11); }
        else { n00 = c00; n01 = c01; n10 = c10; n11 = c11; }
        for (int t = 0; t < nt; t += 2) {
            const bool last = (t == nt - 2);
            const char* a1 = Abase + (size_t)(t + 1) * kstep;
            const char* a2 = last ? Abase : Abase + (size_t)(t + 2) * kstep;
            const char* b2 = last ? nB : cB + (size_t)(t + 2) * kstep;
            const char* a3 = a2 + kstep; const char* b3 = b2 + kstep;
            const unsigned x00 = last ? n00 : c00, x01 = last ? n01 : c01, x10 = last ? n10 : c10, x11 = last ? n11 : c11;
            if constexpr (SP2) {
            PG8_LDB(B0, 0, 0); PG8_LDB(B1, 0, 1); PG8_SCHED; PG8_LDA(At, 0, 0); PG8_STAGE2(PG8_SA(1, 1), a1, c10, c11);
            PG8_WAIT_V(8); PG8_WAIT_L(0); PG8_BAR; PG8_MMA(0, 0, At, B0); PG8_MMA(0, 1, At, B1); PG8_BAR; PG8_SCHED;
            PG8_LDA(At, 0, 1); PG8_STAGEB(PG8_SB(0, 0), b2); PG8_STAGEB(PG8_SB(0, 1), b2 + hstep); PG8_STAGE2(PG8_SA(0, 0), a2, x00, x01);
            PG8_WAIT_V(8); PG8_WAIT_L(0); PG8_BAR; PG8_MMA(1, 0, At, B0); PG8_MMA(1, 1, At, B1); PG8_BAR; PG8_SCHED;
            PG8_LDB(B0, 1, 0); PG8_LDB(B1, 1, 1); PG8_SCHED; PG8_LDA(At, 1, 0); PG8_STAGE2(PG8_SA(0, 1), a2, x10, x11);
            PG8_WAIT_V(8); PG8_WAIT_L(0); PG8_BAR; PG8_MMA(0, 0, At, B0); PG8_MMA(0, 1, At, B1); PG8_BAR; PG8_SCHED;
            PG8_LDA(At, 1, 1); PG8_STAGEB(PG8_SB(1, 0), b3); PG8_STAGEB(PG8_SB(1, 1), b3 + hstep); PG8_STAGE2(PG8_SA(1, 0), a3, x00, x01);
            PG8_WAIT_V(8); PG8_WAIT_L(0); PG8_BAR; PG8_MMA(1, 0, At, B0); PG8_MMA(1, 1, At, B1); PG8_BAR; PG8_SCHED;
            } else {
            PG8_LDB(B0, 0, 0); PG8_SCHED; PG8_LDA(At, 0, 0); PG8_STAGE2(PG8_SA(1, 1), a1, c10, c11);
            PG8_WAIT_L(8); PG8_BAR; PG8_WAIT_L(0); PG8_MMA(0, 0, At, B0); PG8_BAR; PG8_SCHED;
            PG8_LDB(B1, 0, 1); PG8_STAGEB(PG8_SB(0, 0), b2);
            PG8_BAR; PG8_WAIT_L(0); PG8_MMA(0, 1, At, B1); PG8_BAR;
            PG8_LDA(At, 0, 1); PG8_STAGE2(PG8_SA(0, 0), a2, x00, x01);
            PG8_BAR; PG8_WAIT_L(0); PG8_MMA(1, 0, At, B0); PG8_BAR; PG8_SCHED;
            PG8_STAGEB(PG8_SB(0, 1), b2 + hstep);
            PG8_WAIT_V(6); PG8_BAR; PG8_MMA(1, 1, At, B1); PG8_BAR;
            PG8_LDB(B0, 1, 0); PG8_SCHED; PG8_LDA(At, 1, 0); PG8_STAGE2(PG8_SA(0, 1), a2, x10, x11);
            PG8_WAIT_L(8); PG8_BAR; PG8_WAIT_L(0); PG8_MMA(0, 0, At, B0); PG8_BAR; PG8_SCHED;
            PG8_LDB(B1, 1, 1); PG8_STAGEB(PG8_SB(1, 0), b3);
            PG8_BAR; PG8_WAIT_L(0); PG8_MMA(0, 1, At, B1); PG8_BAR;
            PG8_LDA(At, 1, 1); PG8_STAGE2(PG8_SA(1, 0), a3, x00, x01);
            PG8_BAR; PG8_WAIT_L(0); PG8_MMA(1, 0, At, B0); PG8_BAR; PG8_SCHED;
            PG8_STAGEB(PG8_SB(1, 1), b3 + hstep);
            PG8_WAIT_V(6); PG8_BAR; PG8_MMA(1, 1, At, B1); PG8_BAR;
            }
        }
        if constexpr (ALIGN_EPI) { if (wr == 0) PG8_BAR; }
        E(acc, cur, wr, wc);
        if (!has_next) break;
#pragma unroll
        for (int a = 0; a < 2; ++a)
#pragma unroll
            for (int b = 0; b < 2; ++b)
#pragma unroll
                for (int m = 0; m < 4; ++m)
#pragma unroll
                    for (int n = 0; n < 2; ++n) acc[a][b][m][n] = (f32x4){0.f, 0.f, 0.f, 0.f};
        cur = nxt; cB = nB; c00 = n00; c01 = n01; c10 = n10; c11 = n11; ++ui;
        if constexpr (ALIGN_EPI) { if (wr == 1) PG8_BAR; }
    }
    PG8_WAIT_V(0);
    if constexpr (!ALIGN_EPI) { if (wr == 0) PG8_BAR; }
    PG8_BAR;
#undef PG8_SA
#undef PG8_SB
#undef PG8_STAGE2
#undef PG8_STAGEB
#undef PG8_LDA
#undef PG8_LDB
#undef PG8_MMA
#undef PG8_WAIT_V
#undef PG8_WAIT_L
#undef PG8_BAR
#undef PG8_SCHED
#undef PG8_AOFFS
}
}

struct Params {
    const float* in[33];
    float* out;
    unsigned char* ws;
    int layer, pad;
};
enum { I_X = 0, I_C, I_ADAW, I_ADAB, I_NMIX, I_NFFN, I_WIN, I_SCW, I_SCB, I_SDTB, I_SALOG, I_SD, I_SNW, I_HLB, I_HNW, I_LCW, I_LCB, I_LWA, I_LBA, I_LWX, I_LBX, I_LLAM, I_LNW,
       I_WOUT, I_RW, I_RB, I_EG, I_EU, I_ED, I_SG, I_SU, I_SDN, I_FNW };

using pg8::Unit;
struct EpiU {
    static constexpr bool PERM = true;
    bf16_t* O; int ldc;
    __device__ __forceinline__ void operator()(const f32x4 (&acc)[2][2][4][2], const Unit& u, int wr, int wc) const {
        const int lane_ = fresh_lane(), fr = lane_ & 15, fq = lane_ >> 4;
        const int row0 = u.pm * 256 + wr * 64 + fr, col0 = u.pn * 256 + wc * 32 + 8 * fq;
#pragma unroll
        for (int ai = 0; ai < 2; ++ai)
#pragma unroll
            for (int m = 0; m < 4; ++m) { bf16_t* rowp = O + (size_t)(row0 + ai * 128 + m * 16) * ldc + col0;
#pragma unroll
                for (int bj = 0; bj < 2; ++bj) { const f32x4 v0 = acc[ai][bj][m][0], v1 = acc[ai][bj][m][1];
                    u32x4 w; w.x = pk2(v0[0], v0[1]); w.y = pk2(v0[2], v0[3]); w.z = pk2(v1[0], v1[1]); w.w = pk2(v1[2], v1[3]);
                    *(u32x4*)(rowp + bj * 128) = w; } }
    }
};
struct EpiOut {
    static constexpr bool PERM = false;
    const float* xin; float* xout; const float* gate;
    __device__ __forceinline__ void operator()(const f32x4 (&acc)[2][2][4][2], const Unit& u, int wr, int wc) const {
        const int lane_ = fresh_lane(), fr = lane_ & 15, fq = lane_ >> 4;
        const int row0 = u.pm * 256 + wr * 64 + fr, col0 = u.pn * 256 + wc * 32 + 4 * fq, b = u.pm >> 3;
        f32x4 gv[2][2];
#pragma unroll
        for (int bj = 0; bj < 2; ++bj)
#pragma unroll
            for (int n = 0; n < 2; ++n) gv[bj][n] = *(const f32x4*)(gate + (size_t)b * NMOD + col0 + bj * 128 + n * 16);
#pragma unroll
        for (int ai = 0; ai < 2; ++ai)
#pragma unroll
            for (int m = 0; m < 4; ++m) { const size_t off = (size_t)(row0 + ai * 128 + m * 16) * DM + col0;
#pragma unroll
                for (int bj = 0; bj < 2; ++bj)
#pragma unroll
                    for (int n = 0; n < 2; ++n) { const f32x4 xi = *(const f32x4*)(xin + off + bj * 128 + n * 16);
                        *(f32x4*)(xout + off + bj * 128 + n * 16) = xi + gv[bj][n] * acc[ai][bj][m][n]; }
                asm volatile("" ::: "memory"); }
    }
};
struct EpiH {
    static constexpr bool PERM = true;
    bf16_t* Hm;
    __device__ __forceinline__ void operator()(const f32x4 (&acc)[2][2][4][2], const Unit& u, int wr, int wc) const {
        const int lane_ = fresh_lane(), fr = lane_ & 15, fq = lane_ >> 4;
        const int row0 = u.pm * 256 + wr * 64 + fr, col0 = u.pn * 128 + wc * 32 + 8 * fq;
#pragma unroll
        for (int ai = 0; ai < 2; ++ai)
#pragma unroll
            for (int m = 0; m < 4; ++m) { bf16_t* rowp = Hm + (size_t)(row0 + ai * 128 + m * 16) * 256 + col0;
                f32x4 h0, h1;
#pragma unroll
                for (int j = 0; j < 4; ++j) { h0[j] = siluf_(acc[ai][0][m][0][j]) * acc[ai][1][m][0][j]; h1[j] = siluf_(acc[ai][0][m][1][j]) * acc[ai][1][m][1][j]; }
                u32x4 w; w.x = pk2(h0[0], h0[1]); w.y = pk2(h0[2], h0[3]); w.z = pk2(h1[0], h1[1]); w.w = pk2(h1[2], h1[3]);
                *(u32x4*)rowp = w; }
    }
};
struct EpiY {
    static constexpr bool PERM = true;
    unsigned char* Y; unsigned char* Ysh; const int* rinfo;
    __device__ __forceinline__ void operator()(const f32x4 (&acc)[2][2][4][2], const Unit& u, int wr, int wc) const {
        const int lane_ = fresh_lane(), fr = lane_ & 15, fq = lane_ >> 4;
        const int col0 = u.pn * 256 + wc * 32 + 8 * fq;
        unsigned char* base = Y + (size_t)u.pm * 256 * DM;
        if (u.e >= NEXP) base = Ysh + (size_t)(u.pm - rinfo[0]) * 256 * DM;
        base += (size_t)(wr * 64 + fr) * DM + col0;
#pragma unroll
        for (int ai = 0; ai < 2; ++ai)
#pragma unroll
            for (int m = 0; m < 4; ++m) { unsigned char* rowp = base + (size_t)(ai * 128 + m * 16) * DM;
#pragma unroll
                for (int bj = 0; bj < 2; ++bj) { const f32x4 v0 = acc[ai][bj][m][0] * Y8_SCALE, v1 = acc[ai][bj][m][1] * Y8_SCALE;
                    u32x2 w; w.x = pk4_fp8(v0[0], v0[1], v0[2], v0[3]); w.y = pk4_fp8(v1[0], v1[1], v1[2], v1[3]);
                    *(u32x2*)(rowp + bj * 128) = w; } }
    }
};
constexpr int LDS_UTAB = 131072, MAX_UNITS = 24;
__device__ __forceinline__ void moe_build_units(LAS unsigned char* lds, const int* rinfo, int NQ, int G, int cidx, int tid) {
    LAS int* tab = (LAS int*)(lds + LDS_UTAB);
    if (tid < MAX_UNITS) {
        const int nblk = rinfo[0]; const long L = (long)tid * G + cidx;
        int pm = -1, pn = 0, e = 0;
        if (L < (long)(nblk + 64) * NQ) { const int rb = (int)(L / NQ); pm = rb; pn = (int)(L % NQ); e = (rb < nblk) ? rinfo[64 + rb] : NEXP; }
        tab[tid * 4 + 0] = pm; tab[tid * 4 + 1] = pn; tab[tid * 4 + 2] = e; tab[tid * 4 + 3] = 0;
    }
    __syncthreads();
}
struct MoeOrder {
    const LAS int* tab;
    __device__ bool next(int i, Unit& u) const {
        if (i >= MAX_UNITS) return false;
        const int pm = __builtin_amdgcn_readfirstlane(tab[i * 4 + 0]); if (pm < 0) return false;
        u.pm = pm; u.pn = __builtin_amdgcn_readfirstlane(tab[i * 4 + 1]); u.e = __builtin_amdgcn_readfirstlane(tab[i * 4 + 2]); return true;
    }
};
struct GatherRows {
    const int* slot_tok; const int* rinfo;
    __device__ __forceinline__ int row(const Unit& u, int r) const {
        const int nblk = rinfo[0];
        if (u.pm < nblk) { const int t = slot_tok[u.pm * 256 + r]; return t < 0 ? 0 : t; }
        return (u.pm - nblk) * 256 + r;
    }
};

struct Ctx { LAS unsigned char* lds; int tid, lane, wave, G, bid; };

template <class RowMap>
__device__ __forceinline__ void transpose_item(const float* W, int N, int k0, int n0, bf16_t* WT, int ldk, const RowMap& rm, LAS float* scr, int lane) {
    const int nn = n0 + (lane & 31);
#pragma unroll 8
    for (int i = 0; i < 32; ++i) { const int kk = 2 * i + (lane >> 5); scr[kk * 33 + (lane & 31)] = (nn < N) ? W[(size_t)(k0 + kk) * N + nn] : 0.f; }
    LDS_WAIT();
    const int c = lane & 7;
#pragma unroll
    for (int j = 0; j < 4; ++j) { const int n = (lane >> 3) + 8 * j; const LAS float* s = scr + (8 * c) * 33 + n;
        u32x4 o; o.x = pk2(s[0 * 33], s[1 * 33]); o.y = pk2(s[2 * 33], s[3 * 33]); o.z = pk2(s[4 * 33], s[5 * 33]); o.w = pk2(s[6 * 33], s[7 * 33]);
        const int dr = (n0 + n < N) ? rm(n0 + n) : -1;
        if (dr >= 0) *(u32x4*)(WT + (size_t)dr * ldk + k0 + 8 * c) = o; }
    LDS_WAIT();
}
struct RmIdent { __device__ __forceinline__ int operator()(int n) const { return n; } };
struct RmWin { __device__ __forceinline__ int operator()(int n) const { return n < 2560 ? n : (n < 2576 ? -1 : n - 16); } };
struct RmGate { __device__ __forceinline__ int operator()(int n) const { return (n >> 7) * 256 + (n & 127); } };
struct RmUp { __device__ __forceinline__ int operator()(int n) const { return (n >> 7) * 256 + 128 + (n & 127); } };

__device__ __forceinline__ void phase_prep_io(const Params& p, const Ctx& c) {
    LAS float* scr = (LAS float*)(c.lds + c.wave * 16384);
    const int gw = c.bid * NWAVES + c.wave, NGW = c.G * NWAVES;
    constexpr int I_IN = 16 * 177, I_OUT = 32 * 32, PER_L = I_IN + I_OUT;
    for (int it = gw; it < NLAYER * PER_L; it += NGW) {
        const int l = it / PER_L; int r = it % PER_L;
        if (r < I_IN) { const int kb = r / 177, nb = r % 177;
            transpose_item(p.in[I_WIN] + (size_t)l * DM * DIN, DIN, kb * 64, nb * 32, (bf16_t*)(p.ws + WS_WIN) + (size_t)l * NU * DM, DM, RmWin(), scr, c.lane); }
        else { r -= I_IN; const int kb = r / 32, nb = r % 32;
            transpose_item(p.in[I_WOUT] + (size_t)l * 2048 * DM, DM, kb * 64, nb * 32, (bf16_t*)(p.ws + WS_WOUT) + (size_t)l * DM * 2048, 2048, RmIdent(), scr, c.lane); }
    }
}
__device__ __forceinline__ void phase_prep_experts(const Params& p, const Ctx& c, int l) {
    LAS float* scr = (LAS float*)(c.lds + c.wave * 16384);
    const int gw = c.bid * NWAVES + c.wave, NGW = c.G * NWAVES;
    constexpr int PER_E = 3 * 128;
    bf16_t* GU = (bf16_t*)(p.ws + WS_GU); bf16_t* DN = (bf16_t*)(p.ws + WS_DN);
    for (int it = gw; it < 65 * PER_E; it += NGW) {
        const int e = it / PER_E; int r = it % PER_E; const int which = r / 128; r %= 128;
        if (which < 2) {
            const float* src = (e < NEXP) ? p.in[which == 0 ? I_EG : I_EU] + ((size_t)l * NEXP + e) * DM * 256 : p.in[which == 0 ? I_SG : I_SU] + (size_t)l * DM * 256;
            const int kb = r / 8, nb = r % 8;
            if (which == 0) transpose_item(src, 256, kb * 64, nb * 32, GU + (size_t)e * 512 * DM, DM, RmGate(), scr, c.lane);
            else transpose_item(src, 256, kb * 64, nb * 32, GU + (size_t)e * 512 * DM, DM, RmUp(), scr, c.lane);
        } else {
            const float* src = (e < NEXP) ? p.in[I_ED] + ((size_t)l * NEXP + e) * 256 * DM : p.in[I_SDN] + (size_t)l * 256 * DM;
            const int kb = r / 32, nb = r % 32;
            transpose_item(src, DM, kb * 64, nb * 32, DN + (size_t)e * DM * 256, 256, RmIdent(), scr, c.lane);
        }
    }
}
__device__ __forceinline__ void phase_prep_small(const Params& p, const Ctx& c) {
    LAS float* sc = (LAS float*)c.lds;
    LAS float* red = (LAS float*)(c.lds + 32768);
    float* mod = (float*)(p.ws + WS_MOD);
    bool have_sc = false;
    for (int it = c.bid; it < NLAYER * 96; it += c.G) {
        if (!have_sc) { for (int i = c.tid; i < 8 * 1024; i += NTHREADS) sc[i] = siluf_(p.in[I_C][i]); have_sc = true; }
        __syncthreads();
        const int l = it / 96, j0 = (it % 96) * 64, j = c.tid & 63, kg = c.tid >> 6;
        const float* W = p.in[I_ADAW] + (size_t)l * DM * NMOD + j0 + j;
        float a[8];
#pragma unroll
        for (int b = 0; b < 8; ++b) a[b] = 0.f;
#pragma unroll 16
        for (int k = kg * 128; k < kg * 128 + 128; ++k) { const float w = W[(size_t)k * NMOD];
#pragma unroll
            for (int b = 0; b < 8; ++b) a[b] += sc[b * 1024 + k] * w; }
#pragma unroll
        for (int b = 0; b < 8; ++b) red[(kg * 8 + b) * 64 + j] = a[b];
        __syncthreads();
        { const int b = c.tid >> 6; float s = 0.f;
#pragma unroll
          for (int g = 0; g < 8; ++g) s += red[(g * 8 + b) * 64 + j];
          mod[((size_t)l * 8 + b) * NMOD + j0 + j] = s + p.in[I_ADAB][(size_t)l * NMOD + j0 + j]; }
        __syncthreads();
    }
    if (c.bid == c.G - 1) {
        float* lb = (float*)(p.ws + WS_LB);
        for (int i = c.tid; i < 512; i += NTHREADS) { const float v0 = p.in[I_HLB][i], v1 = p.in[I_HLB][512 + i]; const float m = fmaxf(v0, v1), e0 = expf(v0 - m), e1 = expf(v1 - m);
            lb[i] = 0.f; lb[512 + i] = e1 / (e0 + e1); }
    }
    { float* WT = (float*)(p.ws + WS_WRT);
      for (int o = c.bid * NTHREADS + c.tid; o < NLAYER * 64 * 1024; o += c.G * NTHREADS) { const int k = o & 1023, e = (o >> 10) & 63, l = o >> 16; WT[o] = p.in[I_RW][((size_t)l * 1024 + k) * 64 + e]; } }
    { bf16_t* LW = (bf16_t*)(p.ws + WS_LRUW);
      for (int o = c.bid * NTHREADS + c.tid; o < NLAYER * 2 * 8 * 4096; o += c.G * NTHREADS) {
          const int i = o & 63, j = (o >> 6) & 63, g = (o >> 12) & 7, mat = (o >> 15) & 1, l = o >> 16;
          const float* src = p.in[mat == 0 ? I_LWA : I_LWX] + (((size_t)l * 8 + g) * 64 + i) * 64 + j;
          LW[o] = (bf16_t)f2bf(*src); } }
}

__device__ __forceinline__ void load_wdt(const Params& p, const Ctx& c, int l, LAS float* wdt) {
    const float* Win = p.in[I_WIN] + (size_t)l * DM * DIN;
    for (int i = c.tid; i < 16 * 1024; i += NTHREADS) { const int k = i >> 4, j = i & 15; wdt[j * 1024 + k] = Win[(size_t)k * DIN + 2560 + j]; }
    __syncthreads();
}
__device__ __forceinline__ void norm_mix_row(const Ctx& c, const f32x4 (&v)[4], float ss, int tok, const float* nw, const float* mod, const LAS float* wdt, bf16_t* H, float* dtraw) {
        const int b = tok >> 11;
        const float rstd = rsqf_(wave_sum(ss, c.lane) * (1.0f / DM) + EPS);
        f32x4 hv[4], w4v[4], shv[4], scv[4];
#pragma unroll
        for (int j = 0; j < 4; ++j) { const int col = 256 * j + 4 * c.lane;
            w4v[j] = *(const f32x4*)(nw + col); shv[j] = *(const f32x4*)(mod + (size_t)b * NMOD + col); scv[j] = *(const f32x4*)(mod + (size_t)b * NMOD + 1024 + col); }
#pragma unroll
        for (int j = 0; j < 4; ++j) {
            const int col = 256 * j + 4 * c.lane;
            const f32x4 w4 = w4v[j], sh = shv[j], sc = scv[j];
            hv[j] = (v[j] * rstd * w4) * (sc + 1.0f) + sh;
            u32x2 o; o.x = pk2(hv[j][0], hv[j][1]); o.y = pk2(hv[j][2], hv[j][3]);
            *(u32x2*)(H + (size_t)tok * DM + col) = o;
        }
        float d16[16];
#pragma unroll
        for (int q = 0; q < 16; ++q) {
            float s2 = 0.f;
#pragma unroll
            for (int j = 0; j < 4; ++j) { const f32x4 wq = *(const LAS f32x4*)(wdt + q * 1024 + 256 * j + 4 * c.lane); s2 += (hv[j][0] * wq[0] + hv[j][1] * wq[1]) + (hv[j][2] * wq[2] + hv[j][3] * wq[3]); }
            d16[q] = s2;
            if ((q & 1) == 1) asm volatile("" ::: "memory");
        }
        float d8[8], d4[4], d2[2], d1;
        { const bool up = (c.lane & 32) != 0;
#pragma unroll
          for (int i = 0; i < 8; ++i) { const float snd = up ? d16[i] : d16[8 + i], kp = up ? d16[8 + i] : d16[i]; d8[i] = kp + shfl_xor_l(snd, 32, c.lane); } }
        { const bool up = (c.lane & 16) != 0;
#pragma unroll
          for (int i = 0; i < 4; ++i) { const float snd = up ? d8[i] : d8[4 + i], kp = up ? d8[4 + i] : d8[i]; d4[i] = kp + shfl_xor_l(snd, 16, c.lane); } }
        { const bool up = (c.lane & 8) != 0;
#pragma unroll
          for (int i = 0; i < 2; ++i) { const float snd = up ? d4[i] : d4[2 + i], kp = up ? d4[2 + i] : d4[i]; d2[i] = kp + shfl_xor_l(snd, 8, c.lane); } }
        { const bool up = (c.lane & 4) != 0; const float snd = up ? d2[0] : d2[1], kp = up ? d2[1] : d2[0]; d1 = kp + shfl_xor_l(snd, 4, c.lane); }
        d1 += shfl_xor_l(d1, 2, c.lane); d1 += shfl_xor_l(d1, 1, c.lane);
        if ((c.lane & 3) == 0) dtraw[(size_t)tok * 16 + ((c.lane >> 5) & 1) * 8 + ((c.lane >> 4) & 1) * 4 + ((c.lane >> 3) & 1) * 2 + ((c.lane >> 2) & 1)] = d1;
}
__device__ __forceinline__ void phase_norm_mix(const Params& p, const Ctx& c, int l, const float* xin) {
    LAS float* wdt = (LAS float*)c.lds;
    load_wdt(p, c, l, wdt);
    const float* mod = (const float*)(p.ws + WS_MOD) + (size_t)l * 8 * NMOD;
    const float* nw = p.in[I_NMIX] + (size_t)l * DM;
    bf16_t* H = (bf16_t*)(p.ws + WS_H); float* dtraw = (float*)(p.ws + WS_DTRAW);
    const int gw = c.bid * NWAVES + c.wave, NGW = c.G * NWAVES;
    f32x4 vn[4];
    if (gw < NTOK) {
#pragma unroll
        for (int j = 0; j < 4; ++j) vn[j] = ((const f32x4*)(xin + (size_t)gw * DM) + c.lane)[64 * j];
    }
    for (int tok = gw; tok < NTOK; tok += NGW) {
        f32x4 v[4]; float ss = 0.f;
#pragma unroll
        for (int j = 0; j < 4; ++j) { v[j] = vn[j]; ss += (v[j][0] * v[j][0] + v[j][1] * v[j][1]) + (v[j][2] * v[j][2] + v[j][3] * v[j][3]); }
        if (tok + NGW < NTOK) {
#pragma unroll
            for (int j = 0; j < 4; ++j) vn[j] = ((const f32x4*)(xin + (size_t)(tok + NGW) * DM) + c.lane)[64 * j];
        }
        norm_mix_row(c, v, ss, tok, nw, mod, wdt, H, dtraw);
    }
}

__device__ __forceinline__ void phase_ssd_conv(const Params& p, const Ctx& c, int l) {
    const bf16_t* U = (const bf16_t*)(p.ws + WS_U); bf16_t* XA = (bf16_t*)(p.ws + WS_XBC);
    const float* cw = p.in[I_SCW] + (size_t)l * 4 * 1536; const float* cb = p.in[I_SCB] + (size_t)l * 1536;
    const float* dtraw = (const float*)(p.ws + WS_DTRAW); float* dt = (float*)(p.ws + WS_DT); float* acum = (float*)(p.ws + WS_ACUM);
    for (int idx = c.bid * NTHREADS + c.tid; idx < (NTOK / 4) * 192; idx += c.G * NTHREADS) {
        const int oct = idx % 192, tg = idx / 192, tok0 = tg * 4, t0 = tok0 & (SEQ - 1), c0 = oct * 8;
        float w[4][8], bb[8];
#pragma unroll
        for (int k = 0; k < 4; ++k) { const f32x4 a = *(const f32x4*)(cw + k * 1536 + c0), b2 = *(const f32x4*)(cw + k * 1536 + c0 + 4);
            w[k][0] = a[0]; w[k][1] = a[1]; w[k][2] = a[2]; w[k][3] = a[3]; w[k][4] = b2[0]; w[k][5] = b2[1]; w[k][6] = b2[2]; w[k][7] = b2[3]; }
        { const f32x4 a = *(const f32x4*)(cb + c0), b2 = *(const f32x4*)(cb + c0 + 4); bb[0] = a[0]; bb[1] = a[1]; bb[2] = a[2]; bb[3] = a[3]; bb[4] = b2[0]; bb[5] = b2[1]; bb[6] = b2[2]; bb[7] = b2[3]; }
        float x[7][8];
#pragma unroll
        for (int r = 0; r < 7; ++r) {
            u32x4 v = (u32x4){0u, 0u, 0u, 0u};
            if (t0 + r - 3 >= 0) v = *(const u32x4*)(U + (size_t)(tok0 + r - 3) * NU + UXS + c0);
#pragma unroll
            for (int j = 0; j < 4; ++j) { x[r][2 * j] = lo_bf(v[j]); x[r][2 * j + 1] = hi_bf(v[j]); }
        }
#pragma unroll
        for (int t = 0; t < 4; ++t) {
            float y[8];
#pragma unroll
            for (int j = 0; j < 8; ++j) y[j] = siluf_(bb[j] + w[0][j] * x[t][j] + w[1][j] * x[t + 1][j] + w[2][j] * x[t + 2][j] + w[3][j] * x[t + 3][j]);
            u32x4 o; o.x = pk2(y[0], y[1]); o.y = pk2(y[2], y[3]); o.z = pk2(y[4], y[5]); o.w = pk2(y[6], y[7]);
            *(u32x4*)(XA + (size_t)(tok0 + t) * 1536 + c0) = o;
        }
    }
    for (int it = c.bid + c.wave * c.G; it < 128; it += c.G * NWAVES) {
        const int tok0 = it * 128, h = c.lane & 15, qtr = c.lane >> 4;
        const float bias = p.in[I_SDTB][l * 16 + h], A = -expf(p.in[I_SALOG][l * 16 + h]);
        float d[32]; float cum = 0.f;
#pragma unroll
        for (int i = 0; i < 32; ++i) d[i] = softplusf_(dtraw[(size_t)(tok0 + qtr * 32 + i) * 16 + h] + bias);
#pragma unroll
        for (int i = 0; i < 32; ++i) cum += d[i] * A;
        const float c1 = shfl_up_f(cum, 16, c.lane), c2 = shfl_up_f(cum, 32, c.lane), c3 = shfl_up_f(cum, 48, c.lane);
        float off = 0.f; if (qtr >= 1) off += c1; if (qtr >= 2) off += c2; if (qtr >= 3) off += c3;
        float run = off;
#pragma unroll
        for (int i = 0; i < 32; ++i) { run += d[i] * A; dt[(size_t)(tok0 + qtr * 32 + i) * 16 + h] = d[i]; acum[(size_t)(tok0 + qtr * 32 + i) * 16 + h] = run; }
    }
}

__device__ __forceinline__ void phase_ssd_state(const Params& p, const Ctx& c) {
    LAS bf16_t* XS = (LAS bf16_t*)c.lds;
    LAS bf16_t* BS = (LAS bf16_t*)(c.lds + 2 * 18432);
    LAS float* fac = (LAS float*)(c.lds + 2 * 18432 + 34816);
    const bf16_t* XA = (const bf16_t*)(p.ws + WS_XBC); const float* dt = (const float*)(p.ws + WS_DT); const float* acum = (const float*)(p.ws + WS_ACUM);
    bf16_t* ST = (bf16_t*)(p.ws + WS_SST);
    const int fr = c.lane & 15, fq = c.lane >> 4;
    for (int it = c.bid; it < 256; it += c.G) {
        const int g = it & 1, bc = it >> 1, tok0 = bc * 128;
        u32x4 pxs[2];
#pragma unroll
        for (int q = 0; q < 2; ++q) { const int i = c.tid + q * NTHREADS; pxs[q] = *(const u32x4*)(XA + (size_t)(tok0 + (i >> 3)) * 1536 + (g * 8) * 64 + (i & 7) * 8); }
        for (int i = c.tid; i < 128 * 16; i += NTHREADS) { const int lrow = i >> 4, ck = i & 15;
            *(LAS u32x4*)(BS + lrow * 136 + ck * 8) = *(const u32x4*)(XA + (size_t)(tok0 + lrow) * 1536 + 1024 + g * 128 + ck * 8); }
        for (int i = c.tid; i < 1024; i += NTHREADS) { const int h8 = i >> 7, lr = i & 127, h = g * 8 + h8;
            fac[i] = dt[(size_t)(tok0 + lr) * 16 + h] * __expf(acum[(size_t)(tok0 + 127) * 16 + h] - acum[(size_t)(tok0 + lr) * 16 + h]); }
        LDS_BARRIER();
        for (int h8 = 0; h8 < 8; ++h8) {
            const int h = g * 8 + h8; LAS bf16_t* X = XS + (h8 & 1) * (128 * 72);
#pragma unroll
            for (int q = 0; q < 2; ++q) { const int i = c.tid + q * NTHREADS, lrow = i >> 3, ck = i & 7; const u32x4 r = pxs[q]; const float f = fac[h8 * 128 + lrow];
                u32x4 o; o.x = pk2(lo_bf(r.x) * f, hi_bf(r.x) * f); o.y = pk2(lo_bf(r.y) * f, hi_bf(r.y) * f); o.z = pk2(lo_bf(r.z) * f, hi_bf(r.z) * f); o.w = pk2(lo_bf(r.w) * f, hi_bf(r.w) * f);
                *(LAS u32x4*)(X + lrow * 72 + ck * 8) = o; }
            if (h8 < 7) {
#pragma unroll
                for (int q = 0; q < 2; ++q) { const int i = c.tid + q * NTHREADS; pxs[q] = *(const u32x4*)(XA + (size_t)(tok0 + (i >> 3)) * 1536 + (h + 1) * 64 + (i & 7) * 8); } }
            LDS_BARRIER();
            f32x4 acc[4];
#pragma unroll
            for (int m = 0; m < 4; ++m) acc[m] = (f32x4){0.f, 0.f, 0.f, 0.f};
#pragma unroll
            for (int ks = 0; ks < 4; ++ks) {
                const bf16x8 bfr = tr_frag(BS, 136, 32 * ks, 16 * c.wave, c.lane);
#pragma unroll
                for (int m = 0; m < 4; ++m) { const bf16x8 afr = tr_frag(X, 72, 32 * ks, 16 * m, c.lane); acc[m] = MFMA16(bfr, afr, acc[m]); }
            }
            const size_t sit = (size_t)(bc * 16 + h);
#pragma unroll
            for (int m = 0; m < 4; ++m) { u32x2 o; o.x = pk2(acc[m][0], acc[m][1]); o.y = pk2(acc[m][2], acc[m][3]);
                *(u32x2*)(ST + sit * 8192 + (16 * m + fr) * 128 + 16 * c.wave + 4 * fq) = o; }
        }
        LDS_BARRIER();
    }
}
__device__ __forceinline__ void phase_ssd_scan(const Params& p, const Ctx& c) {
    u32x4* ST = (u32x4*)(p.ws + WS_SST); const float* acum = (const float*)(p.ws + WS_ACUM);
    for (int i = c.bid * NTHREADS + c.tid; i < 128 * 1024; i += c.G * NTHREADS) {
        const int e8 = i & 1023, bh = i >> 10, b = bh >> 4, h = bh & 15;
        u32x4 loc[16]; float dec[16];
#pragma unroll
        for (int ch = 0; ch < 16; ++ch) { loc[ch] = ST[(size_t)((b * 16 + ch) * 16 + h) * 1024 + e8]; dec[ch] = __expf(acum[(size_t)(b * SEQ + ch * 128 + 127) * 16 + h]); }
        float r[8];
#pragma unroll
        for (int j = 0; j < 8; ++j) r[j] = 0.f;
#pragma unroll
        for (int ch = 0; ch < 16; ++ch) {
            u32x4 o; o.x = pk2(r[0], r[1]); o.y = pk2(r[2], r[3]); o.z = pk2(r[4], r[5]); o.w = pk2(r[6], r[7]);
            ST[(size_t)((b * 16 + ch) * 16 + h) * 1024 + e8] = o;
            const float d = dec[ch];
#pragma unroll
            for (int j = 0; j < 4; ++j) { r[2 * j] = d * r[2 * j] + lo_bf(loc[ch][j]); r[2 * j + 1] = d * r[2 * j + 1] + hi_bf(loc[ch][j]); }
        }
    }
}
__device__ __forceinline__ void phase_ssd_out_g(const Params& p, const Ctx& c, int l) {
    LAS bf16_t* Cs = (LAS bf16_t*)c.lds;
    LAS bf16_t* CB = (LAS bf16_t*)(c.lds + 34816);
    LAS bf16_t* BD = (LAS bf16_t*)(c.lds + 2 * 34816);
    LAS bf16_t* XS = (LAS bf16_t*)(c.lds + 3 * 34816);
    LAS bf16_t* STs = (LAS bf16_t*)(c.lds + 3 * 34816 + 18432);
    LAS float* acs = (LAS float*)(c.lds + 3 * 34816 + 18432 + 17408);
    LAS float* dts = acs + 1024;
    const bf16_t* XA = (const bf16_t*)(p.ws + WS_XBC); const float* dt = (const float*)(p.ws + WS_DT); const float* acum = (const float*)(p.ws + WS_ACUM);
    const bf16_t* ST = (const bf16_t*)(p.ws + WS_SST); bf16_t* YP = (bf16_t*)(p.ws + WS_H);
    const bf16_t* U = (const bf16_t*)(p.ws + WS_U); bf16_t* YC = (bf16_t*)(p.ws + WS_YCAT);
    const float* nw = p.in[I_SNW] + (size_t)l * 1024;
    const int fr = c.lane & 15, fq = c.lane >> 4, w = c.wave;
    for (int it = c.bid; it < 256; it += c.G) {
        const int g = it & 1, bc = it >> 1, tok0 = bc * 128;
        for (int i = c.tid; i < 128 * 16; i += NTHREADS) { const int row = i >> 4, ck = i & 15;
            *(LAS u32x4*)(BD + row * 136 + ck * 8) = *(const u32x4*)(XA + (size_t)(tok0 + row) * 1536 + 1024 + g * 128 + ck * 8);
            *(LAS u32x4*)(Cs + row * 136 + ck * 8) = *(const u32x4*)(XA + (size_t)(tok0 + row) * 1536 + 1280 + g * 128 + ck * 8); }
        for (int i = c.tid; i < 1024; i += NTHREADS) { const int h8 = i >> 7, lr = i & 127; acs[i] = acum[(size_t)(tok0 + lr) * 16 + g * 8 + h8]; dts[i] = dt[(size_t)(tok0 + lr) * 16 + g * 8 + h8]; }
        LDS_BARRIER();
        {
            f32x4 cb[8];
#pragma unroll
            for (int n = 0; n < 8; ++n) cb[n] = (f32x4){0.f, 0.f, 0.f, 0.f};
#pragma unroll
            for (int ks = 0; ks < 4; ++ks) {
                const bf16x8 afr = *(const LAS bf16x8*)(Cs + (16 * w + fr) * 136 + ks * 32 + 8 * fq);
#pragma unroll
                for (int n = 0; n < 8; ++n) { const bf16x8 bfr = *(const LAS bf16x8*)(BD + (16 * n + fr) * 136 + ks * 32 + 8 * fq); cb[n] = MFMA16(bfr, afr, cb[n]); }
            }
            const int lr = 16 * w + fr;
#pragma unroll
            for (int n = 0; n < 8; ++n) { u32x2 o; o.x = pk2(cb[n][0], cb[n][1]); o.y = pk2(cb[n][2], cb[n][3]); *(LAS u32x2*)(CB + lr * 136 + 16 * n + 4 * fq) = o; }
        }
        LDS_BARRIER();
        u32x4 pst[2], pxs[2];
#pragma unroll
        for (int q = 0; q < 2; ++q) { const int i = c.tid + q * NTHREADS;
            pst[q] = *(const u32x4*)(ST + (size_t)(bc * 16 + g * 8) * 8192 + (i >> 4) * 128 + (i & 15) * 8);
            pxs[q] = *(const u32x4*)(XA + (size_t)(tok0 + (i >> 3)) * 1536 + (g * 8) * 64 + (i & 7) * 8); }
        for (int h8 = 0; h8 < 8; ++h8) {
            const int h = g * 8 + h8;
            const float Dh = p.in[I_SD][l * 16 + h];
            const LAS float* ah = acs + h8 * 128; const LAS float* dh = dts + h8 * 128;
#pragma unroll
            for (int q = 0; q < 2; ++q) { const int i = c.tid + q * NTHREADS;
                *(LAS u32x4*)(STs + (i >> 4) * 136 + (i & 15) * 8) = pst[q];
                const int lrow = i >> 3, ck = i & 7; const u32x4 r = pxs[q]; const float f = dh[lrow];
                u32x4 o; o.x = pk2(lo_bf(r.x) * f, hi_bf(r.x) * f); o.y = pk2(lo_bf(r.y) * f, hi_bf(r.y) * f); o.z = pk2(lo_bf(r.z) * f, hi_bf(r.z) * f); o.w = pk2(lo_bf(r.w) * f, hi_bf(r.w) * f);
                *(LAS u32x4*)(XS + lrow * 72 + ck * 8) = o; }
            if (h8 < 7) {
#pragma unroll
                for (int q = 0; q < 2; ++q) { const int i = c.tid + q * NTHREADS;
                    pst[q] = *(const u32x4*)(ST + (size_t)(bc * 16 + h + 1) * 8192 + (i >> 4) * 128 + (i & 15) * 8);
                    pxs[q] = *(const u32x4*)(XA + (size_t)(tok0 + (i >> 3)) * 1536 + (h + 1) * 64 + (i & 7) * 8); } }
            for (int i = c.tid; i < 128 * 16; i += NTHREADS) { const int lr = i >> 4, ck = i & 15; u32x4 o = (u32x4){0u, 0u, 0u, 0u};
                if (8 * ck <= lr) { const u32x4 cv = *(const LAS u32x4*)(CB + lr * 136 + ck * 8); const float al = ah[lr];
                    const f32x4 s0 = *(const LAS f32x4*)(ah + 8 * ck), s1 = *(const LAS f32x4*)(ah + 8 * ck + 4);
                    float e[8];
#pragma unroll
                    for (int j = 0; j < 4; ++j) { e[j] = (8 * ck + j <= lr) ? __expf(al - s0[j]) : 0.f; e[4 + j] = (8 * ck + 4 + j <= lr) ? __expf(al - s1[j]) : 0.f; }
                    o.x = pk2(lo_bf(cv.x) * e[0], hi_bf(cv.x) * e[1]); o.y = pk2(lo_bf(cv.y) * e[2], hi_bf(cv.y) * e[3]); o.z = pk2(lo_bf(cv.z) * e[4], hi_bf(cv.z) * e[5]); o.w = pk2(lo_bf(cv.w) * e[6], hi_bf(cv.w) * e[7]); }
                *(LAS u32x4*)(BD + lr * 136 + ck * 8) = o; }
            LDS_BARRIER();
            {
                f32x4 a1[4], a2[4];
#pragma unroll
                for (int n = 0; n < 4; ++n) { a1[n] = (f32x4){0.f, 0.f, 0.f, 0.f}; a2[n] = (f32x4){0.f, 0.f, 0.f, 0.f}; }
#pragma unroll
                for (int ks = 0; ks < 4; ++ks) {
                    const bf16x8 ad = *(const LAS bf16x8*)(BD + (16 * w + fr) * 136 + ks * 32 + 8 * fq);
                    const bf16x8 ac = *(const LAS bf16x8*)(Cs + (16 * w + fr) * 136 + ks * 32 + 8 * fq);
#pragma unroll
                    for (int n = 0; n < 4; ++n) {
                        const bf16x8 bx = tr_frag(XS, 72, 32 * ks, 16 * n, c.lane);
                        const bf16x8 bs = *(const LAS bf16x8*)(STs + (16 * n + fr) * 136 + ks * 32 + 8 * fq);
                        a1[n] = MFMA16(bx, ad, a1[n]); a2[n] = MFMA16(bs, ac, a2[n]); }
                }
                const int lr = 16 * w + fr; const float ea = __expf(ah[lr]);
#pragma unroll
                for (int n = 0; n < 4; ++n) { const int pc = 16 * n + 4 * fq;
                    const u32x2 xv = *(const u32x2*)(XA + (size_t)(tok0 + lr) * 1536 + h * 64 + pc);
                    const float y0 = a1[n][0] + ea * a2[n][0] + Dh * lo_bf(xv.x), y1 = a1[n][1] + ea * a2[n][1] + Dh * hi_bf(xv.x);
                    const float y2 = a1[n][2] + ea * a2[n][2] + Dh * lo_bf(xv.y), y3 = a1[n][3] + ea * a2[n][3] + Dh * hi_bf(xv.y);
                    u32x2 o; o.x = pk2(y0, y1); o.y = pk2(y2, y3);
                    *(u32x2*)(YP + (size_t)(tok0 + lr) * DM + h * 64 + pc) = o; }
            }
            LDS_BARRIER();
        }
        __syncthreads();
        for (int pass = 0; pass < 2; ++pass) {
            const int tok = tok0 + pass * 64 + (c.tid >> 3), part = c.tid & 7, col = g * 512 + part * 8;
            u32x4 yv[8], zv[8];
#pragma unroll
            for (int i = 0; i < 8; ++i) { yv[i] = *(const u32x4*)(YP + (size_t)tok * DM + col + 64 * i); zv[i] = *(const u32x4*)(U + (size_t)tok * NU + UZ + col + 64 * i); }
            float v[64]; float ss = 0.f;
#pragma unroll
            for (int i = 0; i < 8; ++i)
#pragma unroll
                for (int j = 0; j < 4; ++j) { const float a = lo_bf(yv[i][j]) * siluf_(lo_bf(zv[i][j])), b2 = hi_bf(yv[i][j]) * siluf_(hi_bf(zv[i][j])); v[8 * i + 2 * j] = a; v[8 * i + 2 * j + 1] = b2; ss += a * a + b2 * b2; }
            ss += shfl_xor_l(ss, 1, c.lane); ss += shfl_xor_l(ss, 2, c.lane); ss += shfl_xor_l(ss, 4, c.lane);
            const float rstd = rsqf_(ss * (1.0f / 512.0f) + EPS);
#pragma unroll
            for (int i = 0; i < 8; ++i) { const f32x4 w0 = *(const f32x4*)(nw + col + 64 * i), w1 = *(const f32x4*)(nw + col + 64 * i + 4);
                u32x4 o; o.x = pk2(v[8 * i] * rstd * w0[0], v[8 * i + 1] * rstd * w0[1]); o.y = pk2(v[8 * i + 2] * rstd * w0[2], v[8 * i + 3] * rstd * w0[3]);
                o.z = pk2(v[8 * i + 4] * rstd * w1[0], v[8 * i + 5] * rstd * w1[1]); o.w = pk2(v[8 * i + 6] * rstd * w1[2], v[8 * i + 7] * rstd * w1[3]);
                *(u32x4*)(YC + (size_t)tok * 2048 + col + 64 * i) = o; }
        }
        LDS_BARRIER();
    }
}
__device__ __forceinline__ void phase_hg_state(const Params& p, const Ctx& c, int l) {
    LAS float* Bf = (LAS float*)c.lds;
    LAS float* KK = (LAS float*)(c.lds + 33792);
    LAS bf16_t* KD = (LAS bf16_t*)(c.lds + 2 * 33792 + 2112);
    LAS bf16_t* VS = (LAS bf16_t*)(c.lds + 2 * 33792 + 2112 + 17408);
    const bf16_t* U = (const bf16_t*)(p.ws + WS_U); const float* lb = (const float*)(p.ws + WS_LB) + l * 512;
    bf16_t* ST = (bf16_t*)(p.ws + WS_HST); float* BL = (float*)(p.ws + WS_HGBL);
    const int fr = c.lane & 15, fq = c.lane >> 4, w = c.wave;
    for (int it = c.bid; it < 1024; it += c.G) {
        const int ch = it & 31, bh = it >> 5, h = bh & 3, b = bh >> 2, tok0 = b * SEQ + ch * 64;
        for (int i = c.tid; i < 64 * 16; i += NTHREADS) { const int sr = i >> 4, ck = i & 15;
            const size_t ro = (size_t)(tok0 + sr) * NU + h * 128 + ck * 8;
            const u32x4 rf = *(const u32x4*)(U + ro + UHF);
            *(LAS u32x4*)(VS + sr * 136 + ck * 8) = *(const u32x4*)(U + ro + UHV);
            const f32x4 l0 = *(const f32x4*)(lb + h * 128 + ck * 8), l1 = *(const f32x4*)(lb + h * 128 + ck * 8 + 4);
            f32x4 k0, k1, g0, g1;
            k0[0] = (1.0f - l0[0]) * sigmoidf_(-lo_bf(rf.x)); k0[1] = (1.0f - l0[1]) * sigmoidf_(-hi_bf(rf.x)); k0[2] = (1.0f - l0[2]) * sigmoidf_(-lo_bf(rf.y)); k0[3] = (1.0f - l0[3]) * sigmoidf_(-hi_bf(rf.y));
            k1[0] = (1.0f - l1[0]) * sigmoidf_(-lo_bf(rf.z)); k1[1] = (1.0f - l1[1]) * sigmoidf_(-hi_bf(rf.z)); k1[2] = (1.0f - l1[2]) * sigmoidf_(-lo_bf(rf.w)); k1[3] = (1.0f - l1[3]) * sigmoidf_(-hi_bf(rf.w));
#pragma unroll
            for (int j = 0; j < 4; ++j) { g0[j] = __logf(1.0f - k0[j]); g1[j] = __logf(1.0f - k1[j]); }
            *(LAS f32x4*)(KK + sr * 132 + ck * 8) = k0; *(LAS f32x4*)(KK + sr * 132 + ck * 8 + 4) = k1;
            *(LAS f32x4*)(Bf + sr * 132 + ck * 8) = g0; *(LAS f32x4*)(Bf + sr * 132 + ck * 8 + 4) = g1; }
        LDS_BARRIER();
        { const int kc = c.tid & 127, q4 = c.tid >> 7; float vals[16]; float cum = 0.f;
#pragma unroll
          for (int i = 0; i < 16; ++i) { cum += Bf[(16 * q4 + i) * 132 + kc]; vals[i] = cum; }
          KK[(64 + q4) * 132 + kc] = cum;
          LDS_BARRIER();
          float off = 0.f;
#pragma unroll
          for (int j = 0; j < 3; ++j) off += (j < q4) ? KK[(64 + j) * 132 + kc] : 0.f;
#pragma unroll
          for (int i = 0; i < 16; ++i) Bf[(16 * q4 + i) * 132 + kc] = vals[i] + off;
          if (q4 == 3) BL[(size_t)it * 128 + kc] = vals[15] + off; }
        LDS_BARRIER();
        for (int i = c.tid; i < 64 * 16; i += NTHREADS) { const int sr = i >> 4, ck = i & 15;
            const f32x4 ka = *(const LAS f32x4*)(KK + sr * 132 + ck * 8), kb = *(const LAS f32x4*)(KK + sr * 132 + ck * 8 + 4);
            const f32x4 ba = *(const LAS f32x4*)(Bf + sr * 132 + ck * 8), bb = *(const LAS f32x4*)(Bf + sr * 132 + ck * 8 + 4);
            const f32x4 ea = *(const LAS f32x4*)(Bf + 63 * 132 + ck * 8), eb = *(const LAS f32x4*)(Bf + 63 * 132 + ck * 8 + 4);
            u32x4 o; o.x = pk2(ka[0] * __expf(ea[0] - ba[0]), ka[1] * __expf(ea[1] - ba[1])); o.y = pk2(ka[2] * __expf(ea[2] - ba[2]), ka[3] * __expf(ea[3] - ba[3]));
            o.z = pk2(kb[0] * __expf(eb[0] - bb[0]), kb[1] * __expf(eb[1] - bb[1])); o.w = pk2(kb[2] * __expf(eb[2] - bb[2]), kb[3] * __expf(eb[3] - bb[3]));
            *(LAS u32x4*)(KD + sr * 136 + ck * 8) = o; }
        LDS_BARRIER();
        f32x4 acc[8];
#pragma unroll
        for (int n = 0; n < 8; ++n) acc[n] = (f32x4){0.f, 0.f, 0.f, 0.f};
#pragma unroll
        for (int ks = 0; ks < 2; ++ks) {
            const bf16x8 afr = tr_frag(VS, 136, 32 * ks, 16 * w, c.lane);
#pragma unroll
            for (int n = 0; n < 8; ++n) { const bf16x8 bfr = tr_frag(KD, 136, 32 * ks, 16 * n, c.lane); acc[n] = MFMA16(bfr, afr, acc[n]); }
        }
#pragma unroll
        for (int n = 0; n < 8; ++n) { u32x2 o; o.x = pk2(acc[n][0], acc[n][1]); o.y = pk2(acc[n][2], acc[n][3]);
            *(u32x2*)(ST + (size_t)it * 16384 + (16 * w + fr) * 128 + 16 * n + 4 * fq) = o; }
        LDS_BARRIER();
    }
}
__device__ __forceinline__ void phase_hg_scan(const Params& p, const Ctx& c) {
    u32x2* ST = (u32x2*)(p.ws + WS_HST); const float* BL = (const float*)(p.ws + WS_HGBL);
    for (int i = c.bid * NTHREADS + c.tid; i < 32 * 4096; i += c.G * NTHREADS) {
        const int e4 = i & 4095, bh = i >> 12, k0 = (4 * e4) & 127;
        float r[4] = {0.f, 0.f, 0.f, 0.f};
        for (int half = 0; half < 2; ++half) {
            u32x2 loc[16]; f32x4 dl[16];
#pragma unroll
            for (int cc = 0; cc < 16; ++cc) { const size_t it = (size_t)(bh * 32 + half * 16 + cc); loc[cc] = ST[it * 4096 + e4]; dl[cc] = *(const f32x4*)(BL + it * 128 + k0); }
#pragma unroll
            for (int cc = 0; cc < 16; ++cc) { const size_t it = (size_t)(bh * 32 + half * 16 + cc);
                u32x2 o; o.x = pk2(r[0], r[1]); o.y = pk2(r[2], r[3]);
                ST[it * 4096 + e4] = o;
                r[0] = __expf(dl[cc][0]) * r[0] + lo_bf(loc[cc].x); r[1] = __expf(dl[cc][1]) * r[1] + hi_bf(loc[cc].x);
                r[2] = __expf(dl[cc][2]) * r[2] + lo_bf(loc[cc].y); r[3] = __expf(dl[cc][3]) * r[3] + hi_bf(loc[cc].y); }
        }
    }
}
__device__ __forceinline__ void phase_hg_out(const Params& p, const Ctx& c, int l) {
    LAS bf16_t* Qs = (LAS bf16_t*)c.lds;
    LAS bf16_t* Ks = (LAS bf16_t*)(c.lds + 17408);
    LAS float* Bf = (LAS float*)(c.lds + 2 * 17408);
    LAS bf16_t* ATT = (LAS bf16_t*)(c.lds + 2 * 17408 + 33792);
    LAS bf16_t* VS = (LAS bf16_t*)(c.lds + 2 * 17408 + 33792 + 9216);
    LAS unsigned char* R5 = c.lds + 2 * 17408 + 33792 + 9216 + 17408;
    LAS bf16_t* QI3 = (LAS bf16_t*)R5;
    LAS bf16_t* KKI3 = (LAS bf16_t*)(R5 + 48 * 272);
    LAS bf16_t* STs = (LAS bf16_t*)R5;
    LAS float* QT = (LAS float*)(R5 + 40000);
    const bf16_t* U = (const bf16_t*)(p.ws + WS_U); const float* lb = (const float*)(p.ws + WS_LB) + l * 512;
    const bf16_t* ST = (const bf16_t*)(p.ws + WS_HST); bf16_t* YC = (bf16_t*)(p.ws + WS_YCAT);
    const float* nw = p.in[I_HNW] + (size_t)l * 512;
    const int fr = c.lane & 15, fq = c.lane >> 4, w = c.wave;
    u32x4 pq[2], pf[2], pv[2], pst[4];
#define HG_LOAD_QFV(item) do { const int ch_ = (item) & 31, bh_ = (item) >> 5, h_ = bh_ & 3, b_ = bh_ >> 2, tk_ = b_ * SEQ + ch_ * 64; _Pragma("unroll") for (int q_ = 0; q_ < 2; ++q_) { const int i_ = c.tid + q_ * NTHREADS; \
        const size_t ro_ = (size_t)(tk_ + (i_ >> 4)) * NU + h_ * 128 + (i_ & 15) * 8; pq[q_] = *(const u32x4*)(U + ro_ + UHQ); pf[q_] = *(const u32x4*)(U + ro_ + UHF); pv[q_] = *(const u32x4*)(U + ro_ + UHV); } } while (0)
#define HG_LOAD_ST(item) do { _Pragma("unroll") for (int q_ = 0; q_ < 4; ++q_) { const int i_ = c.tid + q_ * NTHREADS; pst[q_] = *(const u32x4*)(ST + (size_t)(item) * 16384 + (i_ >> 4) * 128 + (i_ & 15) * 8); } } while (0)
    if (c.bid < 1024) { HG_LOAD_QFV(c.bid); HG_LOAD_ST(c.bid); }
    for (int it = c.bid; it < 1024; it += c.G) {
        const int ch = it & 31, bh = it >> 5, h = bh & 3, b = bh >> 2, tok0 = b * SEQ + ch * 64;
        const bool more = (it + c.G) < 1024;
#pragma unroll
        for (int q = 0; q < 2; ++q) { const int i = c.tid + q * NTHREADS, sr = i >> 4, ck = i & 15;
            const u32x4 rq = pq[q], rf = pf[q];
            *(LAS u32x4*)(VS + sr * 136 + ck * 8) = pv[q];
            const f32x4 l0 = *(const f32x4*)(lb + h * 128 + ck * 8), l1 = *(const f32x4*)(lb + h * 128 + ck * 8 + 4);
            f32x4 k0, k1, g0, g1;
            k0[0] = (1.0f - l0[0]) * sigmoidf_(-lo_bf(rf.x)); k0[1] = (1.0f - l0[1]) * sigmoidf_(-hi_bf(rf.x)); k0[2] = (1.0f - l0[2]) * sigmoidf_(-lo_bf(rf.y)); k0[3] = (1.0f - l0[3]) * sigmoidf_(-hi_bf(rf.y));
            k1[0] = (1.0f - l1[0]) * sigmoidf_(-lo_bf(rf.z)); k1[1] = (1.0f - l1[1]) * sigmoidf_(-hi_bf(rf.z)); k1[2] = (1.0f - l1[2]) * sigmoidf_(-lo_bf(rf.w)); k1[3] = (1.0f - l1[3]) * sigmoidf_(-hi_bf(rf.w));
#pragma unroll
            for (int j = 0; j < 4; ++j) { g0[j] = __logf(1.0f - k0[j]); g1[j] = __logf(1.0f - k1[j]); }
            u32x4 ko; ko.x = pk2(k0[0], k0[1]); ko.y = pk2(k0[2], k0[3]); ko.z = pk2(k1[0], k1[1]); ko.w = pk2(k1[2], k1[3]);
            u32x4 qo; qo.x = pk2(siluf_(lo_bf(rq.x)), siluf_(hi_bf(rq.x))); qo.y = pk2(siluf_(lo_bf(rq.y)), siluf_(hi_bf(rq.y))); qo.z = pk2(siluf_(lo_bf(rq.z)), siluf_(hi_bf(rq.z))); qo.w = pk2(siluf_(lo_bf(rq.w)), siluf_(hi_bf(rq.w)));
            *(LAS u32x4*)(Ks + sr * 136 + ck * 8) = ko; *(LAS u32x4*)(Qs + sr * 136 + ck * 8) = qo;
            *(LAS f32x4*)(Bf + sr * 132 + ck * 8) = g0; *(LAS f32x4*)(Bf + sr * 132 + ck * 8 + 4) = g1; }
        if (more) HG_LOAD_QFV(it + c.G);
        LDS_BARRIER();
        { const int kc = c.tid & 127, q4 = c.tid >> 7; float vals[16]; float cum = 0.f;
#pragma unroll
          for (int i = 0; i < 16; ++i) { cum += Bf[(16 * q4 + i) * 132 + kc]; vals[i] = cum; }
          QT[q4 * 128 + kc] = cum;
          LDS_BARRIER();
          float off = 0.f;
#pragma unroll
          for (int j = 0; j < 3; ++j) off += (j < q4) ? QT[j * 128 + kc] : 0.f;
#pragma unroll
          for (int i = 0; i < 16; ++i) Bf[(16 * q4 + i) * 132 + kc] = vals[i] + off; }
        LDS_BARRIER();
        for (int i = c.tid; i < 48 * 64; i += NTHREADS) { const int rowq = i >> 6, kp = i & 63, ib = (rowq >> 4) + 1, t = 16 + rowq, rref = 16 * ib - 1;
            const unsigned q2 = *(const LAS unsigned*)(Qs + t * 136 + 2 * kp);
            *(LAS unsigned*)(QI3 + rowq * 136 + 2 * kp) = pk2(lo_bf(q2) * __expf(Bf[t * 132 + 2 * kp] - Bf[rref * 132 + 2 * kp]), hi_bf(q2) * __expf(Bf[t * 132 + 2 * kp + 1] - Bf[rref * 132 + 2 * kp + 1])); }
        for (int i = c.tid; i < 96 * 64; i += NTHREADS) { const int rowk = i >> 6, kp = i & 63; const int ib = (rowk < 16) ? 1 : (rowk < 48 ? 2 : 3), s2 = rowk - 8 * ib * (ib - 1), rref = 16 * ib - 1;
            const unsigned k2 = *(const LAS unsigned*)(Ks + s2 * 136 + 2 * kp);
            *(LAS unsigned*)(KKI3 + rowk * 136 + 2 * kp) = pk2(lo_bf(k2) * __expf(Bf[rref * 132 + 2 * kp] - Bf[s2 * 132 + 2 * kp]), hi_bf(k2) * __expf(Bf[rref * 132 + 2 * kp + 1] - Bf[s2 * 132 + 2 * kp + 1])); }
        for (int pidx = c.tid; pidx < 1024; pidx += NTHREADS) {
            const int ib = pidx >> 8, tq = (pidx >> 4) & 15, sq = pidx & 15, t = 16 * ib + tq, s2 = 16 * ib + sq; float a = 0.f;
            if (sq <= tq) {
                for (int k = 0; k < 128; k += 4) {
                    const f32x4 bt = *(const LAS f32x4*)(Bf + t * 132 + k), bs = *(const LAS f32x4*)(Bf + s2 * 132 + k);
                    const u32x2 qv = *(const LAS u32x2*)(Qs + t * 136 + k), kv = *(const LAS u32x2*)(Ks + s2 * 136 + k);
                    a += lo_bf(qv.x) * lo_bf(kv.x) * __expf(bt[0] - bs[0]) + hi_bf(qv.x) * hi_bf(kv.x) * __expf(bt[1] - bs[1])
                       + lo_bf(qv.y) * lo_bf(kv.y) * __expf(bt[2] - bs[2]) + hi_bf(qv.y) * hi_bf(kv.y) * __expf(bt[3] - bs[3]);
                }
            }
            ATT[t * 72 + s2] = (bf16_t)f2bf(a);
        }
        for (int i = c.tid; i < 6 * 256; i += NTHREADS) { const int blk = i >> 8, e = i & 255; const int bi = (blk < 3) ? 0 : (blk < 5 ? 1 : 2), bj = (blk < 3) ? blk + 1 : (blk < 5 ? blk - 1 : 3);
            ATT[(16 * bi + (e >> 4)) * 72 + 16 * bj + (e & 15)] = (bf16_t)0; }
        LDS_BARRIER();
        if (w < 6) {
            const int ib = (w == 0) ? 1 : (w < 3 ? 2 : 3), jb = w - ((ib * (ib - 1)) >> 1);
            f32x4 a4 = (f32x4){0.f, 0.f, 0.f, 0.f};
#pragma unroll
            for (int ks = 0; ks < 4; ++ks) { const bf16x8 afr = *(const LAS bf16x8*)(QI3 + (16 * (ib - 1) + fr) * 136 + ks * 32 + 8 * fq), bfr = *(const LAS bf16x8*)(KKI3 + (8 * ib * (ib - 1) + 16 * jb + fr) * 136 + ks * 32 + 8 * fq); a4 = MFMA16(afr, bfr, a4); }
#pragma unroll
            for (int r = 0; r < 4; ++r) ATT[(16 * ib + 4 * fq + r) * 72 + 16 * jb + fr] = (bf16_t)f2bf(a4[r]);
        }
        for (int i = c.tid; i < 64 * 64; i += NTHREADS) { const int t = i >> 6, kp = i & 63;
            const unsigned q2 = *(const LAS unsigned*)(Qs + t * 136 + 2 * kp);
            *(LAS unsigned*)(Qs + t * 136 + 2 * kp) = pk2(lo_bf(q2) * __expf(Bf[t * 132 + 2 * kp]), hi_bf(q2) * __expf(Bf[t * 132 + 2 * kp + 1])); }
        LDS_BARRIER();
#pragma unroll
        for (int q = 0; q < 4; ++q) { const int i = c.tid + q * NTHREADS; *(LAS u32x4*)(STs + (i >> 4) * 136 + (i & 15) * 8) = pst[q]; }
        if (more) HG_LOAD_ST(it + c.G);
        LDS_BARRIER();
        f32x4 acc[4];
#pragma unroll
        for (int m = 0; m < 4; ++m) acc[m] = (f32x4){0.f, 0.f, 0.f, 0.f};
#pragma unroll
        for (int ks = 0; ks < 4; ++ks) {
            const bf16x8 bfr = *(const LAS bf16x8*)(STs + (16 * w + fr) * 136 + ks * 32 + 8 * fq);
#pragma unroll
            for (int m = 0; m < 4; ++m) { const bf16x8 afr = *(const LAS bf16x8*)(Qs + (16 * m + fr) * 136 + ks * 32 + 8 * fq); acc[m] = MFMA16(afr, bfr, acc[m]); }
        }
#pragma unroll
        for (int ks = 0; ks < 2; ++ks) {
            const bf16x8 bfr = tr_frag(VS, 136, 32 * ks, 16 * w, c.lane);
#pragma unroll
            for (int m = 0; m < 4; ++m) { const bf16x8 afr = *(const LAS bf16x8*)(ATT + (16 * m + fr) * 72 + ks * 32 + 8 * fq); acc[m] = MFMA16(afr, bfr, acc[m]); }
        }
#pragma unroll
        for (int m = 0; m < 4; ++m)
#pragma unroll
            for (int r = 0; r < 4; ++r) Bf[(16 * m + 4 * fq + r) * 132 + 16 * w + fr] = acc[m][r];
        LDS_BARRIER();
        {
            const int t = c.tid >> 3, part = c.tid & 7;
            f32x4 o4[4]; float ss = 0.f;
#pragma unroll
            for (int i = 0; i < 4; ++i) { o4[i] = *(const LAS f32x4*)(Bf + t * 132 + part * 16 + 4 * i); ss += (o4[i][0] * o4[i][0] + o4[i][1] * o4[i][1]) + (o4[i][2] * o4[i][2] + o4[i][3] * o4[i][3]); }
            const u32x4 g0 = *(const u32x4*)(U + (size_t)(tok0 + t) * NU + UHG + h * 128 + part * 16), g1 = *(const u32x4*)(U + (size_t)(tok0 + t) * NU + UHG + h * 128 + part * 16 + 8);
            ss += shfl_xor_l(ss, 1, c.lane); ss += shfl_xor_l(ss, 2, c.lane); ss += shfl_xor_l(ss, 4, c.lane);
            const float rstd = rsqf_(ss * (1.0f / 128.0f) + EPS);
            const float* nwp = nw + h * 128 + part * 16;
            const f32x4 n0 = *(const f32x4*)(nwp), n1 = *(const f32x4*)(nwp + 4), n2 = *(const f32x4*)(nwp + 8), n3 = *(const f32x4*)(nwp + 12);
            u32x4 r0, r1;
            r0.x = pk2(o4[0][0] * rstd * n0[0] * siluf_(lo_bf(g0.x)), o4[0][1] * rstd * n0[1] * siluf_(hi_bf(g0.x))); r0.y = pk2(o4[0][2] * rstd * n0[2] * siluf_(lo_bf(g0.y)), o4[0][3] * rstd * n0[3] * siluf_(hi_bf(g0.y)));
            r0.z = pk2(o4[1][0] * rstd * n1[0] * siluf_(lo_bf(g0.z)), o4[1][1] * rstd * n1[1] * siluf_(hi_bf(g0.z))); r0.w = pk2(o4[1][2] * rstd * n1[2] * siluf_(lo_bf(g0.w)), o4[1][3] * rstd * n1[3] * siluf_(hi_bf(g0.w)));
            r1.x = pk2(o4[2][0] * rstd * n2[0] * siluf_(lo_bf(g1.x)), o4[2][1] * rstd * n2[1] * siluf_(hi_bf(g1.x))); r1.y = pk2(o4[2][2] * rstd * n2[2] * siluf_(lo_bf(g1.y)), o4[2][3] * rstd * n2[3] * siluf_(hi_bf(g1.y)));
            r1.z = pk2(o4[3][0] * rstd * n3[0] * siluf_(lo_bf(g1.z)), o4[3][1] * rstd * n3[1] * siluf_(hi_bf(g1.z))); r1.w = pk2(o4[3][2] * rstd * n3[2] * siluf_(lo_bf(g1.w)), o4[3][3] * rstd * n3[3] * siluf_(hi_bf(g1.w)));
            bf16_t* yo = YC + (size_t)(tok0 + t) * 2048 + 1024 + h * 128 + part * 16;
            *(u32x4*)yo = r0; *(u32x4*)(yo + 8) = r1;
        }
        LDS_BARRIER();
    }
#undef HG_LOAD_QFV
#undef HG_LOAD_ST
}

__device__ __forceinline__ void phase_lru1(const Params& p, const Ctx& c, int l) {
    LAS unsigned char* wl = c.lds + c.wave * 12288;
    LAS bf16_t* XB = (LAS bf16_t*)wl;
    LAS float* As = (LAS float*)(wl + 2304);
    LAS float* Us = (LAS float*)(wl + 2304 + 4096);
    const bf16_t* U = (const bf16_t*)(p.ws + WS_U); bf16_t* LA = (bf16_t*)(p.ws + WS_LA); bf16_t* LH = (bf16_t*)(p.ws + WS_LH);
    const bf16_t* LW = (const bf16_t*)(p.ws + WS_LRUW) + (size_t)l * 2 * 8 * 4096;
    const int fr = c.lane & 15, fq = c.lane >> 4, g = c.wave, chn = g * 64 + c.lane;
    const float cw0 = p.in[I_LCW][(size_t)l * 2048 + chn], cw1 = p.in[I_LCW][(size_t)l * 2048 + 512 + chn], cw2 = p.in[I_LCW][(size_t)l * 2048 + 1024 + chn], cw3 = p.in[I_LCW][(size_t)l * 2048 + 1536 + chn];
    const float cbias = p.in[I_LCB][l * 512 + chn];
    bf16x8 wfa[4][2], wfx[4][2];
#pragma unroll
    for (int n = 0; n < 4; ++n)
#pragma unroll
        for (int ks = 0; ks < 2; ++ks) { wfa[n][ks] = *(const bf16x8*)(LW + (size_t)(0 * 8 + g) * 4096 + (16 * n + fr) * 64 + ks * 32 + 8 * fq);
                                         wfx[n][ks] = *(const bf16x8*)(LW + (size_t)(1 * 8 + g) * 4096 + (16 * n + fr) * 64 + ks * 32 + 8 * fq); }
    float bav[4], bxv[4], spl[4];
#pragma unroll
    for (int n = 0; n < 4; ++n) { const int j = g * 64 + 16 * n + fr; bav[n] = p.in[I_LBA][l * 512 + j]; bxv[n] = p.in[I_LBX][l * 512 + j]; spl[n] = softplusf_(-p.in[I_LLAM][l * 512 + j]); }
    for (int it = c.bid; it < 256; it += c.G) {
        const int seg = it & 31, tok0 = (it >> 5) * SEQ + seg * 64;
        float x0 = 0.f, x1 = 0.f, x2 = 0.f;
        if (seg > 0) { x0 = bf2f(U[(size_t)(tok0 - 3) * NU + ULX + chn]); x1 = bf2f(U[(size_t)(tok0 - 2) * NU + ULX + chn]); x2 = bf2f(U[(size_t)(tok0 - 1) * NU + ULX + chn]); }
        float hrun = 0.f, arun = 1.f;
        for (int st = 0; st < 4; ++st) {
            const int t0 = tok0 + st * 16;
#pragma unroll
            for (int tt = 0; tt < 16; ++tt) { const float xr = bf2f(U[(size_t)(t0 + tt) * NU + ULX + chn]);
                const float xb = cbias + cw0 * x0 + cw1 * x1 + cw2 * x2 + cw3 * xr; x0 = x1; x1 = x2; x2 = xr;
                XB[tt * 72 + c.lane] = (bf16_t)f2bf(xb); }
            LDS_WAIT();
            f32x4 ar[4], ai[4];
#pragma unroll
            for (int n = 0; n < 4; ++n) { ar[n] = (f32x4){0.f, 0.f, 0.f, 0.f}; ai[n] = (f32x4){0.f, 0.f, 0.f, 0.f}; }
#pragma unroll
            for (int ks = 0; ks < 2; ++ks) { const bf16x8 afr = *(const LAS bf16x8*)(XB + fr * 72 + ks * 32 + 8 * fq);
#pragma unroll
                for (int n = 0; n < 4; ++n) { ar[n] = MFMA16(afr, wfa[n][ks], ar[n]); ai[n] = MFMA16(afr, wfx[n][ks], ai[n]); } }
#pragma unroll
            for (int n = 0; n < 4; ++n)
#pragma unroll
                for (int r = 0; r < 4; ++r) { const int t = 4 * fq + r, j = 16 * n + fr;
                    const float rg = sigmoidf_(ar[n][r] + bav[n]), ig = sigmoidf_(ai[n][r] + bxv[n]);
                    const float la = -8.0f * rg * spl[n], a = __expf(la), mult = __builtin_amdgcn_sqrtf(fmaxf(fmaf(-a, a, 1.0f), 0.f));
                    As[t * 64 + j] = a; Us[t * 64 + j] = mult * ig * bf2f(XB[t * 72 + j]); }
            LDS_WAIT();
#pragma unroll
            for (int tt = 0; tt < 16; ++tt) { const float a = As[tt * 64 + c.lane], uu = Us[tt * 64 + c.lane];
                hrun = a * hrun + uu; arun = a * arun;
                LA[(size_t)(t0 + tt) * 512 + chn] = (bf16_t)f2bf(arun); LH[(size_t)(t0 + tt) * 512 + chn] = (bf16_t)f2bf(hrun); }
            LDS_WAIT();
        }
    }
}
__device__ __forceinline__ void phase_lru2(const Params& p, const Ctx& c, int l) {
    LAS float* YS = (LAS float*)c.lds;
    LAS float* RS = (LAS float*)(c.lds + 64 * 516 * 4);
    const bf16_t* U = (const bf16_t*)(p.ws + WS_U); const bf16_t* LA = (const bf16_t*)(p.ws + WS_LA); const bf16_t* LH = (const bf16_t*)(p.ws + WS_LH);
    bf16_t* YC = (bf16_t*)(p.ws + WS_YCAT);
    const int g = c.wave, chn = g * 64 + c.lane;
    const float nwv = p.in[I_LNW][l * 512 + chn];
    for (int it = c.bid; it < 256; it += c.G) {
        const int seg = it & 31, b = it >> 5, tok0 = b * SEQ + seg * 64;
        float hin = 0.f;
        for (int s2 = 0; s2 < seg; ++s2) { const size_t row = (size_t)(b * SEQ + s2 * 64 + 63); hin = bf2f(LH[row * 512 + chn]) + bf2f(LA[row * 512 + chn]) * hin; }
#pragma unroll 8
        for (int tt = 0; tt < 64; ++tt) { const size_t tok = (size_t)(tok0 + tt);
            const float hh = bf2f(LH[tok * 512 + chn]) + bf2f(LA[tok * 512 + chn]) * hin;
            YS[tt * 516 + chn] = hh * gelu_tanhf_(bf2f(U[tok * NU + ULG + chn])); }
        LDS_BARRIER();
        {
            const int t = c.tid >> 3, part = c.tid & 7; float ss = 0.f;
#pragma unroll
            for (int i = 0; i < 16; ++i) { const f32x4 v = *(const LAS f32x4*)(YS + t * 516 + 32 * i + 4 * part); ss += (v[0] * v[0] + v[1] * v[1]) + (v[2] * v[2] + v[3] * v[3]); }
            ss += shfl_xor_l(ss, 1, c.lane); ss += shfl_xor_l(ss, 2, c.lane); ss += shfl_xor_l(ss, 4, c.lane);
            if (part == 0) RS[t] = rsqf_(ss * (1.0f / 512.0f) + EPS);
        }
        LDS_BARRIER();
#pragma unroll 8
        for (int tt = 0; tt < 64; ++tt) YC[(size_t)(tok0 + tt) * 2048 + 1536 + chn] = (bf16_t)f2bf(YS[tt * 516 + chn] * RS[tt] * nwv);
        LDS_BARRIER();
    }
}

__device__ __forceinline__ void phase_norm_router(const Params& p, const Ctx& c, int l, const float* xin) {
    constexpr int HSTR = 1028;
    LAS float* HS = (LAS float*)c.lds;
    LAS float* PL = (LAS float*)(c.lds + 16 * HSTR * 4);
    LAS float* LG = (LAS float*)(c.lds + 16 * HSTR * 4 + 32768);
    const float* mod = (const float*)(p.ws + WS_MOD) + (size_t)l * 8 * NMOD;
    const float* nw = p.in[I_NFFN] + (size_t)l * DM;
    const float* WT = (const float*)(p.ws + WS_WRT) + (size_t)l * 64 * 1024;
    const float rbias = p.in[I_RB][l * NEXP + c.lane];
    bf16_t* H = (bf16_t*)(p.ws + WS_H);
    unsigned long long* selm = (unsigned long long*)(p.ws + WS_SELM); float* rw = (float*)(p.ws + WS_RW);
    const int fr = c.lane & 15, fq = c.lane >> 4, w = c.wave;
    int* cnt = (int*)(p.ws + WS_CNT);
    f32x4 bw[8][4];
#pragma unroll
    for (int j = 0; j < 8; ++j)
#pragma unroll
        for (int n = 0; n < 4; ++n) bw[j][n] = *(const f32x4*)(WT + (size_t)(16 * n + fr) * 1024 + 128 * w + 16 * j + 4 * fq);
    int ecount = 0;
    f32x4 xn[2][4];
    if (c.bid < NTOK / 16) {
#pragma unroll
        for (int q = 0; q < 2; ++q)
#pragma unroll
            for (int j = 0; j < 4; ++j) xn[q][j] = ((const f32x4*)(xin + (size_t)(c.bid * 16 + 2 * w + q) * DM) + c.lane)[64 * j];
    }
    for (int t16 = c.bid; t16 < NTOK / 16; t16 += c.G) {
        const int tokb = t16 * 16, b = tokb >> 11;
        f32x4 pa[4], pb[4];
#pragma unroll
        for (int j = 0; j < 4; ++j) { const int col = 256 * j + 4 * c.lane;
            const f32x4 w4 = *(const f32x4*)(nw + col), sc = *(const f32x4*)(mod + (size_t)b * NMOD + 4096 + col); pb[j] = *(const f32x4*)(mod + (size_t)b * NMOD + 3072 + col); pa[j] = w4 * (sc + 1.0f); }
#pragma unroll
        for (int q = 0; q < 2; ++q) {
            const int tl = 2 * w + q, tok = tokb + tl;
            f32x4 v[4]; float ss = 0.f;
#pragma unroll
            for (int j = 0; j < 4; ++j) { v[j] = xn[q][j]; ss += (v[j][0] * v[j][0] + v[j][1] * v[j][1]) + (v[j][2] * v[j][2] + v[j][3] * v[j][3]); }
            const float rstd = rsqf_(wave_sum(ss, c.lane) * (1.0f / DM) + EPS);
#pragma unroll
            for (int j = 0; j < 4; ++j) {
                const int col = 256 * j + 4 * c.lane;
                const f32x4 h = (v[j] * rstd) * pa[j] + pb[j];
                u32x2 o; o.x = pk2(h[0], h[1]); o.y = pk2(h[2], h[3]);
                *(u32x2*)(H + (size_t)tok * DM + col) = o;
                *(LAS f32x4*)(HS + tl * HSTR + col) = h;
            }
        }
        if (t16 + c.G < NTOK / 16) {
#pragma unroll
            for (int q = 0; q < 2; ++q)
#pragma unroll
                for (int j = 0; j < 4; ++j) xn[q][j] = ((const f32x4*)(xin + (size_t)((t16 + c.G) * 16 + 2 * w + q) * DM) + c.lane)[64 * j];
        }
        LDS_BARRIER();
        {
            f32x4 acc[4];
#pragma unroll
            for (int n = 0; n < 4; ++n) acc[n] = (f32x4){0.f, 0.f, 0.f, 0.f};
#pragma unroll
            for (int j = 0; j < 8; ++j) {
                const int kk = 128 * w + 16 * j + 4 * fq;
                const f32x4 a4 = *(const LAS f32x4*)(HS + fr * HSTR + kk);
#pragma unroll
                for (int i = 0; i < 4; ++i)
#pragma unroll
                    for (int n = 0; n < 4; ++n) acc[n] = __builtin_amdgcn_mfma_f32_16x16x4f32(a4[i], bw[j][n][i], acc[n], 0, 0, 0);
            }
#pragma unroll
            for (int n = 0; n < 4; ++n)
#pragma unroll
                for (int r = 0; r < 4; ++r) PL[(w * 16 + 4 * fq + r) * 64 + 16 * n + fr] = acc[n][r];
        }
        LDS_BARRIER();
        for (int i = c.tid; i < 1024; i += NTHREADS) { float s2 = 0.f;
#pragma unroll
            for (int ww = 0; ww < 8; ++ww) s2 += PL[ww * 1024 + i];
            LG[i] = s2; }
        LDS_BARRIER();
#pragma unroll
        for (int q = 0; q < 2; ++q) {
            const int tl = 2 * w + q, tok = tokb + tl;
            const float s = sigmoidf_(LG[tl * 64 + c.lane]), v = s + rbias;
            float m1 = v;
            m1 = fmaxf(m1, shfl_xor_l(m1, 1, c.lane)); m1 = fmaxf(m1, shfl_xor_l(m1, 2, c.lane)); m1 = fmaxf(m1, shfl_xor_l(m1, 4, c.lane));
            const unsigned long long eq = __ballot(v == m1);
            const int gbase = c.lane & ~7;
            const unsigned gm = (unsigned)((eq >> gbase) & 0xffull);
            const int first = gbase + __builtin_ctz(gm);
            float m2 = (c.lane == first) ? -3.0e38f : v;
            m2 = fmaxf(m2, shfl_xor_l(m2, 1, c.lane)); m2 = fmaxf(m2, shfl_xor_l(m2, 2, c.lane)); m2 = fmaxf(m2, shfl_xor_l(m2, 4, c.lane));
            const float gs = m1 + m2;
            const int mygrp = c.lane >> 3; int grank = 0;
#pragma unroll
            for (int g2 = 0; g2 < 8; ++g2) { const float o = rdlane_f(gs, g2 * 8); grank += (o > gs || (o == gs && g2 < mygrp)) ? 1 : 0; }
            const float vm = (grank < 4) ? v : -1.0e4f;
            int erank = 0;
            for (int e2 = 0; e2 < 64; ++e2) { const float o = rdlane_f(vm, e2); erank += (int)(o > vm) + (int)((o == vm) & (e2 < c.lane)); }
            const bool sel = erank < TOPK;
            const unsigned long long mask = __ballot(sel);
            const float wsum = wave_sum(sel ? s : 0.f, c.lane);
            if (sel) { const int kk = __builtin_popcountll(mask & ((1ull << c.lane) - 1ull)); rw[(size_t)tok * 8 + kk] = s * rcpf_(wsum) * 2.5f; }
            if (c.lane == 0) selm[tok] = mask;
            ecount += sel ? 1 : 0;
        }
        LDS_BARRIER();
    }
    { LAS int* CW = (LAS int*)c.lds; CW[w * 64 + c.lane] = ecount; LDS_BARRIER();
      if (w == 0) { int tot = 0;
#pragma unroll
          for (int ww = 0; ww < 8; ++ww) tot += CW[ww * 64 + c.lane];
          cnt[c.bid * 64 + c.lane] = tot; }
      LDS_BARRIER(); }
}
__device__ __forceinline__ void phase_route_assign(const Params& p, const Ctx& c) {
    const unsigned long long* selm = (const unsigned long long*)(p.ws + WS_SELM); const int* cnt = (const int*)(p.ws + WS_CNT);
    int* slot_tok = (int*)(p.ws + WS_SLOTTOK); int* slot_of = (int*)(p.ws + WS_SLOTOF); int* rinfo = (int*)(p.ws + WS_RINFO);
    LAS int* PT = (LAS int*)c.lds;
    LAS int* PB = PT + 512;
    LAS int* TC = PB + 512;
    const int w = c.wave, ntile = (NTOK / 16 + c.G - 1) / c.G;
    for (int ch = c.bid; ch < c.G; ch += c.G) {
        { int tot = 0, bef = 0; const int per = (c.G + 7) / 8;
#pragma unroll 8
          for (int jj = 0; jj < per; ++jj) { const int j = w * per + jj; const int v = (j < c.G) ? cnt[j * 64 + c.lane] : 0; tot += v; bef += (j < ch) ? v : 0; }
          PT[w * 64 + c.lane] = tot; PB[w * 64 + c.lane] = bef; }
        const int t16 = ch + w * c.G; const bool have = (w < ntile) && (t16 < NTOK / 16);
        unsigned long long mine = 0ull; int tcount = 0;
        if (have) { mine = (c.lane < 16) ? selm[t16 * 16 + c.lane] : 0ull;
            for (int i = 0; i < 16; ++i) { const unsigned long long m = rdlane_u64(mine, i); tcount += (int)((m >> c.lane) & 1ull); } }
        TC[w * 64 + c.lane] = tcount;
        LDS_BARRIER();
        int total = 0, before = 0;
#pragma unroll
        for (int ww = 0; ww < 8; ++ww) { total += PT[ww * 64 + c.lane]; before += PB[ww * 64 + c.lane]; }
        const int pad = (total + 255) & ~255;
        int incl = pad;
#pragma unroll
        for (int o = 1; o < 64; o <<= 1) { const int t = shfl_up_l(incl, o, c.lane); if (c.lane >= o) incl += t; }
        const int pstart = incl - pad;
        if (have) {
            int run = pstart + before;
            for (int ww = 0; ww < w; ++ww) run += TC[ww * 64 + c.lane];
            for (int i = 0; i < 16; ++i) {
                const unsigned long long m = rdlane_u64(mine, i); const int tok = t16 * 16 + i;
                if ((m >> c.lane) & 1ull) { const int kk = __builtin_popcountll(m & ((1ull << c.lane) - 1ull)); slot_tok[run] = tok; slot_of[tok * 8 + kk] = run; ++run; }
            }
        }
        if (ch == 0 && w == 7) {
            for (int s2 = pstart + total; s2 < pstart + pad; ++s2) slot_tok[s2] = -1;
            for (int bk = pstart >> 8; bk < (pstart + pad) >> 8; ++bk) rinfo[64 + bk] = c.lane;
            if (c.lane == 63) rinfo[0] = incl >> 8;
        }
        LDS_BARRIER();
    }
}
__device__ __forceinline__ void phase_combine(const Params& p, const Ctx& c, int l) {
    const float* gate = (const float*)(p.ws + WS_MOD) + (size_t)l * 8 * NMOD + 5120;
    const unsigned char* Y = (const unsigned char*)(p.ws + WS_Y); const unsigned char* YS = (const unsigned char*)(p.ws + WS_YSH); const int* slot_of = (const int*)(p.ws + WS_SLOTOF); const float* rw = (const float*)(p.ws + WS_RW);
    const float* fw = p.in[I_FNW];
    if (l + 1 < NLAYER) load_wdt(p, c, l + 1, (LAS float*)c.lds);
    const int gw = c.bid * NWAVES + c.wave, NGW = c.G * NWAVES;
    for (int tok = gw; tok < NTOK; tok += NGW) {
        const int b = tok >> 11;
        f32x4 acc[4], gvv[4], xv0[4];
        f32x4* xr = (f32x4*)(p.out + (size_t)tok * DM) + c.lane;
#pragma unroll
        for (int j = 0; j < 4; ++j) { acc[j] = (f32x4){0.f, 0.f, 0.f, 0.f}; gvv[j] = *(const f32x4*)(gate + (size_t)b * NMOD + 256 * j + 4 * c.lane); xv0[j] = xr[64 * j]; }
#pragma unroll
        for (int k = 0; k < 8; ++k) { const int sl = slot_of[tok * 8 + k]; const float wk = rw[tok * 8 + k] * Y8_INV;
#pragma unroll
            for (int j = 0; j < 4; ++j) { const int yw = (int)*(const unsigned*)(Y + (size_t)sl * DM + 256 * j + 4 * c.lane);
                const f32x2 y01 = __builtin_amdgcn_cvt_pk_f32_fp8(yw, false), y23 = __builtin_amdgcn_cvt_pk_f32_fp8(yw, true);
                acc[j][0] += wk * y01[0]; acc[j][1] += wk * y01[1]; acc[j][2] += wk * y23[0]; acc[j][3] += wk * y23[1]; } }
#pragma unroll
        for (int j = 0; j < 4; ++j) { const int yw = (int)*(const unsigned*)(YS + (size_t)tok * DM + 256 * j + 4 * c.lane);
            const f32x2 y01 = __builtin_amdgcn_cvt_pk_f32_fp8(yw, false), y23 = __builtin_amdgcn_cvt_pk_f32_fp8(yw, true);
            acc[j][0] += Y8_INV * y01[0]; acc[j][1] += Y8_INV * y01[1]; acc[j][2] += Y8_INV * y23[0]; acc[j][3] += Y8_INV * y23[1]; }
        f32x4 v[4]; float ss = 0.f;
#pragma unroll
        for (int j = 0; j < 4; ++j) { v[j] = xv0[j] + gvv[j] * acc[j];
            ss += (v[j][0] * v[j][0] + v[j][1] * v[j][1]) + (v[j][2] * v[j][2] + v[j][3] * v[j][3]); }
        if (l == NLAYER - 1) {
            const float rstd = rsqf_(wave_sum(ss, c.lane) * (1.0f / DM) + EPS);
#pragma unroll
            for (int j = 0; j < 4; ++j) { const f32x4 w4 = *(const f32x4*)(fw + 256 * j + 4 * c.lane); xr[64 * j] = v[j] * rstd * w4; }
        } else {
#pragma unroll
            for (int j = 0; j < 4; ++j) xr[64 * j] = v[j];
            norm_mix_row(c, v, ss, tok, p.in[I_NMIX] + (size_t)(l + 1) * DM, (const float*)(p.ws + WS_MOD) + (size_t)(l + 1) * 8 * NMOD, (const LAS float*)c.lds, (bf16_t*)(p.ws + WS_H), (float*)(p.ws + WS_DTRAW));
        }
    }
}


#define XB_TMO      128
#define XB_XCNT(j)  (256  + 64 * (j))
#define XB_XSUB(j)  (1280 + 64 * (j))
#define XB_XGEN(j)  (2304 + 64 * (j))
#define XB_TOP      3328
#define XB_TOPGEN   3392
#define XCD_BAR_WORDS 3456
#define XB_SPIN_CAP (1u << 18)
constexpr int LDS_XBST = LDS_PTAB + 320;
__device__ __forceinline__ unsigned xb_ld(unsigned* p)              { return __hip_atomic_load(p, __ATOMIC_RELAXED, __HIP_MEMORY_SCOPE_AGENT); }
__device__ __forceinline__ unsigned xb_add(unsigned* p, unsigned v) { return __hip_atomic_fetch_add(p, v, __ATOMIC_RELAXED, __HIP_MEMORY_SCOPE_AGENT); }
__device__ __forceinline__ unsigned xb_xcc_id() { return (unsigned)__builtin_amdgcn_s_getreg((3 << 11) | 20) & 0xFu; }
#define XB_SPIN(cond, bar) do { unsigned _sp = 0; while (cond) { __builtin_amdgcn_s_sleep(1); \
    if ((++_sp & 255u) == 0u) { if (xb_ld(&(bar)[XB_TMO])) break; if (_sp > XB_SPIN_CAP) { atomicAdd(&(bar)[XB_TMO], 1u); break; } } } } while (0)
__device__ __forceinline__ void xcd_barrier_complete(unsigned* bar, unsigned x, unsigned& nloc, unsigned& nx) {
    const unsigned G = gridDim.x * gridDim.y * gridDim.z;
    unsigned sum, cnt, mine, sp = 0u;
    for (;;) {
        sum = 0u; cnt = 0u; mine = 0u;
#pragma unroll
        for (unsigned j = 0; j < 16; ++j) { const unsigned c = xb_ld(&bar[XB_XCNT(j)]); sum += c; cnt += (c > 0u) ? 1u : 0u; mine = (j == x) ? c : mine; }
        if (sum == G) break;
        __builtin_amdgcn_s_sleep(1);
        if ((++sp & 255u) == 0u) { if (xb_ld(&bar[XB_TMO])) break; if (sp > XB_SPIN_CAP) { atomicAdd(&bar[XB_TMO], 1u); break; } }
    }
    nloc = mine > 0u ? mine : 1u; nx = cnt > 0u ? cnt : 1u;
}
__device__ __forceinline__ void xcd_barrier(unsigned* bar, volatile LAS unsigned* st, bool leader_thread) {
    asm volatile("s_waitcnt vmcnt(0)" ::: "memory");
    __syncthreads();
    if (leader_thread) {
        const unsigned x = xb_xcc_id();
        __builtin_amdgcn_s_waitcnt(0);
        unsigned nloc = st[0], nx = st[1];
        if (nloc == 0u) { xcd_barrier_complete(bar, x, nloc, nx); st[0] = nloc; st[1] = nx; }
        const unsigned old = xb_add(&bar[XB_XSUB(x)], 1u);
        const unsigned gen = old / nloc;
        if (old + 1u == (gen + 1u) * nloc) {
            __builtin_amdgcn_fence(__ATOMIC_RELEASE, "agent");
            asm volatile("s_waitcnt vmcnt(0)" ::: "memory");
            const unsigned og = xb_add(&bar[XB_TOP], 1u);
            const unsigned tg = og / nx;
            if (og + 1u == (tg + 1u) * nx) xb_add(&bar[XB_TOPGEN], 1u);
            else XB_SPIN(xb_ld(&bar[XB_TOPGEN]) == tg, bar);
            __builtin_amdgcn_fence(__ATOMIC_ACQUIRE, "agent");
            xb_add(&bar[XB_XGEN(x)], 1u);
            asm volatile("s_waitcnt vmcnt(0)" ::: "memory");
        } else {
            XB_SPIN(xb_ld(&bar[XB_XGEN(x)]) == gen, bar);
            __builtin_amdgcn_fence(__ATOMIC_ACQUIRE, "agent");
            asm volatile("s_waitcnt vmcnt(0)" ::: "memory");
        }
    }
    __syncthreads();
}

#ifndef PROBE_ID
#define PROBE_ID 0
#endif
#define RUN(id, stmt) do { stmt; if constexpr (PROBE_ID == (id)) { __syncthreads(); stmt; } } while (0)
constexpr int NQ_PHASE = 14;
__device__ __forceinline__ unsigned long long uni64(unsigned long long v) {
    const unsigned lo = (unsigned)__builtin_amdgcn_readfirstlane((int)(unsigned)v), hi = (unsigned)__builtin_amdgcn_readfirstlane((int)(unsigned)(v >> 32)); return ((unsigned long long)hi << 32) | lo; }
#if MK_MEGA
__device__ __forceinline__ void params_to_lds(const Params& p, LAS unsigned char* lds) {
    LAS unsigned long long* tab = (LAS unsigned long long*)(lds + LDS_PTAB);
#pragma unroll
    for (int i = 0; i < 33; ++i) tab[i] = (unsigned long long)p.in[i];
    tab[33] = (unsigned long long)p.out; tab[34] = (unsigned long long)p.ws;
}
__device__ __forceinline__ Params params_from_lds(LAS unsigned char* lds) {
    const LAS unsigned long long* tab = (const LAS unsigned long long*)(lds + LDS_PTAB);
    Params p;
#pragma unroll
    for (int i = 0; i < 33; ++i) p.in[i] = (const float*)(const __attribute__((address_space(1))) float*)uni64(tab[i]);
    p.out = (float*)(__attribute__((address_space(1))) float*)uni64(tab[33]); p.ws = (unsigned char*)(__attribute__((address_space(1))) unsigned char*)uni64(tab[34]); p.layer = 0; p.pad = 0;
    return p;
}
#endif
template <int Q> __device__ __forceinline__ void run_q(const Params& p_in, const Ctx& c_in, int l) {
    Ctx c = c_in;
    asm volatile("" : "+s"(c.wave), "+s"(c.bid), "+s"(c.G), "+s"(l));
    c.lane = fresh_lane(); c.tid = c.wave * 64 + c.lane;
#if MK_MEGA
    const Params p = params_from_lds(c.lds);
#else
    const Params& p = p_in;
#endif
    const float* xin = (l == 0) ? p.in[I_X] : p.out;
    if constexpr (Q == 14) { RUN(1, phase_prep_io(p, c); __syncthreads(); phase_prep_small(p, c)); __syncthreads(); RUN(2, phase_prep_experts(p, c, 0)); }
    if constexpr (Q == 0) { RUN(3, phase_norm_mix(p, c, l, xin)); }
    if constexpr (Q == 1) { pg8::Gemm g{(const bf16_t*)(p.ws + WS_H), (const bf16_t*)(p.ws + WS_WIN) + (size_t)l * NU * DM, DM, 0};
              pg8::DenseOrder S; S.init(NTOK, NU, c.G, c.bid); EpiU E{(bf16_t*)(p.ws + WS_U), NU};
              RUN(4, (pg8::gemm_phase<EpiU, pg8::DenseOrder, pg8::DenseRows, true, true>(c.lds, g, S, E, pg8::DenseRows(), c.wave))); }
    if constexpr (Q == 2) { RUN(5, phase_ssd_conv(p, c, l)); __syncthreads(); RUN(6, phase_hg_state(p, c, l)); __syncthreads(); RUN(7, phase_lru1(p, c, l)); }
    if constexpr (Q == 3) { RUN(8, phase_ssd_state(p, c)); __syncthreads(); phase_hg_scan(p, c); __syncthreads(); RUN(9, phase_lru2(p, c, l)); }
    if constexpr (Q == 4) { phase_ssd_scan(p, c); __syncthreads(); RUN(10, phase_hg_out(p, c, l)); }
    if constexpr (Q == 5) RUN(11, phase_ssd_out_g(p, c, l));
    if constexpr (Q == 7) { pg8::Gemm g{(const bf16_t*)(p.ws + WS_YCAT), (const bf16_t*)(p.ws + WS_WOUT) + (size_t)l * DM * 2048, 2048, 0};
              pg8::DenseOrder S; S.init(NTOK, DM, c.G, c.bid); EpiOut E{xin, p.out, (const float*)(p.ws + WS_MOD) + (size_t)l * 8 * NMOD + 2048};
              pg8::gemm_phase<EpiOut, pg8::DenseOrder, pg8::DenseRows, false, true>(c.lds, g, S, E, pg8::DenseRows(), c.wave);
              if constexpr (PROBE_ID == 13) { if (l == 0) { __syncthreads(); pg8::gemm_phase<EpiOut, pg8::DenseOrder, pg8::DenseRows, false, true>(c.lds, g, S, E, pg8::DenseRows(), c.wave); } } }
    if constexpr (Q == 8) RUN(14, phase_norm_router(p, c, l, p.out));
    if constexpr (Q == 9) RUN(15, phase_route_assign(p, c));
    if constexpr (Q == 11) { pg8::Gemm g{(const bf16_t*)(p.ws + WS_H), (const bf16_t*)(p.ws + WS_GU), DM, (size_t)512 * DM * 2};
               moe_build_units(c.lds, (const int*)(p.ws + WS_RINFO), 2, c.G, (c.G % 8 == 0) ? (c.bid % 8) * (c.G / 8) + c.bid / 8 : c.bid, c.tid);
               MoeOrder S{(const LAS int*)(c.lds + LDS_UTAB)}; EpiH E{(bf16_t*)(p.ws + WS_HMID)};
               GatherRows AM{(const int*)(p.ws + WS_SLOTTOK), (const int*)(p.ws + WS_RINFO)};
               RUN(16, (pg8::gemm_phase<EpiH, MoeOrder, GatherRows, true, true>(c.lds, g, S, E, AM, c.wave))); }
    if constexpr (Q == 12) { pg8::Gemm g{(const bf16_t*)(p.ws + WS_HMID), (const bf16_t*)(p.ws + WS_DN), 256, (size_t)DM * 256 * 2};
               moe_build_units(c.lds, (const int*)(p.ws + WS_RINFO), 4, c.G, (c.G % 8 == 0) ? (c.bid % 8) * (c.G / 8) + c.bid / 8 : c.bid, c.tid);
               MoeOrder S{(const LAS int*)(c.lds + LDS_UTAB)};
               EpiY E{(unsigned char*)(p.ws + WS_Y), (unsigned char*)(p.ws + WS_YSH), (const int*)(p.ws + WS_RINFO)};
               RUN(17, (pg8::gemm_phase<EpiY, MoeOrder, pg8::DenseRows, true, true>(c.lds, g, S, E, pg8::DenseRows(), c.wave))); }
    if constexpr (Q == 13) { phase_combine(p, c, l); if (l + 1 < NLAYER) { __syncthreads(); RUN(2, phase_prep_experts(p, c, l + 1)); } }
}

#if MK_MEGA
__global__ void __launch_bounds__(NTHREADS, 2) trunk_kernel(Params p) {
    extern __shared__ __attribute__((aligned(16))) unsigned char lds_raw[];
    Ctx c; c.lds = (LAS unsigned char*)lds_raw; c.tid = 0; c.lane = 0; c.wave = __builtin_amdgcn_readfirstlane(threadIdx.x >> 6); c.G = gridDim.x; c.bid = blockIdx.x;
    cg::grid_group grid = cg::this_grid();
    unsigned* const xbar = (unsigned*)(p.ws + WS_CTL) + 4096;
    if (threadIdx.x == 0) { params_to_lds(p, c.lds); ((LAS unsigned*)(c.lds + LDS_XBST))[0] = 0u; ((LAS unsigned*)(c.lds + LDS_XBST))[1] = 0u; ((LAS unsigned long long*)(c.lds + LDS_PTAB))[35] = (unsigned long long)xbar;
                            (void)xb_add(&xbar[XB_XCNT(xb_xcc_id())], 1u); }
    __syncthreads();
#define GSYNC1() do { unsigned* bar_ = (unsigned*)(__attribute__((address_space(1))) unsigned*)uni64(((const LAS unsigned long long*)(c.lds + LDS_PTAB))[35]); \
        xcd_barrier(bar_, (volatile LAS unsigned*)(c.lds + LDS_XBST), (c.wave == 0) && (fresh_lane() == 0)); } while (0)
#define GSYNC() do { GSYNC1(); if constexpr (PROBE_ID == 18) GSYNC1(); } while (0)
#define LAYER(l) do { \
        if ((l) == 0) { run_q<0>(p, c, l); GSYNC(); } run_q<1>(p, c, l); GSYNC(); run_q<2>(p, c, l); GSYNC(); run_q<3>(p, c, l); GSYNC(); run_q<4>(p, c, l); GSYNC(); \
        run_q<5>(p, c, l); GSYNC(); run_q<7>(p, c, l); GSYNC(); run_q<8>(p, c, l); GSYNC(); run_q<9>(p, c, l); GSYNC(); \
        run_q<11>(p, c, l); GSYNC(); run_q<12>(p, c, l); GSYNC(); run_q<13>(p, c, l); } while (0)
    run_q<14>(p, c, 0); __syncthreads(); grid.sync();
    LAYER(0); GSYNC();
    LAYER(1);
}
#else
template <int Q> __global__ void __launch_bounds__(NTHREADS, 2) phase_kernel(Params p) {
    extern __shared__ __attribute__((aligned(16))) unsigned char lds_raw[];
    Ctx c; c.lds = (LAS unsigned char*)lds_raw; c.tid = 0; c.lane = 0; c.wave = __builtin_amdgcn_readfirstlane(threadIdx.x >> 6); c.G = gridDim.x; c.bid = blockIdx.x;
    run_q<Q>(p, c, p.layer);
}
template <int Q> static void launch_q(const Params& p, int grid, hipStream_t stream) {
    static bool attr = false;
    if (!attr) { (void)hipFuncSetAttribute((const void*)phase_kernel<Q>, hipFuncAttributeMaxDynamicSharedMemorySize, LDS_BYTES); attr = true; }
    hipLaunchKernelGGL(phase_kernel<Q>, dim3(grid), dim3(NTHREADS), LDS_BYTES, stream, p);
}
#endif

extern "C" void kernel_launch(void* const* d_in, const int* in_sizes, int n_in, void* d_out, int out_size, void* d_ws, size_t ws_size, hipStream_t stream) {
    static int grid = 0;
    if (grid == 0) {
        if (n_in != 33 || out_size != NTOK * DM || ws_size < WS_END) { fprintf(stderr, "kernel_launch: unexpected shapes (n_in %d out %d ws %zu)\n", n_in, out_size, ws_size); grid = -1; return; }
        int dev = 0, cus = 0;
        (void)hipGetDevice(&dev); (void)hipDeviceGetAttribute(&cus, hipDeviceAttributeMultiprocessorCount, dev);
        grid = cus > 0 ? cus : 256;
#if MK_MEGA
        int per_cu = 0;
        if (hipFuncSetAttribute((const void*)trunk_kernel, hipFuncAttributeMaxDynamicSharedMemorySize, LDS_BYTES) != hipSuccess) { fprintf(stderr, "kernel_launch: hipFuncSetAttribute failed\n"); grid = -1; return; }
        if (hipOccupancyMaxActiveBlocksPerMultiprocessor(&per_cu, (const void*)trunk_kernel, NTHREADS, LDS_BYTES) != hipSuccess || per_cu < 1) { fprintf(stderr, "kernel_launch: occupancy query says %d blocks/CU\n", per_cu); grid = -1; return; }
        (void)hipGetLastError();
#endif
    }
    if (grid < 0) return;
    (void)hipMemsetAsync((char*)d_ws + WS_CTL, 0, CTL_ZERO_BYTES, stream);
    Params p{};
    for (int i = 0; i < 33; ++i) p.in[i] = (const float*)d_in[i];
    p.out = (float*)d_out; p.ws = (unsigned char*)d_ws;
#if MK_MEGA
    void* args[] = {&p};
    hipError_t e = hipLaunchCooperativeKernel((const void*)trunk_kernel, dim3(grid), dim3(NTHREADS), args, LDS_BYTES, stream);
    if (e != hipSuccess) fprintf(stderr, "cooperative launch failed: %s (grid %d)\n", hipGetErrorString(e), grid);
#else
    p.layer = 0; launch_q<14>(p, grid, stream);
    for (int l = 0; l < NLAYER; ++l) {
        p.layer = l;
        launch_q<0>(p, grid, stream); launch_q<1>(p, grid, stream); launch_q<2>(p, grid, stream); launch_q<3>(p, grid, stream); launch_q<4>(p, grid, stream);
        launch_q<5>(p, grid, stream); launch_q<6>(p, grid, stream); launch_q<7>(p, grid, stream); launch_q<8>(p, grid, stream); launch_q<9>(p, grid, stream);
        launch_q<10>(p, grid, stream); launch_q<11>(p, grid, stream); launch_q<12>(p, grid, stream); launch_q<13>(p, grid, stream);
    }
#endif
}
```

```cpp
#include <hip/hip_runtime.h>
#include <hip/hip_cooperative_groups.h>
#include <cstdio>
#include <cstdint>
namespace cg = cooperative_groups;

#ifndef MK_MEGA
#define MK_MEGA 1
#endif

#define LAS __attribute__((address_space(3)))
typedef unsigned short bf16_t;
typedef short bf16x8 __attribute__((ext_vector_type(8)));
typedef float f32x4 __attribute__((ext_vector_type(4)));
typedef float f32x2 __attribute__((ext_vector_type(2)));
typedef unsigned u32x4 __attribute__((ext_vector_type(4)));
typedef unsigned u32x2 __attribute__((ext_vector_type(2)));

constexpr int NTOK = 16384, DM = 1024, SEQ = 2048, NBATCH = 8, NLAYER = 2;
constexpr int DIN = 5648, NU = 5632;
constexpr int UZ = 0, UXS = 1024, UB = 2048, UC = 2304, UHQ = 2560, UHF = 3072, UHV = 3584, UHG = 4096, ULG = 4608, ULX = 5120;
constexpr int NMOD = 6144;
constexpr float EPS = 1e-6f;
constexpr int NEXP = 64, TOPK = 8;
constexpr int MAXSLOT = 147456;
constexpr int NTHREADS = 512, NWAVES = 8;
constexpr int LDS_BYTES = 160 * 1024;
constexpr int LDS_PTAB = LDS_BYTES - 512;

constexpr size_t MiB = (size_t)1 << 20;
constexpr size_t WS_CTL = 0, CTL_ZERO_BYTES = 1 * MiB;
constexpr size_t WS_MOD = 1 * MiB;
constexpr size_t WS_LB = WS_MOD + 512 * 1024;
constexpr size_t WS_LRUW = WS_LB + 8192;
constexpr size_t WS_DTRAW = 2 * MiB, WS_DT = 3 * MiB, WS_ACUM = 4 * MiB;
constexpr size_t WS_HGBL = 5 * MiB;
constexpr size_t WS_SELM = 5 * MiB + 512 * 1024;
constexpr size_t WS_RW = 6 * MiB;
constexpr size_t WS_SLOTOF = 6 * MiB + 512 * 1024;
constexpr size_t WS_SLOTTOK = 7 * MiB;
constexpr size_t WS_RINFO = 7 * MiB + 768 * 1024;
constexpr size_t WS_CNT = 8 * MiB;
constexpr size_t WS_WRT = 9 * MiB;
constexpr size_t WS_WIN = 12 * MiB;
constexpr size_t WS_WOUT = 34 * MiB;
constexpr size_t WS_GU = 42 * MiB;
constexpr size_t WS_DN = 107 * MiB;
constexpr size_t WS_H = 140 * MiB;
constexpr size_t WS_U = 172 * MiB;
constexpr size_t WS_SST = 348 * MiB;
constexpr size_t WS_HST = 380 * MiB;
constexpr size_t WS_LA = 412 * MiB, WS_LH = 428 * MiB;
constexpr size_t WS_XBC = 444 * MiB;
constexpr size_t WS_YCAT = 492 * MiB;
constexpr size_t WS_HMID = 172 * MiB;
constexpr size_t WS_Y = 252 * MiB;
constexpr size_t WS_YSH = WS_Y + 160 * MiB;
constexpr size_t WS_END = 556 * MiB;

__device__ __forceinline__ float bf2f(bf16_t b) { return __uint_as_float(((unsigned)b) << 16); }
typedef __bf16 bf16x2_hw __attribute__((ext_vector_type(2)));
__device__ __forceinline__ unsigned pk2(float lo, float hi) { f32x2 v = {lo, hi}; bf16x2_hw b = __builtin_convertvector(v, bf16x2_hw); return __builtin_bit_cast(unsigned, b); }
__device__ __forceinline__ unsigned f2bf(float f) { return pk2(f, 0.f) & 0xffffu; }
constexpr float Y8_SCALE = 16.0f, Y8_INV = 1.0f / 16.0f;
__device__ __forceinline__ unsigned pk4_fp8(float a, float b, float c2, float d) { int w = 0; w = __builtin_amdgcn_cvt_pk_fp8_f32(a, b, w, false); w = __builtin_amdgcn_cvt_pk_fp8_f32(c2, d, w, true); return (unsigned)w; }
__device__ __forceinline__ float lo_bf(unsigned w) { return __uint_as_float(w << 16); }
__device__ __forceinline__ float hi_bf(unsigned w) { return __uint_as_float(w & 0xffff0000u); }
__device__ __forceinline__ float rcpf_(float x) { return __builtin_amdgcn_rcpf(x); }
__device__ __forceinline__ float rsqf_(float x) { return __builtin_amdgcn_rsqf(x); }
__device__ __forceinline__ float sigmoidf_(float x) { return rcpf_(1.0f + __expf(-x)); }
__device__ __forceinline__ float siluf_(float x) { return x * rcpf_(1.0f + __expf(-x)); }
__device__ __forceinline__ float softplusf_(float x) { return fmaxf(x, 0.f) + log1pf(__expf(-fabsf(x))); }
__device__ __forceinline__ float gelu_tanhf_(float x) { const float u = 0.7978845608028654f * (x + 0.044715f * x * x * x); const float t = 1.0f - 2.0f * rcpf_(1.0f + __expf(2.0f * u)); return 0.5f * x * (1.0f + t); }
__device__ __forceinline__ float shfl_xor_l(float v, int mask, int lane) { return __builtin_bit_cast(float, __builtin_amdgcn_ds_bpermute((lane ^ mask) << 2, __builtin_bit_cast(int, v))); }
__device__ __forceinline__ int shfl_up_l(int v, int d, int lane) { return __builtin_amdgcn_ds_bpermute((lane - d) << 2, v); }
__device__ __forceinline__ float shfl_up_f(float v, int d, int lane) { return __builtin_bit_cast(float, __builtin_amdgcn_ds_bpermute((lane - d) << 2, __builtin_bit_cast(int, v))); }
__device__ __forceinline__ float rdlane_f(float v, int src) { return __builtin_bit_cast(float, __builtin_amdgcn_readlane(__builtin_bit_cast(int, v), src)); }
__device__ __forceinline__ unsigned long long rdlane_u64(unsigned long long v, int src) {
    const unsigned lo = (unsigned)__builtin_amdgcn_readlane((int)(unsigned)v, src), hi = (unsigned)__builtin_amdgcn_readlane((int)(unsigned)(v >> 32), src); return ((unsigned long long)hi << 32) | lo; }
__device__ __forceinline__ float wave_sum(float v, int lane) {
#pragma unroll
    for (int o = 1; o < 64; o <<= 1) v += shfl_xor_l(v, o, lane);
    return v;
}
#define LDS_WAIT() asm volatile("s_waitcnt lgkmcnt(0)" ::: "memory")
__device__ __forceinline__ int fresh_lane() { unsigned ones = ~0u; asm volatile("" : "+s"(ones)); return (int)__builtin_amdgcn_mbcnt_hi(ones, __builtin_amdgcn_mbcnt_lo(ones, 0u)); }
#define LDS_BARRIER() do { asm volatile("s_waitcnt lgkmcnt(0)" ::: "memory"); __builtin_amdgcn_s_barrier(); asm volatile("" ::: "memory"); } while (0)
#define MFMA16(a, b, c) __builtin_amdgcn_mfma_f32_16x16x32_bf16((a), (b), (c), 0, 0, 0)
typedef short s16x4 __attribute__((ext_vector_type(4)));
__device__ __forceinline__ bf16x8 tr_frag(const LAS bf16_t* img, int ld, int k0, int c0, int lane) {
    const int g = lane >> 4, q = (lane & 15) >> 2, pp = lane & 3;
    const LAS bf16_t* a0 = img + (k0 + 8 * g + q) * ld + c0 + 4 * pp;
    const s16x4 r0 = __builtin_amdgcn_ds_read_tr16_b64_v4i16((LAS s16x4*)a0);
    const s16x4 r1 = __builtin_amdgcn_ds_read_tr16_b64_v4i16((LAS s16x4*)(a0 + 4 * ld));
    return (bf16x8){r0[0], r0[1], r0[2], r0[3], r1[0], r1[1], r1[2], r1[3]};
}

namespace pg8 {
constexpr int BM = 256, BK = 64, HALF = 128, HTB = HALF * BK * 2, STAGE_BYTES = 8 * HTB, NXCD = 8, WGM = 8;
__device__ __forceinline__ int lds_byte(int r, int c) { const int st = (r >> 4) * 2 + (c >> 5), rr = r & 15, cc = c & 31, ob = rr * 64 + cc * 2; return st * 1024 + (ob ^ (((ob >> 9) & 1) << 5)); }
__device__ __forceinline__ void stage_rc(int b, int& R, int& C) { const int st = b / 1024, sb = b % 1024, swz = sb ^ (((sb >> 9) & 1) << 5); R = (st >> 1) * 16 + swz / 64; C = (st & 1) * 32 + (swz % 64) / 2; }
__device__ __forceinline__ int perm32(int rho) { const int n = rho >> 4, i = rho & 15; return 8 * (i >> 2) + 4 * n + (i & 3); }

struct Unit { int pm, pn, e; };
struct Gemm { const bf16_t* A; const bf16_t* Bt; int K; size_t estride; };

struct DenseOrder {
    int nM, nN, nwg, G, c;
    __device__ void init(int M, int N, int G_, int c_) { nM = M / BM; nN = N / BM; nwg = nM * nN; G = G_; c = c_; }
    __device__ bool next(int i, Unit& u) const {
        const long L = (long)i * G + c; if (L >= nwg) return false;
        int wgid = (int)L; { const int q = nwg / NXCD, r = nwg % NXCD, xcd = wgid % NXCD, off = wgid / NXCD; wgid = (xcd < r ? xcd * (q + 1) : r * (q + 1) + (xcd - r) * q) + off; }
        const int nig = WGM * nN, gid = wgid / nig, fm = gid * WGM, gsz = (nM - fm) < WGM ? (nM - fm) : WGM;
        u.pm = fm + ((wgid % nig) % gsz); u.pn = (wgid % nig) / gsz; u.e = 0; return true;
    }
};
struct DenseRows { __device__ __forceinline__ int row(const Unit& u, int r) const { return u.pm * BM + r; } };

template <class Epi, class Sched, class AMap, bool ALIGN_EPI, bool SP2>
__device__ __forceinline__ void gemm_phase(LAS unsigned char* lds, const Gemm g, const Sched& S, const Epi& E, const AMap& AM, int wave_id) {
    const int wid = wave_id, lane = fresh_lane(), tid = wid * 64 + lane, wr = wid >> 2, wc = wid & 3, fr = lane & 15, fq = lane >> 4;
    const int K = g.K, nt = K / BK;
    unsigned voffB0;
    { int R, C; stage_rc(tid * 16, R, C); const int Rb = Epi::PERM ? ((R & ~31) + perm32(R & 31)) : R; voffB0 = (unsigned)(Rb * K + C) * 2u; }
    const size_t p1step = (size_t)64 * K * 2;
    const size_t kstep = (size_t)(BK * 2);
    const size_t hstep = (size_t)HALF * K * 2;
    const size_t tstep = 2 * hstep;
    const unsigned ldsw = (unsigned)wid * 1024u;
    const int aoff = lds_byte(wr * 64 + fr, fq * 8), boff = lds_byte(wc * 32 + fr, fq * 8);
#define PG8_SA(b, h) (((b) * 2 + (h)) * HTB)
#define PG8_SB(b, h) ((4 + (b) * 2 + (h)) * HTB)
#define PG8_STAGE2(bufoff, gbase, v0, v1) do { \
        __builtin_amdgcn_global_load_lds((const unsigned*)((const char*)(gbase) + (v0)), (LAS unsigned*)(lds + (bufoff) + ldsw), 16, 0, 0); \
        __builtin_amdgcn_global_load_lds((const unsigned*)((const char*)(gbase) + (v1)), (LAS unsigned*)(lds + (bufoff) + ldsw + 8192), 16, 0, 0); } while (0)
#define PG8_STAGEB(bufoff, gbase) do { \
        __builtin_amdgcn_global_load_lds((const unsigned*)((const char*)(gbase) + voffB0), (LAS unsigned*)(lds + (bufoff) + ldsw), 16, 0, 0); \
        __builtin_amdgcn_global_load_lds((const unsigned*)((const char*)(gbase) + p1step + voffB0), (LAS unsigned*)(lds + (bufoff) + ldsw + 8192), 16, 0, 0); } while (0)
#define PG8_LDA(dst, b, h) do { _Pragma("unroll") for (int m = 0; m < 4; ++m) _Pragma("unroll") for (int k = 0; k < 2; ++k) dst[m][k] = *(const LAS bf16x8*)(lds + PG8_SA(b, h) + aoff + m * 2048 + k * 1024); } while (0)
#define PG8_LDB(dst, b, h) do { _Pragma("unroll") for (int n = 0; n < 2; ++n) _Pragma("unroll") for (int k = 0; k < 2; ++k) dst[n][k] = *(const LAS bf16x8*)(lds + PG8_SB(b, h) + boff + n * 2048 + k * 1024); } while (0)
#define PG8_MMA(ai, bj, At, Bt) do { __builtin_amdgcn_s_setprio(1); _Pragma("unroll") for (int m = 0; m < 4; ++m) _Pragma("unroll") for (int n = 0; n < 2; ++n) _Pragma("unroll") for (int k = 0; k < 2; ++k) \
        acc[ai][bj][m][n] = __builtin_amdgcn_mfma_f32_16x16x32_bf16(Bt[n][k], At[m][k], acc[ai][bj][m][n], 0, 0, 0); __builtin_amdgcn_s_setprio(0); } while (0)
#define PG8_WAIT_V(n) asm volatile("s_waitcnt vmcnt(" #n ")" ::: "memory")
#define PG8_WAIT_L(n) asm volatile("s_waitcnt lgkmcnt(" #n ")" ::: "memory")
#define PG8_BAR __builtin_amdgcn_s_barrier()
#define PG8_SCHED __builtin_amdgcn_sched_barrier(0)
#define PG8_AOFFS(u, v00, v01, v10, v11) do { int R_, C_; stage_rc(tid * 16, R_, C_); \
        v00 = (unsigned)(AM.row(u, R_) * K + C_) * 2u; v01 = (unsigned)(AM.row(u, R_ + 64) * K + C_) * 2u; \
        v10 = (unsigned)(AM.row(u, HALF + R_) * K + C_) * 2u; v11 = (unsigned)(AM.row(u, HALF + R_ + 64) * K + C_) * 2u; } while (0)
    Unit cur, nxt; int ui = 0;
    if (!S.next(0, cur)) return;
    f32x4 acc[2][2][4][2];
#pragma unroll
    for (int a = 0; a < 2; ++a)
#pragma unroll
        for (int b = 0; b < 2; ++b)
#pragma unroll
            for (int m = 0; m < 4; ++m)
#pragma unroll
                for (int n = 0; n < 2; ++n) acc[a][b][m][n] = (f32x4){0.f, 0.f, 0.f, 0.f};
    bf16x8 At[4][2], B0[2][2], B1[2][2];
    const char* const Abase = (const char*)g.A;
    const char* cB = (const char*)g.Bt + (size_t)cur.e * g.estride + (size_t)cur.pn * tstep;
    unsigned c00, c01, c10, c11, n00, n01, n10, n11;
    PG8_AOFFS(cur, c00, c01, c10, c11);
    n00 = c00; n01 = c01; n10 = c10; n11 = c11;
    if constexpr (SP2) {
        PG8_STAGEB(PG8_SB(0, 0), cB); PG8_STAGEB(PG8_SB(0, 1), cB + hstep); PG8_STAGE2(PG8_SA(0, 0), Abase, c00, c01); PG8_STAGE2(PG8_SA(0, 1), Abase, c10, c11);
        if (wr == 1) PG8_BAR;
        PG8_WAIT_V(2); PG8_BAR;
        PG8_STAGEB(PG8_SB(1, 0), cB + kstep); PG8_STAGE2(PG8_SA(1, 0), Abase + kstep, c00, c01); PG8_STAGEB(PG8_SB(1, 1), cB + hstep + kstep);
        PG8_WAIT_V(6); PG8_BAR;
    } else {
        PG8_STAGEB(PG8_SB(0, 0), cB); PG8_STAGE2(PG8_SA(0, 0), Abase, c00, c01); PG8_STAGEB(PG8_SB(0, 1), cB + hstep); PG8_STAGE2(PG8_SA(0, 1), Abase, c10, c11);
        if (wr == 1) PG8_BAR;
        PG8_WAIT_V(4); PG8_BAR;
        PG8_STAGEB(PG8_SB(1, 0), cB + kstep); PG8_STAGE2(PG8_SA(1, 0), Abase + kstep, c00, c01); PG8_STAGEB(PG8_SB(1, 1), cB + hstep + kstep);
        PG8_WAIT_V(6); PG8_BAR;
    }
    for (;;) {
        const bool has_next = S.next(ui + 1, nxt);
        const char* nB = cB;
        if (has_next) { nB = (const char*)g.Bt + (size_t)nxt.e * g.estride + (size_t)nxt.pn * tstep; PG8_AOFFS(nxt, n00, n01, n10, n11); }
        else { n00 = c00; n01 = c01; n10 = c10; n11 = c11; }
        for (int t = 0; t < nt; t += 2) {
            const bool last = (t == nt - 2);
            const char* a1 = Abase + (size_t)(t + 1) * kstep;
            const char* a2 = last ? Abase : Abase + (size_t)(t + 2) * kstep;
            const char* b2 = last ? nB : cB + (size_t)(t + 2) * kstep;
            const char* a3 = a2 + kstep; const char* b3 = b2 + kstep;
            const unsigned x00 = last ? n00 : c00, x01 = last ? n01 : c01, x10 = last ? n10 : c10, x11 = last ? n11 : c11;
            if constexpr (SP2) {
            PG8_LDB(B0, 0, 0); PG8_LDB(B1, 0, 1); PG8_SCHED; PG8_LDA(At, 0, 0); PG8_STAGE2(PG8_SA(1, 1), a1, c10, c11);
            PG8_WAIT_V(8); PG8_WAIT_L(0); PG8_BAR; PG8_MMA(0, 0, At, B0); PG8_MMA(0, 1, At, B1); PG8_BAR; PG8_SCHED;
            PG8_LDA(At, 0, 1); PG8_STAGEB(PG8_SB(0, 0), b2); PG8_STAGEB(PG8_SB(0, 1), b2 + hstep); PG8_STAGE2(PG8_SA(0, 0), a2, x00, x01);
            PG8_WAIT_V(8); PG8_WAIT_L(0); PG8_BAR; PG8_MMA(1, 0, At, B0); PG8_MMA(1, 1, At, B1); PG8_BAR; PG8_SCHED;
            PG8_LDB(B0, 1, 0); PG8_LDB(B1, 1, 1); PG8_SCHED; PG8_LDA(At, 1, 0); PG8_STAGE2(PG8_SA(0, 1), a2, x10, x11);
            PG8_WAIT_V(8); PG8_WAIT_L(0); PG8_BAR; PG8_MMA(0, 0, At, B0); PG8_MMA(0, 1, At, B1); PG8_BAR; PG8_SCHED;
            PG8_LDA(At, 1, 1); PG8_STAGEB(PG8_SB(1, 0), b3); PG8_STAGEB(PG8_SB(1, 1), b3 + hstep); PG8_STAGE2(PG8_SA(1, 0), a3, x00, x01);
            PG8_WAIT_V(8); PG8_WAIT_L(0); PG8_BAR; PG8_MMA(1, 0, At, B0); PG8_MMA(1, 1, At, B1); PG8_BAR; PG8_SCHED;
            } else {
            PG8_LDB(B0, 0, 0); PG8_SCHED; PG8_LDA(At, 0, 0); PG8_STAGE2(PG8_SA(1, 1), a1, c10, c11);
            PG8_WAIT_L(8); PG8_BAR; PG8_WAIT_L(0); PG8_MMA(0, 0, At, B0); PG8_BAR; PG8_SCHED;
            PG8_LDB(B1, 0, 1); PG8_STAGEB(PG8_SB(0, 0), b2);
            PG8_BAR; PG8_WAIT_L(0); PG8_MMA(0, 1, At, B1); PG8_BAR;
            PG8_LDA(At, 0, 1); PG8_STAGE2(PG8_SA(0, 0), a2, x00, x01);
            PG8_BAR; PG8_WAIT_L(0); PG8_MMA(1, 0, At, B0); PG8_BAR; PG8_SCHED;
            PG8_STAGEB(PG8_SB(0, 1), b2 + hstep);
            PG8_WAIT_V(6); PG8_BAR; PG8_MMA(1, 1, At, B1); PG8_BAR;
            PG8_LDB(B0, 1, 0); PG8_SCHED; PG8_LDA(At, 1, 0); PG8_STAGE2(PG8_SA(0, 1), a2, x10, x11);
            PG8_WAIT_L(8); PG8_BAR; PG8_WAIT_L(0); PG8_MMA(0, 0, At, B0); PG8_BAR; PG8_SCHED;
            PG8_LDB(B1, 1, 1); PG8_STAGEB(PG8_SB(1, 0), b3);
            PG8_BAR; PG8_WAIT_L(0); PG8_MMA(0, 1, At, B1); PG8_BAR;
            PG8_LDA(At, 1, 1); PG8_STAGE2(PG8_SA(1, 0), a3, x00, x01);
            PG8_BAR; PG8_WAIT_L(0); PG8_MMA(1, 0, At, B0); PG8_BAR; PG8_SCHED;
            PG8_STAGEB(PG8_SB(1, 1), b3 + hstep);
            PG8_WAIT_V(6); PG8_BAR; PG8_MMA(1, 1, At, B1); PG8_BAR;
            }
        }
        if constexpr (ALIGN_EPI) { if (wr == 0) PG8_BAR; }
        E(acc, cur, wr, wc);
        if (!has_next) break;
#pragma unroll
        for (int a = 0; a < 2; ++a)
#pragma unroll
            for (int b = 0; b < 2; ++b)
#pragma unroll
                for (int m = 0; m < 4; ++m)
#pragma unroll
                    for (int n = 0; n < 2; ++n) acc[a][b][m][n] = (f32x4){0.f, 0.f, 0.f, 0.f};
        cur = nxt; cB = nB; c00 = n00; c01 = n01; c10 = n10; c11 = n11; ++ui;
        if constexpr (ALIGN_EPI) { if (wr == 1) PG8_BAR; }
    }
    PG8_WAIT_V(0);
    if constexpr (!ALIGN_EPI) { if (wr == 0) PG8_BAR; }
    PG8_BAR;
#undef PG8_SA
#undef PG8_SB
#undef PG8_STAGE2
#undef PG8_STAGEB
#undef PG8_LDA
#undef PG8_LDB
#undef PG8_MMA
#undef PG8_WAIT_V
#undef PG8_WAIT_L
#undef PG8_BAR
#undef PG8_SCHED
#undef PG8_AOFFS
}
}

struct Params {
    const float* in[33];
    float* out;
    unsigned char* ws;
    int layer, pad;
};
enum { I_X = 0, I_C, I_ADAW, I_ADAB, I_NMIX, I_NFFN, I_WIN, I_SCW, I_SCB, I_SDTB, I_SALOG, I_SD, I_SNW, I_HLB, I_HNW, I_LCW, I_LCB, I_LWA, I_LBA, I_LWX, I_LBX, I_LLAM, I_LNW,
       I_WOUT, I_RW, I_RB, I_EG, I_EU, I_ED, I_SG, I_SU, I_SDN, I_FNW };

using pg8::Unit;
struct EpiU {
    static constexpr bool PERM = true;
    bf16_t* O; int ldc;
    __device__ __forceinline__ void operator()(const f32x4 (&acc)[2][2][4][2], const Unit& u, int wr, int wc) const {
        const int lane_ = fresh_lane(), fr = lane_ & 15, fq = lane_ >> 4;
        const int row0 = u.pm * 256 + wr * 64 + fr, col0 = u.pn * 256 + wc * 32 + 8 * fq;
#pragma unroll
        for (int ai = 0; ai < 2; ++ai)
#pragma unroll
            for (int m = 0; m < 4; ++m) { bf16_t* rowp = O + (size_t)(row0 + ai * 128 + m * 16) * ldc + col0;
#pragma unroll
                for (int bj = 0; bj < 2; ++bj) { const f32x4 v0 = acc[ai][bj][m][0], v1 = acc[ai][bj][m][1];
                    u32x4 w; w.x = pk2(v0[0], v0[1]); w.y = pk2(v0[2], v0[3]); w.z = pk2(v1[0], v1[1]); w.w = pk2(v1[2], v1[3]);
                    *(u32x4*)(rowp + bj * 128) = w; } }
    }
};
struct EpiOut {
    static constexpr bool PERM = false;
    const float* xin; float* xout; const float* gate;
    __device__ __forceinline__ void operator()(const f32x4 (&acc)[2][2][4][2], const Unit& u, int wr, int wc) const {
        const int lane_ = fresh_lane(), fr = lane_ & 15, fq = lane_ >> 4;
        const int row0 = u.pm * 256 + wr * 64 + fr, col0 = u.pn * 256 + wc * 32 + 4 * fq, b = u.pm >> 3;
        f32x4 gv[2][2];
#pragma unroll
        for (int bj = 0; bj < 2; ++bj)
#pragma unroll
            for (int n = 0; n < 2; ++n) gv[bj][n] = *(const f32x4*)(gate + (size_t)b * NMOD + col0 + bj * 128 + n * 16);
#pragma unroll
        for (int ai = 0; ai < 2; ++ai)
#pragma unroll
            for (int m = 0; m < 4; ++m) { const size_t off = (size_t)(row0 + ai * 128 + m * 16) * DM + col0;
#pragma unroll
                for (int bj = 0; bj < 2; ++bj)
#pragma unroll
                    for (int n = 0; n < 2; ++n) { const f32x4 xi = *(const f32x4*)(xin + off + bj * 128 + n * 16);
                        *(f32x4*)(xout + off + bj * 128 + n * 16) = xi + gv[bj][n] * acc[ai][bj][m][n]; }
                asm volatile("" ::: "memory"); }
    }
};
struct EpiH {
    static constexpr bool PERM = true;
    bf16_t* Hm;
    __device__ __forceinline__ void operator()(const f32x4 (&acc)[2][2][4][2], const Unit& u, int wr, int wc) const {
        const int lane_ = fresh_lane(), fr = lane_ & 15, fq = lane_ >> 4;
        const int row0 = u.pm * 256 + wr * 64 + fr, col0 = u.pn * 128 + wc * 32 + 8 * fq;
#pragma unroll
        for (int ai = 0; ai < 2; ++ai)
#pragma unroll
            for (int m = 0; m < 4; ++m) { bf16_t* rowp = Hm + (size_t)(row0 + ai * 128 + m * 16) * 256 + col0;
                f32x4 h0, h1;
#pragma unroll
                for (int j = 0; j < 4; ++j) { h0[j] = siluf_(acc[ai][0][m][0][j]) * acc[ai][1][m][0][j]; h1[j] = siluf_(acc[ai][0][m][1][j]) * acc[ai][1][m][1][j]; }
                u32x4 w; w.x = pk2(h0[0], h0[1]); w.y = pk2(h0[2], h0[3]); w.z = pk2(h1[0], h1[1]); w.w = pk2(h1[2], h1[3]);
                *(u32x4*)rowp = w; }
    }
};
struct EpiY {
    static constexpr bool PERM = true;
    unsigned char* Y; unsigned char* Ysh; const int* rinfo;
    __device__ __forceinline__ void operator()(const f32x4 (&acc)[2][2][4][2], const Unit& u, int wr, int wc) const {
        const int lane_ = fresh_lane(), fr = lane_ & 15, fq = lane_ >> 4;
        const int col0 = u.pn * 256 + wc * 32 + 8 * fq;
        unsigned char* base = Y + (size_t)u.pm * 256 * DM;
        if (u.e >= NEXP) base = Ysh + (size_t)(u.pm - rinfo[0]) * 256 * DM;
        base += (size_t)(wr * 64 + fr) * DM + col0;
#pragma unroll
        for (int ai = 0; ai < 2; ++ai)
#pragma unroll
            for (int m = 0; m < 4; ++m) { unsigned char* rowp = base + (size_t)(ai * 128 + m * 16) * DM;
#pragma unroll
                for (int bj = 0; bj < 2; ++bj) { const f32x4 v0 = acc[ai][bj][m][0] * Y8_SCALE, v1 = acc[ai][bj][m][1] * Y8_SCALE;
                    u32x2 w; w.x = pk4_fp8(v0[0], v0[1], v0[2], v0[3]); w.y = pk4_fp8(v1[0], v1[1], v1[2], v1[3]);
                    *(u32x2*)(rowp + bj * 128) = w; } }
    }
};
constexpr int LDS_UTAB = 131072, MAX_UNITS = 24;
__device__ __forceinline__ void moe_build_units(LAS unsigned char* lds, const int* rinfo, int NQ, int G, int cidx, int tid) {
    LAS int* tab = (LAS int*)(lds + LDS_UTAB);
    if (tid < MAX_UNITS) {
        const int nblk = rinfo[0]; const long L = (long)tid * G + cidx;
        int pm = -1, pn = 0, e = 0;
        if (L < (long)(nblk + 64) * NQ) { const int rb = (int)(L / NQ); pm = rb; pn = (int)(L % NQ); e = (rb < nblk) ? rinfo[64 + rb] : NEXP; }
        tab[tid * 4 + 0] = pm; tab[tid * 4 + 1] = pn; tab[tid * 4 + 2] = e; tab[tid * 4 + 3] = 0;
    }
    __syncthreads();
}
struct MoeOrder {
    const LAS int* tab;
    __device__ bool next(int i, Unit& u) const {
        if (i >= MAX_UNITS) return false;
        const int pm = __builtin_amdgcn_readfirstlane(tab[i * 4 + 0]); if (pm < 0) return false;
        u.pm = pm; u.pn = __builtin_amdgcn_readfirstlane(tab[i * 4 + 1]); u.e = __builtin_amdgcn_readfirstlane(tab[i * 4 + 2]); return true;
    }
};
struct GatherRows {
    const int* slot_tok; const int* rinfo;
    __device__ __forceinline__ int row(const Unit& u, int r) const {
        const int nblk = rinfo[0];
        if (u.pm < nblk) { const int t = slot_tok[u.pm * 256 + r]; return t < 0 ? 0 : t; }
        return (u.pm - nblk) * 256 + r;
    }
};

struct Ctx { LAS unsigned char* lds; int tid, lane, wave, G, bid; };

template <class RowMap>
__device__ __forceinline__ void transpose_item(const float* W, int N, int k0, int n0, bf16_t* WT, int ldk, const RowMap& rm, LAS float* scr, int lane) {
    const int nn = n0 + (lane & 31);
#pragma unroll 8
    for (int i = 0; i < 32; ++i) { const int kk = 2 * i + (lane >> 5); scr[kk * 33 + (lane & 31)] = (nn < N) ? W[(size_t)(k0 + kk) * N + nn] : 0.f; }
    LDS_WAIT();
    const int c = lane & 7;
#pragma unroll
    for (int j = 0; j < 4; ++j) { const int n = (lane >> 3) + 8 * j; const LAS float* s = scr + (8 * c) * 33 + n;
        u32x4 o; o.x = pk2(s[0 * 33], s[1 * 33]); o.y = pk2(s[2 * 33], s[3 * 33]); o.z = pk2(s[4 * 33], s[5 * 33]); o.w = pk2(s[6 * 33], s[7 * 33]);
        const int dr = (n0 + n < N) ? rm(n0 + n) : -1;
        if (dr >= 0) *(u32x4*)(WT + (size_t)dr * ldk + k0 + 8 * c) = o; }
    LDS_WAIT();
}
struct RmIdent { __device__ __forceinline__ int operator()(int n) const { return n; } };
struct RmWin { __device__ __forceinline__ int operator()(int n) const { return n < 2560 ? n : (n < 2576 ? -1 : n - 16); } };
struct RmGate { __device__ __forceinline__ int operator()(int n) const { return (n >> 7) * 256 + (n & 127); } };
struct RmUp { __device__ __forceinline__ int operator()(int n) const { return (n >> 7) * 256 + 128 + (n & 127); } };

__device__ __forceinline__ void phase_prep_io(const Params& p, const Ctx& c) {
    LAS float* scr = (LAS float*)(c.lds + c.wave * 16384);
    const int gw = c.bid * NWAVES + c.wave, NGW = c.G * NWAVES;
    constexpr int I_IN = 16 * 177, I_OUT = 32 * 32, PER_L = I_IN + I_OUT;
    for (int it = gw; it < NLAYER * PER_L; it += NGW) {
        const int l = it / PER_L; int r = it % PER_L;
        if (r < I_IN) { const int kb = r / 177, nb = r % 177;
            transpose_item(p.in[I_WIN] + (size_t)l * DM * DIN, DIN, kb * 64, nb * 32, (bf16_t*)(p.ws + WS_WIN) + (size_t)l * NU * DM, DM, RmWin(), scr, c.lane); }
        else { r -= I_IN; const int kb = r / 32, nb = r % 32;
            transpose_item(p.in[I_WOUT] + (size_t)l * 2048 * DM, DM, kb * 64, nb * 32, (bf16_t*)(p.ws + WS_WOUT) + (size_t)l * DM * 2048, 2048, RmIdent(), scr, c.lane); }
    }
}
__device__ __forceinline__ void phase_prep_experts(const Params& p, const Ctx& c, int l) {
    LAS float* scr = (LAS float*)(c.lds + c.wave * 16384);
    const int gw = c.bid * NWAVES + c.wave, NGW = c.G * NWAVES;
    constexpr int PER_E = 3 * 128;
    bf16_t* GU = (bf16_t*)(p.ws + WS_GU); bf16_t* DN = (bf16_t*)(p.ws + WS_DN);
    for (int it = gw; it < 65 * PER_E; it += NGW) {
        const int e = it / PER_E; int r = it % PER_E; const int which = r / 128; r %= 128;
        if (which < 2) {
            const float* src = (e < NEXP) ? p.in[which == 0 ? I_EG : I_EU] + ((size_t)l * NEXP + e) * DM * 256 : p.in[which == 0 ? I_SG : I_SU] + (size_t)l * DM * 256;
            const int kb = r / 8, nb = r % 8;
            if (which == 0) transpose_item(src, 256, kb * 64, nb * 32, GU + (size_t)e * 512 * DM, DM, RmGate(), scr, c.lane);
            else transpose_item(src, 256, kb * 64, nb * 32, GU + (size_t)e * 512 * DM, DM, RmUp(), scr, c.lane);
        } else {
            const float* src = (e < NEXP) ? p.in[I_ED] + ((size_t)l * NEXP + e) * 256 * DM : p.in[I_SDN] + (size_t)l * 256 * DM;
            const int kb = r / 32, nb = r % 32;
            transpose_item(src, DM, kb * 64, nb * 32, DN + (size_t)e * DM * 256, 256, RmIdent(), scr, c.lane);
        }
    }
}
__device__ __forceinline__ void phase_prep_small(const Params& p, const Ctx& c) {
    LAS float* sc = (LAS float*)c.lds;
    LAS float* red = (LAS float*)(c.lds + 32768);
    float* mod = (float*)(p.ws + WS_MOD);
    bool have_sc = false;
    for (int it = c.bid; it < NLAYER * 96; it += c.G) {
        if (!have_sc) { for (int i = c.tid; i < 8 * 1024; i += NTHREADS) sc[i] = siluf_(p.in[I_C][i]); have_sc = true; }
        __syncthreads();
        const int l = it / 96, j0 = (it % 96) * 64, j = c.tid & 63, kg = c.tid >> 6;
        const float* W = p.in[I_ADAW] + (size_t)l * DM * NMOD + j0 + j;
        float a[8];
#pragma unroll
        for (int b = 0; b < 8; ++b) a[b] = 0.f;
#pragma unroll 16
        for (int k = kg * 128; k < kg * 128 + 128; ++k) { const float w = W[(size_t)k * NMOD];
#pragma unroll
            for (int b = 0; b < 8; ++b) a[b] += sc[b * 1024 + k] * w; }
#pragma unroll
        for (int b = 0; b < 8; ++b) red[(kg * 8 + b) * 64 + j] = a[b];
        __syncthreads();
        { const int b = c.tid >> 6; float s = 0.f;
#pragma unroll
          for (int g = 0; g < 8; ++g) s += red[(g * 8 + b) * 64 + j];
          mod[((size_t)l * 8 + b) * NMOD + j0 + j] = s + p.in[I_ADAB][(size_t)l * NMOD + j0 + j]; }
        __syncthreads();
    }
    if (c.bid == c.G - 1) {
        float* lb = (float*)(p.ws + WS_LB);
        for (int i = c.tid; i < 512; i += NTHREADS) { const float v0 = p.in[I_HLB][i], v1 = p.in[I_HLB][512 + i]; const float m = fmaxf(v0, v1), e0 = expf(v0 - m), e1 = expf(v1 - m);
            lb[i] = 0.f; lb[512 + i] = e1 / (e0 + e1); }
    }
    { float* WT = (float*)(p.ws + WS_WRT);
      for (int o = c.bid * NTHREADS + c.tid; o < NLAYER * 64 * 1024; o += c.G * NTHREADS) { const int k = o & 1023, e = (o >> 10) & 63, l = o >> 16; WT[o] = p.in[I_RW][((size_t)l * 1024 + k) * 64 + e]; } }
    { bf16_t* LW = (bf16_t*)(p.ws + WS_LRUW);
      for (int o = c.bid * NTHREADS + c.tid; o < NLAYER * 2 * 8 * 4096; o += c.G * NTHREADS) {
          const int i = o & 63, j = (o >> 6) & 63, g = (o >> 12) & 7, mat = (o >> 15) & 1, l = o >> 16;
          const float* src = p.in[mat == 0 ? I_LWA : I_LWX] + (((size_t)l * 8 + g) * 64 + i) * 64 + j;
          LW[o] = (bf16_t)f2bf(*src); } }
}

__device__ __forceinline__ void load_wdt(const Params& p, const Ctx& c, int l, LAS float* wdt) {
    const float* Win = p.in[I_WIN] + (size_t)l * DM * DIN;
    for (int i = c.tid; i < 16 * 1024; i += NTHREADS) { const int k = i >> 4, j = i & 15; wdt[j * 1024 + k] = Win[(size_t)k * DIN + 2560 + j]; }
    __syncthreads();
}
__device__ __forceinline__ void norm_mix_row(const Ctx& c, const f32x4 (&v)[4], float ss, int tok, const float* nw, const float* mod, const LAS float* wdt, bf16_t* H, float* dtraw) {
        const int b = tok >> 11;
        const float rstd = rsqf_(wave_sum(ss, c.lane) * (1.0f / DM) + EPS);
        f32x4 hv[4], w4v[4], shv[4], scv[4];
#pragma unroll
        for (int j = 0; j < 4; ++j) { const int col = 256 * j + 4 * c.lane;
            w4v[j] = *(const f32x4*)(nw + col); shv[j] = *(const f32x4*)(mod + (size_t)b * NMOD + col); scv[j] = *(const f32x4*)(mod + (size_t)b * NMOD + 1024 + col); }
#pragma unroll
        for (int j = 0; j < 4; ++j) {
            const int col = 256 * j + 4 * c.lane;
            const f32x4 w4 = w4v[j], sh = shv[j], sc = scv[j];
            hv[j] = (v[j] * rstd * w4) * (sc + 1.0f) + sh;
            u32x2 o; o.x = pk2(hv[j][0], hv[j][1]); o.y = pk2(hv[j][2], hv[j][3]);
            *(u32x2*)(H + (size_t)tok * DM + col) = o;
        }
        float d16[16];
#pragma unroll
        for (int q = 0; q < 16; ++q) {
            float s2 = 0.f;
#pragma unroll
            for (int j = 0; j < 4; ++j) { const f32x4 wq = *(const LAS f32x4*)(wdt + q * 1024 + 256 * j + 4 * c.lane); s2 += (hv[j][0] * wq[0] + hv[j][1] * wq[1]) + (hv[j][2] * wq[2] + hv[j][3] * wq[3]); }
            d16[q] = s2;
            if ((q & 1) == 1) asm volatile("" ::: "memory");
        }
        float d8[8], d4[4], d2[2], d1;
        { const bool up = (c.lane & 32) != 0;
#pragma unroll
          for (int i = 0; i < 8; ++i) { const float snd = up ? d16[i] : d16[8 + i], kp = up ? d16[8 + i] : d16[i]; d8[i] = kp + shfl_xor_l(snd, 32, c.lane); } }
        { const bool up = (c.lane & 16) != 0;
#pragma unroll
          for (int i = 0; i < 4; ++i) { const float snd = up ? d8[i] : d8[4 + i], kp = up ? d8[4 + i] : d8[i]; d4[i] = kp + shfl_xor_l(snd, 16, c.lane); } }
        { const bool up = (c.lane & 8) != 0;
#pragma unroll
          for (int i = 0; i < 2; ++i) { const float snd = up ? d4[i] : d4[2 + i], kp = up ? d4[2 + i] : d4[i]; d2[i] = kp + shfl_xor_l(snd, 8, c.lane); } }
        { const bool up = (c.lane & 4) != 0; const float snd = up ? d2[0] : d2[1], kp = up ? d2[1] : d2[0]; d1 = kp + shfl_xor_l(snd, 4, c.lane); }
        d1 += shfl_xor_l(d1, 2, c.lane); d1 += shfl_xor_l(d1, 1, c.lane);
        if ((c.lane & 3) == 0) dtraw[(size_t)tok * 16 + ((c.lane >> 5) & 1) * 8 + ((c.lane >> 4) & 1) * 4 + ((c.lane >> 3) & 1) * 2 + ((c.lane >> 2) & 1)] = d1;
}
__device__ __forceinline__ void phase_norm_mix(const Params& p, const Ctx& c, int l, const float* xin) {
    LAS float* wdt = (LAS float*)c.lds;
    load_wdt(p, c, l, wdt);
    const float* mod = (const float*)(p.ws + WS_MOD) + (size_t)l * 8 * NMOD;
    const float* nw = p.in[I_NMIX] + (size_t)l * DM;
    bf16_t* H = (bf16_t*)(p.ws + WS_H); float* dtraw = (float*)(p.ws + WS_DTRAW);
    const int gw = c.bid * NWAVES + c.wave, NGW = c.G * NWAVES;
    f32x4 vn[4];
    if (gw < NTOK) {
#pragma unroll
        for (int j = 0; j < 4; ++j) vn[j] = ((const f32x4*)(xin + (size_t)gw * DM) + c.lane)[64 * j];
    }
    for (int tok = gw; tok < NTOK; tok += NGW) {
        f32x4 v[4]; float ss = 0.f;
#pragma unroll
        for (int j = 0; j < 4; ++j) { v[j] = vn[j]; ss += (v[j][0] * v[j][0] + v[j][1] * v[j][1]) + (v[j][2] * v[j][2] + v[j][3] * v[j][3]); }
        if (tok + NGW < NTOK) {
#pragma unroll
            for (int j = 0; j < 4; ++j) vn[j] = ((const f32x4*)(xin + (size_t)(tok + NGW) * DM) + c.lane)[64 * j];
        }
        norm_mix_row(c, v, ss, tok, nw, mod, wdt, H, dtraw);
    }
}

__device__ __forceinline__ void phase_ssd_conv(const Params& p, const Ctx& c, int l) {
    const bf16_t* U = (const bf16_t*)(p.ws + WS_U); bf16_t* XA = (bf16_t*)(p.ws + WS_XBC);
    const float* cw = p.in[I_SCW] + (size_t)l * 4 * 1536; const float* cb = p.in[I_SCB] + (size_t)l * 1536;
    const float* dtraw = (const float*)(p.ws + WS_DTRAW); float* dt = (float*)(p.ws + WS_DT); float* acum = (float*)(p.ws + WS_ACUM);
    for (int idx = c.bid * NTHREADS + c.tid; idx < (NTOK / 4) * 192; idx += c.G * NTHREADS) {
        const int oct = idx % 192, tg = idx / 192, tok0 = tg * 4, t0 = tok0 & (SEQ - 1), c0 = oct * 8;
        float w[4][8], bb[8];
#pragma unroll
        for (int k = 0; k < 4; ++k) { const f32x4 a = *(const f32x4*)(cw + k * 1536 + c0), b2 = *(const f32x4*)(cw + k * 1536 + c0 + 4);
            w[k][0] = a[0]; w[k][1] = a[1]; w[k][2] = a[2]; w[k][3] = a[3]; w[k][4] = b2[0]; w[k][5] = b2[1]; w[k][6] = b2[2]; w[k][7] = b2[3]; }
        { const f32x4 a = *(const f32x4*)(cb + c0), b2 = *(const f32x4*)(cb + c0 + 4); bb[0] = a[0]; bb[1] = a[1]; bb[2] = a[2]; bb[3] = a[3]; bb[4] = b2[0]; bb[5] = b2[1]; bb[6] = b2[2]; bb[7] = b2[3]; }
        float x[7][8];
#pragma unroll
        for (int r = 0; r < 7; ++r) {
            u32x4 v = (u32x4){0u, 0u, 0u, 0u};
            if (t0 + r - 3 >= 0) v = *(const u32x4*)(U + (size_t)(tok0 + r - 3) * NU + UXS + c0);
#pragma unroll
            for (int j = 0; j < 4; ++j) { x[r][2 * j] = lo_bf(v[j]); x[r][2 * j + 1] = hi_bf(v[j]); }
        }
#pragma unroll
        for (int t = 0; t < 4; ++t) {
            float y[8];
#pragma unroll
            for (int j = 0; j < 8; ++j) y[j] = siluf_(bb[j] + w[0][j] * x[t][j] + w[1][j] * x[t + 1][j] + w[2][j] * x[t + 2][j] + w[3][j] * x[t + 3][j]);
            u32x4 o; o.x = pk2(y[0], y[1]); o.y = pk2(y[2], y[3]); o.z = pk2(y[4], y[5]); o.w = pk2(y[6], y[7]);
            *(u32x4*)(XA + (size_t)(tok0 + t) * 1536 + c0) = o;
        }
    }
    for (int it = c.bid + c.wave * c.G; it < 128; it += c.G * NWAVES) {
        const int tok0 = it * 128, h = c.lane & 15, qtr = c.lane >> 4;
        const float bias = p.in[I_SDTB][l * 16 + h], A = -expf(p.in[I_SALOG][l * 16 + h]);
        float d[32]; float cum = 0.f;
#pragma unroll
        for (int i = 0; i < 32; ++i) d[i] = softplusf_(dtraw[(size_t)(tok0 + qtr * 32 + i) * 16 + h] + bias);
#pragma unroll
        for (int i = 0; i < 32; ++i) cum += d[i] * A;
        const float c1 = shfl_up_f(cum, 16, c.lane), c2 = shfl_up_f(cum, 32, c.lane), c3 = shfl_up_f(cum, 48, c.lane);
        float off = 0.f; if (qtr >= 1) off += c1; if (qtr >= 2) off += c2; if (qtr >= 3) off += c3;
        float run = off;
#pragma unroll
        for (int i = 0; i < 32; ++i) { run += d[i] * A; dt[(size_t)(tok0 + qtr * 32 + i) * 16 + h] = d[i]; acum[(size_t)(tok0 + qtr * 32 + i) * 16 + h] = run; }
    }
}

__device__ __forceinline__ void phase_ssd_state(const Params& p, const Ctx& c) {
    LAS bf16_t* XS = (LAS bf16_t*)c.lds;
    LAS bf16_t* BS = (LAS bf16_t*)(c.lds + 2 * 18432);
    LAS float* fac = (LAS float*)(c.lds + 2 * 18432 + 34816);
    const bf16_t* XA = (const bf16_t*)(p.ws + WS_XBC); const float* dt = (const float*)(p.ws + WS_DT); const float* acum = (const float*)(p.ws + WS_ACUM);
    bf16_t* ST = (bf16_t*)(p.ws + WS_SST);
    const int fr = c.lane & 15, fq = c.lane >> 4;
    for (int it = c.bid; it < 256; it += c.G) {
        const int g = it & 1, bc = it >> 1, tok0 = bc * 128;
        u32x4 pxs[2];
#pragma unroll
        for (int q = 0; q < 2; ++q) { const int i = c.tid + q * NTHREADS; pxs[q] = *(const u32x4*)(XA + (size_t)(tok0 + (i >> 3)) * 1536 + (g * 8) * 64 + (i & 7) * 8); }
        for (int i = c.tid; i < 128 * 16; i += NTHREADS) { const int lrow = i >> 4, ck = i & 15;
            *(LAS u32x4*)(BS + lrow * 136 + ck * 8) = *(const u32x4*)(XA + (size_t)(tok0 + lrow) * 1536 + 1024 + g * 128 + ck * 8); }
        for (int i = c.tid; i < 1024; i += NTHREADS) { const int h8 = i >> 7, lr = i & 127, h = g * 8 + h8;
            fac[i] = dt[(size_t)(tok0 + lr) * 16 + h] * __expf(acum[(size_t)(tok0 + 127) * 16 + h] - acum[(size_t)(tok0 + lr) * 16 + h]); }
        LDS_BARRIER();
        for (int h8 = 0; h8 < 8; ++h8) {
            const int h = g * 8 + h8; LAS bf16_t* X = XS + (h8 & 1) * (128 * 72);
#pragma unroll
            for (int q = 0; q < 2; ++q) { const int i = c.tid + q * NTHREADS, lrow = i >> 3, ck = i & 7; const u32x4 r = pxs[q]; const float f = fac[h8 * 128 + lrow];
                u32x4 o; o.x = pk2(lo_bf(r.x) * f, hi_bf(r.x) * f); o.y = pk2(lo_bf(r.y) * f, hi_bf(r.y) * f); o.z = pk2(lo_bf(r.z) * f, hi_bf(r.z) * f); o.w = pk2(lo_bf(r.w) * f, hi_bf(r.w) * f);
                *(LAS u32x4*)(X + lrow * 72 + ck * 8) = o; }
            if (h8 < 7) {
#pragma unroll
                for (int q = 0; q < 2; ++q) { const int i = c.tid + q * NTHREADS; pxs[q] = *(const u32x4*)(XA + (size_t)(tok0 + (i >> 3)) * 1536 + (h + 1) * 64 + (i & 7) * 8); } }
            LDS_BARRIER();
            f32x4 acc[4];
#pragma unroll
            for (int m = 0; m < 4; ++m) acc[m] = (f32x4){0.f, 0.f, 0.f, 0.f};
#pragma unroll
            for (int ks = 0; ks < 4; ++ks) {
                const bf16x8 bfr = tr_frag(BS, 136, 32 * ks, 16 * c.wave, c.lane);
#pragma unroll
                for (int m = 0; m < 4; ++m) { const bf16x8 afr = tr_frag(X, 72, 32 * ks, 16 * m, c.lane); acc[m] = MFMA16(bfr, afr, acc[m]); }
            }
            const size_t sit = (size_t)(bc * 16 + h);
#pragma unroll
            for (int m = 0; m < 4; ++m) { u32x2 o; o.x = pk2(acc[m][0], acc[m][1]); o.y = pk2(acc[m][2], acc[m][3]);
                *(u32x2*)(ST + sit * 8192 + (16 * m + fr) * 128 + 16 * c.wave + 4 * fq) = o; }
        }
        LDS_BARRIER();
    }
}
__device__ __forceinline__ void phase_ssd_scan(const Params& p, const Ctx& c) {
    u32x4* ST = (u32x4*)(p.ws + WS_SST); const float* acum = (const float*)(p.ws + WS_ACUM);
    for (int i = c.bid * NTHREADS + c.tid; i < 128 * 1024; i += c.G * NTHREADS) {
        const int e8 = i & 1023, bh = i >> 10, b = bh >> 4, h = bh & 15;
        u32x4 loc[16]; float dec[16];
#pragma unroll
        for (int ch = 0; ch < 16; ++ch) { loc[ch] = ST[(size_t)((b * 16 + ch) * 16 + h) * 1024 + e8]; dec[ch] = __expf(acum[(size_t)(b * SEQ + ch * 128 + 127) * 16 + h]); }
        float r[8];
#pragma unroll
        for (int j = 0; j < 8; ++j) r[j] = 0.f;
#pragma unroll
        for (int ch = 0; ch < 16; ++ch) {
            u32x4 o; o.x = pk2(r[0], r[1]); o.y = pk2(r[2], r[3]); o.z = pk2(r[4], r[5]); o.w = pk2(r[6], r[7]);
            ST[(size_t)((b * 16 + ch) * 16 + h) * 1024 + e8] = o;
            const float d = dec[ch];
#pragma unroll
            for (int j = 0; j < 4; ++j) { r[2 * j] = d * r[2 * j] + lo_bf(loc[ch][j]); r[2 * j + 1] = d * r[2 * j + 1] + hi_bf(loc[ch][j]); }
        }
    }
}
__device__ __forceinline__ void phase_ssd_out_g(const Params& p, const Ctx& c, int l) {
    LAS bf16_t* Cs = (LAS bf16_t*)c.lds;
    LAS bf16_t* CB = (LAS bf16_t*)(c.lds + 34816);
    LAS bf16_t* BD = (LAS bf16_t*)(c.lds + 2 * 34816);
    LAS bf16_t* XS = (LAS bf16_t*)(c.lds + 3 * 34816);
    LAS bf16_t* STs = (LAS bf16_t*)(c.lds + 3 * 34816 + 18432);
    LAS float* acs = (LAS float*)(c.lds + 3 * 34816 + 18432 + 17408);
    LAS float* dts = acs + 1024;
    const bf16_t* XA = (const bf16_t*)(p.ws + WS_XBC); const float* dt = (const float*)(p.ws + WS_DT); const float* acum = (const float*)(p.ws + WS_ACUM);
    const bf16_t* ST = (const bf16_t*)(p.ws + WS_SST); bf16_t* YP = (bf16_t*)(p.ws + WS_H);
    const bf16_t* U = (const bf16_t*)(p.ws + WS_U); bf16_t* YC = (bf16_t*)(p.ws + WS_YCAT);
    const float* nw = p.in[I_SNW] + (size_t)l * 1024;
    const int fr = c.lane & 15, fq = c.lane >> 4, w = c.wave;
    for (int it = c.bid; it < 256; it += c.G) {
        const int g = it & 1, bc = it >> 1, tok0 = bc * 128;
        for (int i = c.tid; i < 128 * 16; i += NTHREADS) { const int row = i >> 4, ck = i & 15;
            *(LAS u32x4*)(BD + row * 136 + ck * 8) = *(const u32x4*)(XA + (size_t)(tok0 + row) * 1536 + 1024 + g * 128 + ck * 8);
            *(LAS u32x4*)(Cs + row * 136 + ck * 8) = *(const u32x4*)(XA + (size_t)(tok0 + row) * 1536 + 1280 + g * 128 + ck * 8); }
        for (int i = c.tid; i < 1024; i += NTHREADS) { const int h8 = i >> 7, lr = i & 127; acs[i] = acum[(size_t)(tok0 + lr) * 16 + g * 8 + h8]; dts[i] = dt[(size_t)(tok0 + lr) * 16 + g * 8 + h8]; }
        LDS_BARRIER();
        {
            f32x4 cb[8];
#pragma unroll
            for (int n = 0; n < 8; ++n) cb[n] = (f32x4){0.f, 0.f, 0.f, 0.f};
#pragma unroll
            for (int ks = 0; ks < 4; ++ks) {
                const bf16x8 afr = *(const LAS bf16x8*)(Cs + (16 * w + fr) * 136 + ks * 32 + 8 * fq);
#pragma unroll
                for (int n = 0; n < 8; ++n) { const bf16x8 bfr = *(const LAS bf16x8*)(BD + (16 * n + fr) * 136 + ks * 32 + 8 * fq); cb[n] = MFMA16(bfr, afr, cb[n]); }
            }
            const int lr = 16 * w + fr;
#pragma unroll
            for (int n = 0; n < 8; ++n) { u32x2 o; o.x = pk2(cb[n][0], cb[n][1]); o.y = pk2(cb[n][2], cb[n][3]); *(LAS u32x2*)(CB + lr * 136 + 16 * n + 4 * fq) = o; }
        }
        LDS_BARRIER();
        u32x4 pst[2], pxs[2];
#pragma unroll
        for (int q = 0; q < 2; ++q) { const int i = c.tid + q * NTHREADS;
            pst[q] = *(const u32x4*)(ST + (size_t)(bc * 16 + g * 8) * 8192 + (i >> 4) * 128 + (i & 15) * 8);
            pxs[q] = *(const u32x4*)(XA + (size_t)(tok0 + (i >> 3)) * 1536 + (g * 8) * 64 + (i & 7) * 8); }
        for (int h8 = 0; h8 < 8; ++h8) {
            const int h = g * 8 + h8;
            const float Dh = p.in[I_SD][l * 16 + h];
            const LAS float* ah = acs + h8 * 128; const LAS float* dh = dts + h8 * 128;
#pragma unroll
            for (int q = 0; q < 2; ++q) { const int i = c.tid + q * NTHREADS;
                *(LAS u32x4*)(STs + (i >> 4) * 136 + (i & 15) * 8) = pst[q];
                const int lrow = i >> 3, ck = i & 7; const u32x4 r = pxs[q]; const float f = dh[lrow];
                u32x4 o; o.x = pk2(lo_bf(r.x) * f, hi_bf(r.x) * f); o.y = pk2(lo_bf(r.y) * f, hi_bf(r.y) * f); o.z = pk2(lo_bf(r.z) * f, hi_bf(r.z) * f); o.w = pk2(lo_bf(r.w) * f, hi_bf(r.w) * f);
                *(LAS u32x4*)(XS + lrow * 72 + ck * 8) = o; }
            if (h8 < 7) {
#pragma unroll
                for (int q = 0; q < 2; ++q) { const int i = c.tid + q * NTHREADS;
                    pst[q] = *(const u32x4*)(ST + (size_t)(bc * 16 + h + 1) * 8192 + (i >> 4) * 128 + (i & 15) * 8);
                    pxs[q] = *(const u32x4*)(XA + (size_t)(tok0 + (i >> 3)) * 1536 + (h + 1) * 64 + (i & 7) * 8); } }
            for (int i = c.tid; i < 128 * 16; i += NTHREADS) { const int lr = i >> 4, ck = i & 15; u32x4 o = (u32x4){0u, 0u, 0u, 0u};
                if (8 * ck <= lr) { const u32x4 cv = *(const LAS u32x4*)(CB + lr * 136 + ck * 8); const float al = ah[lr];
                    const f32x4 s0 = *(const LAS f32x4*)(ah + 8 * ck), s1 = *(const LAS f32x4*)(ah + 8 * ck + 4);
                    float e[8];
#pragma unroll
                    for (int j = 0; j < 4; ++j) { e[j] = (8 * ck + j <= lr) ? __expf(al - s0[j]) : 0.f; e[4 + j] = (8 * ck + 4 + j <= lr) ? __expf(al - s1[j]) : 0.f; }
                    o.x = pk2(lo_bf(cv.x) * e[0], hi_bf(cv.x) * e[1]); o.y = pk2(lo_bf(cv.y) * e[2], hi_bf(cv.y) * e[3]); o.z = pk2(lo_bf(cv.z) * e[4], hi_bf(cv.z) * e[5]); o.w = pk2(lo_bf(cv.w) * e[6], hi_bf(cv.w) * e[7]); }
                *(LAS u32x4*)(BD + lr * 136 + ck * 8) = o; }
            LDS_BARRIER();
            {
                f32x4 a1[4], a2[4];
#pragma unroll
                for (int n = 0; n < 4; ++n) { a1[n] = (f32x4){0.f, 0.f, 0.f, 0.f}; a2[n] = (f32x4){0.f, 0.f, 0.f, 0.f}; }
#pragma unroll
                for (int ks = 0; ks < 4; ++ks) {
                    const bf16x8 ad = *(const LAS bf16x8*)(BD + (16 * w + fr) * 136 + ks * 32 + 8 * fq);
                    const bf16x8 ac = *(const LAS bf16x8*)(Cs + (16 * w + fr) * 136 + ks * 32 + 8 * fq);
#pragma unroll
                    for (int n = 0; n < 4; ++n) {
                        const bf16x8 bx = tr_frag(XS, 72, 32 * ks, 16 * n, c.lane);
                        const bf16x8 bs = *(const LAS bf16x8*)(STs + (16 * n + fr) * 136 + ks * 32 + 8 * fq);
                        a1[n] = MFMA16(bx, ad, a1[n]); a2[n] = MFMA16(bs, ac, a2[n]); }
                }
                const int lr = 16 * w + fr; const float ea = __expf(ah[lr]);
#pragma unroll
                for (int n = 0; n < 4; ++n) { const int pc = 16 * n + 4 * fq;
                    const u32x2 xv = *(const u32x2*)(XA + (size_t)(tok0 + lr) * 1536 + h * 64 + pc);
                    const float y0 = a1[n][0] + ea * a2[n][0] + Dh * lo_bf(xv.x), y1 = a1[n][1] + ea * a2[n][1] + Dh * hi_bf(xv.x);
                    const float y2 = a1[n][2] + ea * a2[n][2] + Dh * lo_bf(xv.y), y3 = a1[n][3] + ea * a2[n][3] + Dh * hi_bf(xv.y);
                    u32x2 o; o.x = pk2(y0, y1); o.y = pk2(y2, y3);
                    *(u32x2*)(YP + (size_t)(tok0 + lr) * DM + h * 64 + pc) = o; }
            }
            LDS_BARRIER();
        }
        __syncthreads();
        for (int pass = 0; pass < 2; ++pass) {
            const int tok = tok0 + pass * 64 + (c.tid >> 3), part = c.tid & 7, col = g * 512 + part * 8;
            u32x4 yv[8], zv[8];
#pragma unroll
            for (int i = 0; i < 8; ++i) { yv[i] = *(const u32x4*)(YP + (size_t)tok * DM + col + 64 * i); zv[i] = *(const u32x4*)(U + (size_t)tok * NU + UZ + col + 64 * i); }
            float v[64]; float ss = 0.f;
#pragma unroll
            for (int i = 0; i < 8; ++i)
#pragma unroll
                for (int j = 0; j < 4; ++j) { const float a = lo_bf(yv[i][j]) * siluf_(lo_bf(zv[i][j])), b2 = hi_bf(yv[i][j]) * siluf_(hi_bf(zv[i][j])); v[8 * i + 2 * j] = a; v[8 * i + 2 * j + 1] = b2; ss += a * a + b2 * b2; }
            ss += shfl_xor_l(ss, 1, c.lane); ss += shfl_xor_l(ss, 2, c.lane); ss += shfl_xor_l(ss, 4, c.lane);
            const float rstd = rsqf_(ss * (1.0f / 512.0f) + EPS);
#pragma unroll
            for (int i = 0; i < 8; ++i) { const f32x4 w0 = *(const f32x4*)(nw + col + 64 * i), w1 = *(const f32x4*)(nw + col + 64 * i + 4);
                u32x4 o; o.x = pk2(v[8 * i] * rstd * w0[0], v[8 * i + 1] * rstd * w0[1]); o.y = pk2(v[8 * i + 2] * rstd * w0[2], v[8 * i + 3] * rstd * w0[3]);
                o.z = pk2(v[8 * i + 4] * rstd * w1[0], v[8 * i + 5] * rstd * w1[1]); o.w = pk2(v[8 * i + 6] * rstd * w1[2], v[8 * i + 7] * rstd * w1[3]);
                *(u32x4*)(YC + (size_t)tok * 2048 + col + 64 * i) = o; }
        }
        LDS_BARRIER();
    }
}
__device__ __forceinline__ void phase_hg_state(const Params& p, const Ctx& c, int l) {
    LAS float* Bf = (LAS float*)c.lds;
    LAS float* KK = (LAS float*)(c.lds + 33792);
    LAS bf16_t* KD = (LAS bf16_t*)(c.lds + 2 * 33792 + 2112);
    LAS bf16_t* VS = (LAS bf16_t*)(c.lds + 2 * 33792 + 2112 + 17408);
    const bf16_t* U = (const bf16_t*)(p.ws + WS_U); const float* lb = (const float*)(p.ws + WS_LB) + l * 512;
    bf16_t* ST = (bf16_t*)(p.ws + WS_HST); float* BL = (float*)(p.ws + WS_HGBL);
    const int fr = c.lane & 15, fq = c.lane >> 4, w = c.wave;
    u32x4 pf[2], pv[2];
#define HS_LOAD(item) do { const int ch_ = (item) & 31, bh_ = (item) >> 5, h_ = bh_ & 3, b_ = bh_ >> 2, tk_ = b_ * SEQ + ch_ * 64; _Pragma("unroll") for (int q_ = 0; q_ < 2; ++q_) { const int i_ = c.tid + q_ * NTHREADS; \
        const size_t ro_ = (size_t)(tk_ + (i_ >> 4)) * NU + h_ * 128 + (i_ & 15) * 8; pf[q_] = *(const u32x4*)(U + ro_ + UHF); pv[q_] = *(const u32x4*)(U + ro_ + UHV); } } while (0)
    if (c.bid < 1024) HS_LOAD(c.bid);
    for (int it = c.bid; it < 1024; it += c.G) {
        const int ch = it & 31, bh = it >> 5, h = bh & 3, b = bh >> 2, tok0 = b * SEQ + ch * 64;
#pragma unroll
        for (int q = 0; q < 2; ++q) { const int i = c.tid + q * NTHREADS, sr = i >> 4, ck = i & 15;
            const u32x4 rf = pf[q];
            *(LAS u32x4*)(VS + sr * 136 + ck * 8) = pv[q];
            const f32x4 l0 = *(const f32x4*)(lb + h * 128 + ck * 8), l1 = *(const f32x4*)(lb + h * 128 + ck * 8 + 4);
            f32x4 k0, k1, g0, g1;
            k0[0] = (1.0f - l0[0]) * sigmoidf_(-lo_bf(rf.x)); k0[1] = (1.0f - l0[1]) * sigmoidf_(-hi_bf(rf.x)); k0[2] = (1.0f - l0[2]) * sigmoidf_(-lo_bf(rf.y)); k0[3] = (1.0f - l0[3]) * sigmoidf_(-hi_bf(rf.y));
            k1[0] = (1.0f - l1[0]) * sigmoidf_(-lo_bf(rf.z)); k1[1] = (1.0f - l1[1]) * sigmoidf_(-hi_bf(rf.z)); k1[2] = (1.0f - l1[2]) * sigmoidf_(-lo_bf(rf.w)); k1[3] = (1.0f - l1[3]) * sigmoidf_(-hi_bf(rf.w));
#pragma unroll
            for (int j = 0; j < 4; ++j) { g0[j] = __logf(1.0f - k0[j]); g1[j] = __logf(1.0f - k1[j]); }
            *(LAS f32x4*)(KK + sr * 132 + ck * 8) = k0; *(LAS f32x4*)(KK + sr * 132 + ck * 8 + 4) = k1;
            *(LAS f32x4*)(Bf + sr * 132 + ck * 8) = g0; *(LAS f32x4*)(Bf + sr * 132 + ck * 8 + 4) = g1; }
        if (it + c.G < 1024) HS_LOAD(it + c.G);
        LDS_BARRIER();
        { const int kc = c.tid & 127, q4 = c.tid >> 7; float vals[16]; float cum = 0.f;
#pragma unroll
          for (int i = 0; i < 16; ++i) { cum += Bf[(16 * q4 + i) * 132 + kc]; vals[i] = cum; }
          KK[(64 + q4) * 132 + kc] = cum;
          LDS_BARRIER();
          float off = 0.f;
#pragma unroll
          for (int j = 0; j < 3; ++j) off += (j < q4) ? KK[(64 + j) * 132 + kc] : 0.f;
#pragma unroll
          for (int i = 0; i < 16; ++i) Bf[(16 * q4 + i) * 132 + kc] = vals[i] + off;
          if (q4 == 3) BL[(size_t)it * 128 + kc] = vals[15] + off; }
        LDS_BARRIER();
        for (int i = c.tid; i < 64 * 16; i += NTHREADS) { const int sr = i >> 4, ck = i & 15;
            const f32x4 ka = *(const LAS f32x4*)(KK + sr * 132 + ck * 8), kb = *(const LAS f32x4*)(KK + sr * 132 + ck * 8 + 4);
            const f32x4 ba = *(const LAS f32x4*)(Bf + sr * 132 + ck * 8), bb = *(const LAS f32x4*)(Bf + sr * 132 + ck * 8 + 4);
            const f32x4 ea = *(const LAS f32x4*)(Bf + 63 * 132 + ck * 8), eb = *(const LAS f32x4*)(Bf + 63 * 132 + ck * 8 + 4);
            u32x4 o; o.x = pk2(ka[0] * __expf(ea[0] - ba[0]), ka[1] * __expf(ea[1] - ba[1])); o.y = pk2(ka[2] * __expf(ea[2] - ba[2]), ka[3] * __expf(ea[3] - ba[3]));
            o.z = pk2(kb[0] * __expf(eb[0] - bb[0]), kb[1] * __expf(eb[1] - bb[1])); o.w = pk2(kb[2] * __expf(eb[2] - bb[2]), kb[3] * __expf(eb[3] - bb[3]));
            *(LAS u32x4*)(KD + sr * 136 + ck * 8) = o; }
        LDS_BARRIER();
        f32x4 acc[8];
#pragma unroll
        for (int n = 0; n < 8; ++n) acc[n] = (f32x4){0.f, 0.f, 0.f, 0.f};
#pragma unroll
        for (int ks = 0; ks < 2; ++ks) {
            const bf16x8 afr = tr_frag(VS, 136, 32 * ks, 16 * w, c.lane);
#pragma unroll
            for (int n = 0; n < 8; ++n) { const bf16x8 bfr = tr_frag(KD, 136, 32 * ks, 16 * n, c.lane); acc[n] = MFMA16(bfr, afr, acc[n]); }
        }
#pragma unroll
        for (int n = 0; n < 8; ++n) { u32x2 o; o.x = pk2(acc[n][0], acc[n][1]); o.y = pk2(acc[n][2], acc[n][3]);
            *(u32x2*)(ST + (size_t)it * 16384 + (16 * w + fr) * 128 + 16 * n + 4 * fq) = o; }
        LDS_BARRIER();
    }
#undef HS_LOAD
}
__device__ __forceinline__ void phase_hg_scan(const Params& p, const Ctx& c) {
    u32x2* ST = (u32x2*)(p.ws + WS_HST); const float* BL = (const float*)(p.ws + WS_HGBL);
    for (int i = c.bid * NTHREADS + c.tid; i < 32 * 4096; i += c.G * NTHREADS) {
        const int e4 = i & 4095, bh = i >> 12, k0 = (4 * e4) & 127;
        float r[4] = {0.f, 0.f, 0.f, 0.f};
        for (int half = 0; half < 2; ++half) {
            u32x2 loc[16]; f32x4 dl[16];
#pragma unroll
            for (int cc = 0; cc < 16; ++cc) { const size_t it = (size_t)(bh * 32 + half * 16 + cc); loc[cc] = ST[it * 4096 + e4]; dl[cc] = *(const f32x4*)(BL + it * 128 + k0); }
#pragma unroll
            for (int cc = 0; cc < 16; ++cc) { const size_t it = (size_t)(bh * 32 + half * 16 + cc);
                u32x2 o; o.x = pk2(r[0], r[1]); o.y = pk2(r[2], r[3]);
                ST[it * 4096 + e4] = o;
                r[0] = __expf(dl[cc][0]) * r[0] + lo_bf(loc[cc].x); r[1] = __expf(dl[cc][1]) * r[1] + hi_bf(loc[cc].x);
                r[2] = __expf(dl[cc][2]) * r[2] + lo_bf(loc[cc].y); r[3] = __expf(dl[cc][3]) * r[3] + hi_bf(loc[cc].y); }
        }
    }
}
__device__ __forceinline__ void phase_hg_out(const Params& p, const Ctx& c, int l) {
    LAS bf16_t* Qs = (LAS bf16_t*)c.lds;
    LAS bf16_t* Ks = (LAS bf16_t*)(c.lds + 17408);
    LAS float* Bf = (LAS float*)(c.lds + 2 * 17408);
    LAS bf16_t* ATT = (LAS bf16_t*)(c.lds + 2 * 17408 + 33792);
    LAS bf16_t* VS = (LAS bf16_t*)(c.lds + 2 * 17408 + 33792 + 9216);
    LAS unsigned char* R5 = c.lds + 2 * 17408 + 33792 + 9216 + 17408;
    LAS bf16_t* QI3 = (LAS bf16_t*)R5;
    LAS bf16_t* KKI3 = (LAS bf16_t*)(R5 + 48 * 272);
    LAS bf16_t* STs = (LAS bf16_t*)R5;
    LAS float* QT = (LAS float*)(R5 + 40000);
    const bf16_t* U = (const bf16_t*)(p.ws + WS_U); const float* lb = (const float*)(p.ws + WS_LB) + l * 512;
    const bf16_t* ST = (const bf16_t*)(p.ws + WS_HST); bf16_t* YC = (bf16_t*)(p.ws + WS_YCAT);
    const float* nw = p.in[I_HNW] + (size_t)l * 512;
    const int fr = c.lane & 15, fq = c.lane >> 4, w = c.wave;
    u32x4 pq[2], pf[2], pv[2], pst[4];
#define HG_LOAD_QFV(item) do { const int ch_ = (item) & 31, bh_ = (item) >> 5, h_ = bh_ & 3, b_ = bh_ >> 2, tk_ = b_ * SEQ + ch_ * 64; _Pragma("unroll") for (int q_ = 0; q_ < 2; ++q_) { const int i_ = c.tid + q_ * NTHREADS; \
        const size_t ro_ = (size_t)(tk_ + (i_ >> 4)) * NU + h_ * 128 + (i_ & 15) * 8; pq[q_] = *(const u32x4*)(U + ro_ + UHQ); pf[q_] = *(const u32x4*)(U + ro_ + UHF); pv[q_] = *(const u32x4*)(U + ro_ + UHV); } } while (0)
#define HG_LOAD_ST(item) do { _Pragma("unroll") for (int q_ = 0; q_ < 4; ++q_) { const int i_ = c.tid + q_ * NTHREADS; pst[q_] = *(const u32x4*)(ST + (size_t)(item) * 16384 + (i_ >> 4) * 128 + (i_ & 15) * 8); } } while (0)
    if (c.bid < 1024) { HG_LOAD_QFV(c.bid); HG_LOAD_ST(c.bid); }
    for (int it = c.bid; it < 1024; it += c.G) {
        const int ch = it & 31, bh = it >> 5, h = bh & 3, b = bh >> 2, tok0 = b * SEQ + ch * 64;
        const bool more = (it + c.G) < 1024;
#pragma unroll
        for (int q = 0; q < 2; ++q) { const int i = c.tid + q * NTHREADS, sr = i >> 4, ck = i & 15;
            const u32x4 rq = pq[q], rf = pf[q];
            *(LAS u32x4*)(VS + sr * 136 + ck * 8) = pv[q];
            const f32x4 l0 = *(const f32x4*)(lb + h * 128 + ck * 8), l1 = *(const f32x4*)(lb + h * 128 + ck * 8 + 4);
            f32x4 k0, k1, g0, g1;
            k0[0] = (1.0f - l0[0]) * sigmoidf_(-lo_bf(rf.x)); k0[1] = (1.0f - l0[1]) * sigmoidf_(-hi_bf(rf.x)); k0[2] = (1.0f - l0[2]) * sigmoidf_(-lo_bf(rf.y)); k0[3] = (1.0f - l0[3]) * sigmoidf_(-hi_bf(rf.y));
            k1[0] = (1.0f - l1[0]) * sigmoidf_(-lo_bf(rf.z)); k1[1] = (1.0f - l1[1]) * sigmoidf_(-hi_bf(rf.z)); k1[2] = (1.0f - l1[2]) * sigmoidf_(-lo_bf(rf.w)); k1[3] = (1.0f - l1[3]) * sigmoidf_(-hi_bf(rf.w));
#pragma unroll
            for (int j = 0; j < 4; ++j) { g0[j] = __logf(1.0f - k0[j]); g1[j] = __logf(1.0f - k1[j]); }
            u32x4 ko; ko.x = pk2(k0[0], k0[1]); ko.y = pk2(k0[2], k0[3]); ko.z = pk2(k1[0], k1[1]); ko.w = pk2(k1[2], k1[3]);
            u32x4 qo; qo.x = pk2(siluf_(lo_bf(rq.x)), siluf_(hi_bf(rq.x))); qo.y = pk2(siluf_(lo_bf(rq.y)), siluf_(hi_bf(rq.y))); qo.z = pk2(siluf_(lo_bf(rq.z)), siluf_(hi_bf(rq.z))); qo.w = pk2(siluf_(lo_bf(rq.w)), siluf_(hi_bf(rq.w)));
            *(LAS u32x4*)(Ks + sr * 136 + ck * 8) = ko; *(LAS u32x4*)(Qs + sr * 136 + ck * 8) = qo;
            *(LAS f32x4*)(Bf + sr * 132 + ck * 8) = g0; *(LAS f32x4*)(Bf + sr * 132 + ck * 8 + 4) = g1; }
        if (more) HG_LOAD_QFV(it + c.G);
        LDS_BARRIER();
        { const int kc = c.tid & 127, q4 = c.tid >> 7; float vals[16]; float cum = 0.f;
#pragma unroll
          for (int i = 0; i < 16; ++i) { cum += Bf[(16 * q4 + i) * 132 + kc]; vals[i] = cum; }
          QT[q4 * 128 + kc] = cum;
          LDS_BARRIER();
          float off = 0.f;
#pragma unroll
          for (int j = 0; j < 3; ++j) off += (j < q4) ? QT[j * 128 + kc] : 0.f;
#pragma unroll
          for (int i = 0; i < 16; ++i) Bf[(16 * q4 + i) * 132 + kc] = vals[i] + off; }
        LDS_BARRIER();
        for (int i = c.tid; i < 48 * 64; i += NTHREADS) { const int rowq = i >> 6, kp = i & 63, ib = (rowq >> 4) + 1, t = 16 + rowq, rref = 16 * ib - 1;
            const unsigned q2 = *(const LAS unsigned*)(Qs + t * 136 + 2 * kp);
            *(LAS unsigned*)(QI3 + rowq * 136 + 2 * kp) = pk2(lo_bf(q2) * __expf(Bf[t * 132 + 2 * kp] - Bf[rref * 132 + 2 * kp]), hi_bf(q2) * __expf(Bf[t * 132 + 2 * kp + 1] - Bf[rref * 132 + 2 * kp + 1])); }
        for (int i = c.tid; i < 96 * 64; i += NTHREADS) { const int rowk = i >> 6, kp = i & 63; const int ib = (rowk < 16) ? 1 : (rowk < 48 ? 2 : 3), s2 = rowk - 8 * ib * (ib - 1), rref = 16 * ib - 1;
            const unsigned k2 = *(const LAS unsigned*)(Ks + s2 * 136 + 2 * kp);
            *(LAS unsigned*)(KKI3 + rowk * 136 + 2 * kp) = pk2(lo_bf(k2) * __expf(Bf[rref * 132 + 2 * kp] - Bf[s2 * 132 + 2 * kp]), hi_bf(k2) * __expf(Bf[rref * 132 + 2 * kp + 1] - Bf[s2 * 132 + 2 * kp + 1])); }
        for (int pidx = c.tid; pidx < 1024; pidx += NTHREADS) {
            const int ib = pidx >> 8, tq = (pidx >> 4) & 15, sq = pidx & 15, t = 16 * ib + tq, s2 = 16 * ib + sq; float a = 0.f;
            if (sq <= tq) {
                for (int k = 0; k < 128; k += 4) {
                    const f32x4 bt = *(const LAS f32x4*)(Bf + t * 132 + k), bs = *(const LAS f32x4*)(Bf + s2 * 132 + k);
                    const u32x2 qv = *(const LAS u32x2*)(Qs + t * 136 + k), kv = *(const LAS u32x2*)(Ks + s2 * 136 + k);
                    a += lo_bf(qv.x) * lo_bf(kv.x) * __expf(bt[0] - bs[0]) + hi_bf(qv.x) * hi_bf(kv.x) * __expf(bt[1] - bs[1])
                       + lo_bf(qv.y) * lo_bf(kv.y) * __expf(bt[2] - bs[2]) + hi_bf(qv.y) * hi_bf(kv.y) * __expf(bt[3] - bs[3]);
                }
            }
            ATT[t * 72 + s2] = (bf16_t)f2bf(a);
        }
        for (int i = c.tid; i < 6 * 256; i += NTHREADS) { const int blk = i >> 8, e = i & 255; const int bi = (blk < 3) ? 0 : (blk < 5 ? 1 : 2), bj = (blk < 3) ? blk + 1 : (blk < 5 ? blk - 1 : 3);
            ATT[(16 * bi + (e >> 4)) * 72 + 16 * bj + (e & 15)] = (bf16_t)0; }
        LDS_BARRIER();
        if (w < 6) {
            const int ib = (w == 0) ? 1 : (w < 3 ? 2 : 3), jb = w - ((ib * (ib - 1)) >> 1);
            f32x4 a4 = (f32x4){0.f, 0.f, 0.f, 0.f};
#pragma unroll
            for (int ks = 0; ks < 4; ++ks) { const bf16x8 afr = *(const LAS bf16x8*)(QI3 + (16 * (ib - 1) + fr) * 136 + ks * 32 + 8 * fq), bfr = *(const LAS bf16x8*)(KKI3 + (8 * ib * (ib - 1) + 16 * jb + fr) * 136 + ks * 32 + 8 * fq); a4 = MFMA16(afr, bfr, a4); }
#pragma unroll
            for (int r = 0; r < 4; ++r) ATT[(16 * ib + 4 * fq + r) * 72 + 16 * jb + fr] = (bf16_t)f2bf(a4[r]);
        }
        for (int i = c.tid; i < 64 * 64; i += NTHREADS) { const int t = i >> 6, kp = i & 63;
            const unsigned q2 = *(const LAS unsigned*)(Qs + t * 136 + 2 * kp);
            *(LAS unsigned*)(Qs + t * 136 + 2 * kp) = pk2(lo_bf(q2) * __expf(Bf[t * 132 + 2 * kp]), hi_bf(q2) * __expf(Bf[t * 132 + 2 * kp + 1])); }
        LDS_BARRIER();
#pragma unroll
        for (int q = 0; q < 4; ++q) { const int i = c.tid + q * NTHREADS; *(LAS u32x4*)(STs + (i >> 4) * 136 + (i & 15) * 8) = pst[q]; }
        if (more) HG_LOAD_ST(it + c.G);
        LDS_BARRIER();
        f32x4 acc[4];
#pragma unroll
        for (int m = 0; m < 4; ++m) acc[m] = (f32x4){0.f, 0.f, 0.f, 0.f};
#pragma unroll
        for (int ks = 0; ks < 4; ++ks) {
            const bf16x8 bfr = *(const LAS bf16x8*)(STs + (16 * w + fr) * 136 + ks * 32 + 8 * fq);
#pragma unroll
            for (int m = 0; m < 4; ++m) { const bf16x8 afr = *(const LAS bf16x8*)(Qs + (16 * m + fr) * 136 + ks * 32 + 8 * fq); acc[m] = MFMA16(afr, bfr, acc[m]); }
        }
#pragma unroll
        for (int ks = 0; ks < 2; ++ks) {
            const bf16x8 bfr = tr_frag(VS, 136, 32 * ks, 16 * w, c.lane);
#pragma unroll
            for (int m = 0; m < 4; ++m) { const bf16x8 afr = *(const LAS bf16x8*)(ATT + (16 * m + fr) * 72 + ks * 32 + 8 * fq); acc[m] = MFMA16(afr, bfr, acc[m]); }
        }
#pragma unroll
        for (int m = 0; m < 4; ++m)
#pragma unroll
            for (int r = 0; r < 4; ++r) Bf[(16 * m + 4 * fq + r) * 132 + 16 * w + fr] = acc[m][r];
        LDS_BARRIER();
        {
            const int t = c.tid >> 3, part = c.tid & 7;
            f32x4 o4[4]; float ss = 0.f;
#pragma unroll
            for (int i = 0; i < 4; ++i) { o4[i] = *(const LAS f32x4*)(Bf + t * 132 + part * 16 + 4 * i); ss += (o4[i][0] * o4[i][0] + o4[i][1] * o4[i][1]) + (o4[i][2] * o4[i][2] + o4[i][3] * o4[i][3]); }
            const u32x4 g0 = *(const u32x4*)(U + (size_t)(tok0 + t) * NU + UHG + h * 128 + part * 16), g1 = *(const u32x4*)(U + (size_t)(tok0 + t) * NU + UHG + h * 128 + part * 16 + 8);
            ss += shfl_xor_l(ss, 1, c.lane); ss += shfl_xor_l(ss, 2, c.lane); ss += shfl_xor_l(ss, 4, c.lane);
            const float rstd = rsqf_(ss * (1.0f / 128.0f) + EPS);
            const float* nwp = nw + h * 128 + part * 16;
            const f32x4 n0 = *(const f32x4*)(nwp), n1 = *(const f32x4*)(nwp + 4), n2 = *(const f32x4*)(nwp + 8), n3 = *(const f32x4*)(nwp + 12);
            u32x4 r0, r1;
            r0.x = pk2(o4[0][0] * rstd * n0[0] * siluf_(lo_bf(g0.x)), o4[0][1] * rstd * n0[1] * siluf_(hi_bf(g0.x))); r0.y = pk2(o4[0][2] * rstd * n0[2] * siluf_(lo_bf(g0.y)), o4[0][3] * rstd * n0[3] * siluf_(hi_bf(g0.y)));
            r0.z = pk2(o4[1][0] * rstd * n1[0] * siluf_(lo_bf(g0.z)), o4[1][1] * rstd * n1[1] * siluf_(hi_bf(g0.z))); r0.w = pk2(o4[1][2] * rstd * n1[2] * siluf_(lo_bf(g0.w)), o4[1][3] * rstd * n1[3] * siluf_(hi_bf(g0.w)));
            r1.x = pk2(o4[2][0] * rstd * n2[0] * siluf_(lo_bf(g1.x)), o4[2][1] * rstd * n2[1] * siluf_(hi_bf(g1.x))); r1.y = pk2(o4[2][2] * rstd * n2[2] * siluf_(lo_bf(g1.y)), o4[2][3] * rstd * n2[3] * siluf_(hi_bf(g1.y)));
            r1.z = pk2(o4[3][0] * rstd * n3[0] * siluf_(lo_bf(g1.z)), o4[3][1] * rstd * n3[1] * siluf_(hi_bf(g1.z))); r1.w = pk2(o4[3][2] * rstd * n3[2] * siluf_(lo_bf(g1.w)), o4[3][3] * rstd * n3[3] * siluf_(hi_bf(g1.w)));
            bf16_t* yo = YC + (size_t)(tok0 + t) * 2048 + 1024 + h * 128 + part * 16;
            *(u32x4*)yo = r0; *(u32x4*)(yo + 8) = r1;
        }
        LDS_BARRIER();
    }
#undef HG_LOAD_QFV
#undef HG_LOAD_ST
}

__device__ __forceinline__ void phase_lru1(const Params& p, const Ctx& c, int l) {
    LAS unsigned char* wl = c.lds + c.wave * 14336;
    LAS bf16_t* XB = (LAS bf16_t*)wl;
    LAS bf16_t* XR = (LAS bf16_t*)(wl + 12032);
    LAS float* As = (LAS float*)(wl + 2304);
    LAS float* Us = (LAS float*)(wl + 2304 + 4096);
    const bf16_t* U = (const bf16_t*)(p.ws + WS_U); bf16_t* LA = (bf16_t*)(p.ws + WS_LA); bf16_t* LH = (bf16_t*)(p.ws + WS_LH);
    const bf16_t* LW = (const bf16_t*)(p.ws + WS_LRUW) + (size_t)l * 2 * 8 * 4096;
    const int fr = c.lane & 15, fq = c.lane >> 4, g = c.wave, chn = g * 64 + c.lane;
    const float cw0 = p.in[I_LCW][(size_t)l * 2048 + chn], cw1 = p.in[I_LCW][(size_t)l * 2048 + 512 + chn], cw2 = p.in[I_LCW][(size_t)l * 2048 + 1024 + chn], cw3 = p.in[I_LCW][(size_t)l * 2048 + 1536 + chn];
    const float cbias = p.in[I_LCB][l * 512 + chn];
    bf16x8 wfa[4][2], wfx[4][2];
#pragma unroll
    for (int n = 0; n < 4; ++n)
#pragma unroll
        for (int ks = 0; ks < 2; ++ks) { wfa[n][ks] = *(const bf16x8*)(LW + (size_t)(0 * 8 + g) * 4096 + (16 * n + fr) * 64 + ks * 32 + 8 * fq);
                                         wfx[n][ks] = *(const bf16x8*)(LW + (size_t)(1 * 8 + g) * 4096 + (16 * n + fr) * 64 + ks * 32 + 8 * fq); }
    float bav[4], bxv[4], spl[4];
#pragma unroll
    for (int n = 0; n < 4; ++n) { const int j = g * 64 + 16 * n + fr; bav[n] = p.in[I_LBA][l * 512 + j]; bxv[n] = p.in[I_LBX][l * 512 + j]; spl[n] = softplusf_(-p.in[I_LLAM][l * 512 + j]); }
    for (int it = c.bid; it < 256; it += c.G) {
        const int seg = it & 31, tok0 = (it >> 5) * SEQ + seg * 64;
        float x0 = 0.f, x1 = 0.f, x2 = 0.f;
        if (seg > 0) { x0 = bf2f(U[(size_t)(tok0 - 3) * NU + ULX + chn]); x1 = bf2f(U[(size_t)(tok0 - 2) * NU + ULX + chn]); x2 = bf2f(U[(size_t)(tok0 - 1) * NU + ULX + chn]); }
        float hrun = 0.f, arun = 1.f;
        u32x4 praw[2];
#pragma unroll
        for (int q = 0; q < 2; ++q) { const int ci = c.lane + 64 * q; praw[q] = *(const u32x4*)(U + (size_t)(tok0 + (ci >> 3)) * NU + ULX + g * 64 + (ci & 7) * 8); }
        for (int st = 0; st < 4; ++st) {
            const int t0 = tok0 + st * 16;
#pragma unroll
            for (int q = 0; q < 2; ++q) { const int ci = c.lane + 64 * q; *(LAS u32x4*)(XR + (ci >> 3) * 72 + (ci & 7) * 8) = praw[q]; }
            if (st < 3) {
#pragma unroll
                for (int q = 0; q < 2; ++q) { const int ci = c.lane + 64 * q; praw[q] = *(const u32x4*)(U + (size_t)(t0 + 16 + (ci >> 3)) * NU + ULX + g * 64 + (ci & 7) * 8); } }
            LDS_WAIT();
#pragma unroll
            for (int tt = 0; tt < 16; ++tt) { const float xr = bf2f(XR[tt * 72 + c.lane]);
                const float xb = cbias + cw0 * x0 + cw1 * x1 + cw2 * x2 + cw3 * xr; x0 = x1; x1 = x2; x2 = xr;
                XB[tt * 72 + c.lane] = (bf16_t)f2bf(xb); }
            LDS_WAIT();
            f32x4 ar[4], ai[4];
#pragma unroll
            for (int n = 0; n < 4; ++n) { ar[n] = (f32x4){0.f, 0.f, 0.f, 0.f}; ai[n] = (f32x4){0.f, 0.f, 0.f, 0.f}; }
#pragma unroll
            for (int ks = 0; ks < 2; ++ks) { const bf16x8 afr = *(const LAS bf16x8*)(XB + fr * 72 + ks * 32 + 8 * fq);
#pragma unroll
                for (int n = 0; n < 4; ++n) { ar[n] = MFMA16(afr, wfa[n][ks], ar[n]); ai[n] = MFMA16(afr, wfx[n][ks], ai[n]); } }
#pragma unroll
            for (int n = 0; n < 4; ++n)
#pragma unroll
                for (int r = 0; r < 4; ++r) { const int t = 4 * fq + r, j = 16 * n + fr;
                    const float rg = sigmoidf_(ar[n][r] + bav[n]), ig = sigmoidf_(ai[n][r] + bxv[n]);
                    const float la = -8.0f * rg * spl[n], a = __expf(la), mult = __builtin_amdgcn_sqrtf(fmaxf(fmaf(-a, a, 1.0f), 0.f));
                    As[t * 64 + j] = a; Us[t * 64 + j] = mult * ig * bf2f(XB[t * 72 + j]); }
            LDS_WAIT();
#pragma unroll
            for (int tt = 0; tt < 16; ++tt) { const float a = As[tt * 64 + c.lane], uu = Us[tt * 64 + c.lane];
                hrun = a * hrun + uu; arun = a * arun;
                LA[(size_t)(t0 + tt) * 512 + chn] = (bf16_t)f2bf(arun); LH[(size_t)(t0 + tt) * 512 + chn] = (bf16_t)f2bf(hrun); }
            LDS_WAIT();
        }
    }
}
__device__ __forceinline__ void phase_lru2(const Params& p, const Ctx& c, int l) {
    LAS float* YS = (LAS float*)c.lds;
    LAS float* RS = (LAS float*)(c.lds + 64 * 516 * 4);
    const bf16_t* U = (const bf16_t*)(p.ws + WS_U); const bf16_t* LA = (const bf16_t*)(p.ws + WS_LA); const bf16_t* LH = (const bf16_t*)(p.ws + WS_LH);
    bf16_t* YC = (bf16_t*)(p.ws + WS_YCAT);
    const int g = c.wave, chn = g * 64 + c.lane;
    const float nwv = p.in[I_LNW][l * 512 + chn];
    for (int it = c.bid; it < 256; it += c.G) {
        const int seg = it & 31, b = it >> 5, tok0 = b * SEQ + seg * 64;
        float hin = 0.f;
        for (int s2 = 0; s2 < seg; ++s2) { const size_t row = (size_t)(b * SEQ + s2 * 64 + 63); hin = bf2f(LH[row * 512 + chn]) + bf2f(LA[row * 512 + chn]) * hin; }
#pragma unroll 8
        for (int tt = 0; tt < 64; ++tt) { const size_t tok = (size_t)(tok0 + tt);
            const float hh = bf2f(LH[tok * 512 + chn]) + bf2f(LA[tok * 512 + chn]) * hin;
            YS[tt * 516 + chn] = hh * gelu_tanhf_(bf2f(U[tok * NU + ULG + chn])); }
        LDS_BARRIER();
        {
            const int t = c.tid >> 3, part = c.tid & 7; float ss = 0.f;
#pragma unroll
            for (int i = 0; i < 16; ++i) { const f32x4 v = *(const LAS f32x4*)(YS + t * 516 + 32 * i + 4 * part); ss += (v[0] * v[0] + v[1] * v[1]) + (v[2] * v[2] + v[3] * v[3]); }
            ss += shfl_xor_l(ss, 1, c.lane); ss += shfl_xor_l(ss, 2, c.lane); ss += shfl_xor_l(ss, 4, c.lane);
            if (part == 0) RS[t] = rsqf_(ss * (1.0f / 512.0f) + EPS);
        }
        LDS_BARRIER();
#pragma unroll 8
        for (int tt = 0; tt < 64; ++tt) YC[(size_t)(tok0 + tt) * 2048 + 1536 + chn] = (bf16_t)f2bf(YS[tt * 516 + chn] * RS[tt] * nwv);
        LDS_BARRIER();
    }
}

__device__ __forceinline__ void phase_norm_router(const Params& p, const Ctx& c, int l, const float* xin) {
    constexpr int HSTR = 1028;
    LAS float* HS = (LAS float*)c.lds;
    LAS float* PL = (LAS float*)(c.lds + 16 * HSTR * 4);
    LAS float* LG = (LAS float*)(c.lds + 16 * HSTR * 4 + 32768);
    const float* mod = (const float*)(p.ws + WS_MOD) + (size_t)l * 8 * NMOD;
    const float* nw = p.in[I_NFFN] + (size_t)l * DM;
    const float* WT = (const float*)(p.ws + WS_WRT) + (size_t)l * 64 * 1024;
    const float rbias = p.in[I_RB][l * NEXP + c.lane];
    bf16_t* H = (bf16_t*)(p.ws + WS_H);
    unsigned long long* selm = (unsigned long long*)(p.ws + WS_SELM); float* rw = (float*)(p.ws + WS_RW);
    const int fr = c.lane & 15, fq = c.lane >> 4, w = c.wave;
    int* cnt = (int*)(p.ws + WS_CNT);
    f32x4 bw[8][4];
#pragma unroll
    for (int j = 0; j < 8; ++j)
#pragma unroll
        for (int n = 0; n < 4; ++n) bw[j][n] = *(const f32x4*)(WT + (size_t)(16 * n + fr) * 1024 + 128 * w + 16 * j + 4 * fq);
    int ecount = 0;
    f32x4 xn[2][4];
    if (c.bid < NTOK / 16) {
#pragma unroll
        for (int q = 0; q < 2; ++q)
#pragma unroll
            for (int j = 0; j < 4; ++j) xn[q][j] = ((const f32x4*)(xin + (size_t)(c.bid * 16 + 2 * w + q) * DM) + c.lane)[64 * j];
    }
    for (int t16 = c.bid; t16 < NTOK / 16; t16 += c.G) {
        const int tokb = t16 * 16, b = tokb >> 11;
        f32x4 pa[4], pb[4];
#pragma unroll
        for (int j = 0; j < 4; ++j) { const int col = 256 * j + 4 * c.lane;
            const f32x4 w4 = *(const f32x4*)(nw + col), sc = *(const f32x4*)(mod + (size_t)b * NMOD + 4096 + col); pb[j] = *(const f32x4*)(mod + (size_t)b * NMOD + 3072 + col); pa[j] = w4 * (sc + 1.0f); }
#pragma unroll
        for (int q = 0; q < 2; ++q) {
            const int tl = 2 * w + q, tok = tokb + tl;
            f32x4 v[4]; float ss = 0.f;
#pragma unroll
            for (int j = 0; j < 4; ++j) { v[j] = xn[q][j]; ss += (v[j][0] * v[j][0] + v[j][1] * v[j][1]) + (v[j][2] * v[j][2] + v[j][3] * v[j][3]); }
            const float rstd = rsqf_(wave_sum(ss, c.lane) * (1.0f / DM) + EPS);
#pragma unroll
            for (int j = 0; j < 4; ++j) {
                const int col = 256 * j + 4 * c.lane;
                const f32x4 h = (v[j] * rstd) * pa[j] + pb[j];
                u32x2 o; o.x = pk2(h[0], h[1]); o.y = pk2(h[2], h[3]);
                *(u32x2*)(H + (size_t)tok * DM + col) = o;
                *(LAS f32x4*)(HS + tl * HSTR + col) = h;
            }
        }
        if (t16 + c.G < NTOK / 16) {
#pragma unroll
            for (int q = 0; q < 2; ++q)
#pragma unroll
                for (int j = 0; j < 4; ++j) xn[q][j] = ((const f32x4*)(xin + (size_t)((t16 + c.G) * 16 + 2 * w + q) * DM) + c.lane)[64 * j];
        }
        LDS_BARRIER();
        {
            f32x4 acc[4];
#pragma unroll
            for (int n = 0; n < 4; ++n) acc[n] = (f32x4){0.f, 0.f, 0.f, 0.f};
#pragma unroll
            for (int j = 0; j < 8; ++j) {
                const int kk = 128 * w + 16 * j + 4 * fq;
                const f32x4 a4 = *(const LAS f32x4*)(HS + fr * HSTR + kk);
#pragma unroll
                for (int i = 0; i < 4; ++i)
#pragma unroll
                    for (int n = 0; n < 4; ++n) acc[n] = __builtin_amdgcn_mfma_f32_16x16x4f32(a4[i], bw[j][n][i], acc[n], 0, 0, 0);
            }
#pragma unroll
            for (int n = 0; n < 4; ++n)
#pragma unroll
                for (int r = 0; r < 4; ++r) PL[(w * 16 + 4 * fq + r) * 64 + 16 * n + fr] = acc[n][r];
        }
        LDS_BARRIER();
        for (int i = c.tid; i < 1024; i += NTHREADS) { float s2 = 0.f;
#pragma unroll
            for (int ww = 0; ww < 8; ++ww) s2 += PL[ww * 1024 + i];
            LG[i] = s2; }
        LDS_BARRIER();
#pragma unroll
        for (int q = 0; q < 2; ++q) {
            const int tl = 2 * w + q, tok = tokb + tl;
            const float s = sigmoidf_(LG[tl * 64 + c.lane]), v = s + rbias;
            float m1 = v;
            m1 = fmaxf(m1, shfl_xor_l(m1, 1, c.lane)); m1 = fmaxf(m1, shfl_xor_l(m1, 2, c.lane)); m1 = fmaxf(m1, shfl_xor_l(m1, 4, c.lane));
            const unsigned long long eq = __ballot(v == m1);
            const int gbase = c.lane & ~7;
            const unsigned gm = (unsigned)((eq >> gbase) & 0xffull);
            const int first = gbase + __builtin_ctz(gm);
            float m2 = (c.lane == first) ? -3.0e38f : v;
            m2 = fmaxf(m2, shfl_xor_l(m2, 1, c.lane)); m2 = fmaxf(m2, shfl_xor_l(m2, 2, c.lane)); m2 = fmaxf(m2, shfl_xor_l(m2, 4, c.lane));
            const float gs = m1 + m2;
            const int mygrp = c.lane >> 3; int grank = 0;
#pragma unroll
            for (int g2 = 0; g2 < 8; ++g2) { const float o = rdlane_f(gs, g2 * 8); grank += (o > gs || (o == gs && g2 < mygrp)) ? 1 : 0; }
            const float vm = (grank < 4) ? v : -1.0e4f;
            int erank = 0;
            for (int e2 = 0; e2 < 64; ++e2) { const float o = rdlane_f(vm, e2); erank += (int)(o > vm) + (int)((o == vm) & (e2 < c.lane)); }
            const bool sel = erank < TOPK;
            const unsigned long long mask = __ballot(sel);
            const float wsum = wave_sum(sel ? s : 0.f, c.lane);
            if (sel) { const int kk = __builtin_popcountll(mask & ((1ull << c.lane) - 1ull)); rw[(size_t)tok * 8 + kk] = s * rcpf_(wsum) * 2.5f; }
            if (c.lane == 0) selm[tok] = mask;
            ecount += sel ? 1 : 0;
        }
        LDS_BARRIER();
    }
    { LAS int* CW = (LAS int*)c.lds; CW[w * 64 + c.lane] = ecount; LDS_BARRIER();
      if (w == 0) { int tot = 0;
#pragma unroll
          for (int ww = 0; ww < 8; ++ww) tot += CW[ww * 64 + c.lane];
          cnt[c.bid * 64 + c.lane] = tot; }
      LDS_BARRIER(); }
}
__device__ __forceinline__ void phase_route_assign(const Params& p, const Ctx& c) {
    const unsigned long long* selm = (const unsigned long long*)(p.ws + WS_SELM); const int* cnt = (const int*)(p.ws + WS_CNT);
    int* slot_tok = (int*)(p.ws + WS_SLOTTOK); int* slot_of = (int*)(p.ws + WS_SLOTOF); int* rinfo = (int*)(p.ws + WS_RINFO);
    LAS int* PT = (LAS int*)c.lds;
    LAS int* PB = PT + 512;
    LAS int* TC = PB + 512;
    const int w = c.wave, ntile = (NTOK / 16 + c.G - 1) / c.G;
    for (int ch = c.bid; ch < c.G; ch += c.G) {
        { int tot = 0, bef = 0; const int per = (c.G + 7) / 8;
#pragma unroll 8
          for (int jj = 0; jj < per; ++jj) { const int j = w * per + jj; const int v = (j < c.G) ? cnt[j * 64 + c.lane] : 0; tot += v; bef += (j < ch) ? v : 0; }
          PT[w * 64 + c.lane] = tot; PB[w * 64 + c.lane] = bef; }
        const int t16 = ch + w * c.G; const bool have = (w < ntile) && (t16 < NTOK / 16);
        unsigned long long mine = 0ull; int tcount = 0;
        if (have) { mine = (c.lane < 16) ? selm[t16 * 16 + c.lane] : 0ull;
            for (int i = 0; i < 16; ++i) { const unsigned long long m = rdlane_u64(mine, i); tcount += (int)((m >> c.lane) & 1ull); } }
        TC[w * 64 + c.lane] = tcount;
        LDS_BARRIER();
        int total = 0, before = 0;
#pragma unroll
        for (int ww = 0; ww < 8; ++ww) { total += PT[ww * 64 + c.lane]; before += PB[ww * 64 + c.lane]; }
        const int pad = (total + 255) & ~255;
        int incl = pad;
#pragma unroll
        for (int o = 1; o < 64; o <<= 1) { const int t = shfl_up_l(incl, o, c.lane); if (c.lane >= o) incl += t; }
        const int pstart = incl - pad;
        if (have) {
            int run = pstart + before;
            for (int ww = 0; ww < w; ++ww) run += TC[ww * 64 + c.lane];
            for (int i = 0; i < 16; ++i) {
                const unsigned long long m = rdlane_u64(mine, i); const int tok = t16 * 16 + i;
                if ((m >> c.lane) & 1ull) { const int kk = __builtin_popcountll(m & ((1ull << c.lane) - 1ull)); slot_tok[run] = tok; slot_of[tok * 8 + kk] = run; ++run; }
            }
        }
        if (ch == 0 && w == 7) {
            for (int s2 = pstart + total; s2 < pstart + pad; ++s2) slot_tok[s2] = -1;
            for (int bk = pstart >> 8; bk < (pstart + pad) >> 8; ++bk) rinfo[64 + bk] = c.lane;
            if (c.lane == 63) rinfo[0] = incl >> 8;
        }
        LDS_BARRIER();
    }
}
__device__ __forceinline__ void phase_combine(const Params& p, const Ctx& c, int l) {
    const float* gate = (const float*)(p.ws + WS_MOD) + (size_t)l * 8 * NMOD + 5120;
    const unsigned char* Y = (const unsigned char*)(p.ws + WS_Y); const unsigned char* YS = (const unsigned char*)(p.ws + WS_YSH); const int* slot_of = (const int*)(p.ws + WS_SLOTOF); const float* rw = (const float*)(p.ws + WS_RW);
    const float* fw = p.in[I_FNW];
    if (l + 1 < NLAYER) load_wdt(p, c, l + 1, (LAS float*)c.lds);
    const int gw = c.bid * NWAVES + c.wave, NGW = c.G * NWAVES;
    int sln[8]; float wkn[8];
#pragma unroll
    for (int k = 0; k < 8; ++k) { sln[k] = (gw < NTOK) ? slot_of[gw * 8 + k] : 0; wkn[k] = (gw < NTOK) ? rw[gw * 8 + k] : 0.f; }
    for (int tok = gw; tok < NTOK; tok += NGW) {
        const int b = tok >> 11;
        f32x4 acc[4], gvv[4], xv0[4];
        f32x4* xr = (f32x4*)(p.out + (size_t)tok * DM) + c.lane;
        int slc[8]; float wkc[8];
#pragma unroll
        for (int k = 0; k < 8; ++k) { slc[k] = sln[k]; wkc[k] = wkn[k] * Y8_INV; }
#pragma unroll
        for (int j = 0; j < 4; ++j) { acc[j] = (f32x4){0.f, 0.f, 0.f, 0.f}; gvv[j] = *(const f32x4*)(gate + (size_t)b * NMOD + 256 * j + 4 * c.lane); xv0[j] = xr[64 * j]; }
        int yraw[8][4];
#pragma unroll
        for (int k = 0; k < 8; ++k)
#pragma unroll
            for (int j = 0; j < 4; ++j) yraw[k][j] = (int)*(const unsigned*)(Y + (size_t)slc[k] * DM + 256 * j + 4 * c.lane);
        if (tok + NGW < NTOK) {
#pragma unroll
            for (int k = 0; k < 8; ++k) { sln[k] = slot_of[(tok + NGW) * 8 + k]; wkn[k] = rw[(tok + NGW) * 8 + k]; } }
#pragma unroll
        for (int k = 0; k < 8; ++k) { const float wk = wkc[k];
#pragma unroll
            for (int j = 0; j < 4; ++j) { const int yw = yraw[k][j];
                const f32x2 y01 = __builtin_amdgcn_cvt_pk_f32_fp8(yw, false), y23 = __builtin_amdgcn_cvt_pk_f32_fp8(yw, true);
                acc[j][0] += wk * y01[0]; acc[j][1] += wk * y01[1]; acc[j][2] += wk * y23[0]; acc[j][3] += wk * y23[1]; } }
#pragma unroll
        for (int j = 0; j < 4; ++j) { const int yw = (int)*(const unsigned*)(YS + (size_t)tok * DM + 256 * j + 4 * c.lane);
            const f32x2 y01 = __builtin_amdgcn_cvt_pk_f32_fp8(yw, false), y23 = __builtin_amdgcn_cvt_pk_f32_fp8(yw, true);
            acc[j][0] += Y8_INV * y01[0]; acc[j][1] += Y8_INV * y01[1]; acc[j][2] += Y8_INV * y23[0]; acc[j][3] += Y8_INV * y23[1]; }
        f32x4 v[4]; float ss = 0.f;
#pragma unroll
        for (int j = 0; j < 4; ++j) { v[j] = xv0[j] + gvv[j] * acc[j];
            ss += (v[j][0] * v[j][0] + v[j][1] * v[j][1]) + (v[j][2] * v[j][2] + v[j][3] * v[j][3]); }
        if (l == NLAYER - 1) {
            const float rstd = rsqf_(wave_sum(ss, c.lane) * (1.0f / DM) + EPS);
#pragma unroll
            for (int j = 0; j < 4; ++j) { const f32x4 w4 = *(const f32x4*)(fw + 256 * j + 4 * c.lane); xr[64 * j] = v[j] * rstd * w4; }
        } else {
#pragma unroll
            for (int j = 0; j < 4; ++j) xr[64 * j] = v[j];
            norm_mix_row(c, v, ss, tok, p.in[I_NMIX] + (size_t)(l + 1) * DM, (const float*)(p.ws + WS_MOD) + (size_t)(l + 1) * 8 * NMOD, (const LAS float*)c.lds, (bf16_t*)(p.ws + WS_H), (float*)(p.ws + WS_DTRAW));
        }
    }
}


#define XB_TMO      128
#define XB_XCNT(j)  (256  + 64 * (j))
#define XB_XSUB(j)  (1280 + 64 * (j))
#define XB_XGEN(j)  (2304 + 64 * (j))
#define XB_TOP      3328
#define XB_TOPGEN   3392
#define XCD_BAR_WORDS 3456
#define XB_SPIN_CAP (1u << 18)
constexpr int LDS_XBST = LDS_PTAB + 320;
__device__ __forceinline__ unsigned xb_ld(unsigned* p)              { return __hip_atomic_load(p, __ATOMIC_RELAXED, __HIP_MEMORY_SCOPE_AGENT); }
__device__ __forceinline__ unsigned xb_add(unsigned* p, unsigned v) { return __hip_atomic_fetch_add(p, v, __ATOMIC_RELAXED, __HIP_MEMORY_SCOPE_AGENT); }
__device__ __forceinline__ unsigned xb_xcc_id() { return (unsigned)__builtin_amdgcn_s_getreg((3 << 11) | 20) & 0xFu; }
#define XB_SPIN(cond, bar) do { unsigned _sp = 0; while (cond) { __builtin_amdgcn_s_sleep(1); \
    if ((++_sp & 255u) == 0u) { if (xb_ld(&(bar)[XB_TMO])) break; if (_sp > XB_SPIN_CAP) { atomicAdd(&(bar)[XB_TMO], 1u); break; } } } } while (0)
__device__ __forceinline__ void xcd_barrier_complete(unsigned* bar, unsigned x, unsigned& nloc, unsigned& nx) {
    const unsigned G = gridDim.x * gridDim.y * gridDim.z;
    unsigned sum, cnt, mine, sp = 0u;
    for (;;) {
        sum = 0u; cnt = 0u; mine = 0u;
#pragma unroll
        for (unsigned j = 0; j < 16; ++j) { const unsigned c = xb_ld(&bar[XB_XCNT(j)]); sum += c; cnt += (c > 0u) ? 1u : 0u; mine = (j == x) ? c : mine; }
        if (sum == G) break;
        __builtin_amdgcn_s_sleep(1);
        if ((++sp & 255u) == 0u) { if (xb_ld(&bar[XB_TMO])) break; if (sp > XB_SPIN_CAP) { atomicAdd(&bar[XB_TMO], 1u); break; } }
    }
    nloc = mine > 0u ? mine : 1u; nx = cnt > 0u ? cnt : 1u;
}
__device__ __forceinline__ void xcd_barrier(unsigned* bar, volatile LAS unsigned* st, bool leader_thread) {
    asm volatile("s_waitcnt vmcnt(0)" ::: "memory");
    __syncthreads();
    if (leader_thread) {
        const unsigned x = xb_xcc_id();
        __builtin_amdgcn_s_waitcnt(0);
        unsigned nloc = st[0], nx = st[1];
        if (nloc == 0u) { xcd_barrier_complete(bar, x, nloc, nx); st[0] = nloc; st[1] = nx; }
        const unsigned old = xb_add(&bar[XB_XSUB(x)], 1u);
        const unsigned gen = old / nloc;
        if (old + 1u == (gen + 1u) * nloc) {
            __builtin_amdgcn_fence(__ATOMIC_RELEASE, "agent");
            asm volatile("s_waitcnt vmcnt(0)" ::: "memory");
            const unsigned og = xb_add(&bar[XB_TOP], 1u);
            const unsigned tg = og / nx;
            if (og + 1u == (tg + 1u) * nx) xb_add(&bar[XB_TOPGEN], 1u);
            else XB_SPIN(xb_ld(&bar[XB_TOPGEN]) == tg, bar);
            __builtin_amdgcn_fence(__ATOMIC_ACQUIRE, "agent");
            xb_add(&bar[XB_XGEN(x)], 1u);
            asm volatile("s_waitcnt vmcnt(0)" ::: "memory");
        } else {
            XB_SPIN(xb_ld(&bar[XB_XGEN(x)]) == gen, bar);
            __builtin_amdgcn_fence(__ATOMIC_ACQUIRE, "agent");
            asm volatile("s_waitcnt vmcnt(0)" ::: "memory");
        }
    }
    __syncthreads();
}

#ifndef PROBE_ID
#define PROBE_ID 0
#endif
#define RUN(id, stmt) do { stmt; if constexpr (PROBE_ID == (id)) { __syncthreads(); stmt; } } while (0)
constexpr int NQ_PHASE = 14;
__device__ __forceinline__ unsigned long long uni64(unsigned long long v) {
    const unsigned lo = (unsigned)__builtin_amdgcn_readfirstlane((int)(unsigned)v), hi = (unsigned)__builtin_amdgcn_readfirstlane((int)(unsigned)(v >> 32)); return ((unsigned long long)hi << 32) | lo; }
#if MK_MEGA
__device__ __forceinline__ void params_to_lds(const Params& p, LAS unsigned char* lds) {
    LAS unsigned long long* tab = (LAS unsigned long long*)(lds + LDS_PTAB);
#pragma unroll
    for (int i = 0; i < 33; ++i) tab[i] = (unsigned long long)p.in[i];
    tab[33] = (unsigned long long)p.out; tab[34] = (unsigned long long)p.ws;
}
__device__ __forceinline__ Params params_from_lds(LAS unsigned char* lds) {
    const LAS unsigned long long* tab = (const LAS unsigned long long*)(lds + LDS_PTAB);
    Params p;
#pragma unroll
    for (int i = 0; i < 33; ++i) p.in[i] = (const float*)(const __attribute__((address_space(1))) float*)uni64(tab[i]);
    p.out = (float*)(__attribute__((address_space(1))) float*)uni64(tab[33]); p.ws = (unsigned char*)(__attribute__((address_space(1))) unsigned char*)uni64(tab[34]); p.layer = 0; p.pad = 0;
    return p;
}
#endif
template <int Q> __device__ __forceinline__ void run_q(const Params& p_in, const Ctx& c_in, int l) {
    Ctx c = c_in;
    asm volatile("" : "+s"(c.wave), "+s"(c.bid), "+s"(c.G), "+s"(l));
    c.lane = fresh_lane(); c.tid = c.wave * 64 + c.lane;
#if MK_MEGA
    const Params p = params_from_lds(c.lds);
#else
    const Params& p = p_in;
#endif
    const float* xin = (l == 0) ? p.in[I_X] : p.out;
    if constexpr (Q == 14) { RUN(1, phase_prep_io(p, c); __syncthreads(); phase_prep_small(p, c)); __syncthreads(); RUN(2, phase_prep_experts(p, c, 0)); }
    if constexpr (Q == 0) { RUN(3, phase_norm_mix(p, c, l, xin)); }
    if constexpr (Q == 1) { pg8::Gemm g{(const bf16_t*)(p.ws + WS_H), (const bf16_t*)(p.ws + WS_WIN) + (size_t)l * NU * DM, DM, 0};
              pg8::DenseOrder S; S.init(NTOK, NU, c.G, c.bid); EpiU E{(bf16_t*)(p.ws + WS_U), NU};
              RUN(4, (pg8::gemm_phase<EpiU, pg8::DenseOrder, pg8::DenseRows, true, true>(c.lds, g, S, E, pg8::DenseRows(), c.wave))); }
    if constexpr (Q == 2) { RUN(5, phase_ssd_conv(p, c, l)); __syncthreads(); RUN(6, phase_hg_state(p, c, l)); __syncthreads(); RUN(7, phase_lru1(p, c, l)); }
    if constexpr (Q == 3) { RUN(8, phase_ssd_state(p, c)); __syncthreads(); phase_hg_scan(p, c); __syncthreads(); RUN(9, phase_lru2(p, c, l)); }
    if constexpr (Q == 4) { phase_ssd_scan(p, c); __syncthreads(); RUN(10, phase_hg_out(p, c, l)); }
    if constexpr (Q == 5) RUN(11, phase_ssd_out_g(p, c, l));
    if constexpr (Q == 7) { pg8::Gemm g{(const bf16_t*)(p.ws + WS_YCAT), (const bf16_t*)(p.ws + WS_WOUT) + (size_t)l * DM * 2048, 2048, 0};
              pg8::DenseOrder S; S.init(NTOK, DM, c.G, c.bid); EpiOut E{xin, p.out, (const float*)(p.ws + WS_MOD) + (size_t)l * 8 * NMOD + 2048};
              pg8::gemm_phase<EpiOut, pg8::DenseOrder, pg8::DenseRows, false, true>(c.lds, g, S, E, pg8::DenseRows(), c.wave);
              if constexpr (PROBE_ID == 13) { if (l == 0) { __syncthreads(); pg8::gemm_phase<EpiOut, pg8::DenseOrder, pg8::DenseRows, false, true>(c.lds, g, S, E, pg8::DenseRows(), c.wave); } } }
    if constexpr (Q == 8) RUN(14, phase_norm_router(p, c, l, p.out));
    if constexpr (Q == 9) RUN(15, phase_route_assign(p, c));
    if constexpr (Q == 11) { pg8::Gemm g{(const bf16_t*)(p.ws + WS_H), (const bf16_t*)(p.ws + WS_GU), DM, (size_t)512 * DM * 2};
               moe_build_units(c.lds, (const int*)(p.ws + WS_RINFO), 2, c.G, (c.G % 8 == 0) ? (c.bid % 8) * (c.G / 8) + c.bid / 8 : c.bid, c.tid);
               MoeOrder S{(const LAS int*)(c.lds + LDS_UTAB)}; EpiH E{(bf16_t*)(p.ws + WS_HMID)};
               GatherRows AM{(const int*)(p.ws + WS_SLOTTOK), (const int*)(p.ws + WS_RINFO)};
               RUN(16, (pg8::gemm_phase<EpiH, MoeOrder, GatherRows, true, true>(c.lds, g, S, E, AM, c.wave))); }
    if constexpr (Q == 12) { pg8::Gemm g{(const bf16_t*)(p.ws + WS_HMID), (const bf16_t*)(p.ws + WS_DN), 256, (size_t)DM * 256 * 2};
               moe_build_units(c.lds, (const int*)(p.ws + WS_RINFO), 4, c.G, (c.G % 8 == 0) ? (c.bid % 8) * (c.G / 8) + c.bid / 8 : c.bid, c.tid);
               MoeOrder S{(const LAS int*)(c.lds + LDS_UTAB)};
               EpiY E{(unsigned char*)(p.ws + WS_Y), (unsigned char*)(p.ws + WS_YSH), (const int*)(p.ws + WS_RINFO)};
               RUN(17, (pg8::gemm_phase<EpiY, MoeOrder, pg8::DenseRows, true, true>(c.lds, g, S, E, pg8::DenseRows(), c.wave))); }
    if constexpr (Q == 13) { phase_combine(p, c, l); if (l + 1 < NLAYER) { __syncthreads(); RUN(2, phase_prep_experts(p, c, l + 1)); } }
}

#if MK_MEGA
__global__ void __launch_bounds__(NTHREADS, 2) trunk_kernel(Params p) {
    extern __shared__ __attribute__((aligned(16))) unsigned char lds_raw[];
    Ctx c; c.lds = (LAS unsigned char*)lds_raw; c.tid = 0; c.lane = 0; c.wave = __builtin_amdgcn_readfirstlane(threadIdx.x >> 6); c.G = gridDim.x; c.bid = blockIdx.x;
    cg::grid_group grid = cg::this_grid();
    unsigned* const xbar = (unsigned*)(p.ws + WS_CTL) + 4096;
    if (threadIdx.x == 0) { params_to_lds(p, c.lds); ((LAS unsigned*)(c.lds + LDS_XBST))[0] = 0u; ((LAS unsigned*)(c.lds + LDS_XBST))[1] = 0u; ((LAS unsigned long long*)(c.lds + LDS_PTAB))[35] = (unsigned long long)xbar;
                            (void)xb_add(&xbar[XB_XCNT(xb_xcc_id())], 1u); }
    __syncthreads();
#define GSYNC1() do { unsigned* bar_ = (unsigned*)(__attribute__((address_space(1))) unsigned*)uni64(((const LAS unsigned long long*)(c.lds + LDS_PTAB))[35]); \
        xcd_barrier(bar_, (volatile LAS unsigned*)(c.lds + LDS_XBST), (c.wave == 0) && (fresh_lane() == 0)); } while (0)
#define GSYNC() do { GSYNC1(); if constexpr (PROBE_ID == 18) GSYNC1(); } while (0)
#define LAYER(l) do { \
        if ((l) == 0) { run_q<0>(p, c, l); GSYNC(); } run_q<1>(p, c, l); GSYNC(); run_q<2>(p, c, l); GSYNC(); run_q<3>(p, c, l); GSYNC(); run_q<4>(p, c, l); GSYNC(); \
        run_q<5>(p, c, l); GSYNC(); run_q<7>(p, c, l); GSYNC(); run_q<8>(p, c, l); GSYNC(); run_q<9>(p, c, l); GSYNC(); \
        run_q<11>(p, c, l); GSYNC(); run_q<12>(p, c, l); GSYNC(); run_q<13>(p, c, l); } while (0)
    run_q<14>(p, c, 0); __syncthreads(); grid.sync();
    LAYER(0); GSYNC();
    LAYER(1);
}
#else
template <int Q> __global__ void __launch_bounds__(NTHREADS, 2) phase_kernel(Params p) {
    extern __shared__ __attribute__((aligned(16))) unsigned char lds_raw[];
    Ctx c; c.lds = (LAS unsigned char*)lds_raw; c.tid = 0; c.lane = 0; c.wave = __builtin_amdgcn_readfirstlane(threadIdx.x >> 6); c.G = gridDim.x; c.bid = blockIdx.x;
    run_q<Q>(p, c, p.layer);
}
template <int Q> static void launch_q(const Params& p, int grid, hipStream_t stream) {
    static bool attr = false;
    if (!attr) { (void)hipFuncSetAttribute((const void*)phase_kernel<Q>, hipFuncAttributeMaxDynamicSharedMemorySize, LDS_BYTES); attr = true; }
    hipLaunchKernelGGL(phase_kernel<Q>, dim3(grid), dim3(NTHREADS), LDS_BYTES, stream, p);
}
#endif

extern "C" void kernel_launch(void* const* d_in, const int* in_sizes, int n_in, void* d_out, int out_size, void* d_ws, size_t ws_size, hipStream_t stream) {
    static int grid = 0;
    if (grid == 0) {
        if (n_in != 33 || out_size != NTOK * DM || ws_size < WS_END) { fprintf(stderr, "kernel_launch: unexpected shapes (n_in %d out %d ws %zu)\n", n_in, out_size, ws_size); grid = -1; return; }
        int dev = 0, cus = 0;
        (void)hipGetDevice(&dev); (void)hipDeviceGetAttribute(&cus, hipDeviceAttributeMultiprocessorCount, dev);
        grid = cus > 0 ? cus : 256;
#if MK_MEGA
        int per_cu = 0;
        if (hipFuncSetAttribute((const void*)trunk_kernel, hipFuncAttributeMaxDynamicSharedMemorySize, LDS_BYTES) != hipSuccess) { fprintf(stderr, "kernel_launch: hipFuncSetAttribute failed\n"); grid = -1; return; }
        if (hipOccupancyMaxActiveBlocksPerMultiprocessor(&per_cu, (const void*)trunk_kernel, NTHREADS, LDS_BYTES) != hipSuccess || per_cu < 1) { fprintf(stderr, "kernel_launch: occupancy query says %d blocks/CU\n", per_cu); grid = -1; return; }
        (void)hipGetLastError();
#endif
    }
    if (grid < 0) return;
    (void)hipMemsetAsync((char*)d_ws + WS_CTL, 0, CTL_ZERO_BYTES, stream);
    Params p{};
    for (int i = 0; i < 33; ++i) p.in[i] = (const float*)d_in[i];
    p.out = (float*)d_out; p.ws = (unsigned char*)d_ws;
#if MK_MEGA
    void* args[] = {&p};
    hipError_t e = hipLaunchCooperativeKernel((const void*)trunk_kernel, dim3(grid), dim3(NTHREADS), args, LDS_BYTES, stream);
    if (e != hipSuccess) fprintf(stderr, "cooperative launch failed: %s (grid %d)\n", hipGetErrorString(e), grid);
#else
    p.layer = 0; launch_q<14>(p, grid, stream);
    for (int l = 0; l < NLAYER; ++l) {
        p.layer = l;
        launch_q<0>(p, grid, stream); launch_q<1>(p, grid, stream); launch_q<2>(p, grid, stream); launch_q<3>(p, grid, stream); launch_q<4>(p, grid, stream);
        launch_q<5>(p, grid, stream); launch_q<6>(p, grid, stream); launch_q<7>(p, grid, stream); launch_q<8>(p, grid, stream); launch_q<9>(p, grid, stream);
        launch_q<10>(p, grid, stream); launch_q<11>(p, grid, stream); launch_q<12>(p, grid, stream); launch_q<13>(p, grid, stream);
    }
#endif
}
```

```cpp
#include <hip/hip_runtime.h>
#include <hip/hip_cooperative_groups.h>
#include <cstdio>
#include <cstdint>
namespace cg = cooperative_groups;

#ifndef MK_MEGA
#define MK_MEGA 1
#endif

#define LAS __attribute__((address_space(3)))
typedef unsigned short bf16_t;
typedef short bf16x8 __attribute__((ext_vector_type(8)));
typedef float f32x4 __attribute__((ext_vector_type(4)));
typedef float f32x2 __attribute__((ext_vector_type(2)));
typedef unsigned u32x4 __attribute__((ext_vector_type(4)));
typedef unsigned u32x2 __attribute__((ext_vector_type(2)));

constexpr int NTOK = 16384, DM = 1024, SEQ = 2048, NBATCH = 8, NLAYER = 2;
constexpr int DIN = 5648, NU = 5632;
constexpr int UZ = 0, UXS = 1024, UB = 2048, UC = 2304, UHQ = 2560, UHF = 3072, UHV = 3584, UHG = 4096, ULG = 4608, ULX = 5120;
constexpr int NMOD = 6144;
constexpr float EPS = 1e-6f;
constexpr int NEXP = 64, TOPK = 8;
constexpr int MAXSLOT = 147456;
constexpr int NTHREADS = 512, NWAVES = 8;
constexpr int LDS_BYTES = 160 * 1024;
constexpr int LDS_PTAB = LDS_BYTES - 512;

constexpr size_t MiB = (size_t)1 << 20;
constexpr size_t WS_CTL = 0, CTL_ZERO_BYTES = 1 * MiB;
constexpr size_t WS_MOD = 1 * MiB;
constexpr size_t WS_LB = WS_MOD + 512 * 1024;
constexpr size_t WS_LRUW = WS_LB + 8192;
constexpr size_t WS_DTRAW = 2 * MiB, WS_DT = 3 * MiB, WS_ACUM = 4 * MiB;
constexpr size_t WS_HGBL = 5 * MiB;
constexpr size_t WS_SELM = 5 * MiB + 512 * 1024;
constexpr size_t WS_RW = 6 * MiB;
constexpr size_t WS_SLOTOF = 6 * MiB + 512 * 1024;
constexpr size_t WS_SLOTTOK = 7 * MiB;
constexpr size_t WS_RINFO = 7 * MiB + 768 * 1024;
constexpr size_t WS_CNT = 8 * MiB;
constexpr size_t WS_WRT = 9 * MiB;
constexpr size_t WS_WIN = 12 * MiB;
constexpr size_t WS_WOUT = 34 * MiB;
constexpr size_t WS_GU = 42 * MiB;
constexpr size_t WS_DN = 107 * MiB;
constexpr size_t WS_H = 140 * MiB;
constexpr size_t WS_U = 172 * MiB;
constexpr size_t WS_SST = 348 * MiB;
constexpr size_t WS_HST = 380 * MiB;
constexpr size_t WS_LA = 412 * MiB, WS_LH = 428 * MiB;
constexpr size_t WS_XBC = 444 * MiB;
constexpr size_t WS_YCAT = 492 * MiB;
constexpr size_t WS_HMID = 172 * MiB;
constexpr size_t WS_Y = 252 * MiB;
constexpr size_t WS_YSH = WS_Y + 160 * MiB;
constexpr size_t WS_END = 556 * MiB;

__device__ __forceinline__ float bf2f(bf16_t b) { return __uint_as_float(((unsigned)b) << 16); }
typedef __bf16 bf16x2_hw __attribute__((ext_vector_type(2)));
__device__ __forceinline__ unsigned pk2(float lo, float hi) { f32x2 v = {lo, hi}; bf16x2_hw b = __builtin_convertvector(v, bf16x2_hw); return __builtin_bit_cast(unsigned, b); }
__device__ __forceinline__ unsigned f2bf(float f) { return pk2(f, 0.f) & 0xffffu; }
constexpr float Y8_SCALE = 16.0f, Y8_INV = 1.0f / 16.0f;
__device__ __forceinline__ unsigned pk4_fp8(float a, float b, float c2, float d) { int w = 0; w = __builtin_amdgcn_cvt_pk_fp8_f32(a, b, w, false); w = __builtin_amdgcn_cvt_pk_fp8_f32(c2, d, w, true); return (unsigned)w; }
__device__ __forceinline__ float lo_bf(unsigned w) { return __uint_as_float(w << 16); }
__device__ __forceinline__ float hi_bf(unsigned w) { return __uint_as_float(w & 0xffff0000u); }
__device__ __forceinline__ float rcpf_(float x) { return __builtin_amdgcn_rcpf(x); }
__device__ __forceinline__ float rsqf_(float x) { return __builtin_amdgcn_rsqf(x); }
__device__ __forceinline__ float sigmoidf_(float x) { return rcpf_(1.0f + __expf(-x)); }
__device__ __forceinline__ float siluf_(float x) { return x * rcpf_(1.0f + __expf(-x)); }
__device__ __forceinline__ float softplusf_(float x) { return fmaxf(x, 0.f) + log1pf(__expf(-fabsf(x))); }
__device__ __forceinline__ float gelu_tanhf_(float x) { const float u = 0.7978845608028654f * (x + 0.044715f * x * x * x); const float t = 1.0f - 2.0f * rcpf_(1.0f + __expf(2.0f * u)); return 0.5f * x * (1.0f + t); }
__device__ __forceinline__ float shfl_xor_l(float v, int mask, int lane) { return __builtin_bit_cast(float, __builtin_amdgcn_ds_bpermute((lane ^ mask) << 2, __builtin_bit_cast(int, v))); }
__device__ __forceinline__ int shfl_up_l(int v, int d, int lane) { return __builtin_amdgcn_ds_bpermute((lane - d) << 2, v); }
__device__ __forceinline__ float shfl_up_f(float v, int d, int lane) { return __builtin_bit_cast(float, __builtin_amdgcn_ds_bpermute((lane - d) << 2, __builtin_bit_cast(int, v))); }
__device__ __forceinline__ float rdlane_f(float v, int src) { return __builtin_bit_cast(float, __builtin_amdgcn_readlane(__builtin_bit_cast(int, v), src)); }
__device__ __forceinline__ unsigned long long rdlane_u64(unsigned long long v, int src) {
    const unsigned lo = (unsigned)__builtin_amdgcn_readlane((int)(unsigned)v, src), hi = (unsigned)__builtin_amdgcn_readlane((int)(unsigned)(v >> 32), src); return ((unsigned long long)hi << 32) | lo; }
__device__ __forceinline__ float wave_sum(float v, int lane) {
#pragma unroll
    for (int o = 1; o < 64; o <<= 1) v += shfl_xor_l(v, o, lane);
    return v;
}
#define LDS_WAIT() asm volatile("s_waitcnt lgkmcnt(0)" ::: "memory")
__device__ __forceinline__ int fresh_lane() { unsigned ones = ~0u; asm volatile("" : "+s"(ones)); return (int)__builtin_amdgcn_mbcnt_hi(ones, __builtin_amdgcn_mbcnt_lo(ones, 0u)); }
__device__ __forceinline__ void split_bf16(const f32x4& x0, const f32x4& x1, bf16x8& hi, bf16x8& lo) {
    u32x4 h, l2; h.x = pk2(x0[0], x0[1]); h.y = pk2(x0[2], x0[3]); h.z = pk2(x1[0], x1[1]); h.w = pk2(x1[2], x1[3]);
    l2.x = pk2(x0[0] - lo_bf(h.x), x0[1] - hi_bf(h.x)); l2.y = pk2(x0[2] - lo_bf(h.y), x0[3] - hi_bf(h.y)); l2.z = pk2(x1[0] - lo_bf(h.z), x1[1] - hi_bf(h.z)); l2.w = pk2(x1[2] - lo_bf(h.w), x1[3] - hi_bf(h.w));
    hi = __builtin_bit_cast(bf16x8, h); lo = __builtin_bit_cast(bf16x8, l2);
}
#define LDS_BARRIER() do { asm volatile("s_waitcnt lgkmcnt(0)" ::: "memory"); __builtin_amdgcn_s_barrier(); asm volatile("" ::: "memory"); } while (0)
#define MFMA16(a, b, c) __builtin_amdgcn_mfma_f32_16x16x32_bf16((a), (b), (c), 0, 0, 0)
typedef short s16x4 __attribute__((ext_vector_type(4)));
__device__ __forceinline__ bf16x8 tr_frag(const LAS bf16_t* img, int ld, int k0, int c0, int lane) {
    const int g = lane >> 4, q = (lane & 15) >> 2, pp = lane & 3;
    const LAS bf16_t* a0 = img + (k0 + 8 * g + q) * ld + c0 + 4 * pp;
    const s16x4 r0 = __builtin_amdgcn_ds_read_tr16_b64_v4i16((LAS s16x4*)a0);
    const s16x4 r1 = __builtin_amdgcn_ds_read_tr16_b64_v4i16((LAS s16x4*)(a0 + 4 * ld));
    return (bf16x8){r0[0], r0[1], r0[2], r0[3], r1[0], r1[1], r1[2], r1[3]};
}

namespace pg8 {
constexpr int BM = 256, BK = 64, HALF = 128, HTB = HALF * BK * 2, STAGE_BYTES = 8 * HTB, NXCD = 8, WGM = 8;
__device__ __forceinline__ int lds_byte(int r, int c) { const int st = (r >> 4) * 2 + (c >> 5), rr = r & 15, cc = c & 31, ob = rr * 64 + cc * 2; return st * 1024 + (ob ^ (((ob >> 9) & 1) << 5)); }
__device__ __forceinline__ void stage_rc(int b, int& R, int& C) { const int st = b / 1024, sb = b % 1024, swz = sb ^ (((sb >> 9) & 1) << 5); R = (st >> 1) * 16 + swz / 64; C = (st & 1) * 32 + (swz % 64) / 2; }
__device__ __forceinline__ int perm32(int rho) { const int n = rho >> 4, i = rho & 15; return 8 * (i >> 2) + 4 * n + (i & 3); }

struct Unit { int pm, pn, e; };
struct Gemm { const bf16_t* A; const bf16_t* Bt; int K; size_t estride; };

struct DenseOrder {
    int nM, nN, nwg, G, c;
    __device__ void init(int M, int N, int G_, int c_) { nM = M / BM; nN = N / BM; nwg = nM * nN; G = G_; c = c_; }
    __device__ bool next(int i, Unit& u) const {
        const long L = (long)i * G + c; if (L >= nwg) return false;
        int wgid = (int)L; { const int q = nwg / NXCD, r = nwg % NXCD, xcd = wgid % NXCD, off = wgid / NXCD; wgid = (xcd < r ? xcd * (q + 1) : r * (q + 1) + (xcd - r) * q) + off; }
        const int nig = WGM * nN, gid = wgid / nig, fm = gid * WGM, gsz = (nM - fm) < WGM ? (nM - fm) : WGM;
        u.pm = fm + ((wgid % nig) % gsz); u.pn = (wgid % nig) / gsz; u.e = 0; return true;
    }
};
struct DenseRows { __device__ __forceinline__ int row(const Unit& u, int r) const { return u.pm * BM + r; } };

template <class Epi, class Sched, class AMap, bool ALIGN_EPI, bool SP2>
__device__ __forceinline__ void gemm_phase(LAS unsigned char* lds, const Gemm g, const Sched& S, const Epi& E, const AMap& AM, int wave_id) {
    const int wid = wave_id, lane = fresh_lane(), tid = wid * 64 + lane, wr = wid >> 2, wc = wid & 3, fr = lane & 15, fq = lane >> 4;
    const int K = g.K, nt = K / BK;
    unsigned voffB0;
    { int R, C; stage_rc(tid * 16, R, C); const int Rb = Epi::PERM ? ((R & ~31) + perm32(R & 31)) : R; voffB0 = (unsigned)(Rb * K + C) * 2u; }
    const size_t p1step = (size_t)64 * K * 2;
    const size_t kstep = (size_t)(BK * 2);
    const size_t hstep = (size_t)HALF * K * 2;
    const size_t tstep = 2 * hstep;
    const unsigned ldsw = (unsigned)wid * 1024u;
    const int aoff = lds_byte(wr * 64 + fr, fq * 8), boff = lds_byte(wc * 32 + fr, fq * 8);
#define PG8_SA(b, h) (((b) * 2 + (h)) * HTB)
#define PG8_SB(b, h) ((4 + (b) * 2 + (h)) * HTB)
#define PG8_STAGE2(bufoff, gbase, v0, v1) do { \
        __builtin_amdgcn_global_load_lds((const unsigned*)((const char*)(gbase) + (v0)), (LAS unsigned*)(lds + (bufoff) + ldsw), 16, 0, 0); \
        __builtin_amdgcn_global_load_lds((const unsigned*)((const char*)(gbase) + (v1)), (LAS unsigned*)(lds + (bufoff) + ldsw + 8192), 16, 0, 0); } while (0)
#define PG8_STAGEB(bufoff, gbase) do { \
        __builtin_amdgcn_global_load_lds((const unsigned*)((const char*)(gbase) + voffB0), (LAS unsigned*)(lds + (bufoff) + ldsw), 16, 0, 0); \
        __builtin_amdgcn_global_load_lds((const unsigned*)((const char*)(gbase) + p1step + voffB0), (LAS unsigned*)(lds + (bufoff) + ldsw + 8192), 16, 0, 0); } while (0)
#define PG8_LDA(dst, b, h) do { _Pragma("unroll") for (int m = 0; m < 4; ++m) _Pragma("unroll") for (int k = 0; k < 2; ++k) dst[m][k] = *(const LAS bf16x8*)(lds + PG8_SA(b, h) + aoff + m * 2048 + k * 1024); } while (0)
#define PG8_LDB(dst, b, h) do { _Pragma("unroll") for (int n = 0; n < 2; ++n) _Pragma("unroll") for (int k = 0; k < 2; ++k) dst[n][k] = *(const LAS bf16x8*)(lds + PG8_SB(b, h) + boff + n * 2048 + k * 1024); } while (0)
#define PG8_MMA(ai, bj, At, Bt) do { __builtin_amdgcn_s_setprio(1); _Pragma("unroll") for (int m = 0; m < 4; ++m) _Pragma("unroll") for (int n = 0; n < 2; ++n) _Pragma("unroll") for (int k = 0; k < 2; ++k) \
        acc[ai][bj][m][n] = __builtin_amdgcn_mfma_f32_16x16x32_bf16(Bt[n][k], At[m][k], acc[ai][bj][m][n], 0, 0, 0); __builtin_amdgcn_s_setprio(0); } while (0)
#define PG8_WAIT_V(n) asm volatile("s_waitcnt vmcnt(" #n ")" ::: "memory")
#define PG8_WAIT_L(n) asm volatile("s_waitcnt lgkmcnt(" #n ")" ::: "memory")
#define PG8_BAR __builtin_amdgcn_s_barrier()
#define PG8_SCHED __builtin_amdgcn_sched_barrier(0)
#define PG8_AOFFS(u, v00, v01, v10, v11) do { int R_, C_; stage_rc(tid * 16, R_, C_); \
        v00 = (unsigned)(AM.row(u, R_) * K + C_) * 2u; v01 = (unsigned)(AM.row(u, R_ + 64) * K + C_) * 2u; \
        v10 = (unsigned)(AM.row(u, HALF + R_) * K + C_) * 2u; v11 = (unsigned)(AM.row(u, HALF + R_ + 64) * K + C_) * 2u; } while (0)
    Unit cur, nxt; int ui = 0;
    if (!S.next(0, cur)) return;
    f32x4 acc[2][2][4][2];
#pragma unroll
    for (int a = 0; a < 2; ++a)
#pragma unroll
        for (int b = 0; b < 2; ++b)
#pragma unroll
            for (int m = 0; m < 4; ++m)
#pragma unroll
                for (int n = 0; n < 2; ++n) acc[a][b][m][n] = (f32x4){0.f, 0.f, 0.f, 0.f};
    bf16x8 At[4][2], B0[2][2], B1[2][2];
    const char* const Abase = (const char*)g.A;
    const char* cB = (const char*)g.Bt + (size_t)cur.e * g.estride + (size_t)cur.pn * tstep;
    unsigned c00, c01, c10, c11, n00, n01, n10, n11;
    PG8_AOFFS(cur, c00, c01, c10, c11);
    n00 = c00; n01 = c01; n10 = c10; n11 = c11;
    if constexpr (SP2) {
        PG8_STAGEB(PG8_SB(0, 0), cB); PG8_STAGEB(PG8_SB(0, 1), cB + hstep); PG8_STAGE2(PG8_SA(0, 0), Abase, c00, c01); PG8_STAGE2(PG8_SA(0, 1), Abase, c10, c11);
        if (wr == 1) PG8_BAR;
        PG8_WAIT_V(2); PG8_BAR;
        PG8_STAGEB(PG8_SB(1, 0), cB + kstep); PG8_STAGE2(PG8_SA(1, 0), Abase + kstep, c00, c01); PG8_STAGEB(PG8_SB(1, 1), cB + hstep + kstep);
        PG8_WAIT_V(6); PG8_BAR;
    } else {
        PG8_STAGEB(PG8_SB(0, 0), cB); PG8_STAGE2(PG8_SA(0, 0), Abase, c00, c01); PG8_STAGEB(PG8_SB(0, 1), cB + hstep); PG8_STAGE2(PG8_SA(0, 1), Abase, c10, c11);
        if (wr == 1) PG8_BAR;
        PG8_WAIT_V(4); PG8_BAR;
        PG8_STAGEB(PG8_SB(1, 0), cB + kstep); PG8_STAGE2(PG8_SA(1, 0), Abase + kstep, c00, c01); PG8_STAGEB(PG8_SB(1, 1), cB + hstep + kstep);
        PG8_WAIT_V(6); PG8_BAR;
    }
    for (;;) {
        const bool has_next = S.next(ui + 1, nxt);
        const char* nB = cB;
        if (has_next) { nB = (const char*)g.Bt + (size_t)nxt.e * g.estride + (size_t)nxt.pn * tstep; PG8_AOFFS(nxt, n00, n01, n10, n11); }
        else { n00 = c00; n01 = c01; n10 = c10; n11 = c11; }
        for (int t = 0; t < nt; t += 2) {
            const bool last = (t == nt - 2);
            const char* a1 = Abase + (size_t)(t + 1) * kstep;
            const char* a2 = last ? Abase : Abase + (size_t)(t + 2) * kstep;
            const char* b2 = last ? nB : cB + (size_t)(t + 2) * kstep;
            const char* a3 = a2 + kstep; const char* b3 = b2 + kstep;
            const unsigned x00 = last ? n00 : c00, x01 = last ? n01 : c01, x10 = last ? n10 : c10, x11 = last ? n11 : c11;
            if constexpr (SP2) {
            PG8_LDB(B0, 0, 0); PG8_LDB(B1, 0, 1); PG8_SCHED; PG8_LDA(At, 0, 0); PG8_STAGE2(PG8_SA(1, 1), a1, c10, c11);
            PG8_WAIT_V(8); PG8_WAIT_L(0); PG8_BAR; PG8_MMA(0, 0, At, B0); PG8_MMA(0, 1, At, B1); PG8_BAR; PG8_SCHED;
            PG8_LDA(At, 0, 1); PG8_STAGEB(PG8_SB(0, 0), b2); PG8_STAGEB(PG8_SB(0, 1), b2 + hstep); PG8_STAGE2(PG8_SA(0, 0), a2, x00, x01);
            PG8_WAIT_V(8); PG8_WAIT_L(0); PG8_BAR; PG8_MMA(1, 0, At, B0); PG8_MMA(1, 1, At, B1); PG8_BAR; PG8_SCHED;
            PG8_LDB(B0, 1, 0); PG8_LDB(B1, 1, 1); PG8_SCHED; PG8_LDA(At, 1, 0); PG8_STAGE2(PG8_SA(0, 1), a2, x10, x11);
            PG8_WAIT_V(8); PG8_WAIT_L(0); PG8_BAR; PG8_MMA(0, 0, At, B0); PG8_MMA(0, 1, At, B1); PG8_BAR; PG8_SCHED;
            PG8_LDA(At, 1, 1); PG8_STAGEB(PG8_SB(1, 0), b3); PG8_STAGEB(PG8_SB(1, 1), b3 + hstep); PG8_STAGE2(PG8_SA(1, 0), a3, x00, x01);
            PG8_WAIT_V(8); PG8_WAIT_L(0); PG8_BAR; PG8_MMA(1, 0, At, B0); PG8_MMA(1, 1, At, B1); PG8_BAR; PG8_SCHED;
            } else {
            PG8_LDB(B0, 0, 0); PG8_SCHED; PG8_LDA(At, 0, 0); PG8_STAGE2(PG8_SA(1, 1), a1, c10, c11);
            PG8_WAIT_L(8); PG8_BAR; PG8_WAIT_L(0); PG8_MMA(0, 0, At, B0); PG8_BAR; PG8_SCHED;
            PG8_LDB(B1, 0, 1); PG8_STAGEB(PG8_SB(0, 0), b2);
            PG8_BAR; PG8_WAIT_L(0); PG8_MMA(0, 1, At, B1); PG8_BAR;
            PG8_LDA(At, 0, 1); PG8_STAGE2(PG8_SA(0, 0), a2, x00, x01);
            PG8_BAR; PG8_WAIT_L(0); PG8_MMA(1, 0, At, B0); PG8_BAR; PG8_SCHED;
            PG8_STAGEB(PG8_SB(0, 1), b2 + hstep);
            PG8_WAIT_V(6); PG8_BAR; PG8_MMA(1, 1, At, B1); PG8_BAR;
            PG8_LDB(B0, 1, 0); PG8_SCHED; PG8_LDA(At, 1, 0); PG8_STAGE2(PG8_SA(0, 1), a2, x10, x11);
            PG8_WAIT_L(8); PG8_BAR; PG8_WAIT_L(0); PG8_MMA(0, 0, At, B0); PG8_BAR; PG8_SCHED;
            PG8_LDB(B1, 1, 1); PG8_STAGEB(PG8_SB(1, 0), b3);
            PG8_BAR; PG8_WAIT_L(0); PG8_MMA(0, 1, At, B1); PG8_BAR;
            PG8_LDA(At, 1, 1); PG8_STAGE2(PG8_SA(1, 0), a3, x00, x01);
            PG8_BAR; PG8_WAIT_L(0); PG8_MMA(1, 0, At, B0); PG8_BAR; PG8_SCHED;
            PG8_STAGEB(PG8_SB(1, 1), b3 + hstep);
            PG8_WAIT_V(6); PG8_BAR; PG8_MMA(1, 1, At, B1); PG8_BAR;
            }
        }
        if constexpr (ALIGN_EPI) { if (wr == 0) PG8_BAR; }
        E(acc, cur, wr, wc);
        if (!has_next) break;
#pragma unroll
        for (int a = 0; a < 2; ++a)
#pragma unroll
            for (int b = 0; b < 2; ++b)
#pragma unroll
                for (int m = 0; m < 4; ++m)
#pragma unroll
                    for (int n = 0; n < 2; ++n) acc[a][b][m][n] = (f32x4){0.f, 0.f, 0.f, 0.f};
        cur = nxt; cB = nB; c00 = n00; c01 = n01; c10 = n10; c11 = n11; ++ui;
        if constexpr (ALIGN_EPI) { if (wr == 1) PG8_BAR; }
    }
    PG8_WAIT_V(0);
    if constexpr (!ALIGN_EPI) { if (wr == 0) PG8_BAR; }
    PG8_BAR;
#undef PG8_SA
#undef PG8_SB
#undef PG8_STAGE2
#undef PG8_STAGEB
#undef PG8_LDA
#undef PG8_LDB
#undef PG8_MMA
#undef PG8_WAIT_V
#undef PG8_WAIT_L
#undef PG8_BAR
#undef PG8_SCHED
#undef PG8_AOFFS
}
}

struct Params {
    const float* in[33];
    float* out;
    unsigned char* ws;
    int layer, pad;
};
enum { I_X = 0, I_C, I_ADAW, I_ADAB, I_NMIX, I_NFFN, I_WIN, I_SCW, I_SCB, I_SDTB, I_SALOG, I_SD, I_SNW, I_HLB, I_HNW, I_LCW, I_LCB, I_LWA, I_LBA, I_LWX, I_LBX, I_LLAM, I_LNW,
       I_WOUT, I_RW, I_RB, I_EG, I_EU, I_ED, I_SG, I_SU, I_SDN, I_FNW };

using pg8::Unit;
struct EpiU {
    static constexpr bool PERM = true;
    bf16_t* O; int ldc;
    __device__ __forceinline__ void operator()(const f32x4 (&acc)[2][2][4][2], const Unit& u, int wr, int wc) const {
        const int lane_ = fresh_lane(), fr = lane_ & 15, fq = lane_ >> 4;
        const int row0 = u.pm * 256 + wr * 64 + fr, col0 = u.pn * 256 + wc * 32 + 8 * fq;
#pragma unroll
        for (int ai = 0; ai < 2; ++ai)
#pragma unroll
            for (int m = 0; m < 4; ++m) { bf16_t* rowp = O + (size_t)(row0 + ai * 128 + m * 16) * ldc + col0;
#pragma unroll
                for (int bj = 0; bj < 2; ++bj) { const f32x4 v0 = acc[ai][bj][m][0], v1 = acc[ai][bj][m][1];
                    u32x4 w; w.x = pk2(v0[0], v0[1]); w.y = pk2(v0[2], v0[3]); w.z = pk2(v1[0], v1[1]); w.w = pk2(v1[2], v1[3]);
                    *(u32x4*)(rowp + bj * 128) = w; } }
    }
};
struct EpiOut {
    static constexpr bool PERM = false;
    const float* xin; float* xout; const float* gate;
    __device__ __forceinline__ void operator()(const f32x4 (&acc)[2][2][4][2], const Unit& u, int wr, int wc) const {
        const int lane_ = fresh_lane(), fr = lane_ & 15, fq = lane_ >> 4;
        const int row0 = u.pm * 256 + wr * 64 + fr, col0 = u.pn * 256 + wc * 32 + 4 * fq, b = u.pm >> 3;
        f32x4 gv[2][2];
#pragma unroll
        for (int bj = 0; bj < 2; ++bj)
#pragma unroll
            for (int n = 0; n < 2; ++n) gv[bj][n] = *(const f32x4*)(gate + (size_t)b * NMOD + col0 + bj * 128 + n * 16);
#pragma unroll
        for (int ai = 0; ai < 2; ++ai)
#pragma unroll
            for (int m = 0; m < 4; ++m) { const size_t off = (size_t)(row0 + ai * 128 + m * 16) * DM + col0;
#pragma unroll
                for (int bj = 0; bj < 2; ++bj)
#pragma unroll
                    for (int n = 0; n < 2; ++n) { const f32x4 xi = *(const f32x4*)(xin + off + bj * 128 + n * 16);
                        *(f32x4*)(xout + off + bj * 128 + n * 16) = xi + gv[bj][n] * acc[ai][bj][m][n]; }
                asm volatile("" ::: "memory"); }
    }
};
struct EpiH {
    static constexpr bool PERM = true;
    bf16_t* Hm;
    __device__ __forceinline__ void operator()(const f32x4 (&acc)[2][2][4][2], const Unit& u, int wr, int wc) const {
        const int lane_ = fresh_lane(), fr = lane_ & 15, fq = lane_ >> 4;
        const int row0 = u.pm * 256 + wr * 64 + fr, col0 = u.pn * 128 + wc * 32 + 8 * fq;
#pragma unroll
        for (int ai = 0; ai < 2; ++ai)
#pragma unroll
            for (int m = 0; m < 4; ++m) { bf16_t* rowp = Hm + (size_t)(row0 + ai * 128 + m * 16) * 256 + col0;
                f32x4 h0, h1;
#pragma unroll
                for (int j = 0; j < 4; ++j) { h0[j] = siluf_(acc[ai][0][m][0][j]) * acc[ai][1][m][0][j]; h1[j] = siluf_(acc[ai][0][m][1][j]) * acc[ai][1][m][1][j]; }
                u32x4 w; w.x = pk2(h0[0], h0[1]); w.y = pk2(h0[2], h0[3]); w.z = pk2(h1[0], h1[1]); w.w = pk2(h1[2], h1[3]);
                *(u32x4*)rowp = w; }
    }
};
struct EpiY {
    static constexpr bool PERM = true;
    unsigned char* Y; unsigned char* Ysh; const int* rinfo;
    __device__ __forceinline__ void operator()(const f32x4 (&acc)[2][2][4][2], const Unit& u, int wr, int wc) const {
        const int lane_ = fresh_lane(), fr = lane_ & 15, fq = lane_ >> 4;
        const int col0 = u.pn * 256 + wc * 32 + 8 * fq;
        unsigned char* base = Y + (size_t)u.pm * 256 * DM;
        if (u.e >= NEXP) base = Ysh + (size_t)(u.pm - rinfo[0]) * 256 * DM;
        base += (size_t)(wr * 64 + fr) * DM + col0;
#pragma unroll
        for (int ai = 0; ai < 2; ++ai)
#pragma unroll
            for (int m = 0; m < 4; ++m) { unsigned char* rowp = base + (size_t)(ai * 128 + m * 16) * DM;
#pragma unroll
                for (int bj = 0; bj < 2; ++bj) { const f32x4 v0 = acc[ai][bj][m][0] * Y8_SCALE, v1 = acc[ai][bj][m][1] * Y8_SCALE;
                    u32x2 w; w.x = pk4_fp8(v0[0], v0[1], v0[2], v0[3]); w.y = pk4_fp8(v1[0], v1[1], v1[2], v1[3]);
                    *(u32x2*)(rowp + bj * 128) = w; } }
    }
};
constexpr int LDS_UTAB = 131072, MAX_UNITS = 24;
__device__ __forceinline__ void moe_build_units(LAS unsigned char* lds, const int* rinfo, int NQ, int G, int cidx, int tid) {
    LAS int* tab = (LAS int*)(lds + LDS_UTAB);
    if (tid < MAX_UNITS) {
        const int nblk = rinfo[0]; const long L = (long)tid * G + cidx;
        int pm = -1, pn = 0, e = 0;
        if (L < (long)(nblk + 64) * NQ) { const int rb = (int)(L / NQ); pm = rb; pn = (int)(L % NQ); e = (rb < nblk) ? rinfo[64 + rb] : NEXP; }
        tab[tid * 4 + 0] = pm; tab[tid * 4 + 1] = pn; tab[tid * 4 + 2] = e; tab[tid * 4 + 3] = 0;
    }
    __syncthreads();
}
struct MoeOrder {
    const LAS int* tab;
    __device__ bool next(int i, Unit& u) const {
        if (i >= MAX_UNITS) return false;
        const int pm = __builtin_amdgcn_readfirstlane(tab[i * 4 + 0]); if (pm < 0) return false;
        u.pm = pm; u.pn = __builtin_amdgcn_readfirstlane(tab[i * 4 + 1]); u.e = __builtin_amdgcn_readfirstlane(tab[i * 4 + 2]); return true;
    }
};
struct GatherRows {
    const int* slot_tok; const int* rinfo;
    __device__ __forceinline__ int row(const Unit& u, int r) const {
        const int nblk = rinfo[0];
        if (u.pm < nblk) { const int t = slot_tok[u.pm * 256 + r]; return t < 0 ? 0 : t; }
        return (u.pm - nblk) * 256 + r;
    }
};

struct Ctx { LAS unsigned char* lds; int tid, lane, wave, G, bid; };

template <class RowMap>
__device__ __forceinline__ void transpose_item(const float* W, int N, int k0, int n0, bf16_t* WT, int ldk, const RowMap& rm, LAS float* scr, int lane) {
    const int nn = n0 + (lane & 31);
#pragma unroll 8
    for (int i = 0; i < 32; ++i) { const int kk = 2 * i + (lane >> 5); scr[kk * 33 + (lane & 31)] = (nn < N) ? W[(size_t)(k0 + kk) * N + nn] : 0.f; }
    LDS_WAIT();
    const int c = lane & 7;
#pragma unroll
    for (int j = 0; j < 4; ++j) { const int n = (lane >> 3) + 8 * j; const LAS float* s = scr + (8 * c) * 33 + n;
        u32x4 o; o.x = pk2(s[0 * 33], s[1 * 33]); o.y = pk2(s[2 * 33], s[3 * 33]); o.z = pk2(s[4 * 33], s[5 * 33]); o.w = pk2(s[6 * 33], s[7 * 33]);
        const int dr = (n0 + n < N) ? rm(n0 + n) : -1;
        if (dr >= 0) *(u32x4*)(WT + (size_t)dr * ldk + k0 + 8 * c) = o; }
    LDS_WAIT();
}
struct RmIdent { __device__ __forceinline__ int operator()(int n) const { return n; } };
struct RmWin { __device__ __forceinline__ int operator()(int n) const { return n < 2560 ? n : (n < 2576 ? -1 : n - 16); } };
struct RmGate { __device__ __forceinline__ int operator()(int n) const { return (n >> 7) * 256 + (n & 127); } };
struct RmUp { __device__ __forceinline__ int operator()(int n) const { return (n >> 7) * 256 + 128 + (n & 127); } };

__device__ __forceinline__ void phase_prep_io(const Params& p, const Ctx& c) {
    LAS float* scr = (LAS float*)(c.lds + c.wave * 16384);
    const int gw = c.bid * NWAVES + c.wave, NGW = c.G * NWAVES;
    constexpr int I_IN = 16 * 177, I_OUT = 32 * 32, PER_L = I_IN + I_OUT;
    for (int it = gw; it < NLAYER * PER_L; it += NGW) {
        const int l = it / PER_L; int r = it % PER_L;
        if (r < I_IN) { const int kb = r / 177, nb = r % 177;
            transpose_item(p.in[I_WIN] + (size_t)l * DM * DIN, DIN, kb * 64, nb * 32, (bf16_t*)(p.ws + WS_WIN) + (size_t)l * NU * DM, DM, RmWin(), scr, c.lane); }
        else { r -= I_IN; const int kb = r / 32, nb = r % 32;
            transpose_item(p.in[I_WOUT] + (size_t)l * 2048 * DM, DM, kb * 64, nb * 32, (bf16_t*)(p.ws + WS_WOUT) + (size_t)l * DM * 2048, 2048, RmIdent(), scr, c.lane); }
    }
}
__device__ __forceinline__ void phase_prep_experts(const Params& p, const Ctx& c, int l) {
    LAS float* scr = (LAS float*)(c.lds + c.wave * 16384);
    const int gw = c.bid * NWAVES + c.wave, NGW = c.G * NWAVES;
    constexpr int PER_E = 3 * 128;
    bf16_t* GU = (bf16_t*)(p.ws + WS_GU); bf16_t* DN = (bf16_t*)(p.ws + WS_DN);
    for (int it = gw; it < 65 * PER_E; it += NGW) {
        const int e = it / PER_E; int r = it % PER_E; const int which = r / 128; r %= 128;
        if (which < 2) {
            const float* src = (e < NEXP) ? p.in[which == 0 ? I_EG : I_EU] + ((size_t)l * NEXP + e) * DM * 256 : p.in[which == 0 ? I_SG : I_SU] + (size_t)l * DM * 256;
            const int kb = r / 8, nb = r % 8;
            if (which == 0) transpose_item(src, 256, kb * 64, nb * 32, GU + (size_t)e * 512 * DM, DM, RmGate(), scr, c.lane);
            else transpose_item(src, 256, kb * 64, nb * 32, GU + (size_t)e * 512 * DM, DM, RmUp(), scr, c.lane);
        } else {
            const float* src = (e < NEXP) ? p.in[I_ED] + ((size_t)l * NEXP + e) * 256 * DM : p.in[I_SDN] + (size_t)l * 256 * DM;
            const int kb = r / 32, nb = r % 32;
            transpose_item(src, DM, kb * 64, nb * 32, DN + (size_t)e * DM * 256, 256, RmIdent(), scr, c.lane);
        }
    }
}
__device__ __forceinline__ void phase_prep_small(const Params& p, const Ctx& c) {
    LAS float* sc = (LAS float*)c.lds;
    LAS float* red = (LAS float*)(c.lds + 32768);
    float* mod = (float*)(p.ws + WS_MOD);
    bool have_sc = false;
    for (int it = c.bid; it < NLAYER * 96; it += c.G) {
        if (!have_sc) { for (int i = c.tid; i < 8 * 1024; i += NTHREADS) sc[i] = siluf_(p.in[I_C][i]); have_sc = true; }
        __syncthreads();
        const int l = it / 96, j0 = (it % 96) * 64, j = c.tid & 63, kg = c.tid >> 6;
        const float* W = p.in[I_ADAW] + (size_t)l * DM * NMOD + j0 + j;
        float a[8];
#pragma unroll
        for (int b = 0; b < 8; ++b) a[b] = 0.f;
#pragma unroll 16
        for (int k = kg * 128; k < kg * 128 + 128; ++k) { const float w = W[(size_t)k * NMOD];
#pragma unroll
            for (int b = 0; b < 8; ++b) a[b] += sc[b * 1024 + k] * w; }
#pragma unroll
        for (int b = 0; b < 8; ++b) red[(kg * 8 + b) * 64 + j] = a[b];
        __syncthreads();
        { const int b = c.tid >> 6; float s = 0.f;
#pragma unroll
          for (int g = 0; g < 8; ++g) s += red[(g * 8 + b) * 64 + j];
          mod[((size_t)l * 8 + b) * NMOD + j0 + j] = s + p.in[I_ADAB][(size_t)l * NMOD + j0 + j]; }
        __syncthreads();
    }
    if (c.bid == c.G - 1) {
        float* lb = (float*)(p.ws + WS_LB);
        for (int i = c.tid; i < 512; i += NTHREADS) { const float v0 = p.in[I_HLB][i], v1 = p.in[I_HLB][512 + i]; const float m = fmaxf(v0, v1), e0 = expf(v0 - m), e1 = expf(v1 - m);
            lb[i] = 0.f; lb[512 + i] = e1 / (e0 + e1); }
    }
    { float* WT = (float*)(p.ws + WS_WRT);
      for (int o = c.bid * NTHREADS + c.tid; o < NLAYER * 64 * 1024; o += c.G * NTHREADS) { const int k = o & 1023, e = (o >> 10) & 63, l = o >> 16; WT[o] = p.in[I_RW][((size_t)l * 1024 + k) * 64 + e]; } }
    { bf16_t* LW = (bf16_t*)(p.ws + WS_LRUW);
      for (int o = c.bid * NTHREADS + c.tid; o < NLAYER * 2 * 8 * 4096; o += c.G * NTHREADS) {
          const int i = o & 63, j = (o >> 6) & 63, g = (o >> 12) & 7, mat = (o >> 15) & 1, l = o >> 16;
          const float* src = p.in[mat == 0 ? I_LWA : I_LWX] + (((size_t)l * 8 + g) * 64 + i) * 64 + j;
          LW[o] = (bf16_t)f2bf(*src); } }
}

__device__ __forceinline__ void load_wdt(const Params& p, const Ctx& c, int l, LAS float* wdt) {
    const float* Win = p.in[I_WIN] + (size_t)l * DM * DIN;
    for (int i = c.tid; i < 16 * 1024; i += NTHREADS) { const int k = i >> 4, j = i & 15; wdt[j * 1024 + k] = Win[(size_t)k * DIN + 2560 + j]; }
    __syncthreads();
}
__device__ __forceinline__ void norm_mix_row(const Ctx& c, const f32x4 (&v)[4], float ss, int tok, const float* nw, const float* mod, const LAS float* wdt, bf16_t* H, float* dtraw) {
        const int b = tok >> 11;
        const float rstd = rsqf_(wave_sum(ss, c.lane) * (1.0f / DM) + EPS);
        f32x4 hv[4], w4v[4], shv[4], scv[4];
#pragma unroll
        for (int j = 0; j < 4; ++j) { const int col = 256 * j + 4 * c.lane;
            w4v[j] = *(const f32x4*)(nw + col); shv[j] = *(const f32x4*)(mod + (size_t)b * NMOD + col); scv[j] = *(const f32x4*)(mod + (size_t)b * NMOD + 1024 + col); }
#pragma unroll
        for (int j = 0; j < 4; ++j) {
            const int col = 256 * j + 4 * c.lane;
            const f32x4 w4 = w4v[j], sh = shv[j], sc = scv[j];
            hv[j] = (v[j] * rstd * w4) * (sc + 1.0f) + sh;
            u32x2 o; o.x = pk2(hv[j][0], hv[j][1]); o.y = pk2(hv[j][2], hv[j][3]);
            *(u32x2*)(H + (size_t)tok * DM + col) = o;
        }
        float d16[16];
#pragma unroll
        for (int q = 0; q < 16; ++q) {
            float s2 = 0.f;
#pragma unroll
            for (int j = 0; j < 4; ++j) { const f32x4 wq = *(const LAS f32x4*)(wdt + q * 1024 + 256 * j + 4 * c.lane); s2 += (hv[j][0] * wq[0] + hv[j][1] * wq[1]) + (hv[j][2] * wq[2] + hv[j][3] * wq[3]); }
            d16[q] = s2;
            if ((q & 1) == 1) asm volatile("" ::: "memory");
        }
        float d8[8], d4[4], d2[2], d1;
        { const bool up = (c.lane & 32) != 0;
#pragma unroll
          for (int i = 0; i < 8; ++i) { const float snd = up ? d16[i] : d16[8 + i], kp = up ? d16[8 + i] : d16[i]; d8[i] = kp + shfl_xor_l(snd, 32, c.lane); } }
        { const bool up = (c.lane & 16) != 0;
#pragma unroll
          for (int i = 0; i < 4; ++i) { const float snd = up ? d8[i] : d8[4 + i], kp = up ? d8[4 + i] : d8[i]; d4[i] = kp + shfl_xor_l(snd, 16, c.lane); } }
        { const bool up = (c.lane & 8) != 0;
#pragma unroll
          for (int i = 0; i < 2; ++i) { const float snd = up ? d4[i] : d4[2 + i], kp = up ? d4[2 + i] : d4[i]; d2[i] = kp + shfl_xor_l(snd, 8, c.lane); } }
        { const bool up = (c.lane & 4) != 0; const float snd = up ? d2[0] : d2[1], kp = up ? d2[1] : d2[0]; d1 = kp + shfl_xor_l(snd, 4, c.lane); }
        d1 += shfl_xor_l(d1, 2, c.lane); d1 += shfl_xor_l(d1, 1, c.lane);
        if ((c.lane & 3) == 0) dtraw[(size_t)tok * 16 + ((c.lane >> 5) & 1) * 8 + ((c.lane >> 4) & 1) * 4 + ((c.lane >> 3) & 1) * 2 + ((c.lane >> 2) & 1)] = d1;
}
__device__ __forceinline__ void phase_norm_mix(const Params& p, const Ctx& c, int l, const float* xin) {
    LAS float* wdt = (LAS float*)c.lds;
    load_wdt(p, c, l, wdt);
    const float* mod = (const float*)(p.ws + WS_MOD) + (size_t)l * 8 * NMOD;
    const float* nw = p.in[I_NMIX] + (size_t)l * DM;
    bf16_t* H = (bf16_t*)(p.ws + WS_H); float* dtraw = (float*)(p.ws + WS_DTRAW);
    const int gw = c.bid * NWAVES + c.wave, NGW = c.G * NWAVES;
    f32x4 vn[4];
    if (gw < NTOK) {
#pragma unroll
        for (int j = 0; j < 4; ++j) vn[j] = ((const f32x4*)(xin + (size_t)gw * DM) + c.lane)[64 * j];
    }
    for (int tok = gw; tok < NTOK; tok += NGW) {
        f32x4 v[4]; float ss = 0.f;
#pragma unroll
        for (int j = 0; j < 4; ++j) { v[j] = vn[j]; ss += (v[j][0] * v[j][0] + v[j][1] * v[j][1]) + (v[j][2] * v[j][2] + v[j][3] * v[j][3]); }
        if (tok + NGW < NTOK) {
#pragma unroll
            for (int j = 0; j < 4; ++j) vn[j] = ((const f32x4*)(xin + (size_t)(tok + NGW) * DM) + c.lane)[64 * j];
        }
        norm_mix_row(c, v, ss, tok, nw, mod, wdt, H, dtraw);
    }
}

__device__ __forceinline__ void phase_ssd_conv(const Params& p, const Ctx& c, int l) {
    const bf16_t* U = (const bf16_t*)(p.ws + WS_U); bf16_t* XA = (bf16_t*)(p.ws + WS_XBC);
    const float* cw = p.in[I_SCW] + (size_t)l * 4 * 1536; const float* cb = p.in[I_SCB] + (size_t)l * 1536;
    const float* dtraw = (const float*)(p.ws + WS_DTRAW); float* dt = (float*)(p.ws + WS_DT); float* acum = (float*)(p.ws + WS_ACUM);
    for (int idx = c.bid * NTHREADS + c.tid; idx < (NTOK / 4) * 192; idx += c.G * NTHREADS) {
        const int oct = idx % 192, tg = idx / 192, tok0 = tg * 4, t0 = tok0 & (SEQ - 1), c0 = oct * 8;
        float w[4][8], bb[8];
#pragma unroll
        for (int k = 0; k < 4; ++k) { const f32x4 a = *(const f32x4*)(cw + k * 1536 + c0), b2 = *(const f32x4*)(cw + k * 1536 + c0 + 4);
            w[k][0] = a[0]; w[k][1] = a[1]; w[k][2] = a[2]; w[k][3] = a[3]; w[k][4] = b2[0]; w[k][5] = b2[1]; w[k][6] = b2[2]; w[k][7] = b2[3]; }
        { const f32x4 a = *(const f32x4*)(cb + c0), b2 = *(const f32x4*)(cb + c0 + 4); bb[0] = a[0]; bb[1] = a[1]; bb[2] = a[2]; bb[3] = a[3]; bb[4] = b2[0]; bb[5] = b2[1]; bb[6] = b2[2]; bb[7] = b2[3]; }
        float x[7][8];
#pragma unroll
        for (int r = 0; r < 7; ++r) {
            u32x4 v = (u32x4){0u, 0u, 0u, 0u};
            if (t0 + r - 3 >= 0) v = *(const u32x4*)(U + (size_t)(tok0 + r - 3) * NU + UXS + c0);
#pragma unroll
            for (int j = 0; j < 4; ++j) { x[r][2 * j] = lo_bf(v[j]); x[r][2 * j + 1] = hi_bf(v[j]); }
        }
#pragma unroll
        for (int t = 0; t < 4; ++t) {
            float y[8];
#pragma unroll
            for (int j = 0; j < 8; ++j) y[j] = siluf_(bb[j] + w[0][j] * x[t][j] + w[1][j] * x[t + 1][j] + w[2][j] * x[t + 2][j] + w[3][j] * x[t + 3][j]);
            u32x4 o; o.x = pk2(y[0], y[1]); o.y = pk2(y[2], y[3]); o.z = pk2(y[4], y[5]); o.w = pk2(y[6], y[7]);
            *(u32x4*)(XA + (size_t)(tok0 + t) * 1536 + c0) = o;
        }
    }
    for (int it = c.bid + c.wave * c.G; it < 128; it += c.G * NWAVES) {
        const int tok0 = it * 128, h = c.lane & 15, qtr = c.lane >> 4;
        const float bias = p.in[I_SDTB][l * 16 + h], A = -expf(p.in[I_SALOG][l * 16 + h]);
        float d[32]; float cum = 0.f;
#pragma unroll
        for (int i = 0; i < 32; ++i) d[i] = softplusf_(dtraw[(size_t)(tok0 + qtr * 32 + i) * 16 + h] + bias);
#pragma unroll
        for (int i = 0; i < 32; ++i) cum += d[i] * A;
        const float c1 = shfl_up_f(cum, 16, c.lane), c2 = shfl_up_f(cum, 32, c.lane), c3 = shfl_up_f(cum, 48, c.lane);
        float off = 0.f; if (qtr >= 1) off += c1; if (qtr >= 2) off += c2; if (qtr >= 3) off += c3;
        float run = off;
#pragma unroll
        for (int i = 0; i < 32; ++i) { run += d[i] * A; dt[(size_t)(tok0 + qtr * 32 + i) * 16 + h] = d[i]; acum[(size_t)(tok0 + qtr * 32 + i) * 16 + h] = run; }
    }
}

__device__ __forceinline__ void phase_ssd_state(const Params& p, const Ctx& c) {
    LAS bf16_t* XS = (LAS bf16_t*)c.lds;
    LAS bf16_t* BS = (LAS bf16_t*)(c.lds + 2 * 18432);
    LAS float* fac = (LAS float*)(c.lds + 2 * 18432 + 34816);
    const bf16_t* XA = (const bf16_t*)(p.ws + WS_XBC); const float* dt = (const float*)(p.ws + WS_DT); const float* acum = (const float*)(p.ws + WS_ACUM);
    bf16_t* ST = (bf16_t*)(p.ws + WS_SST);
    const int fr = c.lane & 15, fq = c.lane >> 4;
    for (int it = c.bid; it < 256; it += c.G) {
        const int g = it & 1, bc = it >> 1, tok0 = bc * 128;
        u32x4 pxs[2];
#pragma unroll
        for (int q = 0; q < 2; ++q) { const int i = c.tid + q * NTHREADS; pxs[q] = *(const u32x4*)(XA + (size_t)(tok0 + (i >> 3)) * 1536 + (g * 8) * 64 + (i & 7) * 8); }
        for (int i = c.tid; i < 128 * 16; i += NTHREADS) { const int lrow = i >> 4, ck = i & 15;
            *(LAS u32x4*)(BS + lrow * 136 + ck * 8) = *(const u32x4*)(XA + (size_t)(tok0 + lrow) * 1536 + 1024 + g * 128 + ck * 8); }
        for (int i = c.tid; i < 1024; i += NTHREADS) { const int h8 = i >> 7, lr = i & 127, h = g * 8 + h8;
            fac[i] = dt[(size_t)(tok0 + lr) * 16 + h] * __expf(acum[(size_t)(tok0 + 127) * 16 + h] - acum[(size_t)(tok0 + lr) * 16 + h]); }
        LDS_BARRIER();
        for (int h8 = 0; h8 < 8; ++h8) {
            const int h = g * 8 + h8; LAS bf16_t* X = XS + (h8 & 1) * (128 * 72);
#pragma unroll
            for (int q = 0; q < 2; ++q) { const int i = c.tid + q * NTHREADS, lrow = i >> 3, ck = i & 7; const u32x4 r = pxs[q]; const float f = fac[h8 * 128 + lrow];
                u32x4 o; o.x = pk2(lo_bf(r.x) * f, hi_bf(r.x) * f); o.y = pk2(lo_bf(r.y) * f, hi_bf(r.y) * f); o.z = pk2(lo_bf(r.z) * f, hi_bf(r.z) * f); o.w = pk2(lo_bf(r.w) * f, hi_bf(r.w) * f);
                *(LAS u32x4*)(X + lrow * 72 + ck * 8) = o; }
            if (h8 < 7) {
#pragma unroll
                for (int q = 0; q < 2; ++q) { const int i = c.tid + q * NTHREADS; pxs[q] = *(const u32x4*)(XA + (size_t)(tok0 + (i >> 3)) * 1536 + (h + 1) * 64 + (i & 7) * 8); } }
            LDS_BARRIER();
            f32x4 acc[4];
#pragma unroll
            for (int m = 0; m < 4; ++m) acc[m] = (f32x4){0.f, 0.f, 0.f, 0.f};
#pragma unroll
            for (int ks = 0; ks < 4; ++ks) {
                const bf16x8 bfr = tr_frag(BS, 136, 32 * ks, 16 * c.wave, c.lane);
#pragma unroll
                for (int m = 0; m < 4; ++m) { const bf16x8 afr = tr_frag(X, 72, 32 * ks, 16 * m, c.lane); acc[m] = MFMA16(bfr, afr, acc[m]); }
            }
            const size_t sit = (size_t)(bc * 16 + h);
#pragma unroll
            for (int m = 0; m < 4; ++m) { u32x2 o; o.x = pk2(acc[m][0], acc[m][1]); o.y = pk2(acc[m][2], acc[m][3]);
                *(u32x2*)(ST + sit * 8192 + (16 * m + fr) * 128 + 16 * c.wave + 4 * fq) = o; }
        }
        LDS_BARRIER();
    }
}
__device__ __forceinline__ void phase_ssd_scan(const Params& p, const Ctx& c) {
    u32x4* ST = (u32x4*)(p.ws + WS_SST); const float* acum = (const float*)(p.ws + WS_ACUM);
    for (int i = c.bid * NTHREADS + c.tid; i < 128 * 1024; i += c.G * NTHREADS) {
        const int e8 = i & 1023, bh = i >> 10, b = bh >> 4, h = bh & 15;
        u32x4 loc[16]; float dec[16];
#pragma unroll
        for (int ch = 0; ch < 16; ++ch) { loc[ch] = ST[(size_t)((b * 16 + ch) * 16 + h) * 1024 + e8]; dec[ch] = __expf(acum[(size_t)(b * SEQ + ch * 128 + 127) * 16 + h]); }
        float r[8];
#pragma unroll
        for (int j = 0; j < 8; ++j) r[j] = 0.f;
#pragma unroll
        for (int ch = 0; ch < 16; ++ch) {
            u32x4 o; o.x = pk2(r[0], r[1]); o.y = pk2(r[2], r[3]); o.z = pk2(r[4], r[5]); o.w = pk2(r[6], r[7]);
            ST[(size_t)((b * 16 + ch) * 16 + h) * 1024 + e8] = o;
            const float d = dec[ch];
#pragma unroll
            for (int j = 0; j < 4; ++j) { r[2 * j] = d * r[2 * j] + lo_bf(loc[ch][j]); r[2 * j + 1] = d * r[2 * j + 1] + hi_bf(loc[ch][j]); }
        }
    }
}
__device__ __forceinline__ void phase_ssd_out_g(const Params& p, const Ctx& c, int l) {
    LAS bf16_t* Cs = (LAS bf16_t*)c.lds;
    LAS bf16_t* CB = (LAS bf16_t*)(c.lds + 34816);
    LAS bf16_t* BD = (LAS bf16_t*)(c.lds + 2 * 34816);
    LAS bf16_t* XS = (LAS bf16_t*)(c.lds + 3 * 34816);
    LAS bf16_t* STs = (LAS bf16_t*)(c.lds + 3 * 34816 + 18432);
    LAS float* acs = (LAS float*)(c.lds + 3 * 34816 + 18432 + 17408);
    LAS float* dts = acs + 1024;
    const bf16_t* XA = (const bf16_t*)(p.ws + WS_XBC); const float* dt = (const float*)(p.ws + WS_DT); const float* acum = (const float*)(p.ws + WS_ACUM);
    const bf16_t* ST = (const bf16_t*)(p.ws + WS_SST); bf16_t* YP = (bf16_t*)(p.ws + WS_H);
    const bf16_t* U = (const bf16_t*)(p.ws + WS_U); bf16_t* YC = (bf16_t*)(p.ws + WS_YCAT);
    const float* nw = p.in[I_SNW] + (size_t)l * 1024;
    const int fr = c.lane & 15, fq = c.lane >> 4, w = c.wave;
    for (int it = c.bid; it < 256; it += c.G) {
        const int g = it & 1, bc = it >> 1, tok0 = bc * 128;
        for (int i = c.tid; i < 128 * 16; i += NTHREADS) { const int row = i >> 4, ck = i & 15;
            *(LAS u32x4*)(BD + row * 136 + ck * 8) = *(const u32x4*)(XA + (size_t)(tok0 + row) * 1536 + 1024 + g * 128 + ck * 8);
            *(LAS u32x4*)(Cs + row * 136 + ck * 8) = *(const u32x4*)(XA + (size_t)(tok0 + row) * 1536 + 1280 + g * 128 + ck * 8); }
        for (int i = c.tid; i < 1024; i += NTHREADS) { const int h8 = i >> 7, lr = i & 127; acs[i] = acum[(size_t)(tok0 + lr) * 16 + g * 8 + h8]; dts[i] = dt[(size_t)(tok0 + lr) * 16 + g * 8 + h8]; }
        LDS_BARRIER();
        {
            f32x4 cb[8];
#pragma unroll
            for (int n = 0; n < 8; ++n) cb[n] = (f32x4){0.f, 0.f, 0.f, 0.f};
#pragma unroll
            for (int ks = 0; ks < 4; ++ks) {
                const bf16x8 afr = *(const LAS bf16x8*)(Cs + (16 * w + fr) * 136 + ks * 32 + 8 * fq);
#pragma unroll
                for (int n = 0; n < 8; ++n) { const bf16x8 bfr = *(const LAS bf16x8*)(BD + (16 * n + fr) * 136 + ks * 32 + 8 * fq); cb[n] = MFMA16(bfr, afr, cb[n]); }
            }
            const int lr = 16 * w + fr;
#pragma unroll
            for (int n = 0; n < 8; ++n) { u32x2 o; o.x = pk2(cb[n][0], cb[n][1]); o.y = pk2(cb[n][2], cb[n][3]); *(LAS u32x2*)(CB + lr * 136 + 16 * n + 4 * fq) = o; }
        }
        LDS_BARRIER();
        u32x4 pst[2], pxs[2];
#pragma unroll
        for (int q = 0; q < 2; ++q) { const int i = c.tid + q * NTHREADS;
            pst[q] = *(const u32x4*)(ST + (size_t)(bc * 16 + g * 8) * 8192 + (i >> 4) * 128 + (i & 15) * 8);
            pxs[q] = *(const u32x4*)(XA + (size_t)(tok0 + (i >> 3)) * 1536 + (g * 8) * 64 + (i & 7) * 8); }
        for (int h8 = 0; h8 < 8; ++h8) {
            const int h = g * 8 + h8;
            const float Dh = p.in[I_SD][l * 16 + h];
            const LAS float* ah = acs + h8 * 128; const LAS float* dh = dts + h8 * 128;
#pragma unroll
            for (int q = 0; q < 2; ++q) { const int i = c.tid + q * NTHREADS;
                *(LAS u32x4*)(STs + (i >> 4) * 136 + (i & 15) * 8) = pst[q];
                const int lrow = i >> 3, ck = i & 7; const u32x4 r = pxs[q]; const float f = dh[lrow];
                u32x4 o; o.x = pk2(lo_bf(r.x) * f, hi_bf(r.x) * f); o.y = pk2(lo_bf(r.y) * f, hi_bf(r.y) * f); o.z = pk2(lo_bf(r.z) * f, hi_bf(r.z) * f); o.w = pk2(lo_bf(r.w) * f, hi_bf(r.w) * f);
                *(LAS u32x4*)(XS + lrow * 72 + ck * 8) = o; }
            if (h8 < 7) {
#pragma unroll
                for (int q = 0; q < 2; ++q) { const int i = c.tid + q * NTHREADS;
                    pst[q] = *(const u32x4*)(ST + (size_t)(bc * 16 + h + 1) * 8192 + (i >> 4) * 128 + (i & 15) * 8);
                    pxs[q] = *(const u32x4*)(XA + (size_t)(tok0 + (i >> 3)) * 1536 + (h + 1) * 64 + (i & 7) * 8); } }
            for (int i = c.tid; i < 128 * 16; i += NTHREADS) { const int lr = i >> 4, ck = i & 15; u32x4 o = (u32x4){0u, 0u, 0u, 0u};
                if (8 * ck <= lr) { const u32x4 cv = *(const LAS u32x4*)(CB + lr * 136 + ck * 8); const float al = ah[lr];
                    const f32x4 s0 = *(const LAS f32x4*)(ah + 8 * ck), s1 = *(const LAS f32x4*)(ah + 8 * ck + 4);
                    float e[8];
#pragma unroll
                    for (int j = 0; j < 4; ++j) { e[j] = (8 * ck + j <= lr) ? __expf(al - s0[j]) : 0.f; e[4 + j] = (8 * ck + 4 + j <= lr) ? __expf(al - s1[j]) : 0.f; }
                    o.x = pk2(lo_bf(cv.x) * e[0], hi_bf(cv.x) * e[1]); o.y = pk2(lo_bf(cv.y) * e[2], hi_bf(cv.y) * e[3]); o.z = pk2(lo_bf(cv.z) * e[4], hi_bf(cv.z) * e[5]); o.w = pk2(lo_bf(cv.w) * e[6], hi_bf(cv.w) * e[7]); }
                *(LAS u32x4*)(BD + lr * 136 + ck * 8) = o; }
            LDS_BARRIER();
            {
                f32x4 a1[4], a2[4];
#pragma unroll
                for (int n = 0; n < 4; ++n) { a1[n] = (f32x4){0.f, 0.f, 0.f, 0.f}; a2[n] = (f32x4){0.f, 0.f, 0.f, 0.f}; }
#pragma unroll
                for (int ks = 0; ks < 4; ++ks) {
                    const bf16x8 ad = *(const LAS bf16x8*)(BD + (16 * w + fr) * 136 + ks * 32 + 8 * fq);
                    const bf16x8 ac = *(const LAS bf16x8*)(Cs + (16 * w + fr) * 136 + ks * 32 + 8 * fq);
#pragma unroll
                    for (int n = 0; n < 4; ++n) {
                        const bf16x8 bx = tr_frag(XS, 72, 32 * ks, 16 * n, c.lane);
                        const bf16x8 bs = *(const LAS bf16x8*)(STs + (16 * n + fr) * 136 + ks * 32 + 8 * fq);
                        a1[n] = MFMA16(bx, ad, a1[n]); a2[n] = MFMA16(bs, ac, a2[n]); }
                }
                const int lr = 16 * w + fr; const float ea = __expf(ah[lr]);
#pragma unroll
                for (int n = 0; n < 4; ++n) { const int pc = 16 * n + 4 * fq;
                    const u32x2 xv = *(const u32x2*)(XA + (size_t)(tok0 + lr) * 1536 + h * 64 + pc);
                    const float y0 = a1[n][0] + ea * a2[n][0] + Dh * lo_bf(xv.x), y1 = a1[n][1] + ea * a2[n][1] + Dh * hi_bf(xv.x);
                    const float y2 = a1[n][2] + ea * a2[n][2] + Dh * lo_bf(xv.y), y3 = a1[n][3] + ea * a2[n][3] + Dh * hi_bf(xv.y);
                    u32x2 o; o.x = pk2(y0, y1); o.y = pk2(y2, y3);
                    *(u32x2*)(YP + (size_t)(tok0 + lr) * DM + h * 64 + pc) = o; }
            }
            LDS_BARRIER();
        }
        __syncthreads();
        for (int pass = 0; pass < 2; ++pass) {
            const int tok = tok0 + pass * 64 + (c.tid >> 3), part = c.tid & 7, col = g * 512 + part * 8;
            u32x4 yv[8], zv[8];
#pragma unroll
            for (int i = 0; i < 8; ++i) { yv[i] = *(const u32x4*)(YP + (size_t)tok * DM + col + 64 * i); zv[i] = *(const u32x4*)(U + (size_t)tok * NU + UZ + col + 64 * i); }
            float v[64]; float ss = 0.f;
#pragma unroll
            for (int i = 0; i < 8; ++i)
#pragma unroll
                for (int j = 0; j < 4; ++j) { const float a = lo_bf(yv[i][j]) * siluf_(lo_bf(zv[i][j])), b2 = hi_bf(yv[i][j]) * siluf_(hi_bf(zv[i][j])); v[8 * i + 2 * j] = a; v[8 * i + 2 * j + 1] = b2; ss += a * a + b2 * b2; }
            ss += shfl_xor_l(ss, 1, c.lane); ss += shfl_xor_l(ss, 2, c.lane); ss += shfl_xor_l(ss, 4, c.lane);
            const float rstd = rsqf_(ss * (1.0f / 512.0f) + EPS);
#pragma unroll
            for (int i = 0; i < 8; ++i) { const f32x4 w0 = *(const f32x4*)(nw + col + 64 * i), w1 = *(const f32x4*)(nw + col + 64 * i + 4);
                u32x4 o; o.x = pk2(v[8 * i] * rstd * w0[0], v[8 * i + 1] * rstd * w0[1]); o.y = pk2(v[8 * i + 2] * rstd * w0[2], v[8 * i + 3] * rstd * w0[3]);
                o.z = pk2(v[8 * i + 4] * rstd * w1[0], v[8 * i + 5] * rstd * w1[1]); o.w = pk2(v[8 * i + 6] * rstd * w1[2], v[8 * i + 7] * rstd * w1[3]);
                *(u32x4*)(YC + (size_t)tok * 2048 + col + 64 * i) = o; }
        }
        LDS_BARRIER();
    }
}
__device__ __forceinline__ void phase_hg_state(const Params& p, const Ctx& c, int l) {
    LAS float* Bf = (LAS float*)c.lds;
    LAS float* KK = (LAS float*)(c.lds + 33792);
    LAS bf16_t* KD = (LAS bf16_t*)(c.lds + 2 * 33792 + 2112);
    LAS bf16_t* VS = (LAS bf16_t*)(c.lds + 2 * 33792 + 2112 + 17408);
    const bf16_t* U = (const bf16_t*)(p.ws + WS_U); const float* lb = (const float*)(p.ws + WS_LB) + l * 512;
    bf16_t* ST = (bf16_t*)(p.ws + WS_HST); float* BL = (float*)(p.ws + WS_HGBL);
    const int fr = c.lane & 15, fq = c.lane >> 4, w = c.wave;
    u32x4 pf[2], pv[2];
#define HS_LOAD(item) do { const int ch_ = (item) & 31, bh_ = (item) >> 5, h_ = bh_ & 3, b_ = bh_ >> 2, tk_ = b_ * SEQ + ch_ * 64; _Pragma("unroll") for (int q_ = 0; q_ < 2; ++q_) { const int i_ = c.tid + q_ * NTHREADS; \
        const size_t ro_ = (size_t)(tk_ + (i_ >> 4)) * NU + h_ * 128 + (i_ & 15) * 8; pf[q_] = *(const u32x4*)(U + ro_ + UHF); pv[q_] = *(const u32x4*)(U + ro_ + UHV); } } while (0)
    if (c.bid < 1024) HS_LOAD(c.bid);
    for (int it = c.bid; it < 1024; it += c.G) {
        const int ch = it & 31, bh = it >> 5, h = bh & 3, b = bh >> 2, tok0 = b * SEQ + ch * 64;
#pragma unroll
        for (int q = 0; q < 2; ++q) { const int i = c.tid + q * NTHREADS, sr = i >> 4, ck = i & 15;
            const u32x4 rf = pf[q];
            *(LAS u32x4*)(VS + sr * 136 + ck * 8) = pv[q];
            const f32x4 l0 = *(const f32x4*)(lb + h * 128 + ck * 8), l1 = *(const f32x4*)(lb + h * 128 + ck * 8 + 4);
            f32x4 k0, k1, g0, g1;
            k0[0] = (1.0f - l0[0]) * sigmoidf_(-lo_bf(rf.x)); k0[1] = (1.0f - l0[1]) * sigmoidf_(-hi_bf(rf.x)); k0[2] = (1.0f - l0[2]) * sigmoidf_(-lo_bf(rf.y)); k0[3] = (1.0f - l0[3]) * sigmoidf_(-hi_bf(rf.y));
            k1[0] = (1.0f - l1[0]) * sigmoidf_(-lo_bf(rf.z)); k1[1] = (1.0f - l1[1]) * sigmoidf_(-hi_bf(rf.z)); k1[2] = (1.0f - l1[2]) * sigmoidf_(-lo_bf(rf.w)); k1[3] = (1.0f - l1[3]) * sigmoidf_(-hi_bf(rf.w));
#pragma unroll
            for (int j = 0; j < 4; ++j) { g0[j] = __logf(1.0f - k0[j]); g1[j] = __logf(1.0f - k1[j]); }
            *(LAS f32x4*)(KK + sr * 132 + ck * 8) = k0; *(LAS f32x4*)(KK + sr * 132 + ck * 8 + 4) = k1;
            *(LAS f32x4*)(Bf + sr * 132 + ck * 8) = g0; *(LAS f32x4*)(Bf + sr * 132 + ck * 8 + 4) = g1; }
        if (it + c.G < 1024) HS_LOAD(it + c.G);
        LDS_BARRIER();
        { const int kc = c.tid & 127, q4 = c.tid >> 7; float vals[16]; float cum = 0.f;
#pragma unroll
          for (int i = 0; i < 16; ++i) { cum += Bf[(16 * q4 + i) * 132 + kc]; vals[i] = cum; }
          KK[(64 + q4) * 132 + kc] = cum;
          LDS_BARRIER();
          float off = 0.f;
#pragma unroll
          for (int j = 0; j < 3; ++j) off += (j < q4) ? KK[(64 + j) * 132 + kc] : 0.f;
#pragma unroll
          for (int i = 0; i < 16; ++i) Bf[(16 * q4 + i) * 132 + kc] = vals[i] + off;
          if (q4 == 3) BL[(size_t)it * 128 + kc] = vals[15] + off; }
        LDS_BARRIER();
        for (int i = c.tid; i < 64 * 16; i += NTHREADS) { const int sr = i >> 4, ck = i & 15;
            const f32x4 ka = *(const LAS f32x4*)(KK + sr * 132 + ck * 8), kb = *(const LAS f32x4*)(KK + sr * 132 + ck * 8 + 4);
            const f32x4 ba = *(const LAS f32x4*)(Bf + sr * 132 + ck * 8), bb = *(const LAS f32x4*)(Bf + sr * 132 + ck * 8 + 4);
            const f32x4 ea = *(const LAS f32x4*)(Bf + 63 * 132 + ck * 8), eb = *(const LAS f32x4*)(Bf + 63 * 132 + ck * 8 + 4);
            u32x4 o; o.x = pk2(ka[0] * __expf(ea[0] - ba[0]), ka[1] * __expf(ea[1] - ba[1])); o.y = pk2(ka[2] * __expf(ea[2] - ba[2]), ka[3] * __expf(ea[3] - ba[3]));
            o.z = pk2(kb[0] * __expf(eb[0] - bb[0]), kb[1] * __expf(eb[1] - bb[1])); o.w = pk2(kb[2] * __expf(eb[2] - bb[2]), kb[3] * __expf(eb[3] - bb[3]));
            *(LAS u32x4*)(KD + sr * 136 + ck * 8) = o; }
        LDS_BARRIER();
        f32x4 acc[8];
#pragma unroll
        for (int n = 0; n < 8; ++n) acc[n] = (f32x4){0.f, 0.f, 0.f, 0.f};
#pragma unroll
        for (int ks = 0; ks < 2; ++ks) {
            const bf16x8 afr = tr_frag(VS, 136, 32 * ks, 16 * w, c.lane);
#pragma unroll
            for (int n = 0; n < 8; ++n) { const bf16x8 bfr = tr_frag(KD, 136, 32 * ks, 16 * n, c.lane); acc[n] = MFMA16(bfr, afr, acc[n]); }
        }
#pragma unroll
        for (int n = 0; n < 8; ++n) { u32x2 o; o.x = pk2(acc[n][0], acc[n][1]); o.y = pk2(acc[n][2], acc[n][3]);
            *(u32x2*)(ST + (size_t)it * 16384 + (16 * w + fr) * 128 + 16 * n + 4 * fq) = o; }
        LDS_BARRIER();
    }
#undef HS_LOAD
}
__device__ __forceinline__ void phase_hg_scan(const Params& p, const Ctx& c) {
    u32x2* ST = (u32x2*)(p.ws + WS_HST); const float* BL = (const float*)(p.ws + WS_HGBL);
    for (int i = c.bid * NTHREADS + c.tid; i < 32 * 4096; i += c.G * NTHREADS) {
        const int e4 = i & 4095, bh = i >> 12, k0 = (4 * e4) & 127;
        float r[4] = {0.f, 0.f, 0.f, 0.f};
        for (int half = 0; half < 2; ++half) {
            u32x2 loc[16]; f32x4 dl[16];
#pragma unroll
            for (int cc = 0; cc < 16; ++cc) { const size_t it = (size_t)(bh * 32 + half * 16 + cc); loc[cc] = ST[it * 4096 + e4]; dl[cc] = *(const f32x4*)(BL + it * 128 + k0); }
#pragma unroll
            for (int cc = 0; cc < 16; ++cc) { const size_t it = (size_t)(bh * 32 + half * 16 + cc);
                u32x2 o; o.x = pk2(r[0], r[1]); o.y = pk2(r[2], r[3]);
                ST[it * 4096 + e4] = o;
                r[0] = __expf(dl[cc][0]) * r[0] + lo_bf(loc[cc].x); r[1] = __expf(dl[cc][1]) * r[1] + hi_bf(loc[cc].x);
                r[2] = __expf(dl[cc][2]) * r[2] + lo_bf(loc[cc].y); r[3] = __expf(dl[cc][3]) * r[3] + hi_bf(loc[cc].y); }
        }
    }
}
__device__ __forceinline__ void phase_hg_out(const Params& p, const Ctx& c, int l) {
    LAS bf16_t* Qs = (LAS bf16_t*)c.lds;
    LAS bf16_t* Ks = (LAS bf16_t*)(c.lds + 17408);
    LAS float* Bf = (LAS float*)(c.lds + 2 * 17408);
    LAS bf16_t* ATT = (LAS bf16_t*)(c.lds + 2 * 17408 + 33792);
    LAS bf16_t* VS = (LAS bf16_t*)(c.lds + 2 * 17408 + 33792 + 9216);
    LAS unsigned char* R5 = c.lds + 2 * 17408 + 33792 + 9216 + 17408;
    LAS bf16_t* QI3 = (LAS bf16_t*)R5;
    LAS bf16_t* KKI3 = (LAS bf16_t*)(R5 + 48 * 272);
    LAS bf16_t* STs = (LAS bf16_t*)R5;
    LAS float* QT = (LAS float*)(R5 + 40000);
    const bf16_t* U = (const bf16_t*)(p.ws + WS_U); const float* lb = (const float*)(p.ws + WS_LB) + l * 512;
    const bf16_t* ST = (const bf16_t*)(p.ws + WS_HST); bf16_t* YC = (bf16_t*)(p.ws + WS_YCAT);
    const float* nw = p.in[I_HNW] + (size_t)l * 512;
    const int fr = c.lane & 15, fq = c.lane >> 4, w = c.wave;
    u32x4 pq[2], pf[2], pv[2], pst[4];
#define HG_LOAD_QFV(item) do { const int ch_ = (item) & 31, bh_ = (item) >> 5, h_ = bh_ & 3, b_ = bh_ >> 2, tk_ = b_ * SEQ + ch_ * 64; _Pragma("unroll") for (int q_ = 0; q_ < 2; ++q_) { const int i_ = c.tid + q_ * NTHREADS; \
        const size_t ro_ = (size_t)(tk_ + (i_ >> 4)) * NU + h_ * 128 + (i_ & 15) * 8; pq[q_] = *(const u32x4*)(U + ro_ + UHQ); pf[q_] = *(const u32x4*)(U + ro_ + UHF); pv[q_] = *(const u32x4*)(U + ro_ + UHV); } } while (0)
#define HG_LOAD_ST(item) do { _Pragma("unroll") for (int q_ = 0; q_ < 4; ++q_) { const int i_ = c.tid + q_ * NTHREADS; pst[q_] = *(const u32x4*)(ST + (size_t)(item) * 16384 + (i_ >> 4) * 128 + (i_ & 15) * 8); } } while (0)
    if (c.bid < 1024) { HG_LOAD_QFV(c.bid); HG_LOAD_ST(c.bid); }
    for (int it = c.bid; it < 1024; it += c.G) {
        const int ch = it & 31, bh = it >> 5, h = bh & 3, b = bh >> 2, tok0 = b * SEQ + ch * 64;
        const bool more = (it + c.G) < 1024;
#pragma unroll
        for (int q = 0; q < 2; ++q) { const int i = c.tid + q * NTHREADS, sr = i >> 4, ck = i & 15;
            const u32x4 rq = pq[q], rf = pf[q];
            *(LAS u32x4*)(VS + sr * 136 + ck * 8) = pv[q];
            const f32x4 l0 = *(const f32x4*)(lb + h * 128 + ck * 8), l1 = *(const f32x4*)(lb + h * 128 + ck * 8 + 4);
            f32x4 k0, k1, g0, g1;
            k0[0] = (1.0f - l0[0]) * sigmoidf_(-lo_bf(rf.x)); k0[1] = (1.0f - l0[1]) * sigmoidf_(-hi_bf(rf.x)); k0[2] = (1.0f - l0[2]) * sigmoidf_(-lo_bf(rf.y)); k0[3] = (1.0f - l0[3]) * sigmoidf_(-hi_bf(rf.y));
            k1[0] = (1.0f - l1[0]) * sigmoidf_(-lo_bf(rf.z)); k1[1] = (1.0f - l1[1]) * sigmoidf_(-hi_bf(rf.z)); k1[2] = (1.0f - l1[2]) * sigmoidf_(-lo_bf(rf.w)); k1[3] = (1.0f - l1[3]) * sigmoidf_(-hi_bf(rf.w));
#pragma unroll
            for (int j = 0; j < 4; ++j) { g0[j] = __logf(1.0f - k0[j]); g1[j] = __logf(1.0f - k1[j]); }
            u32x4 ko; ko.x = pk2(k0[0], k0[1]); ko.y = pk2(k0[2], k0[3]); ko.z = pk2(k1[0], k1[1]); ko.w = pk2(k1[2], k1[3]);
            u32x4 qo; qo.x = pk2(siluf_(lo_bf(rq.x)), siluf_(hi_bf(rq.x))); qo.y = pk2(siluf_(lo_bf(rq.y)), siluf_(hi_bf(rq.y))); qo.z = pk2(siluf_(lo_bf(rq.z)), siluf_(hi_bf(rq.z))); qo.w = pk2(siluf_(lo_bf(rq.w)), siluf_(hi_bf(rq.w)));
            *(LAS u32x4*)(Ks + sr * 136 + ck * 8) = ko; *(LAS u32x4*)(Qs + sr * 136 + ck * 8) = qo;
            *(LAS f32x4*)(Bf + sr * 132 + ck * 8) = g0; *(LAS f32x4*)(Bf + sr * 132 + ck * 8 + 4) = g1; }
        if (more) HG_LOAD_QFV(it + c.G);
        LDS_BARRIER();
        { const int kc = c.tid & 127, q4 = c.tid >> 7; float vals[16]; float cum = 0.f;
#pragma unroll
          for (int i = 0; i < 16; ++i) { cum += Bf[(16 * q4 + i) * 132 + kc]; vals[i] = cum; }
          QT[q4 * 128 + kc] = cum;
          LDS_BARRIER();
          float off = 0.f;
#pragma unroll
          for (int j = 0; j < 3; ++j) off += (j < q4) ? QT[j * 128 + kc] : 0.f;
#pragma unroll
          for (int i = 0; i < 16; ++i) Bf[(16 * q4 + i) * 132 + kc] = vals[i] + off; }
        LDS_BARRIER();
        for (int i = c.tid; i < 48 * 64; i += NTHREADS) { const int rowq = i >> 6, kp = i & 63, ib = (rowq >> 4) + 1, t = 16 + rowq, rref = 16 * ib - 1;
            const unsigned q2 = *(const LAS unsigned*)(Qs + t * 136 + 2 * kp);
            *(LAS unsigned*)(QI3 + rowq * 136 + 2 * kp) = pk2(lo_bf(q2) * __expf(Bf[t * 132 + 2 * kp] - Bf[rref * 132 + 2 * kp]), hi_bf(q2) * __expf(Bf[t * 132 + 2 * kp + 1] - Bf[rref * 132 + 2 * kp + 1])); }
        for (int i = c.tid; i < 96 * 64; i += NTHREADS) { const int rowk = i >> 6, kp = i & 63; const int ib = (rowk < 16) ? 1 : (rowk < 48 ? 2 : 3), s2 = rowk - 8 * ib * (ib - 1), rref = 16 * ib - 1;
            const unsigned k2 = *(const LAS unsigned*)(Ks + s2 * 136 + 2 * kp);
            *(LAS unsigned*)(KKI3 + rowk * 136 + 2 * kp) = pk2(lo_bf(k2) * __expf(Bf[rref * 132 + 2 * kp] - Bf[s2 * 132 + 2 * kp]), hi_bf(k2) * __expf(Bf[rref * 132 + 2 * kp + 1] - Bf[s2 * 132 + 2 * kp + 1])); }
        for (int pidx = c.tid; pidx < 1024; pidx += NTHREADS) {
            const int ib = pidx >> 8, tq = (pidx >> 4) & 15, sq = pidx & 15, t = 16 * ib + tq, s2 = 16 * ib + sq; float a = 0.f;
            if (sq <= tq) {
                for (int k = 0; k < 128; k += 4) {
                    const f32x4 bt = *(const LAS f32x4*)(Bf + t * 132 + k), bs = *(const LAS f32x4*)(Bf + s2 * 132 + k);
                    const u32x2 qv = *(const LAS u32x2*)(Qs + t * 136 + k), kv = *(const LAS u32x2*)(Ks + s2 * 136 + k);
                    a += lo_bf(qv.x) * lo_bf(kv.x) * __expf(bt[0] - bs[0]) + hi_bf(qv.x) * hi_bf(kv.x) * __expf(bt[1] - bs[1])
                       + lo_bf(qv.y) * lo_bf(kv.y) * __expf(bt[2] - bs[2]) + hi_bf(qv.y) * hi_bf(kv.y) * __expf(bt[3] - bs[3]);
                }
            }
            ATT[t * 72 + s2] = (bf16_t)f2bf(a);
        }
        for (int i = c.tid; i < 6 * 256; i += NTHREADS) { const int blk = i >> 8, e = i & 255; const int bi = (blk < 3) ? 0 : (blk < 5 ? 1 : 2), bj = (blk < 3) ? blk + 1 : (blk < 5 ? blk - 1 : 3);
            ATT[(16 * bi + (e >> 4)) * 72 + 16 * bj + (e & 15)] = (bf16_t)0; }
        LDS_BARRIER();
        if (w < 6) {
            const int ib = (w == 0) ? 1 : (w < 3 ? 2 : 3), jb = w - ((ib * (ib - 1)) >> 1);
            f32x4 a4 = (f32x4){0.f, 0.f, 0.f, 0.f};
#pragma unroll
            for (int ks = 0; ks < 4; ++ks) { const bf16x8 afr = *(const LAS bf16x8*)(QI3 + (16 * (ib - 1) + fr) * 136 + ks * 32 + 8 * fq), bfr = *(const LAS bf16x8*)(KKI3 + (8 * ib * (ib - 1) + 16 * jb + fr) * 136 + ks * 32 + 8 * fq); a4 = MFMA16(afr, bfr, a4); }
#pragma unroll
            for (int r = 0; r < 4; ++r) ATT[(16 * ib + 4 * fq + r) * 72 + 16 * jb + fr] = (bf16_t)f2bf(a4[r]);
        }
        for (int i = c.tid; i < 64 * 64; i += NTHREADS) { const int t = i >> 6, kp = i & 63;
            const unsigned q2 = *(const LAS unsigned*)(Qs + t * 136 + 2 * kp);
            *(LAS unsigned*)(Qs + t * 136 + 2 * kp) = pk2(lo_bf(q2) * __expf(Bf[t * 132 + 2 * kp]), hi_bf(q2) * __expf(Bf[t * 132 + 2 * kp + 1])); }
        LDS_BARRIER();
#pragma unroll
        for (int q = 0; q < 4; ++q) { const int i = c.tid + q * NTHREADS; *(LAS u32x4*)(STs + (i >> 4) * 136 + (i & 15) * 8) = pst[q]; }
        if (more) HG_LOAD_ST(it + c.G);
        LDS_BARRIER();
        f32x4 acc[4];
#pragma unroll
        for (int m = 0; m < 4; ++m) acc[m] = (f32x4){0.f, 0.f, 0.f, 0.f};
#pragma unroll
        for (int ks = 0; ks < 4; ++ks) {
            const bf16x8 bfr = *(const LAS bf16x8*)(STs + (16 * w + fr) * 136 + ks * 32 + 8 * fq);
#pragma unroll
            for (int m = 0; m < 4; ++m) { const bf16x8 afr = *(const LAS bf16x8*)(Qs + (16 * m + fr) * 136 + ks * 32 + 8 * fq); acc[m] = MFMA16(afr, bfr, acc[m]); }
        }
#pragma unroll
        for (int ks = 0; ks < 2; ++ks) {
            const bf16x8 bfr = tr_frag(VS, 136, 32 * ks, 16 * w, c.lane);
#pragma unroll
            for (int m = 0; m < 4; ++m) { const bf16x8 afr = *(const LAS bf16x8*)(ATT + (16 * m + fr) * 72 + ks * 32 + 8 * fq); acc[m] = MFMA16(afr, bfr, acc[m]); }
        }
#pragma unroll
        for (int m = 0; m < 4; ++m)
#pragma unroll
            for (int r = 0; r < 4; ++r) Bf[(16 * m + 4 * fq + r) * 132 + 16 * w + fr] = acc[m][r];
        LDS_BARRIER();
        {
            const int t = c.tid >> 3, part = c.tid & 7;
            f32x4 o4[4]; float ss = 0.f;
#pragma unroll
            for (int i = 0; i < 4; ++i) { o4[i] = *(const LAS f32x4*)(Bf + t * 132 + part * 16 + 4 * i); ss += (o4[i][0] * o4[i][0] + o4[i][1] * o4[i][1]) + (o4[i][2] * o4[i][2] + o4[i][3] * o4[i][3]); }
            const u32x4 g0 = *(const u32x4*)(U + (size_t)(tok0 + t) * NU + UHG + h * 128 + part * 16), g1 = *(const u32x4*)(U + (size_t)(tok0 + t) * NU + UHG + h * 128 + part * 16 + 8);
            ss += shfl_xor_l(ss, 1, c.lane); ss += shfl_xor_l(ss, 2, c.lane); ss += shfl_xor_l(ss, 4, c.lane);
            const float rstd = rsqf_(ss * (1.0f / 128.0f) + EPS);
            const float* nwp = nw + h * 128 + part * 16;
            const f32x4 n0 = *(const f32x4*)(nwp), n1 = *(const f32x4*)(nwp + 4), n2 = *(const f32x4*)(nwp + 8), n3 = *(const f32x4*)(nwp + 12);
            u32x4 r0, r1;
            r0.x = pk2(o4[0][0] * rstd * n0[0] * siluf_(lo_bf(g0.x)), o4[0][1] * rstd * n0[1] * siluf_(hi_bf(g0.x))); r0.y = pk2(o4[0][2] * rstd * n0[2] * siluf_(lo_bf(g0.y)), o4[0][3] * rstd * n0[3] * siluf_(hi_bf(g0.y)));
            r0.z = pk2(o4[1][0] * rstd * n1[0] * siluf_(lo_bf(g0.z)), o4[1][1] * rstd * n1[1] * siluf_(hi_bf(g0.z))); r0.w = pk2(o4[1][2] * rstd * n1[2] * siluf_(lo_bf(g0.w)), o4[1][3] * rstd * n1[3] * siluf_(hi_bf(g0.w)));
            r1.x = pk2(o4[2][0] * rstd * n2[0] * siluf_(lo_bf(g1.x)), o4[2][1] * rstd * n2[1] * siluf_(hi_bf(g1.x))); r1.y = pk2(o4[2][2] * rstd * n2[2] * siluf_(lo_bf(g1.y)), o4[2][3] * rstd * n2[3] * siluf_(hi_bf(g1.y)));
            r1.z = pk2(o4[3][0] * rstd * n3[0] * siluf_(lo_bf(g1.z)), o4[3][1] * rstd * n3[1] * siluf_(hi_bf(g1.z))); r1.w = pk2(o4[3][2] * rstd * n3[2] * siluf_(lo_bf(g1.w)), o4[3][3] * rstd * n3[3] * siluf_(hi_bf(g1.w)));
            bf16_t* yo = YC + (size_t)(tok0 + t) * 2048 + 1024 + h * 128 + part * 16;
            *(u32x4*)yo = r0; *(u32x4*)(yo + 8) = r1;
        }
        LDS_BARRIER();
    }
#undef HG_LOAD_QFV
#undef HG_LOAD_ST
}

__device__ __forceinline__ void phase_lru1(const Params& p, const Ctx& c, int l) {
    LAS unsigned char* wl = c.lds + c.wave * 14336;
    LAS bf16_t* XB = (LAS bf16_t*)wl;
    LAS bf16_t* XR = (LAS bf16_t*)(wl + 12032);
    LAS float* As = (LAS float*)(wl + 2304);
    LAS float* Us = (LAS float*)(wl + 2304 + 4096);
    const bf16_t* U = (const bf16_t*)(p.ws + WS_U); bf16_t* LA = (bf16_t*)(p.ws + WS_LA); bf16_t* LH = (bf16_t*)(p.ws + WS_LH);
    const bf16_t* LW = (const bf16_t*)(p.ws + WS_LRUW) + (size_t)l * 2 * 8 * 4096;
    const int fr = c.lane & 15, fq = c.lane >> 4, g = c.wave, chn = g * 64 + c.lane;
    const float cw0 = p.in[I_LCW][(size_t)l * 2048 + chn], cw1 = p.in[I_LCW][(size_t)l * 2048 + 512 + chn], cw2 = p.in[I_LCW][(size_t)l * 2048 + 1024 + chn], cw3 = p.in[I_LCW][(size_t)l * 2048 + 1536 + chn];
    const float cbias = p.in[I_LCB][l * 512 + chn];
    bf16x8 wfa[4][2], wfx[4][2];
#pragma unroll
    for (int n = 0; n < 4; ++n)
#pragma unroll
        for (int ks = 0; ks < 2; ++ks) { wfa[n][ks] = *(const bf16x8*)(LW + (size_t)(0 * 8 + g) * 4096 + (16 * n + fr) * 64 + ks * 32 + 8 * fq);
                                         wfx[n][ks] = *(const bf16x8*)(LW + (size_t)(1 * 8 + g) * 4096 + (16 * n + fr) * 64 + ks * 32 + 8 * fq); }
    float bav[4], bxv[4], spl[4];
#pragma unroll
    for (int n = 0; n < 4; ++n) { const int j = g * 64 + 16 * n + fr; bav[n] = p.in[I_LBA][l * 512 + j]; bxv[n] = p.in[I_LBX][l * 512 + j]; spl[n] = softplusf_(-p.in[I_LLAM][l * 512 + j]); }
    for (int it = c.bid; it < 256; it += c.G) {
        const int seg = it & 31, tok0 = (it >> 5) * SEQ + seg * 64;
        float x0 = 0.f, x1 = 0.f, x2 = 0.f;
        if (seg > 0) { x0 = bf2f(U[(size_t)(tok0 - 3) * NU + ULX + chn]); x1 = bf2f(U[(size_t)(tok0 - 2) * NU + ULX + chn]); x2 = bf2f(U[(size_t)(tok0 - 1) * NU + ULX + chn]); }
        float hrun = 0.f, arun = 1.f;
        u32x4 praw[2];
#pragma unroll
        for (int q = 0; q < 2; ++q) { const int ci = c.lane + 64 * q; praw[q] = *(const u32x4*)(U + (size_t)(tok0 + (ci >> 3)) * NU + ULX + g * 64 + (ci & 7) * 8); }
        for (int st = 0; st < 4; ++st) {
            const int t0 = tok0 + st * 16;
#pragma unroll
            for (int q = 0; q < 2; ++q) { const int ci = c.lane + 64 * q; *(LAS u32x4*)(XR + (ci >> 3) * 72 + (ci & 7) * 8) = praw[q]; }
            if (st < 3) {
#pragma unroll
                for (int q = 0; q < 2; ++q) { const int ci = c.lane + 64 * q; praw[q] = *(const u32x4*)(U + (size_t)(t0 + 16 + (ci >> 3)) * NU + ULX + g * 64 + (ci & 7) * 8); } }
            LDS_WAIT();
#pragma unroll
            for (int tt = 0; tt < 16; ++tt) { const float xr = bf2f(XR[tt * 72 + c.lane]);
                const float xb = cbias + cw0 * x0 + cw1 * x1 + cw2 * x2 + cw3 * xr; x0 = x1; x1 = x2; x2 = xr;
                XB[tt * 72 + c.lane] = (bf16_t)f2bf(xb); }
            LDS_WAIT();
            f32x4 ar[4], ai[4];
#pragma unroll
            for (int n = 0; n < 4; ++n) { ar[n] = (f32x4){0.f, 0.f, 0.f, 0.f}; ai[n] = (f32x4){0.f, 0.f, 0.f, 0.f}; }
#pragma unroll
            for (int ks = 0; ks < 2; ++ks) { const bf16x8 afr = *(const LAS bf16x8*)(XB + fr * 72 + ks * 32 + 8 * fq);
#pragma unroll
                for (int n = 0; n < 4; ++n) { ar[n] = MFMA16(afr, wfa[n][ks], ar[n]); ai[n] = MFMA16(afr, wfx[n][ks], ai[n]); } }
#pragma unroll
            for (int n = 0; n < 4; ++n)
#pragma unroll
                for (int r = 0; r < 4; ++r) { const int t = 4 * fq + r, j = 16 * n + fr;
                    const float rg = sigmoidf_(ar[n][r] + bav[n]), ig = sigmoidf_(ai[n][r] + bxv[n]);
                    const float la = -8.0f * rg * spl[n], a = __expf(la), mult = __builtin_amdgcn_sqrtf(fmaxf(fmaf(-a, a, 1.0f), 0.f));
                    As[t * 64 + j] = a; Us[t * 64 + j] = mult * ig * bf2f(XB[t * 72 + j]); }
            LDS_WAIT();
#pragma unroll
            for (int tt = 0; tt < 16; ++tt) { const float a = As[tt * 64 + c.lane], uu = Us[tt * 64 + c.lane];
                hrun = a * hrun + uu; arun = a * arun;
                LA[(size_t)(t0 + tt) * 512 + chn] = (bf16_t)f2bf(arun); LH[(size_t)(t0 + tt) * 512 + chn] = (bf16_t)f2bf(hrun); }
            LDS_WAIT();
        }
    }
}
__device__ __forceinline__ void phase_lru2(const Params& p, const Ctx& c, int l) {
    LAS float* YS = (LAS float*)c.lds;
    LAS float* RS = (LAS float*)(c.lds + 64 * 516 * 4);
    const bf16_t* U = (const bf16_t*)(p.ws + WS_U); const bf16_t* LA = (const bf16_t*)(p.ws + WS_LA); const bf16_t* LH = (const bf16_t*)(p.ws + WS_LH);
    bf16_t* YC = (bf16_t*)(p.ws + WS_YCAT);
    const int g = c.wave, chn = g * 64 + c.lane;
    const float nwv = p.in[I_LNW][l * 512 + chn];
    for (int it = c.bid; it < 256; it += c.G) {
        const int seg = it & 31, b = it >> 5, tok0 = b * SEQ + seg * 64;
        float hin = 0.f;
        for (int s2 = 0; s2 < seg; ++s2) { const size_t row = (size_t)(b * SEQ + s2 * 64 + 63); hin = bf2f(LH[row * 512 + chn]) + bf2f(LA[row * 512 + chn]) * hin; }
#pragma unroll 8
        for (int tt = 0; tt < 64; ++tt) { const size_t tok = (size_t)(tok0 + tt);
            const float hh = bf2f(LH[tok * 512 + chn]) + bf2f(LA[tok * 512 + chn]) * hin;
            YS[tt * 516 + chn] = hh * gelu_tanhf_(bf2f(U[tok * NU + ULG + chn])); }
        LDS_BARRIER();
        {
            const int t = c.tid >> 3, part = c.tid & 7; float ss = 0.f;
#pragma unroll
            for (int i = 0; i < 16; ++i) { const f32x4 v = *(const LAS f32x4*)(YS + t * 516 + 32 * i + 4 * part); ss += (v[0] * v[0] + v[1] * v[1]) + (v[2] * v[2] + v[3] * v[3]); }
            ss += shfl_xor_l(ss, 1, c.lane); ss += shfl_xor_l(ss, 2, c.lane); ss += shfl_xor_l(ss, 4, c.lane);
            if (part == 0) RS[t] = rsqf_(ss * (1.0f / 512.0f) + EPS);
        }
        LDS_BARRIER();
#pragma unroll 8
        for (int tt = 0; tt < 64; ++tt) YC[(size_t)(tok0 + tt) * 2048 + 1536 + chn] = (bf16_t)f2bf(YS[tt * 516 + chn] * RS[tt] * nwv);
        LDS_BARRIER();
    }
}

__device__ __forceinline__ void phase_norm_router(const Params& p, const Ctx& c, int l, const float* xin) {
    constexpr int HSTR = 1028;
    LAS float* HS = (LAS float*)c.lds;
    LAS float* PL = (LAS float*)(c.lds + 16 * HSTR * 4);
    LAS float* LG = (LAS float*)(c.lds + 16 * HSTR * 4 + 32768);
    const float* mod = (const float*)(p.ws + WS_MOD) + (size_t)l * 8 * NMOD;
    const float* nw = p.in[I_NFFN] + (size_t)l * DM;
    const float* WT = (const float*)(p.ws + WS_WRT) + (size_t)l * 64 * 1024;
    const float rbias = p.in[I_RB][l * NEXP + c.lane];
    bf16_t* H = (bf16_t*)(p.ws + WS_H);
    unsigned long long* selm = (unsigned long long*)(p.ws + WS_SELM); float* rw = (float*)(p.ws + WS_RW);
    const int fr = c.lane & 15, fq = c.lane >> 4, w = c.wave;
    int* cnt = (int*)(p.ws + WS_CNT);
    bf16x8 bhi[4][4], blo[4][4];
#pragma unroll
    for (int j = 0; j < 4; ++j)
#pragma unroll
        for (int n = 0; n < 4; ++n) { const float* wp = WT + (size_t)(16 * n + fr) * 1024 + 128 * w + 32 * j + 8 * fq; const f32x4 x0 = *(const f32x4*)wp, x1 = *(const f32x4*)(wp + 4);
            split_bf16(x0, x1, bhi[j][n], blo[j][n]); }
    int ecount = 0;
    f32x4 xn[2][4];
    if (c.bid < NTOK / 16) {
#pragma unroll
        for (int q = 0; q < 2; ++q)
#pragma unroll
            for (int j = 0; j < 4; ++j) xn[q][j] = ((const f32x4*)(xin + (size_t)(c.bid * 16 + 2 * w + q) * DM) + c.lane)[64 * j];
    }
    for (int t16 = c.bid; t16 < NTOK / 16; t16 += c.G) {
        const int tokb = t16 * 16, b = tokb >> 11;
        f32x4 pa[4], pb[4];
#pragma unroll
        for (int j = 0; j < 4; ++j) { const int col = 256 * j + 4 * c.lane;
            const f32x4 w4 = *(const f32x4*)(nw + col), sc = *(const f32x4*)(mod + (size_t)b * NMOD + 4096 + col); pb[j] = *(const f32x4*)(mod + (size_t)b * NMOD + 3072 + col); pa[j] = w4 * (sc + 1.0f); }
#pragma unroll
        for (int q = 0; q < 2; ++q) {
            const int tl = 2 * w + q, tok = tokb + tl;
            f32x4 v[4]; float ss = 0.f;
#pragma unroll
            for (int j = 0; j < 4; ++j) { v[j] = xn[q][j]; ss += (v[j][0] * v[j][0] + v[j][1] * v[j][1]) + (v[j][2] * v[j][2] + v[j][3] * v[j][3]); }
            const float rstd = rsqf_(wave_sum(ss, c.lane) * (1.0f / DM) + EPS);
#pragma unroll
            for (int j = 0; j < 4; ++j) {
                const int col = 256 * j + 4 * c.lane;
                const f32x4 h = (v[j] * rstd) * pa[j] + pb[j];
                u32x2 o; o.x = pk2(h[0], h[1]); o.y = pk2(h[2], h[3]);
                *(u32x2*)(H + (size_t)tok * DM + col) = o;
                *(LAS f32x4*)(HS + tl * HSTR + col) = h;
            }
        }
        if (t16 + c.G < NTOK / 16) {
#pragma unroll
            for (int q = 0; q < 2; ++q)
#pragma unroll
                for (int j = 0; j < 4; ++j) xn[q][j] = ((const f32x4*)(xin + (size_t)((t16 + c.G) * 16 + 2 * w + q) * DM) + c.lane)[64 * j];
        }
        LDS_BARRIER();
        {
            f32x4 acc[4];
#pragma unroll
            for (int n = 0; n < 4; ++n) acc[n] = (f32x4){0.f, 0.f, 0.f, 0.f};
#pragma unroll
            for (int j = 0; j < 4; ++j) {
                const int kk = 128 * w + 32 * j + 8 * fq;
                const f32x4 a0 = *(const LAS f32x4*)(HS + fr * HSTR + kk), a1 = *(const LAS f32x4*)(HS + fr * HSTR + kk + 4);
                bf16x8 ahi, alo; split_bf16(a0, a1, ahi, alo);
#pragma unroll
                for (int n = 0; n < 4; ++n) { acc[n] = MFMA16(ahi, bhi[j][n], acc[n]); acc[n] = MFMA16(ahi, blo[j][n], acc[n]); acc[n] = MFMA16(alo, bhi[j][n], acc[n]); }
            }
#pragma unroll
            for (int n = 0; n < 4; ++n)
#pragma unroll
                for (int r = 0; r < 4; ++r) PL[(w * 16 + 4 * fq + r) * 64 + 16 * n + fr] = acc[n][r];
        }
        LDS_BARRIER();
        for (int i = c.tid; i < 1024; i += NTHREADS) { float s2 = 0.f;
#pragma unroll
            for (int ww = 0; ww < 8; ++ww) s2 += PL[ww * 1024 + i];
            LG[i] = s2; }
        LDS_BARRIER();
#pragma unroll
        for (int q = 0; q < 2; ++q) {
            const int tl = 2 * w + q, tok = tokb + tl;
            const float s = sigmoidf_(LG[tl * 64 + c.lane]), v = s + rbias;
            float m1 = v;
            m1 = fmaxf(m1, shfl_xor_l(m1, 1, c.lane)); m1 = fmaxf(m1, shfl_xor_l(m1, 2, c.lane)); m1 = fmaxf(m1, shfl_xor_l(m1, 4, c.lane));
            const unsigned long long eq = __ballot(v == m1);
            const int gbase = c.lane & ~7;
            const unsigned gm = (unsigned)((eq >> gbase) & 0xffull);
            const int first = gbase + __builtin_ctz(gm);
            float m2 = (c.lane == first) ? -3.0e38f : v;
            m2 = fmaxf(m2, shfl_xor_l(m2, 1, c.lane)); m2 = fmaxf(m2, shfl_xor_l(m2, 2, c.lane)); m2 = fmaxf(m2, shfl_xor_l(m2, 4, c.lane));
            const float gs = m1 + m2;
            const int mygrp = c.lane >> 3; int grank = 0;
#pragma unroll
            for (int g2 = 0; g2 < 8; ++g2) { const float o = rdlane_f(gs, g2 * 8); grank += (o > gs || (o == gs && g2 < mygrp)) ? 1 : 0; }
            const float vm = (grank < 4) ? v : -1.0e4f;
            int erank = 0;
            for (int e2 = 0; e2 < 64; ++e2) { const float o = rdlane_f(vm, e2); erank += (int)(o > vm) + (int)((o == vm) & (e2 < c.lane)); }
            const bool sel = erank < TOPK;
            const unsigned long long mask = __ballot(sel);
            const float wsum = wave_sum(sel ? s : 0.f, c.lane);
            if (sel) { const int kk = __builtin_popcountll(mask & ((1ull << c.lane) - 1ull)); rw[(size_t)tok * 8 + kk] = s * rcpf_(wsum) * 2.5f; }
            if (c.lane == 0) selm[tok] = mask;
            ecount += sel ? 1 : 0;
        }
        LDS_BARRIER();
    }
    { LAS int* CW = (LAS int*)c.lds; CW[w * 64 + c.lane] = ecount; LDS_BARRIER();
      if (w == 0) { int tot = 0;
#pragma unroll
          for (int ww = 0; ww < 8; ++ww) tot += CW[ww * 64 + c.lane];
          cnt[c.bid * 64 + c.lane] = tot; }
      LDS_BARRIER(); }
}
__device__ __forceinline__ void phase_route_assign(const Params& p, const Ctx& c) {
    const unsigned long long* selm = (const unsigned long long*)(p.ws + WS_SELM); const int* cnt = (const int*)(p.ws + WS_CNT);
    int* slot_tok = (int*)(p.ws + WS_SLOTTOK); int* slot_of = (int*)(p.ws + WS_SLOTOF); int* rinfo = (int*)(p.ws + WS_RINFO);
    LAS int* PT = (LAS int*)c.lds;
    LAS int* PB = PT + 512;
    LAS int* TC = PB + 512;
    const int w = c.wave, ntile = (NTOK / 16 + c.G - 1) / c.G;
    for (int ch = c.bid; ch < c.G; ch += c.G) {
        { int tot = 0, bef = 0; const int per = (c.G + 7) / 8;
#pragma unroll 8
          for (int jj = 0; jj < per; ++jj) { const int j = w * per + jj; const int v = (j < c.G) ? cnt[j * 64 + c.lane] : 0; tot += v; bef += (j < ch) ? v : 0; }
          PT[w * 64 + c.lane] = tot; PB[w * 64 + c.lane] = bef; }
        const int t16 = ch + w * c.G; const bool have = (w < ntile) && (t16 < NTOK / 16);
        unsigned long long mine = 0ull; int tcount = 0;
        if (have) { mine = (c.lane < 16) ? selm[t16 * 16 + c.lane] : 0ull;
            for (int i = 0; i < 16; ++i) { const unsigned long long m = rdlane_u64(mine, i); tcount += (int)((m >> c.lane) & 1ull); } }
        TC[w * 64 + c.lane] = tcount;
        LDS_BARRIER();
        int total = 0, before = 0;
#pragma unroll
        for (int ww = 0; ww < 8; ++ww) { total += PT[ww * 64 + c.lane]; before += PB[ww * 64 + c.lane]; }
        const int pad = (total + 255) & ~255;
        int incl = pad;
#pragma unroll
        for (int o = 1; o < 64; o <<= 1) { const int t = shfl_up_l(incl, o, c.lane); if (c.lane >= o) incl += t; }
        const int pstart = incl - pad;
        if (have) {
            int run = pstart + before;
            for (int ww = 0; ww < w; ++ww) run += TC[ww * 64 + c.lane];
            for (int i = 0; i < 16; ++i) {
                const unsigned long long m = rdlane_u64(mine, i); const int tok = t16 * 16 + i;
                if ((m >> c.lane) & 1ull) { const int kk = __builtin_popcountll(m & ((1ull << c.lane) - 1ull)); slot_tok[run] = tok; slot_of[tok * 8 + kk] = run; ++run; }
            }
        }
        if (ch == 0 && w == 7) {
            for (int s2 = pstart + total; s2 < pstart + pad; ++s2) slot_tok[s2] = -1;
            for (int bk = pstart >> 8; bk < (pstart + pad) >> 8; ++bk) rinfo[64 + bk] = c.lane;
            if (c.lane == 63) rinfo[0] = incl >> 8;
        }
        LDS_BARRIER();
    }
}
__device__ __forceinline__ void phase_combine(const Params& p, const Ctx& c, int l) {
    const float* gate = (const float*)(p.ws + WS_MOD) + (size_t)l * 8 * NMOD + 5120;
    const unsigned char* Y = (const unsigned char*)(p.ws + WS_Y); const unsigned char* YS = (const unsigned char*)(p.ws + WS_YSH); const int* slot_of = (const int*)(p.ws + WS_SLOTOF); const float* rw = (const float*)(p.ws + WS_RW);
    const float* fw = p.in[I_FNW];
    if (l + 1 < NLAYER) load_wdt(p, c, l + 1, (LAS float*)c.lds);
    const int gw = c.bid * NWAVES + c.wave, NGW = c.G * NWAVES;
    int sln[8]; float wkn[8];
#pragma unroll
    for (int k = 0; k < 8; ++k) { sln[k] = (gw < NTOK) ? slot_of[gw * 8 + k] : 0; wkn[k] = (gw < NTOK) ? rw[gw * 8 + k] : 0.f; }
    for (int tok = gw; tok < NTOK; tok += NGW) {
        const int b = tok >> 11;
        f32x4 acc[4], gvv[4], xv0[4];
        f32x4* xr = (f32x4*)(p.out + (size_t)tok * DM) + c.lane;
        int slc[8]; float wkc[8];
#pragma unroll
        for (int k = 0; k < 8; ++k) { slc[k] = sln[k]; wkc[k] = wkn[k] * Y8_INV; }
#pragma unroll
        for (int j = 0; j < 4; ++j) { acc[j] = (f32x4){0.f, 0.f, 0.f, 0.f}; gvv[j] = *(const f32x4*)(gate + (size_t)b * NMOD + 256 * j + 4 * c.lane); xv0[j] = xr[64 * j]; }
        int yraw[8][4];
#pragma unroll
        for (int k = 0; k < 8; ++k)
#pragma unroll
            for (int j = 0; j < 4; ++j) yraw[k][j] = (int)*(const unsigned*)(Y + (size_t)slc[k] * DM + 256 * j + 4 * c.lane);
        if (tok + NGW < NTOK) {
#pragma unroll
            for (int k = 0; k < 8; ++k) { sln[k] = slot_of[(tok + NGW) * 8 + k]; wkn[k] = rw[(tok + NGW) * 8 + k]; } }
#pragma unroll
        for (int k = 0; k < 8; ++k) { const float wk = wkc[k];
#pragma unroll
            for (int j = 0; j < 4; ++j) { const int yw = yraw[k][j];
                const f32x2 y01 = __builtin_amdgcn_cvt_pk_f32_fp8(yw, false), y23 = __builtin_amdgcn_cvt_pk_f32_fp8(yw, true);
                acc[j][0] += wk * y01[0]; acc[j][1] += wk * y01[1]; acc[j][2] += wk * y23[0]; acc[j][3] += wk * y23[1]; } }
#pragma unroll
        for (int j = 0; j < 4; ++j) { const int yw = (int)*(const unsigned*)(YS + (size_t)tok * DM + 256 * j + 4 * c.lane);
            const f32x2 y01 = __builtin_amdgcn_cvt_pk_f32_fp8(yw, false), y23 = __builtin_amdgcn_cvt_pk_f32_fp8(yw, true);
            acc[j][0] += Y8_INV * y01[0]; acc[j][1] += Y8_INV * y01[1]; acc[j][2] += Y8_INV * y23[0]; acc[j][3] += Y8_INV * y23[1]; }
        f32x4 v[4]; float ss = 0.f;
#pragma unroll
        for (int j = 0; j < 4; ++j) { v[j] = xv0[j] + gvv[j] * acc[j];
            ss += (v[j][0] * v[j][0] + v[j][1] * v[j][1]) + (v[j][2] * v[j][2] + v[j][3] * v[j][3]); }
        if (l == NLAYER - 1) {
            const float rstd = rsqf_(wave_sum(ss, c.lane) * (1.0f / DM) + EPS);
#pragma unroll
            for (int j = 0; j < 4; ++j) { const f32x4 w4 = *(const f32x4*)(fw + 256 * j + 4 * c.lane); xr[64 * j] = v[j] * rstd * w4; }
        } else {
#pragma unroll
            for (int j = 0; j < 4; ++j) xr[64 * j] = v[j];
            norm_mix_row(c, v, ss, tok, p.in[I_NMIX] + (size_t)(l + 1) * DM, (const float*)(p.ws + WS_MOD) + (size_t)(l + 1) * 8 * NMOD, (const LAS float*)c.lds, (bf16_t*)(p.ws + WS_H), (float*)(p.ws + WS_DTRAW));
        }
    }
}


#define XB_TMO      128
#define XB_XCNT(j)  (256  + 64 * (j))
#define XB_XSUB(j)  (1280 + 64 * (j))
#define XB_XGEN(j)  (2304 + 64 * (j))
#define XB_TOP      3328
#define XB_TOPGEN   3392
#define XCD_BAR_WORDS 3456
#define XB_SPIN_CAP (1u << 18)
constexpr int LDS_XBST = LDS_PTAB + 320;
__device__ __forceinline__ unsigned xb_ld(unsigned* p)              { return __hip_atomic_load(p, __ATOMIC_RELAXED, __HIP_MEMORY_SCOPE_AGENT); }
__device__ __forceinline__ unsigned xb_add(unsigned* p, unsigned v) { return __hip_atomic_fetch_add(p, v, __ATOMIC_RELAXED, __HIP_MEMORY_SCOPE_AGENT); }
__device__ __forceinline__ unsigned xb_xcc_id() { return (unsigned)__builtin_amdgcn_s_getreg((3 << 11) | 20) & 0xFu; }
#define XB_SPIN(cond, bar) do { unsigned _sp = 0; while (cond) { __builtin_amdgcn_s_sleep(1); \
    if ((++_sp & 255u) == 0u) { if (xb_ld(&(bar)[XB_TMO])) break; if (_sp > XB_SPIN_CAP) { atomicAdd(&(bar)[XB_TMO], 1u); break; } } } } while (0)
__device__ __forceinline__ void xcd_barrier_complete(unsigned* bar, unsigned x, unsigned& nloc, unsigned& nx) {
    const unsigned G = gridDim.x * gridDim.y * gridDim.z;
    unsigned sum, cnt, mine, sp = 0u;
    for (;;) {
        sum = 0u; cnt = 0u; mine = 0u;
#pragma unroll
        for (unsigned j = 0; j < 16; ++j) { const unsigned c = xb_ld(&bar[XB_XCNT(j)]); sum += c; cnt += (c > 0u) ? 1u : 0u; mine = (j == x) ? c : mine; }
        if (sum == G) break;
        __builtin_amdgcn_s_sleep(1);
        if ((++sp & 255u) == 0u) { if (xb_ld(&bar[XB_TMO])) break; if (sp > XB_SPIN_CAP) { atomicAdd(&bar[XB_TMO], 1u); break; } }
    }
    nloc = mine > 0u ? mine : 1u; nx = cnt > 0u ? cnt : 1u;
}
__device__ __forceinline__ void xcd_barrier(unsigned* bar, volatile LAS unsigned* st, bool leader_thread) {
    asm volatile("s_waitcnt vmcnt(0)" ::: "memory");
    __syncthreads();
    if (leader_thread) {
        const unsigned x = xb_xcc_id();
        __builtin_amdgcn_s_waitcnt(0);
        unsigned nloc = st[0], nx = st[1];
        if (nloc == 0u) { xcd_barrier_complete(bar, x, nloc, nx); st[0] = nloc; st[1] = nx; }
        const unsigned old = xb_add(&bar[XB_XSUB(x)], 1u);
        const unsigned gen = old / nloc;
        if (old + 1u == (gen + 1u) * nloc) {
            __builtin_amdgcn_fence(__ATOMIC_RELEASE, "agent");
            asm volatile("s_waitcnt vmcnt(0)" ::: "memory");
            const unsigned og = xb_add(&bar[XB_TOP], 1u);
            const unsigned tg = og / nx;
            if (og + 1u == (tg + 1u) * nx) xb_add(&bar[XB_TOPGEN], 1u);
            else XB_SPIN(xb_ld(&bar[XB_TOPGEN]) == tg, bar);
            __builtin_amdgcn_fence(__ATOMIC_ACQUIRE, "agent");
            xb_add(&bar[XB_XGEN(x)], 1u);
            asm volatile("s_waitcnt vmcnt(0)" ::: "memory");
        } else {
            XB_SPIN(xb_ld(&bar[XB_XGEN(x)]) == gen, bar);
            __builtin_amdgcn_fence(__ATOMIC_ACQUIRE, "agent");
            asm volatile("s_waitcnt vmcnt(0)" ::: "memory");
        }
    }
    __syncthreads();
}

#ifndef PROBE_ID
#define PROBE_ID 0
#endif
#define RUN(id, stmt) do { stmt; if constexpr (PROBE_ID == (id)) { __syncthreads(); stmt; } } while (0)
constexpr int NQ_PHASE = 14;
__device__ __forceinline__ unsigned long long uni64(unsigned long long v) {
    const unsigned lo = (unsigned)__builtin_amdgcn_readfirstlane((int)(unsigned)v), hi = (unsigned)__builtin_amdgcn_readfirstlane((int)(unsigned)(v >> 32)); return ((unsigned long long)hi << 32) | lo; }
#if MK_MEGA
__device__ __forceinline__ void params_to_lds(const Params& p, LAS unsigned char* lds) {
    LAS unsigned long long* tab = (LAS unsigned long long*)(lds + LDS_PTAB);
#pragma unroll
    for (int i = 0; i < 33; ++i) tab[i] = (unsigned long long)p.in[i];
    tab[33] = (unsigned long long)p.out; tab[34] = (unsigned long long)p.ws;
}
__device__ __forceinline__ Params params_from_lds(LAS unsigned char* lds) {
    const LAS unsigned long long* tab = (const LAS unsigned long long*)(lds + LDS_PTAB);
    Params p;
#pragma unroll
    for (int i = 0; i < 33; ++i) p.in[i] = (const float*)(const __attribute__((address_space(1))) float*)uni64(tab[i]);
    p.out = (float*)(__attribute__((address_space(1))) float*)uni64(tab[33]); p.ws = (unsigned char*)(__attribute__((address_space(1))) unsigned char*)uni64(tab[34]); p.layer = 0; p.pad = 0;
    return p;
}
#endif
template <int Q> __device__ __forceinline__ void run_q(const Params& p_in, const Ctx& c_in, int l) {
    Ctx c = c_in;
    asm volatile("" : "+s"(c.wave), "+s"(c.bid), "+s"(c.G), "+s"(l));
    c.lane = fresh_lane(); c.tid = c.wave * 64 + c.lane;
#if MK_MEGA
    const Params p = params_from_lds(c.lds);
#else
    const Params& p = p_in;
#endif
    const float* xin = (l == 0) ? p.in[I_X] : p.out;
    if constexpr (Q == 14) { RUN(1, phase_prep_io(p, c); __syncthreads(); phase_prep_small(p, c)); __syncthreads(); RUN(2, phase_prep_experts(p, c, 0)); }
    if constexpr (Q == 0) { RUN(3, phase_norm_mix(p, c, l, xin)); }
    if constexpr (Q == 1) { pg8::Gemm g{(const bf16_t*)(p.ws + WS_H), (const bf16_t*)(p.ws + WS_WIN) + (size_t)l * NU * DM, DM, 0};
              pg8::DenseOrder S; S.init(NTOK, NU, c.G, c.bid); EpiU E{(bf16_t*)(p.ws + WS_U), NU};
              RUN(4, (pg8::gemm_phase<EpiU, pg8::DenseOrder, pg8::DenseRows, true, true>(c.lds, g, S, E, pg8::DenseRows(), c.wave))); }
    if constexpr (Q == 2) { RUN(5, phase_ssd_conv(p, c, l)); __syncthreads(); RUN(6, phase_hg_state(p, c, l)); __syncthreads(); RUN(7, phase_lru1(p, c, l)); }
    if constexpr (Q == 3) { RUN(8, phase_ssd_state(p, c)); __syncthreads(); phase_hg_scan(p, c); __syncthreads(); RUN(9, phase_lru2(p, c, l)); }
    if constexpr (Q == 4) { phase_ssd_scan(p, c); __syncthreads(); RUN(10, phase_hg_out(p, c, l)); }
    if constexpr (Q == 5) RUN(11, phase_ssd_out_g(p, c, l));
    if constexpr (Q == 7) { pg8::Gemm g{(const bf16_t*)(p.ws + WS_YCAT), (const bf16_t*)(p.ws + WS_WOUT) + (size_t)l * DM * 2048, 2048, 0};
              pg8::DenseOrder S; S.init(NTOK, DM, c.G, c.bid); EpiOut E{xin, p.out, (const float*)(p.ws + WS_MOD) + (size_t)l * 8 * NMOD + 2048};
              pg8::gemm_phase<EpiOut, pg8::DenseOrder, pg8::DenseRows, false, true>(c.lds, g, S, E, pg8::DenseRows(), c.wave);
              if constexpr (PROBE_ID == 13) { if (l == 0) { __syncthreads(); pg8::gemm_phase<EpiOut, pg8::DenseOrder, pg8::DenseRows, false, true>(c.lds, g, S, E, pg8::DenseRows(), c.wave); } } }
    if constexpr (Q == 8) RUN(14, phase_norm_router(p, c, l, p.out));
    if constexpr (Q == 9) RUN(15, phase_route_assign(p, c));
    if constexpr (Q == 11) { pg8::Gemm g{(const bf16_t*)(p.ws + WS_H), (const bf16_t*)(p.ws + WS_GU), DM, (size_t)512 * DM * 2};
               moe_build_units(c.lds, (const int*)(p.ws + WS_RINFO), 2, c.G, (c.G % 8 == 0) ? (c.bid % 8) * (c.G / 8) + c.bid / 8 : c.bid, c.tid);
               MoeOrder S{(const LAS int*)(c.lds + LDS_UTAB)}; EpiH E{(bf16_t*)(p.ws + WS_HMID)};
               GatherRows AM{(const int*)(p.ws + WS_SLOTTOK), (const int*)(p.ws + WS_RINFO)};
               RUN(16, (pg8::gemm_phase<EpiH, MoeOrder, GatherRows, true, true>(c.lds, g, S, E, AM, c.wave))); }
    if constexpr (Q == 12) { pg8::Gemm g{(const bf16_t*)(p.ws + WS_HMID), (const bf16_t*)(p.ws + WS_DN), 256, (size_t)DM * 256 * 2};
               moe_build_units(c.lds, (const int*)(p.ws + WS_RINFO), 4, c.G, (c.G % 8 == 0) ? (c.bid % 8) * (c.G / 8) + c.bid / 8 : c.bid, c.tid);
               MoeOrder S{(const LAS int*)(c.lds + LDS_UTAB)};
               EpiY E{(unsigned char*)(p.ws + WS_Y), (unsigned char*)(p.ws + WS_YSH), (const int*)(p.ws + WS_RINFO)};
               RUN(17, (pg8::gemm_phase<EpiY, MoeOrder, pg8::DenseRows, true, true>(c.lds, g, S, E, pg8::DenseRows(), c.wave))); }
    if constexpr (Q == 13) { phase_combine(p, c, l); if (l + 1 < NLAYER) { __syncthreads(); RUN(2, phase_prep_experts(p, c, l + 1)); } }
}

#if MK_MEGA
__global__ void __launch_bounds__(NTHREADS, 2) trunk_kernel(Params p) {
    extern __shared__ __attribute__((aligned(16))) unsigned char lds_raw[];
    Ctx c; c.lds = (LAS unsigned char*)lds_raw; c.tid = 0; c.lane = 0; c.wave = __builtin_amdgcn_readfirstlane(threadIdx.x >> 6); c.G = gridDim.x; c.bid = blockIdx.x;
    cg::grid_group grid = cg::this_grid();
    unsigned* const xbar = (unsigned*)(p.ws + WS_CTL) + 4096;
    if (threadIdx.x == 0) { params_to_lds(p, c.lds); ((LAS unsigned*)(c.lds + LDS_XBST))[0] = 0u; ((LAS unsigned*)(c.lds + LDS_XBST))[1] = 0u; ((LAS unsigned long long*)(c.lds + LDS_PTAB))[35] = (unsigned long long)xbar;
                            (void)xb_add(&xbar[XB_XCNT(xb_xcc_id())], 1u); }
    __syncthreads();
#define GSYNC1() do { unsigned* bar_ = (unsigned*)(__attribute__((address_space(1))) unsigned*)uni64(((const LAS unsigned long long*)(c.lds + LDS_PTAB))[35]); \
        xcd_barrier(bar_, (volatile LAS unsigned*)(c.lds + LDS_XBST), (c.wave == 0) && (fresh_lane() == 0)); } while (0)
#define GSYNC() do { GSYNC1(); if constexpr (PROBE_ID == 18) GSYNC1(); } while (0)
#define LAYER(l) do { \
        if ((l) == 0) { run_q<0>(p, c, l); GSYNC(); } run_q<1>(p, c, l); GSYNC(); run_q<2>(p, c, l); GSYNC(); run_q<3>(p, c, l); GSYNC(); run_q<4>(p, c, l); GSYNC(); \
        run_q<5>(p, c, l); GSYNC(); run_q<7>(p, c, l); GSYNC(); run_q<8>(p, c, l); GSYNC(); run_q<9>(p, c, l); GSYNC(); \
        run_q<11>(p, c, l); GSYNC(); run_q<12>(p, c, l); GSYNC(); run_q<13>(p, c, l); } while (0)
    run_q<14>(p, c, 0); __syncthreads(); grid.sync();
    LAYER(0); GSYNC();
    LAYER(1);
}
#else
template <int Q> __global__ void __launch_bounds__(NTHREADS, 2) phase_kernel(Params p) {
    extern __shared__ __attribute__((aligned(16))) unsigned char lds_raw[];
    Ctx c; c.lds = (LAS unsigned char*)lds_raw; c.tid = 0; c.lane = 0; c.wave = __builtin_amdgcn_readfirstlane(threadIdx.x >> 6); c.G = gridDim.x; c.bid = blockIdx.x;
    run_q<Q>(p, c, p.layer);
}
template <int Q> static void launch_q(const Params& p, int grid, hipStream_t stream) {
    static bool attr = false;
    if (!attr) { (void)hipFuncSetAttribute((const void*)phase_kernel<Q>, hipFuncAttributeMaxDynamicSharedMemorySize, LDS_BYTES); attr = true; }
    hipLaunchKernelGGL(phase_kernel<Q>, dim3(grid), dim3(NTHREADS), LDS_BYTES, stream, p);
}
#endif

extern "C" void kernel_launch(void* const* d_in, const int* in_sizes, int n_in, void* d_out, int out_size, void* d_ws, size_t ws_size, hipStream_t stream) {
    static int grid = 0;
    if (grid == 0) {
        if (n_in != 33 || out_size != NTOK * DM || ws_size < WS_END) { fprintf(stderr, "kernel_launch: unexpected shapes (n_in %d out %d ws %zu)\n", n_in, out_size, ws_size); grid = -1; return; }
        int dev = 0, cus = 0;
        (void)hipGetDevice(&dev); (void)hipDeviceGetAttribute(&cus, hipDeviceAttributeMultiprocessorCount, dev);
        grid = cus > 0 ? cus : 256;
#if MK_MEGA
        int per_cu = 0;
        if (hipFuncSetAttribute((const void*)trunk_kernel, hipFuncAttributeMaxDynamicSharedMemorySize, LDS_BYTES) != hipSuccess) { fprintf(stderr, "kernel_launch: hipFuncSetAttribute failed\n"); grid = -1; return; }
        if (hipOccupancyMaxActiveBlocksPerMultiprocessor(&per_cu, (const void*)trunk_kernel, NTHREADS, LDS_BYTES) != hipSuccess || per_cu < 1) { fprintf(stderr, "kernel_launch: occupancy query says %d blocks/CU\n", per_cu); grid = -1; return; }
        (void)hipGetLastError();
#endif
    }
    if (grid < 0) return;
    (void)hipMemsetAsync((char*)d_ws + WS_CTL, 0, CTL_ZERO_BYTES, stream);
    Params p{};
    for (int i = 0; i < 33; ++i) p.in[i] = (const float*)d_in[i];
    p.out = (float*)d_out; p.ws = (unsigned char*)d_ws;
#if MK_MEGA
    void* args[] = {&p};
    hipError_t e = hipLaunchCooperativeKernel((const void*)trunk_kernel, dim3(grid), dim3(NTHREADS), args, LDS_BYTES, stream);
    if (e != hipSuccess) fprintf(stderr, "cooperative launch failed: %s (grid %d)\n", hipGetErrorString(e), grid);
#else
    p.layer = 0; launch_q<14>(p, grid, stream);
    for (int l = 0; l < NLAYER; ++l) {
        p.layer = l;
        launch_q<0>(p, grid, stream); launch_q<1>(p, grid, stream); launch_q<2>(p, grid, stream); launch_q<3>(p, grid, stream); launch_q<4>(p, grid, stream);
        launch_q<5>(p, grid, stream); launch_q<6>(p, grid, stream); launch_q<7>(p, grid, stream); launch_q<8>(p, grid, stream); launch_q<9>(p, grid, stream);
        launch_q<10>(p, grid, stream); launch_q<11>(p, grid, stream); launch_q<12>(p, grid, stream); launch_q<13>(p, grid, stream);
    }
#endif
}
```

```cpp
#include <hip/hip_runtime.h>
#include <hip/hip_cooperative_groups.h>
#include <cstdio>
#include <cstdint>
namespace cg = cooperative_groups;

#ifndef MK_MEGA
#define MK_MEGA 1
#endif

#define LAS __attribute__((address_space(3)))
typedef unsigned short bf16_t;
typedef short bf16x8 __attribute__((ext_vector_type(8)));
typedef float f32x4 __attribute__((ext_vector_type(4)));
typedef float f32x2 __attribute__((ext_vector_type(2)));
typedef unsigned u32x4 __attribute__((ext_vector_type(4)));
typedef unsigned u32x2 __attribute__((ext_vector_type(2)));

constexpr int NTOK = 16384, DM = 1024, SEQ = 2048, NBATCH = 8, NLAYER = 2;
constexpr int DIN = 5648, NU = 5632;
constexpr int UZ = 0, UXS = 1024, UB = 2048, UC = 2304, UHQ = 2560, UHF = 3072, UHV = 3584, UHG = 4096, ULG = 4608, ULX = 5120;
constexpr int NMOD = 6144;
constexpr float EPS = 1e-6f;
constexpr int NEXP = 64, TOPK = 8;
constexpr int MAXSLOT = 147456;
constexpr int NTHREADS = 512, NWAVES = 8;
constexpr int LDS_BYTES = 160 * 1024;
constexpr int LDS_PTAB = LDS_BYTES - 512;

constexpr size_t MiB = (size_t)1 << 20;
constexpr size_t WS_CTL = 0, CTL_ZERO_BYTES = 1 * MiB;
constexpr size_t WS_MOD = 1 * MiB;
constexpr size_t WS_LB = WS_MOD + 512 * 1024;
constexpr size_t WS_LRUW = WS_LB + 8192;
constexpr size_t WS_DTRAW = 2 * MiB, WS_DT = 3 * MiB, WS_ACUM = 4 * MiB;
constexpr size_t WS_HGBL = 5 * MiB;
constexpr size_t WS_SELM = 5 * MiB + 512 * 1024;
constexpr size_t WS_RW = 6 * MiB;
constexpr size_t WS_SLOTOF = 6 * MiB + 512 * 1024;
constexpr size_t WS_SLOTTOK = 7 * MiB;
constexpr size_t WS_RINFO = 7 * MiB + 768 * 1024;
constexpr size_t WS_CNT = 8 * MiB;
constexpr size_t WS_WRT = 9 * MiB;
constexpr size_t WS_WIN = 12 * MiB;
constexpr size_t WS_WOUT = 34 * MiB;
constexpr size_t WS_GU = 42 * MiB;
constexpr size_t WS_DN = 107 * MiB;
constexpr size_t WS_H = 140 * MiB;
constexpr size_t WS_U = 172 * MiB;
constexpr size_t WS_SST = 348 * MiB;
constexpr size_t WS_HST = 380 * MiB;
constexpr size_t WS_LA = 412 * MiB, WS_LH = 428 * MiB;
constexpr size_t WS_XBC = 444 * MiB;
constexpr size_t WS_YCAT = 492 * MiB;
constexpr size_t WS_HMID = 172 * MiB;
constexpr size_t WS_Y = 252 * MiB;
constexpr size_t WS_MIX = 444 * MiB;
constexpr size_t WS_YSH = WS_Y + 160 * MiB;
constexpr size_t WS_END = 556 * MiB;

__device__ __forceinline__ float bf2f(bf16_t b) { return __uint_as_float(((unsigned)b) << 16); }
typedef __bf16 bf16x2_hw __attribute__((ext_vector_type(2)));
__device__ __forceinline__ unsigned pk2(float lo, float hi) { f32x2 v = {lo, hi}; bf16x2_hw b = __builtin_convertvector(v, bf16x2_hw); return __builtin_bit_cast(unsigned, b); }
__device__ __forceinline__ unsigned f2bf(float f) { return pk2(f, 0.f) & 0xffffu; }
constexpr float Y8_SCALE = 16.0f, Y8_INV = 1.0f / 16.0f;
__device__ __forceinline__ unsigned pk4_fp8(float a, float b, float c2, float d) { int w = 0; w = __builtin_amdgcn_cvt_pk_fp8_f32(a, b, w, false); w = __builtin_amdgcn_cvt_pk_fp8_f32(c2, d, w, true); return (unsigned)w; }
__device__ __forceinline__ float lo_bf(unsigned w) { return __uint_as_float(w << 16); }
__device__ __forceinline__ float hi_bf(unsigned w) { return __uint_as_float(w & 0xffff0000u); }
__device__ __forceinline__ float rcpf_(float x) { return __builtin_amdgcn_rcpf(x); }
__device__ __forceinline__ float rsqf_(float x) { return __builtin_amdgcn_rsqf(x); }
__device__ __forceinline__ float sigmoidf_(float x) { return rcpf_(1.0f + __expf(-x)); }
__device__ __forceinline__ float siluf_(float x) { return x * rcpf_(1.0f + __expf(-x)); }
__device__ __forceinline__ float softplusf_(float x) { return fmaxf(x, 0.f) + log1pf(__expf(-fabsf(x))); }
__device__ __forceinline__ float gelu_tanhf_(float x) { const float u = 0.7978845608028654f * (x + 0.044715f * x * x * x); const float t = 1.0f - 2.0f * rcpf_(1.0f + __expf(2.0f * u)); return 0.5f * x * (1.0f + t); }
__device__ __forceinline__ float shfl_xor_l(float v, int mask, int lane) { return __builtin_bit_cast(float, __builtin_amdgcn_ds_bpermute((lane ^ mask) << 2, __builtin_bit_cast(int, v))); }
__device__ __forceinline__ int shfl_up_l(int v, int d, int lane) { return __builtin_amdgcn_ds_bpermute((lane - d) << 2, v); }
__device__ __forceinline__ float shfl_up_f(float v, int d, int lane) { return __builtin_bit_cast(float, __builtin_amdgcn_ds_bpermute((lane - d) << 2, __builtin_bit_cast(int, v))); }
__device__ __forceinline__ float rdlane_f(float v, int src) { return __builtin_bit_cast(float, __builtin_amdgcn_readlane(__builtin_bit_cast(int, v), src)); }
__device__ __forceinline__ unsigned long long rdlane_u64(unsigned long long v, int src) {
    const unsigned lo = (unsigned)__builtin_amdgcn_readlane((int)(unsigned)v, src), hi = (unsigned)__builtin_amdgcn_readlane((int)(unsigned)(v >> 32), src); return ((unsigned long long)hi << 32) | lo; }
__device__ __forceinline__ float wave_sum(float v, int lane) {
#pragma unroll
    for (int o = 1; o < 64; o <<= 1) v += shfl_xor_l(v, o, lane);
    return v;
}
#define LDS_WAIT() asm volatile("s_waitcnt lgkmcnt(0)" ::: "memory")
__device__ __forceinline__ int fresh_lane() { unsigned ones = ~0u; asm volatile("" : "+s"(ones)); return (int)__builtin_amdgcn_mbcnt_hi(ones, __builtin_amdgcn_mbcnt_lo(ones, 0u)); }
__device__ __forceinline__ void split_bf16(const f32x4& x0, const f32x4& x1, bf16x8& hi, bf16x8& lo) {
    u32x4 h, l2; h.x = pk2(x0[0], x0[1]); h.y = pk2(x0[2], x0[3]); h.z = pk2(x1[0], x1[1]); h.w = pk2(x1[2], x1[3]);
    l2.x = pk2(x0[0] - lo_bf(h.x), x0[1] - hi_bf(h.x)); l2.y = pk2(x0[2] - lo_bf(h.y), x0[3] - hi_bf(h.y)); l2.z = pk2(x1[0] - lo_bf(h.z), x1[1] - hi_bf(h.z)); l2.w = pk2(x1[2] - lo_bf(h.w), x1[3] - hi_bf(h.w));
    hi = __builtin_bit_cast(bf16x8, h); lo = __builtin_bit_cast(bf16x8, l2);
}
#define LDS_BARRIER() do { asm volatile("s_waitcnt lgkmcnt(0)" ::: "memory"); __builtin_amdgcn_s_barrier(); asm volatile("" ::: "memory"); } while (0)
#define MFMA16(a, b, c) __builtin_amdgcn_mfma_f32_16x16x32_bf16((a), (b), (c), 0, 0, 0)
typedef short s16x4 __attribute__((ext_vector_type(4)));
__device__ __forceinline__ bf16x8 tr_frag(const LAS bf16_t* img, int ld, int k0, int c0, int lane) {
    const int g = lane >> 4, q = (lane & 15) >> 2, pp = lane & 3;
    const LAS bf16_t* a0 = img + (k0 + 8 * g + q) * ld + c0 + 4 * pp;
    const s16x4 r0 = __builtin_amdgcn_ds_read_tr16_b64_v4i16((LAS s16x4*)a0);
    const s16x4 r1 = __builtin_amdgcn_ds_read_tr16_b64_v4i16((LAS s16x4*)(a0 + 4 * ld));
    return (bf16x8){r0[0], r0[1], r0[2], r0[3], r1[0], r1[1], r1[2], r1[3]};
}

namespace pg8 {
constexpr int BM = 256, BK = 64, HALF = 128, HTB = HALF * BK * 2, STAGE_BYTES = 8 * HTB, NXCD = 8, WGM = 8;
__device__ __forceinline__ int lds_byte(int r, int c) { const int st = (r >> 4) * 2 + (c >> 5), rr = r & 15, cc = c & 31, ob = rr * 64 + cc * 2; return st * 1024 + (ob ^ (((ob >> 9) & 1) << 5)); }
__device__ __forceinline__ void stage_rc(int b, int& R, int& C) { const int st = b / 1024, sb = b % 1024, swz = sb ^ (((sb >> 9) & 1) << 5); R = (st >> 1) * 16 + swz / 64; C = (st & 1) * 32 + (swz % 64) / 2; }
__device__ __forceinline__ int perm32(int rho) { const int n = rho >> 4, i = rho & 15; return 8 * (i >> 2) + 4 * n + (i & 3); }

struct Unit { int pm, pn, e; };
struct Gemm { const bf16_t* A; const bf16_t* Bt; int K; size_t estride; };

struct DenseOrder {
    int nM, nN, nwg, G, c;
    __device__ void init(int M, int N, int G_, int c_) { nM = M / BM; nN = N / BM; nwg = nM * nN; G = G_; c = c_; }
    __device__ bool next(int i, Unit& u) const {
        const long L = (long)i * G + c; if (L >= nwg) return false;
        int wgid = (int)L; { const int q = nwg / NXCD, r = nwg % NXCD, xcd = wgid % NXCD, off = wgid / NXCD; wgid = (xcd < r ? xcd * (q + 1) : r * (q + 1) + (xcd - r) * q) + off; }
        const int nig = WGM * nN, gid = wgid / nig, fm = gid * WGM, gsz = (nM - fm) < WGM ? (nM - fm) : WGM;
        u.pm = fm + ((wgid % nig) % gsz); u.pn = (wgid % nig) / gsz; u.e = 0; return true;
    }
};
struct DenseRows { __device__ __forceinline__ int row(const Unit& u, int r) const { return u.pm * BM + r; } };

template <class Epi, class Sched, class AMap, bool ALIGN_EPI, bool SP2>
__device__ __forceinline__ void gemm_phase(LAS unsigned char* lds, const Gemm g, const Sched& S, const Epi& E, const AMap& AM, int wave_id) {
    const int wid = wave_id, lane = fresh_lane(), tid = wid * 64 + lane, wr = wid >> 2, wc = wid & 3, fr = lane & 15, fq = lane >> 4;
    const int K = g.K, nt = K / BK;
    unsigned voffB0;
    { int R, C; stage_rc(tid * 16, R, C); const int Rb = Epi::PERM ? ((R & ~31) + perm32(R & 31)) : R; voffB0 = (unsigned)(Rb * K + C) * 2u; }
    const size_t p1step = (size_t)64 * K * 2;
    const size_t kstep = (size_t)(BK * 2);
    const size_t hstep = (size_t)HALF * K * 2;
    const size_t tstep = 2 * hstep;
    const unsigned ldsw = (unsigned)wid * 1024u;
    const int aoff = lds_byte(wr * 64 + fr, fq * 8), boff = lds_byte(wc * 32 + fr, fq * 8);
#define PG8_SA(b, h) (((b) * 2 + (h)) * HTB)
#define PG8_SB(b, h) ((4 + (b) * 2 + (h)) * HTB)
#define PG8_STAGE2(bufoff, gbase, v0, v1) do { \
        __builtin_amdgcn_global_load_lds((const unsigned*)((const char*)(gbase) + (v0)), (LAS unsigned*)(lds + (bufoff) + ldsw), 16, 0, 0); \
        __builtin_amdgcn_global_load_lds((const unsigned*)((const char*)(gbase) + (v1)), (LAS unsigned*)(lds + (bufoff) + ldsw + 8192), 16, 0, 0); } while (0)
#define PG8_STAGEB(bufoff, gbase) do { \
        __builtin_amdgcn_global_load_lds((const unsigned*)((const char*)(gbase) + voffB0), (LAS unsigned*)(lds + (bufoff) + ldsw), 16, 0, 0); \
        __builtin_amdgcn_global_load_lds((const unsigned*)((const char*)(gbase) + p1step + voffB0), (LAS unsigned*)(lds + (bufoff) + ldsw + 8192), 16, 0, 0); } while (0)
#define PG8_LDA(dst, b, h) do { _Pragma("unroll") for (int m = 0; m < 4; ++m) _Pragma("unroll") for (int k = 0; k < 2; ++k) dst[m][k] = *(const LAS bf16x8*)(lds + PG8_SA(b, h) + aoff + m * 2048 + k * 1024); } while (0)
#define PG8_LDB(dst, b, h) do { _Pragma("unroll") for (int n = 0; n < 2; ++n) _Pragma("unroll") for (int k = 0; k < 2; ++k) dst[n][k] = *(const LAS bf16x8*)(lds + PG8_SB(b, h) + boff + n * 2048 + k * 1024); } while (0)
#define PG8_MMA(ai, bj, At, Bt) do { __builtin_amdgcn_s_setprio(1); _Pragma("unroll") for (int m = 0; m < 4; ++m) _Pragma("unroll") for (int n = 0; n < 2; ++n) _Pragma("unroll") for (int k = 0; k < 2; ++k) \
        acc[ai][bj][m][n] = __builtin_amdgcn_mfma_f32_16x16x32_bf16(Bt[n][k], At[m][k], acc[ai][bj][m][n], 0, 0, 0); __builtin_amdgcn_s_setprio(0); } while (0)
#define PG8_WAIT_V(n) asm volatile("s_waitcnt vmcnt(" #n ")" ::: "memory")
#define PG8_WAIT_L(n) asm volatile("s_waitcnt lgkmcnt(" #n ")" ::: "memory")
#define PG8_BAR __builtin_amdgcn_s_barrier()
#define PG8_SCHED __builtin_amdgcn_sched_barrier(0)
#define PG8_AOFFS(u, v00, v01, v10, v11) do { int R_, C_; stage_rc(tid * 16, R_, C_); \
        v00 = (unsigned)(AM.row(u, R_) * K + C_) * 2u; v01 = (unsigned)(AM.row(u, R_ + 64) * K + C_) * 2u; \
        v10 = (unsigned)(AM.row(u, HALF + R_) * K + C_) * 2u; v11 = (unsigned)(AM.row(u, HALF + R_ + 64) * K + C_) * 2u; } while (0)
    Unit cur, nxt; int ui = 0;
    if (!S.next(0, cur)) return;
    f32x4 acc[2][2][4][2];
#pragma unroll
    for (int a = 0; a < 2; ++a)
#pragma unroll
        for (int b = 0; b < 2; ++b)
#pragma unroll
            for (int m = 0; m < 4; ++m)
#pragma unroll
                for (int n = 0; n < 2; ++n) acc[a][b][m][n] = (f32x4){0.f, 0.f, 0.f, 0.f};
    bf16x8 At[4][2], B0[2][2], B1[2][2];
    const char* const Abase = (const char*)g.A;
    const char* cB = (const char*)g.Bt + (size_t)cur.e * g.estride + (size_t)cur.pn * tstep;
    unsigned c00, c01, c10, c11, n00, n01, n10, n11;
    PG8_AOFFS(cur, c00, c01, c10, c11);
    n00 = c00; n01 = c01; n10 = c10; n11 = c11;
    if constexpr (SP2) {
        PG8_STAGEB(PG8_SB(0, 0), cB); PG8_STAGEB(PG8_SB(0, 1), cB + hstep); PG8_STAGE2(PG8_SA(0, 0), Abase, c00, c01); PG8_STAGE2(PG8_SA(0, 1), Abase, c10, c11);
        if (wr == 1) PG8_BAR;
        PG8_WAIT_V(2); PG8_BAR;
        PG8_STAGEB(PG8_SB(1, 0), cB + kstep); PG8_STAGE2(PG8_SA(1, 0), Abase + kstep, c00, c01); PG8_STAGEB(PG8_SB(1, 1), cB + hstep + kstep);
        PG8_WAIT_V(6); PG8_BAR;
    } else {
        PG8_STAGEB(PG8_SB(0, 0), cB); PG8_STAGE2(PG8_SA(0, 0), Abase, c00, c01); PG8_STAGEB(PG8_SB(0, 1), cB + hstep); PG8_STAGE2(PG8_SA(0, 1), Abase, c10, c11);
        if (wr == 1) PG8_BAR;
        PG8_WAIT_V(4); PG8_BAR;
        PG8_STAGEB(PG8_SB(1, 0), cB + kstep); PG8_STAGE2(PG8_SA(1, 0), Abase + kstep, c00, c01); PG8_STAGEB(PG8_SB(1, 1), cB + hstep + kstep);
        PG8_WAIT_V(6); PG8_BAR;
    }
    for (;;) {
        const bool has_next = S.next(ui + 1, nxt);
        const char* nB = cB;
        if (has_next) { nB = (const char*)g.Bt + (size_t)nxt.e * g.estride + (size_t)nxt.pn * tstep; PG8_AOFFS(nxt, n00, n01, n10, n11); }
        else { n00 = c00; n01 = c01; n10 = c10; n11 = c11; }
        for (int t = 0; t < nt; t += 2) {
            const bool last = (t == nt - 2);
            const char* a1 = Abase + (size_t)(t + 1) * kstep;
            const char* a2 = last ? Abase : Abase + (size_t)(t + 2) * kstep;
            const char* b2 = last ? nB : cB + (size_t)(t + 2) * kstep;
            const char* a3 = a2 + kstep; const char* b3 = b2 + kstep;
            const unsigned x00 = last ? n00 : c00, x01 = last ? n01 : c01, x10 = last ? n10 : c10, x11 = last ? n11 : c11;
            if constexpr (SP2) {
            PG8_LDB(B0, 0, 0); PG8_LDB(B1, 0, 1); PG8_SCHED; PG8_LDA(At, 0, 0); PG8_STAGE2(PG8_SA(1, 1), a1, c10, c11);
            PG8_WAIT_V(8); PG8_WAIT_L(0); PG8_BAR; PG8_MMA(0, 0, At, B0); PG8_MMA(0, 1, At, B1); PG8_BAR; PG8_SCHED;
            PG8_LDA(At, 0, 1); PG8_STAGEB(PG8_SB(0, 0), b2); PG8_STAGEB(PG8_SB(0, 1), b2 + hstep); PG8_STAGE2(PG8_SA(0, 0), a2, x00, x01);
            PG8_WAIT_V(8); PG8_WAIT_L(0); PG8_BAR; PG8_MMA(1, 0, At, B0); PG8_MMA(1, 1, At, B1); PG8_BAR; PG8_SCHED;
            PG8_LDB(B0, 1, 0); PG8_LDB(B1, 1, 1); PG8_SCHED; PG8_LDA(At, 1, 0); PG8_STAGE2(PG8_SA(0, 1), a2, x10, x11);
            PG8_WAIT_V(8); PG8_WAIT_L(0); PG8_BAR; PG8_MMA(0, 0, At, B0); PG8_MMA(0, 1, At, B1); PG8_BAR; PG8_SCHED;
            PG8_LDA(At, 1, 1); PG8_STAGEB(PG8_SB(1, 0), b3); PG8_STAGEB(PG8_SB(1, 1), b3 + hstep); PG8_STAGE2(PG8_SA(1, 0), a3, x00, x01);
            PG8_WAIT_V(8); PG8_WAIT_L(0); PG8_BAR; PG8_MMA(1, 0, At, B0); PG8_MMA(1, 1, At, B1); PG8_BAR; PG8_SCHED;
            } else {
            PG8_LDB(B0, 0, 0); PG8_SCHED; PG8_LDA(At, 0, 0); PG8_STAGE2(PG8_SA(1, 1), a1, c10, c11);
            PG8_WAIT_L(8); PG8_BAR; PG8_WAIT_L(0); PG8_MMA(0, 0, At, B0); PG8_BAR; PG8_SCHED;
            PG8_LDB(B1, 0, 1); PG8_STAGEB(PG8_SB(0, 0), b2);
            PG8_BAR; PG8_WAIT_L(0); PG8_MMA(0, 1, At, B1); PG8_BAR;
            PG8_LDA(At, 0, 1); PG8_STAGE2(PG8_SA(0, 0), a2, x00, x01);
            PG8_BAR; PG8_WAIT_L(0); PG8_MMA(1, 0, At, B0); PG8_BAR; PG8_SCHED;
            PG8_STAGEB(PG8_SB(0, 1), b2 + hstep);
            PG8_WAIT_V(6); PG8_BAR; PG8_MMA(1, 1, At, B1); PG8_BAR;
            PG8_LDB(B0, 1, 0); PG8_SCHED; PG8_LDA(At, 1, 0); PG8_STAGE2(PG8_SA(0, 1), a2, x10, x11);
            PG8_WAIT_L(8); PG8_BAR; PG8_WAIT_L(0); PG8_MMA(0, 0, At, B0); PG8_BAR; PG8_SCHED;
            PG8_LDB(B1, 1, 1); PG8_STAGEB(PG8_SB(1, 0), b3);
            PG8_BAR; PG8_WAIT_L(0); PG8_MMA(0, 1, At, B1); PG8_BAR;
            PG8_LDA(At, 1, 1); PG8_STAGE2(PG8_SA(1, 0), a3, x00, x01);
            PG8_BAR; PG8_WAIT_L(0); PG8_MMA(1, 0, At, B0); PG8_BAR; PG8_SCHED;
            PG8_STAGEB(PG8_SB(1, 1), b3 + hstep);
            PG8_WAIT_V(6); PG8_BAR; PG8_MMA(1, 1, At, B1); PG8_BAR;
            }
        }
        if constexpr (ALIGN_EPI) { if (wr == 0) PG8_BAR; }
        E(acc, cur, wr, wc);
        if (!has_next) break;
#pragma unroll
        for (int a = 0; a < 2; ++a)
#pragma unroll
            for (int b = 0; b < 2; ++b)
#pragma unroll
                for (int m = 0; m < 4; ++m)
#pragma unroll
                    for (int n = 0; n < 2; ++n) acc[a][b][m][n] = (f32x4){0.f, 0.f, 0.f, 0.f};
        cur = nxt; cB = nB; c00 = n00; c01 = n01; c10 = n10; c11 = n11; ++ui;
        if constexpr (ALIGN_EPI) { if (wr == 1) PG8_BAR; }
    }
    PG8_WAIT_V(0);
    if constexpr (!ALIGN_EPI) { if (wr == 0) PG8_BAR; }
    PG8_BAR;
#undef PG8_SA
#undef PG8_SB
#undef PG8_STAGE2
#undef PG8_STAGEB
#undef PG8_LDA
#undef PG8_LDB
#undef PG8_MMA
#undef PG8_WAIT_V
#undef PG8_WAIT_L
#undef PG8_BAR
#undef PG8_SCHED
#undef PG8_AOFFS
}
}

struct Params {
    const float* in[33];
    float* out;
    unsigned char* ws;
    int layer, pad;
};
enum { I_X = 0, I_C, I_ADAW, I_ADAB, I_NMIX, I_NFFN, I_WIN, I_SCW, I_SCB, I_SDTB, I_SALOG, I_SD, I_SNW, I_HLB, I_HNW, I_LCW, I_LCB, I_LWA, I_LBA, I_LWX, I_LBX, I_LLAM, I_LNW,
       I_WOUT, I_RW, I_RB, I_EG, I_EU, I_ED, I_SG, I_SU, I_SDN, I_FNW };

using pg8::Unit;
struct EpiU {
    static constexpr bool PERM = true;
    bf16_t* O; int ldc;
    __device__ __forceinline__ void operator()(const f32x4 (&acc)[2][2][4][2], const Unit& u, int wr, int wc) const {
        const int lane_ = fresh_lane(), fr = lane_ & 15, fq = lane_ >> 4;
        const int row0 = u.pm * 256 + wr * 64 + fr, col0 = u.pn * 256 + wc * 32 + 8 * fq;
#pragma unroll
        for (int ai = 0; ai < 2; ++ai)
#pragma unroll
            for (int m = 0; m < 4; ++m) { bf16_t* rowp = O + (size_t)(row0 + ai * 128 + m * 16) * ldc + col0;
#pragma unroll
                for (int bj = 0; bj < 2; ++bj) { const f32x4 v0 = acc[ai][bj][m][0], v1 = acc[ai][bj][m][1];
                    u32x4 w; w.x = pk2(v0[0], v0[1]); w.y = pk2(v0[2], v0[3]); w.z = pk2(v1[0], v1[1]); w.w = pk2(v1[2], v1[3]);
                    *(u32x4*)(rowp + bj * 128) = w; } }
    }
};
struct EpiOut {
    static constexpr bool PERM = false;
    const float* xin; float* xout; const float* gate;
    __device__ __forceinline__ void operator()(const f32x4 (&acc)[2][2][4][2], const Unit& u, int wr, int wc) const {
        const int lane_ = fresh_lane(), fr = lane_ & 15, fq = lane_ >> 4;
        const int row0 = u.pm * 256 + wr * 64 + fr, col0 = u.pn * 256 + wc * 32 + 4 * fq, b = u.pm >> 3;
        f32x4 gv[2][2];
#pragma unroll
        for (int bj = 0; bj < 2; ++bj)
#pragma unroll
            for (int n = 0; n < 2; ++n) gv[bj][n] = *(const f32x4*)(gate + (size_t)b * NMOD + col0 + bj * 128 + n * 16);
#pragma unroll
        for (int ai = 0; ai < 2; ++ai)
#pragma unroll
            for (int m = 0; m < 4; ++m) { const size_t off = (size_t)(row0 + ai * 128 + m * 16) * DM + col0;
#pragma unroll
                for (int bj = 0; bj < 2; ++bj)
#pragma unroll
                    for (int n = 0; n < 2; ++n) { const f32x4 xi = *(const f32x4*)(xin + off + bj * 128 + n * 16);
                        *(f32x4*)(xout + off + bj * 128 + n * 16) = xi + gv[bj][n] * acc[ai][bj][m][n]; }
                asm volatile("" ::: "memory"); }
    }
};
struct EpiH {
    static constexpr bool PERM = true;
    bf16_t* Hm;
    __device__ __forceinline__ void operator()(const f32x4 (&acc)[2][2][4][2], const Unit& u, int wr, int wc) const {
        const int lane_ = fresh_lane(), fr = lane_ & 15, fq = lane_ >> 4;
        const int row0 = u.pm * 256 + wr * 64 + fr, col0 = u.pn * 128 + wc * 32 + 8 * fq;
#pragma unroll
        for (int ai = 0; ai < 2; ++ai)
#pragma unroll
            for (int m = 0; m < 4; ++m) { bf16_t* rowp = Hm + (size_t)(row0 + ai * 128 + m * 16) * 256 + col0;
                f32x4 h0, h1;
#pragma unroll
                for (int j = 0; j < 4; ++j) { h0[j] = siluf_(acc[ai][0][m][0][j]) * acc[ai][1][m][0][j]; h1[j] = siluf_(acc[ai][0][m][1][j]) * acc[ai][1][m][1][j]; }
                u32x4 w; w.x = pk2(h0[0], h0[1]); w.y = pk2(h0[2], h0[3]); w.z = pk2(h1[0], h1[1]); w.w = pk2(h1[2], h1[3]);
                *(u32x4*)rowp = w; }
    }
};
struct EpiY {
    static constexpr bool PERM = true;
    unsigned char* Y; unsigned char* Ysh; const int* rinfo;
    __device__ __forceinline__ void operator()(const f32x4 (&acc)[2][2][4][2], const Unit& u, int wr, int wc) const {
        const int lane_ = fresh_lane(), fr = lane_ & 15, fq = lane_ >> 4;
        const int col0 = u.pn * 256 + wc * 32 + 8 * fq;
        unsigned char* base = Y + (size_t)u.pm * 256 * DM;
        if (u.e >= NEXP) base = Ysh + (size_t)(u.pm - rinfo[0]) * 256 * DM;
        base += (size_t)(wr * 64 + fr) * DM + col0;
#pragma unroll
        for (int ai = 0; ai < 2; ++ai)
#pragma unroll
            for (int m = 0; m < 4; ++m) { unsigned char* rowp = base + (size_t)(ai * 128 + m * 16) * DM;
#pragma unroll
                for (int bj = 0; bj < 2; ++bj) { const f32x4 v0 = acc[ai][bj][m][0] * Y8_SCALE, v1 = acc[ai][bj][m][1] * Y8_SCALE;
                    u32x2 w; w.x = pk4_fp8(v0[0], v0[1], v0[2], v0[3]); w.y = pk4_fp8(v1[0], v1[1], v1[2], v1[3]);
                    *(u32x2*)(rowp + bj * 128) = w; } }
    }
};
constexpr int LDS_UTAB = 131072, MAX_UNITS = 24;
__device__ __forceinline__ void moe_build_units(LAS unsigned char* lds, const int* rinfo, int NQ, int G, int cidx, int tid) {
    LAS int* tab = (LAS int*)(lds + LDS_UTAB);
    if (tid < MAX_UNITS) {
        const int nblk = rinfo[0]; const long L = (long)tid * G + cidx;
        int pm = -1, pn = 0, e = 0;
        if (L < (long)(nblk + 64) * NQ) { const int rb = (int)(L / NQ); pm = rb; pn = (int)(L % NQ); e = (rb < nblk) ? rinfo[64 + rb] : NEXP; }
        tab[tid * 4 + 0] = pm; tab[tid * 4 + 1] = pn; tab[tid * 4 + 2] = e; tab[tid * 4 + 3] = 0;
    }
    __syncthreads();
}
struct MoeOrder {
    const LAS int* tab;
    __device__ bool next(int i, Unit& u) const {
        if (i >= MAX_UNITS) return false;
        const int pm = __builtin_amdgcn_readfirstlane(tab[i * 4 + 0]); if (pm < 0) return false;
        u.pm = pm; u.pn = __builtin_amdgcn_readfirstlane(tab[i * 4 + 1]); u.e = __builtin_amdgcn_readfirstlane(tab[i * 4 + 2]); return true;
    }
};
struct GatherRows {
    const int* slot_tok; const int* rinfo;
    __device__ __forceinline__ int row(const Unit& u, int r) const {
        const int nblk = rinfo[0];
        if (u.pm < nblk) { const int t = slot_tok[u.pm * 256 + r]; return t < 0 ? 0 : t; }
        return (u.pm - nblk) * 256 + r;
    }
};

struct Ctx { LAS unsigned char* lds; int tid, lane, wave, G, bid; };

template <class RowMap>
__device__ __forceinline__ void transpose_item(const float* W, int N, int k0, int n0, bf16_t* WT, int ldk, const RowMap& rm, LAS float* scr, int lane) {
    const int nn = n0 + (lane & 31);
#pragma unroll 8
    for (int i = 0; i < 32; ++i) { const int kk = 2 * i + (lane >> 5); scr[kk * 33 + (lane & 31)] = (nn < N) ? W[(size_t)(k0 + kk) * N + nn] : 0.f; }
    LDS_WAIT();
    const int c = lane & 7;
#pragma unroll
    for (int j = 0; j < 4; ++j) { const int n = (lane >> 3) + 8 * j; const LAS float* s = scr + (8 * c) * 33 + n;
        u32x4 o; o.x = pk2(s[0 * 33], s[1 * 33]); o.y = pk2(s[2 * 33], s[3 * 33]); o.z = pk2(s[4 * 33], s[5 * 33]); o.w = pk2(s[6 * 33], s[7 * 33]);
        const int dr = (n0 + n < N) ? rm(n0 + n) : -1;
        if (dr >= 0) *(u32x4*)(WT + (size_t)dr * ldk + k0 + 8 * c) = o; }
    LDS_WAIT();
}
struct RmIdent { __device__ __forceinline__ int operator()(int n) const { return n; } };
struct RmWin { __device__ __forceinline__ int operator()(int n) const { return n < 2560 ? n : (n < 2576 ? -1 : n - 16); } };
struct RmGate { __device__ __forceinline__ int operator()(int n) const { return (n >> 7) * 256 + (n & 127); } };
struct RmUp { __device__ __forceinline__ int operator()(int n) const { return (n >> 7) * 256 + 128 + (n & 127); } };

__device__ __forceinline__ void phase_prep_io(const Params& p, const Ctx& c) {
    LAS float* scr = (LAS float*)(c.lds + c.wave * 16384);
    const int gw = c.bid * NWAVES + c.wave, NGW = c.G * NWAVES;
    constexpr int I_IN = 16 * 177, I_OUT = 32 * 32, PER_L = I_IN + I_OUT;
    for (int it = gw; it < NLAYER * PER_L; it += NGW) {
        const int l = it / PER_L; int r = it % PER_L;
        if (r < I_IN) { const int kb = r / 177, nb = r % 177;
            transpose_item(p.in[I_WIN] + (size_t)l * DM * DIN, DIN, kb * 64, nb * 32, (bf16_t*)(p.ws + WS_WIN) + (size_t)l * NU * DM, DM, RmWin(), scr, c.lane); }
        else { r -= I_IN; const int kb = r / 32, nb = r % 32;
            transpose_item(p.in[I_WOUT] + (size_t)l * 2048 * DM, DM, kb * 64, nb * 32, (bf16_t*)(p.ws + WS_WOUT) + (size_t)l * DM * 2048, 2048, RmIdent(), scr, c.lane); }
    }
}
__device__ __forceinline__ void phase_prep_experts(const Params& p, const Ctx& c, int l) {
    LAS float* scr = (LAS float*)(c.lds + c.wave * 16384);
    const int gw = c.bid * NWAVES + c.wave, NGW = c.G * NWAVES;
    constexpr int PER_E = 3 * 128;
    bf16_t* GU = (bf16_t*)(p.ws + WS_GU); bf16_t* DN = (bf16_t*)(p.ws + WS_DN);
    for (int it = gw; it < 65 * PER_E; it += NGW) {
        const int e = it / PER_E; int r = it % PER_E; const int which = r / 128; r %= 128;
        if (which < 2) {
            const float* src = (e < NEXP) ? p.in[which == 0 ? I_EG : I_EU] + ((size_t)l * NEXP + e) * DM * 256 : p.in[which == 0 ? I_SG : I_SU] + (size_t)l * DM * 256;
            const int kb = r / 8, nb = r % 8;
            if (which == 0) transpose_item(src, 256, kb * 64, nb * 32, GU + (size_t)e * 512 * DM, DM, RmGate(), scr, c.lane);
            else transpose_item(src, 256, kb * 64, nb * 32, GU + (size_t)e * 512 * DM, DM, RmUp(), scr, c.lane);
        } else {
            const float* src = (e < NEXP) ? p.in[I_ED] + ((size_t)l * NEXP + e) * 256 * DM : p.in[I_SDN] + (size_t)l * 256 * DM;
            const int kb = r / 32, nb = r % 32;
            transpose_item(src, DM, kb * 64, nb * 32, DN + (size_t)e * DM * 256, 256, RmIdent(), scr, c.lane);
        }
    }
}
__device__ __forceinline__ void phase_prep_small(const Params& p, const Ctx& c) {
    LAS float* sc = (LAS float*)c.lds;
    LAS float* red = (LAS float*)(c.lds + 32768);
    float* mod = (float*)(p.ws + WS_MOD);
    bool have_sc = false;
    for (int it = c.bid; it < NLAYER * 96; it += c.G) {
        if (!have_sc) { for (int i = c.tid; i < 8 * 1024; i += NTHREADS) sc[i] = siluf_(p.in[I_C][i]); have_sc = true; }
        __syncthreads();
        const int l = it / 96, j0 = (it % 96) * 64, j = c.tid & 63, kg = c.tid >> 6;
        const float* W = p.in[I_ADAW] + (size_t)l * DM * NMOD + j0 + j;
        float a[8];
#pragma unroll
        for (int b = 0; b < 8; ++b) a[b] = 0.f;
#pragma unroll 16
        for (int k = kg * 128; k < kg * 128 + 128; ++k) { const float w = W[(size_t)k * NMOD];
#pragma unroll
            for (int b = 0; b < 8; ++b) a[b] += sc[b * 1024 + k] * w; }
#pragma unroll
        for (int b = 0; b < 8; ++b) red[(kg * 8 + b) * 64 + j] = a[b];
        __syncthreads();
        { const int b = c.tid >> 6; float s = 0.f;
#pragma unroll
          for (int g = 0; g < 8; ++g) s += red[(g * 8 + b) * 64 + j];
          mod[((size_t)l * 8 + b) * NMOD + j0 + j] = s + p.in[I_ADAB][(size_t)l * NMOD + j0 + j]; }
        __syncthreads();
    }
    if (c.bid == c.G - 1) {
        float* lb = (float*)(p.ws + WS_LB);
        for (int i = c.tid; i < 512; i += NTHREADS) { const float v0 = p.in[I_HLB][i], v1 = p.in[I_HLB][512 + i]; const float m = fmaxf(v0, v1), e0 = expf(v0 - m), e1 = expf(v1 - m);
            lb[i] = 0.f; lb[512 + i] = e1 / (e0 + e1); }
    }
    { float* WT = (float*)(p.ws + WS_WRT);
      for (int o = c.bid * NTHREADS + c.tid; o < NLAYER * 64 * 1024; o += c.G * NTHREADS) { const int k = o & 1023, e = (o >> 10) & 63, l = o >> 16; WT[o] = p.in[I_RW][((size_t)l * 1024 + k) * 64 + e]; } }
    { bf16_t* LW = (bf16_t*)(p.ws + WS_LRUW);
      for (int o = c.bid * NTHREADS + c.tid; o < NLAYER * 2 * 8 * 4096; o += c.G * NTHREADS) {
          const int i = o & 63, j = (o >> 6) & 63, g = (o >> 12) & 7, mat = (o >> 15) & 1, l = o >> 16;
          const float* src = p.in[mat == 0 ? I_LWA : I_LWX] + (((size_t)l * 8 + g) * 64 + i) * 64 + j;
          LW[o] = (bf16_t)f2bf(*src); } }
}

__device__ __forceinline__ void load_wdt(const Params& p, const Ctx& c, int l, LAS float* wdt) {
    const float* Win = p.in[I_WIN] + (size_t)l * DM * DIN;
    for (int i = c.tid; i < 16 * 1024; i += NTHREADS) { const int k = i >> 4, j = i & 15; wdt[j * 1024 + k] = Win[(size_t)k * DIN + 2560 + j]; }
    __syncthreads();
}
__device__ __forceinline__ void norm_mix_row(const Ctx& c, const f32x4 (&v)[4], float ss, int tok, const float* nw, const float* mod, const LAS float* wdt, bf16_t* H, float* dtraw) {
        const int b = tok >> 11;
        const float rstd = rsqf_(wave_sum(ss, c.lane) * (1.0f / DM) + EPS);
        f32x4 hv[4], w4v[4], shv[4], scv[4];
#pragma unroll
        for (int j = 0; j < 4; ++j) { const int col = 256 * j + 4 * c.lane;
            w4v[j] = *(const f32x4*)(nw + col); shv[j] = *(const f32x4*)(mod + (size_t)b * NMOD + col); scv[j] = *(const f32x4*)(mod + (size_t)b * NMOD + 1024 + col); }
#pragma unroll
        for (int j = 0; j < 4; ++j) {
            const int col = 256 * j + 4 * c.lane;
            const f32x4 w4 = w4v[j], sh = shv[j], sc = scv[j];
            hv[j] = (v[j] * rstd * w4) * (sc + 1.0f) + sh;
            u32x2 o; o.x = pk2(hv[j][0], hv[j][1]); o.y = pk2(hv[j][2], hv[j][3]);
            *(u32x2*)(H + (size_t)tok * DM + col) = o;
        }
        float d16[16];
#pragma unroll
        for (int q = 0; q < 16; ++q) {
            float s2 = 0.f;
#pragma unroll
            for (int j = 0; j < 4; ++j) { const f32x4 wq = *(const LAS f32x4*)(wdt + q * 1024 + 256 * j + 4 * c.lane); s2 += (hv[j][0] * wq[0] + hv[j][1] * wq[1]) + (hv[j][2] * wq[2] + hv[j][3] * wq[3]); }
            d16[q] = s2;
            if ((q & 1) == 1) asm volatile("" ::: "memory");
        }
        float d8[8], d4[4], d2[2], d1;
        { const bool up = (c.lane & 32) != 0;
#pragma unroll
          for (int i = 0; i < 8; ++i) { const float snd = up ? d16[i] : d16[8 + i], kp = up ? d16[8 + i] : d16[i]; d8[i] = kp + shfl_xor_l(snd, 32, c.lane); } }
        { const bool up = (c.lane & 16) != 0;
#pragma unroll
          for (int i = 0; i < 4; ++i) { const float snd = up ? d8[i] : d8[4 + i], kp = up ? d8[4 + i] : d8[i]; d4[i] = kp + shfl_xor_l(snd, 16, c.lane); } }
        { const bool up = (c.lane & 8) != 0;
#pragma unroll
          for (int i = 0; i < 2; ++i) { const float snd = up ? d4[i] : d4[2 + i], kp = up ? d4[2 + i] : d4[i]; d2[i] = kp + shfl_xor_l(snd, 8, c.lane); } }
        { const bool up = (c.lane & 4) != 0; const float snd = up ? d2[0] : d2[1], kp = up ? d2[1] : d2[0]; d1 = kp + shfl_xor_l(snd, 4, c.lane); }
        d1 += shfl_xor_l(d1, 2, c.lane); d1 += shfl_xor_l(d1, 1, c.lane);
        if ((c.lane & 3) == 0) dtraw[(size_t)tok * 16 + ((c.lane >> 5) & 1) * 8 + ((c.lane >> 4) & 1) * 4 + ((c.lane >> 3) & 1) * 2 + ((c.lane >> 2) & 1)] = d1;
}
__device__ __forceinline__ void phase_norm_mix(const Params& p, const Ctx& c, int l, const float* xin) {
    LAS float* wdt = (LAS float*)c.lds;
    load_wdt(p, c, l, wdt);
    const float* mod = (const float*)(p.ws + WS_MOD) + (size_t)l * 8 * NMOD;
    const float* nw = p.in[I_NMIX] + (size_t)l * DM;
    bf16_t* H = (bf16_t*)(p.ws + WS_H); float* dtraw = (float*)(p.ws + WS_DTRAW);
    const int gw = c.bid * NWAVES + c.wave, NGW = c.G * NWAVES;
    f32x4 vn[4];
    if (gw < NTOK) {
#pragma unroll
        for (int j = 0; j < 4; ++j) vn[j] = ((const f32x4*)(xin + (size_t)gw * DM) + c.lane)[64 * j];
    }
    for (int tok = gw; tok < NTOK; tok += NGW) {
        f32x4 v[4]; float ss = 0.f;
#pragma unroll
        for (int j = 0; j < 4; ++j) { v[j] = vn[j]; ss += (v[j][0] * v[j][0] + v[j][1] * v[j][1]) + (v[j][2] * v[j][2] + v[j][3] * v[j][3]); }
        if (tok + NGW < NTOK) {
#pragma unroll
            for (int j = 0; j < 4; ++j) vn[j] = ((const f32x4*)(xin + (size_t)(tok + NGW) * DM) + c.lane)[64 * j];
        }
        norm_mix_row(c, v, ss, tok, nw, mod, wdt, H, dtraw);
    }
}

__device__ __forceinline__ void phase_ssd_conv(const Params& p, const Ctx& c, int l) {
    const bf16_t* U = (const bf16_t*)(p.ws + WS_U); bf16_t* XA = (bf16_t*)(p.ws + WS_XBC);
    const float* cw = p.in[I_SCW] + (size_t)l * 4 * 1536; const float* cb = p.in[I_SCB] + (size_t)l * 1536;
    const float* dtraw = (const float*)(p.ws + WS_DTRAW); float* dt = (float*)(p.ws + WS_DT); float* acum = (float*)(p.ws + WS_ACUM);
    for (int idx = c.bid * NTHREADS + c.tid; idx < (NTOK / 4) * 192; idx += c.G * NTHREADS) {
        const int oct = idx % 192, tg = idx / 192, tok0 = tg * 4, t0 = tok0 & (SEQ - 1), c0 = oct * 8;
        float w[4][8], bb[8];
#pragma unroll
        for (int k = 0; k < 4; ++k) { const f32x4 a = *(const f32x4*)(cw + k * 1536 + c0), b2 = *(const f32x4*)(cw + k * 1536 + c0 + 4);
            w[k][0] = a[0]; w[k][1] = a[1]; w[k][2] = a[2]; w[k][3] = a[3]; w[k][4] = b2[0]; w[k][5] = b2[1]; w[k][6] = b2[2]; w[k][7] = b2[3]; }
        { const f32x4 a = *(const f32x4*)(cb + c0), b2 = *(const f32x4*)(cb + c0 + 4); bb[0] = a[0]; bb[1] = a[1]; bb[2] = a[2]; bb[3] = a[3]; bb[4] = b2[0]; bb[5] = b2[1]; bb[6] = b2[2]; bb[7] = b2[3]; }
        float x[7][8];
#pragma unroll
        for (int r = 0; r < 7; ++r) {
            u32x4 v = (u32x4){0u, 0u, 0u, 0u};
            if (t0 + r - 3 >= 0) v = *(const u32x4*)(U + (size_t)(tok0 + r - 3) * NU + UXS + c0);
#pragma unroll
            for (int j = 0; j < 4; ++j) { x[r][2 * j] = lo_bf(v[j]); x[r][2 * j + 1] = hi_bf(v[j]); }
        }
#pragma unroll
        for (int t = 0; t < 4; ++t) {
            float y[8];
#pragma unroll
            for (int j = 0; j < 8; ++j) y[j] = siluf_(bb[j] + w[0][j] * x[t][j] + w[1][j] * x[t + 1][j] + w[2][j] * x[t + 2][j] + w[3][j] * x[t + 3][j]);
            u32x4 o; o.x = pk2(y[0], y[1]); o.y = pk2(y[2], y[3]); o.z = pk2(y[4], y[5]); o.w = pk2(y[6], y[7]);
            *(u32x4*)(XA + (size_t)(tok0 + t) * 1536 + c0) = o;
        }
    }
    for (int it = c.bid + c.wave * c.G; it < 128; it += c.G * NWAVES) {
        const int tok0 = it * 128, h = c.lane & 15, qtr = c.lane >> 4;
        const float bias = p.in[I_SDTB][l * 16 + h], A = -expf(p.in[I_SALOG][l * 16 + h]);
        float d[32]; float cum = 0.f;
#pragma unroll
        for (int i = 0; i < 32; ++i) d[i] = softplusf_(dtraw[(size_t)(tok0 + qtr * 32 + i) * 16 + h] + bias);
#pragma unroll
        for (int i = 0; i < 32; ++i) cum += d[i] * A;
        const float c1 = shfl_up_f(cum, 16, c.lane), c2 = shfl_up_f(cum, 32, c.lane), c3 = shfl_up_f(cum, 48, c.lane);
        float off = 0.f; if (qtr >= 1) off += c1; if (qtr >= 2) off += c2; if (qtr >= 3) off += c3;
        float run = off;
#pragma unroll
        for (int i = 0; i < 32; ++i) { run += d[i] * A; dt[(size_t)(tok0 + qtr * 32 + i) * 16 + h] = d[i]; acum[(size_t)(tok0 + qtr * 32 + i) * 16 + h] = run; }
    }
}

__device__ __forceinline__ void phase_ssd_state(const Params& p, const Ctx& c) {
    LAS bf16_t* XS = (LAS bf16_t*)c.lds;
    LAS bf16_t* BS = (LAS bf16_t*)(c.lds + 2 * 18432);
    LAS float* fac = (LAS float*)(c.lds + 2 * 18432 + 34816);
    const bf16_t* XA = (const bf16_t*)(p.ws + WS_XBC); const float* dt = (const float*)(p.ws + WS_DT); const float* acum = (const float*)(p.ws + WS_ACUM);
    bf16_t* ST = (bf16_t*)(p.ws + WS_SST);
    const int fr = c.lane & 15, fq = c.lane >> 4;
    for (int it = c.bid; it < 256; it += c.G) {
        const int g = it & 1, bc = it >> 1, tok0 = bc * 128;
        u32x4 pxs[2];
#pragma unroll
        for (int q = 0; q < 2; ++q) { const int i = c.tid + q * NTHREADS; pxs[q] = *(const u32x4*)(XA + (size_t)(tok0 + (i >> 3)) * 1536 + (g * 8) * 64 + (i & 7) * 8); }
        for (int i = c.tid; i < 128 * 16; i += NTHREADS) { const int lrow = i >> 4, ck = i & 15;
            *(LAS u32x4*)(BS + lrow * 136 + ck * 8) = *(const u32x4*)(XA + (size_t)(tok0 + lrow) * 1536 + 1024 + g * 128 + ck * 8); }
        for (int i = c.tid; i < 1024; i += NTHREADS) { const int h8 = i >> 7, lr = i & 127, h = g * 8 + h8;
            fac[i] = dt[(size_t)(tok0 + lr) * 16 + h] * __expf(acum[(size_t)(tok0 + 127) * 16 + h] - acum[(size_t)(tok0 + lr) * 16 + h]); }
        LDS_BARRIER();
        for (int h8 = 0; h8 < 8; ++h8) {
            const int h = g * 8 + h8; LAS bf16_t* X = XS + (h8 & 1) * (128 * 72);
#pragma unroll
            for (int q = 0; q < 2; ++q) { const int i = c.tid + q * NTHREADS, lrow = i >> 3, ck = i & 7; const u32x4 r = pxs[q]; const float f = fac[h8 * 128 + lrow];
                u32x4 o; o.x = pk2(lo_bf(r.x) * f, hi_bf(r.x) * f); o.y = pk2(lo_bf(r.y) * f, hi_bf(r.y) * f); o.z = pk2(lo_bf(r.z) * f, hi_bf(r.z) * f); o.w = pk2(lo_bf(r.w) * f, hi_bf(r.w) * f);
                *(LAS u32x4*)(X + lrow * 72 + ck * 8) = o; }
            if (h8 < 7) {
#pragma unroll
                for (int q = 0; q < 2; ++q) { const int i = c.tid + q * NTHREADS; pxs[q] = *(const u32x4*)(XA + (size_t)(tok0 + (i >> 3)) * 1536 + (h + 1) * 64 + (i & 7) * 8); } }
            LDS_BARRIER();
            f32x4 acc[4];
#pragma unroll
            for (int m = 0; m < 4; ++m) acc[m] = (f32x4){0.f, 0.f, 0.f, 0.f};
#pragma unroll
            for (int ks = 0; ks < 4; ++ks) {
                const bf16x8 bfr = tr_frag(BS, 136, 32 * ks, 16 * c.wave, c.lane);
#pragma unroll
                for (int m = 0; m < 4; ++m) { const bf16x8 afr = tr_frag(X, 72, 32 * ks, 16 * m, c.lane); acc[m] = MFMA16(bfr, afr, acc[m]); }
            }
            const size_t sit = (size_t)(bc * 16 + h);
#pragma unroll
            for (int m = 0; m < 4; ++m) { u32x2 o; o.x = pk2(acc[m][0], acc[m][1]); o.y = pk2(acc[m][2], acc[m][3]);
                *(u32x2*)(ST + sit * 8192 + (16 * m + fr) * 128 + 16 * c.wave + 4 * fq) = o; }
        }
        LDS_BARRIER();
    }
}
__device__ __forceinline__ void phase_ssd_scan(const Params& p, const Ctx& c) {
    u32x4* ST = (u32x4*)(p.ws + WS_SST); const float* acum = (const float*)(p.ws + WS_ACUM);
    for (int i = c.bid * NTHREADS + c.tid; i < 128 * 1024; i += c.G * NTHREADS) {
        const int e8 = i & 1023, bh = i >> 10, b = bh >> 4, h = bh & 15;
        u32x4 loc[16]; float dec[16];
#pragma unroll
        for (int ch = 0; ch < 16; ++ch) { loc[ch] = ST[(size_t)((b * 16 + ch) * 16 + h) * 1024 + e8]; dec[ch] = __expf(acum[(size_t)(b * SEQ + ch * 128 + 127) * 16 + h]); }
        float r[8];
#pragma unroll
        for (int j = 0; j < 8; ++j) r[j] = 0.f;
#pragma unroll
        for (int ch = 0; ch < 16; ++ch) {
            u32x4 o; o.x = pk2(r[0], r[1]); o.y = pk2(r[2], r[3]); o.z = pk2(r[4], r[5]); o.w = pk2(r[6], r[7]);
            ST[(size_t)((b * 16 + ch) * 16 + h) * 1024 + e8] = o;
            const float d = dec[ch];
#pragma unroll
            for (int j = 0; j < 4; ++j) { r[2 * j] = d * r[2 * j] + lo_bf(loc[ch][j]); r[2 * j + 1] = d * r[2 * j + 1] + hi_bf(loc[ch][j]); }
        }
    }
}
__device__ __forceinline__ void phase_ssd_out_g(const Params& p, const Ctx& c, int l) {
    LAS bf16_t* Cs = (LAS bf16_t*)c.lds;
    LAS bf16_t* CB = (LAS bf16_t*)(c.lds + 34816);
    LAS bf16_t* BD = (LAS bf16_t*)(c.lds + 2 * 34816);
    LAS bf16_t* XS = (LAS bf16_t*)(c.lds + 3 * 34816);
    LAS bf16_t* STs = (LAS bf16_t*)(c.lds + 3 * 34816 + 18432);
    LAS float* acs = (LAS float*)(c.lds + 3 * 34816 + 18432 + 17408);
    LAS float* dts = acs + 1024;
    const bf16_t* XA = (const bf16_t*)(p.ws + WS_XBC); const float* dt = (const float*)(p.ws + WS_DT); const float* acum = (const float*)(p.ws + WS_ACUM);
    const bf16_t* ST = (const bf16_t*)(p.ws + WS_SST); bf16_t* YP = (bf16_t*)(p.ws + WS_H);
    const bf16_t* U = (const bf16_t*)(p.ws + WS_U); bf16_t* YC = (bf16_t*)(p.ws + WS_YCAT);
    const float* nw = p.in[I_SNW] + (size_t)l * 1024;
    const int fr = c.lane & 15, fq = c.lane >> 4, w = c.wave;
    for (int it = c.bid; it < 256; it += c.G) {
        const int g = it & 1, bc = it >> 1, tok0 = bc * 128;
        for (int i = c.tid; i < 128 * 16; i += NTHREADS) { const int row = i >> 4, ck = i & 15;
            *(LAS u32x4*)(BD + row * 136 + ck * 8) = *(const u32x4*)(XA + (size_t)(tok0 + row) * 1536 + 1024 + g * 128 + ck * 8);
            *(LAS u32x4*)(Cs + row * 136 + ck * 8) = *(const u32x4*)(XA + (size_t)(tok0 + row) * 1536 + 1280 + g * 128 + ck * 8); }
        for (int i = c.tid; i < 1024; i += NTHREADS) { const int h8 = i >> 7, lr = i & 127; acs[i] = acum[(size_t)(tok0 + lr) * 16 + g * 8 + h8]; dts[i] = dt[(size_t)(tok0 + lr) * 16 + g * 8 + h8]; }
        LDS_BARRIER();
        {
            f32x4 cb[8];
#pragma unroll
            for (int n = 0; n < 8; ++n) cb[n] = (f32x4){0.f, 0.f, 0.f, 0.f};
#pragma unroll
            for (int ks = 0; ks < 4; ++ks) {
                const bf16x8 afr = *(const LAS bf16x8*)(Cs + (16 * w + fr) * 136 + ks * 32 + 8 * fq);
#pragma unroll
                for (int n = 0; n < 8; ++n) { const bf16x8 bfr = *(const LAS bf16x8*)(BD + (16 * n + fr) * 136 + ks * 32 + 8 * fq); cb[n] = MFMA16(bfr, afr, cb[n]); }
            }
            const int lr = 16 * w + fr;
#pragma unroll
            for (int n = 0; n < 8; ++n) { u32x2 o; o.x = pk2(cb[n][0], cb[n][1]); o.y = pk2(cb[n][2], cb[n][3]); *(LAS u32x2*)(CB + lr * 136 + 16 * n + 4 * fq) = o; }
        }
        LDS_BARRIER();
        u32x4 pst[2], pxs[2];
#pragma unroll
        for (int q = 0; q < 2; ++q) { const int i = c.tid + q * NTHREADS;
            pst[q] = *(const u32x4*)(ST + (size_t)(bc * 16 + g * 8) * 8192 + (i >> 4) * 128 + (i & 15) * 8);
            pxs[q] = *(const u32x4*)(XA + (size_t)(tok0 + (i >> 3)) * 1536 + (g * 8) * 64 + (i & 7) * 8); }
        for (int h8 = 0; h8 < 8; ++h8) {
            const int h = g * 8 + h8;
            const float Dh = p.in[I_SD][l * 16 + h];
            const LAS float* ah = acs + h8 * 128; const LAS float* dh = dts + h8 * 128;
#pragma unroll
            for (int q = 0; q < 2; ++q) { const int i = c.tid + q * NTHREADS;
                *(LAS u32x4*)(STs + (i >> 4) * 136 + (i & 15) * 8) = pst[q];
                const int lrow = i >> 3, ck = i & 7; const u32x4 r = pxs[q]; const float f = dh[lrow];
                u32x4 o; o.x = pk2(lo_bf(r.x) * f, hi_bf(r.x) * f); o.y = pk2(lo_bf(r.y) * f, hi_bf(r.y) * f); o.z = pk2(lo_bf(r.z) * f, hi_bf(r.z) * f); o.w = pk2(lo_bf(r.w) * f, hi_bf(r.w) * f);
                *(LAS u32x4*)(XS + lrow * 72 + ck * 8) = o; }
            if (h8 < 7) {
#pragma unroll
                for (int q = 0; q < 2; ++q) { const int i = c.tid + q * NTHREADS;
                    pst[q] = *(const u32x4*)(ST + (size_t)(bc * 16 + h + 1) * 8192 + (i >> 4) * 128 + (i & 15) * 8);
                    pxs[q] = *(const u32x4*)(XA + (size_t)(tok0 + (i >> 3)) * 1536 + (h + 1) * 64 + (i & 7) * 8); } }
            for (int i = c.tid; i < 128 * 16; i += NTHREADS) { const int lr = i >> 4, ck = i & 15; u32x4 o = (u32x4){0u, 0u, 0u, 0u};
                if (8 * ck <= lr) { const u32x4 cv = *(const LAS u32x4*)(CB + lr * 136 + ck * 8); const float al = ah[lr];
                    const f32x4 s0 = *(const LAS f32x4*)(ah + 8 * ck), s1 = *(const LAS f32x4*)(ah + 8 * ck + 4);
                    float e[8];
#pragma unroll
                    for (int j = 0; j < 4; ++j) { e[j] = (8 * ck + j <= lr) ? __expf(al - s0[j]) : 0.f; e[4 + j] = (8 * ck + 4 + j <= lr) ? __expf(al - s1[j]) : 0.f; }
                    o.x = pk2(lo_bf(cv.x) * e[0], hi_bf(cv.x) * e[1]); o.y = pk2(lo_bf(cv.y) * e[2], hi_bf(cv.y) * e[3]); o.z = pk2(lo_bf(cv.z) * e[4], hi_bf(cv.z) * e[5]); o.w = pk2(lo_bf(cv.w) * e[6], hi_bf(cv.w) * e[7]); }
                *(LAS u32x4*)(BD + lr * 136 + ck * 8) = o; }
            LDS_BARRIER();
            {
                f32x4 a1[4], a2[4];
#pragma unroll
                for (int n = 0; n < 4; ++n) { a1[n] = (f32x4){0.f, 0.f, 0.f, 0.f}; a2[n] = (f32x4){0.f, 0.f, 0.f, 0.f}; }
#pragma unroll
                for (int ks = 0; ks < 4; ++ks) {
                    const bf16x8 ad = *(const LAS bf16x8*)(BD + (16 * w + fr) * 136 + ks * 32 + 8 * fq);
                    const bf16x8 ac = *(const LAS bf16x8*)(Cs + (16 * w + fr) * 136 + ks * 32 + 8 * fq);
#pragma unroll
                    for (int n = 0; n < 4; ++n) {
                        const bf16x8 bx = tr_frag(XS, 72, 32 * ks, 16 * n, c.lane);
                        const bf16x8 bs = *(const LAS bf16x8*)(STs + (16 * n + fr) * 136 + ks * 32 + 8 * fq);
                        a1[n] = MFMA16(bx, ad, a1[n]); a2[n] = MFMA16(bs, ac, a2[n]); }
                }
                const int lr = 16 * w + fr; const float ea = __expf(ah[lr]);
#pragma unroll
                for (int n = 0; n < 4; ++n) { const int pc = 16 * n + 4 * fq;
                    const u32x2 xv = *(const u32x2*)(XA + (size_t)(tok0 + lr) * 1536 + h * 64 + pc);
                    const float y0 = a1[n][0] + ea * a2[n][0] + Dh * lo_bf(xv.x), y1 = a1[n][1] + ea * a2[n][1] + Dh * hi_bf(xv.x);
                    const float y2 = a1[n][2] + ea * a2[n][2] + Dh * lo_bf(xv.y), y3 = a1[n][3] + ea * a2[n][3] + Dh * hi_bf(xv.y);
                    u32x2 o; o.x = pk2(y0, y1); o.y = pk2(y2, y3);
                    *(u32x2*)(YP + (size_t)(tok0 + lr) * DM + h * 64 + pc) = o; }
            }
            LDS_BARRIER();
        }
        __syncthreads();
        for (int pass = 0; pass < 2; ++pass) {
            const int tok = tok0 + pass * 64 + (c.tid >> 3), part = c.tid & 7, col = g * 512 + part * 8;
            u32x4 yv[8], zv[8];
#pragma unroll
            for (int i = 0; i < 8; ++i) { yv[i] = *(const u32x4*)(YP + (size_t)tok * DM + col + 64 * i); zv[i] = *(const u32x4*)(U + (size_t)tok * NU + UZ + col + 64 * i); }
            float v[64]; float ss = 0.f;
#pragma unroll
            for (int i = 0; i < 8; ++i)
#pragma unroll
                for (int j = 0; j < 4; ++j) { const float a = lo_bf(yv[i][j]) * siluf_(lo_bf(zv[i][j])), b2 = hi_bf(yv[i][j]) * siluf_(hi_bf(zv[i][j])); v[8 * i + 2 * j] = a; v[8 * i + 2 * j + 1] = b2; ss += a * a + b2 * b2; }
            ss += shfl_xor_l(ss, 1, c.lane); ss += shfl_xor_l(ss, 2, c.lane); ss += shfl_xor_l(ss, 4, c.lane);
            const float rstd = rsqf_(ss * (1.0f / 512.0f) + EPS);
#pragma unroll
            for (int i = 0; i < 8; ++i) { const f32x4 w0 = *(const f32x4*)(nw + col + 64 * i), w1 = *(const f32x4*)(nw + col + 64 * i + 4);
                u32x4 o; o.x = pk2(v[8 * i] * rstd * w0[0], v[8 * i + 1] * rstd * w0[1]); o.y = pk2(v[8 * i + 2] * rstd * w0[2], v[8 * i + 3] * rstd * w0[3]);
                o.z = pk2(v[8 * i + 4] * rstd * w1[0], v[8 * i + 5] * rstd * w1[1]); o.w = pk2(v[8 * i + 6] * rstd * w1[2], v[8 * i + 7] * rstd * w1[3]);
                *(u32x4*)(YC + (size_t)tok * 2048 + col + 64 * i) = o; }
        }
        LDS_BARRIER();
    }
}
__device__ __forceinline__ void phase_hg_state(const Params& p, const Ctx& c, int l) {
    LAS float* Bf = (LAS float*)c.lds;
    LAS float* KK = (LAS float*)(c.lds + 33792);
    LAS bf16_t* KD = (LAS bf16_t*)(c.lds + 2 * 33792 + 2112);
    LAS bf16_t* VS = (LAS bf16_t*)(c.lds + 2 * 33792 + 2112 + 17408);
    const bf16_t* U = (const bf16_t*)(p.ws + WS_U); const float* lb = (const float*)(p.ws + WS_LB) + l * 512;
    bf16_t* ST = (bf16_t*)(p.ws + WS_HST); float* BL = (float*)(p.ws + WS_HGBL);
    const int fr = c.lane & 15, fq = c.lane >> 4, w = c.wave;
    u32x4 pf[2], pv[2];
#define HS_LOAD(item) do { const int ch_ = (item) & 31, bh_ = (item) >> 5, h_ = bh_ & 3, b_ = bh_ >> 2, tk_ = b_ * SEQ + ch_ * 64; _Pragma("unroll") for (int q_ = 0; q_ < 2; ++q_) { const int i_ = c.tid + q_ * NTHREADS; \
        const size_t ro_ = (size_t)(tk_ + (i_ >> 4)) * NU + h_ * 128 + (i_ & 15) * 8; pf[q_] = *(const u32x4*)(U + ro_ + UHF); pv[q_] = *(const u32x4*)(U + ro_ + UHV); } } while (0)
    if (c.bid < 1024) HS_LOAD(c.bid);
    for (int it = c.bid; it < 1024; it += c.G) {
        const int ch = it & 31, bh = it >> 5, h = bh & 3, b = bh >> 2, tok0 = b * SEQ + ch * 64;
#pragma unroll
        for (int q = 0; q < 2; ++q) { const int i = c.tid + q * NTHREADS, sr = i >> 4, ck = i & 15;
            const u32x4 rf = pf[q];
            *(LAS u32x4*)(VS + sr * 136 + ck * 8) = pv[q];
            const f32x4 l0 = *(const f32x4*)(lb + h * 128 + ck * 8), l1 = *(const f32x4*)(lb + h * 128 + ck * 8 + 4);
            f32x4 k0, k1, g0, g1;
            k0[0] = (1.0f - l0[0]) * sigmoidf_(-lo_bf(rf.x)); k0[1] = (1.0f - l0[1]) * sigmoidf_(-hi_bf(rf.x)); k0[2] = (1.0f - l0[2]) * sigmoidf_(-lo_bf(rf.y)); k0[3] = (1.0f - l0[3]) * sigmoidf_(-hi_bf(rf.y));
            k1[0] = (1.0f - l1[0]) * sigmoidf_(-lo_bf(rf.z)); k1[1] = (1.0f - l1[1]) * sigmoidf_(-hi_bf(rf.z)); k1[2] = (1.0f - l1[2]) * sigmoidf_(-lo_bf(rf.w)); k1[3] = (1.0f - l1[3]) * sigmoidf_(-hi_bf(rf.w));
#pragma unroll
            for (int j = 0; j < 4; ++j) { g0[j] = __logf(1.0f - k0[j]); g1[j] = __logf(1.0f - k1[j]); }
            *(LAS f32x4*)(KK + sr * 132 + ck * 8) = k0; *(LAS f32x4*)(KK + sr * 132 + ck * 8 + 4) = k1;
            *(LAS f32x4*)(Bf + sr * 132 + ck * 8) = g0; *(LAS f32x4*)(Bf + sr * 132 + ck * 8 + 4) = g1; }
        if (it + c.G < 1024) HS_LOAD(it + c.G);
        LDS_BARRIER();
        { const int kc = c.tid & 127, q4 = c.tid >> 7; float vals[16]; float cum = 0.f;
#pragma unroll
          for (int i = 0; i < 16; ++i) { cum += Bf[(16 * q4 + i) * 132 + kc]; vals[i] = cum; }
          KK[(64 + q4) * 132 + kc] = cum;
          LDS_BARRIER();
          float off = 0.f;
#pragma unroll
          for (int j = 0; j < 3; ++j) off += (j < q4) ? KK[(64 + j) * 132 + kc] : 0.f;
#pragma unroll
          for (int i = 0; i < 16; ++i) Bf[(16 * q4 + i) * 132 + kc] = vals[i] + off;
          if (q4 == 3) BL[(size_t)it * 128 + kc] = vals[15] + off; }
        LDS_BARRIER();
        for (int i = c.tid; i < 64 * 16; i += NTHREADS) { const int sr = i >> 4, ck = i & 15;
            const f32x4 ka = *(const LAS f32x4*)(KK + sr * 132 + ck * 8), kb = *(const LAS f32x4*)(KK + sr * 132 + ck * 8 + 4);
            const f32x4 ba = *(const LAS f32x4*)(Bf + sr * 132 + ck * 8), bb = *(const LAS f32x4*)(Bf + sr * 132 + ck * 8 + 4);
            const f32x4 ea = *(const LAS f32x4*)(Bf + 63 * 132 + ck * 8), eb = *(const LAS f32x4*)(Bf + 63 * 132 + ck * 8 + 4);
            u32x4 o; o.x = pk2(ka[0] * __expf(ea[0] - ba[0]), ka[1] * __expf(ea[1] - ba[1])); o.y = pk2(ka[2] * __expf(ea[2] - ba[2]), ka[3] * __expf(ea[3] - ba[3]));
            o.z = pk2(kb[0] * __expf(eb[0] - bb[0]), kb[1] * __expf(eb[1] - bb[1])); o.w = pk2(kb[2] * __expf(eb[2] - bb[2]), kb[3] * __expf(eb[3] - bb[3]));
            *(LAS u32x4*)(KD + sr * 136 + ck * 8) = o; }
        LDS_BARRIER();
        f32x4 acc[8];
#pragma unroll
        for (int n = 0; n < 8; ++n) acc[n] = (f32x4){0.f, 0.f, 0.f, 0.f};
#pragma unroll
        for (int ks = 0; ks < 2; ++ks) {
            const bf16x8 afr = tr_frag(VS, 136, 32 * ks, 16 * w, c.lane);
#pragma unroll
            for (int n = 0; n < 8; ++n) { const bf16x8 bfr = tr_frag(KD, 136, 32 * ks, 16 * n, c.lane); acc[n] = MFMA16(bfr, afr, acc[n]); }
        }
#pragma unroll
        for (int n = 0; n < 8; ++n) { u32x2 o; o.x = pk2(acc[n][0], acc[n][1]); o.y = pk2(acc[n][2], acc[n][3]);
            *(u32x2*)(ST + (size_t)it * 16384 + (16 * w + fr) * 128 + 16 * n + 4 * fq) = o; }
        LDS_BARRIER();
    }
#undef HS_LOAD
}
__device__ __forceinline__ void phase_hg_scan(const Params& p, const Ctx& c) {
    u32x2* ST = (u32x2*)(p.ws + WS_HST); const float* BL = (const float*)(p.ws + WS_HGBL);
    for (int i = c.bid * NTHREADS + c.tid; i < 32 * 4096; i += c.G * NTHREADS) {
        const int e4 = i & 4095, bh = i >> 12, k0 = (4 * e4) & 127;
        float r[4] = {0.f, 0.f, 0.f, 0.f};
        for (int half = 0; half < 2; ++half) {
            u32x2 loc[16]; f32x4 dl[16];
#pragma unroll
            for (int cc = 0; cc < 16; ++cc) { const size_t it = (size_t)(bh * 32 + half * 16 + cc); loc[cc] = ST[it * 4096 + e4]; dl[cc] = *(const f32x4*)(BL + it * 128 + k0); }
#pragma unroll
            for (int cc = 0; cc < 16; ++cc) { const size_t it = (size_t)(bh * 32 + half * 16 + cc);
                u32x2 o; o.x = pk2(r[0], r[1]); o.y = pk2(r[2], r[3]);
                ST[it * 4096 + e4] = o;
                r[0] = __expf(dl[cc][0]) * r[0] + lo_bf(loc[cc].x); r[1] = __expf(dl[cc][1]) * r[1] + hi_bf(loc[cc].x);
                r[2] = __expf(dl[cc][2]) * r[2] + lo_bf(loc[cc].y); r[3] = __expf(dl[cc][3]) * r[3] + hi_bf(loc[cc].y); }
        }
    }
}
__device__ __forceinline__ void phase_hg_out(const Params& p, const Ctx& c, int l) {
    LAS bf16_t* Qs = (LAS bf16_t*)c.lds;
    LAS bf16_t* Ks = (LAS bf16_t*)(c.lds + 17408);
    LAS float* Bf = (LAS float*)(c.lds + 2 * 17408);
    LAS bf16_t* ATT = (LAS bf16_t*)(c.lds + 2 * 17408 + 33792);
    LAS bf16_t* VS = (LAS bf16_t*)(c.lds + 2 * 17408 + 33792 + 9216);
    LAS unsigned char* R5 = c.lds + 2 * 17408 + 33792 + 9216 + 17408;
    LAS bf16_t* QI3 = (LAS bf16_t*)R5;
    LAS bf16_t* KKI3 = (LAS bf16_t*)(R5 + 48 * 272);
    LAS bf16_t* STs = (LAS bf16_t*)R5;
    LAS float* QT = (LAS float*)(R5 + 40000);
    const bf16_t* U = (const bf16_t*)(p.ws + WS_U); const float* lb = (const float*)(p.ws + WS_LB) + l * 512;
    const bf16_t* ST = (const bf16_t*)(p.ws + WS_HST); bf16_t* YC = (bf16_t*)(p.ws + WS_YCAT);
    const float* nw = p.in[I_HNW] + (size_t)l * 512;
    const int fr = c.lane & 15, fq = c.lane >> 4, w = c.wave;
    u32x4 pq[2], pf[2], pv[2], pst[4];
#define HG_LOAD_QFV(item) do { const int ch_ = (item) & 31, bh_ = (item) >> 5, h_ = bh_ & 3, b_ = bh_ >> 2, tk_ = b_ * SEQ + ch_ * 64; _Pragma("unroll") for (int q_ = 0; q_ < 2; ++q_) { const int i_ = c.tid + q_ * NTHREADS; \
        const size_t ro_ = (size_t)(tk_ + (i_ >> 4)) * NU + h_ * 128 + (i_ & 15) * 8; pq[q_] = *(const u32x4*)(U + ro_ + UHQ); pf[q_] = *(const u32x4*)(U + ro_ + UHF); pv[q_] = *(const u32x4*)(U + ro_ + UHV); } } while (0)
#define HG_LOAD_ST(item) do { _Pragma("unroll") for (int q_ = 0; q_ < 4; ++q_) { const int i_ = c.tid + q_ * NTHREADS; pst[q_] = *(const u32x4*)(ST + (size_t)(item) * 16384 + (i_ >> 4) * 128 + (i_ & 15) * 8); } } while (0)
    if (c.bid < 1024) { HG_LOAD_QFV(c.bid); HG_LOAD_ST(c.bid); }
    for (int it = c.bid; it < 1024; it += c.G) {
        const int ch = it & 31, bh = it >> 5, h = bh & 3, b = bh >> 2, tok0 = b * SEQ + ch * 64;
        const bool more = (it + c.G) < 1024;
#pragma unroll
        for (int q = 0; q < 2; ++q) { const int i = c.tid + q * NTHREADS, sr = i >> 4, ck = i & 15;
            const u32x4 rq = pq[q], rf = pf[q];
            *(LAS u32x4*)(VS + sr * 136 + ck * 8) = pv[q];
            const f32x4 l0 = *(const f32x4*)(lb + h * 128 + ck * 8), l1 = *(const f32x4*)(lb + h * 128 + ck * 8 + 4);
            f32x4 k0, k1, g0, g1;
            k0[0] = (1.0f - l0[0]) * sigmoidf_(-lo_bf(rf.x)); k0[1] = (1.0f - l0[1]) * sigmoidf_(-hi_bf(rf.x)); k0[2] = (1.0f - l0[2]) * sigmoidf_(-lo_bf(rf.y)); k0[3] = (1.0f - l0[3]) * sigmoidf_(-hi_bf(rf.y));
            k1[0] = (1.0f - l1[0]) * sigmoidf_(-lo_bf(rf.z)); k1[1] = (1.0f - l1[1]) * sigmoidf_(-hi_bf(rf.z)); k1[2] = (1.0f - l1[2]) * sigmoidf_(-lo_bf(rf.w)); k1[3] = (1.0f - l1[3]) * sigmoidf_(-hi_bf(rf.w));
#pragma unroll
            for (int j = 0; j < 4; ++j) { g0[j] = __logf(1.0f - k0[j]); g1[j] = __logf(1.0f - k1[j]); }
            u32x4 ko; ko.x = pk2(k0[0], k0[1]); ko.y = pk2(k0[2], k0[3]); ko.z = pk2(k1[0], k1[1]); ko.w = pk2(k1[2], k1[3]);
            u32x4 qo; qo.x = pk2(siluf_(lo_bf(rq.x)), siluf_(hi_bf(rq.x))); qo.y = pk2(siluf_(lo_bf(rq.y)), siluf_(hi_bf(rq.y))); qo.z = pk2(siluf_(lo_bf(rq.z)), siluf_(hi_bf(rq.z))); qo.w = pk2(siluf_(lo_bf(rq.w)), siluf_(hi_bf(rq.w)));
            *(LAS u32x4*)(Ks + sr * 136 + ck * 8) = ko; *(LAS u32x4*)(Qs + sr * 136 + ck * 8) = qo;
            *(LAS f32x4*)(Bf + sr * 132 + ck * 8) = g0; *(LAS f32x4*)(Bf + sr * 132 + ck * 8 + 4) = g1; }
        if (more) HG_LOAD_QFV(it + c.G);
        LDS_BARRIER();
        { const int kc = c.tid & 127, q4 = c.tid >> 7; float vals[16]; float cum = 0.f;
#pragma unroll
          for (int i = 0; i < 16; ++i) { cum += Bf[(16 * q4 + i) * 132 + kc]; vals[i] = cum; }
          QT[q4 * 128 + kc] = cum;
          LDS_BARRIER();
          float off = 0.f;
#pragma unroll
          for (int j = 0; j < 3; ++j) off += (j < q4) ? QT[j * 128 + kc] : 0.f;
#pragma unroll
          for (int i = 0; i < 16; ++i) Bf[(16 * q4 + i) * 132 + kc] = vals[i] + off; }
        LDS_BARRIER();
        for (int i = c.tid; i < 48 * 64; i += NTHREADS) { const int rowq = i >> 6, kp = i & 63, ib = (rowq >> 4) + 1, t = 16 + rowq, rref = 16 * ib - 1;
            const unsigned q2 = *(const LAS unsigned*)(Qs + t * 136 + 2 * kp);
            *(LAS unsigned*)(QI3 + rowq * 136 + 2 * kp) = pk2(lo_bf(q2) * __expf(Bf[t * 132 + 2 * kp] - Bf[rref * 132 + 2 * kp]), hi_bf(q2) * __expf(Bf[t * 132 + 2 * kp + 1] - Bf[rref * 132 + 2 * kp + 1])); }
        for (int i = c.tid; i < 96 * 64; i += NTHREADS) { const int rowk = i >> 6, kp = i & 63; const int ib = (rowk < 16) ? 1 : (rowk < 48 ? 2 : 3), s2 = rowk - 8 * ib * (ib - 1), rref = 16 * ib - 1;
            const unsigned k2 = *(const LAS unsigned*)(Ks + s2 * 136 + 2 * kp);
            *(LAS unsigned*)(KKI3 + rowk * 136 + 2 * kp) = pk2(lo_bf(k2) * __expf(Bf[rref * 132 + 2 * kp] - Bf[s2 * 132 + 2 * kp]), hi_bf(k2) * __expf(Bf[rref * 132 + 2 * kp + 1] - Bf[s2 * 132 + 2 * kp + 1])); }
        for (int pidx = c.tid; pidx < 1024; pidx += NTHREADS) {
            const int ib = pidx >> 8, tq = (pidx >> 4) & 15, sq = pidx & 15, t = 16 * ib + tq, s2 = 16 * ib + sq; float a = 0.f;
            if (sq <= tq) {
                for (int k = 0; k < 128; k += 4) {
                    const f32x4 bt = *(const LAS f32x4*)(Bf + t * 132 + k), bs = *(const LAS f32x4*)(Bf + s2 * 132 + k);
                    const u32x2 qv = *(const LAS u32x2*)(Qs + t * 136 + k), kv = *(const LAS u32x2*)(Ks + s2 * 136 + k);
                    a += lo_bf(qv.x) * lo_bf(kv.x) * __expf(bt[0] - bs[0]) + hi_bf(qv.x) * hi_bf(kv.x) * __expf(bt[1] - bs[1])
                       + lo_bf(qv.y) * lo_bf(kv.y) * __expf(bt[2] - bs[2]) + hi_bf(qv.y) * hi_bf(kv.y) * __expf(bt[3] - bs[3]);
                }
            }
            ATT[t * 72 + s2] = (bf16_t)f2bf(a);
        }
        for (int i = c.tid; i < 6 * 256; i += NTHREADS) { const int blk = i >> 8, e = i & 255; const int bi = (blk < 3) ? 0 : (blk < 5 ? 1 : 2), bj = (blk < 3) ? blk + 1 : (blk < 5 ? blk - 1 : 3);
            ATT[(16 * bi + (e >> 4)) * 72 + 16 * bj + (e & 15)] = (bf16_t)0; }
        LDS_BARRIER();
        if (w < 6) {
            const int ib = (w == 0) ? 1 : (w < 3 ? 2 : 3), jb = w - ((ib * (ib - 1)) >> 1);
            f32x4 a4 = (f32x4){0.f, 0.f, 0.f, 0.f};
#pragma unroll
            for (int ks = 0; ks < 4; ++ks) { const bf16x8 afr = *(const LAS bf16x8*)(QI3 + (16 * (ib - 1) + fr) * 136 + ks * 32 + 8 * fq), bfr = *(const LAS bf16x8*)(KKI3 + (8 * ib * (ib - 1) + 16 * jb + fr) * 136 + ks * 32 + 8 * fq); a4 = MFMA16(afr, bfr, a4); }
#pragma unroll
            for (int r = 0; r < 4; ++r) ATT[(16 * ib + 4 * fq + r) * 72 + 16 * jb + fr] = (bf16_t)f2bf(a4[r]);
        }
        for (int i = c.tid; i < 64 * 64; i += NTHREADS) { const int t = i >> 6, kp = i & 63;
            const unsigned q2 = *(const LAS unsigned*)(Qs + t * 136 + 2 * kp);
            *(LAS unsigned*)(Qs + t * 136 + 2 * kp) = pk2(lo_bf(q2) * __expf(Bf[t * 132 + 2 * kp]), hi_bf(q2) * __expf(Bf[t * 132 + 2 * kp + 1])); }
        LDS_BARRIER();
#pragma unroll
        for (int q = 0; q < 4; ++q) { const int i = c.tid + q * NTHREADS; *(LAS u32x4*)(STs + (i >> 4) * 136 + (i & 15) * 8) = pst[q]; }
        if (more) HG_LOAD_ST(it + c.G);
        LDS_BARRIER();
        f32x4 acc[4];
#pragma unroll
        for (int m = 0; m < 4; ++m) acc[m] = (f32x4){0.f, 0.f, 0.f, 0.f};
#pragma unroll
        for (int ks = 0; ks < 4; ++ks) {
            const bf16x8 bfr = *(const LAS bf16x8*)(STs + (16 * w + fr) * 136 + ks * 32 + 8 * fq);
#pragma unroll
            for (int m = 0; m < 4; ++m) { const bf16x8 afr = *(const LAS bf16x8*)(Qs + (16 * m + fr) * 136 + ks * 32 + 8 * fq); acc[m] = MFMA16(afr, bfr, acc[m]); }
        }
#pragma unroll
        for (int ks = 0; ks < 2; ++ks) {
            const bf16x8 bfr = tr_frag(VS, 136, 32 * ks, 16 * w, c.lane);
#pragma unroll
            for (int m = 0; m < 4; ++m) { const bf16x8 afr = *(const LAS bf16x8*)(ATT + (16 * m + fr) * 72 + ks * 32 + 8 * fq); acc[m] = MFMA16(afr, bfr, acc[m]); }
        }
#pragma unroll
        for (int m = 0; m < 4; ++m)
#pragma unroll
            for (int r = 0; r < 4; ++r) Bf[(16 * m + 4 * fq + r) * 132 + 16 * w + fr] = acc[m][r];
        LDS_BARRIER();
        {
            const int t = c.tid >> 3, part = c.tid & 7;
            f32x4 o4[4]; float ss = 0.f;
#pragma unroll
            for (int i = 0; i < 4; ++i) { o4[i] = *(const LAS f32x4*)(Bf + t * 132 + part * 16 + 4 * i); ss += (o4[i][0] * o4[i][0] + o4[i][1] * o4[i][1]) + (o4[i][2] * o4[i][2] + o4[i][3] * o4[i][3]); }
            const u32x4 g0 = *(const u32x4*)(U + (size_t)(tok0 + t) * NU + UHG + h * 128 + part * 16), g1 = *(const u32x4*)(U + (size_t)(tok0 + t) * NU + UHG + h * 128 + part * 16 + 8);
            ss += shfl_xor_l(ss, 1, c.lane); ss += shfl_xor_l(ss, 2, c.lane); ss += shfl_xor_l(ss, 4, c.lane);
            const float rstd = rsqf_(ss * (1.0f / 128.0f) + EPS);
            const float* nwp = nw + h * 128 + part * 16;
            const f32x4 n0 = *(const f32x4*)(nwp), n1 = *(const f32x4*)(nwp + 4), n2 = *(const f32x4*)(nwp + 8), n3 = *(const f32x4*)(nwp + 12);
            u32x4 r0, r1;
            r0.x = pk2(o4[0][0] * rstd * n0[0] * siluf_(lo_bf(g0.x)), o4[0][1] * rstd * n0[1] * siluf_(hi_bf(g0.x))); r0.y = pk2(o4[0][2] * rstd * n0[2] * siluf_(lo_bf(g0.y)), o4[0][3] * rstd * n0[3] * siluf_(hi_bf(g0.y)));
            r0.z = pk2(o4[1][0] * rstd * n1[0] * siluf_(lo_bf(g0.z)), o4[1][1] * rstd * n1[1] * siluf_(hi_bf(g0.z))); r0.w = pk2(o4[1][2] * rstd * n1[2] * siluf_(lo_bf(g0.w)), o4[1][3] * rstd * n1[3] * siluf_(hi_bf(g0.w)));
            r1.x = pk2(o4[2][0] * rstd * n2[0] * siluf_(lo_bf(g1.x)), o4[2][1] * rstd * n2[1] * siluf_(hi_bf(g1.x))); r1.y = pk2(o4[2][2] * rstd * n2[2] * siluf_(lo_bf(g1.y)), o4[2][3] * rstd * n2[3] * siluf_(hi_bf(g1.y)));
            r1.z = pk2(o4[3][0] * rstd * n3[0] * siluf_(lo_bf(g1.z)), o4[3][1] * rstd * n3[1] * siluf_(hi_bf(g1.z))); r1.w = pk2(o4[3][2] * rstd * n3[2] * siluf_(lo_bf(g1.w)), o4[3][3] * rstd * n3[3] * siluf_(hi_bf(g1.w)));
            bf16_t* yo = YC + (size_t)(tok0 + t) * 2048 + 1024 + h * 128 + part * 16;
            *(u32x4*)yo = r0; *(u32x4*)(yo + 8) = r1;
        }
        LDS_BARRIER();
    }
#undef HG_LOAD_QFV
#undef HG_LOAD_ST
}

__device__ __forceinline__ void phase_lru1(const Params& p, const Ctx& c, int l) {
    LAS unsigned char* wl = c.lds + c.wave * 14336;
    LAS bf16_t* XB = (LAS bf16_t*)wl;
    LAS bf16_t* XR = (LAS bf16_t*)(wl + 12032);
    LAS float* As = (LAS float*)(wl + 2304);
    LAS float* Us = (LAS float*)(wl + 2304 + 4096);
    const bf16_t* U = (const bf16_t*)(p.ws + WS_U); bf16_t* LA = (bf16_t*)(p.ws + WS_LA); bf16_t* LH = (bf16_t*)(p.ws + WS_LH);
    const bf16_t* LW = (const bf16_t*)(p.ws + WS_LRUW) + (size_t)l * 2 * 8 * 4096;
    const int fr = c.lane & 15, fq = c.lane >> 4, g = c.wave, chn = g * 64 + c.lane;
    const float cw0 = p.in[I_LCW][(size_t)l * 2048 + chn], cw1 = p.in[I_LCW][(size_t)l * 2048 + 512 + chn], cw2 = p.in[I_LCW][(size_t)l * 2048 + 1024 + chn], cw3 = p.in[I_LCW][(size_t)l * 2048 + 1536 + chn];
    const float cbias = p.in[I_LCB][l * 512 + chn];
    bf16x8 wfa[4][2], wfx[4][2];
#pragma unroll
    for (int n = 0; n < 4; ++n)
#pragma unroll
        for (int ks = 0; ks < 2; ++ks) { wfa[n][ks] = *(const bf16x8*)(LW + (size_t)(0 * 8 + g) * 4096 + (16 * n + fr) * 64 + ks * 32 + 8 * fq);
                                         wfx[n][ks] = *(const bf16x8*)(LW + (size_t)(1 * 8 + g) * 4096 + (16 * n + fr) * 64 + ks * 32 + 8 * fq); }
    float bav[4], bxv[4], spl[4];
#pragma unroll
    for (int n = 0; n < 4; ++n) { const int j = g * 64 + 16 * n + fr; bav[n] = p.in[I_LBA][l * 512 + j]; bxv[n] = p.in[I_LBX][l * 512 + j]; spl[n] = softplusf_(-p.in[I_LLAM][l * 512 + j]); }
    for (int it = c.bid; it < 256; it += c.G) {
        const int seg = it & 31, tok0 = (it >> 5) * SEQ + seg * 64;
        float x0 = 0.f, x1 = 0.f, x2 = 0.f;
        if (seg > 0) { x0 = bf2f(U[(size_t)(tok0 - 3) * NU + ULX + chn]); x1 = bf2f(U[(size_t)(tok0 - 2) * NU + ULX + chn]); x2 = bf2f(U[(size_t)(tok0 - 1) * NU + ULX + chn]); }
        float hrun = 0.f, arun = 1.f;
        u32x4 praw[2];
#pragma unroll
        for (int q = 0; q < 2; ++q) { const int ci = c.lane + 64 * q; praw[q] = *(const u32x4*)(U + (size_t)(tok0 + (ci >> 3)) * NU + ULX + g * 64 + (ci & 7) * 8); }
        for (int st = 0; st < 4; ++st) {
            const int t0 = tok0 + st * 16;
#pragma unroll
            for (int q = 0; q < 2; ++q) { const int ci = c.lane + 64 * q; *(LAS u32x4*)(XR + (ci >> 3) * 72 + (ci & 7) * 8) = praw[q]; }
            if (st < 3) {
#pragma unroll
                for (int q = 0; q < 2; ++q) { const int ci = c.lane + 64 * q; praw[q] = *(const u32x4*)(U + (size_t)(t0 + 16 + (ci >> 3)) * NU + ULX + g * 64 + (ci & 7) * 8); } }
            LDS_WAIT();
#pragma unroll
            for (int tt = 0; tt < 16; ++tt) { const float xr = bf2f(XR[tt * 72 + c.lane]);
                const float xb = cbias + cw0 * x0 + cw1 * x1 + cw2 * x2 + cw3 * xr; x0 = x1; x1 = x2; x2 = xr;
                XB[tt * 72 + c.lane] = (bf16_t)f2bf(xb); }
            LDS_WAIT();
            f32x4 ar[4], ai[4];
#pragma unroll
            for (int n = 0; n < 4; ++n) { ar[n] = (f32x4){0.f, 0.f, 0.f, 0.f}; ai[n] = (f32x4){0.f, 0.f, 0.f, 0.f}; }
#pragma unroll
            for (int ks = 0; ks < 2; ++ks) { const bf16x8 afr = *(const LAS bf16x8*)(XB + fr * 72 + ks * 32 + 8 * fq);
#pragma unroll
                for (int n = 0; n < 4; ++n) { ar[n] = MFMA16(afr, wfa[n][ks], ar[n]); ai[n] = MFMA16(afr, wfx[n][ks], ai[n]); } }
#pragma unroll
            for (int n = 0; n < 4; ++n)
#pragma unroll
                for (int r = 0; r < 4; ++r) { const int t = 4 * fq + r, j = 16 * n + fr;
                    const float rg = sigmoidf_(ar[n][r] + bav[n]), ig = sigmoidf_(ai[n][r] + bxv[n]);
                    const float la = -8.0f * rg * spl[n], a = __expf(la), mult = __builtin_amdgcn_sqrtf(fmaxf(fmaf(-a, a, 1.0f), 0.f));
                    As[t * 64 + j] = a; Us[t * 64 + j] = mult * ig * bf2f(XB[t * 72 + j]); }
            LDS_WAIT();
#pragma unroll
            for (int tt = 0; tt < 16; ++tt) { const float a = As[tt * 64 + c.lane], uu = Us[tt * 64 + c.lane];
                hrun = a * hrun + uu; arun = a * arun;
                LA[(size_t)(t0 + tt) * 512 + chn] = (bf16_t)f2bf(arun); LH[(size_t)(t0 + tt) * 512 + chn] = (bf16_t)f2bf(hrun); }
            LDS_WAIT();
        }
    }
}
__device__ __forceinline__ void phase_lru2(const Params& p, const Ctx& c, int l) {
    LAS float* YS = (LAS float*)c.lds;
    LAS float* RS = (LAS float*)(c.lds + 64 * 516 * 4);
    const bf16_t* U = (const bf16_t*)(p.ws + WS_U); const bf16_t* LA = (const bf16_t*)(p.ws + WS_LA); const bf16_t* LH = (const bf16_t*)(p.ws + WS_LH);
    bf16_t* YC = (bf16_t*)(p.ws + WS_YCAT);
    const int g = c.wave, chn = g * 64 + c.lane;
    const float nwv = p.in[I_LNW][l * 512 + chn];
    for (int it = c.bid; it < 256; it += c.G) {
        const int seg = it & 31, b = it >> 5, tok0 = b * SEQ + seg * 64;
        float hin = 0.f;
        for (int s2 = 0; s2 < seg; ++s2) { const size_t row = (size_t)(b * SEQ + s2 * 64 + 63); hin = bf2f(LH[row * 512 + chn]) + bf2f(LA[row * 512 + chn]) * hin; }
#pragma unroll 8
        for (int tt = 0; tt < 64; ++tt) { const size_t tok = (size_t)(tok0 + tt);
            const float hh = bf2f(LH[tok * 512 + chn]) + bf2f(LA[tok * 512 + chn]) * hin;
            YS[tt * 516 + chn] = hh * gelu_tanhf_(bf2f(U[tok * NU + ULG + chn])); }
        LDS_BARRIER();
        {
            const int t = c.tid >> 3, part = c.tid & 7; float ss = 0.f;
#pragma unroll
            for (int i = 0; i < 16; ++i) { const f32x4 v = *(const LAS f32x4*)(YS + t * 516 + 32 * i + 4 * part); ss += (v[0] * v[0] + v[1] * v[1]) + (v[2] * v[2] + v[3] * v[3]); }
            ss += shfl_xor_l(ss, 1, c.lane); ss += shfl_xor_l(ss, 2, c.lane); ss += shfl_xor_l(ss, 4, c.lane);
            if (part == 0) RS[t] = rsqf_(ss * (1.0f / 512.0f) + EPS);
        }
        LDS_BARRIER();
#pragma unroll 8
        for (int tt = 0; tt < 64; ++tt) YC[(size_t)(tok0 + tt) * 2048 + 1536 + chn] = (bf16_t)f2bf(YS[tt * 516 + chn] * RS[tt] * nwv);
        LDS_BARRIER();
    }
}

__device__ __forceinline__ void phase_norm_router(const Params& p, const Ctx& c, int l, const float* xin) {
    constexpr int HSTR = 1028;
    LAS float* HS = (LAS float*)c.lds;
    LAS float* PL = (LAS float*)(c.lds + 16 * HSTR * 4);
    LAS float* LG = (LAS float*)(c.lds + 16 * HSTR * 4 + 32768);
    const float* mod = (const float*)(p.ws + WS_MOD) + (size_t)l * 8 * NMOD;
    const float* nw = p.in[I_NFFN] + (size_t)l * DM;
    const float* WT = (const float*)(p.ws + WS_WRT) + (size_t)l * 64 * 1024;
    const float rbias = p.in[I_RB][l * NEXP + c.lane];
    bf16_t* H = (bf16_t*)(p.ws + WS_H);
    unsigned long long* selm = (unsigned long long*)(p.ws + WS_SELM); float* rw = (float*)(p.ws + WS_RW);
    const int fr = c.lane & 15, fq = c.lane >> 4, w = c.wave;
    int* cnt = (int*)(p.ws + WS_CNT);
    bf16x8 bhi[4][4], blo[4][4];
#pragma unroll
    for (int j = 0; j < 4; ++j)
#pragma unroll
        for (int n = 0; n < 4; ++n) { const float* wp = WT + (size_t)(16 * n + fr) * 1024 + 128 * w + 32 * j + 8 * fq; const f32x4 x0 = *(const f32x4*)wp, x1 = *(const f32x4*)(wp + 4);
            split_bf16(x0, x1, bhi[j][n], blo[j][n]); }
    int ecount = 0;
    const bf16_t* MIX = (const bf16_t*)(p.ws + WS_MIX);
    f32x4 xn[2][4];
    if (c.bid < NTOK / 16) {
#pragma unroll
        for (int q = 0; q < 2; ++q)
#pragma unroll
            for (int j = 0; j < 4; ++j) xn[q][j] = ((const f32x4*)(xin + (size_t)(c.bid * 16 + 2 * w + q) * DM) + c.lane)[64 * j];
    }
    for (int t16 = c.bid; t16 < NTOK / 16; t16 += c.G) {
        const int tokb = t16 * 16, b = tokb >> 11;
        f32x4 pa[4], pb[4];
#pragma unroll
        for (int j = 0; j < 4; ++j) { const int col = 256 * j + 4 * c.lane;
            const f32x4 w4 = *(const f32x4*)(nw + col), sc = *(const f32x4*)(mod + (size_t)b * NMOD + 4096 + col); pb[j] = *(const f32x4*)(mod + (size_t)b * NMOD + 3072 + col); pa[j] = w4 * (sc + 1.0f); }
#pragma unroll
        for (int q = 0; q < 2; ++q) {
            const int tl = 2 * w + q, tok = tokb + tl;
            f32x4 v[4]; float ss = 0.f;
#pragma unroll
            for (int j = 0; j < 4; ++j) { const f32x4 gm = *(const f32x4*)(mod + (size_t)b * NMOD + 2048 + 256 * j + 4 * c.lane); const u32x2 mv = *(const u32x2*)(MIX + (size_t)tok * DM + 256 * j + 4 * c.lane);
                v[j] = xn[q][j] + gm * (f32x4){lo_bf(mv.x), hi_bf(mv.x), lo_bf(mv.y), hi_bf(mv.y)};
                ss += (v[j][0] * v[j][0] + v[j][1] * v[j][1]) + (v[j][2] * v[j][2] + v[j][3] * v[j][3]); }
            const float rstd = rsqf_(wave_sum(ss, c.lane) * (1.0f / DM) + EPS);
#pragma unroll
            for (int j = 0; j < 4; ++j) {
                const int col = 256 * j + 4 * c.lane;
                const f32x4 h = (v[j] * rstd) * pa[j] + pb[j];
                u32x2 o; o.x = pk2(h[0], h[1]); o.y = pk2(h[2], h[3]);
                *(u32x2*)(H + (size_t)tok * DM + col) = o;
                *(LAS f32x4*)(HS + tl * HSTR + col) = h;
            }
            asm volatile("" ::: "memory");
        }
        if (t16 + c.G < NTOK / 16) {
#pragma unroll
            for (int q = 0; q < 2; ++q)
#pragma unroll
                for (int j = 0; j < 4; ++j) xn[q][j] = ((const f32x4*)(xin + (size_t)((t16 + c.G) * 16 + 2 * w + q) * DM) + c.lane)[64 * j];
        }
        LDS_BARRIER();
        {
            f32x4 acc[4];
#pragma unroll
            for (int n = 0; n < 4; ++n) acc[n] = (f32x4){0.f, 0.f, 0.f, 0.f};
#pragma unroll
            for (int j = 0; j < 4; ++j) {
                const int kk = 128 * w + 32 * j + 8 * fq;
                const f32x4 a0 = *(const LAS f32x4*)(HS + fr * HSTR + kk), a1 = *(const LAS f32x4*)(HS + fr * HSTR + kk + 4);
                bf16x8 ahi, alo; split_bf16(a0, a1, ahi, alo);
#pragma unroll
                for (int n = 0; n < 4; ++n) { acc[n] = MFMA16(ahi, bhi[j][n], acc[n]); acc[n] = MFMA16(ahi, blo[j][n], acc[n]); acc[n] = MFMA16(alo, bhi[j][n], acc[n]); }
            }
#pragma unroll
            for (int n = 0; n < 4; ++n)
#pragma unroll
                for (int r = 0; r < 4; ++r) PL[(w * 16 + 4 * fq + r) * 64 + 16 * n + fr] = acc[n][r];
        }
        LDS_BARRIER();
#pragma unroll
        for (int q = 0; q < 2; ++q) { const int i = c.tid + q * NTHREADS; float s2 = 0.f;
#pragma unroll
            for (int ww = 0; ww < 8; ++ww) s2 += PL[ww * 1024 + i];
            LG[i] = s2; }
        LDS_BARRIER();
#pragma unroll
        for (int q = 0; q < 2; ++q) {
            const int tl = 2 * w + q, tok = tokb + tl;
            const float s = sigmoidf_(LG[tl * 64 + c.lane]), v = s + rbias;
            float m1 = v;
            m1 = fmaxf(m1, shfl_xor_l(m1, 1, c.lane)); m1 = fmaxf(m1, shfl_xor_l(m1, 2, c.lane)); m1 = fmaxf(m1, shfl_xor_l(m1, 4, c.lane));
            const unsigned long long eq = __ballot(v == m1);
            const int gbase = c.lane & ~7;
            const unsigned gm = (unsigned)((eq >> gbase) & 0xffull);
            const int first = gbase + __builtin_ctz(gm);
            float m2 = (c.lane == first) ? -3.0e38f : v;
            m2 = fmaxf(m2, shfl_xor_l(m2, 1, c.lane)); m2 = fmaxf(m2, shfl_xor_l(m2, 2, c.lane)); m2 = fmaxf(m2, shfl_xor_l(m2, 4, c.lane));
            const float gs = m1 + m2;
            const int mygrp = c.lane >> 3; int grank = 0;
#pragma unroll
            for (int g2 = 0; g2 < 8; ++g2) { const float o = rdlane_f(gs, g2 * 8); grank += (o > gs || (o == gs && g2 < mygrp)) ? 1 : 0; }
            const float vm = (grank < 4) ? v : -1.0e4f;
            int erank = 0;
            for (int e2 = 0; e2 < 64; ++e2) { const float o = rdlane_f(vm, e2); erank += (int)(o > vm) + (int)((o == vm) & (e2 < c.lane)); }
            const bool sel = erank < TOPK;
            const unsigned long long mask = __ballot(sel);
            const float wsum = wave_sum(sel ? s : 0.f, c.lane);
            if (sel) { const int kk = __builtin_popcountll(mask & ((1ull << c.lane) - 1ull)); rw[(size_t)tok * 8 + kk] = s * rcpf_(wsum) * 2.5f; }
            if (c.lane == 0) selm[tok] = mask;
            ecount += sel ? 1 : 0;
        }
        LDS_BARRIER();
    }
    { LAS int* CW = (LAS int*)c.lds; CW[w * 64 + c.lane] = ecount; LDS_BARRIER();
      if (w == 0) { int tot = 0;
#pragma unroll
          for (int ww = 0; ww < 8; ++ww) tot += CW[ww * 64 + c.lane];
          cnt[c.bid * 64 + c.lane] = tot; }
      LDS_BARRIER(); }
}
__device__ __forceinline__ void phase_route_assign(const Params& p, const Ctx& c) {
    const unsigned long long* selm = (const unsigned long long*)(p.ws + WS_SELM); const int* cnt = (const int*)(p.ws + WS_CNT);
    int* slot_tok = (int*)(p.ws + WS_SLOTTOK); int* slot_of = (int*)(p.ws + WS_SLOTOF); int* rinfo = (int*)(p.ws + WS_RINFO);
    LAS int* PT = (LAS int*)c.lds;
    LAS int* PB = PT + 512;
    LAS int* TC = PB + 512;
    const int w = c.wave, ntile = (NTOK / 16 + c.G - 1) / c.G;
    for (int ch = c.bid; ch < c.G; ch += c.G) {
        { int tot = 0, bef = 0; const int per = (c.G + 7) / 8;
#pragma unroll 8
          for (int jj = 0; jj < per; ++jj) { const int j = w * per + jj; const int v = (j < c.G) ? cnt[j * 64 + c.lane] : 0; tot += v; bef += (j < ch) ? v : 0; }
          PT[w * 64 + c.lane] = tot; PB[w * 64 + c.lane] = bef; }
        const int t16 = ch + w * c.G; const bool have = (w < ntile) && (t16 < NTOK / 16);
        unsigned long long mine = 0ull; int tcount = 0;
        if (have) { mine = (c.lane < 16) ? selm[t16 * 16 + c.lane] : 0ull;
            for (int i = 0; i < 16; ++i) { const unsigned long long m = rdlane_u64(mine, i); tcount += (int)((m >> c.lane) & 1ull); } }
        TC[w * 64 + c.lane] = tcount;
        LDS_BARRIER();
        int total = 0, before = 0;
#pragma unroll
        for (int ww = 0; ww < 8; ++ww) { total += PT[ww * 64 + c.lane]; before += PB[ww * 64 + c.lane]; }
        const int pad = (total + 255) & ~255;
        int incl = pad;
#pragma unroll
        for (int o = 1; o < 64; o <<= 1) { const int t = shfl_up_l(incl, o, c.lane); if (c.lane >= o) incl += t; }
        const int pstart = incl - pad;
        if (have) {
            int run = pstart + before;
            for (int ww = 0; ww < w; ++ww) run += TC[ww * 64 + c.lane];
            for (int i = 0; i < 16; ++i) {
                const unsigned long long m = rdlane_u64(mine, i); const int tok = t16 * 16 + i;
                if ((m >> c.lane) & 1ull) { const int kk = __builtin_popcountll(m & ((1ull << c.lane) - 1ull)); slot_tok[run] = tok; slot_of[tok * 8 + kk] = run; ++run; }
            }
        }
        if (ch == 0 && w == 7) {
            for (int s2 = pstart + total; s2 < pstart + pad; ++s2) slot_tok[s2] = -1;
            for (int bk = pstart >> 8; bk < (pstart + pad) >> 8; ++bk) rinfo[64 + bk] = c.lane;
            if (c.lane == 63) rinfo[0] = incl >> 8;
        }
        LDS_BARRIER();
    }
}
__device__ __forceinline__ void phase_combine(const Params& p, const Ctx& c, int l, const float* xin) {
    const float* gate = (const float*)(p.ws + WS_MOD) + (size_t)l * 8 * NMOD + 5120; const float* gatem = gate - 3072; const bf16_t* MIX = (const bf16_t*)(p.ws + WS_MIX);
    const unsigned char* Y = (const unsigned char*)(p.ws + WS_Y); const unsigned char* YS = (const unsigned char*)(p.ws + WS_YSH); const int* slot_of = (const int*)(p.ws + WS_SLOTOF); const float* rw = (const float*)(p.ws + WS_RW);
    const float* fw = p.in[I_FNW];
    if (l + 1 < NLAYER) load_wdt(p, c, l + 1, (LAS float*)c.lds);
    const int gw = c.bid * NWAVES + c.wave, NGW = c.G * NWAVES;
    int sln[8]; float wkn[8];
#pragma unroll
    for (int k = 0; k < 8; ++k) { sln[k] = (gw < NTOK) ? slot_of[gw * 8 + k] : 0; wkn[k] = (gw < NTOK) ? rw[gw * 8 + k] : 0.f; }
    for (int tok = gw; tok < NTOK; tok += NGW) {
        const int b = tok >> 11;
        f32x4 acc[4], gvv[4], xv0[4];
        f32x4* xr = (f32x4*)(p.out + (size_t)tok * DM) + c.lane;
        int slc[8]; float wkc[8];
#pragma unroll
        for (int k = 0; k < 8; ++k) { slc[k] = sln[k]; wkc[k] = wkn[k] * Y8_INV; }
#pragma unroll
        for (int j = 0; j < 4; ++j) { acc[j] = (f32x4){0.f, 0.f, 0.f, 0.f}; gvv[j] = *(const f32x4*)(gate + (size_t)b * NMOD + 256 * j + 4 * c.lane);
            const f32x4 gm = *(const f32x4*)(gatem + (size_t)b * NMOD + 256 * j + 4 * c.lane); const u32x2 mv = *(const u32x2*)(MIX + (size_t)tok * DM + 256 * j + 4 * c.lane);
            xv0[j] = ((const f32x4*)(xin + (size_t)tok * DM) + c.lane)[64 * j] + gm * (f32x4){lo_bf(mv.x), hi_bf(mv.x), lo_bf(mv.y), hi_bf(mv.y)}; }
        int yraw[8][4];
#pragma unroll
        for (int k = 0; k < 8; ++k)
#pragma unroll
            for (int j = 0; j < 4; ++j) yraw[k][j] = (int)*(const unsigned*)(Y + (size_t)slc[k] * DM + 256 * j + 4 * c.lane);
        if (tok + NGW < NTOK) {
#pragma unroll
            for (int k = 0; k < 8; ++k) { sln[k] = slot_of[(tok + NGW) * 8 + k]; wkn[k] = rw[(tok + NGW) * 8 + k]; } }
#pragma unroll
        for (int k = 0; k < 8; ++k) { const float wk = wkc[k];
#pragma unroll
            for (int j = 0; j < 4; ++j) { const int yw = yraw[k][j];
                const f32x2 y01 = __builtin_amdgcn_cvt_pk_f32_fp8(yw, false), y23 = __builtin_amdgcn_cvt_pk_f32_fp8(yw, true);
                acc[j][0] += wk * y01[0]; acc[j][1] += wk * y01[1]; acc[j][2] += wk * y23[0]; acc[j][3] += wk * y23[1]; } }
#pragma unroll
        for (int j = 0; j < 4; ++j) { const int yw = (int)*(const unsigned*)(YS + (size_t)tok * DM + 256 * j + 4 * c.lane);
            const f32x2 y01 = __builtin_amdgcn_cvt_pk_f32_fp8(yw, false), y23 = __builtin_amdgcn_cvt_pk_f32_fp8(yw, true);
            acc[j][0] += Y8_INV * y01[0]; acc[j][1] += Y8_INV * y01[1]; acc[j][2] += Y8_INV * y23[0]; acc[j][3] += Y8_INV * y23[1]; }
        f32x4 v[4]; float ss = 0.f;
#pragma unroll
        for (int j = 0; j < 4; ++j) { v[j] = xv0[j] + gvv[j] * acc[j];
            ss += (v[j][0] * v[j][0] + v[j][1] * v[j][1]) + (v[j][2] * v[j][2] + v[j][3] * v[j][3]); }
        if (l == NLAYER - 1) {
            const float rstd = rsqf_(wave_sum(ss, c.lane) * (1.0f / DM) + EPS);
#pragma unroll
            for (int j = 0; j < 4; ++j) { const f32x4 w4 = *(const f32x4*)(fw + 256 * j + 4 * c.lane); xr[64 * j] = v[j] * rstd * w4; }
        } else {
#pragma unroll
            for (int j = 0; j < 4; ++j) xr[64 * j] = v[j];
            norm_mix_row(c, v, ss, tok, p.in[I_NMIX] + (size_t)(l + 1) * DM, (const float*)(p.ws + WS_MOD) + (size_t)(l + 1) * 8 * NMOD, (const LAS float*)c.lds, (bf16_t*)(p.ws + WS_H), (float*)(p.ws + WS_DTRAW));
        }
    }
}


#define XB_TMO      128
#define XB_XCNT(j)  (256  + 64 * (j))
#define XB_XSUB(j)  (1280 + 64 * (j))
#define XB_XGEN(j)  (2304 + 64 * (j))
#define XB_TOP      3328
#define XB_TOPGEN   3392
#define XCD_BAR_WORDS 3456
#define XB_SPIN_CAP (1u << 18)
constexpr int LDS_XBST = LDS_PTAB + 320;
__device__ __forceinline__ unsigned xb_ld(unsigned* p)              { return __hip_atomic_load(p, __ATOMIC_RELAXED, __HIP_MEMORY_SCOPE_AGENT); }
__device__ __forceinline__ unsigned xb_add(unsigned* p, unsigned v) { return __hip_atomic_fetch_add(p, v, __ATOMIC_RELAXED, __HIP_MEMORY_SCOPE_AGENT); }
__device__ __forceinline__ unsigned xb_xcc_id() { return (unsigned)__builtin_amdgcn_s_getreg((3 << 11) | 20) & 0xFu; }
#define XB_SPIN(cond, bar) do { unsigned _sp = 0; while (cond) { __builtin_amdgcn_s_sleep(1); \
    if ((++_sp & 255u) == 0u) { if (xb_ld(&(bar)[XB_TMO])) break; if (_sp > XB_SPIN_CAP) { atomicAdd(&(bar)[XB_TMO], 1u); break; } } } } while (0)
__device__ __forceinline__ void xcd_barrier_complete(unsigned* bar, unsigned x, unsigned& nloc, unsigned& nx) {
    const unsigned G = gridDim.x * gridDim.y * gridDim.z;
    unsigned sum, cnt, mine, sp = 0u;
    for (;;) {
        sum = 0u; cnt = 0u; mine = 0u;
#pragma unroll
        for (unsigned j = 0; j < 16; ++j) { const unsigned c = xb_ld(&bar[XB_XCNT(j)]); sum += c; cnt += (c > 0u) ? 1u : 0u; mine = (j == x) ? c : mine; }
        if (sum == G) break;
        __builtin_amdgcn_s_sleep(1);
        if ((++sp & 255u) == 0u) { if (xb_ld(&bar[XB_TMO])) break; if (sp > XB_SPIN_CAP) { atomicAdd(&bar[XB_TMO], 1u); break; } }
    }
    nloc = mine > 0u ? mine : 1u; nx = cnt > 0u ? cnt : 1u;
}
__device__ __forceinline__ void xcd_barrier(unsigned* bar, volatile LAS unsigned* st, bool leader_thread) {
    asm volatile("s_waitcnt vmcnt(0)" ::: "memory");
    __syncthreads();
    if (leader_thread) {
        const unsigned x = xb_xcc_id();
        __builtin_amdgcn_s_waitcnt(0);
        unsigned nloc = st[0], nx = st[1];
        if (nloc == 0u) { xcd_barrier_complete(bar, x, nloc, nx); st[0] = nloc; st[1] = nx; }
        const unsigned old = xb_add(&bar[XB_XSUB(x)], 1u);
        const unsigned gen = old / nloc;
        if (old + 1u == (gen + 1u) * nloc) {
            __builtin_amdgcn_fence(__ATOMIC_RELEASE, "agent");
            asm volatile("s_waitcnt vmcnt(0)" ::: "memory");
            const unsigned og = xb_add(&bar[XB_TOP], 1u);
            const unsigned tg = og / nx;
            if (og + 1u == (tg + 1u) * nx) xb_add(&bar[XB_TOPGEN], 1u);
            else XB_SPIN(xb_ld(&bar[XB_TOPGEN]) == tg, bar);
            __builtin_amdgcn_fence(__ATOMIC_ACQUIRE, "agent");
            xb_add(&bar[XB_XGEN(x)], 1u);
            asm volatile("s_waitcnt vmcnt(0)" ::: "memory");
        } else {
            XB_SPIN(xb_ld(&bar[XB_XGEN(x)]) == gen, bar);
            __builtin_amdgcn_fence(__ATOMIC_ACQUIRE, "agent");
            asm volatile("s_waitcnt vmcnt(0)" ::: "memory");
        }
    }
    __syncthreads();
}

#ifndef PROBE_ID
#define PROBE_ID 0
#endif
#define RUN(id, stmt) do { stmt; if constexpr (PROBE_ID == (id)) { __syncthreads(); stmt; } } while (0)
constexpr int NQ_PHASE = 14;
__device__ __forceinline__ unsigned long long uni64(unsigned long long v) {
    const unsigned lo = (unsigned)__builtin_amdgcn_readfirstlane((int)(unsigned)v), hi = (unsigned)__builtin_amdgcn_readfirstlane((int)(unsigned)(v >> 32)); return ((unsigned long long)hi << 32) | lo; }
#if MK_MEGA
__device__ __forceinline__ void params_to_lds(const Params& p, LAS unsigned char* lds) {
    LAS unsigned long long* tab = (LAS unsigned long long*)(lds + LDS_PTAB);
#pragma unroll
    for (int i = 0; i < 33; ++i) tab[i] = (unsigned long long)p.in[i];
    tab[33] = (unsigned long long)p.out; tab[34] = (unsigned long long)p.ws;
}
__device__ __forceinline__ Params params_from_lds(LAS unsigned char* lds) {
    const LAS unsigned long long* tab = (const LAS unsigned long long*)(lds + LDS_PTAB);
    Params p;
#pragma unroll
    for (int i = 0; i < 33; ++i) p.in[i] = (const float*)(const __attribute__((address_space(1))) float*)uni64(tab[i]);
    p.out = (float*)(__attribute__((address_space(1))) float*)uni64(tab[33]); p.ws = (unsigned char*)(__attribute__((address_space(1))) unsigned char*)uni64(tab[34]); p.layer = 0; p.pad = 0;
    return p;
}
#endif
template <int Q> __device__ __forceinline__ void run_q(const Params& p_in, const Ctx& c_in, int l) {
    Ctx c = c_in;
    asm volatile("" : "+s"(c.wave), "+s"(c.bid), "+s"(c.G), "+s"(l));
    c.lane = fresh_lane(); c.tid = c.wave * 64 + c.lane;
#if MK_MEGA
    const Params p = params_from_lds(c.lds);
#else
    const Params& p = p_in;
#endif
    const float* xin = (l == 0) ? p.in[I_X] : p.out;
    if constexpr (Q == 14) { RUN(1, phase_prep_io(p, c); __syncthreads(); phase_prep_small(p, c)); __syncthreads(); RUN(2, phase_prep_experts(p, c, 0)); }
    if constexpr (Q == 0) { RUN(3, phase_norm_mix(p, c, l, xin)); }
    if constexpr (Q == 1) { pg8::Gemm g{(const bf16_t*)(p.ws + WS_H), (const bf16_t*)(p.ws + WS_WIN) + (size_t)l * NU * DM, DM, 0};
              pg8::DenseOrder S; S.init(NTOK, NU, c.G, c.bid); EpiU E{(bf16_t*)(p.ws + WS_U), NU};
              RUN(4, (pg8::gemm_phase<EpiU, pg8::DenseOrder, pg8::DenseRows, true, true>(c.lds, g, S, E, pg8::DenseRows(), c.wave))); }
    if constexpr (Q == 2) { RUN(5, phase_ssd_conv(p, c, l)); __syncthreads(); RUN(6, phase_hg_state(p, c, l)); __syncthreads(); RUN(7, phase_lru1(p, c, l)); }
    if constexpr (Q == 3) { RUN(8, phase_ssd_state(p, c)); __syncthreads(); phase_hg_scan(p, c); __syncthreads(); RUN(9, phase_lru2(p, c, l)); }
    if constexpr (Q == 4) { phase_ssd_scan(p, c); __syncthreads(); RUN(10, phase_hg_out(p, c, l)); }
    if constexpr (Q == 5) RUN(11, phase_ssd_out_g(p, c, l));
    if constexpr (Q == 7) { pg8::Gemm g{(const bf16_t*)(p.ws + WS_YCAT), (const bf16_t*)(p.ws + WS_WOUT) + (size_t)l * DM * 2048, 2048, 0};
              pg8::DenseOrder S; S.init(NTOK, DM, c.G, c.bid); EpiU E{(bf16_t*)(p.ws + WS_MIX), DM};
              pg8::gemm_phase<EpiU, pg8::DenseOrder, pg8::DenseRows, false, true>(c.lds, g, S, E, pg8::DenseRows(), c.wave);
              if constexpr (PROBE_ID == 13) { __syncthreads(); pg8::gemm_phase<EpiU, pg8::DenseOrder, pg8::DenseRows, false, true>(c.lds, g, S, E, pg8::DenseRows(), c.wave); } }
    if constexpr (Q == 8) RUN(14, phase_norm_router(p, c, l, xin));
    if constexpr (Q == 9) RUN(15, phase_route_assign(p, c));
    if constexpr (Q == 11) { pg8::Gemm g{(const bf16_t*)(p.ws + WS_H), (const bf16_t*)(p.ws + WS_GU), DM, (size_t)512 * DM * 2};
               moe_build_units(c.lds, (const int*)(p.ws + WS_RINFO), 2, c.G, (c.G % 8 == 0) ? (c.bid % 8) * (c.G / 8) + c.bid / 8 : c.bid, c.tid);
               MoeOrder S{(const LAS int*)(c.lds + LDS_UTAB)}; EpiH E{(bf16_t*)(p.ws + WS_HMID)};
               GatherRows AM{(const int*)(p.ws + WS_SLOTTOK), (const int*)(p.ws + WS_RINFO)};
               RUN(16, (pg8::gemm_phase<EpiH, MoeOrder, GatherRows, true, true>(c.lds, g, S, E, AM, c.wave))); }
    if constexpr (Q == 12) { pg8::Gemm g{(const bf16_t*)(p.ws + WS_HMID), (const bf16_t*)(p.ws + WS_DN), 256, (size_t)DM * 256 * 2};
               moe_build_units(c.lds, (const int*)(p.ws + WS_RINFO), 4, c.G, (c.G % 8 == 0) ? (c.bid % 8) * (c.G / 8) + c.bid / 8 : c.bid, c.tid);
               MoeOrder S{(const LAS int*)(c.lds + LDS_UTAB)};
               EpiY E{(unsigned char*)(p.ws + WS_Y), (unsigned char*)(p.ws + WS_YSH), (const int*)(p.ws + WS_RINFO)};
               RUN(17, (pg8::gemm_phase<EpiY, MoeOrder, pg8::DenseRows, true, true>(c.lds, g, S, E, pg8::DenseRows(), c.wave))); }
    if constexpr (Q == 13) { phase_combine(p, c, l, xin); if (l + 1 < NLAYER) { __syncthreads(); RUN(2, phase_prep_experts(p, c, l + 1)); } }
}

#if MK_MEGA
__global__ void __launch_bounds__(NTHREADS, 2) trunk_kernel(Params p) {
    extern __shared__ __attribute__((aligned(16))) unsigned char lds_raw[];
    Ctx c; c.lds = (LAS unsigned char*)lds_raw; c.tid = 0; c.lane = 0; c.wave = __builtin_amdgcn_readfirstlane(threadIdx.x >> 6); c.G = gridDim.x; c.bid = blockIdx.x;
    cg::grid_group grid = cg::this_grid();
    unsigned* const xbar = (unsigned*)(p.ws + WS_CTL) + 4096;
    if (threadIdx.x == 0) { params_to_lds(p, c.lds); ((LAS unsigned*)(c.lds + LDS_XBST))[0] = 0u; ((LAS unsigned*)(c.lds + LDS_XBST))[1] = 0u; ((LAS unsigned long long*)(c.lds + LDS_PTAB))[35] = (unsigned long long)xbar;
                            (void)xb_add(&xbar[XB_XCNT(xb_xcc_id())], 1u); }
    __syncthreads();
#define GSYNC1() do { unsigned* bar_ = (unsigned*)(__attribute__((address_space(1))) unsigned*)uni64(((const LAS unsigned long long*)(c.lds + LDS_PTAB))[35]); \
        xcd_barrier(bar_, (volatile LAS unsigned*)(c.lds + LDS_XBST), (c.wave == 0) && (fresh_lane() == 0)); } while (0)
#define GSYNC() do { GSYNC1(); if constexpr (PROBE_ID == 18) GSYNC1(); } while (0)
#define LAYER(l) do { \
        if ((l) == 0) { run_q<0>(p, c, l); GSYNC(); } run_q<1>(p, c, l); GSYNC(); run_q<2>(p, c, l); GSYNC(); run_q<3>(p, c, l); GSYNC(); run_q<4>(p, c, l); GSYNC(); \
        run_q<5>(p, c, l); GSYNC(); run_q<7>(p, c, l); GSYNC(); run_q<8>(p, c, l); GSYNC(); run_q<9>(p, c, l); GSYNC(); \
        run_q<11>(p, c, l); GSYNC(); run_q<12>(p, c, l); GSYNC(); run_q<13>(p, c, l); } while (0)
    run_q<14>(p, c, 0); __syncthreads(); grid.sync();
    LAYER(0); GSYNC();
    LAYER(1);
}
#else
template <int Q> __global__ void __launch_bounds__(NTHREADS, 2) phase_kernel(Params p) {
    extern __shared__ __attribute__((aligned(16))) unsigned char lds_raw[];
    Ctx c; c.lds = (LAS unsigned char*)lds_raw; c.tid = 0; c.lane = 0; c.wave = __builtin_amdgcn_readfirstlane(threadIdx.x >> 6); c.G = gridDim.x; c.bid = blockIdx.x;
    run_q<Q>(p, c, p.layer);
}
template <int Q> static void launch_q(const Params& p, int grid, hipStream_t stream) {
    static bool attr = false;
    if (!attr) { (void)hipFuncSetAttribute((const void*)phase_kernel<Q>, hipFuncAttributeMaxDynamicSharedMemorySize, LDS_BYTES); attr = true; }
    hipLaunchKernelGGL(phase_kernel<Q>, dim3(grid), dim3(NTHREADS), LDS_BYTES, stream, p);
}
#endif

extern "C" void kernel_launch(void* const* d_in, const int* in_sizes, int n_in, void* d_out, int out_size, void* d_ws, size_t ws_size, hipStream_t stream) {
    static int grid = 0;
    if (grid == 0) {
        if (n_in != 33 || out_size != NTOK * DM || ws_size < WS_END) { fprintf(stderr, "kernel_launch: unexpected shapes (n_in %d out %d ws %zu)\n", n_in, out_size, ws_size); grid = -1; return; }
        int dev = 0, cus = 0;
        (void)hipGetDevice(&dev); (void)hipDeviceGetAttribute(&cus, hipDeviceAttributeMultiprocessorCount, dev);
        grid = cus > 0 ? cus : 256;
#if MK_MEGA
        int per_cu = 0;
        if (hipFuncSetAttribute((const void*)trunk_kernel, hipFuncAttributeMaxDynamicSharedMemorySize, LDS_BYTES) != hipSuccess) { fprintf(stderr, "kernel_launch: hipFuncSetAttribute failed\n"); grid = -1; return; }
        if (hipOccupancyMaxActiveBlocksPerMultiprocessor(&per_cu, (const void*)trunk_kernel, NTHREADS, LDS_BYTES) != hipSuccess || per_cu < 1) { fprintf(stderr, "kernel_launch: occupancy query says %d blocks/CU\n", per_cu); grid = -1; return; }
        (void)hipGetLastError();
#endif
    }
    if (grid < 0) return;
    (void)hipMemsetAsync((char*)d_ws + WS_CTL, 0, CTL_ZERO_BYTES, stream);
    Params p{};
    for (int i = 0; i < 33; ++i) p.in[i] = (const float*)d_in[i];
    p.out = (float*)d_out; p.ws = (unsigned char*)d_ws;
#if MK_MEGA
    void* args[] = {&p};
    hipError_t e = hipLaunchCooperativeKernel((const void*)trunk_kernel, dim3(grid), dim3(NTHREADS), args, LDS_BYTES, stream);
    if (e != hipSuccess) fprintf(stderr, "cooperative launch failed: %s (grid %d)\n", hipGetErrorString(e), grid);
#else
    p.layer = 0; launch_q<14>(p, grid, stream);
    for (int l = 0; l < NLAYER; ++l) {
        p.layer = l;
        launch_q<0>(p, grid, stream); launch_q<1>(p, grid, stream); launch_q<2>(p, grid, stream); launch_q<3>(p, grid, stream); launch_q<4>(p, grid, stream);
        launch_q<5>(p, grid, stream); launch_q<6>(p, grid, stream); launch_q<7>(p, grid, stream); launch_q<8>(p, grid, stream); launch_q<9>(p, grid, stream);
        launch_q<10>(p, grid, stream); launch_q<11>(p, grid, stream); launch_q<12>(p, grid, stream); launch_q<13>(p, grid, stream);
    }
#endif
}
```
